# Optimizing an MI355X kernel written in HIP

```python
import math
import jax, jax.numpy as jnp
from jax import lax
import numpy as np

D_MODEL = 1024
BATCH = 2
SEQ = 8192
DEPTH = 1

N_MEM = 256
D_LRU = 512
LRU_BLOCKS = 8
CONV_W = 4
LRU_C = 8.0
N_HEADS = 8
N_KV = 2
HEAD_DIM = 64
D_NSA = N_HEADS * HEAD_DIM
D_MIX = D_LRU + D_NSA
CMP_BLOCK = 32
CMP_STRIDE = 16
SEL_BLOCK = 64
N_SELECT = 16
WINDOW = 512
Q_BLOCK = 128
MEM_HEADS = 4
MEM_HEAD_DIM = D_MODEL // MEM_HEADS
PEER_HEADS = 8
PEER_NKEYS = 128
PEER_N = PEER_NKEYS * PEER_NKEYS
PEER_TOPK = 16
PEER_QDIM = 256
PEER_TOK_BLOCK = 128
EPS = 1e-6
KV_W = N_KV * HEAD_DIM
IN_SIZES = [D_LRU, D_LRU, D_NSA, KV_W, KV_W, KV_W, KV_W, KV_W, KV_W, 3 * N_HEADS]
N_IN = sum(IN_SIZES)

kernel_name = 'hymba_style_rglru_nsa_peer_block'


def rmsnorm(x, g):
    xf = x.astype(jnp.float32)
    y = xf * lax.rsqrt(jnp.mean(xf * xf, axis=-1, keepdims=True) + EPS)
    return (y * g.astype(jnp.float32)).astype(x.dtype)


def masked_softmax(s, mask):
    s = jnp.where(mask, s.astype(jnp.float32), -1e30)
    p = jax.nn.softmax(s, axis=-1)
    return jnp.where(mask, p, 0.0)


def rg_lru(xb, gate, conv_w, conv_b, w_a, b_a, w_i, b_i, lam):
    B, S, _ = xb.shape
    xp = jnp.pad(xb, ((0, 0), (CONV_W - 1, 0), (0, 0)))
    xc = conv_b
    for k in range(CONV_W):
        xc = xc + xp[:, k:k + S] * conv_w[k]
    xh = xc.reshape(B, S, LRU_BLOCKS, D_LRU // LRU_BLOCKS)
    r = jax.nn.sigmoid(jnp.einsum('bshi,hij->bshj', xh, w_a) + b_a).reshape(B, S, D_LRU)
    i = jax.nn.sigmoid(jnp.einsum('bshi,hij->bshj', xh, w_i) + b_i).reshape(B, S, D_LRU)
    log_a = -LRU_C * r.astype(jnp.float32) * jax.nn.softplus(-lam.astype(jnp.float32))
    a = jnp.exp(log_a)
    b = jnp.sqrt(-jnp.expm1(2.0 * log_a)) * (i * xc).astype(jnp.float32)

    def comb(left, right):
        a1, b1 = left
        a2, b2 = right
        return a1 * a2, a2 * b1 + b2

    _, h = lax.associative_scan(comb, (a, b), axis=1)
    return h.astype(xb.dtype) * jax.nn.gelu(gate)


def compress(k_raw, pos, w1, w2):
    B, S = k_raw.shape[:2]
    nc = (S - CMP_BLOCK) // CMP_STRIDE + 1
    idx = jnp.arange(nc)[:, None] * CMP_STRIDE + jnp.arange(CMP_BLOCK)[None, :]
    blk = k_raw[:, idx] + pos[None, None, :, None, :]
    blk = blk.transpose(0, 1, 3, 2, 4).reshape(B, nc, N_KV, CMP_BLOCK * HEAD_DIM)
    return jax.nn.gelu(blk @ w1) @ w2


def nsa(q, kc, vc, ks, vs, kw, vw, gates):
    B, S = q.shape[:2]
    G = N_HEADS // N_KV
    nc = kc.shape[1]
    nsb = S // SEL_BLOCK
    nsel = min(N_SELECT, nsb)
    ci = jnp.arange(nc)[:, None] * CMP_STRIDE
    bj = jnp.arange(nsb)[None, :] * SEL_BLOCK
    overlap = ((ci < bj + SEL_BLOCK) & (ci + CMP_BLOCK > bj)).astype(jnp.float32)
    cmp_end = jnp.arange(nc) * CMP_STRIDE + CMP_BLOCK - 1
    ks_b = ks.reshape(B, nsb, SEL_BLOCK, N_KV, HEAD_DIM).transpose(0, 3, 1, 2, 4)
    vs_b = vs.reshape(B, nsb, SEL_BLOCK, N_KV, HEAD_DIM).transpose(0, 3, 1, 2, 4)
    kw_p = jnp.pad(kw, ((0, 0), (WINDOW, 0), (0, 0), (0, 0)))
    vw_p = jnp.pad(vw, ((0, 0), (WINDOW, 0), (0, 0), (0, 0)))
    q5 = q.reshape(B, S, N_KV, G, HEAD_DIM) * (HEAD_DIM ** -0.5)
    bi = jnp.arange(B)[:, None, None, None]
    hi = jnp.arange(N_KV)[None, :, None, None]
    jb = jnp.arange(nsb)

    def block(c):
        s0 = c * Q_BLOCK
        t = s0 + jnp.arange(Q_BLOCK)
        qc = lax.dynamic_slice_in_dim(q5, s0, Q_BLOCK, axis=1)
        gc = lax.dynamic_slice_in_dim(gates, s0, Q_BLOCK, axis=1)
        sc = jnp.einsum('bqkgd,bnkd->bkgqn', qc, kc)
        mc = cmp_end[None, :] <= t[:, None]
        pc = masked_softmax(sc, mc)
        o_cmp = jnp.einsum('bkgqn,bnkd->bqkgd', pc.astype(vc.dtype), vc)
        imp = jnp.einsum('bkgqn,nj->bkqj', pc, overlap)
        cur = t // SEL_BLOCK
        valid = jb[None, :] <= cur[:, None]
        forced = (jb[None, :] == 0) | (jb[None, :] == cur[:, None]) | (jb[None, :] == cur[:, None] - 1)
        imp = jnp.where(valid, jnp.where(forced, jnp.inf, imp), -jnp.inf)
        top, idx = lax.top_k(imp, nsel)
        kg = ks_b[bi, hi, idx]
        vg = vs_b[bi, hi, idx]
        tok = idx[..., None] * SEL_BLOCK + jnp.arange(SEL_BLOCK)
        ms = (top > -1.0)[..., None] & (tok <= t[None, None, :, None, None])
        ss = jnp.einsum('bqkgd,bkqsld->bkgqsl', qc, kg)
        ps = masked_softmax(ss.reshape(B, N_KV, G, Q_BLOCK, nsel * SEL_BLOCK),
                            ms.reshape(B, N_KV, 1, Q_BLOCK, nsel * SEL_BLOCK)).reshape(ss.shape)
        o_slc = jnp.einsum('bkgqsl,bkqsld->bqkgd', ps.astype(vg.dtype), vg)
        kwc = lax.dynamic_slice_in_dim(kw_p, s0, Q_BLOCK + WINDOW, axis=1)
        vwc = lax.dynamic_slice_in_dim(vw_p, s0, Q_BLOCK + WINDOW, axis=1)
        kpos = s0 - WINDOW + jnp.arange(Q_BLOCK + WINDOW)
        mw = (kpos[None, :] <= t[:, None]) & (kpos[None, :] > t[:, None] - WINDOW) & (kpos[None, :] >= 0)
        sw = jnp.einsum('bqkgd,bnkd->bkgqn', qc, kwc)
        pw = masked_softmax(sw, mw)
        o_win = jnp.einsum('bkgqn,bnkd->bqkgd', pw.astype(vwc.dtype), vwc)
        out = gc[..., 0:1] * o_cmp + gc[..., 1:2] * o_slc + gc[..., 2:3] * o_win
        return out.reshape(B, Q_BLOCK, D_NSA)

    outs = lax.map(block, jnp.arange(S // Q_BLOCK))
    return outs.transpose(1, 0, 2, 3).reshape(B, S, D_NSA)


def mem_attn(xn, memn, wq, wk, wv, wo):
    B, S, _ = xn.shape
    M = memn.shape[1]
    q = (xn @ wq).reshape(B, S, MEM_HEADS, MEM_HEAD_DIM) * (MEM_HEAD_DIM ** -0.5)
    k = (memn @ wk).reshape(B, M, MEM_HEADS, MEM_HEAD_DIM)
    v = (memn @ wv).reshape(B, M, MEM_HEADS, MEM_HEAD_DIM)
    s = jnp.einsum('bshd,bmhd->bhsm', q, k).astype(jnp.float32)
    p = jax.nn.softmax(s, axis=-1).astype(v.dtype)
    o = jnp.einsum('bhsm,bmhd->bshd', p, v).reshape(B, S, D_MODEL)
    return o @ wo


def peer(xn, w_pq, sub_keys, U, V):
    B, S, D = xn.shape
    xt = xn.reshape(-1, PEER_TOK_BLOCK, D)

    def block(xc):
        T = xc.shape[0]
        q = (xc @ w_pq).reshape(T, PEER_HEADS, 2, PEER_QDIM // 2)
        s = jnp.einsum('thcd,hcnd->thcn', q, sub_keys).astype(jnp.float32)
        v1, i1 = lax.top_k(s[:, :, 0], PEER_TOPK)
        v2, i2 = lax.top_k(s[:, :, 1], PEER_TOPK)
        cand = (v1[..., :, None] + v2[..., None, :]).reshape(T, PEER_HEADS, PEER_TOPK * PEER_TOPK)
        cid = (i1[..., :, None] * PEER_NKEYS + i2[..., None, :]).reshape(T, PEER_HEADS, PEER_TOPK * PEER_TOPK)
        top, pos = lax.top_k(cand, PEER_TOPK)
        eid = jnp.take_along_axis(cid, pos, axis=-1)
        g = jax.nn.softmax(top, axis=-1).astype(xc.dtype)
        u = U[eid]
        v = V[eid]
        h = jax.nn.gelu(jnp.einsum('td,thkd->thk', xc, u))
        return jnp.einsum('thk,thkd->td', g * h, v)

    return lax.map(block, xt).reshape(B, S, D)


def setup_inputs(seed: int = 0) -> dict:
    key = jax.random.key(seed)
    ks = iter(jax.random.split(key, 40))
    f32 = jnp.float32

    def nrm(shape, scale):
        return jax.random.normal(next(ks), shape, f32) * scale

    def gain(shape):
        return 1.0 + 0.02 * jax.random.normal(next(ks), shape, f32)

    L = DEPTH
    bd = D_LRU // LRU_BLOCKS
    u = jax.random.uniform(next(ks), (L, D_LRU), f32, minval=0.9, maxval=0.999)
    a0 = u ** (1.0 / LRU_C)
    lam = jnp.log(a0) - jnp.log1p(-a0)
    return {
        'x': nrm((BATCH, SEQ, D_MODEL), 1.0),
        'mem': nrm((BATCH, N_MEM, D_MODEL), 1.0),
        'g_mix': gain((L, D_MODEL)),
        'w_in': nrm((L, D_MODEL, N_IN), D_MODEL ** -0.5),
        'b_gate': nrm((L, 3 * N_HEADS), 0.1),
        'conv_w': nrm((L, CONV_W, D_LRU), CONV_W ** -0.5),
        'conv_b': nrm((L, D_LRU), 0.02),
        'w_rg_a': nrm((L, LRU_BLOCKS, bd, bd), bd ** -0.5),
        'b_rg_a': nrm((L, LRU_BLOCKS, bd), 0.1),
        'w_rg_i': nrm((L, LRU_BLOCKS, bd, bd), bd ** -0.5),
        'b_rg_i': nrm((L, LRU_BLOCKS, bd), 0.1),
        'lam': lam,
        'cmp_pos_k': nrm((L, CMP_BLOCK, HEAD_DIM), 0.02),
        'cmp_w1_k': nrm((L, CMP_BLOCK * HEAD_DIM, HEAD_DIM), (CMP_BLOCK * HEAD_DIM) ** -0.5),
        'cmp_w2_k': nrm((L, HEAD_DIM, HEAD_DIM), HEAD_DIM ** -0.5),
        'cmp_pos_v': nrm((L, CMP_BLOCK, HEAD_DIM), 0.02),
        'cmp_w1_v': nrm((L, CMP_BLOCK * HEAD_DIM, HEAD_DIM), (CMP_BLOCK * HEAD_DIM) ** -0.5),
        'cmp_w2_v': nrm((L, HEAD_DIM, HEAD_DIM), HEAD_DIM ** -0.5),
        'g_out_lru': gain((L, D_LRU)),
        'g_out_nsa': gain((L, D_NSA)),
        'w_out': nrm((L, D_MIX, D_MODEL), D_MIX ** -0.5),
        'g_mem_q': gain((L, D_MODEL)),
        'g_mem_kv': gain((L, D_MODEL)),
        'w_mq': nrm((L, D_MODEL, D_MODEL), D_MODEL ** -0.5),
        'w_mk': nrm((L, D_MODEL, D_MODEL), D_MODEL ** -0.5),
        'w_mv': nrm((L, D_MODEL, D_MODEL), D_MODEL ** -0.5),
        'w_mo': nrm((L, D_MODEL, D_MODEL), D_MODEL ** -0.5),
        'g_ffn': gain((L, D_MODEL)),
        'w_pq': nrm((L, D_MODEL, PEER_HEADS * PEER_QDIM), D_MODEL ** -0.5),
        'sub_keys': nrm((L, PEER_HEADS, 2, PEER_NKEYS, PEER_QDIM // 2), (PEER_QDIM // 2) ** -0.5),
        'peer_u': nrm((L, PEER_N, D_MODEL), D_MODEL ** -0.5),
        'peer_v': nrm((L, PEER_N, D_MODEL), (PEER_HEADS * PEER_TOPK) ** -0.5),
        'g_final': gain((D_MODEL,)),
    }


def reference(x, mem, g_mix, w_in, b_gate, conv_w, conv_b, w_rg_a, b_rg_a, w_rg_i, b_rg_i, lam,
              cmp_pos_k, cmp_w1_k, cmp_w2_k, cmp_pos_v, cmp_w1_v, cmp_w2_v, g_out_lru, g_out_nsa,
              w_out, g_mem_q, g_mem_kv, w_mq, w_mk, w_mv, w_mo, g_ffn, w_pq, sub_keys, peer_u,
              peer_v, g_final):
    B, S, _ = x.shape
    G = N_HEADS // N_KV
    offs = [int(o) for o in np.cumsum(IN_SIZES)[:-1]]

    def kv(t):
        return t.reshape(B, S, N_KV, HEAD_DIM)

    for l in range(DEPTH):
        h = rmsnorm(x, g_mix[l])
        z = h @ w_in[l]
        x_lru, gate_lru, q, k_c, v_c, k_s, v_s, k_w, v_w, g_raw = jnp.split(z, offs, axis=-1)
        y_lru = rg_lru(x_lru, gate_lru, conv_w[l], conv_b[l], w_rg_a[l], b_rg_a[l],
                       w_rg_i[l], b_rg_i[l], lam[l])
        kc = compress(kv(k_c), cmp_pos_k[l], cmp_w1_k[l], cmp_w2_k[l])
        vc = compress(kv(v_c), cmp_pos_v[l], cmp_w1_v[l], cmp_w2_v[l])
        gates = jax.nn.sigmoid(g_raw + b_gate[l]).reshape(B, S, N_KV, G, 3)
        y_nsa = nsa(q.reshape(B, S, N_HEADS, HEAD_DIM), kc, vc, kv(k_s), kv(v_s), kv(k_w), kv(v_w), gates)
        y = jnp.concatenate([rmsnorm(y_lru, g_out_lru[l]), rmsnorm(y_nsa, g_out_nsa[l])], axis=-1)
        x = x + y @ w_out[l]
        x = x + mem_attn(rmsnorm(x, g_mem_q[l]), rmsnorm(mem, g_mem_kv[l]),
                         w_mq[l], w_mk[l], w_mv[l], w_mo[l])
        x = x + peer(rmsnorm(x, g_ffn[l]), w_pq[l], sub_keys[l], peer_u[l], peer_v[l])
    return rmsnorm(x, g_final)
```

```cpp
#include <hip/hip_runtime.h>
#include <cstdio>
#include <cstdint>

namespace pg8 {
#define PG8_LAS __attribute__((address_space(3)))
typedef unsigned short bf16_t;
typedef short bf16x8 __attribute__((ext_vector_type(8)));
typedef float f32x4 __attribute__((ext_vector_type(4)));
typedef unsigned u32x4 __attribute__((ext_vector_type(4)));
constexpr int BM = 256, BK = 64, HALF = 128, HTB = HALF * BK * 2  , STAGE_BYTES = 8 * HTB, NXCD = 8, WGM = 8;

__host__ __device__ __forceinline__ int lds_byte(int r, int c) { const int st = (r >> 4) * 2 + (c >> 5), rr = r & 15, cc = c & 31, ob = rr * 64 + cc * 2; return st * 1024 + (ob ^ (((ob >> 9) & 1) << 5)); }
__host__ __device__ __forceinline__ void stage_rc(int b, int& R, int& C) { const int st = b / 1024, sb = b % 1024, swz = sb ^ (((sb >> 9) & 1) << 5); R = (st >> 1) * 16 + swz / 64; C = (st & 1) * 32 + (swz % 64) / 2; }
__host__ __device__ __forceinline__ int perm32(int rho) { const int n = rho >> 4, i = rho & 15; return 8 * (i >> 2) + 4 * n + (i & 3); }

struct Unit { int pm, pn; };
struct Gemm { const bf16_t* A; const bf16_t* Bt; int M, N, K; };

struct StaticOrder {
    int nM, nN, nwg, G, c;
    __host__ __device__ void init(int M, int N, int G_, int c_) { nM = M / BM; nN = N / BM; nwg = nM * nN; G = G_; c = c_; }
    __host__ __device__ bool next(int i, Unit& u) const {
        const long L = (long)i * G + c; if (L >= nwg) return false;
        int wgid = (int)L; { const int q = nwg / NXCD, r = nwg % NXCD, xcd = wgid % NXCD, off = wgid / NXCD; wgid = (xcd < r ? xcd * (q + 1) : r * (q + 1) + (xcd - r) * q) + off; }
        const int nig = WGM * nN, gid = wgid / nig, fm = gid * WGM, gsz = (nM - fm) < WGM ? (nM - fm) : WGM;
        u.pm = fm + ((wgid % nig) % gsz); u.pn = (wgid % nig) / gsz; return true;
    }
    __device__ __forceinline__ void a_ready(const Unit&) const {}
    __device__ __forceinline__ void done(const Unit&) const {}
};

__device__ __forceinline__ unsigned cvt_pk_bf16(float lo, float hi) { unsigned r; asm volatile("v_cvt_pk_bf16_f32 %0, %1, %2" : "=v"(r) : "v"(lo), "v"(hi)); return r; }
typedef float f32x2 __attribute__((ext_vector_type(2)));
typedef unsigned u32x2 __attribute__((ext_vector_type(2)));
__device__ __forceinline__ unsigned short f2bf1(float f) { unsigned u = __builtin_bit_cast(unsigned, f); return (unsigned short)((u + 0x7fffu + ((u >> 16) & 1u)) >> 16); }
struct EpiZ {
    static constexpr bool PERM = true, AFTER_DRAIN = false, MIDSCALE = false;
    bf16_t* Z; bf16_t* KSF; bf16_t* VSF; bf16_t* KWF; bf16_t* VWF; float* GATES; const float* bgate;
    __device__ __forceinline__ void operator()(const f32x4 (&acc)[2][2][4][2], const Unit& u, int wr, int wc, int fr, int fq) const {
        const int row0 = u.pm * BM + wr * 64 + fr;
        if (u.pn < 9) {
            const int col0 = u.pn * BM + wc * 32 + 8 * fq;
#pragma unroll
            for (int ai = 0; ai < 2; ++ai)
#pragma unroll
                for (int m = 0; m < 4; ++m) { bf16_t* rowp = Z + (size_t)(row0 + ai * HALF + m * 16) * 2304 + col0;
#pragma unroll
                    for (int bj = 0; bj < 2; ++bj) { const f32x4 v0 = acc[ai][bj][m][0], v1 = acc[ai][bj][m][1];
                        u32x4 w; w.x = cvt_pk_bf16(v0[0], v0[1]); w.y = cvt_pk_bf16(v0[2], v0[3]); w.z = cvt_pk_bf16(v1[0], v1[1]); w.w = cvt_pk_bf16(v1[2], v1[3]);
                        *(u32x4*)(rowp + bj * HALF) = w; } }
            if (u.pn >= 7) {
                bf16_t* KF = (u.pn == 7) ? KSF : KWF; bf16_t* VF = (u.pn == 7) ? VSF : VWF;
                const int kvh = wc >> 1, dbase = 32 * (wc & 1) + 8 * fq;
#pragma unroll
                for (int ai = 0; ai < 2; ++ai)
#pragma unroll
                    for (int m = 0; m < 4; ++m) { const int row = row0 + ai * HALF + m * 16, b = row >> 13, s = row & 8191, tile = s >> 5, k = s & 31;
                        const size_t tb = ((size_t)(b * 2 + kvh) * 256 + tile) * 2048;
                        { const f32x4 v0 = acc[ai][0][m][0], v1 = acc[ai][0][m][1];
                          u32x4 w; w.x = cvt_pk_bf16(v0[0], v0[1]); w.y = cvt_pk_bf16(v0[2], v0[3]); w.z = cvt_pk_bf16(v1[0], v1[1]); w.w = cvt_pk_bf16(v1[2], v1[3]);
                          *(u32x4*)(KF + tb + (dbase >> 4) * 512 + ((dbase >> 3) & 1) * 256 + k * 8) = w; }
                        const int kk = k & 15, vo = ((kk >> 2) & 1) * 512 + (k >> 4) * 8 + (kk & 3) + 4 * (kk >> 3);
                        unsigned char* V8 = (unsigned char*)VF + ((size_t)(b * 2 + kvh) * 256 + tile) * 2048;
#pragma unroll
                        for (int n = 0; n < 2; ++n) { const f32x4 v = acc[ai][1][m][n]; int w = 0; w = __builtin_amdgcn_cvt_pk_fp8_f32(v[0], v[1], w, false); w = __builtin_amdgcn_cvt_pk_fp8_f32(v[2], v[3], w, true);
#pragma unroll
                            for (int e = 0; e < 4; ++e) { const int d = dbase + 4 * n + e; V8[(d >> 5) * 1024 + (d & 31) * 16 + vo] = (unsigned char)((unsigned)w >> (8 * e)); } }
                        asm volatile("" ::: "memory"); }
            }
        } else {
            if (wc == 0 && fq < 3) {
#pragma unroll
                for (int ai = 0; ai < 2; ++ai)
#pragma unroll
                    for (int m = 0; m < 4; ++m) { const int row = row0 + ai * HALF + m * 16;
#pragma unroll
                        for (int n = 0; n < 2; ++n)
#pragma unroll
                            for (int e = 0; e < 4; ++e) { const int c = 8 * fq + 4 * n + e; const float v = acc[ai][0][m][n][e] + bgate[c]; GATES[(size_t)row * 24 + c] = 1.0f / (1.0f + __expf(-v)); } }
            }
        }
    }
};
struct EpiStore {
    static constexpr bool PERM = true, AFTER_DRAIN = false, MIDSCALE = false;
    bf16_t* O; int ldc; const float* ssq; int frag;
    __device__ __forceinline__ void operator()(const f32x4 (&acc)[2][2][4][2], const Unit& u, int wr, int wc, int fr, int fq) const {
        const int row0 = u.pm * BM + wr * 64 + fr; const int col0 = u.pn * BM + wc * 32 + 8 * fq;
#pragma unroll
        for (int ai = 0; ai < 2; ++ai)
#pragma unroll
            for (int m = 0; m < 4; ++m) { const int row = row0 + ai * HALF + m * 16;
                bf16_t* rowp = frag ? O + (size_t)(row >> 5) * 32 * ldc + (size_t)(col0 >> 4) * 512 + ((col0 >> 3) & 1) * 256 + (row & 31) * 8 : O + (size_t)row * ldc + col0;
                const int bjstep = frag ? (HALF >> 4) * 512 : HALF;
                float sc = 1.f;
                if (ssq) { const f32x4* p = (const f32x4*)(ssq + (size_t)row * 16); const f32x4 a = p[0], b = p[1], c = p[2], d = p[3];
                    const float s = ((a[0] + a[1]) + (a[2] + a[3])) + ((b[0] + b[1]) + (b[2] + b[3])) + ((c[0] + c[1]) + (c[2] + c[3])) + ((d[0] + d[1]) + (d[2] + d[3]));
                    sc = rsqrtf(s * (1.0f / 1024.0f) + 1e-6f); }
#pragma unroll
                for (int bj = 0; bj < 2; ++bj) { const f32x4 v0 = acc[ai][bj][m][0] * sc, v1 = acc[ai][bj][m][1] * sc;
                    u32x4 w; w.x = cvt_pk_bf16(v0[0], v0[1]); w.y = cvt_pk_bf16(v0[2], v0[3]); w.z = cvt_pk_bf16(v1[0], v1[1]); w.w = cvt_pk_bf16(v1[2], v1[3]);
                    *(u32x4*)(rowp + bj * bjstep) = w; } }
    }
};
struct EpiVFrag {
    static constexpr bool PERM = true, AFTER_DRAIN = false, MIDSCALE = false;
    bf16_t* O;
    __device__ __forceinline__ void operator()(const f32x4 (&acc)[2][2][4][2], const Unit& u, int wr, int wc, int fr, int fq) const {
        const int row0 = u.pm * BM + wr * 64 + fr; const int col0 = u.pn * BM + wc * 32 + 8 * fq;
#pragma unroll
        for (int ai = 0; ai < 2; ++ai)
#pragma unroll
            for (int m = 0; m < 4; ++m) { const int D = row0 + ai * HALF + m * 16, h = D >> 8, dt = (D >> 5) & 7, r = D & 31;
#pragma unroll
                for (int bj = 0; bj < 2; ++bj) { const int K0 = col0 + bj * HALF, b = K0 >> 8, kt = (K0 >> 5) & 7, k0 = K0 & 31;
                    bf16_t* p = O + (size_t)((b * 4 + h) * 8 + kt) * 8192 + dt * 1024 + (k0 >> 4) * 512 + r * 8 + 4 * ((k0 >> 3) & 1);
                    const f32x4 v0 = acc[ai][bj][m][0], v1 = acc[ai][bj][m][1];
                    u32x2 w0, w1; w0.x = cvt_pk_bf16(v0[0], v0[1]); w0.y = cvt_pk_bf16(v0[2], v0[3]); w1.x = cvt_pk_bf16(v1[0], v1[1]); w1.y = cvt_pk_bf16(v1[2], v1[3]);
                    *(u32x2*)p = w0; *(u32x2*)(p + 256) = w1; } }
    }
};
template <bool MID> struct EpiRes {
    static constexpr bool PERM = false, AFTER_DRAIN = false, MIDSCALE = MID;
    const float* base; const bf16_t* base16; float* out; bf16_t* XB; float* ssq; const float* ssqn;
    __device__ __forceinline__ void midscale(f32x4 (&acc)[2][2][4][2], const Unit& u, int wr, int wc, int fr, int fq) const {
        const int row0 = u.pm * BM + wr * 64 + fr;
#pragma unroll
        for (int ai = 0; ai < 2; ++ai)
#pragma unroll
            for (int m = 0; m < 4; ++m) { const int row = row0 + ai * HALF + m * 16; const f32x2 sq = *(const f32x2*)(ssqn + (size_t)row * 2);
                const float sc = rsqrtf((sq[0] + sq[1]) * (1.0f / 512.0f) + 1e-6f);
#pragma unroll
                for (int bj = 0; bj < 2; ++bj)
#pragma unroll
                    for (int n = 0; n < 2; ++n) acc[ai][bj][m][n] = acc[ai][bj][m][n] * sc; }
    }
    __device__ __forceinline__ void operator()(const f32x4 (&acc)[2][2][4][2], const Unit& u, int wr, int wc, int fr, int fq) const {
        const int row0 = u.pm * BM + wr * 64 + fr; const int col0 = u.pn * BM + wc * 32 + 4 * fq;
#pragma unroll
        for (int ai = 0; ai < 2; ++ai)
#pragma unroll
            for (int m = 0; m < 4; ++m) { const int row = row0 + ai * HALF + m * 16; const size_t off = (size_t)row * 1024 + col0; float s = 0.f;
#pragma unroll
                for (int bj = 0; bj < 2; ++bj)
#pragma unroll
                    for (int n = 0; n < 2; ++n) { f32x4 b;
                        if (base) b = *(const f32x4*)(base + off + bj * HALF + n * 16);
                        else { const u32x2 w = *(const u32x2*)(base16 + off + bj * HALF + n * 16); b[0] = __builtin_bit_cast(float, w.x << 16); b[1] = __builtin_bit_cast(float, w.x & 0xffff0000u); b[2] = __builtin_bit_cast(float, w.y << 16); b[3] = __builtin_bit_cast(float, w.y & 0xffff0000u); }
                        const f32x4 v = b + acc[ai][bj][m][n];
                        if (out) *(f32x4*)(out + off + bj * HALF + n * 16) = v;
                        s += (v[0] * v[0] + v[1] * v[1]) + (v[2] * v[2] + v[3] * v[3]);
                        u32x2 w; w.x = cvt_pk_bf16(v[0], v[1]); w.y = cvt_pk_bf16(v[2], v[3]); *(u32x2*)(XB + off + bj * HALF + n * 16) = w; }
                s += __shfl_xor(s, 16); s += __shfl_xor(s, 32);
                if (fq == 0) ssq[(size_t)row * 16 + u.pn * 4 + wc] = s;
                asm volatile("" ::: "memory"); }
    }
};
template <class Epi, class Sched, bool ALIGN_EPI = false, bool SP2 = false>
__device__ __forceinline__ void gemm_phase(PG8_LAS unsigned char* lds, const Gemm g, const Sched& S, const Epi& E, int wave  ) {
    int lane; asm volatile("v_mbcnt_lo_u32_b32 %0, -1, 0\n\tv_mbcnt_hi_u32_b32 %0, -1, %0" : "=v"(lane));
    const int wid = wave, tid = wid * 64 + lane, wr = wid >> 2, wc = wid & 3, fr = lane & 15, fq = lane >> 4;
    const int K = g.K, nt = K / BK;
    unsigned voffA[2], voffB[2];
#pragma unroll
    for (int i = 0; i < 2; ++i) { int R, C; stage_rc(tid * 16 + i * 8192, R, C); const int Rb = Epi::PERM ? ((R & ~31) + perm32(R & 31)) : R;
        voffA[i] = (unsigned)(R * K + C) * 2u; voffB[i] = (unsigned)(Rb * K + C) * 2u; }
    const size_t kstep = (size_t)(BK * 2);
    const size_t hstep = (size_t)HALF * K * 2;
    const size_t tstep = 2 * hstep;
    const unsigned ldsw = (unsigned)wid * 1024u;
    const int aoff = lds_byte(wr * 64 + fr, fq * 8), boff = lds_byte(wc * 32 + fr, fq * 8);
#define PG8_SA(b, h) (((b) * 2 + (h)) * HTB)
#define PG8_SB(b, h) ((4 + (b) * 2 + (h)) * HTB)
#define PG8_STAGE(bufoff, gbase, voff) do { _Pragma("unroll") for (int _i = 0; _i < 2; ++_i) \
        __builtin_amdgcn_global_load_lds((const unsigned*)((const char*)(gbase) + (voff)[_i]), (PG8_LAS unsigned*)(lds + (bufoff) + ldsw + _i * 8192), 16, 0, 0); } while (0)
#define PG8_LDA(dst, b, h) do { _Pragma("unroll") for (int m = 0; m < 4; ++m) _Pragma("unroll") for (int k = 0; k < 2; ++k) dst[m][k] = *(const PG8_LAS bf16x8*)(lds + PG8_SA(b, h) + aoff + m * 2048 + k * 1024); } while (0)
#define PG8_LDB(dst, b, h) do { _Pragma("unroll") for (int n = 0; n < 2; ++n) _Pragma("unroll") for (int k = 0; k < 2; ++k) dst[n][k] = *(const PG8_LAS bf16x8*)(lds + PG8_SB(b, h) + boff + n * 2048 + k * 1024); } while (0)
#define PG8_MMA(ai, bj, At, Bt) do { __builtin_amdgcn_s_setprio(1); _Pragma("unroll") for (int m = 0; m < 4; ++m) _Pragma("unroll") for (int n = 0; n < 2; ++n) _Pragma("unroll") for (int k = 0; k < 2; ++k) \
        acc[ai][bj][m][n] = __builtin_amdgcn_mfma_f32_16x16x32_bf16(Bt[n][k], At[m][k], acc[ai][bj][m][n], 0, 0, 0); __builtin_amdgcn_s_setprio(0); } while (0)
#define PG8_WAIT_V(n) asm volatile("s_waitcnt vmcnt(" #n ")" ::: "memory")
#define PG8_WAIT_L(n) asm volatile("s_waitcnt lgkmcnt(" #n ")" ::: "memory")
#define PG8_BAR __builtin_amdgcn_s_barrier()
#define PG8_SCHED __builtin_amdgcn_sched_barrier(0)
    Unit cur, nxt; int ui = 0;
    if (!S.next(0, cur)) return;
    f32x4 acc[2][2][4][2];
#pragma unroll
    for (int a = 0; a < 2; ++a)
#pragma unroll
        for (int b = 0; b < 2; ++b)
#pragma unroll
            for (int m = 0; m < 4; ++m)
#pragma unroll
                for (int n = 0; n < 2; ++n) acc[a][b][m][n] = (f32x4){0.f, 0.f, 0.f, 0.f};
    bf16x8 At[4][2], B0[2][2], B1[2][2];
    const char* cA = (const char*)g.A + (size_t)cur.pm * tstep; const char* cB = (const char*)g.Bt + (size_t)cur.pn * tstep;
    S.a_ready(cur);
    if constexpr (SP2) {
        PG8_STAGE(PG8_SB(0, 0), cB, voffB); PG8_STAGE(PG8_SB(0, 1), cB + hstep, voffB); PG8_STAGE(PG8_SA(0, 0), cA, voffA); PG8_STAGE(PG8_SA(0, 1), cA + hstep, voffA);
        if (wr == 1) PG8_BAR;
        PG8_WAIT_V(2); PG8_BAR;
        PG8_STAGE(PG8_SB(1, 0), cB + kstep, voffB); PG8_STAGE(PG8_SA(1, 0), cA + kstep, voffA); PG8_STAGE(PG8_SB(1, 1), cB + hstep + kstep, voffB);
        PG8_WAIT_V(6); PG8_BAR;
    } else {
        PG8_STAGE(PG8_SB(0, 0), cB, voffB); PG8_STAGE(PG8_SA(0, 0), cA, voffA); PG8_STAGE(PG8_SB(0, 1), cB + hstep, voffB); PG8_STAGE(PG8_SA(0, 1), cA + hstep, voffA);
        if (wr == 1) PG8_BAR;
        PG8_WAIT_V(4); PG8_BAR;
        PG8_STAGE(PG8_SB(1, 0), cB + kstep, voffB); PG8_STAGE(PG8_SA(1, 0), cA + kstep, voffA); PG8_STAGE(PG8_SB(1, 1), cB + hstep + kstep, voffB);
        PG8_WAIT_V(6); PG8_BAR;
    }
    for (;;) {
        const bool has_next = S.next(ui + 1, nxt);
        const char* nA = has_next ? (const char*)g.A + (size_t)nxt.pm * tstep : cA; const char* nB = has_next ? (const char*)g.Bt + (size_t)nxt.pn * tstep : cB;
        for (int t = 0; t < nt; t += 2) {
            if constexpr (Epi::MIDSCALE) { if (t == nt / 2) E.midscale(acc, cur, wr, wc, fr, fq); }
            const bool last = (t == nt - 2);
            const char* a1 = cA + (size_t)(t + 1) * kstep;
            const char* a2 = last ? nA : cA + (size_t)(t + 2) * kstep; const char* b2 = last ? nB : cB + (size_t)(t + 2) * kstep;
            const char* a3 = a2 + kstep; const char* b3 = b2 + kstep;
            if (last && has_next) S.a_ready(nxt);
            if constexpr (SP2) {
            PG8_LDB(B0, 0, 0); PG8_LDB(B1, 0, 1); PG8_SCHED; PG8_LDA(At, 0, 0); PG8_STAGE(PG8_SA(1, 1), a1 + hstep, voffA);
            PG8_WAIT_V(8); PG8_WAIT_L(0); PG8_BAR; PG8_MMA(0, 0, At, B0); PG8_MMA(0, 1, At, B1); PG8_BAR; PG8_SCHED;
            PG8_LDA(At, 0, 1); PG8_STAGE(PG8_SB(0, 0), b2, voffB); PG8_STAGE(PG8_SB(0, 1), b2 + hstep, voffB); PG8_STAGE(PG8_SA(0, 0), a2, voffA);
            PG8_WAIT_V(8); PG8_WAIT_L(0); PG8_BAR; PG8_MMA(1, 0, At, B0); PG8_MMA(1, 1, At, B1); PG8_BAR; PG8_SCHED;
            PG8_LDB(B0, 1, 0); PG8_LDB(B1, 1, 1); PG8_SCHED; PG8_LDA(At, 1, 0); PG8_STAGE(PG8_SA(0, 1), a2 + hstep, voffA);
            PG8_WAIT_V(8); PG8_WAIT_L(0); PG8_BAR; PG8_MMA(0, 0, At, B0); PG8_MMA(0, 1, At, B1); PG8_BAR; PG8_SCHED;
            PG8_LDA(At, 1, 1); PG8_STAGE(PG8_SB(1, 0), b3, voffB); PG8_STAGE(PG8_SB(1, 1), b3 + hstep, voffB); PG8_STAGE(PG8_SA(1, 0), a3, voffA);
            PG8_WAIT_V(8); PG8_WAIT_L(0); PG8_BAR; PG8_MMA(1, 0, At, B0); PG8_MMA(1, 1, At, B1); PG8_BAR; PG8_SCHED;
            } else {
            PG8_LDB(B0, 0, 0); PG8_SCHED; PG8_LDA(At, 0, 0); PG8_STAGE(PG8_SA(1, 1), a1 + hstep, voffA);
            PG8_WAIT_L(8); PG8_BAR; PG8_WAIT_L(0); PG8_MMA(0, 0, At, B0); PG8_BAR; PG8_SCHED;
            PG8_LDB(B1, 0, 1); PG8_STAGE(PG8_SB(0, 0), b2, voffB);
            PG8_BAR; PG8_WAIT_L(0); PG8_MMA(0, 1, At, B1); PG8_BAR;
            PG8_LDA(At, 0, 1); PG8_STAGE(PG8_SA(0, 0), a2, voffA);
            PG8_BAR; PG8_WAIT_L(0); PG8_MMA(1, 0, At, B0); PG8_BAR; PG8_SCHED;
            PG8_STAGE(PG8_SB(0, 1), b2 + hstep, voffB);
            PG8_WAIT_V(6); PG8_BAR; PG8_MMA(1, 1, At, B1); PG8_BAR;
            PG8_LDB(B0, 1, 0); PG8_SCHED; PG8_LDA(At, 1, 0); PG8_STAGE(PG8_SA(0, 1), a2 + hstep, voffA);
            PG8_WAIT_L(8); PG8_BAR; PG8_WAIT_L(0); PG8_MMA(0, 0, At, B0); PG8_BAR; PG8_SCHED;
            PG8_LDB(B1, 1, 1); PG8_STAGE(PG8_SB(1, 0), b3, voffB);
            PG8_BAR; PG8_WAIT_L(0); PG8_MMA(0, 1, At, B1); PG8_BAR;
            PG8_LDA(At, 1, 1); PG8_STAGE(PG8_SA(1, 0), a3, voffA);
            PG8_BAR; PG8_WAIT_L(0); PG8_MMA(1, 0, At, B0); PG8_BAR; PG8_SCHED;
            PG8_STAGE(PG8_SB(1, 1), b3 + hstep, voffB);
            PG8_WAIT_V(6); PG8_BAR; PG8_MMA(1, 1, At, B1); PG8_BAR;
            }
        }
        if constexpr (ALIGN_EPI) { if (wr == 0) PG8_BAR; }
        if constexpr (!Epi::AFTER_DRAIN) { E(acc, cur, wr, wc, fr, fq); S.done(cur); }
        if (!has_next) break;
#pragma unroll
        for (int a = 0; a < 2; ++a)
#pragma unroll
            for (int b = 0; b < 2; ++b)
#pragma unroll
                for (int m = 0; m < 4; ++m)
#pragma unroll
                    for (int n = 0; n < 2; ++n) acc[a][b][m][n] = (f32x4){0.f, 0.f, 0.f, 0.f};
        cur = nxt; cA = nA; cB = nB; ++ui;
        if constexpr (ALIGN_EPI) { if (wr == 1) PG8_BAR; }
    }
    PG8_WAIT_V(0);
    if constexpr (!ALIGN_EPI) { if (wr == 0) PG8_BAR; }
    PG8_BAR;
    if constexpr (Epi::AFTER_DRAIN) { E.fused(acc, cur, wr, wc, fr, fq, lds, wid, lane); S.done(cur); }
#undef PG8_SA
#undef PG8_SB
#undef PG8_STAGE
#undef PG8_LDA
#undef PG8_LDB
#undef PG8_MMA
#undef PG8_WAIT_V
#undef PG8_WAIT_L
#undef PG8_BAR
#undef PG8_SCHED
}
}

constexpr int NB = 2, SEQ = 8192, DM = 1024, MTOK = NB * SEQ;
constexpr int NZ = 2304, NZP = 2560;
constexpr int NMEM = 256;
constexpr float EPS = 1e-6f;
constexpr float QSCALE = 0.125f * 1.4426950408889634f;
constexpr int ZC_XL = 0, ZC_GT = 512, ZC_Q = 1024, ZC_KC = 1536, ZC_VC = 1664, ZC_KS = 1792, ZC_VS = 1920, ZC_KW = 2048, ZC_VW = 2176, ZC_G = 2304;

constexpr size_t MiB = 1u << 20;
constexpr size_t WS_CTL = 0;
constexpr size_t WS_WIN = 1 * MiB, WS_WOUT = 6 * MiB, WS_WMQ = 8 * MiB, WS_WMK = 10 * MiB, WS_WMV = 12 * MiB, WS_WMO = 14 * MiB, WS_WPQ = 16 * MiB;
constexpr size_t WS_SKEY = 20 * MiB;
constexpr size_t WS_CW1T = WS_SKEY + 512 * 1024;
constexpr size_t WS_CW2T = WS_CW1T + 512 * 1024;
constexpr size_t WS_C1 = WS_CW2T + 16 * 1024;
constexpr size_t WS_WRGT = WS_C1 + 16 * 1024;
constexpr size_t WS_MEMN = 22 * MiB, WS_MEMK = 23 * MiB, WS_MEMVT = 24 * MiB;
constexpr size_t WS_KC = 26 * MiB;
constexpr size_t WS_VCT = WS_KC + 256 * 1024;
constexpr size_t WS_SUMM = 27 * MiB;
constexpr size_t WS_SSQ1 = 28 * MiB, WS_SSQ2 = 29 * MiB;
constexpr size_t WS_GATES = 30 * MiB;
constexpr size_t WS_SSQN = 31 * MiB + 512 * 1024;
constexpr size_t WS_U8 = 32 * MiB, WS_V8 = 48 * MiB;
constexpr size_t WS_SU = 64 * MiB, WS_SV = 64 * MiB + 65536;
constexpr size_t WS_SSQ3 = 65 * MiB;
constexpr size_t WS_W = 66 * MiB;
constexpr size_t WS_PART = 128 * MiB;
constexpr size_t WS_XN = 96 * MiB;
constexpr size_t WS_Z = 128 * MiB;
constexpr size_t WS_KSF = 240 * MiB, WS_VSF = 244 * MiB, WS_KWF = 248 * MiB, WS_VWF = 252 * MiB;
constexpr size_t WS_QM = 128 * MiB, WS_OM = 160 * MiB;
constexpr size_t WS_QP = 128 * MiB;
constexpr size_t WS_Y = 208 * MiB;
constexpr size_t WS_EID = 208 * MiB, WS_GW = 216 * MiB;
constexpr size_t WS_END = 256 * MiB;

constexpr int CW_KMAX = 12288;
constexpr int LDS_BYTES = 147456;

#define GAS __attribute__((address_space(1)))
#define LAS __attribute__((address_space(3)))
typedef unsigned short bf16;
typedef unsigned v4u __attribute__((ext_vector_type(4)));
typedef unsigned v2u __attribute__((ext_vector_type(2)));
typedef float f32x4 __attribute__((ext_vector_type(4)));
typedef float f32x16 __attribute__((ext_vector_type(16)));
typedef short bf16x8 __attribute__((ext_vector_type(8)));
typedef short bf16x4 __attribute__((ext_vector_type(4)));
__device__ __forceinline__ unsigned f2bf(float f) { unsigned u = __builtin_bit_cast(unsigned, f); return (u + 0x7fffu + ((u >> 16) & 1u)) >> 16; }
typedef float f32x2_ __attribute__((ext_vector_type(2))); typedef __bf16 bf16x2_ __attribute__((ext_vector_type(2)));
__device__ __forceinline__ unsigned pk2(float lo, float hi) { f32x2_ v = {lo, hi}; bf16x2_ b = __builtin_convertvector(v, bf16x2_); return __builtin_bit_cast(unsigned, b); }
__device__ __forceinline__ float bf2f(unsigned short h) { return __builtin_bit_cast(float, (unsigned)h << 16); }
__device__ __forceinline__ float bflo(unsigned w) { return __builtin_bit_cast(float, w << 16); }
__device__ __forceinline__ float bfhi(unsigned w) { return __builtin_bit_cast(float, w & 0xffff0000u); }
__device__ __forceinline__ void swap32(unsigned& a, unsigned& b) { asm("s_nop 1\n\tv_permlane32_swap_b32 %0, %1" : "+v"(a), "+v"(b)); }
__device__ __forceinline__ int maxswap32_i(int v) { unsigned a = (unsigned)v, b = (unsigned)v; swap32(a, b); return max((int)a, (int)b); }
__device__ __forceinline__ float maxswap32_f(float v) { unsigned a = __builtin_bit_cast(unsigned, v), b = a; swap32(a, b); return fmaxf(__builtin_bit_cast(float, a), __builtin_bit_cast(float, b)); }
__device__ __forceinline__ float addswap32_f(float v) { unsigned a = __builtin_bit_cast(unsigned, v), b = a; swap32(a, b); return __builtin_bit_cast(float, a) + __builtin_bit_cast(float, b); }
__device__ __forceinline__ float wave_sum(float v) {
#pragma unroll
    for (int o = 1; o < 64; o <<= 1) v += __shfl_xor(v, o);
    return v;
}

struct Args { const float* in[33]; float* out; unsigned char* ws; int ph_lo, ph_hi; };

struct Frame {
    int tid, lane, wave, vcu, G, gw, NGW;
};
__device__ __forceinline__ int lane_id() { int l; asm volatile("v_mbcnt_lo_u32_b32 %0, -1, 0\n\tv_mbcnt_hi_u32_b32 %0, -1, %0" : "=v"(l)); return l; }
#define REFRESH_LANE(F) do { (F).lane = lane_id(); (F).tid = (F).wave * 64 + (F).lane; } while (0)

__device__ __forceinline__ void transpose_item(const float* W, int K, int N, bf16* WT, int ldt, int row_off, const float* gain, int slo, int shi, float cs, LAS float* scr, int item, int lane, int kxor = 0) {
    const int nblk = (N + 31) / 32, kb = item / nblk, nb = item % nblk, k0 = 64 * kb, n0 = 32 * nb;
#pragma unroll 16
    for (int i = 0; i < 32; ++i) { const int kk = 2 * i + (lane >> 5), n = n0 + (lane & 31);
        float v = (n < N) ? W[(size_t)(k0 + kk) * N + n] : 0.f; if (gain) v *= gain[k0 + kk]; if (n >= slo && n < shi) v *= cs;
        scr[kk * 33 + (lane & 31)] = v; }
    asm volatile("s_waitcnt lgkmcnt(0)" ::: "memory");
    const int c = lane & 7;
#pragma unroll
    for (int j = 0; j < 4; ++j) { const int n = (lane >> 3) + 8 * j; const LAS float* s = scr + (8 * c) * 33 + n;
        v4u o; o.x = pk2(s[0 * 33], s[1 * 33]); o.y = pk2(s[2 * 33], s[3 * 33]); o.z = pk2(s[4 * 33], s[5 * 33]); o.w = pk2(s[6 * 33], s[7 * 33]);
        *(v4u*)(WT + (size_t)(row_off + n0 + n) * ldt + (k0 ^ kxor) + 8 * c) = o; }
    asm volatile("s_waitcnt lgkmcnt(0)" ::: "memory");
}
__device__ __forceinline__ void rms_row_to_bf16(const float* xrow, bf16* orow, int lane) {
    const f32x4* xr = (const f32x4*)xrow + lane;
    f32x4 v[4]; float s = 0.f;
#pragma unroll
    for (int j = 0; j < 4; ++j) { v[j] = xr[64 * j]; s += (v[j].x * v[j].x + v[j].y * v[j].y) + (v[j].z * v[j].z + v[j].w * v[j].w); }
    const float rstd = rsqrtf(wave_sum(s) * (1.f / DM) + EPS);
    unsigned long long* o8 = (unsigned long long*)orow + lane;
#pragma unroll
    for (int j = 0; j < 4; ++j) o8[64 * j] = (unsigned long long)pk2(v[j].x * rstd, v[j].y * rstd) | ((unsigned long long)pk2(v[j].z * rstd, v[j].w * rstd) << 32);
}
__device__ __forceinline__ void quant_row_fp8(const float* src, const float* gain, unsigned char* dst, float* scale_out, int lane) {
    const f32x4* p = (const f32x4*)src + 4 * lane; f32x4 v[4]; float am = 0.f;
#pragma unroll
    for (int j = 0; j < 4; ++j) { v[j] = p[j]; if (gain) v[j] = v[j] * ((const f32x4*)gain)[4 * lane + j]; am = fmaxf(am, fmaxf(fmaxf(fabsf(v[j].x), fabsf(v[j].y)), fmaxf(fabsf(v[j].z), fabsf(v[j].w)))); }
#pragma unroll
    for (int o = 1; o < 64; o <<= 1) am = fmaxf(am, __shfl_xor(am, o));
    const float inv = am > 0.f ? 448.0f / am : 0.f;
    v4u o4;
#pragma unroll
    for (int j = 0; j < 4; ++j) { int w = 0; w = __builtin_amdgcn_cvt_pk_fp8_f32(v[j].x * inv, v[j].y * inv, w, false); w = __builtin_amdgcn_cvt_pk_fp8_f32(v[j].z * inv, v[j].w * inv, w, true); o4[j] = (unsigned)w; }
    *(v4u*)(dst + (size_t)(lane >> 3) * 16384 * 128 + (lane & 7) * 16) = o4;
    if (lane == 0) *scale_out = am * (1.0f / 448.0f);
}
__device__ __forceinline__ void rms_rows4_to_bf16(const float* x0, bf16* o0, size_t rstride  , int lane) {
    f32x4 v[4][4]; float s[4];
#pragma unroll
    for (int r = 0; r < 4; ++r)
#pragma unroll
        for (int j = 0; j < 4; ++j) v[r][j] = ((const f32x4*)(x0 + r * rstride))[lane + 64 * j];
#pragma unroll
    for (int r = 0; r < 4; ++r) { s[r] = 0.f;
#pragma unroll
        for (int j = 0; j < 4; ++j) s[r] += (v[r][j].x * v[r][j].x + v[r][j].y * v[r][j].y) + (v[r][j].z * v[r][j].z + v[r][j].w * v[r][j].w); }
#pragma unroll
    for (int o = 1; o < 64; o <<= 1)
#pragma unroll
        for (int r = 0; r < 4; ++r) s[r] += __shfl_xor(s[r], o);
#pragma unroll
    for (int r = 0; r < 4; ++r) { const float rstd = rsqrtf(s[r] * (1.f / DM) + EPS); unsigned long long* o8 = (unsigned long long*)(o0 + r * rstride) + lane;
#pragma unroll
        for (int j = 0; j < 4; ++j) o8[64 * j] = (unsigned long long)pk2(v[r][j].x * rstd, v[r][j].y * rstd) | ((unsigned long long)pk2(v[r][j].z * rstd, v[r][j].w * rstd) << 32); }
}
__device__ __forceinline__ void quant_rows4_fp8(const float* src0, size_t rstride, const float* gain, unsigned char* dst0, float* scale0, int sstride, int lane) {
    f32x4 v[4][4]; float am[4];
#pragma unroll
    for (int r = 0; r < 4; ++r)
#pragma unroll
        for (int j = 0; j < 4; ++j) v[r][j] = ((const f32x4*)(src0 + r * rstride))[4 * lane + j];
    if (gain) {
#pragma unroll
        for (int j = 0; j < 4; ++j) { const f32x4 g = ((const f32x4*)gain)[4 * lane + j];
#pragma unroll
            for (int r = 0; r < 4; ++r) v[r][j] = v[r][j] * g; } }
#pragma unroll
    for (int r = 0; r < 4; ++r) { am[r] = 0.f;
#pragma unroll
        for (int j = 0; j < 4; ++j) am[r] = fmaxf(am[r], fmaxf(fmaxf(fabsf(v[r][j].x), fabsf(v[r][j].y)), fmaxf(fabsf(v[r][j].z), fabsf(v[r][j].w)))); }
#pragma unroll
    for (int o = 1; o < 64; o <<= 1)
#pragma unroll
        for (int r = 0; r < 4; ++r) am[r] = fmaxf(am[r], __shfl_xor(am[r], o));
#pragma unroll
    for (int r = 0; r < 4; ++r) { const float inv = am[r] > 0.f ? 448.0f / am[r] : 0.f; v4u o4;
#pragma unroll
        for (int j = 0; j < 4; ++j) { int w = 0; w = __builtin_amdgcn_cvt_pk_fp8_f32(v[r][j].x * inv, v[r][j].y * inv, w, false); w = __builtin_amdgcn_cvt_pk_fp8_f32(v[r][j].z * inv, v[r][j].w * inv, w, true); o4[j] = (unsigned)w; }
        *(v4u*)(dst0 + (size_t)r * sstride * 128 + (size_t)(lane >> 3) * 16384 * 128 + (lane & 7) * 16) = o4;
        if (lane == 0) scale0[r * sstride] = am[r] * (1.0f / 448.0f); }
}
__device__ __forceinline__ void p0_prologue(const Frame& F, const Args& A, LAS unsigned char* lds) {
    unsigned char* ws = A.ws;
    LAS float* scr = (LAS float*)(lds + F.wave * 16384);
    const float* const* in = A.in;
    const int gw = F.gw, NGW = F.NGW;
    constexpr int I_IN = 16 * 73, I_SQ = 16 * 32, I_PQ = 16 * 64, I_C1 = 64, I_C2 = 2, I_RG = 2;
    constexpr int E_IN = I_IN, E_OUT = E_IN + I_SQ, E_MQ = E_OUT + I_SQ, E_MK = E_MQ + I_SQ, E_MV = E_MK + I_SQ, E_MO = E_MV + I_SQ, E_PQ = E_MO + I_PQ, E_C1 = E_PQ + 2 * I_C1, E_C2 = E_C1 + 2 * I_C2, E_RG = E_C2 + 16 * I_RG;
    for (int it = gw; it < E_RG; it += NGW) {
        if (it < E_IN) transpose_item(in[3], 1024, 2328, (bf16*)(ws + WS_WIN), 1024, 0, in[2], ZC_Q, ZC_KC, QSCALE, scr, it, F.lane);
        else if (it < E_OUT) { const int j = it - E_IN, kb = j / 32; transpose_item(in[20], 1024, 1024, (bf16*)(ws + WS_WOUT), 1024, 0, (kb < 8 ? in[18] : in[19] - 512), 0, 0, 1.f, scr, j, F.lane, 512); }
        else if (it < E_MQ) transpose_item(in[23], 1024, 1024, (bf16*)(ws + WS_WMQ), 1024, 0, in[21], 0, 1024, 0.0625f * 1.4426950408889634f, scr, it - E_OUT, F.lane);
        else if (it < E_MK) transpose_item(in[24], 1024, 1024, (bf16*)(ws + WS_WMK), 1024, 0, in[22], 0, 0, 1.f, scr, it - E_MQ, F.lane);
        else if (it < E_MV) transpose_item(in[25], 1024, 1024, (bf16*)(ws + WS_WMV), 1024, 0, in[22], 0, 0, 1.f, scr, it - E_MK, F.lane);
        else if (it < E_MO) transpose_item(in[26], 1024, 1024, (bf16*)(ws + WS_WMO), 1024, 0, nullptr, 0, 0, 1.f, scr, it - E_MV, F.lane);
        else if (it < E_PQ) transpose_item(in[28], 1024, 2048, (bf16*)(ws + WS_WPQ), 1024, 0, in[27], 0, 0, 1.f, scr, it - E_MO, F.lane);
        else if (it < E_C1) { const int j = it - E_PQ, kv = j / I_C1; transpose_item(in[kv ? 16 : 13], 2048, 64, (bf16*)(ws + WS_CW1T) + (size_t)kv * 64 * 2048, 2048, 0, nullptr, 0, 0, 1.f, scr, j % I_C1, F.lane); }
        else if (it < E_C2) { const int j = it - E_C1, kv = j / I_C2; transpose_item(in[kv ? 17 : 14], 64, 64, (bf16*)(ws + WS_CW2T) + (size_t)kv * 64 * 64, 64, 0, nullptr, 0, 0, 1.f, scr, j % I_C2, F.lane); }
        else { const int j = it - E_C2, ai = j / 16, h = (j / 2) % 8; transpose_item(in[ai ? 9 : 7] + (size_t)h * 4096, 64, 64, (bf16*)(ws + WS_WRGT) + (size_t)(ai * 8 + h) * 4096, 64, 0, nullptr, 0, 0, 1.f, scr, j % 2, F.lane); }
    }
    for (int i = gw * 64 + F.lane; i < (2560 - 2336) * 1024 / 8; i += NGW * 64) ((v4u*)((bf16*)(ws + WS_WIN) + (size_t)2336 * 1024))[i] = (v4u){0u, 0u, 0u, 0u};
    for (int it = NGW - 1 - gw; it < 32; it += NGW) { const int kv = it >> 4, ch = it & 15; const float* pos = in[kv ? 15 : 12] + 128 * ch; const float* w1 = in[kv ? 16 : 13] + (size_t)128 * ch * 64 + F.lane; float s = 0.f;
#pragma unroll 16
        for (int k = 0; k < 128; ++k) s += pos[k] * w1[(size_t)k * 64];
        ((float*)(ws + WS_C1))[it * 64 + F.lane] = s; }
    { const size_t i0 = (size_t)gw * 64 + F.lane, st = (size_t)NGW * 64;
      for (int r = gw; r < 32768; r += 4 * NGW) { const int tb = r >> 14, e = r & 16383;
          if ((16384 % (4 * NGW)) == 0) quant_rows4_fp8(in[30 + tb] + (size_t)e * DM, (size_t)NGW * DM, tb ? nullptr : in[27], ws + (tb ? WS_V8 : WS_U8) + (size_t)e * 128, (float*)(ws + (tb ? WS_SV : WS_SU)) + e, NGW, F.lane);
          else for (int q = 0; q < 4; ++q) { const int rr = r + q * NGW; if (rr < 32768) { const int t2 = rr >> 14, e2 = rr & 16383; quant_row_fp8(in[30 + t2] + (size_t)e2 * DM, t2 ? nullptr : in[27], ws + (t2 ? WS_V8 : WS_U8) + (size_t)e2 * 128, (float*)(ws + (t2 ? WS_SV : WS_SU)) + e2, F.lane); } } }
      for (size_t i = i0; i < (size_t)8 * 2 * 128 * 128 / 8; i += st) { const f32x4 a = ((const f32x4*)in[29])[2 * i], bq = ((const f32x4*)in[29])[2 * i + 1];
          v4u o; o.x = pk2(a.x, a.y); o.y = pk2(a.z, a.w); o.z = pk2(bq.x, bq.y); o.w = pk2(bq.z, bq.w);
          const size_t R = i >> 4, d0 = (i & 15) * 8;
          *(v4u*)((bf16*)(ws + WS_SKEY) + (R >> 5) * 4096 + (d0 >> 4) * 512 + ((d0 >> 3) & 1) * 256 + (R & 31) * 8) = o; } }
    if ((MTOK % (4 * NGW)) == 0) for (int m = gw; m < MTOK; m += 4 * NGW) rms_rows4_to_bf16(in[0] + (size_t)m * DM, (bf16*)(ws + WS_XN) + (size_t)m * DM, (size_t)NGW * DM, F.lane);
    else for (int m = gw; m < MTOK; m += NGW) rms_row_to_bf16(in[0] + (size_t)m * DM, (bf16*)(ws + WS_XN) + (size_t)m * DM, F.lane);
    for (int m = gw; m < NB * NMEM; m += NGW) rms_row_to_bf16(in[1] + (size_t)m * DM, (bf16*)(ws + WS_MEMN) + (size_t)m * DM, F.lane);
}

__device__ __forceinline__ int crow(int r, int hi) { return (r & 3) + 8 * (r >> 2) + 4 * hi; }
__device__ __forceinline__ float gelu_tanh(float x) {
    const float u = 0.7978845608028654f * (x + 0.044715f * x * x * x);
    const float t = 1.0f - 2.0f * __builtin_amdgcn_rcpf(__builtin_amdgcn_exp2f(2.0f * 1.4426950408889634f * u) + 1.0f);
    return 0.5f * x * (1.0f + t);
}
constexpr int XC_LD = 520;
__device__ __forceinline__ void lru_local_item(const Frame& F, const Args& A, LAS unsigned char* lds, int item) {
    unsigned char* ws = A.ws;
    const bf16* Z = (const bf16*)(ws + WS_Z);
    const int b = item >> 7, chunk = item & 127, s0 = chunk * 64; const size_t row0 = (size_t)b * SEQ + s0;
    LAS bf16* xcs = (LAS bf16*)lds;
    {
        const int c8 = F.tid & 63, tg = F.tid >> 6, c0 = 8 * c8;
        v4u xr[11];
#pragma unroll
        for (int r = 0; r < 11; ++r) { const long tok = (long)(8 * tg + r) - 3;
            if (s0 == 0 && tok < 0) xr[r] = (v4u){0u, 0u, 0u, 0u}; else xr[r] = *(const v4u*)(Z + (size_t)((long)row0 + tok) * NZ + c0); }
        const float* cw = A.in[5]; float w0[8], w1[8], w2[8], w3[8], cb[8];
#pragma unroll
        for (int j = 0; j < 2; ++j) { const f32x4 a = *(const f32x4*)(cw + c0 + 4 * j), b = *(const f32x4*)(cw + 512 + c0 + 4 * j), c = *(const f32x4*)(cw + 1024 + c0 + 4 * j), d = *(const f32x4*)(cw + 1536 + c0 + 4 * j), e2 = *(const f32x4*)(A.in[6] + c0 + 4 * j);
#pragma unroll
            for (int k = 0; k < 4; ++k) { w0[4 * j + k] = a[k]; w1[4 * j + k] = b[k]; w2[4 * j + k] = c[k]; w3[4 * j + k] = d[k]; cb[4 * j + k] = e2[k]; } }
#pragma unroll
        for (int tt = 0; tt < 8; ++tt) { float o[8];
#pragma unroll
            for (int q = 0; q < 4; ++q) { const unsigned a = xr[tt][q], b = xr[tt + 1][q], c = xr[tt + 2][q], d = xr[tt + 3][q];
                o[2 * q] = cb[2 * q] + w0[2 * q] * bflo(a) + w1[2 * q] * bflo(b) + w2[2 * q] * bflo(c) + w3[2 * q] * bflo(d);
                o[2 * q + 1] = cb[2 * q + 1] + w0[2 * q + 1] * bfhi(a) + w1[2 * q + 1] * bfhi(b) + w2[2 * q + 1] * bfhi(c) + w3[2 * q + 1] * bfhi(d); }
            v4u ov; ov.x = pk2(o[0], o[1]); ov.y = pk2(o[2], o[3]); ov.z = pk2(o[4], o[5]); ov.w = pk2(o[6], o[7]);
            *(LAS v4u*)(xcs + (8 * tg + tt) * XC_LD + c0) = ov; }
    }
    __syncthreads();
    const int h = F.wave, lane = F.lane, r32 = lane & 31, hi = lane >> 5;
    bf16x8 af[2][4];
#pragma unroll
    for (int tt = 0; tt < 2; ++tt)
#pragma unroll
        for (int ks = 0; ks < 4; ++ks) af[tt][ks] = *(const LAS bf16x8*)(xcs + (32 * tt + r32) * XC_LD + 64 * h + 16 * ks + 8 * hi);
    const bf16* WT = (const bf16*)(ws + WS_WRGT);
    float* SUMM = (float*)(ws + WS_SUMM);
    unsigned* HA = (unsigned*)A.out;
#pragma unroll 1
    for (int ct = 0; ct < 2; ++ct) {
        const int c = 64 * h + 32 * ct + r32;
        f32x16 ga[2], gi[2];
#pragma unroll
        for (int tt = 0; tt < 2; ++tt) { ga[tt] = f32x16{}; gi[tt] = f32x16{}; }
#pragma unroll
        for (int ks = 0; ks < 4; ++ks) {
            const bf16x8 ba = *(const bf16x8*)(WT + (size_t)(0 * 8 + h) * 4096 + (32 * ct + r32) * 64 + 16 * ks + 8 * hi);
            const bf16x8 bi = *(const bf16x8*)(WT + (size_t)(1 * 8 + h) * 4096 + (32 * ct + r32) * 64 + 16 * ks + 8 * hi);
#pragma unroll
            for (int tt = 0; tt < 2; ++tt) { ga[tt] = __builtin_amdgcn_mfma_f32_32x32x16_bf16(af[tt][ks], ba, ga[tt], 0, 0, 0); gi[tt] = __builtin_amdgcn_mfma_f32_32x32x16_bf16(af[tt][ks], bi, gi[tt], 0, 0, 0); }
        }
        const float ba_ = A.in[8][c], bi_ = A.in[10][c], lam = A.in[11][c];
        const float sp = (lam > 15.f) ? __expf(-lam) : log1pf(__expf(-lam));
#pragma unroll
        for (int tt = 0; tt < 2; ++tt)
#pragma unroll
            for (int r = 0; r < 16; ++r) { const int t = 32 * tt + crow(r, hi);
                const float rr = __builtin_amdgcn_rcpf(1.0f + __builtin_amdgcn_exp2f(-1.4426950408889634f * (ga[tt][r] + ba_))), ii = __builtin_amdgcn_rcpf(1.0f + __builtin_amdgcn_exp2f(-1.4426950408889634f * (gi[tt][r] + bi_)));
                const float a = __builtin_amdgcn_exp2f(-8.0f * 1.4426950408889634f * rr * sp);
                const float xcv = bf2f(xcs[t * XC_LD + c]);
                const float bb = __builtin_amdgcn_sqrtf(fmaxf(1.0f - a * a, 0.f)) * (ii * xcv);
                ga[tt][r] = a; gi[tt][r] = bb; }
        float SA[8], SB[8];
#pragma unroll
        for (int tt = 0; tt < 2; ++tt)
#pragma unroll
            for (int q = 0; q < 4; ++q) {
#pragma unroll
                for (int k = 1; k < 4; ++k) { const int r = 4 * q + k; gi[tt][r] = ga[tt][r] * gi[tt][r - 1] + gi[tt][r]; ga[tt][r] = ga[tt][r] * ga[tt][r - 1]; }
                SA[tt * 4 + q] = ga[tt][4 * q + 3]; SB[tt * 4 + q] = gi[tt][4 * q + 3]; }
        float CA = 1.f, CB = 0.f; float inA[8], inB[8];
#pragma unroll
        for (int s = 0; s < 8; ++s) {
            const float pA = __shfl_xor(SA[s], 32), pB = __shfl_xor(SB[s], 32);
            const float Ae = hi ? pA : SA[s], Be = hi ? pB : SB[s], Ao = hi ? SA[s] : pA, Bo = hi ? SB[s] : pB;
            if (!hi) { inA[s] = CA; inB[s] = CB; }
            CB = Ae * CB + Be; CA = Ae * CA;
            if (hi) { inA[s] = CA; inB[s] = CB; }
            CB = Ao * CB + Bo; CA = Ao * CA;
        }
        unsigned hoff = (unsigned)((row0 + 4 * hi) * 512 + c);
        if (hi == 0) { float* sp2 = SUMM + ((size_t)(b * 128 + chunk) * 512 + c) * 2; sp2[0] = CA; sp2[1] = CB; }
#pragma unroll
        for (int tt = 0; tt < 2; ++tt)
#pragma unroll
            for (int r = 0; r < 16; ++r) { const int s = tt * 4 + (r >> 2);
                const float acum = ga[tt][r] * inA[s], hloc = ga[tt][r] * inB[s] + gi[tt][r];
                asm volatile("" : "+v"(hoff));
                HA[hoff + (unsigned)((32 * tt + (r & 3) + 8 * (r >> 2)) * 512)] = f2bf(hloc) | (f2bf(acum) << 16); }
    }
    __syncthreads();
}
__device__ __forceinline__ void lru_fix_item(const Frame& F, const Args& A, LAS unsigned char* lds, int item, bool zero_nsa) {
    unsigned char* ws = A.ws;
    const int b = item >> 7, chunk = item & 127; const size_t row0 = (size_t)b * SEQ + chunk * 64;
    LAS float* carry = (LAS float*)lds;
    { const int c = F.tid; const float* SUMM = (const float*)(ws + WS_SUMM) + (size_t)b * 128 * 1024 + 2 * c; float hc = 0.f;
      int j = 0;
      for (; j + 8 <= chunk; j += 8) { float2 ab[8];
#pragma unroll
          for (int q = 0; q < 8; ++q) ab[q] = *(const float2*)(SUMM + (size_t)(j + q) * 1024);
#pragma unroll
          for (int q = 0; q < 8; ++q) hc = ab[q].x * hc + ab[q].y; }
      for (; j < chunk; ++j) { const float2 ab = *(const float2*)(SUMM + (size_t)j * 1024); hc = ab.x * hc + ab.y; }
      carry[c] = hc; }
    __syncthreads();
    const bf16* Z = (const bf16*)(ws + WS_Z); const unsigned* HA = (const unsigned*)A.out; bf16* Y = (bf16*)(ws + WS_Y);
    const int c0 = 8 * F.lane;
    float cr[8];
#pragma unroll
    for (int j = 0; j < 8; ++j) cr[j] = carry[c0 + j];
#pragma unroll 1
    for (int t4 = 0; t4 < 8; t4 += 4) {
        v4u h0[4], h1[4], gz[4]; float y[4][8], s[4];
#pragma unroll
        for (int q = 0; q < 4; ++q) { const size_t row = row0 + F.wave * 8 + t4 + q; h0[q] = *(const v4u*)(HA + row * 512 + c0); h1[q] = *(const v4u*)(HA + row * 512 + c0 + 4); gz[q] = *(const v4u*)(Z + row * NZ + ZC_GT + c0); }
#pragma unroll
        for (int q = 0; q < 4; ++q) { const unsigned hw[8] = {h0[q].x, h0[q].y, h0[q].z, h0[q].w, h1[q].x, h1[q].y, h1[q].z, h1[q].w};
            const float gt[8] = {bflo(gz[q].x), bfhi(gz[q].x), bflo(gz[q].y), bfhi(gz[q].y), bflo(gz[q].z), bfhi(gz[q].z), bflo(gz[q].w), bfhi(gz[q].w)};
            s[q] = 0.f;
#pragma unroll
            for (int j = 0; j < 8; ++j) { const float hv = bfhi(hw[j]) * cr[j] + bflo(hw[j]); y[q][j] = hv * gelu_tanh(gt[j]); s[q] += y[q][j] * y[q][j]; } }
#pragma unroll
        for (int o = 1; o < 64; o <<= 1)
#pragma unroll
            for (int q = 0; q < 4; ++q) s[q] += __shfl_xor(s[q], o);
#pragma unroll
        for (int q = 0; q < 4; ++q) { const size_t row = row0 + F.wave * 8 + t4 + q; const float rstd = rsqrtf(s[q] * (1.f / 512.f) + EPS);
            v4u o; o.x = pk2(y[q][0] * rstd, y[q][1] * rstd); o.y = pk2(y[q][2] * rstd, y[q][3] * rstd); o.z = pk2(y[q][4] * rstd, y[q][5] * rstd); o.w = pk2(y[q][6] * rstd, y[q][7] * rstd);
            *(v4u*)(Y + row * DM + 512 + c0) = o;
            if (zero_nsa) *(v4u*)(Y + row * DM + c0) = (v4u){0u, 0u, 0u, 0u}; }
    }
    __syncthreads();
}

__device__ __forceinline__ void kmax_item(const Frame& F, const Args& A, int item) {
    unsigned char* ws = A.ws; const int lane = lane_id();
    const int bk = item >> 9, br = (item >> 8) & 1, tile = item & 255;
    const unsigned char* K = ws + (br ? WS_KWF : WS_KSF) + ((size_t)bk * 256 + tile) * 4096 + 16 * lane;
    float s = 0.f;
#pragma unroll
    for (int ks = 0; ks < 4; ++ks) { const v4u w = *(const v4u*)(K + 1024 * ks); const unsigned ww[4] = {w.x, w.y, w.z, w.w};
#pragma unroll
        for (int k = 0; k < 4; ++k) { const float a = bflo(ww[k]), c = bfhi(ww[k]); s += a * a + c * c; } }
    s = addswap32_f(s);
#pragma unroll
    for (int o = 1; o < 32; o <<= 1) s = fmaxf(s, __shfl_xor(s, o));
    if (lane == 0) atomicMax((unsigned*)(ws + WS_CTL) + CW_KMAX + bk * 2 + br, __builtin_bit_cast(unsigned, s));
}
__device__ __forceinline__ void compress_item(const Frame& F, const Args& A, LAS unsigned char* lds, int item) {
    unsigned char* ws = A.ws;
    const int kv = item >> 6, b = (item >> 5) & 1, h = (item >> 4) & 1, nt = item & 15, n0 = 32 * nt;
    const int lane = F.lane, r32 = lane & 31, hi = lane >> 5, w = F.wave;
    const bf16* Z = (const bf16*)(ws + WS_Z); const bf16* W1T = (const bf16*)(ws + WS_CW1T) + (size_t)kv * 64 * 2048; const bf16* W2T = (const bf16*)(ws + WS_CW2T) + (size_t)kv * 4096;
    const int zc = (kv ? ZC_VC : ZC_KC) + h * 64;
    LAS float* part = (LAS float*)lds;
    LAS float* G = (LAS float*)(lds + 65536);
    {
        int n = n0 + r32; if (n > 510) n = 510;
        f32x16 acc[2]; acc[0] = f32x16{}; acc[1] = f32x16{};
#pragma unroll 4
        for (int kk = 0; kk < 16; ++kk) { const int ks = 16 * w + kk, l = ks >> 2, d0 = (ks & 3) * 16 + 8 * hi;
            const bf16x8 bfr = *(const bf16x8*)(Z + ((size_t)b * SEQ + 16 * n + l) * NZ + zc + d0);
            const bf16x8 a0 = *(const bf16x8*)(W1T + (size_t)(r32) * 2048 + ks * 16 + 8 * hi), a1 = *(const bf16x8*)(W1T + (size_t)(32 + r32) * 2048 + ks * 16 + 8 * hi);
            acc[0] = __builtin_amdgcn_mfma_f32_32x32x16_bf16(a0, bfr, acc[0], 0, 0, 0); acc[1] = __builtin_amdgcn_mfma_f32_32x32x16_bf16(a1, bfr, acc[1], 0, 0, 0); }
#pragma unroll
        for (int ot = 0; ot < 2; ++ot)
#pragma unroll
            for (int r = 0; r < 16; ++r) part[(w * 64 + 32 * ot + crow(r, hi)) * 32 + r32] = acc[ot][r];
    }
    __syncthreads();
    { const float* c1 = (const float*)(ws + WS_C1) + kv * 16 * 64;
#pragma unroll
      for (int i = 0; i < 4; ++i) { const int e = F.tid + 512 * i, o = e >> 5, n = e & 31; float s = 0.f;
#pragma unroll
          for (int ch = 0; ch < 16; ++ch) s += c1[ch * 64 + o];
#pragma unroll
          for (int ww = 0; ww < 8; ++ww) s += part[(ww * 64 + o) * 32 + n];
          G[o * 33 + n] = gelu_tanh(s); } }
    __syncthreads();
    if (w < 2) {
        f32x16 acc = f32x16{};
#pragma unroll
        for (int ks = 0; ks < 4; ++ks) { const bf16x8 a = *(const bf16x8*)(W2T + (size_t)(32 * w + r32) * 64 + 16 * ks + 8 * hi);
            v4u bw; const LAS float* gp = G + (16 * ks + 8 * hi) * 33 + r32;
            bw.x = pk2(gp[0], gp[33]); bw.y = pk2(gp[66], gp[99]); bw.z = pk2(gp[132], gp[165]); bw.w = pk2(gp[198], gp[231]);
            acc = __builtin_amdgcn_mfma_f32_32x32x16_bf16(a, __builtin_bit_cast(bf16x8, bw), acc, 0, 0, 0); }
        const int n = n0 + r32;
        const size_t tbase = ((size_t)(b * 2 + h) * 16 + nt) * 2048;
        if (kv == 0) { bf16* KC = (bf16*)(ws + WS_KC) + tbase;
#pragma unroll
            for (int q = 0; q < 4; ++q) { v2u o; o.x = pk2(acc[4 * q], acc[4 * q + 1]); o.y = pk2(acc[4 * q + 2], acc[4 * q + 3]); if (n > 510) { o.x = 0u; o.y = 0u; }
                *(v2u*)(KC + (2 * w + (q >> 1)) * 512 + (q & 1) * 256 + r32 * 8 + 4 * hi) = o; } }
        else { bf16* VC = (bf16*)(ws + WS_VCT) + tbase; const int kk = r32 & 15, vo = (r32 >> 4) * 512 + ((kk >> 2) & 1) * 256 + (kk & 3) + 4 * (kk >> 3);
#pragma unroll
            for (int r = 0; r < 16; ++r) VC[w * 1024 + crow(r, hi) * 8 + vo] = (n > 510) ? (bf16)0 : (bf16)f2bf(acc[r]); }
    }
    __syncthreads();
}

__device__ __forceinline__ void sort16_desc(int (&k)[16]) {
#define CX(i, j) { const int hi_ = max(k[i], k[j]), lo_ = min(k[i], k[j]); k[i] = hi_; k[j] = lo_; }
    CX(0, 1) CX(2, 3) CX(0, 2) CX(1, 3) CX(1, 2) CX(4, 5) CX(6, 7) CX(4, 6) CX(5, 7) CX(5, 6) CX(0, 4) CX(2, 6) CX(2, 4) CX(1, 5) CX(3, 7) CX(3, 5) CX(1, 2)
    CX(3, 4) CX(5, 6) CX(8, 9) CX(10, 11) CX(8, 10) CX(9, 11) CX(9, 10) CX(12, 13) CX(14, 15) CX(12, 14) CX(13, 15) CX(13, 14) CX(8, 12) CX(10, 14) CX(10, 12)
    CX(9, 13) CX(11, 15) CX(11, 13) CX(9, 10) CX(11, 12) CX(13, 14) CX(0, 8) CX(4, 12) CX(4, 8) CX(2, 10) CX(6, 14) CX(6, 10) CX(2, 4) CX(6, 8) CX(10, 12)
    CX(1, 9) CX(5, 13) CX(5, 9) CX(3, 11) CX(7, 15) CX(7, 11) CX(3, 5) CX(7, 9) CX(11, 13) CX(1, 2) CX(3, 4) CX(5, 6) CX(7, 8) CX(9, 10) CX(11, 12) CX(13, 14)
#undef CX
}
__device__ __forceinline__ void sort32_desc(int (&k)[32]) {
#define CX(i, j) { const int hi_ = max(k[i], k[j]), lo_ = min(k[i], k[j]); k[i] = hi_; k[j] = lo_; }
    CX(0, 1) CX(2, 3) CX(0, 2) CX(1, 3) CX(1, 2) CX(4, 5) CX(6, 7) CX(4, 6) CX(5, 7) CX(5, 6) CX(0, 4) CX(2, 6) CX(2, 4) CX(1, 5) CX(3, 7) CX(3, 5) CX(1, 2)
    CX(3, 4) CX(5, 6) CX(8, 9) CX(10, 11) CX(8, 10) CX(9, 11) CX(9, 10) CX(12, 13) CX(14, 15) CX(12, 14) CX(13, 15) CX(13, 14) CX(8, 12) CX(10, 14) CX(10, 12)
    CX(9, 13) CX(11, 15) CX(11, 13) CX(9, 10) CX(11, 12) CX(13, 14) CX(0, 8) CX(4, 12) CX(4, 8) CX(2, 10) CX(6, 14) CX(6, 10) CX(2, 4) CX(6, 8) CX(10, 12)
    CX(1, 9) CX(5, 13) CX(5, 9) CX(3, 11) CX(7, 15) CX(7, 11) CX(3, 5) CX(7, 9) CX(11, 13) CX(1, 2) CX(3, 4) CX(5, 6) CX(7, 8) CX(9, 10) CX(11, 12) CX(13, 14)
    CX(16, 17) CX(18, 19) CX(16, 18) CX(17, 19) CX(17, 18) CX(20, 21) CX(22, 23) CX(20, 22) CX(21, 23) CX(21, 22) CX(16, 20) CX(18, 22) CX(18, 20) CX(17, 21)
    CX(19, 23) CX(19, 21) CX(17, 18) CX(19, 20) CX(21, 22) CX(24, 25) CX(26, 27) CX(24, 26) CX(25, 27) CX(25, 26) CX(28, 29) CX(30, 31) CX(28, 30) CX(29, 31)
    CX(29, 30) CX(24, 28) CX(26, 30) CX(26, 28) CX(25, 29) CX(27, 31) CX(27, 29) CX(25, 26) CX(27, 28) CX(29, 30) CX(16, 24) CX(20, 28) CX(20, 24) CX(18, 26)
    CX(22, 30) CX(22, 26) CX(18, 20) CX(22, 24) CX(26, 28) CX(17, 25) CX(21, 29) CX(21, 25) CX(19, 27) CX(23, 31) CX(23, 27) CX(19, 21) CX(23, 25) CX(27, 29)
    CX(17, 18) CX(19, 20) CX(21, 22) CX(23, 24) CX(25, 26) CX(27, 28) CX(29, 30) CX(0, 16) CX(8, 24) CX(8, 16) CX(4, 20) CX(12, 28) CX(12, 20) CX(4, 8)
    CX(12, 16) CX(20, 24) CX(2, 18) CX(10, 26) CX(10, 18) CX(6, 22) CX(14, 30) CX(14, 22) CX(6, 10) CX(14, 18) CX(22, 26) CX(2, 4) CX(6, 8) CX(10, 12)
    CX(14, 16) CX(18, 20) CX(22, 24) CX(26, 28) CX(1, 17) CX(9, 25) CX(9, 17) CX(5, 21) CX(13, 29) CX(13, 21) CX(5, 9) CX(13, 17) CX(21, 25) CX(3, 19)
    CX(11, 27) CX(11, 19) CX(7, 23) CX(15, 31) CX(15, 23) CX(7, 11) CX(15, 19) CX(23, 27) CX(3, 5) CX(7, 9) CX(11, 13) CX(15, 17) CX(19, 21) CX(23, 25)
    CX(27, 29) CX(1, 2) CX(3, 4) CX(5, 6) CX(7, 8) CX(9, 10) CX(11, 12) CX(13, 14) CX(15, 16) CX(17, 18) CX(19, 20) CX(21, 22) CX(23, 24) CX(25, 26) CX(27, 28)
    CX(29, 30)
#undef CX
}
__device__ __forceinline__ void bitonic16_desc(int (&a)[16]) {
#pragma unroll
    for (int s = 8; s >= 1; s >>= 1)
#pragma unroll
        for (int i = 0; i < 16; ++i) if ((i & s) == 0) { const int hi_ = max(a[i], a[i + s]), lo_ = min(a[i], a[i + s]); a[i] = hi_; a[i + s] = lo_; }
}
__device__ __forceinline__ void merge16_desc(int (&a)[16], const int (&b)[16]) {
#pragma unroll
    for (int i = 0; i < 16; ++i) a[i] = max(a[i], b[15 - i]);
    bitonic16_desc(a);
}
struct AttnSt { float m, l; f32x16 o[2]; };
#define EX2(x) __builtin_amdgcn_exp2f(x)
struct KVF { bf16x8 k[4]; bf16x8 v[2][2]; };
struct KVF8 { bf16x8 k[4]; v4u v8[2]; };
__device__ __forceinline__ void kv_load8(KVF8& f, const bf16* Kt, const unsigned char* Vt8, unsigned lo16) {
    const char* kb = (const char*)Kt + lo16;
#pragma unroll
    for (int ks = 0; ks < 4; ++ks) f.k[ks] = *(const bf16x8*)(kb + 1024 * ks);
#pragma unroll
    for (int dt = 0; dt < 2; ++dt) f.v8[dt] = *(const v4u*)(Vt8 + lo16 + 1024 * dt);
}
typedef __bf16 bf16x2v __attribute__((ext_vector_type(2)));
__device__ __forceinline__ bf16x8 dq8(unsigned w0, unsigned w1) {
    v4u o; o.x = __builtin_bit_cast(unsigned, __builtin_amdgcn_cvt_scalef32_pk_bf16_fp8(w0, 1.0f, false)); o.y = __builtin_bit_cast(unsigned, __builtin_amdgcn_cvt_scalef32_pk_bf16_fp8(w0, 1.0f, true));
    o.z = __builtin_bit_cast(unsigned, __builtin_amdgcn_cvt_scalef32_pk_bf16_fp8(w1, 1.0f, false)); o.w = __builtin_bit_cast(unsigned, __builtin_amdgcn_cvt_scalef32_pk_bf16_fp8(w1, 1.0f, true));
    return __builtin_bit_cast(bf16x8, o); }
__device__ __forceinline__ void kv_load(KVF& f, const bf16* Kt, const bf16* Vt, unsigned lo16) {
    const char* kb = (const char*)Kt + lo16; const char* vb = (const char*)Vt + lo16;
#pragma unroll
    for (int ks = 0; ks < 4; ++ks) f.k[ks] = *(const bf16x8*)(kb + 1024 * ks);
#pragma unroll
    for (int dt = 0; dt < 2; ++dt)
#pragma unroll
        for (int s2 = 0; s2 < 2; ++s2) f.v[dt][s2] = *(const bf16x8*)(vb + 2048 * dt + 1024 * s2);
}
#define MAX3(a, b, c) __builtin_fmaxf(__builtin_fmaxf((a), (b)), (c))
__device__ __forceinline__ float max16(const f32x16& s) { const float a = MAX3(s[0], s[1], s[2]), b = MAX3(s[3], s[4], s[5]), c = MAX3(s[6], s[7], s[8]), d = MAX3(s[9], s[10], s[11]), e = MAX3(s[12], s[13], s[14]);
    return MAX3(MAX3(a, b, c), MAX3(d, e, s[15]), -1e30f); }
__device__ __forceinline__ float sum16(const f32x16& s) { return (((s[0] + s[1]) + (s[2] + s[3])) + ((s[4] + s[5]) + (s[6] + s[7]))) + (((s[8] + s[9]) + (s[10] + s[11])) + ((s[12] + s[13]) + (s[14] + s[15]))); }
template <int MODE, bool FIXED, class AllowF>
__device__ __forceinline__ void attn_compute(const KVF8& f, const bf16x8 (&qf)[4], const f32x16& negm, bool sel, AllowF allow, AttnSt& st) {
    f32x16 s = FIXED ? negm : f32x16{};
#pragma unroll
    for (int ks = 0; ks < 4; ++ks) s = __builtin_amdgcn_mfma_f32_32x32x16_bf16(f.k[ks], qf[ks], s, 0, 0, 0);
    if (MODE == 2) {
#pragma unroll
        for (int r = 0; r < 16; ++r) if (!allow(r)) s[r] = -1e30f; }
    if (!FIXED) {
        float mt = max16(s);
        if (MODE == 1) mt = sel ? mt : -1e30f;
        mt = maxswap32_f(mt);
        if (__any(mt > st.m)) {
            const float mn = fmaxf(st.m, mt), alpha = EX2(st.m - mn);
            st.m = mn; st.l *= alpha;
#pragma unroll
            for (int dt = 0; dt < 2; ++dt)
#pragma unroll
                for (int r = 0; r < 16; ++r) st.o[dt][r] *= alpha;
        }
        const float mref = (MODE == 1 && !sel) ? 1e30f : fmaxf(st.m, -1e29f);
#pragma unroll
        for (int r = 0; r < 16; ++r) s[r] = EX2(s[r] - mref);
        st.l += sum16(s);
    } else {
#pragma unroll
        for (int r = 0; r < 16; ++r) s[r] = EX2(s[r]);
        const float ps = sum16(s);
        st.l += (MODE == 1 && !sel) ? 0.f : ps;
    }
#pragma unroll
    for (int s2 = 0; s2 < 2; ++s2) { v4u pw; pw.x = pk2(s[8 * s2], s[8 * s2 + 1]); pw.y = pk2(s[8 * s2 + 2], s[8 * s2 + 3]); pw.z = pk2(s[8 * s2 + 4], s[8 * s2 + 5]); pw.w = pk2(s[8 * s2 + 6], s[8 * s2 + 7]);
        if (FIXED && MODE == 1) { pw.x = sel ? pw.x : 0u; pw.y = sel ? pw.y : 0u; pw.z = sel ? pw.z : 0u; pw.w = sel ? pw.w : 0u; }
        const bf16x8 pf = __builtin_bit_cast(bf16x8, pw);
#pragma unroll
        for (int dt = 0; dt < 2; ++dt) st.o[dt] = __builtin_amdgcn_mfma_f32_32x32x16_bf16(dq8(f.v8[dt][2 * s2], f.v8[dt][2 * s2 + 1]), pf, st.o[dt], 0, 0, 0); }
}
constexpr int IMP_LD = 132;
__device__ __forceinline__ void nsa_item(const Frame& F, const Args& A, LAS unsigned char* lds, int b, int kvh, int tb, int wsub) {
    unsigned char* ws = A.ws;
    int lane = lane_id(); asm volatile("" : "+v"(lane));
    const int r32 = lane & 31, hi = lane >> 5, w = F.wave;
    const int t0 = 64 * tb + 8 * wsub, ti = r32 & 7, g = r32 >> 3, t = t0 + ti, cur = tb;
    const size_t rowb = (size_t)b * SEQ;
    const bf16* Z = (const bf16*)(ws + WS_Z);
    LAS float* imp = (LAS float*)lds + w * 8 * IMP_LD;
    for (int i = lane; i < 8 * IMP_LD; i += 64) imp[i] = 0.f;
    bf16x8 qf[4];
#pragma unroll
    for (int ks = 0; ks < 4; ++ks) qf[ks] = *(const bf16x8*)(Z + (rowb + t) * NZ + ZC_Q + (kvh * 4 + g) * 64 + 16 * ks + 8 * hi);
    const float* gp = (const float*)(ws + WS_GATES) + (rowb + t) * 24 + (kvh * 4 + g) * 3;
    const float gate_c = gp[0], gate_s = gp[1], gate_w = gp[2];
    LAS float* oacc = (LAS float*)(lds + 8 * 8 * IMP_LD * 4) + w * 2048 + lane;
    {
        const bf16* KC = (const bf16*)(ws + WS_KC) + (size_t)(b * 2 + kvh) * 16 * 2048;
        const bf16* VCT = (const bf16*)(ws + WS_VCT) + (size_t)(b * 2 + kvh) * 16 * 2048;
        const int nv = (t >= 31) ? ((t - 31) >> 4) + 1 : 0;
        const int tl = t0 + 7, nvmax = (tl >= 31) ? ((tl - 31) >> 4) + 1 : 0;
        const unsigned lo16 = 16u * (unsigned)lane;
        float m1 = -1e30f, l1 = 0.f;
        {
            bf16x8 ka[4], kb[4];
#pragma unroll
            for (int ks = 0; ks < 4; ++ks) ka[ks] = *(const bf16x8*)((const char*)KC + lo16 + 1024 * ks);
            for (int n0 = 0; n0 < nvmax; n0 += 32) {
                if (n0 + 32 < nvmax) {
#pragma unroll
                    for (int ks = 0; ks < 4; ++ks) kb[ks] = *(const bf16x8*)((const char*)(KC + (size_t)(n0 + 32) * 64) + lo16 + 1024 * ks);
                }
                f32x16 s = f32x16{};
#pragma unroll
                for (int ks = 0; ks < 4; ++ks) s = __builtin_amdgcn_mfma_f32_32x32x16_bf16(ka[ks], qf[ks], s, 0, 0, 0);
                float mt = -1e30f;
#pragma unroll
                for (int r = 0; r < 16; ++r) { if (n0 + crow(r, hi) >= nv) s[r] = -1e30f; mt = fmaxf(mt, s[r]); }
                const float mn = fmaxf(m1, mt); float ps = 0.f;
#pragma unroll
                for (int r = 0; r < 16; ++r) ps += (s[r] > -1e29f) ? EX2(s[r] - mn) : 0.f;
                l1 = l1 * EX2(m1 - mn) + ps; m1 = mn;
#pragma unroll
                for (int ks = 0; ks < 4; ++ks) ka[ks] = kb[ks];
            }
        }
        { const float mo = __shfl_xor(m1, 32), lo = __shfl_xor(l1, 32); const float mn = fmaxf(m1, mo); l1 = l1 * EX2(m1 - mn) + lo * EX2(mo - mn); m1 = mn; }
        const float invl = (l1 > 0.f) ? 1.0f / l1 : 0.f;
        f32x16 o[2]; o[0] = f32x16{}; o[1] = f32x16{};
        KVF fa, fb;
        if (nvmax > 0) kv_load(fa, KC, VCT, lo16);
        for (int n0 = 0; n0 < nvmax; n0 += 32) {
            if (n0 + 32 < nvmax) kv_load(fb, KC + (size_t)(n0 + 32) * 64, VCT + (size_t)(n0 + 32) * 64, lo16);
            f32x16 s = f32x16{};
#pragma unroll
            for (int ks = 0; ks < 4; ++ks) s = __builtin_amdgcn_mfma_f32_32x32x16_bf16(fa.k[ks], qf[ks], s, 0, 0, 0);
#pragma unroll
            for (int r = 0; r < 16; ++r) s[r] = (n0 + crow(r, hi) < nv) ? EX2(s[r] - m1) * invl : 0.f;
            float bs[4], sp[4];
#pragma unroll
            for (int q = 0; q < 4; ++q) { bs[q] = (s[4 * q] + s[4 * q + 1]) + (s[4 * q + 2] + s[4 * q + 3]); sp[q] = s[4 * q + 3];
                bs[q] += __shfl_xor(bs[q], 8); bs[q] += __shfl_xor(bs[q], 16); sp[q] += __shfl_xor(sp[q], 8); sp[q] += __shfl_xor(sp[q], 16); }
            if (r32 < 8) {
                LAS float* ip = imp + r32 * IMP_LD + (n0 >> 2) + hi;
#pragma unroll
                for (int q = 0; q < 4; ++q) ip[2 * q] += bs[q];
                asm volatile("s_waitcnt lgkmcnt(0)" ::: "memory");
#pragma unroll
                for (int q = 0; q < 4; ++q) ip[2 * q + 1] += sp[q];
                asm volatile("s_waitcnt lgkmcnt(0)" ::: "memory");
            }
#pragma unroll
            for (int s2 = 0; s2 < 2; ++s2) { v4u pw; pw.x = pk2(s[8 * s2], s[8 * s2 + 1]); pw.y = pk2(s[8 * s2 + 2], s[8 * s2 + 3]); pw.z = pk2(s[8 * s2 + 4], s[8 * s2 + 5]); pw.w = pk2(s[8 * s2 + 6], s[8 * s2 + 7]);
                const bf16x8 pf = __builtin_bit_cast(bf16x8, pw);
#pragma unroll
                for (int dt = 0; dt < 2; ++dt) o[dt] = __builtin_amdgcn_mfma_f32_32x32x16_bf16(fa.v[dt][s2], pf, o[dt], 0, 0, 0); }
            if (n0 + 32 < nvmax) fa = fb;
        }
#pragma unroll
        for (int dt = 0; dt < 2; ++dt)
#pragma unroll
            for (int r = 0; r < 16; ++r) oacc[(dt * 16 + r) * 64] = gate_c * o[dt][r];
    }
    asm volatile("s_waitcnt lgkmcnt(0)" ::: "memory");
    unsigned mym[4] = {0u, 0u, 0u, 0u}, un[4] = {0u, 0u, 0u, 0u};
    if (cur < 16) { const unsigned mk = (2u << cur) - 1u; mym[0] = mk; un[0] = mk; }
    else {
        const int tq = lane >> 3, sub = lane & 7;
        int key[16];
#pragma unroll
        for (int i = 0; i < 16; ++i) { const int j = 16 * sub + i; const float v = imp[tq * IMP_LD + j];
            key[i] = (j >= 1 && j <= cur - 2) ? (int)((__builtin_bit_cast(unsigned, v) & ~0x7fu) | (unsigned)(127 - j)) : 0; }
        sort16_desc(key);
        { int ot[16];
#pragma unroll
          for (int i = 0; i < 16; ++i) ot[i] = __builtin_amdgcn_mov_dpp(key[i], 0xB1, 0xf, 0xf, true);
          merge16_desc(key, ot);
#pragma unroll
          for (int i = 0; i < 16; ++i) ot[i] = __builtin_amdgcn_mov_dpp(key[i], 0x4E, 0xf, 0xf, true);
          merge16_desc(key, ot);
#pragma unroll
          for (int i = 0; i < 16; ++i) ot[i] = __builtin_amdgcn_mov_dpp(key[i], 0x141, 0xf, 0xf, true);
          merge16_desc(key, ot); }
        unsigned mk[4] = {1u, 0u, 0u, 0u};
        { const int c1 = cur - 1; if (c1 < 32) mk[0] |= 1u << c1; else if (c1 < 64) mk[1] |= 1u << (c1 - 32); else if (c1 < 96) mk[2] |= 1u << (c1 - 64); else mk[3] |= 1u << (c1 - 96);
          if (cur < 32) mk[0] |= 1u << cur; else if (cur < 64) mk[1] |= 1u << (cur - 32); else if (cur < 96) mk[2] |= 1u << (cur - 64); else mk[3] |= 1u << (cur - 96); }
#pragma unroll
        for (int i = 0; i < 13; ++i) { const int j = 127 - (key[i] & 0x7f); const unsigned bit = (key[i] != 0) ? (1u << (j & 31)) : 0u; const int wd = j >> 5;
            mk[0] |= (wd == 0) ? bit : 0u; mk[1] |= (wd == 1) ? bit : 0u; mk[2] |= (wd == 2) ? bit : 0u; mk[3] |= (wd == 3) ? bit : 0u; }
#pragma unroll
        for (int i = 0; i < 4; ++i) { unsigned u = mk[i]; u |= (unsigned)__shfl_xor((int)u, 8); u |= (unsigned)__shfl_xor((int)u, 16); u |= (unsigned)__shfl_xor((int)u, 32); un[i] = u;
            mym[i] = (unsigned)__shfl((int)mk[i], 8 * ti); }
    }
    float q2 = 0.f;
#pragma unroll
    for (int ks = 0; ks < 4; ++ks) { const v4u qw = __builtin_bit_cast(v4u, qf[ks]); const unsigned ww[4] = {qw.x, qw.y, qw.z, qw.w};
#pragma unroll
        for (int k = 0; k < 4; ++k) { const float a = bflo(ww[k]), c = bfhi(ww[k]); q2 += a * a + c * c; } }
    q2 = addswap32_f(q2);
    const unsigned* KMX = (const unsigned*)(ws + WS_CTL) + CW_KMAX + (b * 2 + kvh) * 2;
    const float Ms = __builtin_amdgcn_sqrtf(q2 * __builtin_bit_cast(float, KMX[0])) * 1.0001f + 1e-3f, Mw = __builtin_amdgcn_sqrtf(q2 * __builtin_bit_cast(float, KMX[1])) * 1.0001f + 1e-3f;
    const bool fixed_ok = !__any(Ms >= 60.f || Mw >= 60.f);
    {
        AttnSt st; st.m = -1e30f; st.l = 0.f; st.o[0] = f32x16{}; st.o[1] = f32x16{};
        const bf16* KS = (const bf16*)(ws + WS_KSF) + (size_t)(b * 2 + kvh) * 256 * 2048; const unsigned char* VS = ws + WS_VSF + (size_t)(b * 2 + kvh) * 256 * 2048;
        const unsigned lo16 = 16u * (unsigned)lane;
        unsigned um0 = (unsigned)__builtin_amdgcn_readfirstlane((int)un[0]), um1 = (unsigned)__builtin_amdgcn_readfirstlane((int)un[1]), um2 = (unsigned)__builtin_amdgcn_readfirstlane((int)un[2]), um3 = (unsigned)__builtin_amdgcn_readfirstlane((int)un[3]);
#define NEXT_BLOCK(jv) do { if (um0) { jv = __builtin_ctz(um0); um0 &= um0 - 1u; } else if (um1) { jv = 32 + __builtin_ctz(um1); um1 &= um1 - 1u; } else if (um2) { jv = 64 + __builtin_ctz(um2); um2 &= um2 - 1u; } \
            else if (um3) { jv = 96 + __builtin_ctz(um3); um3 &= um3 - 1u; } else jv = -1; } while (0)
#define SLC_LOOP(FX) do { f32x16 negm; _Pragma("unroll") for (int r = 0; r < 16; ++r) negm[r] = -Ms; \
        KVF8 fa, fb; int j; NEXT_BLOCK(j); \
        if (j >= 0) kv_load8(fa, KS + (size_t)j * 4096, VS + (size_t)j * 4096, lo16); \
        while (j >= 0) { const int key0 = j * 64; \
            const unsigned mw = (j < 32) ? mym[0] : (j < 64) ? mym[1] : (j < 96) ? mym[2] : mym[3]; const bool sel = (mw >> (j & 31)) & 1u; \
            kv_load8(fb, KS + (size_t)j * 4096 + 2048, VS + (size_t)j * 4096 + 2048, lo16); \
            if (j == cur) attn_compute<2, FX>(fa, qf, negm, sel, [&](int r) { return sel && (key0 + crow(r, hi) <= t); }, st); \
            else attn_compute<1, FX>(fa, qf, negm, sel, [&](int) { return true; }, st); \
            int jn; NEXT_BLOCK(jn); \
            if (jn >= 0) kv_load8(fa, KS + (size_t)jn * 4096, VS + (size_t)jn * 4096, lo16); \
            if (j == cur) attn_compute<2, FX>(fb, qf, negm, sel, [&](int r) { return sel && (key0 + 32 + crow(r, hi) <= t); }, st); \
            else attn_compute<1, FX>(fb, qf, negm, sel, [&](int) { return true; }, st); \
            j = jn; } } while (0)
        if (fixed_ok) SLC_LOOP(true); else SLC_LOOP(false);
#undef SLC_LOOP
#undef NEXT_BLOCK
        const float l = addswap32_f(st.l); const float sc = gate_s / l;
#pragma unroll
        for (int dt = 0; dt < 2; ++dt)
#pragma unroll
            for (int r = 0; r < 16; ++r) oacc[(dt * 16 + r) * 64] += sc * st.o[dt][r];
    }
    f32x16 outv[2];
    {
        AttnSt st; st.m = -1e30f; st.l = 0.f; st.o[0] = f32x16{}; st.o[1] = f32x16{};
        const bf16* KW = (const bf16*)(ws + WS_KWF) + (size_t)(b * 2 + kvh) * 256 * 2048; const unsigned char* VW = ws + WS_VWF + (size_t)(b * 2 + kvh) * 256 * 2048;
        const unsigned lo16 = 16u * (unsigned)lane;
        const int klo = (t0 - 511 > 0) ? ((t0 - 511) & ~31) : 0, khi = (t0 + 7) & ~31;
#define WIN_LOOP(FX) do { f32x16 negm; _Pragma("unroll") for (int r = 0; r < 16; ++r) negm[r] = -Mw; \
        KVF8 fa, fb; kv_load8(fa, KW + (size_t)klo * 64, VW + (size_t)klo * 64, lo16); \
        _Pragma("unroll 1") for (int key0 = klo; key0 <= khi; key0 += 32) { \
            if (key0 + 32 <= khi) kv_load8(fb, KW + (size_t)(key0 + 32) * 64, VW + (size_t)(key0 + 32) * 64, lo16); \
            if (key0 + 31 > t0 || key0 <= t0 + 7 - 512) attn_compute<2, FX>(fa, qf, negm, true, [&](int r) { const int kp = key0 + crow(r, hi); return kp <= t && kp > t - 512; }, st); \
            else attn_compute<0, FX>(fa, qf, negm, true, [&](int) { return true; }, st); \
            if (key0 + 32 <= khi) fa = fb; } } while (0)
        if (fixed_ok) WIN_LOOP(true); else WIN_LOOP(false);
#undef WIN_LOOP
        const float l = addswap32_f(st.l); const float sc = gate_w / l;
#pragma unroll
        for (int dt = 0; dt < 2; ++dt)
#pragma unroll
            for (int r = 0; r < 16; ++r) outv[dt][r] = oacc[(dt * 16 + r) * 64] + sc * st.o[dt][r];
    }
    float ss = 0.f;
#pragma unroll
    for (int dt = 0; dt < 2; ++dt)
#pragma unroll
        for (int r = 0; r < 16; ++r) ss += outv[dt][r] * outv[dt][r];
    ss += __shfl_xor(ss, 32); ss += __shfl_xor(ss, 8); ss += __shfl_xor(ss, 16);
    if (lane < 8) ((float*)(ws + WS_SSQN))[(rowb + t0 + lane) * 2 + kvh] = ss;
    bf16* Yp = (bf16*)(ws + WS_Y) + (rowb + t) * DM + (kvh * 4 + g) * 64 + 4 * hi;
#pragma unroll
    for (int dt = 0; dt < 2; ++dt)
#pragma unroll
        for (int q = 0; q < 4; ++q) { v2u o; o.x = pk2(outv[dt][4 * q], outv[dt][4 * q + 1]); o.y = pk2(outv[dt][4 * q + 2], outv[dt][4 * q + 3]); *(v2u*)(Yp + 32 * dt + 8 * q) = o; }
}
__device__ __forceinline__ void memattn_item(const Frame& F, const Args& A, int item) {
    unsigned char* ws = A.ws;
    const int lane = F.lane, r32 = lane & 31, hi = lane >> 5;
    const int h = item & 3, tile = item >> 2; const size_t row0 = (size_t)tile * 32; const int b = (int)(row0 >> 13);
    const bf16* Q = (const bf16*)(ws + WS_QM) + (size_t)tile * 32 * DM + (size_t)(h * 16) * 512 + 8 * lane;
    const bf16* K = (const bf16*)(ws + WS_MEMK) + (size_t)(b * 8) * 32 * DM + (size_t)(h * 16) * 512 + 8 * lane;
    const bf16* VF = (const bf16*)(ws + WS_MEMVT) + (size_t)((b * 4 + h) * 8) * 8192 + 8 * lane;
    f32x16 s[8];
#pragma unroll
    for (int kt = 0; kt < 8; ++kt) s[kt] = f32x16{};
#define QK_LOAD(qv, kv, ks_) do { const int kk_ = (ks_) < 16 ? (ks_) : 15; qv = *(const bf16x8*)(Q + 512 * kk_); _Pragma("unroll") for (int kt = 0; kt < 8; ++kt) kv[kt] = *(const bf16x8*)(K + (size_t)kt * 32 * DM + 512 * kk_); } while (0)
#define QK_MMA(qv, kv) do { _Pragma("unroll") for (int kt = 0; kt < 8; ++kt) s[kt] = __builtin_amdgcn_mfma_f32_32x32x16_bf16(kv[kt], qv, s[kt], 0, 0, 0); } while (0)
    { bf16x8 qa, qb, ka[8], kb[8];
      QK_LOAD(qa, ka, 0);
#pragma unroll 1
      for (int ks = 0; ks < 16; ks += 2) {
          QK_LOAD(qb, kb, ks + 1); asm volatile("" ::: "memory");
          QK_MMA(qa, ka);
          QK_LOAD(qa, ka, ks + 2); asm volatile("" ::: "memory");
          QK_MMA(qb, kb); } }
#undef QK_LOAD
#undef QK_MMA
    float m = -1e30f;
#pragma unroll
    for (int kt = 0; kt < 8; ++kt) m = fmaxf(m, max16(s[kt]));
    m = maxswap32_f(m);
    float l = 0.f; v4u pw[8][2];
#pragma unroll
    for (int kt = 0; kt < 8; ++kt) {
#pragma unroll
        for (int r = 0; r < 16; ++r) s[kt][r] = EX2(s[kt][r] - m);
        l += sum16(s[kt]);
#pragma unroll
        for (int s2 = 0; s2 < 2; ++s2) { pw[kt][s2].x = pk2(s[kt][8 * s2], s[kt][8 * s2 + 1]); pw[kt][s2].y = pk2(s[kt][8 * s2 + 2], s[kt][8 * s2 + 3]); pw[kt][s2].z = pk2(s[kt][8 * s2 + 4], s[kt][8 * s2 + 5]); pw[kt][s2].w = pk2(s[kt][8 * s2 + 6], s[kt][8 * s2 + 7]); } }
    l = addswap32_f(l);
    const float invl = 1.0f / l;
    bf16* O = (bf16*)(ws + WS_OM) + (row0 + r32) * DM + h * 256 + 4 * hi;
#define PV_LOAD(vv, dt_) do { const int dd_ = (dt_) < 8 ? (dt_) : 7; _Pragma("unroll") for (int kt = 0; kt < 8; ++kt) _Pragma("unroll") for (int s2 = 0; s2 < 2; ++s2) vv[2 * kt + s2] = *(const bf16x8*)(VF + (size_t)kt * 8192 + dd_ * 1024 + s2 * 512); } while (0)
#define PV_MMA(vv, dt_) do { f32x16 o = f32x16{}; _Pragma("unroll") for (int kt = 0; kt < 8; ++kt) _Pragma("unroll") for (int s2 = 0; s2 < 2; ++s2) o = __builtin_amdgcn_mfma_f32_32x32x16_bf16(vv[2 * kt + s2], __builtin_bit_cast(bf16x8, pw[kt][s2]), o, 0, 0, 0); \
        _Pragma("unroll") for (int q = 0; q < 4; ++q) { v2u ov; ov.x = pk2(o[4 * q] * invl, o[4 * q + 1] * invl); ov.y = pk2(o[4 * q + 2] * invl, o[4 * q + 3] * invl); *(v2u*)(O + 32 * (dt_) + 8 * q) = ov; } } while (0)
    { bf16x8 va[16], vb[16];
      PV_LOAD(va, 0);
#pragma unroll 1
      for (int dt = 0; dt < 8; dt += 2) {
          PV_LOAD(vb, dt + 1); asm volatile("" ::: "memory");
          PV_MMA(va, dt);
          PV_LOAD(va, dt + 2); asm volatile("" ::: "memory");
          PV_MMA(vb, dt + 1); } }
#undef PV_LOAD
#undef PV_MMA
}

__device__ __forceinline__ int f2key(float f) { const int u = __builtin_bit_cast(int, f); return u ^ ((u >> 31) & 0x7fffffff); }
__device__ __forceinline__ float key2f(int k) { const int u = k ^ ((k >> 31) & 0x7fffffff); return __builtin_bit_cast(float, u); }
__device__ __forceinline__ void top16_of_128(f32x16 (&s)[4], int hi, int (&kv)[16]) {
    int key[4][16];
#pragma unroll
    for (int nt = 0; nt < 4; ++nt)
#pragma unroll
        for (int r = 0; r < 16; ++r) key[nt][r] = (f2key(s[nt][r]) & ~0x7f) | (127 - (32 * nt + crow(r, hi)));
#pragma unroll
    for (int nt = 0; nt < 4; ++nt) sort16_desc(key[nt]);
    merge16_desc(key[0], key[1]); merge16_desc(key[2], key[3]); merge16_desc(key[0], key[2]);
    unsigned a[16], b[16];
#pragma unroll
    for (int i = 0; i < 16; ++i) { a[i] = (unsigned)key[0][i]; b[i] = a[i]; swap32(a[i], b[i]); }
#pragma unroll
    for (int i = 0; i < 16; ++i) kv[i] = max((int)a[i], (int)b[15 - i]);
    bitonic16_desc(kv);
}
template <bool LDSK>
__device__ __forceinline__ void peer_topk_item(const Frame& F, const Args& A, int item, const LAS unsigned char* lds) {
    unsigned char* ws = A.ws;
    int lane = lane_id(); asm volatile("" : "+v"(lane));
    const int r32 = lane & 31, hi = lane >> 5;
    const int h = item & 7, tile = item >> 3; const size_t row = (size_t)tile * 32 + r32;
    const bf16* QP = (const bf16*)(ws + WS_QP) + (size_t)tile * 32 * 2048 + (size_t)(h * 16) * 512 + 8 * lane;
    int k1[16], k2[16];
#pragma unroll
    for (int i = 0; i < 16; ++i) { k1[i] = 0; k2[i] = 0; }
#pragma unroll 1
    for (int c = 0; c < 2; ++c) {
        const bf16* SK = (const bf16*)(ws + WS_SKEY) + (size_t)((h * 2 + c) * 4) * 4096 + 8 * lane;
        f32x16 s[4];
#pragma unroll
        for (int nt = 0; nt < 4; ++nt) s[nt] = f32x16{};
        bf16x8 qf[8];
#pragma unroll
        for (int ks = 0; ks < 8; ++ks) qf[ks] = *(const bf16x8*)(QP + (size_t)(c * 8 + ks) * 512);
#pragma unroll
        for (int ks = 0; ks < 8; ++ks) {
#pragma unroll
            for (int nt = 0; nt < 4; ++nt) { const bf16x8 kf = LDSK ? *(const LAS bf16x8*)(lds + ((c * 4 + nt) * 4096 + ks * 512) * 2 + lane * 16) : *(const bf16x8*)(SK + (size_t)nt * 4096 + ks * 512);
                s[nt] = __builtin_amdgcn_mfma_f32_32x32x16_bf16(kf, qf[ks], s[nt], 0, 0, 0); } }
        if (c == 0) top16_of_128(s, hi, k1); else top16_of_128(s, hi, k2);
    }
    float v1[16], v2[16];
#pragma unroll
    for (int i = 0; i < 16; ++i) { v1[i] = key2f(k1[i] & ~0x7f); v2[i] = key2f(k2[i] & ~0x7f); }
    int ck[32];
    {
        int idx = 0;
#pragma unroll
        for (int i = 0; i < 32; ++i) ck[i] = (int)0x80000000;
#pragma unroll
        for (int a = 0; a < 16; ++a)
#pragma unroll
            for (int bq = 0; bq < 16; ++bq) if ((a + 1) * (bq + 1) <= 16) {
                const int flat = a * 16 + bq; const int kk = (f2key(v1[a] + v2[bq]) & ~0xff) | (255 - flat);
                if ((idx & 1) == hi) ck[idx >> 1] = kk;
                ++idx; }
    }
    sort32_desc(ck);
    int tk[16];
    { unsigned a[16], b[16];
#pragma unroll
      for (int i = 0; i < 16; ++i) { a[i] = (unsigned)ck[i]; b[i] = a[i]; swap32(a[i], b[i]); }
#pragma unroll
      for (int i = 0; i < 16; ++i) tk[i] = max((int)a[i], (int)b[15 - i]);
      bitonic16_desc(tk); }
    int te[16];
    { LAS int* tab = (LAS int*)(lds + 65536 + F.wave * 8448) + lane * 33;
#pragma unroll
      for (int i = 0; i < 16; ++i) { tab[i] = 127 - (k1[i] & 0x7f); tab[16 + i] = 127 - (k2[i] & 0x7f); }
      asm volatile("s_waitcnt lgkmcnt(0)" ::: "memory");
#pragma unroll
      for (int i = 0; i < 16; ++i) { const int flat = 255 - (tk[i] & 0xff); te[i] = tab[flat >> 4] * 128 + tab[16 + (flat & 15)]; }
      asm volatile("s_waitcnt lgkmcnt(0)" ::: "memory"); }
    float gsm[16]; const float mx = key2f(tk[0] & ~0xff); float den = 0.f;
#pragma unroll
    for (int i = 0; i < 16; ++i) { gsm[i] = __expf(key2f(tk[i] & ~0xff) - mx); den += gsm[i]; }
    const float inv = 1.0f / den;
    if (hi == 0) {
        int* EID = (int*)(ws + WS_EID) + row * 128 + h * 16; float* GW = (float*)(ws + WS_GW) + row * 128 + h * 16;
#pragma unroll
        for (int q = 0; q < 4; ++q) { *(v4u*)(EID + 4 * q) = (v4u){(unsigned)te[4 * q], (unsigned)te[4 * q + 1], (unsigned)te[4 * q + 2], (unsigned)te[4 * q + 3]};
            *(f32x4*)(GW + 4 * q) = (f32x4){gsm[4 * q] * inv, gsm[4 * q + 1] * inv, gsm[4 * q + 2] * inv, gsm[4 * q + 3] * inv}; }
    }
}

typedef float f32x2 __attribute__((ext_vector_type(2)));
__device__ __forceinline__ float dot16_fp8(const v4u u, const f32x2 (&xn)[8]) {
    f32x2 a0 = {0.f, 0.f}, a1 = {0.f, 0.f};
#pragma unroll
    for (int j = 0; j < 4; ++j) { const f32x2 lo = __builtin_amdgcn_cvt_pk_f32_fp8((int)u[j], false), hi = __builtin_amdgcn_cvt_pk_f32_fp8((int)u[j], true);
        a0 = __builtin_elementwise_fma(lo, xn[2 * j], a0); a1 = __builtin_elementwise_fma(hi, xn[2 * j + 1], a1); }
    return (a0.x + a0.y) + (a1.x + a1.y);
}
__device__ __forceinline__ void axpy16_fp8(f32x2 (&acc)[8], const float w, const v4u u) {
    const f32x2 w2 = {w, w};
#pragma unroll
    for (int j = 0; j < 4; ++j) { const f32x2 lo = __builtin_amdgcn_cvt_pk_f32_fp8((int)u[j], false), hi = __builtin_amdgcn_cvt_pk_f32_fp8((int)u[j], true);
        acc[2 * j] = __builtin_elementwise_fma(lo, w2, acc[2 * j]); acc[2 * j + 1] = __builtin_elementwise_fma(hi, w2, acc[2 * j + 1]); }
}
#define TIE_ROW(val, nxt) asm volatile("" : "+v"(val), "+v"((nxt).x), "+v"((nxt).y), "+v"((nxt).z), "+v"((nxt).w))
constexpr int PQ_CHUNK = 128, PQ_NCHUNK = MTOK / PQ_CHUNK;
constexpr int CW_NQ = 10240;
constexpr int CW_PQ = 8192;
__device__ __forceinline__ int pq_pop(unsigned* ctl, int pass, int own, int& q_s, LAS int* bc, int wave) {
    __syncthreads();
    if (wave == 0 && lane_id() == 0) { int res = -1; int s = q_s;
        while (s < 8) { const int x = (own + s) & 7; const unsigned c = __hip_atomic_fetch_add(ctl + CW_PQ + 64 * (8 * pass + x), 1u, __ATOMIC_RELAXED, __HIP_MEMORY_SCOPE_AGENT);
            if (c < (unsigned)PQ_NCHUNK) { res = x * PQ_NCHUNK + (int)c; break; } ++s; }
        bc[0] = res; bc[1] = s; }
    __syncthreads();
    q_s = bc[1]; return bc[0];
}
template <int CTRL> __device__ __forceinline__ float dppf(float v) { return __builtin_bit_cast(float, __builtin_amdgcn_mov_dpp(__builtin_bit_cast(int, v), CTRL, 0xf, 0xf, true)); }
__device__ __forceinline__ float red8(float d) { d += dppf<0xB1>(d); d += dppf<0x4E>(d); d += dppf<0x141>(d); return d; }
__device__ __forceinline__ void peer_issue8(v4u (&rb)[8], const v4u ia, const v4u ib, const unsigned char* T  , unsigned c16) {
    const unsigned e[8] = {ia.x, ia.y, ia.z, ia.w, ib.x, ib.y, ib.z, ib.w};
#pragma unroll
    for (int i = 0; i < 8; ++i) rb[i] = *(const v4u*)(T + (e[i] * 128u + c16));
}
__device__ __forceinline__ void peer_u_chunk(const Frame& F, const Args& A, int x, int chunk) {
    unsigned char* ws = A.ws; int lane = lane_id(); asm volatile("" : "+v"(lane));
    const int tk = lane >> 3, c8 = lane & 7;
    const unsigned char* U = ws + WS_U8 + (size_t)x * 16384 * 128; const unsigned c16 = 16u * (unsigned)c8;
#pragma unroll 1
    for (int oc = 0; oc < 2; ++oc) {
        const unsigned row = (unsigned)(chunk * PQ_CHUNK + F.wave * 16 + oc * 8 + tk);
        const unsigned char* EIDb = ws + WS_EID; const unsigned eoff = row * 512u;
#define EID_LD(i_) (*(const v4u*)(EIDb + (eoff + 16u * (unsigned)(i_))))
        f32x2 xn[8];
        { const unsigned char* xb_ = ws + WS_XN; const unsigned xo = row * 2048u + 256u * (unsigned)x + 32u * (unsigned)c8; const v4u xa = *(const v4u*)(xb_ + xo), xb = *(const v4u*)(xb_ + (xo + 16u));
          const unsigned xw[8] = {xa.x, xa.y, xa.z, xa.w, xb.x, xb.y, xb.z, xb.w};
#pragma unroll
          for (int j = 0; j < 8; ++j) { xn[j].x = bflo(xw[j]); xn[j].y = bfhi(xw[j]); } }
        float rstd; { const f32x4* sp = (const f32x4*)(ws + WS_SSQ2 + (size_t)row * 64); const f32x4 a = sp[0], b = sp[1], c = sp[2], d = sp[3];
            rstd = rsqrtf((((a.x + a.y) + (a.z + a.w)) + ((b.x + b.y) + (b.z + b.w)) + ((c.x + c.y) + (c.z + c.w)) + ((d.x + d.y) + (d.z + d.w))) * (1.f / DM) + EPS); }
        unsigned char* ppb = ws + WS_PART; const unsigned po = ((unsigned)x * MTOK + row) * 256u + 32u * (unsigned)c8;
        v4u ra[8], rb[8]; v4u ia0 = EID_LD(0), ia1 = EID_LD(1), ib0 = EID_LD(2), ib1 = EID_LD(3);
        peer_issue8(ra, ia0, ia1, U, c16); ia0 = EID_LD(4); ia1 = EID_LD(5);
#pragma unroll 1
        for (int q = 0; q < 16; q += 2) {
            peer_issue8(rb, ib0, ib1, U, c16); { const int qn = (q + 3 < 16) ? q + 3 : 15; ib0 = EID_LD(2 * qn); ib1 = EID_LD(2 * qn + 1); }
            float k0 = 0.f, k1 = 0.f;
#pragma unroll
            for (int i = 0; i < 8; ++i) { float d = dot16_fp8(ra[i], xn); if (i < 7) TIE_ROW(d, ra[i + 1]); d = red8(d); k0 = (c8 == i) ? d : k0; }
            peer_issue8(ra, ia0, ia1, U, c16); { const int qn = (q + 4 < 16) ? q + 4 : 15; ia0 = EID_LD(2 * qn); ia1 = EID_LD(2 * qn + 1); }
#pragma unroll
            for (int i = 0; i < 8; ++i) { float d = dot16_fp8(rb[i], xn); if (i < 7) TIE_ROW(d, rb[i + 1]); d = red8(d); k1 = (c8 == i) ? d : k1; }
            *(unsigned*)(ppb + (po + 2u * (unsigned)q)) = pk2(k0 * rstd, k1 * rstd);
        }
    }
}
__device__ __forceinline__ void peer_w_rows(const Frame& F, const Args& A) {
    unsigned char* ws = A.ws; const int lane = lane_id();
    const float* SU = (const float*)(ws + WS_SU); const float* SV = (const float*)(ws + WS_SV);
    const int p0 = 2 * lane, k0 = 8 * (p0 & 15) + (p0 >> 4), k1 = k0 + 8;
    for (int m0 = F.gw; m0 < MTOK; m0 += 4 * F.NGW) {
        int e0[4], e1[4]; float g0[4], g1[4]; unsigned pw[4][8];
#pragma unroll
        for (int r = 0; r < 4; ++r) { const size_t row = (size_t)(m0 + r * F.NGW < MTOK ? m0 + r * F.NGW : m0);
            const int* EID = (const int*)(ws + WS_EID) + row * 128; const float* GW = (const float*)(ws + WS_GW) + row * 128;
            e0[r] = EID[k0]; e1[r] = EID[k1]; g0[r] = GW[k0]; g1[r] = GW[k1];
#pragma unroll
            for (int x = 0; x < 8; ++x) pw[r][x] = *(const unsigned*)((const bf16*)(ws + WS_PART) + ((size_t)x * MTOK + row) * 128 + p0); }
        float su0[4], su1[4], sv0[4], sv1[4];
#pragma unroll
        for (int r = 0; r < 4; ++r) { su0[r] = SU[e0[r]]; su1[r] = SU[e1[r]]; sv0[r] = SV[e0[r]]; sv1[r] = SV[e1[r]]; }
#pragma unroll
        for (int r = 0; r < 4; ++r) { if (m0 + r * F.NGW < MTOK) { const size_t row = (size_t)(m0 + r * F.NGW); float s0 = 0.f, s1 = 0.f;
#pragma unroll
            for (int x = 0; x < 8; ++x) { s0 += bflo(pw[r][x]); s1 += bfhi(pw[r][x]); }
            float* W = (float*)(ws + WS_W) + row * 128;
            W[k0] = gelu_tanh(s0 * su0[r]) * g0[r] * sv0[r]; W[k1] = gelu_tanh(s1 * su1[r]) * g1[r] * sv1[r]; } }
    }
}
__device__ __forceinline__ void peer_v_chunk(const Frame& F, const Args& A, int x, int chunk) {
    unsigned char* ws = A.ws; int lane = lane_id(); asm volatile("" : "+v"(lane));
    const int tk = lane >> 3, c8 = lane & 7;
    const unsigned char* V = ws + WS_V8 + (size_t)x * 16384 * 128; const unsigned c16 = 16u * (unsigned)c8;
#pragma unroll 1
    for (int oc = 0; oc < 2; ++oc) {
        const unsigned row = (unsigned)(chunk * PQ_CHUNK + F.wave * 16 + oc * 8 + tk);
        const unsigned char* EIDb = ws + WS_EID; const unsigned char* Wb = ws + WS_W; const unsigned eoff = row * 512u;
#define W_LD(i_) (*(const f32x4*)(Wb + (eoff + 16u * (unsigned)(i_))))
        f32x2 acc[8];
#pragma unroll
        for (int j = 0; j < 8; ++j) acc[j] = (f32x2){0.f, 0.f};
        v4u ra[8], rb[8]; v4u ia0 = EID_LD(0), ia1 = EID_LD(1), ib0 = EID_LD(2), ib1 = EID_LD(3); f32x4 wa0 = W_LD(0), wa1 = W_LD(1), wb0 = W_LD(2), wb1 = W_LD(3);
        peer_issue8(ra, ia0, ia1, V, c16); ia0 = EID_LD(4); ia1 = EID_LD(5);
#pragma unroll 1
        for (int q = 0; q < 16; q += 2) {
            peer_issue8(rb, ib0, ib1, V, c16); { const int qn = (q + 3 < 16) ? q + 3 : 15; ib0 = EID_LD(2 * qn); ib1 = EID_LD(2 * qn + 1); }
            { const float wv[8] = {wa0.x, wa0.y, wa0.z, wa0.w, wa1.x, wa1.y, wa1.z, wa1.w};
#pragma unroll
              for (int i = 0; i < 8; ++i) { axpy16_fp8(acc, wv[i], ra[i]); if (i < 7) TIE_ROW(acc[7].y, ra[i + 1]); } }
            { const int qn = (q + 2 < 16) ? q + 2 : 15; wa0 = W_LD(2 * qn); wa1 = W_LD(2 * qn + 1); }
            peer_issue8(ra, ia0, ia1, V, c16); { const int qn = (q + 4 < 16) ? q + 4 : 15; ia0 = EID_LD(2 * qn); ia1 = EID_LD(2 * qn + 1); }
            { const float wv[8] = {wb0.x, wb0.y, wb0.z, wb0.w, wb1.x, wb1.y, wb1.z, wb1.w};
#pragma unroll
              for (int i = 0; i < 8; ++i) { axpy16_fp8(acc, wv[i], rb[i]); if (i < 7) TIE_ROW(acc[7].y, rb[i + 1]); } }
            { const int qn = (q + 3 < 16) ? q + 3 : 15; wb0 = W_LD(2 * qn); wb1 = W_LD(2 * qn + 1); }
        }
        unsigned char* xr = ws + WS_XN + (row * 2048u + 256u * (unsigned)x + 32u * (unsigned)c8); float ss = 0.f;
        const v4u x2a = *(const v4u*)xr, x2b = *(const v4u*)(xr + 16);
        const unsigned xw[8] = {x2a.x, x2a.y, x2a.z, x2a.w, x2b.x, x2b.y, x2b.z, x2b.w};
        unsigned ow[8];
#pragma unroll
        for (int j = 0; j < 4; ++j) { f32x4 v; v.x = bflo(xw[2 * j]) + acc[2 * j].x; v.y = bfhi(xw[2 * j]) + acc[2 * j].y; v.z = bflo(xw[2 * j + 1]) + acc[2 * j + 1].x; v.w = bfhi(xw[2 * j + 1]) + acc[2 * j + 1].y;
            ss += (v.x * v.x + v.y * v.y) + (v.z * v.z + v.w * v.w); ow[2 * j] = pk2(v.x, v.y); ow[2 * j + 1] = pk2(v.z, v.w); }
        *(v4u*)xr = (v4u){ow[0], ow[1], ow[2], ow[3]}; *(v4u*)(xr + 16) = (v4u){ow[4], ow[5], ow[6], ow[7]};
        ss = red8(ss);
        if (c8 == 0) ((float*)(ws + WS_SSQ3))[row * 8 + x] = ss;
    }
#undef W_LD
#undef EID_LD
}
__device__ __forceinline__ void peer_final_rows(const Frame& F, const Args& A) {
    unsigned char* ws = A.ws; const int lane = lane_id(); const float* g = A.in[32];
    for (int m = F.gw; m < MTOK; m += F.NGW) {
        const f32x4 sa = *(const f32x4*)((const float*)(ws + WS_SSQ3) + (size_t)m * 8), sb = *(const f32x4*)((const float*)(ws + WS_SSQ3) + (size_t)m * 8 + 4);
        const float rstd = rsqrtf((((sa.x + sa.y) + (sa.z + sa.w)) + ((sb.x + sb.y) + (sb.z + sb.w))) * (1.f / DM) + EPS);
        f32x4* xr = (f32x4*)(A.out + (size_t)m * DM) + lane; const v2u* xb = (const v2u*)((const bf16*)(ws + WS_XN) + (size_t)m * DM) + lane;
#pragma unroll
        for (int j = 0; j < 4; ++j) { const v2u w = xb[64 * j]; const f32x4 gg = ((const f32x4*)g)[lane + 64 * j]; const f32x4 v = {bflo(w.x), bfhi(w.x), bflo(w.y), bfhi(w.y)}; xr[64 * j] = v * rstd * gg; }
    }
}

typedef GAS unsigned gu32;
#define RLX_AGENT __ATOMIC_RELAXED, __HIP_MEMORY_SCOPE_AGENT
#define XB_TMO      128
#define XB_XCNT(j)  (256  + 64 * (j))
#define XB_XSUB(j)  (1280 + 64 * (j))
#define XB_XGEN(j)  (2304 + 64 * (j))
#define XB_TOP      3328
#define XB_TOPGEN   3392
#define XCD_BAR_WORDS 3456
#define XB_SPIN_CAP (1u << 18)

__device__ __forceinline__ unsigned xb_ld(unsigned* p)              { return __hip_atomic_load(p, __ATOMIC_RELAXED, __HIP_MEMORY_SCOPE_AGENT); }
__device__ __forceinline__ unsigned xb_add(unsigned* p, unsigned v) { return __hip_atomic_fetch_add(p, v, __ATOMIC_RELAXED, __HIP_MEMORY_SCOPE_AGENT); }
__device__ __forceinline__ unsigned xb_xcc_id() { return (unsigned)__builtin_amdgcn_s_getreg((3 << 11) | 20) & 0xFu; }
#define XB_SPIN(cond, bar) do { unsigned _sp = 0; while (cond) { __builtin_amdgcn_s_sleep(1); \
    if ((++_sp & 255u) == 0u) { if (xb_ld(&(bar)[XB_TMO])) break; if (_sp > XB_SPIN_CAP) { atomicAdd(&(bar)[XB_TMO], 1u); break; } } } } while (0)

struct XcdBarrier {
    unsigned* bar; unsigned x;
    volatile LAS unsigned* st;
};

__device__ __forceinline__ XcdBarrier xcd_barrier_post(unsigned* bar, volatile LAS unsigned* st) {
    XcdBarrier b; b.bar = bar; b.x = xb_xcc_id(); b.st = st;
    if (threadIdx.x == 0) (void)xb_add(&bar[XB_XCNT(b.x)], 1u);
    return b;
}
__device__ __forceinline__ void xcd_barrier_complete(unsigned* bar, unsigned x, unsigned& nloc, unsigned& nx) {
    const unsigned G = gridDim.x * gridDim.y * gridDim.z;
    unsigned sum, cnt, mine, sp = 0u;
    for (;;) {
        sum = 0u; cnt = 0u; mine = 0u;
#pragma unroll
        for (unsigned j = 0; j < 16; ++j) { const unsigned c = xb_ld(&bar[XB_XCNT(j)]); sum += c; cnt += (c > 0u) ? 1u : 0u; mine = (j == x) ? c : mine; }
        if (sum == G) break;
        __builtin_amdgcn_s_sleep(1);
        if ((++sp & 255u) == 0u) { if (xb_ld(&bar[XB_TMO])) break; if (sp > XB_SPIN_CAP) { atomicAdd(&bar[XB_TMO], 1u); break; } }
    }
    nloc = mine > 0u ? mine : 1u; nx = cnt > 0u ? cnt : 1u;
}

__device__ __forceinline__ void xcd_barrier(const XcdBarrier& b) {
    asm volatile("s_waitcnt vmcnt(0)" ::: "memory");
    __syncthreads();
    if (threadIdx.x == 0) {
        unsigned* bar = b.bar;
        __builtin_amdgcn_s_waitcnt(0);
        unsigned nloc = b.st[0], nx = b.st[1];
        if (nloc == 0u) { xcd_barrier_complete(bar, b.x, nloc, nx); b.st[0] = nloc; b.st[1] = nx; }
        const unsigned old = xb_add(&bar[XB_XSUB(b.x)], 1u);
        const unsigned gen = old / nloc;
        if (old + 1u == (gen + 1u) * nloc) {
            __builtin_amdgcn_fence(__ATOMIC_RELEASE, "agent");
            asm volatile("s_waitcnt vmcnt(0)" ::: "memory");
            const unsigned og = xb_add(&bar[XB_TOP], 1u);
            const unsigned tg = og / nx;
            if (og + 1u == (tg + 1u) * nx) xb_add(&bar[XB_TOPGEN], 1u);
            else XB_SPIN(xb_ld(&bar[XB_TOPGEN]) == tg, bar);
            __builtin_amdgcn_fence(__ATOMIC_ACQUIRE, "agent");
            xb_add(&bar[XB_XGEN(b.x)], 1u);
            asm volatile("s_waitcnt vmcnt(0)" ::: "memory");
        } else {
            XB_SPIN(xb_ld(&bar[XB_XGEN(b.x)]) == gen, bar);
            __builtin_amdgcn_fence(__ATOMIC_ACQUIRE, "agent");
            asm volatile("s_waitcnt vmcnt(0)" ::: "memory");
        }
    }
    __syncthreads();
}

#ifndef DBL_MASK
#define DBL_MASK 0
#endif
constexpr int NPHASE = 12;
__global__ void __launch_bounds__(512, 2) fwd_kernel(Args args) {
    extern __shared__ __attribute__((aligned(16))) unsigned char lds_raw[];
    LAS unsigned char* lds = (LAS unsigned char*)lds_raw;
    Frame F;
    F.tid = threadIdx.x; F.lane = F.tid & 63; F.wave = __builtin_amdgcn_readfirstlane(F.tid >> 6);
    F.G = gridDim.x; { const int bx = blockIdx.x; F.vcu = (F.G % 8 == 0) ? (bx % 8) * (F.G / 8) + bx / 8 : bx; }
    F.gw = F.vcu * 8 + F.wave; F.NGW = F.G * 8;
    unsigned char* ws = args.ws;
    const int lo = args.ph_lo, hi = args.ph_hi;
    volatile LAS unsigned* MISC = (volatile LAS unsigned*)(lds + LDS_BYTES - 64);
    if (F.tid < 16) MISC[F.tid] = 0u;
    __syncthreads();
    XcdBarrier bar = xcd_barrier_post((unsigned*)(ws + WS_CTL), MISC);
#define IN(k) (lo <= (k) && (k) < hi)
#define SEAM(k) do { if (IN(k) && IN((k) + 1)) xcd_barrier(bar); } while (0)

    if (IN(0)) for (int rep_ = 0; rep_ <= ((DBL_MASK >> 0) & 1); ++rep_) { if (rep_) xcd_barrier(bar); REFRESH_LANE(F); p0_prologue(F, args, lds); }
    SEAM(0);
    if (IN(1)) for (int rep_ = 0; rep_ <= ((DBL_MASK >> 1) & 1); ++rep_) { if (rep_) xcd_barrier(bar); REFRESH_LANE(F);
        { pg8::Gemm g{(const bf16*)(ws + WS_XN), (const bf16*)(ws + WS_WIN), MTOK, NZP, DM}; pg8::StaticOrder S; S.init(MTOK, NZP, F.G, (int)blockIdx.x);
          pg8::EpiZ E{(bf16*)(ws + WS_Z), (bf16*)(ws + WS_KSF), (bf16*)(ws + WS_VSF), (bf16*)(ws + WS_KWF), (bf16*)(ws + WS_VWF), (float*)(ws + WS_GATES), args.in[4]};
          pg8::gemm_phase<pg8::EpiZ, pg8::StaticOrder, true, true>(lds, g, S, E, F.wave); }
        { pg8::Gemm g{(const bf16*)(ws + WS_MEMN), (const bf16*)(ws + WS_WMK), NB * NMEM, DM, DM}; pg8::StaticOrder S; S.init(NB * NMEM, DM, F.G, ((int)blockIdx.x + 128) & 255);
          pg8::EpiStore E{(bf16*)(ws + WS_MEMK), DM, nullptr, 1};
          pg8::gemm_phase<pg8::EpiStore, pg8::StaticOrder, true, true>(lds, g, S, E, F.wave); }
        { pg8::Gemm g{(const bf16*)(ws + WS_WMV), (const bf16*)(ws + WS_MEMN), DM, NB * NMEM, DM}; pg8::StaticOrder S; S.init(DM, NB * NMEM, F.G, ((int)blockIdx.x + 120) & 255);
          pg8::EpiVFrag E{(bf16*)(ws + WS_MEMVT)};
          pg8::gemm_phase<pg8::EpiVFrag, pg8::StaticOrder, true, true>(lds, g, S, E, F.wave); }
    }
    SEAM(1);
    if (IN(2)) for (int rep_ = 0; rep_ <= ((DBL_MASK >> 2) & 1); ++rep_) { if (rep_) xcd_barrier(bar); REFRESH_LANE(F); for (int it = F.gw; it < 2048; it += F.NGW) kmax_item(F, args, it);
                 for (int it = F.vcu; it < 256; it += F.G) lru_local_item(F, args, lds, it);
                 for (int it = F.G - 1 - F.vcu; it < 128; it += F.G) compress_item(F, args, lds, it); }
    SEAM(2);
    if (IN(3)) for (int rep_ = 0; rep_ <= ((DBL_MASK >> 3) & 1); ++rep_) { if (rep_) xcd_barrier(bar); REFRESH_LANE(F);
                 { unsigned* ctl = (unsigned*)(ws + WS_CTL); const int own = (int)(((long)F.vcu * 8) / F.G) & 7; int qs = 0;
                   for (;;) { int id = -1;
                       if (lane_id() == 0) { while (qs < 8) { const int x = (own + qs) & 7; const unsigned c = __hip_atomic_fetch_add(ctl + CW_NQ + 64 * x, 1u, __ATOMIC_RELAXED, __HIP_MEMORY_SCOPE_AGENT);
                               if (c < 512u) { id = x * 512 + (int)c; break; } ++qs; } }
                       id = __builtin_amdgcn_readfirstlane(id); qs = __builtin_amdgcn_readfirstlane(qs);
                       if (id < 0) break;
                       const int x = id >> 9, i = id & 511; nsa_item(F, args, lds, x >> 2, (x >> 1) & 1, 2 * (63 - (i >> 3)) + (x & 1), 7 - (i & 7)); } }
                 __syncthreads(); REFRESH_LANE(F);
                 for (int it = F.vcu; it < 256; it += F.G) lru_fix_item(F, args, lds, it, false); }
    SEAM(3);
    if (IN(4)) for (int rep_ = 0; rep_ <= ((DBL_MASK >> 4) & 1); ++rep_) { if (rep_) xcd_barrier(bar); REFRESH_LANE(F);
        pg8::Gemm g{(const bf16*)(ws + WS_Y), (const bf16*)(ws + WS_WOUT), MTOK, DM, DM}; pg8::StaticOrder S; S.init(MTOK, DM, F.G, (int)blockIdx.x);
        pg8::EpiRes<true> E{args.in[0], nullptr, nullptr, (bf16*)(ws + WS_XN), (float*)(ws + WS_SSQ1), (const float*)(ws + WS_SSQN)};
        pg8::gemm_phase<pg8::EpiRes<true>, pg8::StaticOrder, true, true>(lds, g, S, E, F.wave);
    }
    SEAM(4);
    if (IN(5)) for (int rep_ = 0; rep_ <= ((DBL_MASK >> 5) & 1); ++rep_) { if (rep_) xcd_barrier(bar); REFRESH_LANE(F);
        pg8::Gemm g{(const bf16*)(ws + WS_XN), (const bf16*)(ws + WS_WMQ), MTOK, DM, DM}; pg8::StaticOrder S; S.init(MTOK, DM, F.G, (int)blockIdx.x);
        pg8::EpiStore E{(bf16*)(ws + WS_QM), DM, (const float*)(ws + WS_SSQ1), 1};
        pg8::gemm_phase<pg8::EpiStore, pg8::StaticOrder, true, true>(lds, g, S, E, F.wave);
    }
    SEAM(5);
    if (IN(6)) for (int rep_ = 0; rep_ <= ((DBL_MASK >> 6) & 1); ++rep_) { if (rep_) xcd_barrier(bar); REFRESH_LANE(F); for (int it = F.gw; it < 2048; it += F.NGW) memattn_item(F, args, it); }
    SEAM(6);
    if (IN(7)) for (int rep_ = 0; rep_ <= ((DBL_MASK >> 7) & 1); ++rep_) { if (rep_) xcd_barrier(bar); REFRESH_LANE(F);
        pg8::Gemm g{(const bf16*)(ws + WS_OM), (const bf16*)(ws + WS_WMO), MTOK, DM, DM}; pg8::StaticOrder S; S.init(MTOK, DM, F.G, (int)blockIdx.x);
        pg8::EpiRes<false> E{nullptr, (const bf16*)(ws + WS_XN), nullptr, (bf16*)(ws + WS_XN), (float*)(ws + WS_SSQ2), nullptr};
        pg8::gemm_phase<pg8::EpiRes<false>, pg8::StaticOrder, true, true>(lds, g, S, E, F.wave);
    }
    SEAM(7);
    if (IN(8)) for (int rep_ = 0; rep_ <= ((DBL_MASK >> 8) & 1); ++rep_) { if (rep_) xcd_barrier(bar); REFRESH_LANE(F);
        pg8::Gemm g{(const bf16*)(ws + WS_XN), (const bf16*)(ws + WS_WPQ), MTOK, 2048, DM}; pg8::StaticOrder S; S.init(MTOK, 2048, F.G, (int)blockIdx.x);
        pg8::EpiStore E{(bf16*)(ws + WS_QP), 2048, (const float*)(ws + WS_SSQ2), 1};
        pg8::gemm_phase<pg8::EpiStore, pg8::StaticOrder, true, true>(lds, g, S, E, F.wave);
    }
    SEAM(8);
    if (IN(9)) for (int rep_ = 0; rep_ <= ((DBL_MASK >> 9) & 1); ++rep_) { if (rep_) xcd_barrier(bar); REFRESH_LANE(F); for (int gi = F.vcu; gi < 256; gi += F.G) {
                     const int h = gi & 7, tgp = gi >> 3;
                     { const v4u* src = (const v4u*)((const bf16*)(ws + WS_SKEY) + (size_t)h * 8 * 4096); const int tid = F.wave * 64 + lane_id();
#pragma unroll
                       for (int i = 0; i < 8; ++i) ((LAS v4u*)lds)[tid + 512 * i] = src[tid + 512 * i]; }
                     __syncthreads();
                     peer_topk_item<true>(F, args, (tgp * 16 + F.wave) * 8 + h, lds); peer_topk_item<true>(F, args, (tgp * 16 + 8 + F.wave) * 8 + h, lds);
                     __syncthreads(); } }
    SEAM(9);
    if (IN(10)) {   REFRESH_LANE(F);
        LAS int* bc = (LAS int*)(lds + LDS_BYTES - 128); unsigned* ctl = (unsigned*)(ws + WS_CTL); const int own = (int)(bar.x & 7u);
        { int qs = 0; for (;;) { const int id = __builtin_amdgcn_readfirstlane(pq_pop(ctl, 0, own, qs, bc, F.wave)); if (id < 0) break; peer_u_chunk(F, args, id / PQ_NCHUNK, id % PQ_NCHUNK); } }
        xcd_barrier(bar);
        peer_w_rows(F, args);
        xcd_barrier(bar);
        { int qs = 0; for (;;) { const int id = __builtin_amdgcn_readfirstlane(pq_pop(ctl, 1, own, qs, bc, F.wave)); if (id < 0) break; peer_v_chunk(F, args, id / PQ_NCHUNK, id % PQ_NCHUNK); } }
        xcd_barrier(bar);
        peer_final_rows(F, args);
    }
#undef IN
#undef SEAM
}

extern "C" void kernel_launch(void* const* d_in, const int* in_sizes, int n_in, void* d_out, int out_size, void* d_ws, size_t ws_size, hipStream_t stream) {
    static int grid = 0;
    if (grid == 0) {
        if (n_in != 33 || out_size != MTOK * DM || ws_size < WS_END) { fprintf(stderr, "kernel_launch: unexpected problem (n_in %d, out %d, ws %zu)\n", n_in, out_size, ws_size); grid = -1; return; }
        int dev = 0, cus = 0, per_cu = 0;
        (void)hipGetDevice(&dev); (void)hipDeviceGetAttribute(&cus, hipDeviceAttributeMultiprocessorCount, dev);
        (void)hipFuncSetAttribute((const void*)fwd_kernel, hipFuncAttributeMaxDynamicSharedMemorySize, LDS_BYTES);
        (void)hipOccupancyMaxActiveBlocksPerMultiprocessor(&per_cu, (const void*)fwd_kernel, 512, LDS_BYTES);
        if (per_cu < 1) { fprintf(stderr, "kernel_launch: occupancy query says %d blocks per CU\n", per_cu); per_cu = 1; }
        grid = cus * 1;
        if (grid != 256) fprintf(stderr, "kernel_launch: %d CUs (built for 256)\n", cus);
    }
    if (grid < 0) return;
    (void)hipMemsetAsync((char*)d_ws + WS_CTL, 0, 65536, stream);
    Args a{};
    for (int i = 0; i < 33; ++i) a.in[i] = (const float*)d_in[i];
    a.out = (float*)d_out; a.ws = (unsigned char*)d_ws; a.ph_lo = 0; a.ph_hi = NPHASE;
    void* kargs[] = {&a};
    hipError_t e = hipLaunchCooperativeKernel((const void*)fwd_kernel, dim3(grid), dim3(512), kargs, LDS_BYTES, stream);
    if (e != hipSuccess) fprintf(stderr, "cooperative launch failed: %s (grid %d)\n", hipGetErrorString(e), grid);
}
```

```cpp
#include <hip/hip_runtime.h>
#include <cstdio>
#include <cstdint>

namespace pg8 {
#define PG8_LAS __attribute__((address_space(3)))
typedef unsigned short bf16_t;
typedef short bf16x8 __attribute__((ext_vector_type(8)));
typedef float f32x4 __attribute__((ext_vector_type(4)));
typedef unsigned u32x4 __attribute__((ext_vector_type(4)));
constexpr int BM = 256, BK = 64, HALF = 128, HTB = HALF * BK * 2  , STAGE_BYTES = 8 * HTB, NXCD = 8, WGM = 8;

__host__ __device__ __forceinline__ int lds_byte(int r, int c) { const int st = (r >> 4) * 2 + (c >> 5), rr = r & 15, cc = c & 31, ob = rr * 64 + cc * 2; return st * 1024 + (ob ^ (((ob >> 9) & 1) << 5)); }
__host__ __device__ __forceinline__ void stage_rc(int b, int& R, int& C) { const int st = b / 1024, sb = b % 1024, swz = sb ^ (((sb >> 9) & 1) << 5); R = (st >> 1) * 16 + swz / 64; C = (st & 1) * 32 + (swz % 64) / 2; }
__host__ __device__ __forceinline__ int perm32(int rho) { const int n = rho >> 4, i = rho & 15; return 8 * (i >> 2) + 4 * n + (i & 3); }

struct Unit { int pm, pn; };
struct Gemm { const bf16_t* A; const bf16_t* Bt; int M, N, K; };

struct StaticOrder {
    int nM, nN, nwg, G, c;
    __host__ __device__ void init(int M, int N, int G_, int c_) { nM = M / BM; nN = N / BM; nwg = nM * nN; G = G_; c = c_; }
    __host__ __device__ bool next(int i, Unit& u) const {
        const long L = (long)i * G + c; if (L >= nwg) return false;
        int wgid = (int)L; { const int q = nwg / NXCD, r = nwg % NXCD, xcd = wgid % NXCD, off = wgid / NXCD; wgid = (xcd < r ? xcd * (q + 1) : r * (q + 1) + (xcd - r) * q) + off; }
        const int nig = WGM * nN, gid = wgid / nig, fm = gid * WGM, gsz = (nM - fm) < WGM ? (nM - fm) : WGM;
        u.pm = fm + ((wgid % nig) % gsz); u.pn = (wgid % nig) / gsz; return true;
    }
    __device__ __forceinline__ void a_ready(const Unit&) const {}
    __device__ __forceinline__ void done(const Unit&) const {}
};

__device__ __forceinline__ unsigned cvt_pk_bf16(float lo, float hi) { unsigned r; asm volatile("v_cvt_pk_bf16_f32 %0, %1, %2" : "=v"(r) : "v"(lo), "v"(hi)); return r; }
typedef float f32x2 __attribute__((ext_vector_type(2)));
typedef unsigned u32x2 __attribute__((ext_vector_type(2)));
__device__ __forceinline__ unsigned short f2bf1(float f) { unsigned u = __builtin_bit_cast(unsigned, f); return (unsigned short)((u + 0x7fffu + ((u >> 16) & 1u)) >> 16); }
struct EpiZ {
    static constexpr bool PERM = true, AFTER_DRAIN = false, MIDSCALE = false;
    bf16_t* Z; bf16_t* KSF; bf16_t* VSF; bf16_t* KWF; bf16_t* VWF; float* GATES; const float* bgate;
    __device__ __forceinline__ void operator()(const f32x4 (&acc)[2][2][4][2], const Unit& u, int wr, int wc, int fr, int fq) const {
        const int row0 = u.pm * BM + wr * 64 + fr;
        if (u.pn < 9) {
            const int col0 = u.pn * BM + wc * 32 + 8 * fq;
#pragma unroll
            for (int ai = 0; ai < 2; ++ai)
#pragma unroll
                for (int m = 0; m < 4; ++m) { bf16_t* rowp = Z + (size_t)(row0 + ai * HALF + m * 16) * 2304 + col0;
#pragma unroll
                    for (int bj = 0; bj < 2; ++bj) { const f32x4 v0 = acc[ai][bj][m][0], v1 = acc[ai][bj][m][1];
                        u32x4 w; w.x = cvt_pk_bf16(v0[0], v0[1]); w.y = cvt_pk_bf16(v0[2], v0[3]); w.z = cvt_pk_bf16(v1[0], v1[1]); w.w = cvt_pk_bf16(v1[2], v1[3]);
                        *(u32x4*)(rowp + bj * HALF) = w; } }
            if (u.pn >= 7) {
                bf16_t* KF = (u.pn == 7) ? KSF : KWF; bf16_t* VF = (u.pn == 7) ? VSF : VWF;
                const int kvh = wc >> 1, dbase = 32 * (wc & 1) + 8 * fq;
#pragma unroll
                for (int ai = 0; ai < 2; ++ai)
#pragma unroll
                    for (int m = 0; m < 4; ++m) { const int row = row0 + ai * HALF + m * 16, b = row >> 13, s = row & 8191, tile = s >> 5, k = s & 31;
                        const size_t tb = ((size_t)(b * 2 + kvh) * 256 + tile) * 2048;
                        { const f32x4 v0 = acc[ai][0][m][0], v1 = acc[ai][0][m][1];
                          u32x4 w; w.x = cvt_pk_bf16(v0[0], v0[1]); w.y = cvt_pk_bf16(v0[2], v0[3]); w.z = cvt_pk_bf16(v1[0], v1[1]); w.w = cvt_pk_bf16(v1[2], v1[3]);
                          *(u32x4*)(KF + tb + (dbase >> 4) * 512 + ((dbase >> 3) & 1) * 256 + k * 8) = w; }
                        const int kk = k & 15, vo = ((kk >> 2) & 1) * 512 + (k >> 4) * 8 + (kk & 3) + 4 * (kk >> 3);
                        unsigned char* V8 = (unsigned char*)VF + ((size_t)(b * 2 + kvh) * 256 + tile) * 2048;
#pragma unroll
                        for (int n = 0; n < 2; ++n) { const f32x4 v = acc[ai][1][m][n]; int w = 0; w = __builtin_amdgcn_cvt_pk_fp8_f32(v[0], v[1], w, false); w = __builtin_amdgcn_cvt_pk_fp8_f32(v[2], v[3], w, true);
#pragma unroll
                            for (int e = 0; e < 4; ++e) { const int d = dbase + 4 * n + e; V8[(d >> 5) * 1024 + (d & 31) * 16 + vo] = (unsigned char)((unsigned)w >> (8 * e)); } }
                        asm volatile("" ::: "memory"); }
            }
        } else {
            if (wc == 0 && fq < 3) {
#pragma unroll
                for (int ai = 0; ai < 2; ++ai)
#pragma unroll
                    for (int m = 0; m < 4; ++m) { const int row = row0 + ai * HALF + m * 16;
#pragma unroll
                        for (int n = 0; n < 2; ++n)
#pragma unroll
                            for (int e = 0; e < 4; ++e) { const int c = 8 * fq + 4 * n + e; const float v = acc[ai][0][m][n][e] + bgate[c]; GATES[(size_t)row * 24 + c] = 1.0f / (1.0f + __expf(-v)); } }
            }
        }
    }
};
struct EpiStore {
    static constexpr bool PERM = true, AFTER_DRAIN = false, MIDSCALE = false;
    bf16_t* O; int ldc; const float* ssq; int frag;
    __device__ __forceinline__ void operator()(const f32x4 (&acc)[2][2][4][2], const Unit& u, int wr, int wc, int fr, int fq) const {
        const int row0 = u.pm * BM + wr * 64 + fr; const int col0 = u.pn * BM + wc * 32 + 8 * fq;
#pragma unroll
        for (int ai = 0; ai < 2; ++ai)
#pragma unroll
            for (int m = 0; m < 4; ++m) { const int row = row0 + ai * HALF + m * 16;
                bf16_t* rowp = frag ? O + (size_t)(row >> 5) * 32 * ldc + (size_t)(col0 >> 4) * 512 + ((col0 >> 3) & 1) * 256 + (row & 31) * 8 : O + (size_t)row * ldc + col0;
                const int bjstep = frag ? (HALF >> 4) * 512 : HALF;
                float sc = 1.f;
                if (ssq) { const f32x4* p = (const f32x4*)(ssq + (size_t)row * 16); const f32x4 a = p[0], b = p[1], c = p[2], d = p[3];
                    const float s = ((a[0] + a[1]) + (a[2] + a[3])) + ((b[0] + b[1]) + (b[2] + b[3])) + ((c[0] + c[1]) + (c[2] + c[3])) + ((d[0] + d[1]) + (d[2] + d[3]));
                    sc = rsqrtf(s * (1.0f / 1024.0f) + 1e-6f); }
#pragma unroll
                for (int bj = 0; bj < 2; ++bj) { const f32x4 v0 = acc[ai][bj][m][0] * sc, v1 = acc[ai][bj][m][1] * sc;
                    u32x4 w; w.x = cvt_pk_bf16(v0[0], v0[1]); w.y = cvt_pk_bf16(v0[2], v0[3]); w.z = cvt_pk_bf16(v1[0], v1[1]); w.w = cvt_pk_bf16(v1[2], v1[3]);
                    *(u32x4*)(rowp + bj * bjstep) = w; } }
    }
};
struct EpiVFrag {
    static constexpr bool PERM = true, AFTER_DRAIN = false, MIDSCALE = false;
    bf16_t* O;
    __device__ __forceinline__ void operator()(const f32x4 (&acc)[2][2][4][2], const Unit& u, int wr, int wc, int fr, int fq) const {
        const int row0 = u.pm * BM + wr * 64 + fr; const int col0 = u.pn * BM + wc * 32 + 8 * fq;
#pragma unroll
        for (int ai = 0; ai < 2; ++ai)
#pragma unroll
            for (int m = 0; m < 4; ++m) { const int D = row0 + ai * HALF + m * 16, h = D >> 8, dt = (D >> 5) & 7, r = D & 31;
#pragma unroll
                for (int bj = 0; bj < 2; ++bj) { const int K0 = col0 + bj * HALF, b = K0 >> 8, kt = (K0 >> 5) & 7, k0 = K0 & 31;
                    bf16_t* p = O + (size_t)((b * 4 + h) * 8 + kt) * 8192 + dt * 1024 + (k0 >> 4) * 512 + r * 8 + 4 * ((k0 >> 3) & 1);
                    const f32x4 v0 = acc[ai][bj][m][0], v1 = acc[ai][bj][m][1];
                    u32x2 w0, w1; w0.x = cvt_pk_bf16(v0[0], v0[1]); w0.y = cvt_pk_bf16(v0[2], v0[3]); w1.x = cvt_pk_bf16(v1[0], v1[1]); w1.y = cvt_pk_bf16(v1[2], v1[3]);
                    *(u32x2*)p = w0; *(u32x2*)(p + 256) = w1; } }
    }
};
template <bool MID> struct EpiRes {
    static constexpr bool PERM = false, AFTER_DRAIN = false, MIDSCALE = MID;
    const float* base; const bf16_t* base16; float* out; bf16_t* XB; float* ssq; const float* ssqn;
    __device__ __forceinline__ void midscale(f32x4 (&acc)[2][2][4][2], const Unit& u, int wr, int wc, int fr, int fq) const {
        const int row0 = u.pm * BM + wr * 64 + fr;
#pragma unroll
        for (int ai = 0; ai < 2; ++ai)
#pragma unroll
            for (int m = 0; m < 4; ++m) { const int row = row0 + ai * HALF + m * 16; const f32x2 sq = *(const f32x2*)(ssqn + (size_t)row * 2);
                const float sc = rsqrtf((sq[0] + sq[1]) * (1.0f / 512.0f) + 1e-6f);
#pragma unroll
                for (int bj = 0; bj < 2; ++bj)
#pragma unroll
                    for (int n = 0; n < 2; ++n) acc[ai][bj][m][n] = acc[ai][bj][m][n] * sc; }
    }
    __device__ __forceinline__ void operator()(const f32x4 (&acc)[2][2][4][2], const Unit& u, int wr, int wc, int fr, int fq) const {
        const int row0 = u.pm * BM + wr * 64 + fr; const int col0 = u.pn * BM + wc * 32 + 4 * fq;
#pragma unroll
        for (int ai = 0; ai < 2; ++ai)
#pragma unroll
            for (int m = 0; m < 4; ++m) { const int row = row0 + ai * HALF + m * 16; const size_t off = (size_t)row * 1024 + col0; float s = 0.f;
#pragma unroll
                for (int bj = 0; bj < 2; ++bj)
#pragma unroll
                    for (int n = 0; n < 2; ++n) { f32x4 b;
                        if (base) b = *(const f32x4*)(base + off + bj * HALF + n * 16);
                        else { const u32x2 w = *(const u32x2*)(base16 + off + bj * HALF + n * 16); b[0] = __builtin_bit_cast(float, w.x << 16); b[1] = __builtin_bit_cast(float, w.x & 0xffff0000u); b[2] = __builtin_bit_cast(float, w.y << 16); b[3] = __builtin_bit_cast(float, w.y & 0xffff0000u); }
                        const f32x4 v = b + acc[ai][bj][m][n];
                        if (out) *(f32x4*)(out + off + bj * HALF + n * 16) = v;
                        s += (v[0] * v[0] + v[1] * v[1]) + (v[2] * v[2] + v[3] * v[3]);
                        u32x2 w; w.x = cvt_pk_bf16(v[0], v[1]); w.y = cvt_pk_bf16(v[2], v[3]); *(u32x2*)(XB + off + bj * HALF + n * 16) = w; }
                s += __shfl_xor(s, 16); s += __shfl_xor(s, 32);
                if (fq == 0) ssq[(size_t)row * 16 + u.pn * 4 + wc] = s;
                asm volatile("" ::: "memory"); }
    }
};
template <class Epi, class Sched, bool ALIGN_EPI = false, bool SP2 = false>
__device__ __forceinline__ void gemm_phase(PG8_LAS unsigned char* lds, const Gemm g, const Sched& S, const Epi& E, int wave  ) {
    int lane; asm volatile("v_mbcnt_lo_u32_b32 %0, -1, 0\n\tv_mbcnt_hi_u32_b32 %0, -1, %0" : "=v"(lane));
    const int wid = wave, tid = wid * 64 + lane, wr = wid >> 2, wc = wid & 3, fr = lane & 15, fq = lane >> 4;
    const int K = g.K, nt = K / BK;
    unsigned voffA[2], voffB[2];
#pragma unroll
    for (int i = 0; i < 2; ++i) { int R, C; stage_rc(tid * 16 + i * 8192, R, C); const int Rb = Epi::PERM ? ((R & ~31) + perm32(R & 31)) : R;
        voffA[i] = (unsigned)(R * K + C) * 2u; voffB[i] = (unsigned)(Rb * K + C) * 2u; }
    const size_t kstep = (size_t)(BK * 2);
    const size_t hstep = (size_t)HALF * K * 2;
    const size_t tstep = 2 * hstep;
    const unsigned ldsw = (unsigned)wid * 1024u;
    const int aoff = lds_byte(wr * 64 + fr, fq * 8), boff = lds_byte(wc * 32 + fr, fq * 8);
#define PG8_SA(b, h) (((b) * 2 + (h)) * HTB)
#define PG8_SB(b, h) ((4 + (b) * 2 + (h)) * HTB)
#define PG8_STAGE(bufoff, gbase, voff) do { _Pragma("unroll") for (int _i = 0; _i < 2; ++_i) \
        __builtin_amdgcn_global_load_lds((const unsigned*)((const char*)(gbase) + (voff)[_i]), (PG8_LAS unsigned*)(lds + (bufoff) + ldsw + _i * 8192), 16, 0, 0); } while (0)
#define PG8_LDA(dst, b, h) do { _Pragma("unroll") for (int m = 0; m < 4; ++m) _Pragma("unroll") for (int k = 0; k < 2; ++k) dst[m][k] = *(const PG8_LAS bf16x8*)(lds + PG8_SA(b, h) + aoff + m * 2048 + k * 1024); } while (0)
#define PG8_LDB(dst, b, h) do { _Pragma("unroll") for (int n = 0; n < 2; ++n) _Pragma("unroll") for (int k = 0; k < 2; ++k) dst[n][k] = *(const PG8_LAS bf16x8*)(lds + PG8_SB(b, h) + boff + n * 2048 + k * 1024); } while (0)
#define PG8_MMA(ai, bj, At, Bt) do { __builtin_amdgcn_s_setprio(1); _Pragma("unroll") for (int m = 0; m < 4; ++m) _Pragma("unroll") for (int n = 0; n < 2; ++n) _Pragma("unroll") for (int k = 0; k < 2; ++k) \
        acc[ai][bj][m][n] = __builtin_amdgcn_mfma_f32_16x16x32_bf16(Bt[n][k], At[m][k], acc[ai][bj][m][n], 0, 0, 0); __builtin_amdgcn_s_setprio(0); } while (0)
#define PG8_WAIT_V(n) asm volatile("s_waitcnt vmcnt(" #n ")" ::: "memory")
#define PG8_WAIT_L(n) asm volatile("s_waitcnt lgkmcnt(" #n ")" ::: "memory")
#define PG8_BAR __builtin_amdgcn_s_barrier()
#define PG8_SCHED __builtin_amdgcn_sched_barrier(0)
    Unit cur, nxt; int ui = 0;
    if (!S.next(0, cur)) return;
    f32x4 acc[2][2][4][2];
#pragma unroll
    for (int a = 0; a < 2; ++a)
#pragma unroll
        for (int b = 0; b < 2; ++b)
#pragma unroll
            for (int m = 0; m < 4; ++m)
#pragma unroll
                for (int n = 0; n < 2; ++n) acc[a][b][m][n] = (f32x4){0.f, 0.f, 0.f, 0.f};
    bf16x8 At[4][2], B0[2][2], B1[2][2];
    const char* cA = (const char*)g.A + (size_t)cur.pm * tstep; const char* cB = (const char*)g.Bt + (size_t)cur.pn * tstep;
    S.a_ready(cur);
    if constexpr (SP2) {
        PG8_STAGE(PG8_SB(0, 0), cB, voffB); PG8_STAGE(PG8_SB(0, 1), cB + hstep, voffB); PG8_STAGE(PG8_SA(0, 0), cA, voffA); PG8_STAGE(PG8_SA(0, 1), cA + hstep, voffA);
        if (wr == 1) PG8_BAR;
        PG8_WAIT_V(2); PG8_BAR;
        PG8_STAGE(PG8_SB(1, 0), cB + kstep, voffB); PG8_STAGE(PG8_SA(1, 0), cA + kstep, voffA); PG8_STAGE(PG8_SB(1, 1), cB + hstep + kstep, voffB);
        PG8_WAIT_V(6); PG8_BAR;
    } else {
        PG8_STAGE(PG8_SB(0, 0), cB, voffB); PG8_STAGE(PG8_SA(0, 0), cA, voffA); PG8_STAGE(PG8_SB(0, 1), cB + hstep, voffB); PG8_STAGE(PG8_SA(0, 1), cA + hstep, voffA);
        if (wr == 1) PG8_BAR;
        PG8_WAIT_V(4); PG8_BAR;
        PG8_STAGE(PG8_SB(1, 0), cB + kstep, voffB); PG8_STAGE(PG8_SA(1, 0), cA + kstep, voffA); PG8_STAGE(PG8_SB(1, 1), cB + hstep + kstep, voffB);
        PG8_WAIT_V(6); PG8_BAR;
    }
    for (;;) {
        const bool has_next = S.next(ui + 1, nxt);
        const char* nA = has_next ? (const char*)g.A + (size_t)nxt.pm * tstep : cA; const char* nB = has_next ? (const char*)g.Bt + (size_t)nxt.pn * tstep : cB;
        for (int t = 0; t < nt; t += 2) {
            if constexpr (Epi::MIDSCALE) { if (t == nt / 2) E.midscale(acc, cur, wr, wc, fr, fq); }
            const bool last = (t == nt - 2);
            const char* a1 = cA + (size_t)(t + 1) * kstep;
            const char* a2 = last ? nA : cA + (size_t)(t + 2) * kstep; const char* b2 = last ? nB : cB + (size_t)(t + 2) * kstep;
            const char* a3 = a2 + kstep; const char* b3 = b2 + kstep;
            if (last && has_next) S.a_ready(nxt);
            if constexpr (SP2) {
            PG8_LDB(B0, 0, 0); PG8_LDB(B1, 0, 1); PG8_SCHED; PG8_LDA(At, 0, 0); PG8_STAGE(PG8_SA(1, 1), a1 + hstep, voffA);
            PG8_WAIT_V(8); PG8_WAIT_L(0); PG8_BAR; PG8_MMA(0, 0, At, B0); PG8_MMA(0, 1, At, B1); PG8_BAR; PG8_SCHED;
            PG8_LDA(At, 0, 1); PG8_STAGE(PG8_SB(0, 0), b2, voffB); PG8_STAGE(PG8_SB(0, 1), b2 + hstep, voffB); PG8_STAGE(PG8_SA(0, 0), a2, voffA);
            PG8_WAIT_V(8); PG8_WAIT_L(0); PG8_BAR; PG8_MMA(1, 0, At, B0); PG8_MMA(1, 1, At, B1); PG8_BAR; PG8_SCHED;
            PG8_LDB(B0, 1, 0); PG8_LDB(B1, 1, 1); PG8_SCHED; PG8_LDA(At, 1, 0); PG8_STAGE(PG8_SA(0, 1), a2 + hstep, voffA);
            PG8_WAIT_V(8); PG8_WAIT_L(0); PG8_BAR; PG8_MMA(0, 0, At, B0); PG8_MMA(0, 1, At, B1); PG8_BAR; PG8_SCHED;
            PG8_LDA(At, 1, 1); PG8_STAGE(PG8_SB(1, 0), b3, voffB); PG8_STAGE(PG8_SB(1, 1), b3 + hstep, voffB); PG8_STAGE(PG8_SA(1, 0), a3, voffA);
            PG8_WAIT_V(8); PG8_WAIT_L(0); PG8_BAR; PG8_MMA(1, 0, At, B0); PG8_MMA(1, 1, At, B1); PG8_BAR; PG8_SCHED;
            } else {
            PG8_LDB(B0, 0, 0); PG8_SCHED; PG8_LDA(At, 0, 0); PG8_STAGE(PG8_SA(1, 1), a1 + hstep, voffA);
            PG8_WAIT_L(8); PG8_BAR; PG8_WAIT_L(0); PG8_MMA(0, 0, At, B0); PG8_BAR; PG8_SCHED;
            PG8_LDB(B1, 0, 1); PG8_STAGE(PG8_SB(0, 0), b2, voffB);
            PG8_BAR; PG8_WAIT_L(0); PG8_MMA(0, 1, At, B1); PG8_BAR;
            PG8_LDA(At, 0, 1); PG8_STAGE(PG8_SA(0, 0), a2, voffA);
            PG8_BAR; PG8_WAIT_L(0); PG8_MMA(1, 0, At, B0); PG8_BAR; PG8_SCHED;
            PG8_STAGE(PG8_SB(0, 1), b2 + hstep, voffB);
            PG8_WAIT_V(6); PG8_BAR; PG8_MMA(1, 1, At, B1); PG8_BAR;
            PG8_LDB(B0, 1, 0); PG8_SCHED; PG8_LDA(At, 1, 0); PG8_STAGE(PG8_SA(0, 1), a2 + hstep, voffA);
            PG8_WAIT_L(8); PG8_BAR; PG8_WAIT_L(0); PG8_MMA(0, 0, At, B0); PG8_BAR; PG8_SCHED;
            PG8_LDB(B1, 1, 1); PG8_STAGE(PG8_SB(1, 0), b3, voffB);
            PG8_BAR; PG8_WAIT_L(0); PG8_MMA(0, 1, At, B1); PG8_BAR;
            PG8_LDA(At, 1, 1); PG8_STAGE(PG8_SA(1, 0), a3, voffA);
            PG8_BAR; PG8_WAIT_L(0); PG8_MMA(1, 0, At, B0); PG8_BAR; PG8_SCHED;
            PG8_STAGE(PG8_SB(1, 1), b3 + hstep, voffB);
            PG8_WAIT_V(6); PG8_BAR; PG8_MMA(1, 1, At, B1); PG8_BAR;
            }
        }
        if constexpr (ALIGN_EPI) { if (wr == 0) PG8_BAR; }
        if constexpr (!Epi::AFTER_DRAIN) { E(acc, cur, wr, wc, fr, fq); S.done(cur); }
        if (!has_next) break;
#pragma unroll
        for (int a = 0; a < 2; ++a)
#pragma unroll
            for (int b = 0; b < 2; ++b)
#pragma unroll
                for (int m = 0; m < 4; ++m)
#pragma unroll
                    for (int n = 0; n < 2; ++n) acc[a][b][m][n] = (f32x4){0.f, 0.f, 0.f, 0.f};
        cur = nxt; cA = nA; cB = nB; ++ui;
        if constexpr (ALIGN_EPI) { if (wr == 1) PG8_BAR; }
    }
    PG8_WAIT_V(0);
    if constexpr (!ALIGN_EPI) { if (wr == 0) PG8_BAR; }
    PG8_BAR;
    if constexpr (Epi::AFTER_DRAIN) { E.fused(acc, cur, wr, wc, fr, fq, lds, wid, lane); S.done(cur); }
#undef PG8_SA
#undef PG8_SB
#undef PG8_STAGE
#undef PG8_LDA
#undef PG8_LDB
#undef PG8_MMA
#undef PG8_WAIT_V
#undef PG8_WAIT_L
#undef PG8_BAR
#undef PG8_SCHED
}
}

constexpr int NB = 2, SEQ = 8192, DM = 1024, MTOK = NB * SEQ;
constexpr int NZ = 2304, NZP = 2560;
constexpr int NMEM = 256;
constexpr float EPS = 1e-6f;
constexpr float QSCALE = 0.125f * 1.4426950408889634f;
constexpr int ZC_XL = 0, ZC_GT = 512, ZC_Q = 1024, ZC_KC = 1536, ZC_VC = 1664, ZC_KS = 1792, ZC_VS = 1920, ZC_KW = 2048, ZC_VW = 2176, ZC_G = 2304;

constexpr size_t MiB = 1u << 20;
constexpr size_t WS_CTL = 0;
constexpr size_t WS_WIN = 1 * MiB, WS_WOUT = 6 * MiB, WS_WMQ = 8 * MiB, WS_WMK = 10 * MiB, WS_WMV = 12 * MiB, WS_WMO = 14 * MiB, WS_WPQ = 16 * MiB;
constexpr size_t WS_SKEY = 20 * MiB;
constexpr size_t WS_CW1T = WS_SKEY + 512 * 1024;
constexpr size_t WS_CW2T = WS_CW1T + 512 * 1024;
constexpr size_t WS_C1 = WS_CW2T + 16 * 1024;
constexpr size_t WS_WRGT = WS_C1 + 16 * 1024;
constexpr size_t WS_MEMN = 22 * MiB, WS_MEMK = 23 * MiB, WS_MEMVT = 24 * MiB;
constexpr size_t WS_KC = 26 * MiB;
constexpr size_t WS_VCT = WS_KC + 256 * 1024;
constexpr size_t WS_SUMM = 27 * MiB;
constexpr size_t WS_SSQ1 = 28 * MiB, WS_SSQ2 = 29 * MiB;
constexpr size_t WS_GATES = 30 * MiB;
constexpr size_t WS_SSQN = 31 * MiB + 512 * 1024;
constexpr size_t WS_U8 = 32 * MiB, WS_V8 = 48 * MiB;
constexpr size_t WS_SU = 64 * MiB, WS_SV = 64 * MiB + 65536;
constexpr size_t WS_SSQ3 = 65 * MiB;
constexpr size_t WS_W = 66 * MiB;
constexpr size_t WS_PART = 128 * MiB;
constexpr size_t WS_XN = 96 * MiB;
constexpr size_t WS_Z = 128 * MiB;
constexpr size_t WS_KSF = 240 * MiB, WS_VSF = 244 * MiB, WS_KWF = 248 * MiB, WS_VWF = 252 * MiB;
constexpr size_t WS_QM = 128 * MiB, WS_OM = 160 * MiB;
constexpr size_t WS_QP = 128 * MiB;
constexpr size_t WS_Y = 208 * MiB;
constexpr size_t WS_EID = 208 * MiB, WS_GW = 216 * MiB;
constexpr size_t WS_END = 256 * MiB;

constexpr int CW_KMAX = 12288;
constexpr int LDS_BYTES = 147456;

#define GAS __attribute__((address_space(1)))
#define LAS __attribute__((address_space(3)))
typedef unsigned short bf16;
typedef unsigned v4u __attribute__((ext_vector_type(4)));
typedef unsigned v2u __attribute__((ext_vector_type(2)));
typedef float f32x4 __attribute__((ext_vector_type(4)));
typedef float f32x16 __attribute__((ext_vector_type(16)));
typedef short bf16x8 __attribute__((ext_vector_type(8)));
typedef short bf16x4 __attribute__((ext_vector_type(4)));
__device__ __forceinline__ unsigned f2bf(float f) { unsigned u = __builtin_bit_cast(unsigned, f); return (u + 0x7fffu + ((u >> 16) & 1u)) >> 16; }
typedef float f32x2_ __attribute__((ext_vector_type(2))); typedef __bf16 bf16x2_ __attribute__((ext_vector_type(2)));
__device__ __forceinline__ unsigned pk2(float lo, float hi) { f32x2_ v = {lo, hi}; bf16x2_ b = __builtin_convertvector(v, bf16x2_); return __builtin_bit_cast(unsigned, b); }
__device__ __forceinline__ float bf2f(unsigned short h) { return __builtin_bit_cast(float, (unsigned)h << 16); }
__device__ __forceinline__ float bflo(unsigned w) { return __builtin_bit_cast(float, w << 16); }
__device__ __forceinline__ float bfhi(unsigned w) { return __builtin_bit_cast(float, w & 0xffff0000u); }
__device__ __forceinline__ void swap32(unsigned& a, unsigned& b) { asm("s_nop 1\n\tv_permlane32_swap_b32 %0, %1" : "+v"(a), "+v"(b)); }
__device__ __forceinline__ int maxswap32_i(int v) { unsigned a = (unsigned)v, b = (unsigned)v; swap32(a, b); return max((int)a, (int)b); }
__device__ __forceinline__ float maxswap32_f(float v) { unsigned a = __builtin_bit_cast(unsigned, v), b = a; swap32(a, b); return fmaxf(__builtin_bit_cast(float, a), __builtin_bit_cast(float, b)); }
__device__ __forceinline__ float addswap32_f(float v) { unsigned a = __builtin_bit_cast(unsigned, v), b = a; swap32(a, b); return __builtin_bit_cast(float, a) + __builtin_bit_cast(float, b); }
__device__ __forceinline__ float wave_sum(float v) {
#pragma unroll
    for (int o = 1; o < 64; o <<= 1) v += __shfl_xor(v, o);
    return v;
}

struct Args { const float* in[33]; float* out; unsigned char* ws; int ph_lo, ph_hi; };

struct Frame {
    int tid, lane, wave, vcu, G, gw, NGW;
};
__device__ __forceinline__ int lane_id() { int l; asm volatile("v_mbcnt_lo_u32_b32 %0, -1, 0\n\tv_mbcnt_hi_u32_b32 %0, -1, %0" : "=v"(l)); return l; }
#define REFRESH_LANE(F) do { (F).lane = lane_id(); (F).tid = (F).wave * 64 + (F).lane; } while (0)

__device__ __forceinline__ void transpose_item(const float* W, int K, int N, bf16* WT, int ldt, int row_off, const float* gain, int slo, int shi, float cs, LAS float* scr, int item, int lane, int kxor = 0) {
    const int nblk = (N + 31) / 32, kb = item / nblk, nb = item % nblk, k0 = 64 * kb, n0 = 32 * nb;
#pragma unroll 16
    for (int i = 0; i < 32; ++i) { const int kk = 2 * i + (lane >> 5), n = n0 + (lane & 31);
        float v = (n < N) ? W[(size_t)(k0 + kk) * N + n] : 0.f; if (gain) v *= gain[k0 + kk]; if (n >= slo && n < shi) v *= cs;
        scr[kk * 33 + (lane & 31)] = v; }
    asm volatile("s_waitcnt lgkmcnt(0)" ::: "memory");
    const int c = lane & 7;
#pragma unroll
    for (int j = 0; j < 4; ++j) { const int n = (lane >> 3) + 8 * j; const LAS float* s = scr + (8 * c) * 33 + n;
        v4u o; o.x = pk2(s[0 * 33], s[1 * 33]); o.y = pk2(s[2 * 33], s[3 * 33]); o.z = pk2(s[4 * 33], s[5 * 33]); o.w = pk2(s[6 * 33], s[7 * 33]);
        *(v4u*)(WT + (size_t)(row_off + n0 + n) * ldt + (k0 ^ kxor) + 8 * c) = o; }
    asm volatile("s_waitcnt lgkmcnt(0)" ::: "memory");
}
__device__ __forceinline__ void rms_row_to_bf16(const float* xrow, bf16* orow, int lane) {
    const f32x4* xr = (const f32x4*)xrow + lane;
    f32x4 v[4]; float s = 0.f;
#pragma unroll
    for (int j = 0; j < 4; ++j) { v[j] = xr[64 * j]; s += (v[j].x * v[j].x + v[j].y * v[j].y) + (v[j].z * v[j].z + v[j].w * v[j].w); }
    const float rstd = rsqrtf(wave_sum(s) * (1.f / DM) + EPS);
    unsigned long long* o8 = (unsigned long long*)orow + lane;
#pragma unroll
    for (int j = 0; j < 4; ++j) o8[64 * j] = (unsigned long long)pk2(v[j].x * rstd, v[j].y * rstd) | ((unsigned long long)pk2(v[j].z * rstd, v[j].w * rstd) << 32);
}
__device__ __forceinline__ void quant_row_fp8(const float* src, const float* gain, unsigned char* dst, float* scale_out, int lane) {
    const f32x4* p = (const f32x4*)src + 4 * lane; f32x4 v[4]; float am = 0.f;
#pragma unroll
    for (int j = 0; j < 4; ++j) { v[j] = p[j]; if (gain) v[j] = v[j] * ((const f32x4*)gain)[4 * lane + j]; am = fmaxf(am, fmaxf(fmaxf(fabsf(v[j].x), fabsf(v[j].y)), fmaxf(fabsf(v[j].z), fabsf(v[j].w)))); }
#pragma unroll
    for (int o = 1; o < 64; o <<= 1) am = fmaxf(am, __shfl_xor(am, o));
    const float inv = am > 0.f ? 448.0f / am : 0.f;
    v4u o4;
#pragma unroll
    for (int j = 0; j < 4; ++j) { int w = 0; w = __builtin_amdgcn_cvt_pk_fp8_f32(v[j].x * inv, v[j].y * inv, w, false); w = __builtin_amdgcn_cvt_pk_fp8_f32(v[j].z * inv, v[j].w * inv, w, true); o4[j] = (unsigned)w; }
    *(v4u*)(dst + (size_t)(lane >> 3) * 16384 * 128 + (lane & 7) * 16) = o4;
    if (lane == 0) *scale_out = am * (1.0f / 448.0f);
}
__device__ __forceinline__ void rms_rows4_to_bf16(const float* x0, bf16* o0, size_t rstride  , int lane) {
    f32x4 v[4][4]; float s[4];
#pragma unroll
    for (int r = 0; r < 4; ++r)
#pragma unroll
        for (int j = 0; j < 4; ++j) v[r][j] = __builtin_nontemporal_load((const f32x4*)(x0 + r * rstride) + lane + 64 * j);
#pragma unroll
    for (int r = 0; r < 4; ++r) { s[r] = 0.f;
#pragma unroll
        for (int j = 0; j < 4; ++j) s[r] += (v[r][j].x * v[r][j].x + v[r][j].y * v[r][j].y) + (v[r][j].z * v[r][j].z + v[r][j].w * v[r][j].w); }
#pragma unroll
    for (int o = 1; o < 64; o <<= 1)
#pragma unroll
        for (int r = 0; r < 4; ++r) s[r] += __shfl_xor(s[r], o);
#pragma unroll
    for (int r = 0; r < 4; ++r) { const float rstd = rsqrtf(s[r] * (1.f / DM) + EPS); unsigned long long* o8 = (unsigned long long*)(o0 + r * rstride) + lane;
#pragma unroll
        for (int j = 0; j < 4; ++j) o8[64 * j] = (unsigned long long)pk2(v[r][j].x * rstd, v[r][j].y * rstd) | ((unsigned long long)pk2(v[r][j].z * rstd, v[r][j].w * rstd) << 32); }
}
__device__ __forceinline__ void quant_rows4_fp8(const float* src0, size_t rstride, const float* gain, unsigned char* dst0, float* scale0, int sstride, int lane) {
    f32x4 v[4][4]; float am[4];
#pragma unroll
    for (int r = 0; r < 4; ++r)
#pragma unroll
        for (int j = 0; j < 4; ++j) v[r][j] = __builtin_nontemporal_load((const f32x4*)(src0 + r * rstride) + 4 * lane + j);
    if (gain) {
#pragma unroll
        for (int j = 0; j < 4; ++j) { const f32x4 g = ((const f32x4*)gain)[4 * lane + j];
#pragma unroll
            for (int r = 0; r < 4; ++r) v[r][j] = v[r][j] * g; } }
#pragma unroll
    for (int r = 0; r < 4; ++r) { am[r] = 0.f;
#pragma unroll
        for (int j = 0; j < 4; ++j) am[r] = fmaxf(am[r], fmaxf(fmaxf(fabsf(v[r][j].x), fabsf(v[r][j].y)), fmaxf(fabsf(v[r][j].z), fabsf(v[r][j].w)))); }
#pragma unroll
    for (int o = 1; o < 64; o <<= 1)
#pragma unroll
        for (int r = 0; r < 4; ++r) am[r] = fmaxf(am[r], __shfl_xor(am[r], o));
#pragma unroll
    for (int r = 0; r < 4; ++r) { const float inv = am[r] > 0.f ? 448.0f / am[r] : 0.f; v4u o4;
#pragma unroll
        for (int j = 0; j < 4; ++j) { int w = 0; w = __builtin_amdgcn_cvt_pk_fp8_f32(v[r][j].x * inv, v[r][j].y * inv, w, false); w = __builtin_amdgcn_cvt_pk_fp8_f32(v[r][j].z * inv, v[r][j].w * inv, w, true); o4[j] = (unsigned)w; }
        *(v4u*)(dst0 + (size_t)r * sstride * 128 + (size_t)(lane >> 3) * 16384 * 128 + (lane & 7) * 16) = o4;
        if (lane == 0) scale0[r * sstride] = am[r] * (1.0f / 448.0f); }
}
__device__ __forceinline__ void p0_prologue(const Frame& F, const Args& A, LAS unsigned char* lds) {
    unsigned char* ws = A.ws;
    LAS float* scr = (LAS float*)(lds + F.wave * 16384);
    const float* const* in = A.in;
    const int gw = F.gw, NGW = F.NGW;
    constexpr int I_IN = 16 * 73, I_SQ = 16 * 32, I_PQ = 16 * 64, I_C1 = 64, I_C2 = 2, I_RG = 2;
    constexpr int E_IN = I_IN, E_OUT = E_IN + I_SQ, E_MQ = E_OUT + I_SQ, E_MK = E_MQ + I_SQ, E_MV = E_MK + I_SQ, E_MO = E_MV + I_SQ, E_PQ = E_MO + I_PQ, E_C1 = E_PQ + 2 * I_C1, E_C2 = E_C1 + 2 * I_C2, E_RG = E_C2 + 16 * I_RG;
    for (int it = gw; it < E_RG; it += NGW) {
        if (it < E_IN) transpose_item(in[3], 1024, 2328, (bf16*)(ws + WS_WIN), 1024, 0, in[2], ZC_Q, ZC_KC, QSCALE, scr, it, F.lane);
        else if (it < E_OUT) { const int j = it - E_IN, kb = j / 32; transpose_item(in[20], 1024, 1024, (bf16*)(ws + WS_WOUT), 1024, 0, (kb < 8 ? in[18] : in[19] - 512), 0, 0, 1.f, scr, j, F.lane, 512); }
        else if (it < E_MQ) transpose_item(in[23], 1024, 1024, (bf16*)(ws + WS_WMQ), 1024, 0, in[21], 0, 1024, 0.0625f * 1.4426950408889634f, scr, it - E_OUT, F.lane);
        else if (it < E_MK) transpose_item(in[24], 1024, 1024, (bf16*)(ws + WS_WMK), 1024, 0, in[22], 0, 0, 1.f, scr, it - E_MQ, F.lane);
        else if (it < E_MV) transpose_item(in[25], 1024, 1024, (bf16*)(ws + WS_WMV), 1024, 0, in[22], 0, 0, 1.f, scr, it - E_MK, F.lane);
        else if (it < E_MO) transpose_item(in[26], 1024, 1024, (bf16*)(ws + WS_WMO), 1024, 0, nullptr, 0, 0, 1.f, scr, it - E_MV, F.lane);
        else if (it < E_PQ) transpose_item(in[28], 1024, 2048, (bf16*)(ws + WS_WPQ), 1024, 0, in[27], 0, 0, 1.f, scr, it - E_MO, F.lane);
        else if (it < E_C1) { const int j = it - E_PQ, kv = j / I_C1; transpose_item(in[kv ? 16 : 13], 2048, 64, (bf16*)(ws + WS_CW1T) + (size_t)kv * 64 * 2048, 2048, 0, nullptr, 0, 0, 1.f, scr, j % I_C1, F.lane); }
        else if (it < E_C2) { const int j = it - E_C1, kv = j / I_C2; transpose_item(in[kv ? 17 : 14], 64, 64, (bf16*)(ws + WS_CW2T) + (size_t)kv * 64 * 64, 64, 0, nullptr, 0, 0, 1.f, scr, j % I_C2, F.lane); }
        else { const int j = it - E_C2, ai = j / 16, h = (j / 2) % 8; transpose_item(in[ai ? 9 : 7] + (size_t)h * 4096, 64, 64, (bf16*)(ws + WS_WRGT) + (size_t)(ai * 8 + h) * 4096, 64, 0, nullptr, 0, 0, 1.f, scr, j % 2, F.lane); }
    }
    for (int i = gw * 64 + F.lane; i < (2560 - 2336) * 1024 / 8; i += NGW * 64) ((v4u*)((bf16*)(ws + WS_WIN) + (size_t)2336 * 1024))[i] = (v4u){0u, 0u, 0u, 0u};
    for (int it = NGW - 1 - gw; it < 32; it += NGW) { const int kv = it >> 4, ch = it & 15; const float* pos = in[kv ? 15 : 12] + 128 * ch; const float* w1 = in[kv ? 16 : 13] + (size_t)128 * ch * 64 + F.lane; float s = 0.f;
#pragma unroll 16
        for (int k = 0; k < 128; ++k) s += pos[k] * w1[(size_t)k * 64];
        ((float*)(ws + WS_C1))[it * 64 + F.lane] = s; }
    { const size_t i0 = (size_t)gw * 64 + F.lane, st = (size_t)NGW * 64;
      for (int r = gw; r < 32768; r += 4 * NGW) { const int tb = r >> 14, e = r & 16383;
          if ((16384 % (4 * NGW)) == 0) quant_rows4_fp8(in[30 + tb] + (size_t)e * DM, (size_t)NGW * DM, tb ? nullptr : in[27], ws + (tb ? WS_V8 : WS_U8) + (size_t)e * 128, (float*)(ws + (tb ? WS_SV : WS_SU)) + e, NGW, F.lane);
          else for (int q = 0; q < 4; ++q) { const int rr = r + q * NGW; if (rr < 32768) { const int t2 = rr >> 14, e2 = rr & 16383; quant_row_fp8(in[30 + t2] + (size_t)e2 * DM, t2 ? nullptr : in[27], ws + (t2 ? WS_V8 : WS_U8) + (size_t)e2 * 128, (float*)(ws + (t2 ? WS_SV : WS_SU)) + e2, F.lane); } } }
      for (size_t i = i0; i < (size_t)8 * 2 * 128 * 128 / 8; i += st) { const f32x4 a = ((const f32x4*)in[29])[2 * i], bq = ((const f32x4*)in[29])[2 * i + 1];
          v4u o; o.x = pk2(a.x, a.y); o.y = pk2(a.z, a.w); o.z = pk2(bq.x, bq.y); o.w = pk2(bq.z, bq.w);
          const size_t R = i >> 4, d0 = (i & 15) * 8;
          *(v4u*)((bf16*)(ws + WS_SKEY) + (R >> 5) * 4096 + (d0 >> 4) * 512 + ((d0 >> 3) & 1) * 256 + (R & 31) * 8) = o; } }
    if ((MTOK % (4 * NGW)) == 0) for (int m = gw; m < MTOK; m += 4 * NGW) rms_rows4_to_bf16(in[0] + (size_t)m * DM, (bf16*)(ws + WS_XN) + (size_t)m * DM, (size_t)NGW * DM, F.lane);
    else for (int m = gw; m < MTOK; m += NGW) rms_row_to_bf16(in[0] + (size_t)m * DM, (bf16*)(ws + WS_XN) + (size_t)m * DM, F.lane);
    for (int m = gw; m < NB * NMEM; m += NGW) rms_row_to_bf16(in[1] + (size_t)m * DM, (bf16*)(ws + WS_MEMN) + (size_t)m * DM, F.lane);
}

__device__ __forceinline__ int crow(int r, int hi) { return (r & 3) + 8 * (r >> 2) + 4 * hi; }
__device__ __forceinline__ float gelu_tanh(float x) {
    const float u = 0.7978845608028654f * (x + 0.044715f * x * x * x);
    const float t = 1.0f - 2.0f * __builtin_amdgcn_rcpf(__builtin_amdgcn_exp2f(2.0f * 1.4426950408889634f * u) + 1.0f);
    return 0.5f * x * (1.0f + t);
}
constexpr int XC_LD = 520;
__device__ __forceinline__ void lru_local_item(const Frame& F, const Args& A, LAS unsigned char* lds, int item) {
    unsigned char* ws = A.ws;
    const bf16* Z = (const bf16*)(ws + WS_Z);
    const int b = item >> 7, chunk = item & 127, s0 = chunk * 64; const size_t row0 = (size_t)b * SEQ + s0;
    LAS bf16* xcs = (LAS bf16*)lds;
    {
        const int c8 = F.tid & 63, tg = F.tid >> 6, c0 = 8 * c8;
        v4u xr[11];
#pragma unroll
        for (int r = 0; r < 11; ++r) { const long tok = (long)(8 * tg + r) - 3;
            if (s0 == 0 && tok < 0) xr[r] = (v4u){0u, 0u, 0u, 0u}; else xr[r] = *(const v4u*)(Z + (size_t)((long)row0 + tok) * NZ + c0); }
        const float* cw = A.in[5]; float w0[8], w1[8], w2[8], w3[8], cb[8];
#pragma unroll
        for (int j = 0; j < 2; ++j) { const f32x4 a = *(const f32x4*)(cw + c0 + 4 * j), b = *(const f32x4*)(cw + 512 + c0 + 4 * j), c = *(const f32x4*)(cw + 1024 + c0 + 4 * j), d = *(const f32x4*)(cw + 1536 + c0 + 4 * j), e2 = *(const f32x4*)(A.in[6] + c0 + 4 * j);
#pragma unroll
            for (int k = 0; k < 4; ++k) { w0[4 * j + k] = a[k]; w1[4 * j + k] = b[k]; w2[4 * j + k] = c[k]; w3[4 * j + k] = d[k]; cb[4 * j + k] = e2[k]; } }
#pragma unroll
        for (int tt = 0; tt < 8; ++tt) { float o[8];
#pragma unroll
            for (int q = 0; q < 4; ++q) { const unsigned a = xr[tt][q], b = xr[tt + 1][q], c = xr[tt + 2][q], d = xr[tt + 3][q];
                o[2 * q] = cb[2 * q] + w0[2 * q] * bflo(a) + w1[2 * q] * bflo(b) + w2[2 * q] * bflo(c) + w3[2 * q] * bflo(d);
                o[2 * q + 1] = cb[2 * q + 1] + w0[2 * q + 1] * bfhi(a) + w1[2 * q + 1] * bfhi(b) + w2[2 * q + 1] * bfhi(c) + w3[2 * q + 1] * bfhi(d); }
            v4u ov; ov.x = pk2(o[0], o[1]); ov.y = pk2(o[2], o[3]); ov.z = pk2(o[4], o[5]); ov.w = pk2(o[6], o[7]);
            *(LAS v4u*)(xcs + (8 * tg + tt) * XC_LD + c0) = ov; }
    }
    __syncthreads();
    const int h = F.wave, lane = F.lane, r32 = lane & 31, hi = lane >> 5;
    bf16x8 af[2][4];
#pragma unroll
    for (int tt = 0; tt < 2; ++tt)
#pragma unroll
        for (int ks = 0; ks < 4; ++ks) af[tt][ks] = *(const LAS bf16x8*)(xcs + (32 * tt + r32) * XC_LD + 64 * h + 16 * ks + 8 * hi);
    const bf16* WT = (const bf16*)(ws + WS_WRGT);
    float* SUMM = (float*)(ws + WS_SUMM);
    unsigned* HA = (unsigned*)A.out;
#pragma unroll 1
    for (int ct = 0; ct < 2; ++ct) {
        const int c = 64 * h + 32 * ct + r32;
        f32x16 ga[2], gi[2];
#pragma unroll
        for (int tt = 0; tt < 2; ++tt) { ga[tt] = f32x16{}; gi[tt] = f32x16{}; }
#pragma unroll
        for (int ks = 0; ks < 4; ++ks) {
            const bf16x8 ba = *(const bf16x8*)(WT + (size_t)(0 * 8 + h) * 4096 + (32 * ct + r32) * 64 + 16 * ks + 8 * hi);
            const bf16x8 bi = *(const bf16x8*)(WT + (size_t)(1 * 8 + h) * 4096 + (32 * ct + r32) * 64 + 16 * ks + 8 * hi);
#pragma unroll
            for (int tt = 0; tt < 2; ++tt) { ga[tt] = __builtin_amdgcn_mfma_f32_32x32x16_bf16(af[tt][ks], ba, ga[tt], 0, 0, 0); gi[tt] = __builtin_amdgcn_mfma_f32_32x32x16_bf16(af[tt][ks], bi, gi[tt], 0, 0, 0); }
        }
        const float ba_ = A.in[8][c], bi_ = A.in[10][c], lam = A.in[11][c];
        const float sp = (lam > 15.f) ? __expf(-lam) : log1pf(__expf(-lam));
#pragma unroll
        for (int tt = 0; tt < 2; ++tt)
#pragma unroll
            for (int r = 0; r < 16; ++r) { const int t = 32 * tt + crow(r, hi);
                const float rr = __builtin_amdgcn_rcpf(1.0f + __builtin_amdgcn_exp2f(-1.4426950408889634f * (ga[tt][r] + ba_))), ii = __builtin_amdgcn_rcpf(1.0f + __builtin_amdgcn_exp2f(-1.4426950408889634f * (gi[tt][r] + bi_)));
                const float a = __builtin_amdgcn_exp2f(-8.0f * 1.4426950408889634f * rr * sp);
                const float xcv = bf2f(xcs[t * XC_LD + c]);
                const float bb = __builtin_amdgcn_sqrtf(fmaxf(1.0f - a * a, 0.f)) * (ii * xcv);
                ga[tt][r] = a; gi[tt][r] = bb; }
        float SA[8], SB[8];
#pragma unroll
        for (int tt = 0; tt < 2; ++tt)
#pragma unroll
            for (int q = 0; q < 4; ++q) {
#pragma unroll
                for (int k = 1; k < 4; ++k) { const int r = 4 * q + k; gi[tt][r] = ga[tt][r] * gi[tt][r - 1] + gi[tt][r]; ga[tt][r] = ga[tt][r] * ga[tt][r - 1]; }
                SA[tt * 4 + q] = ga[tt][4 * q + 3]; SB[tt * 4 + q] = gi[tt][4 * q + 3]; }
        float CA = 1.f, CB = 0.f; float inA[8], inB[8];
#pragma unroll
        for (int s = 0; s < 8; ++s) {
            const float pA = __shfl_xor(SA[s], 32), pB = __shfl_xor(SB[s], 32);
            const float Ae = hi ? pA : SA[s], Be = hi ? pB : SB[s], Ao = hi ? SA[s] : pA, Bo = hi ? SB[s] : pB;
            if (!hi) { inA[s] = CA; inB[s] = CB; }
            CB = Ae * CB + Be; CA = Ae * CA;
            if (hi) { inA[s] = CA; inB[s] = CB; }
            CB = Ao * CB + Bo; CA = Ao * CA;
        }
        unsigned hoff = (unsigned)((row0 + 4 * hi) * 512 + c);
        if (hi == 0) { float* sp2 = SUMM + ((size_t)(b * 128 + chunk) * 512 + c) * 2; sp2[0] = CA; sp2[1] = CB; }
#pragma unroll
        for (int tt = 0; tt < 2; ++tt)
#pragma unroll
            for (int r = 0; r < 16; ++r) { const int s = tt * 4 + (r >> 2);
                const float acum = ga[tt][r] * inA[s], hloc = ga[tt][r] * inB[s] + gi[tt][r];
                asm volatile("" : "+v"(hoff));
                HA[hoff + (unsigned)((32 * tt + (r & 3) + 8 * (r >> 2)) * 512)] = f2bf(hloc) | (f2bf(acum) << 16); }
    }
    __syncthreads();
}
__device__ __forceinline__ void lru_fix_item(const Frame& F, const Args& A, LAS unsigned char* lds, int item, bool zero_nsa) {
    unsigned char* ws = A.ws;
    const int b = item >> 7, chunk = item & 127; const size_t row0 = (size_t)b * SEQ + chunk * 64;
    LAS float* carry = (LAS float*)lds;
    { const int c = F.tid; const float* SUMM = (const float*)(ws + WS_SUMM) + (size_t)b * 128 * 1024 + 2 * c; float hc = 0.f;
      int j = 0;
      for (; j + 8 <= chunk; j += 8) { float2 ab[8];
#pragma unroll
          for (int q = 0; q < 8; ++q) ab[q] = *(const float2*)(SUMM + (size_t)(j + q) * 1024);
#pragma unroll
          for (int q = 0; q < 8; ++q) hc = ab[q].x * hc + ab[q].y; }
      for (; j < chunk; ++j) { const float2 ab = *(const float2*)(SUMM + (size_t)j * 1024); hc = ab.x * hc + ab.y; }
      carry[c] = hc; }
    __syncthreads();
    const bf16* Z = (const bf16*)(ws + WS_Z); const unsigned* HA = (const unsigned*)A.out; bf16* Y = (bf16*)(ws + WS_Y);
    const int c0 = 8 * F.lane;
    float cr[8];
#pragma unroll
    for (int j = 0; j < 8; ++j) cr[j] = carry[c0 + j];
#pragma unroll 1
    for (int t4 = 0; t4 < 8; t4 += 4) {
        v4u h0[4], h1[4], gz[4]; float y[4][8], s[4];
#pragma unroll
        for (int q = 0; q < 4; ++q) { const size_t row = row0 + F.wave * 8 + t4 + q; h0[q] = *(const v4u*)(HA + row * 512 + c0); h1[q] = *(const v4u*)(HA + row * 512 + c0 + 4); gz[q] = *(const v4u*)(Z + row * NZ + ZC_GT + c0); }
#pragma unroll
        for (int q = 0; q < 4; ++q) { const unsigned hw[8] = {h0[q].x, h0[q].y, h0[q].z, h0[q].w, h1[q].x, h1[q].y, h1[q].z, h1[q].w};
            const float gt[8] = {bflo(gz[q].x), bfhi(gz[q].x), bflo(gz[q].y), bfhi(gz[q].y), bflo(gz[q].z), bfhi(gz[q].z), bflo(gz[q].w), bfhi(gz[q].w)};
            s[q] = 0.f;
#pragma unroll
            for (int j = 0; j < 8; ++j) { const float hv = bfhi(hw[j]) * cr[j] + bflo(hw[j]); y[q][j] = hv * gelu_tanh(gt[j]); s[q] += y[q][j] * y[q][j]; } }
#pragma unroll
        for (int o = 1; o < 64; o <<= 1)
#pragma unroll
            for (int q = 0; q < 4; ++q) s[q] += __shfl_xor(s[q], o);
#pragma unroll
        for (int q = 0; q < 4; ++q) { const size_t row = row0 + F.wave * 8 + t4 + q; const float rstd = rsqrtf(s[q] * (1.f / 512.f) + EPS);
            v4u o; o.x = pk2(y[q][0] * rstd, y[q][1] * rstd); o.y = pk2(y[q][2] * rstd, y[q][3] * rstd); o.z = pk2(y[q][4] * rstd, y[q][5] * rstd); o.w = pk2(y[q][6] * rstd, y[q][7] * rstd);
            *(v4u*)(Y + row * DM + 512 + c0) = o;
            if (zero_nsa) *(v4u*)(Y + row * DM + c0) = (v4u){0u, 0u, 0u, 0u}; }
    }
    __syncthreads();
}

__device__ __forceinline__ void kmax_item(const Frame& F, const Args& A, int item) {
    unsigned char* ws = A.ws; const int lane = lane_id();
    const int bk = item >> 9, br = (item >> 8) & 1, tile = item & 255;
    const unsigned char* K = ws + (br ? WS_KWF : WS_KSF) + ((size_t)bk * 256 + tile) * 4096 + 16 * lane;
    float s = 0.f;
#pragma unroll
    for (int ks = 0; ks < 4; ++ks) { const v4u w = *(const v4u*)(K + 1024 * ks); const unsigned ww[4] = {w.x, w.y, w.z, w.w};
#pragma unroll
        for (int k = 0; k < 4; ++k) { const float a = bflo(ww[k]), c = bfhi(ww[k]); s += a * a + c * c; } }
    s = addswap32_f(s);
#pragma unroll
    for (int o = 1; o < 32; o <<= 1) s = fmaxf(s, __shfl_xor(s, o));
    if (lane == 0) atomicMax((unsigned*)(ws + WS_CTL) + CW_KMAX + bk * 2 + br, __builtin_bit_cast(unsigned, s));
}
__device__ __forceinline__ void compress_item(const Frame& F, const Args& A, LAS unsigned char* lds, int item) {
    unsigned char* ws = A.ws;
    const int kv = item >> 6, b = (item >> 5) & 1, h = (item >> 4) & 1, nt = item & 15, n0 = 32 * nt;
    const int lane = F.lane, r32 = lane & 31, hi = lane >> 5, w = F.wave;
    const bf16* Z = (const bf16*)(ws + WS_Z); const bf16* W1T = (const bf16*)(ws + WS_CW1T) + (size_t)kv * 64 * 2048; const bf16* W2T = (const bf16*)(ws + WS_CW2T) + (size_t)kv * 4096;
    const int zc = (kv ? ZC_VC : ZC_KC) + h * 64;
    LAS float* part = (LAS float*)lds;
    LAS float* G = (LAS float*)(lds + 65536);
    {
        int n = n0 + r32; if (n > 510) n = 510;
        f32x16 acc[2]; acc[0] = f32x16{}; acc[1] = f32x16{};
#pragma unroll 4
        for (int kk = 0; kk < 16; ++kk) { const int ks = 16 * w + kk, l = ks >> 2, d0 = (ks & 3) * 16 + 8 * hi;
            const bf16x8 bfr = *(const bf16x8*)(Z + ((size_t)b * SEQ + 16 * n + l) * NZ + zc + d0);
            const bf16x8 a0 = *(const bf16x8*)(W1T + (size_t)(r32) * 2048 + ks * 16 + 8 * hi), a1 = *(const bf16x8*)(W1T + (size_t)(32 + r32) * 2048 + ks * 16 + 8 * hi);
            acc[0] = __builtin_amdgcn_mfma_f32_32x32x16_bf16(a0, bfr, acc[0], 0, 0, 0); acc[1] = __builtin_amdgcn_mfma_f32_32x32x16_bf16(a1, bfr, acc[1], 0, 0, 0); }
#pragma unroll
        for (int ot = 0; ot < 2; ++ot)
#pragma unroll
            for (int r = 0; r < 16; ++r) part[(w * 64 + 32 * ot + crow(r, hi)) * 32 + r32] = acc[ot][r];
    }
    __syncthreads();
    { const float* c1 = (const float*)(ws + WS_C1) + kv * 16 * 64;
#pragma unroll
      for (int i = 0; i < 4; ++i) { const int e = F.tid + 512 * i, o = e >> 5, n = e & 31; float s = 0.f;
#pragma unroll
          for (int ch = 0; ch < 16; ++ch) s += c1[ch * 64 + o];
#pragma unroll
          for (int ww = 0; ww < 8; ++ww) s += part[(ww * 64 + o) * 32 + n];
          G[o * 33 + n] = gelu_tanh(s); } }
    __syncthreads();
    if (w < 2) {
        f32x16 acc = f32x16{};
#pragma unroll
        for (int ks = 0; ks < 4; ++ks) { const bf16x8 a = *(const bf16x8*)(W2T + (size_t)(32 * w + r32) * 64 + 16 * ks + 8 * hi);
            v4u bw; const LAS float* gp = G + (16 * ks + 8 * hi) * 33 + r32;
            bw.x = pk2(gp[0], gp[33]); bw.y = pk2(gp[66], gp[99]); bw.z = pk2(gp[132], gp[165]); bw.w = pk2(gp[198], gp[231]);
            acc = __builtin_amdgcn_mfma_f32_32x32x16_bf16(a, __builtin_bit_cast(bf16x8, bw), acc, 0, 0, 0); }
        const int n = n0 + r32;
        const size_t tbase = ((size_t)(b * 2 + h) * 16 + nt) * 2048;
        if (kv == 0) { bf16* KC = (bf16*)(ws + WS_KC) + tbase;
#pragma unroll
            for (int q = 0; q < 4; ++q) { v2u o; o.x = pk2(acc[4 * q], acc[4 * q + 1]); o.y = pk2(acc[4 * q + 2], acc[4 * q + 3]); if (n > 510) { o.x = 0u; o.y = 0u; }
                *(v2u*)(KC + (2 * w + (q >> 1)) * 512 + (q & 1) * 256 + r32 * 8 + 4 * hi) = o; } }
        else { bf16* VC = (bf16*)(ws + WS_VCT) + tbase; const int kk = r32 & 15, vo = (r32 >> 4) * 512 + ((kk >> 2) & 1) * 256 + (kk & 3) + 4 * (kk >> 3);
#pragma unroll
            for (int r = 0; r < 16; ++r) VC[w * 1024 + crow(r, hi) * 8 + vo] = (n > 510) ? (bf16)0 : (bf16)f2bf(acc[r]); }
    }
    __syncthreads();
}

__device__ __forceinline__ void sort16_desc(int (&k)[16]) {
#define CX(i, j) { const int hi_ = max(k[i], k[j]), lo_ = min(k[i], k[j]); k[i] = hi_; k[j] = lo_; }
    CX(0, 1) CX(2, 3) CX(0, 2) CX(1, 3) CX(1, 2) CX(4, 5) CX(6, 7) CX(4, 6) CX(5, 7) CX(5, 6) CX(0, 4) CX(2, 6) CX(2, 4) CX(1, 5) CX(3, 7) CX(3, 5) CX(1, 2)
    CX(3, 4) CX(5, 6) CX(8, 9) CX(10, 11) CX(8, 10) CX(9, 11) CX(9, 10) CX(12, 13) CX(14, 15) CX(12, 14) CX(13, 15) CX(13, 14) CX(8, 12) CX(10, 14) CX(10, 12)
    CX(9, 13) CX(11, 15) CX(11, 13) CX(9, 10) CX(11, 12) CX(13, 14) CX(0, 8) CX(4, 12) CX(4, 8) CX(2, 10) CX(6, 14) CX(6, 10) CX(2, 4) CX(6, 8) CX(10, 12)
    CX(1, 9) CX(5, 13) CX(5, 9) CX(3, 11) CX(7, 15) CX(7, 11) CX(3, 5) CX(7, 9) CX(11, 13) CX(1, 2) CX(3, 4) CX(5, 6) CX(7, 8) CX(9, 10) CX(11, 12) CX(13, 14)
#undef CX
}
__device__ __forceinline__ void sort32_desc(int (&k)[32]) {
#define CX(i, j) { const int hi_ = max(k[i], k[j]), lo_ = min(k[i], k[j]); k[i] = hi_; k[j] = lo_; }
    CX(0, 1) CX(2, 3) CX(0, 2) CX(1, 3) CX(1, 2) CX(4, 5) CX(6, 7) CX(4, 6) CX(5, 7) CX(5, 6) CX(0, 4) CX(2, 6) CX(2, 4) CX(1, 5) CX(3, 7) CX(3, 5) CX(1, 2)
    CX(3, 4) CX(5, 6) CX(8, 9) CX(10, 11) CX(8, 10) CX(9, 11) CX(9, 10) CX(12, 13) CX(14, 15) CX(12, 14) CX(13, 15) CX(13, 14) CX(8, 12) CX(10, 14) CX(10, 12)
    CX(9, 13) CX(11, 15) CX(11, 13) CX(9, 10) CX(11, 12) CX(13, 14) CX(0, 8) CX(4, 12) CX(4, 8) CX(2, 10) CX(6, 14) CX(6, 10) CX(2, 4) CX(6, 8) CX(10, 12)
    CX(1, 9) CX(5, 13) CX(5, 9) CX(3, 11) CX(7, 15) CX(7, 11) CX(3, 5) CX(7, 9) CX(11, 13) CX(1, 2) CX(3, 4) CX(5, 6) CX(7, 8) CX(9, 10) CX(11, 12) CX(13, 14)
    CX(16, 17) CX(18, 19) CX(16, 18) CX(17, 19) CX(17, 18) CX(20, 21) CX(22, 23) CX(20, 22) CX(21, 23) CX(21, 22) CX(16, 20) CX(18, 22) CX(18, 20) CX(17, 21)
    CX(19, 23) CX(19, 21) CX(17, 18) CX(19, 20) CX(21, 22) CX(24, 25) CX(26, 27) CX(24, 26) CX(25, 27) CX(25, 26) CX(28, 29) CX(30, 31) CX(28, 30) CX(29, 31)
    CX(29, 30) CX(24, 28) CX(26, 30) CX(26, 28) CX(25, 29) CX(27, 31) CX(27, 29) CX(25, 26) CX(27, 28) CX(29, 30) CX(16, 24) CX(20, 28) CX(20, 24) CX(18, 26)
    CX(22, 30) CX(22, 26) CX(18, 20) CX(22, 24) CX(26, 28) CX(17, 25) CX(21, 29) CX(21, 25) CX(19, 27) CX(23, 31) CX(23, 27) CX(19, 21) CX(23, 25) CX(27, 29)
    CX(17, 18) CX(19, 20) CX(21, 22) CX(23, 24) CX(25, 26) CX(27, 28) CX(29, 30) CX(0, 16) CX(8, 24) CX(8, 16) CX(4, 20) CX(12, 28) CX(12, 20) CX(4, 8)
    CX(12, 16) CX(20, 24) CX(2, 18) CX(10, 26) CX(10, 18) CX(6, 22) CX(14, 30) CX(14, 22) CX(6, 10) CX(14, 18) CX(22, 26) CX(2, 4) CX(6, 8) CX(10, 12)
    CX(14, 16) CX(18, 20) CX(22, 24) CX(26, 28) CX(1, 17) CX(9, 25) CX(9, 17) CX(5, 21) CX(13, 29) CX(13, 21) CX(5, 9) CX(13, 17) CX(21, 25) CX(3, 19)
    CX(11, 27) CX(11, 19) CX(7, 23) CX(15, 31) CX(15, 23) CX(7, 11) CX(15, 19) CX(23, 27) CX(3, 5) CX(7, 9) CX(11, 13) CX(15, 17) CX(19, 21) CX(23, 25)
    CX(27, 29) CX(1, 2) CX(3, 4) CX(5, 6) CX(7, 8) CX(9, 10) CX(11, 12) CX(13, 14) CX(15, 16) CX(17, 18) CX(19, 20) CX(21, 22) CX(23, 24) CX(25, 26) CX(27, 28)
    CX(29, 30)
#undef CX
}
__device__ __forceinline__ void bitonic16_desc(int (&a)[16]) {
#pragma unroll
    for (int s = 8; s >= 1; s >>= 1)
#pragma unroll
        for (int i = 0; i < 16; ++i) if ((i & s) == 0) { const int hi_ = max(a[i], a[i + s]), lo_ = min(a[i], a[i + s]); a[i] = hi_; a[i + s] = lo_; }
}
__device__ __forceinline__ void merge16_desc(int (&a)[16], const int (&b)[16]) {
#pragma unroll
    for (int i = 0; i < 16; ++i) a[i] = max(a[i], b[15 - i]);
    bitonic16_desc(a);
}
struct AttnSt { float m, l; f32x16 o[2]; };
#define EX2(x) __builtin_amdgcn_exp2f(x)
struct KVF { bf16x8 k[4]; bf16x8 v[2][2]; };
struct KVF8 { bf16x8 k[4]; v4u v8[2]; };
__device__ __forceinline__ void kv_load8(KVF8& f, const bf16* Kt, const unsigned char* Vt8, unsigned lo16) {
    const char* kb = (const char*)Kt + lo16;
#pragma unroll
    for (int ks = 0; ks < 4; ++ks) f.k[ks] = *(const bf16x8*)(kb + 1024 * ks);
#pragma unroll
    for (int dt = 0; dt < 2; ++dt) f.v8[dt] = *(const v4u*)(Vt8 + lo16 + 1024 * dt);
}
typedef __bf16 bf16x2v __attribute__((ext_vector_type(2)));
__device__ __forceinline__ bf16x8 dq8(unsigned w0, unsigned w1) {
    v4u o; o.x = __builtin_bit_cast(unsigned, __builtin_amdgcn_cvt_scalef32_pk_bf16_fp8(w0, 1.0f, false)); o.y = __builtin_bit_cast(unsigned, __builtin_amdgcn_cvt_scalef32_pk_bf16_fp8(w0, 1.0f, true));
    o.z = __builtin_bit_cast(unsigned, __builtin_amdgcn_cvt_scalef32_pk_bf16_fp8(w1, 1.0f, false)); o.w = __builtin_bit_cast(unsigned, __builtin_amdgcn_cvt_scalef32_pk_bf16_fp8(w1, 1.0f, true));
    return __builtin_bit_cast(bf16x8, o); }
__device__ __forceinline__ void kv_load(KVF& f, const bf16* Kt, const bf16* Vt, unsigned lo16) {
    const char* kb = (const char*)Kt + lo16; const char* vb = (const char*)Vt + lo16;
#pragma unroll
    for (int ks = 0; ks < 4; ++ks) f.k[ks] = *(const bf16x8*)(kb + 1024 * ks);
#pragma unroll
    for (int dt = 0; dt < 2; ++dt)
#pragma unroll
        for (int s2 = 0; s2 < 2; ++s2) f.v[dt][s2] = *(const bf16x8*)(vb + 2048 * dt + 1024 * s2);
}
#define MAX3(a, b, c) __builtin_fmaxf(__builtin_fmaxf((a), (b)), (c))
__device__ __forceinline__ float max16(const f32x16& s) { const float a = MAX3(s[0], s[1], s[2]), b = MAX3(s[3], s[4], s[5]), c = MAX3(s[6], s[7], s[8]), d = MAX3(s[9], s[10], s[11]), e = MAX3(s[12], s[13], s[14]);
    return MAX3(MAX3(a, b, c), MAX3(d, e, s[15]), -1e30f); }
__device__ __forceinline__ float sum16(const f32x16& s) { return (((s[0] + s[1]) + (s[2] + s[3])) + ((s[4] + s[5]) + (s[6] + s[7]))) + (((s[8] + s[9]) + (s[10] + s[11])) + ((s[12] + s[13]) + (s[14] + s[15]))); }
template <int MODE, bool FIXED, class AllowF>
__device__ __forceinline__ void attn_compute(const KVF8& f, const bf16x8 (&qf)[4], const f32x16& negm, bool sel, AllowF allow, AttnSt& st) {
    f32x16 s = FIXED ? negm : f32x16{};
#pragma unroll
    for (int ks = 0; ks < 4; ++ks) s = __builtin_amdgcn_mfma_f32_32x32x16_bf16(f.k[ks], qf[ks], s, 0, 0, 0);
    if (MODE == 2) {
#pragma unroll
        for (int r = 0; r < 16; ++r) if (!allow(r)) s[r] = -1e30f; }
    if (!FIXED) {
        float mt = max16(s);
        if (MODE == 1) mt = sel ? mt : -1e30f;
        mt = maxswap32_f(mt);
        if (__any(mt > st.m)) {
            const float mn = fmaxf(st.m, mt), alpha = EX2(st.m - mn);
            st.m = mn; st.l *= alpha;
#pragma unroll
            for (int dt = 0; dt < 2; ++dt)
#pragma unroll
                for (int r = 0; r < 16; ++r) st.o[dt][r] *= alpha;
        }
        const float mref = (MODE == 1 && !sel) ? 1e30f : fmaxf(st.m, -1e29f);
#pragma unroll
        for (int r = 0; r < 16; ++r) s[r] = EX2(s[r] - mref);
        st.l += sum16(s);
    } else {
#pragma unroll
        for (int r = 0; r < 16; ++r) s[r] = EX2(s[r]);
        const float ps = sum16(s);
        st.l += (MODE == 1 && !sel) ? 0.f : ps;
    }
#pragma unroll
    for (int s2 = 0; s2 < 2; ++s2) { v4u pw; pw.x = pk2(s[8 * s2], s[8 * s2 + 1]); pw.y = pk2(s[8 * s2 + 2], s[8 * s2 + 3]); pw.z = pk2(s[8 * s2 + 4], s[8 * s2 + 5]); pw.w = pk2(s[8 * s2 + 6], s[8 * s2 + 7]);
        if (FIXED && MODE == 1) { pw.x = sel ? pw.x : 0u; pw.y = sel ? pw.y : 0u; pw.z = sel ? pw.z : 0u; pw.w = sel ? pw.w : 0u; }
        const bf16x8 pf = __builtin_bit_cast(bf16x8, pw);
#pragma unroll
        for (int dt = 0; dt < 2; ++dt) st.o[dt] = __builtin_amdgcn_mfma_f32_32x32x16_bf16(dq8(f.v8[dt][2 * s2], f.v8[dt][2 * s2 + 1]), pf, st.o[dt], 0, 0, 0); }
}
constexpr int IMP_LD = 132;
__device__ __forceinline__ void nsa_item(const Frame& F, const Args& A, LAS unsigned char* lds, int b, int kvh, int tb, int wsub) {
    unsigned char* ws = A.ws;
    int lane = lane_id(); asm volatile("" : "+v"(lane));
    const int r32 = lane & 31, hi = lane >> 5, w = F.wave;
    const int t0 = 64 * tb + 8 * wsub, ti = r32 & 7, g = r32 >> 3, t = t0 + ti, cur = tb;
    const size_t rowb = (size_t)b * SEQ;
    const bf16* Z = (const bf16*)(ws + WS_Z);
    LAS float* imp = (LAS float*)lds + w * 8 * IMP_LD;
    for (int i = lane; i < 8 * IMP_LD; i += 64) imp[i] = 0.f;
    bf16x8 qf[4];
#pragma unroll
    for (int ks = 0; ks < 4; ++ks) qf[ks] = *(const bf16x8*)(Z + (rowb + t) * NZ + ZC_Q + (kvh * 4 + g) * 64 + 16 * ks + 8 * hi);
    const float* gp = (const float*)(ws + WS_GATES) + (rowb + t) * 24 + (kvh * 4 + g) * 3;
    const float gate_c = gp[0], gate_s = gp[1], gate_w = gp[2];
    LAS float* oacc = (LAS float*)(lds + 8 * 8 * IMP_LD * 4) + w * 2048 + lane;
    {
        const bf16* KC = (const bf16*)(ws + WS_KC) + (size_t)(b * 2 + kvh) * 16 * 2048;
        const bf16* VCT = (const bf16*)(ws + WS_VCT) + (size_t)(b * 2 + kvh) * 16 * 2048;
        const int nv = (t >= 31) ? ((t - 31) >> 4) + 1 : 0;
        const int tl = t0 + 7, nvmax = (tl >= 31) ? ((tl - 31) >> 4) + 1 : 0;
        const unsigned lo16 = 16u * (unsigned)lane;
        float m1 = -1e30f, l1 = 0.f;
        {
            bf16x8 ka[4], kb[4];
#pragma unroll
            for (int ks = 0; ks < 4; ++ks) ka[ks] = *(const bf16x8*)((const char*)KC + lo16 + 1024 * ks);
            for (int n0 = 0; n0 < nvmax; n0 += 32) {
                if (n0 + 32 < nvmax) {
#pragma unroll
                    for (int ks = 0; ks < 4; ++ks) kb[ks] = *(const bf16x8*)((const char*)(KC + (size_t)(n0 + 32) * 64) + lo16 + 1024 * ks);
                }
                f32x16 s = f32x16{};
#pragma unroll
                for (int ks = 0; ks < 4; ++ks) s = __builtin_amdgcn_mfma_f32_32x32x16_bf16(ka[ks], qf[ks], s, 0, 0, 0);
                float mt = -1e30f;
#pragma unroll
                for (int r = 0; r < 16; ++r) { if (n0 + crow(r, hi) >= nv) s[r] = -1e30f; mt = fmaxf(mt, s[r]); }
                const float mn = fmaxf(m1, mt); float ps = 0.f;
#pragma unroll
                for (int r = 0; r < 16; ++r) ps += (s[r] > -1e29f) ? EX2(s[r] - mn) : 0.f;
                l1 = l1 * EX2(m1 - mn) + ps; m1 = mn;
#pragma unroll
                for (int ks = 0; ks < 4; ++ks) ka[ks] = kb[ks];
            }
        }
        { const float mo = __shfl_xor(m1, 32), lo = __shfl_xor(l1, 32); const float mn = fmaxf(m1, mo); l1 = l1 * EX2(m1 - mn) + lo * EX2(mo - mn); m1 = mn; }
        const float invl = (l1 > 0.f) ? 1.0f / l1 : 0.f;
        f32x16 o[2]; o[0] = f32x16{}; o[1] = f32x16{};
        KVF fa, fb;
        if (nvmax > 0) kv_load(fa, KC, VCT, lo16);
        for (int n0 = 0; n0 < nvmax; n0 += 32) {
            if (n0 + 32 < nvmax) kv_load(fb, KC + (size_t)(n0 + 32) * 64, VCT + (size_t)(n0 + 32) * 64, lo16);
            f32x16 s = f32x16{};
#pragma unroll
            for (int ks = 0; ks < 4; ++ks) s = __builtin_amdgcn_mfma_f32_32x32x16_bf16(fa.k[ks], qf[ks], s, 0, 0, 0);
#pragma unroll
            for (int r = 0; r < 16; ++r) s[r] = (n0 + crow(r, hi) < nv) ? EX2(s[r] - m1) * invl : 0.f;
            float bs[4], sp[4];
#pragma unroll
            for (int q = 0; q < 4; ++q) { bs[q] = (s[4 * q] + s[4 * q + 1]) + (s[4 * q + 2] + s[4 * q + 3]); sp[q] = s[4 * q + 3];
                bs[q] += __shfl_xor(bs[q], 8); bs[q] += __shfl_xor(bs[q], 16); sp[q] += __shfl_xor(sp[q], 8); sp[q] += __shfl_xor(sp[q], 16); }
            if (r32 < 8) {
                LAS float* ip = imp + r32 * IMP_LD + (n0 >> 2) + hi;
#pragma unroll
                for (int q = 0; q < 4; ++q) ip[2 * q] += bs[q];
                asm volatile("s_waitcnt lgkmcnt(0)" ::: "memory");
#pragma unroll
                for (int q = 0; q < 4; ++q) ip[2 * q + 1] += sp[q];
                asm volatile("s_waitcnt lgkmcnt(0)" ::: "memory");
            }
#pragma unroll
            for (int s2 = 0; s2 < 2; ++s2) { v4u pw; pw.x = pk2(s[8 * s2], s[8 * s2 + 1]); pw.y = pk2(s[8 * s2 + 2], s[8 * s2 + 3]); pw.z = pk2(s[8 * s2 + 4], s[8 * s2 + 5]); pw.w = pk2(s[8 * s2 + 6], s[8 * s2 + 7]);
                const bf16x8 pf = __builtin_bit_cast(bf16x8, pw);
#pragma unroll
                for (int dt = 0; dt < 2; ++dt) o[dt] = __builtin_amdgcn_mfma_f32_32x32x16_bf16(fa.v[dt][s2], pf, o[dt], 0, 0, 0); }
            if (n0 + 32 < nvmax) fa = fb;
        }
#pragma unroll
        for (int dt = 0; dt < 2; ++dt)
#pragma unroll
            for (int r = 0; r < 16; ++r) oacc[(dt * 16 + r) * 64] = gate_c * o[dt][r];
    }
    asm volatile("s_waitcnt lgkmcnt(0)" ::: "memory");
    unsigned mym[4] = {0u, 0u, 0u, 0u}, un[4] = {0u, 0u, 0u, 0u};
    if (cur < 16) { const unsigned mk = (2u << cur) - 1u; mym[0] = mk; un[0] = mk; }
    else {
        const int tq = lane >> 3, sub = lane & 7;
        int key[16];
#pragma unroll
        for (int i = 0; i < 16; ++i) { const int j = 16 * sub + i; const float v = imp[tq * IMP_LD + j];
            key[i] = (j >= 1 && j <= cur - 2) ? (int)((__builtin_bit_cast(unsigned, v) & ~0x7fu) | (unsigned)(127 - j)) : 0; }
        sort16_desc(key);
        { int ot[16];
#pragma unroll
          for (int i = 0; i < 16; ++i) ot[i] = __builtin_amdgcn_mov_dpp(key[i], 0xB1, 0xf, 0xf, true);
          merge16_desc(key, ot);
#pragma unroll
          for (int i = 0; i < 16; ++i) ot[i] = __builtin_amdgcn_mov_dpp(key[i], 0x4E, 0xf, 0xf, true);
          merge16_desc(key, ot);
#pragma unroll
          for (int i = 0; i < 16; ++i) ot[i] = __builtin_amdgcn_mov_dpp(key[i], 0x141, 0xf, 0xf, true);
          merge16_desc(key, ot); }
        unsigned mk[4] = {1u, 0u, 0u, 0u};
        { const int c1 = cur - 1; if (c1 < 32) mk[0] |= 1u << c1; else if (c1 < 64) mk[1] |= 1u << (c1 - 32); else if (c1 < 96) mk[2] |= 1u << (c1 - 64); else mk[3] |= 1u << (c1 - 96);
          if (cur < 32) mk[0] |= 1u << cur; else if (cur < 64) mk[1] |= 1u << (cur - 32); else if (cur < 96) mk[2] |= 1u << (cur - 64); else mk[3] |= 1u << (cur - 96); }
#pragma unroll
        for (int i = 0; i < 13; ++i) { const int j = 127 - (key[i] & 0x7f); const unsigned bit = (key[i] != 0) ? (1u << (j & 31)) : 0u; const int wd = j >> 5;
            mk[0] |= (wd == 0) ? bit : 0u; mk[1] |= (wd == 1) ? bit : 0u; mk[2] |= (wd == 2) ? bit : 0u; mk[3] |= (wd == 3) ? bit : 0u; }
#pragma unroll
        for (int i = 0; i < 4; ++i) { unsigned u = mk[i]; u |= (unsigned)__shfl_xor((int)u, 8); u |= (unsigned)__shfl_xor((int)u, 16); u |= (unsigned)__shfl_xor((int)u, 32); un[i] = u;
            mym[i] = (unsigned)__shfl((int)mk[i], 8 * ti); }
    }
    float q2 = 0.f;
#pragma unroll
    for (int ks = 0; ks < 4; ++ks) { const v4u qw = __builtin_bit_cast(v4u, qf[ks]); const unsigned ww[4] = {qw.x, qw.y, qw.z, qw.w};
#pragma unroll
        for (int k = 0; k < 4; ++k) { const float a = bflo(ww[k]), c = bfhi(ww[k]); q2 += a * a + c * c; } }
    q2 = addswap32_f(q2);
    const unsigned* KMX = (const unsigned*)(ws + WS_CTL) + CW_KMAX + (b * 2 + kvh) * 2;
    const float Ms = __builtin_amdgcn_sqrtf(q2 * __builtin_bit_cast(float, KMX[0])) * 1.0001f + 1e-3f, Mw = __builtin_amdgcn_sqrtf(q2 * __builtin_bit_cast(float, KMX[1])) * 1.0001f + 1e-3f;
    const bool fixed_ok = !__any(Ms >= 60.f || Mw >= 60.f);
    {
        AttnSt st; st.m = -1e30f; st.l = 0.f; st.o[0] = f32x16{}; st.o[1] = f32x16{};
        const bf16* KS = (const bf16*)(ws + WS_KSF) + (size_t)(b * 2 + kvh) * 256 * 2048; const unsigned char* VS = ws + WS_VSF + (size_t)(b * 2 + kvh) * 256 * 2048;
        const unsigned lo16 = 16u * (unsigned)lane;
        unsigned um0 = (unsigned)__builtin_amdgcn_readfirstlane((int)un[0]), um1 = (unsigned)__builtin_amdgcn_readfirstlane((int)un[1]), um2 = (unsigned)__builtin_amdgcn_readfirstlane((int)un[2]), um3 = (unsigned)__builtin_amdgcn_readfirstlane((int)un[3]);
#define NEXT_BLOCK(jv) do { if (um0) { jv = __builtin_ctz(um0); um0 &= um0 - 1u; } else if (um1) { jv = 32 + __builtin_ctz(um1); um1 &= um1 - 1u; } else if (um2) { jv = 64 + __builtin_ctz(um2); um2 &= um2 - 1u; } \
            else if (um3) { jv = 96 + __builtin_ctz(um3); um3 &= um3 - 1u; } else jv = -1; } while (0)
#define SLC_LOOP(FX) do { f32x16 negm; _Pragma("unroll") for (int r = 0; r < 16; ++r) negm[r] = -Ms; \
        KVF8 fa, fb; int j; NEXT_BLOCK(j); \
        if (j >= 0) kv_load8(fa, KS + (size_t)j * 4096, VS + (size_t)j * 4096, lo16); \
        while (j >= 0) { const int key0 = j * 64; \
            const unsigned mw = (j < 32) ? mym[0] : (j < 64) ? mym[1] : (j < 96) ? mym[2] : mym[3]; const bool sel = (mw >> (j & 31)) & 1u; \
            kv_load8(fb, KS + (size_t)j * 4096 + 2048, VS + (size_t)j * 4096 + 2048, lo16); \
            if (j == cur) attn_compute<2, FX>(fa, qf, negm, sel, [&](int r) { return sel && (key0 + crow(r, hi) <= t); }, st); \
            else attn_compute<1, FX>(fa, qf, negm, sel, [&](int) { return true; }, st); \
            int jn; NEXT_BLOCK(jn); \
            if (jn >= 0) kv_load8(fa, KS + (size_t)jn * 4096, VS + (size_t)jn * 4096, lo16); \
            if (j == cur) attn_compute<2, FX>(fb, qf, negm, sel, [&](int r) { return sel && (key0 + 32 + crow(r, hi) <= t); }, st); \
            else attn_compute<1, FX>(fb, qf, negm, sel, [&](int) { return true; }, st); \
            j = jn; } } while (0)
        if (fixed_ok) SLC_LOOP(true); else SLC_LOOP(false);
#undef SLC_LOOP
#undef NEXT_BLOCK
        const float l = addswap32_f(st.l); const float sc = gate_s / l;
#pragma unroll
        for (int dt = 0; dt < 2; ++dt)
#pragma unroll
            for (int r = 0; r < 16; ++r) oacc[(dt * 16 + r) * 64] += sc * st.o[dt][r];
    }
    f32x16 outv[2];
    {
        AttnSt st; st.m = -1e30f; st.l = 0.f; st.o[0] = f32x16{}; st.o[1] = f32x16{};
        const bf16* KW = (const bf16*)(ws + WS_KWF) + (size_t)(b * 2 + kvh) * 256 * 2048; const unsigned char* VW = ws + WS_VWF + (size_t)(b * 2 + kvh) * 256 * 2048;
        const unsigned lo16 = 16u * (unsigned)lane;
        const int klo = (t0 - 511 > 0) ? ((t0 - 511) & ~31) : 0, khi = (t0 + 7) & ~31;
#define WIN_LOOP(FX) do { f32x16 negm; _Pragma("unroll") for (int r = 0; r < 16; ++r) negm[r] = -Mw; \
        KVF8 fa, fb; kv_load8(fa, KW + (size_t)klo * 64, VW + (size_t)klo * 64, lo16); \
        _Pragma("unroll 1") for (int key0 = klo; key0 <= khi; key0 += 32) { \
            if (key0 + 32 <= khi) kv_load8(fb, KW + (size_t)(key0 + 32) * 64, VW + (size_t)(key0 + 32) * 64, lo16); \
            if (key0 + 31 > t0 || key0 <= t0 + 7 - 512) attn_compute<2, FX>(fa, qf, negm, true, [&](int r) { const int kp = key0 + crow(r, hi); return kp <= t && kp > t - 512; }, st); \
            else attn_compute<0, FX>(fa, qf, negm, true, [&](int) { return true; }, st); \
            if (key0 + 32 <= khi) fa = fb; } } while (0)
        if (fixed_ok) WIN_LOOP(true); else WIN_LOOP(false);
#undef WIN_LOOP
        const float l = addswap32_f(st.l); const float sc = gate_w / l;
#pragma unroll
        for (int dt = 0; dt < 2; ++dt)
#pragma unroll
            for (int r = 0; r < 16; ++r) outv[dt][r] = oacc[(dt * 16 + r) * 64] + sc * st.o[dt][r];
    }
    float ss = 0.f;
#pragma unroll
    for (int dt = 0; dt < 2; ++dt)
#pragma unroll
        for (int r = 0; r < 16; ++r) ss += outv[dt][r] * outv[dt][r];
    ss += __shfl_xor(ss, 32); ss += __shfl_xor(ss, 8); ss += __shfl_xor(ss, 16);
    if (lane < 8) ((float*)(ws + WS_SSQN))[(rowb + t0 + lane) * 2 + kvh] = ss;
    bf16* Yp = (bf16*)(ws + WS_Y) + (rowb + t) * DM + (kvh * 4 + g) * 64 + 4 * hi;
#pragma unroll
    for (int dt = 0; dt < 2; ++dt)
#pragma unroll
        for (int q = 0; q < 4; ++q) { v2u o; o.x = pk2(outv[dt][4 * q], outv[dt][4 * q + 1]); o.y = pk2(outv[dt][4 * q + 2], outv[dt][4 * q + 3]); *(v2u*)(Yp + 32 * dt + 8 * q) = o; }
}
__device__ __forceinline__ void memattn_item(const Frame& F, const Args& A, int item) {
    unsigned char* ws = A.ws;
    const int lane = F.lane, r32 = lane & 31, hi = lane >> 5;
    const int h = item & 3, tile = item >> 2; const size_t row0 = (size_t)tile * 32; const int b = (int)(row0 >> 13);
    const bf16* Q = (const bf16*)(ws + WS_QM) + (size_t)tile * 32 * DM + (size_t)(h * 16) * 512 + 8 * lane;
    const bf16* K = (const bf16*)(ws + WS_MEMK) + (size_t)(b * 8) * 32 * DM + (size_t)(h * 16) * 512 + 8 * lane;
    const bf16* VF = (const bf16*)(ws + WS_MEMVT) + (size_t)((b * 4 + h) * 8) * 8192 + 8 * lane;
    f32x16 s[8];
#pragma unroll
    for (int kt = 0; kt < 8; ++kt) s[kt] = f32x16{};
#define QK_LOAD(qv, kv, ks_) do { const int kk_ = (ks_) < 16 ? (ks_) : 15; qv = *(const bf16x8*)(Q + 512 * kk_); _Pragma("unroll") for (int kt = 0; kt < 8; ++kt) kv[kt] = *(const bf16x8*)(K + (size_t)kt * 32 * DM + 512 * kk_); } while (0)
#define QK_MMA(qv, kv) do { _Pragma("unroll") for (int kt = 0; kt < 8; ++kt) s[kt] = __builtin_amdgcn_mfma_f32_32x32x16_bf16(kv[kt], qv, s[kt], 0, 0, 0); } while (0)
    { bf16x8 qa, qb, ka[8], kb[8];
      QK_LOAD(qa, ka, 0);
#pragma unroll 1
      for (int ks = 0; ks < 16; ks += 2) {
          QK_LOAD(qb, kb, ks + 1); asm volatile("" ::: "memory");
          QK_MMA(qa, ka);
          QK_LOAD(qa, ka, ks + 2); asm volatile("" ::: "memory");
          QK_MMA(qb, kb); } }
#undef QK_LOAD
#undef QK_MMA
    float m = -1e30f;
#pragma unroll
    for (int kt = 0; kt < 8; ++kt) m = fmaxf(m, max16(s[kt]));
    m = maxswap32_f(m);
    float l = 0.f; v4u pw[8][2];
#pragma unroll
    for (int kt = 0; kt < 8; ++kt) {
#pragma unroll
        for (int r = 0; r < 16; ++r) s[kt][r] = EX2(s[kt][r] - m);
        l += sum16(s[kt]);
#pragma unroll
        for (int s2 = 0; s2 < 2; ++s2) { pw[kt][s2].x = pk2(s[kt][8 * s2], s[kt][8 * s2 + 1]); pw[kt][s2].y = pk2(s[kt][8 * s2 + 2], s[kt][8 * s2 + 3]); pw[kt][s2].z = pk2(s[kt][8 * s2 + 4], s[kt][8 * s2 + 5]); pw[kt][s2].w = pk2(s[kt][8 * s2 + 6], s[kt][8 * s2 + 7]); } }
    l = addswap32_f(l);
    const float invl = 1.0f / l;
    bf16* O = (bf16*)(ws + WS_OM) + (row0 + r32) * DM + h * 256 + 4 * hi;
#define PV_LOAD(vv, dt_) do { const int dd_ = (dt_) < 8 ? (dt_) : 7; _Pragma("unroll") for (int kt = 0; kt < 8; ++kt) _Pragma("unroll") for (int s2 = 0; s2 < 2; ++s2) vv[2 * kt + s2] = *(const bf16x8*)(VF + (size_t)kt * 8192 + dd_ * 1024 + s2 * 512); } while (0)
#define PV_MMA(vv, dt_) do { f32x16 o = f32x16{}; _Pragma("unroll") for (int kt = 0; kt < 8; ++kt) _Pragma("unroll") for (int s2 = 0; s2 < 2; ++s2) o = __builtin_amdgcn_mfma_f32_32x32x16_bf16(vv[2 * kt + s2], __builtin_bit_cast(bf16x8, pw[kt][s2]), o, 0, 0, 0); \
        _Pragma("unroll") for (int q = 0; q < 4; ++q) { v2u ov; ov.x = pk2(o[4 * q] * invl, o[4 * q + 1] * invl); ov.y = pk2(o[4 * q + 2] * invl, o[4 * q + 3] * invl); *(v2u*)(O + 32 * (dt_) + 8 * q) = ov; } } while (0)
    { bf16x8 va[16], vb[16];
      PV_LOAD(va, 0);
#pragma unroll 1
      for (int dt = 0; dt < 8; dt += 2) {
          PV_LOAD(vb, dt + 1); asm volatile("" ::: "memory");
          PV_MMA(va, dt);
          PV_LOAD(va, dt + 2); asm volatile("" ::: "memory");
          PV_MMA(vb, dt + 1); } }
#undef PV_LOAD
#undef PV_MMA
}

__device__ __forceinline__ int f2key(float f) { const int u = __builtin_bit_cast(int, f); return u ^ ((u >> 31) & 0x7fffffff); }
__device__ __forceinline__ float key2f(int k) { const int u = k ^ ((k >> 31) & 0x7fffffff); return __builtin_bit_cast(float, u); }
__device__ __forceinline__ void top16_of_128(f32x16 (&s)[4], int hi, int (&kv)[16]) {
    int key[4][16];
#pragma unroll
    for (int nt = 0; nt < 4; ++nt)
#pragma unroll
        for (int r = 0; r < 16; ++r) key[nt][r] = (f2key(s[nt][r]) & ~0x7f) | (127 - (32 * nt + crow(r, hi)));
#pragma unroll
    for (int nt = 0; nt < 4; ++nt) sort16_desc(key[nt]);
    merge16_desc(key[0], key[1]); merge16_desc(key[2], key[3]); merge16_desc(key[0], key[2]);
    unsigned a[16], b[16];
#pragma unroll
    for (int i = 0; i < 16; ++i) { a[i] = (unsigned)key[0][i]; b[i] = a[i]; swap32(a[i], b[i]); }
#pragma unroll
    for (int i = 0; i < 16; ++i) kv[i] = max((int)a[i], (int)b[15 - i]);
    bitonic16_desc(kv);
}
template <bool LDSK>
__device__ __forceinline__ void peer_topk_item(const Frame& F, const Args& A, int item, const LAS unsigned char* lds) {
    unsigned char* ws = A.ws;
    int lane = lane_id(); asm volatile("" : "+v"(lane));
    const int r32 = lane & 31, hi = lane >> 5;
    const int h = item & 7, tile = item >> 3; const size_t row = (size_t)tile * 32 + r32;
    const bf16* QP = (const bf16*)(ws + WS_QP) + (size_t)tile * 32 * 2048 + (size_t)(h * 16) * 512 + 8 * lane;
    int k1[16], k2[16];
#pragma unroll
    for (int i = 0; i < 16; ++i) { k1[i] = 0; k2[i] = 0; }
#pragma unroll 1
    for (int c = 0; c < 2; ++c) {
        const bf16* SK = (const bf16*)(ws + WS_SKEY) + (size_t)((h * 2 + c) * 4) * 4096 + 8 * lane;
        f32x16 s[4];
#pragma unroll
        for (int nt = 0; nt < 4; ++nt) s[nt] = f32x16{};
        bf16x8 qf[8];
#pragma unroll
        for (int ks = 0; ks < 8; ++ks) qf[ks] = *(const bf16x8*)(QP + (size_t)(c * 8 + ks) * 512);
#pragma unroll
        for (int ks = 0; ks < 8; ++ks) {
#pragma unroll
            for (int nt = 0; nt < 4; ++nt) { const bf16x8 kf = LDSK ? *(const LAS bf16x8*)(lds + ((c * 4 + nt) * 4096 + ks * 512) * 2 + lane * 16) : *(const bf16x8*)(SK + (size_t)nt * 4096 + ks * 512);
                s[nt] = __builtin_amdgcn_mfma_f32_32x32x16_bf16(kf, qf[ks], s[nt], 0, 0, 0); } }
        if (c == 0) top16_of_128(s, hi, k1); else top16_of_128(s, hi, k2);
    }
    float v1[16], v2[16];
#pragma unroll
    for (int i = 0; i < 16; ++i) { v1[i] = key2f(k1[i] & ~0x7f); v2[i] = key2f(k2[i] & ~0x7f); }
    int ck[32];
    {
        int idx = 0;
#pragma unroll
        for (int i = 0; i < 32; ++i) ck[i] = (int)0x80000000;
#pragma unroll
        for (int a = 0; a < 16; ++a)
#pragma unroll
            for (int bq = 0; bq < 16; ++bq) if ((a + 1) * (bq + 1) <= 16) {
                const int flat = a * 16 + bq; const int kk = (f2key(v1[a] + v2[bq]) & ~0xff) | (255 - flat);
                if ((idx & 1) == hi) ck[idx >> 1] = kk;
                ++idx; }
    }
    sort32_desc(ck);
    int tk[16];
    { unsigned a[16], b[16];
#pragma unroll
      for (int i = 0; i < 16; ++i) { a[i] = (unsigned)ck[i]; b[i] = a[i]; swap32(a[i], b[i]); }
#pragma unroll
      for (int i = 0; i < 16; ++i) tk[i] = max((int)a[i], (int)b[15 - i]);
      bitonic16_desc(tk); }
    int te[16];
    { LAS int* tab = (LAS int*)(lds + 65536 + F.wave * 8448) + lane * 33;
#pragma unroll
      for (int i = 0; i < 16; ++i) { tab[i] = 127 - (k1[i] & 0x7f); tab[16 + i] = 127 - (k2[i] & 0x7f); }
      asm volatile("s_waitcnt lgkmcnt(0)" ::: "memory");
#pragma unroll
      for (int i = 0; i < 16; ++i) { const int flat = 255 - (tk[i] & 0xff); te[i] = tab[flat >> 4] * 128 + tab[16 + (flat & 15)]; }
      asm volatile("s_waitcnt lgkmcnt(0)" ::: "memory"); }
    float gsm[16]; const float mx = key2f(tk[0] & ~0xff); float den = 0.f;
#pragma unroll
    for (int i = 0; i < 16; ++i) { gsm[i] = __expf(key2f(tk[i] & ~0xff) - mx); den += gsm[i]; }
    const float inv = 1.0f / den;
    if (hi == 0) {
        int* EID = (int*)(ws + WS_EID) + row * 128 + h * 16; float* GW = (float*)(ws + WS_GW) + row * 128 + h * 16;
#pragma unroll
        for (int q = 0; q < 4; ++q) { *(v4u*)(EID + 4 * q) = (v4u){(unsigned)te[4 * q], (unsigned)te[4 * q + 1], (unsigned)te[4 * q + 2], (unsigned)te[4 * q + 3]};
            *(f32x4*)(GW + 4 * q) = (f32x4){gsm[4 * q] * inv, gsm[4 * q + 1] * inv, gsm[4 * q + 2] * inv, gsm[4 * q + 3] * inv}; }
    }
}

typedef float f32x2 __attribute__((ext_vector_type(2)));
__device__ __forceinline__ float dot16_fp8(const v4u u, const f32x2 (&xn)[8]) {
    f32x2 a0 = {0.f, 0.f}, a1 = {0.f, 0.f};
#pragma unroll
    for (int j = 0; j < 4; ++j) { const f32x2 lo = __builtin_amdgcn_cvt_pk_f32_fp8((int)u[j], false), hi = __builtin_amdgcn_cvt_pk_f32_fp8((int)u[j], true);
        a0 = __builtin_elementwise_fma(lo, xn[2 * j], a0); a1 = __builtin_elementwise_fma(hi, xn[2 * j + 1], a1); }
    return (a0.x + a0.y) + (a1.x + a1.y);
}
__device__ __forceinline__ void axpy16_fp8(f32x2 (&acc)[8], const float w, const v4u u) {
    const f32x2 w2 = {w, w};
#pragma unroll
    for (int j = 0; j < 4; ++j) { const f32x2 lo = __builtin_amdgcn_cvt_pk_f32_fp8((int)u[j], false), hi = __builtin_amdgcn_cvt_pk_f32_fp8((int)u[j], true);
        acc[2 * j] = __builtin_elementwise_fma(lo, w2, acc[2 * j]); acc[2 * j + 1] = __builtin_elementwise_fma(hi, w2, acc[2 * j + 1]); }
}
#define TIE_ROW(val, nxt) asm volatile("" : "+v"(val), "+v"((nxt).x), "+v"((nxt).y), "+v"((nxt).z), "+v"((nxt).w))
constexpr int PQ_CHUNK = 128, PQ_NCHUNK = MTOK / PQ_CHUNK;
constexpr int CW_NQ = 10240;
constexpr int CW_PQ = 8192;
__device__ __forceinline__ int pq_pop(unsigned* ctl, int pass, int own, int& q_s, LAS int* bc, int wave) {
    __syncthreads();
    if (wave == 0 && lane_id() == 0) { int res = -1; int s = q_s;
        while (s < 8) { const int x = (own + s) & 7; const unsigned c = __hip_atomic_fetch_add(ctl + CW_PQ + 64 * (8 * pass + x), 1u, __ATOMIC_RELAXED, __HIP_MEMORY_SCOPE_AGENT);
            if (c < (unsigned)PQ_NCHUNK) { res = x * PQ_NCHUNK + (int)c; break; } ++s; }
        bc[0] = res; bc[1] = s; }
    __syncthreads();
    q_s = bc[1]; return bc[0];
}
template <int CTRL> __device__ __forceinline__ float dppf(float v) { return __builtin_bit_cast(float, __builtin_amdgcn_mov_dpp(__builtin_bit_cast(int, v), CTRL, 0xf, 0xf, true)); }
__device__ __forceinline__ float red8(float d) { d += dppf<0xB1>(d); d += dppf<0x4E>(d); d += dppf<0x141>(d); return d; }
__device__ __forceinline__ void peer_issue8(v4u (&rb)[8], const v4u ia, const v4u ib, const unsigned char* T  , unsigned c16) {
    const unsigned e[8] = {ia.x, ia.y, ia.z, ia.w, ib.x, ib.y, ib.z, ib.w};
#pragma unroll
    for (int i = 0; i < 8; ++i) rb[i] = *(const v4u*)(T + (e[i] * 128u + c16));
}
__device__ __forceinline__ void peer_u_chunk(const Frame& F, const Args& A, int x, int chunk) {
    unsigned char* ws = A.ws; int lane = lane_id(); asm volatile("" : "+v"(lane));
    const int tk = lane >> 3, c8 = lane & 7;
    const unsigned char* U = ws + WS_U8 + (size_t)x * 16384 * 128; const unsigned c16 = 16u * (unsigned)c8;
#pragma unroll 1
    for (int oc = 0; oc < 2; ++oc) {
        const unsigned row = (unsigned)(chunk * PQ_CHUNK + F.wave * 16 + oc * 8 + tk);
        const unsigned char* EIDb = ws + WS_EID; const unsigned eoff = row * 512u;
#define EID_LD(i_) (*(const v4u*)(EIDb + (eoff + 16u * (unsigned)(i_))))
        f32x2 xn[8];
        { const unsigned char* xb_ = ws + WS_XN; const unsigned xo = row * 2048u + 256u * (unsigned)x + 32u * (unsigned)c8; const v4u xa = *(const v4u*)(xb_ + xo), xb = *(const v4u*)(xb_ + (xo + 16u));
          const unsigned xw[8] = {xa.x, xa.y, xa.z, xa.w, xb.x, xb.y, xb.z, xb.w};
#pragma unroll
          for (int j = 0; j < 8; ++j) { xn[j].x = bflo(xw[j]); xn[j].y = bfhi(xw[j]); } }
        float rstd; { const f32x4* sp = (const f32x4*)(ws + WS_SSQ2 + (size_t)row * 64); const f32x4 a = sp[0], b = sp[1], c = sp[2], d = sp[3];
            rstd = rsqrtf((((a.x + a.y) + (a.z + a.w)) + ((b.x + b.y) + (b.z + b.w)) + ((c.x + c.y) + (c.z + c.w)) + ((d.x + d.y) + (d.z + d.w))) * (1.f / DM) + EPS); }
        unsigned char* ppb = ws + WS_PART; const unsigned po = ((unsigned)x * MTOK + row) * 256u + 32u * (unsigned)c8;
        v4u ra[8], rb[8]; v4u ia0 = EID_LD(0), ia1 = EID_LD(1), ib0 = EID_LD(2), ib1 = EID_LD(3);
        peer_issue8(ra, ia0, ia1, U, c16); ia0 = EID_LD(4); ia1 = EID_LD(5);
#pragma unroll 1
        for (int q = 0; q < 16; q += 2) {
            peer_issue8(rb, ib0, ib1, U, c16); { const int qn = (q + 3 < 16) ? q + 3 : 15; ib0 = EID_LD(2 * qn); ib1 = EID_LD(2 * qn + 1); }
            float k0 = 0.f, k1 = 0.f;
#pragma unroll
            for (int i = 0; i < 8; ++i) { float d = dot16_fp8(ra[i], xn); if (i < 7) TIE_ROW(d, ra[i + 1]); d = red8(d); k0 = (c8 == i) ? d : k0; }
            peer_issue8(ra, ia0, ia1, U, c16); { const int qn = (q + 4 < 16) ? q + 4 : 15; ia0 = EID_LD(2 * qn); ia1 = EID_LD(2 * qn + 1); }
#pragma unroll
            for (int i = 0; i < 8; ++i) { float d = dot16_fp8(rb[i], xn); if (i < 7) TIE_ROW(d, rb[i + 1]); d = red8(d); k1 = (c8 == i) ? d : k1; }
            *(unsigned*)(ppb + (po + 2u * (unsigned)q)) = pk2(k0 * rstd, k1 * rstd);
        }
    }
}
__device__ __forceinline__ void peer_w_rows(const Frame& F, const Args& A) {
    unsigned char* ws = A.ws; const int lane = lane_id();
    const float* SU = (const float*)(ws + WS_SU); const float* SV = (const float*)(ws + WS_SV);
    const int p0 = 2 * lane, k0 = 8 * (p0 & 15) + (p0 >> 4), k1 = k0 + 8;
    for (int m0 = F.gw; m0 < MTOK; m0 += 4 * F.NGW) {
        int e0[4], e1[4]; float g0[4], g1[4]; unsigned pw[4][8];
#pragma unroll
        for (int r = 0; r < 4; ++r) { const size_t row = (size_t)(m0 + r * F.NGW < MTOK ? m0 + r * F.NGW : m0);
            const int* EID = (const int*)(ws + WS_EID) + row * 128; const float* GW = (const float*)(ws + WS_GW) + row * 128;
            e0[r] = EID[k0]; e1[r] = EID[k1]; g0[r] = GW[k0]; g1[r] = GW[k1];
#pragma unroll
            for (int x = 0; x < 8; ++x) pw[r][x] = *(const unsigned*)((const bf16*)(ws + WS_PART) + ((size_t)x * MTOK + row) * 128 + p0); }
        float su0[4], su1[4], sv0[4], sv1[4];
#pragma unroll
        for (int r = 0; r < 4; ++r) { su0[r] = SU[e0[r]]; su1[r] = SU[e1[r]]; sv0[r] = SV[e0[r]]; sv1[r] = SV[e1[r]]; }
#pragma unroll
        for (int r = 0; r < 4; ++r) { if (m0 + r * F.NGW < MTOK) { const size_t row = (size_t)(m0 + r * F.NGW); float s0 = 0.f, s1 = 0.f;
#pragma unroll
            for (int x = 0; x < 8; ++x) { s0 += bflo(pw[r][x]); s1 += bfhi(pw[r][x]); }
            float* W = (float*)(ws + WS_W) + row * 128;
            W[k0] = gelu_tanh(s0 * su0[r]) * g0[r] * sv0[r]; W[k1] = gelu_tanh(s1 * su1[r]) * g1[r] * sv1[r]; } }
    }
}
__device__ __forceinline__ void peer_v_chunk(const Frame& F, const Args& A, int x, int chunk) {
    unsigned char* ws = A.ws; int lane = lane_id(); asm volatile("" : "+v"(lane));
    const int tk = lane >> 3, c8 = lane & 7;
    const unsigned char* V = ws + WS_V8 + (size_t)x * 16384 * 128; const unsigned c16 = 16u * (unsigned)c8;
#pragma unroll 1
    for (int oc = 0; oc < 2; ++oc) {
        const unsigned row = (unsigned)(chunk * PQ_CHUNK + F.wave * 16 + oc * 8 + tk);
        const unsigned char* EIDb = ws + WS_EID; const unsigned char* Wb = ws + WS_W; const unsigned eoff = row * 512u;
#define W_LD(i_) (*(const f32x4*)(Wb + (eoff + 16u * (unsigned)(i_))))
        f32x2 acc[8];
#pragma unroll
        for (int j = 0; j < 8; ++j) acc[j] = (f32x2){0.f, 0.f};
        v4u ra[8], rb[8]; v4u ia0 = EID_LD(0), ia1 = EID_LD(1), ib0 = EID_LD(2), ib1 = EID_LD(3); f32x4 wa0 = W_LD(0), wa1 = W_LD(1), wb0 = W_LD(2), wb1 = W_LD(3);
        peer_issue8(ra, ia0, ia1, V, c16); ia0 = EID_LD(4); ia1 = EID_LD(5);
#pragma unroll 1
        for (int q = 0; q < 16; q += 2) {
            peer_issue8(rb, ib0, ib1, V, c16); { const int qn = (q + 3 < 16) ? q + 3 : 15; ib0 = EID_LD(2 * qn); ib1 = EID_LD(2 * qn + 1); }
            { const float wv[8] = {wa0.x, wa0.y, wa0.z, wa0.w, wa1.x, wa1.y, wa1.z, wa1.w};
#pragma unroll
              for (int i = 0; i < 8; ++i) { axpy16_fp8(acc, wv[i], ra[i]); if (i < 7) TIE_ROW(acc[7].y, ra[i + 1]); } }
            { const int qn = (q + 2 < 16) ? q + 2 : 15; wa0 = W_LD(2 * qn); wa1 = W_LD(2 * qn + 1); }
            peer_issue8(ra, ia0, ia1, V, c16); { const int qn = (q + 4 < 16) ? q + 4 : 15; ia0 = EID_LD(2 * qn); ia1 = EID_LD(2 * qn + 1); }
            { const float wv[8] = {wb0.x, wb0.y, wb0.z, wb0.w, wb1.x, wb1.y, wb1.z, wb1.w};
#pragma unroll
              for (int i = 0; i < 8; ++i) { axpy16_fp8(acc, wv[i], rb[i]); if (i < 7) TIE_ROW(acc[7].y, rb[i + 1]); } }
            { const int qn = (q + 3 < 16) ? q + 3 : 15; wb0 = W_LD(2 * qn); wb1 = W_LD(2 * qn + 1); }
        }
        unsigned char* xr = ws + WS_XN + (row * 2048u + 256u * (unsigned)x + 32u * (unsigned)c8); float ss = 0.f;
        const v4u x2a = *(const v4u*)xr, x2b = *(const v4u*)(xr + 16);
        const unsigned xw[8] = {x2a.x, x2a.y, x2a.z, x2a.w, x2b.x, x2b.y, x2b.z, x2b.w};
        unsigned ow[8];
#pragma unroll
        for (int j = 0; j < 4; ++j) { f32x4 v; v.x = bflo(xw[2 * j]) + acc[2 * j].x; v.y = bfhi(xw[2 * j]) + acc[2 * j].y; v.z = bflo(xw[2 * j + 1]) + acc[2 * j + 1].x; v.w = bfhi(xw[2 * j + 1]) + acc[2 * j + 1].y;
            ss += (v.x * v.x + v.y * v.y) + (v.z * v.z + v.w * v.w); ow[2 * j] = pk2(v.x, v.y); ow[2 * j + 1] = pk2(v.z, v.w); }
        *(v4u*)xr = (v4u){ow[0], ow[1], ow[2], ow[3]}; *(v4u*)(xr + 16) = (v4u){ow[4], ow[5], ow[6], ow[7]};
        ss = red8(ss);
        if (c8 == 0) ((float*)(ws + WS_SSQ3))[row * 8 + x] = ss;
    }
#undef W_LD
#undef EID_LD
}
__device__ __forceinline__ void peer_final_rows(const Frame& F, const Args& A) {
    unsigned char* ws = A.ws; const int lane = lane_id(); const float* g = A.in[32];
    for (int m = F.gw; m < MTOK; m += F.NGW) {
        const f32x4 sa = *(const f32x4*)((const float*)(ws + WS_SSQ3) + (size_t)m * 8), sb = *(const f32x4*)((const float*)(ws + WS_SSQ3) + (size_t)m * 8 + 4);
        const float rstd = rsqrtf((((sa.x + sa.y) + (sa.z + sa.w)) + ((sb.x + sb.y) + (sb.z + sb.w))) * (1.f / DM) + EPS);
        f32x4* xr = (f32x4*)(A.out + (size_t)m * DM) + lane; const v2u* xb = (const v2u*)((const bf16*)(ws + WS_XN) + (size_t)m * DM) + lane;
#pragma unroll
        for (int j = 0; j < 4; ++j) { const v2u w = xb[64 * j]; const f32x4 gg = ((const f32x4*)g)[lane + 64 * j]; const f32x4 v = {bflo(w.x), bfhi(w.x), bflo(w.y), bfhi(w.y)}; xr[64 * j] = v * rstd * gg; }
    }
}

typedef GAS unsigned gu32;
#define RLX_AGENT __ATOMIC_RELAXED, __HIP_MEMORY_SCOPE_AGENT
#define XB_TMO      128
#define XB_XCNT(j)  (256  + 64 * (j))
#define XB_XSUB(j)  (1280 + 64 * (j))
#define XB_XGEN(j)  (2304 + 64 * (j))
#define XB_TOP      3328
#define XB_TOPGEN   3392
#define XCD_BAR_WORDS 3456
#define XB_SPIN_CAP (1u << 18)

__device__ __forceinline__ unsigned xb_ld(unsigned* p)              { return __hip_atomic_load(p, __ATOMIC_RELAXED, __HIP_MEMORY_SCOPE_AGENT); }
__device__ __forceinline__ unsigned xb_add(unsigned* p, unsigned v) { return __hip_atomic_fetch_add(p, v, __ATOMIC_RELAXED, __HIP_MEMORY_SCOPE_AGENT); }
__device__ __forceinline__ unsigned xb_xcc_id() { return (unsigned)__builtin_amdgcn_s_getreg((3 << 11) | 20) & 0xFu; }
#define XB_SPIN(cond, bar) do { unsigned _sp = 0; while (cond) { __builtin_amdgcn_s_sleep(1); \
    if ((++_sp & 255u) == 0u) { if (xb_ld(&(bar)[XB_TMO])) break; if (_sp > XB_SPIN_CAP) { atomicAdd(&(bar)[XB_TMO], 1u); break; } } } } while (0)

struct XcdBarrier {
    unsigned* bar; unsigned x;
    volatile LAS unsigned* st;
};

__device__ __forceinline__ XcdBarrier xcd_barrier_post(unsigned* bar, volatile LAS unsigned* st) {
    XcdBarrier b; b.bar = bar; b.x = xb_xcc_id(); b.st = st;
    if (threadIdx.x == 0) (void)xb_add(&bar[XB_XCNT(b.x)], 1u);
    return b;
}
__device__ __forceinline__ void xcd_barrier_complete(unsigned* bar, unsigned x, unsigned& nloc, unsigned& nx) {
    const unsigned G = gridDim.x * gridDim.y * gridDim.z;
    unsigned sum, cnt, mine, sp = 0u;
    for (;;) {
        sum = 0u; cnt = 0u; mine = 0u;
#pragma unroll
        for (unsigned j = 0; j < 16; ++j) { const unsigned c = xb_ld(&bar[XB_XCNT(j)]); sum += c; cnt += (c > 0u) ? 1u : 0u; mine = (j == x) ? c : mine; }
        if (sum == G) break;
        __builtin_amdgcn_s_sleep(1);
        if ((++sp & 255u) == 0u) { if (xb_ld(&bar[XB_TMO])) break; if (sp > XB_SPIN_CAP) { atomicAdd(&bar[XB_TMO], 1u); break; } }
    }
    nloc = mine > 0u ? mine : 1u; nx = cnt > 0u ? cnt : 1u;
}

__device__ __forceinline__ void xcd_barrier(const XcdBarrier& b) {
    asm volatile("s_waitcnt vmcnt(0)" ::: "memory");
    __syncthreads();
    if (threadIdx.x == 0) {
        unsigned* bar = b.bar;
        __builtin_amdgcn_s_waitcnt(0);
        unsigned nloc = b.st[0], nx = b.st[1];
        if (nloc == 0u) { xcd_barrier_complete(bar, b.x, nloc, nx); b.st[0] = nloc; b.st[1] = nx; }
        const unsigned old = xb_add(&bar[XB_XSUB(b.x)], 1u);
        const unsigned gen = old / nloc;
        if (old + 1u == (gen + 1u) * nloc) {
            __builtin_amdgcn_fence(__ATOMIC_RELEASE, "agent");
            asm volatile("s_waitcnt vmcnt(0)" ::: "memory");
            const unsigned og = xb_add(&bar[XB_TOP], 1u);
            const unsigned tg = og / nx;
            if (og + 1u == (tg + 1u) * nx) xb_add(&bar[XB_TOPGEN], 1u);
            else XB_SPIN(xb_ld(&bar[XB_TOPGEN]) == tg, bar);
            __builtin_amdgcn_fence(__ATOMIC_ACQUIRE, "agent");
            xb_add(&bar[XB_XGEN(b.x)], 1u);
            asm volatile("s_waitcnt vmcnt(0)" ::: "memory");
        } else {
            XB_SPIN(xb_ld(&bar[XB_XGEN(b.x)]) == gen, bar);
            __builtin_amdgcn_fence(__ATOMIC_ACQUIRE, "agent");
            asm volatile("s_waitcnt vmcnt(0)" ::: "memory");
        }
    }
    __syncthreads();
}

#ifndef DBL_MASK
#define DBL_MASK 0
#endif
constexpr int NPHASE = 12;
__global__ void __launch_bounds__(512, 2) fwd_kernel(Args args) {
    extern __shared__ __attribute__((aligned(16))) unsigned char lds_raw[];
    LAS unsigned char* lds = (LAS unsigned char*)lds_raw;
    Frame F;
    F.tid = threadIdx.x; F.lane = F.tid & 63; F.wave = __builtin_amdgcn_readfirstlane(F.tid >> 6);
    F.G = gridDim.x; { const int bx = blockIdx.x; F.vcu = (F.G % 8 == 0) ? (bx % 8) * (F.G / 8) + bx / 8 : bx; }
    F.gw = F.vcu * 8 + F.wave; F.NGW = F.G * 8;
    unsigned char* ws = args.ws;
    const int lo = args.ph_lo, hi = args.ph_hi;
    volatile LAS unsigned* MISC = (volatile LAS unsigned*)(lds + LDS_BYTES - 64);
    if (F.tid < 16) MISC[F.tid] = 0u;
    __syncthreads();
    XcdBarrier bar = xcd_barrier_post((unsigned*)(ws + WS_CTL), MISC);
#define IN(k) (lo <= (k) && (k) < hi)
#define SEAM(k) do { if (IN(k) && IN((k) + 1)) xcd_barrier(bar); } while (0)

    if (IN(0)) for (int rep_ = 0; rep_ <= ((DBL_MASK >> 0) & 1); ++rep_) { if (rep_) xcd_barrier(bar); REFRESH_LANE(F); p0_prologue(F, args, lds); }
    SEAM(0);
    if (IN(1)) for (int rep_ = 0; rep_ <= ((DBL_MASK >> 1) & 1); ++rep_) { if (rep_) xcd_barrier(bar); REFRESH_LANE(F);
        { pg8::Gemm g{(const bf16*)(ws + WS_XN), (const bf16*)(ws + WS_WIN), MTOK, NZP, DM}; pg8::StaticOrder S; S.init(MTOK, NZP, F.G, (int)blockIdx.x);
          pg8::EpiZ E{(bf16*)(ws + WS_Z), (bf16*)(ws + WS_KSF), (bf16*)(ws + WS_VSF), (bf16*)(ws + WS_KWF), (bf16*)(ws + WS_VWF), (float*)(ws + WS_GATES), args.in[4]};
          pg8::gemm_phase<pg8::EpiZ, pg8::StaticOrder, true, true>(lds, g, S, E, F.wave); }
        { pg8::Gemm g{(const bf16*)(ws + WS_MEMN), (const bf16*)(ws + WS_WMK), NB * NMEM, DM, DM}; pg8::StaticOrder S; S.init(NB * NMEM, DM, F.G, ((int)blockIdx.x + 128) & 255);
          pg8::EpiStore E{(bf16*)(ws + WS_MEMK), DM, nullptr, 1};
          pg8::gemm_phase<pg8::EpiStore, pg8::StaticOrder, true, true>(lds, g, S, E, F.wave); }
        { pg8::Gemm g{(const bf16*)(ws + WS_WMV), (const bf16*)(ws + WS_MEMN), DM, NB * NMEM, DM}; pg8::StaticOrder S; S.init(DM, NB * NMEM, F.G, ((int)blockIdx.x + 120) & 255);
          pg8::EpiVFrag E{(bf16*)(ws + WS_MEMVT)};
          pg8::gemm_phase<pg8::EpiVFrag, pg8::StaticOrder, true, true>(lds, g, S, E, F.wave); }
    }
    SEAM(1);
    if (IN(2)) for (int rep_ = 0; rep_ <= ((DBL_MASK >> 2) & 1); ++rep_) { if (rep_) xcd_barrier(bar); REFRESH_LANE(F); for (int it = F.gw; it < 2048; it += F.NGW) kmax_item(F, args, it);
                 for (int it = F.vcu; it < 256; it += F.G) lru_local_item(F, args, lds, it);
                 for (int it = F.G - 1 - F.vcu; it < 128; it += F.G) compress_item(F, args, lds, it); }
    SEAM(2);
    if (IN(3)) for (int rep_ = 0; rep_ <= ((DBL_MASK >> 3) & 1); ++rep_) { if (rep_) xcd_barrier(bar); REFRESH_LANE(F);
                 { unsigned* ctl = (unsigned*)(ws + WS_CTL); const int own = (int)(((long)F.vcu * 8) / F.G) & 7; int qs = 0;
                   for (;;) { int id = -1;
                       if (lane_id() == 0) { while (qs < 8) { const int x = (own + qs) & 7; const unsigned c = __hip_atomic_fetch_add(ctl + CW_NQ + 64 * x, 1u, __ATOMIC_RELAXED, __HIP_MEMORY_SCOPE_AGENT);
                               if (c < 512u) { id = x * 512 + (int)c; break; } ++qs; } }
                       id = __builtin_amdgcn_readfirstlane(id); qs = __builtin_amdgcn_readfirstlane(qs);
                       if (id < 0) break;
                       const int x = id >> 9, i = id & 511; nsa_item(F, args, lds, x >> 2, (x >> 1) & 1, 2 * (63 - (i >> 3)) + (x & 1), 7 - (i & 7)); } }
                 __syncthreads(); REFRESH_LANE(F);
                 for (int it = F.vcu; it < 256; it += F.G) lru_fix_item(F, args, lds, it, false); }
    SEAM(3);
    if (IN(4)) for (int rep_ = 0; rep_ <= ((DBL_MASK >> 4) & 1); ++rep_) { if (rep_) xcd_barrier(bar); REFRESH_LANE(F);
        pg8::Gemm g{(const bf16*)(ws + WS_Y), (const bf16*)(ws + WS_WOUT), MTOK, DM, DM}; pg8::StaticOrder S; S.init(MTOK, DM, F.G, (int)blockIdx.x);
        pg8::EpiRes<true> E{args.in[0], nullptr, nullptr, (bf16*)(ws + WS_XN), (float*)(ws + WS_SSQ1), (const float*)(ws + WS_SSQN)};
        pg8::gemm_phase<pg8::EpiRes<true>, pg8::StaticOrder, true, true>(lds, g, S, E, F.wave);
    }
    SEAM(4);
    if (IN(5)) for (int rep_ = 0; rep_ <= ((DBL_MASK >> 5) & 1); ++rep_) { if (rep_) xcd_barrier(bar); REFRESH_LANE(F);
        pg8::Gemm g{(const bf16*)(ws + WS_XN), (const bf16*)(ws + WS_WMQ), MTOK, DM, DM}; pg8::StaticOrder S; S.init(MTOK, DM, F.G, (int)blockIdx.x);
        pg8::EpiStore E{(bf16*)(ws + WS_QM), DM, (const float*)(ws + WS_SSQ1), 1};
        pg8::gemm_phase<pg8::EpiStore, pg8::StaticOrder, true, true>(lds, g, S, E, F.wave);
    }
    SEAM(5);
    if (IN(6)) for (int rep_ = 0; rep_ <= ((DBL_MASK >> 6) & 1); ++rep_) { if (rep_) xcd_barrier(bar); REFRESH_LANE(F); for (int it = F.gw; it < 2048; it += F.NGW) memattn_item(F, args, it); }
    SEAM(6);
    if (IN(7)) for (int rep_ = 0; rep_ <= ((DBL_MASK >> 7) & 1); ++rep_) { if (rep_) xcd_barrier(bar); REFRESH_LANE(F);
        pg8::Gemm g{(const bf16*)(ws + WS_OM), (const bf16*)(ws + WS_WMO), MTOK, DM, DM}; pg8::StaticOrder S; S.init(MTOK, DM, F.G, (int)blockIdx.x);
        pg8::EpiRes<false> E{nullptr, (const bf16*)(ws + WS_XN), nullptr, (bf16*)(ws + WS_XN), (float*)(ws + WS_SSQ2), nullptr};
        pg8::gemm_phase<pg8::EpiRes<false>, pg8::StaticOrder, true, true>(lds, g, S, E, F.wave);
    }
    SEAM(7);
    if (IN(8)) for (int rep_ = 0; rep_ <= ((DBL_MASK >> 8) & 1); ++rep_) { if (rep_) xcd_barrier(bar); REFRESH_LANE(F);
        pg8::Gemm g{(const bf16*)(ws + WS_XN), (const bf16*)(ws + WS_WPQ), MTOK, 2048, DM}; pg8::StaticOrder S; S.init(MTOK, 2048, F.G, (int)blockIdx.x);
        pg8::EpiStore E{(bf16*)(ws + WS_QP), 2048, (const float*)(ws + WS_SSQ2), 1};
        pg8::gemm_phase<pg8::EpiStore, pg8::StaticOrder, true, true>(lds, g, S, E, F.wave);
    }
    SEAM(8);
    if (IN(9)) for (int rep_ = 0; rep_ <= ((DBL_MASK >> 9) & 1); ++rep_) { if (rep_) xcd_barrier(bar); REFRESH_LANE(F); for (int gi = F.vcu; gi < 256; gi += F.G) {
                     const int h = gi & 7, tgp = gi >> 3;
                     { const v4u* src = (const v4u*)((const bf16*)(ws + WS_SKEY) + (size_t)h * 8 * 4096); const int tid = F.wave * 64 + lane_id();
#pragma unroll
                       for (int i = 0; i < 8; ++i) ((LAS v4u*)lds)[tid + 512 * i] = src[tid + 512 * i]; }
                     __syncthreads();
                     peer_topk_item<true>(F, args, (tgp * 16 + F.wave) * 8 + h, lds); peer_topk_item<true>(F, args, (tgp * 16 + 8 + F.wave) * 8 + h, lds);
                     __syncthreads(); } }
    SEAM(9);
    if (IN(10)) {   REFRESH_LANE(F);
        LAS int* bc = (LAS int*)(lds + LDS_BYTES - 128); unsigned* ctl = (unsigned*)(ws + WS_CTL); const int own = (int)(bar.x & 7u);
        { int qs = 0; for (;;) { const int id = __builtin_amdgcn_readfirstlane(pq_pop(ctl, 0, own, qs, bc, F.wave)); if (id < 0) break; peer_u_chunk(F, args, id / PQ_NCHUNK, id % PQ_NCHUNK); } }
        xcd_barrier(bar);
        peer_w_rows(F, args);
        xcd_barrier(bar);
        { int qs = 0; for (;;) { const int id = __builtin_amdgcn_readfirstlane(pq_pop(ctl, 1, own, qs, bc, F.wave)); if (id < 0) break; peer_v_chunk(F, args, id / PQ_NCHUNK, id % PQ_NCHUNK); } }
        xcd_barrier(bar);
        peer_final_rows(F, args);
    }
#undef IN
#undef SEAM
}

extern "C" void kernel_launch(void* const* d_in, const int* in_sizes, int n_in, void* d_out, int out_size, void* d_ws, size_t ws_size, hipStream_t stream) {
    static int grid = 0;
    if (grid == 0) {
        if (n_in != 33 || out_size != MTOK * DM || ws_size < WS_END) { fprintf(stderr, "kernel_launch: unexpected problem (n_in %d, out %d, ws %zu)\n", n_in, out_size, ws_size); grid = -1; return; }
        int dev = 0, cus = 0, per_cu = 0;
        (void)hipGetDevice(&dev); (void)hipDeviceGetAttribute(&cus, hipDeviceAttributeMultiprocessorCount, dev);
        (void)hipFuncSetAttribute((const void*)fwd_kernel, hipFuncAttributeMaxDynamicSharedMemorySize, LDS_BYTES);
        (void)hipOccupancyMaxActiveBlocksPerMultiprocessor(&per_cu, (const void*)fwd_kernel, 512, LDS_BYTES);
        if (per_cu < 1) { fprintf(stderr, "kernel_launch: occupancy query says %d blocks per CU\n", per_cu); per_cu = 1; }
        grid = cus * 1;
        if (grid != 256) fprintf(stderr, "kernel_launch: %d CUs (built for 256)\n", cus);
    }
    if (grid < 0) return;
    (void)hipMemsetAsync((char*)d_ws + WS_CTL, 0, 65536, stream);
    Args a{};
    for (int i = 0; i < 33; ++i) a.in[i] = (const float*)d_in[i];
    a.out = (float*)d_out; a.ws = (unsigned char*)d_ws; a.ph_lo = 0; a.ph_hi = NPHASE;
    void* kargs[] = {&a};
    hipError_t e = hipLaunchCooperativeKernel((const void*)fwd_kernel, dim3(grid), dim3(512), kargs, LDS_BYTES, stream);
    if (e != hipSuccess) fprintf(stderr, "cooperative launch failed: %s (grid %d)\n", hipGetErrorString(e), grid);
}
```

```cpp
#include <hip/hip_runtime.h>
#include <cstdio>
#include <cstdint>

namespace pg8 {
#define PG8_LAS __attribute__((address_space(3)))
typedef unsigned short bf16_t;
typedef short bf16x8 __attribute__((ext_vector_type(8)));
typedef float f32x4 __attribute__((ext_vector_type(4)));
typedef unsigned u32x4 __attribute__((ext_vector_type(4)));
constexpr int BM = 256, BK = 64, HALF = 128, HTB = HALF * BK * 2  , STAGE_BYTES = 8 * HTB, NXCD = 8, WGM = 8;

__host__ __device__ __forceinline__ int lds_byte(int r, int c) { const int st = (r >> 4) * 2 + (c >> 5), rr = r & 15, cc = c & 31, ob = rr * 64 + cc * 2; return st * 1024 + (ob ^ (((ob >> 9) & 1) << 5)); }
__host__ __device__ __forceinline__ void stage_rc(int b, int& R, int& C) { const int st = b / 1024, sb = b % 1024, swz = sb ^ (((sb >> 9) & 1) << 5); R = (st >> 1) * 16 + swz / 64; C = (st & 1) * 32 + (swz % 64) / 2; }
__host__ __device__ __forceinline__ int perm32(int rho) { const int n = rho >> 4, i = rho & 15; return 8 * (i >> 2) + 4 * n + (i & 3); }

struct Unit { int pm, pn; };
struct Gemm { const bf16_t* A; const bf16_t* Bt; int M, N, K; };

struct StaticOrder {
    int nM, nN, nwg, G, c;
    __host__ __device__ void init(int M, int N, int G_, int c_) { nM = M / BM; nN = N / BM; nwg = nM * nN; G = G_; c = c_; }
    __host__ __device__ bool next(int i, Unit& u) const {
        const long L = (long)i * G + c; if (L >= nwg) return false;
        int wgid = (int)L; { const int q = nwg / NXCD, r = nwg % NXCD, xcd = wgid % NXCD, off = wgid / NXCD; wgid = (xcd < r ? xcd * (q + 1) : r * (q + 1) + (xcd - r) * q) + off; }
        const int nig = WGM * nN, gid = wgid / nig, fm = gid * WGM, gsz = (nM - fm) < WGM ? (nM - fm) : WGM;
        u.pm = fm + ((wgid % nig) % gsz); u.pn = (wgid % nig) / gsz; return true;
    }
    __device__ __forceinline__ void a_ready(const Unit&) const {}
    __device__ __forceinline__ void done(const Unit&) const {}
};

__device__ __forceinline__ unsigned cvt_pk_bf16(float lo, float hi) { unsigned r; asm volatile("v_cvt_pk_bf16_f32 %0, %1, %2" : "=v"(r) : "v"(lo), "v"(hi)); return r; }
typedef float f32x2 __attribute__((ext_vector_type(2)));
typedef unsigned u32x2 __attribute__((ext_vector_type(2)));
__device__ __forceinline__ unsigned short f2bf1(float f) { unsigned u = __builtin_bit_cast(unsigned, f); return (unsigned short)((u + 0x7fffu + ((u >> 16) & 1u)) >> 16); }
struct EpiZ {
    static constexpr bool PERM = true, AFTER_DRAIN = false, MIDSCALE = false;
    bf16_t* Z; bf16_t* KSF; bf16_t* VSF; bf16_t* KWF; bf16_t* VWF; float* GATES; const float* bgate;
    __device__ __forceinline__ void operator()(const f32x4 (&acc)[2][2][4][2], const Unit& u, int wr, int wc, int fr, int fq) const {
        const int row0 = u.pm * BM + wr * 64 + fr;
        if (u.pn < 9) {
            const int col0 = u.pn * BM + wc * 32 + 8 * fq;
#pragma unroll
            for (int ai = 0; ai < 2; ++ai)
#pragma unroll
                for (int m = 0; m < 4; ++m) { bf16_t* rowp = Z + (size_t)(row0 + ai * HALF + m * 16) * 2304 + col0;
#pragma unroll
                    for (int bj = 0; bj < 2; ++bj) { const f32x4 v0 = acc[ai][bj][m][0], v1 = acc[ai][bj][m][1];
                        u32x4 w; w.x = cvt_pk_bf16(v0[0], v0[1]); w.y = cvt_pk_bf16(v0[2], v0[3]); w.z = cvt_pk_bf16(v1[0], v1[1]); w.w = cvt_pk_bf16(v1[2], v1[3]);
                        *(u32x4*)(rowp + bj * HALF) = w; } }
            if (u.pn >= 7) {
                bf16_t* KF = (u.pn == 7) ? KSF : KWF; bf16_t* VF = (u.pn == 7) ? VSF : VWF;
                const int kvh = wc >> 1, dbase = 32 * (wc & 1) + 8 * fq;
#pragma unroll
                for (int ai = 0; ai < 2; ++ai)
#pragma unroll
                    for (int m = 0; m < 4; ++m) { const int row = row0 + ai * HALF + m * 16, b = row >> 13, s = row & 8191, tile = s >> 5, k = s & 31;
                        const size_t tb = ((size_t)(b * 2 + kvh) * 256 + tile) * 2048;
                        { const f32x4 v0 = acc[ai][0][m][0], v1 = acc[ai][0][m][1];
                          u32x4 w; w.x = cvt_pk_bf16(v0[0], v0[1]); w.y = cvt_pk_bf16(v0[2], v0[3]); w.z = cvt_pk_bf16(v1[0], v1[1]); w.w = cvt_pk_bf16(v1[2], v1[3]);
                          *(u32x4*)(KF + tb + (dbase >> 4) * 512 + ((dbase >> 3) & 1) * 256 + k * 8) = w; }
                        const int kk = k & 15, vo = ((kk >> 2) & 1) * 512 + (k >> 4) * 8 + (kk & 3) + 4 * (kk >> 3);
                        unsigned char* V8 = (unsigned char*)VF + ((size_t)(b * 2 + kvh) * 256 + tile) * 2048;
#pragma unroll
                        for (int n = 0; n < 2; ++n) { const f32x4 v = acc[ai][1][m][n]; int w = 0; w = __builtin_amdgcn_cvt_pk_fp8_f32(v[0], v[1], w, false); w = __builtin_amdgcn_cvt_pk_fp8_f32(v[2], v[3], w, true);
#pragma unroll
                            for (int e = 0; e < 4; ++e) { const int d = dbase + 4 * n + e; V8[(d >> 5) * 1024 + (d & 31) * 16 + vo] = (unsigned char)((unsigned)w >> (8 * e)); } }
                        asm volatile("" ::: "memory"); }
            }
        } else {
            if (wc == 0 && fq < 3) {
#pragma unroll
                for (int ai = 0; ai < 2; ++ai)
#pragma unroll
                    for (int m = 0; m < 4; ++m) { const int row = row0 + ai * HALF + m * 16;
#pragma unroll
                        for (int n = 0; n < 2; ++n)
#pragma unroll
                            for (int e = 0; e < 4; ++e) { const int c = 8 * fq + 4 * n + e; const float v = acc[ai][0][m][n][e] + bgate[c]; GATES[(size_t)row * 24 + c] = 1.0f / (1.0f + __expf(-v)); } }
            }
        }
    }
};
struct EpiStore {
    static constexpr bool PERM = true, AFTER_DRAIN = false, MIDSCALE = false;
    bf16_t* O; int ldc; const float* ssq; int frag;
    __device__ __forceinline__ void operator()(const f32x4 (&acc)[2][2][4][2], const Unit& u, int wr, int wc, int fr, int fq) const {
        const int row0 = u.pm * BM + wr * 64 + fr; const int col0 = u.pn * BM + wc * 32 + 8 * fq;
#pragma unroll
        for (int ai = 0; ai < 2; ++ai)
#pragma unroll
            for (int m = 0; m < 4; ++m) { const int row = row0 + ai * HALF + m * 16;
                bf16_t* rowp = frag ? O + (size_t)(row >> 5) * 32 * ldc + (size_t)(col0 >> 4) * 512 + ((col0 >> 3) & 1) * 256 + (row & 31) * 8 : O + (size_t)row * ldc + col0;
                const int bjstep = frag ? (HALF >> 4) * 512 : HALF;
                float sc = 1.f;
                if (ssq) { const f32x4* p = (const f32x4*)(ssq + (size_t)row * 16); const f32x4 a = p[0], b = p[1], c = p[2], d = p[3];
                    const float s = ((a[0] + a[1]) + (a[2] + a[3])) + ((b[0] + b[1]) + (b[2] + b[3])) + ((c[0] + c[1]) + (c[2] + c[3])) + ((d[0] + d[1]) + (d[2] + d[3]));
                    sc = rsqrtf(s * (1.0f / 1024.0f) + 1e-6f); }
#pragma unroll
                for (int bj = 0; bj < 2; ++bj) { const f32x4 v0 = acc[ai][bj][m][0] * sc, v1 = acc[ai][bj][m][1] * sc;
                    u32x4 w; w.x = cvt_pk_bf16(v0[0], v0[1]); w.y = cvt_pk_bf16(v0[2], v0[3]); w.z = cvt_pk_bf16(v1[0], v1[1]); w.w = cvt_pk_bf16(v1[2], v1[3]);
                    *(u32x4*)(rowp + bj * bjstep) = w; } }
    }
};
struct EpiVFrag {
    static constexpr bool PERM = true, AFTER_DRAIN = false, MIDSCALE = false;
    bf16_t* O;
    __device__ __forceinline__ void operator()(const f32x4 (&acc)[2][2][4][2], const Unit& u, int wr, int wc, int fr, int fq) const {
        const int row0 = u.pm * BM + wr * 64 + fr; const int col0 = u.pn * BM + wc * 32 + 8 * fq;
#pragma unroll
        for (int ai = 0; ai < 2; ++ai)
#pragma unroll
            for (int m = 0; m < 4; ++m) { const int D = row0 + ai * HALF + m * 16, h = D >> 8, dt = (D >> 5) & 7, r = D & 31;
#pragma unroll
                for (int bj = 0; bj < 2; ++bj) { const int K0 = col0 + bj * HALF, b = K0 >> 8, kt = (K0 >> 5) & 7, k0 = K0 & 31;
                    bf16_t* p = O + (size_t)((b * 4 + h) * 8 + kt) * 8192 + dt * 1024 + (k0 >> 4) * 512 + r * 8 + 4 * ((k0 >> 3) & 1);
                    const f32x4 v0 = acc[ai][bj][m][0], v1 = acc[ai][bj][m][1];
                    u32x2 w0, w1; w0.x = cvt_pk_bf16(v0[0], v0[1]); w0.y = cvt_pk_bf16(v0[2], v0[3]); w1.x = cvt_pk_bf16(v1[0], v1[1]); w1.y = cvt_pk_bf16(v1[2], v1[3]);
                    *(u32x2*)p = w0; *(u32x2*)(p + 256) = w1; } }
    }
};
template <bool MID> struct EpiRes {
    static constexpr bool PERM = false, AFTER_DRAIN = false, MIDSCALE = MID;
    const float* base; const bf16_t* base16; float* out; bf16_t* XB; float* ssq; const float* ssqn;
    __device__ __forceinline__ void midscale(f32x4 (&acc)[2][2][4][2], const Unit& u, int wr, int wc, int fr, int fq) const {
        const int row0 = u.pm * BM + wr * 64 + fr;
#pragma unroll
        for (int ai = 0; ai < 2; ++ai)
#pragma unroll
            for (int m = 0; m < 4; ++m) { const int row = row0 + ai * HALF + m * 16; const f32x2 sq = *(const f32x2*)(ssqn + (size_t)row * 2);
                const float sc = rsqrtf((sq[0] + sq[1]) * (1.0f / 512.0f) + 1e-6f);
#pragma unroll
                for (int bj = 0; bj < 2; ++bj)
#pragma unroll
                    for (int n = 0; n < 2; ++n) acc[ai][bj][m][n] = acc[ai][bj][m][n] * sc; }
    }
    __device__ __forceinline__ void operator()(const f32x4 (&acc)[2][2][4][2], const Unit& u, int wr, int wc, int fr, int fq) const {
        const int row0 = u.pm * BM + wr * 64 + fr; const int col0 = u.pn * BM + wc * 32 + 4 * fq;
#pragma unroll
        for (int ai = 0; ai < 2; ++ai)
#pragma unroll
            for (int m = 0; m < 4; ++m) { const int row = row0 + ai * HALF + m * 16; const size_t off = (size_t)row * 1024 + col0; float s = 0.f;
#pragma unroll
                for (int bj = 0; bj < 2; ++bj)
#pragma unroll
                    for (int n = 0; n < 2; ++n) { f32x4 b;
                        if (base) b = *(const f32x4*)(base + off + bj * HALF + n * 16);
                        else { const u32x2 w = *(const u32x2*)(base16 + off + bj * HALF + n * 16); b[0] = __builtin_bit_cast(float, w.x << 16); b[1] = __builtin_bit_cast(float, w.x & 0xffff0000u); b[2] = __builtin_bit_cast(float, w.y << 16); b[3] = __builtin_bit_cast(float, w.y & 0xffff0000u); }
                        const f32x4 v = b + acc[ai][bj][m][n];
                        if (out) *(f32x4*)(out + off + bj * HALF + n * 16) = v;
                        s += (v[0] * v[0] + v[1] * v[1]) + (v[2] * v[2] + v[3] * v[3]);
                        u32x2 w; w.x = cvt_pk_bf16(v[0], v[1]); w.y = cvt_pk_bf16(v[2], v[3]); *(u32x2*)(XB + off + bj * HALF + n * 16) = w; }
                s += __shfl_xor(s, 16); s += __shfl_xor(s, 32);
                if (fq == 0) ssq[(size_t)row * 16 + u.pn * 4 + wc] = s;
                asm volatile("" ::: "memory"); }
    }
};
template <class Epi, class Sched, bool ALIGN_EPI = false, bool SP2 = false>
__device__ __forceinline__ void gemm_phase(PG8_LAS unsigned char* lds, const Gemm g, const Sched& S, const Epi& E, int wave  ) {
    int lane; asm volatile("v_mbcnt_lo_u32_b32 %0, -1, 0\n\tv_mbcnt_hi_u32_b32 %0, -1, %0" : "=v"(lane));
    const int wid = wave, tid = wid * 64 + lane, wr = wid >> 2, wc = wid & 3, fr = lane & 15, fq = lane >> 4;
    const int K = g.K, nt = K / BK;
    unsigned voffA[2], voffB[2];
#pragma unroll
    for (int i = 0; i < 2; ++i) { int R, C; stage_rc(tid * 16 + i * 8192, R, C); const int Rb = Epi::PERM ? ((R & ~31) + perm32(R & 31)) : R;
        voffA[i] = (unsigned)(R * K + C) * 2u; voffB[i] = (unsigned)(Rb * K + C) * 2u; }
    const size_t kstep = (size_t)(BK * 2);
    const size_t hstep = (size_t)HALF * K * 2;
    const size_t tstep = 2 * hstep;
    const unsigned ldsw = (unsigned)wid * 1024u;
    const int aoff = lds_byte(wr * 64 + fr, fq * 8), boff = lds_byte(wc * 32 + fr, fq * 8);
#define PG8_SA(b, h) (((b) * 2 + (h)) * HTB)
#define PG8_SB(b, h) ((4 + (b) * 2 + (h)) * HTB)
#define PG8_STAGE(bufoff, gbase, voff) do { _Pragma("unroll") for (int _i = 0; _i < 2; ++_i) \
        __builtin_amdgcn_global_load_lds((const unsigned*)((const char*)(gbase) + (voff)[_i]), (PG8_LAS unsigned*)(lds + (bufoff) + ldsw + _i * 8192), 16, 0, 0); } while (0)
#define PG8_LDA(dst, b, h) do { _Pragma("unroll") for (int m = 0; m < 4; ++m) _Pragma("unroll") for (int k = 0; k < 2; ++k) dst[m][k] = *(const PG8_LAS bf16x8*)(lds + PG8_SA(b, h) + aoff + m * 2048 + k * 1024); } while (0)
#define PG8_LDB(dst, b, h) do { _Pragma("unroll") for (int n = 0; n < 2; ++n) _Pragma("unroll") for (int k = 0; k < 2; ++k) dst[n][k] = *(const PG8_LAS bf16x8*)(lds + PG8_SB(b, h) + boff + n * 2048 + k * 1024); } while (0)
#define PG8_MMA(ai, bj, At, Bt) do { __builtin_amdgcn_s_setprio(1); _Pragma("unroll") for (int m = 0; m < 4; ++m) _Pragma("unroll") for (int n = 0; n < 2; ++n) _Pragma("unroll") for (int k = 0; k < 2; ++k) \
        acc[ai][bj][m][n] = __builtin_amdgcn_mfma_f32_16x16x32_bf16(Bt[n][k], At[m][k], acc[ai][bj][m][n], 0, 0, 0); __builtin_amdgcn_s_setprio(0); } while (0)
#define PG8_WAIT_V(n) asm volatile("s_waitcnt vmcnt(" #n ")" ::: "memory")
#define PG8_WAIT_L(n) asm volatile("s_waitcnt lgkmcnt(" #n ")" ::: "memory")
#define PG8_BAR __builtin_amdgcn_s_barrier()
#define PG8_SCHED __builtin_amdgcn_sched_barrier(0)
    Unit cur, nxt; int ui = 0;
    if (!S.next(0, cur)) return;
    f32x4 acc[2][2][4][2];
#pragma unroll
    for (int a = 0; a < 2; ++a)
#pragma unroll
        for (int b = 0; b < 2; ++b)
#pragma unroll
            for (int m = 0; m < 4; ++m)
#pragma unroll
                for (int n = 0; n < 2; ++n) acc[a][b][m][n] = (f32x4){0.f, 0.f, 0.f, 0.f};
    bf16x8 At[4][2], B0[2][2], B1[2][2];
    const char* cA = (const char*)g.A + (size_t)cur.pm * tstep; const char* cB = (const char*)g.Bt + (size_t)cur.pn * tstep;
    S.a_ready(cur);
    if constexpr (SP2) {
        PG8_STAGE(PG8_SB(0, 0), cB, voffB); PG8_STAGE(PG8_SB(0, 1), cB + hstep, voffB); PG8_STAGE(PG8_SA(0, 0), cA, voffA); PG8_STAGE(PG8_SA(0, 1), cA + hstep, voffA);
        if (wr == 1) PG8_BAR;
        PG8_WAIT_V(2); PG8_BAR;
        PG8_STAGE(PG8_SB(1, 0), cB + kstep, voffB); PG8_STAGE(PG8_SA(1, 0), cA + kstep, voffA); PG8_STAGE(PG8_SB(1, 1), cB + hstep + kstep, voffB);
        PG8_WAIT_V(6); PG8_BAR;
    } else {
        PG8_STAGE(PG8_SB(0, 0), cB, voffB); PG8_STAGE(PG8_SA(0, 0), cA, voffA); PG8_STAGE(PG8_SB(0, 1), cB + hstep, voffB); PG8_STAGE(PG8_SA(0, 1), cA + hstep, voffA);
        if (wr == 1) PG8_BAR;
        PG8_WAIT_V(4); PG8_BAR;
        PG8_STAGE(PG8_SB(1, 0), cB + kstep, voffB); PG8_STAGE(PG8_SA(1, 0), cA + kstep, voffA); PG8_STAGE(PG8_SB(1, 1), cB + hstep + kstep, voffB);
        PG8_WAIT_V(6); PG8_BAR;
    }
    for (;;) {
        const bool has_next = S.next(ui + 1, nxt);
        const char* nA = has_next ? (const char*)g.A + (size_t)nxt.pm * tstep : cA; const char* nB = has_next ? (const char*)g.Bt + (size_t)nxt.pn * tstep : cB;
        for (int t = 0; t < nt; t += 2) {
            if constexpr (Epi::MIDSCALE) { if (t == nt / 2) E.midscale(acc, cur, wr, wc, fr, fq); }
            const bool last = (t == nt - 2);
            const char* a1 = cA + (size_t)(t + 1) * kstep;
            const char* a2 = last ? nA : cA + (size_t)(t + 2) * kstep; const char* b2 = last ? nB : cB + (size_t)(t + 2) * kstep;
            const char* a3 = a2 + kstep; const char* b3 = b2 + kstep;
            if (last && has_next) S.a_ready(nxt);
            if constexpr (SP2) {
            PG8_LDB(B0, 0, 0); PG8_LDB(B1, 0, 1); PG8_SCHED; PG8_LDA(At, 0, 0); PG8_STAGE(PG8_SA(1, 1), a1 + hstep, voffA);
            PG8_WAIT_V(8); PG8_WAIT_L(0); PG8_BAR; PG8_MMA(0, 0, At, B0); PG8_MMA(0, 1, At, B1); PG8_BAR; PG8_SCHED;
            PG8_LDA(At, 0, 1); PG8_STAGE(PG8_SB(0, 0), b2, voffB); PG8_STAGE(PG8_SB(0, 1), b2 + hstep, voffB); PG8_STAGE(PG8_SA(0, 0), a2, voffA);
            PG8_WAIT_V(8); PG8_WAIT_L(0); PG8_BAR; PG8_MMA(1, 0, At, B0); PG8_MMA(1, 1, At, B1); PG8_BAR; PG8_SCHED;
            PG8_LDB(B0, 1, 0); PG8_LDB(B1, 1, 1); PG8_SCHED; PG8_LDA(At, 1, 0); PG8_STAGE(PG8_SA(0, 1), a2 + hstep, voffA);
            PG8_WAIT_V(8); PG8_WAIT_L(0); PG8_BAR; PG8_MMA(0, 0, At, B0); PG8_MMA(0, 1, At, B1); PG8_BAR; PG8_SCHED;
            PG8_LDA(At, 1, 1); PG8_STAGE(PG8_SB(1, 0), b3, voffB); PG8_STAGE(PG8_SB(1, 1), b3 + hstep, voffB); PG8_STAGE(PG8_SA(1, 0), a3, voffA);
            PG8_WAIT_V(8); PG8_WAIT_L(0); PG8_BAR; PG8_MMA(1, 0, At, B0); PG8_MMA(1, 1, At, B1); PG8_BAR; PG8_SCHED;
            } else {
            PG8_LDB(B0, 0, 0); PG8_SCHED; PG8_LDA(At, 0, 0); PG8_STAGE(PG8_SA(1, 1), a1 + hstep, voffA);
            PG8_WAIT_L(8); PG8_BAR; PG8_WAIT_L(0); PG8_MMA(0, 0, At, B0); PG8_BAR; PG8_SCHED;
            PG8_LDB(B1, 0, 1); PG8_STAGE(PG8_SB(0, 0), b2, voffB);
            PG8_BAR; PG8_WAIT_L(0); PG8_MMA(0, 1, At, B1); PG8_BAR;
            PG8_LDA(At, 0, 1); PG8_STAGE(PG8_SA(0, 0), a2, voffA);
            PG8_BAR; PG8_WAIT_L(0); PG8_MMA(1, 0, At, B0); PG8_BAR; PG8_SCHED;
            PG8_STAGE(PG8_SB(0, 1), b2 + hstep, voffB);
            PG8_WAIT_V(6); PG8_BAR; PG8_MMA(1, 1, At, B1); PG8_BAR;
            PG8_LDB(B0, 1, 0); PG8_SCHED; PG8_LDA(At, 1, 0); PG8_STAGE(PG8_SA(0, 1), a2 + hstep, voffA);
            PG8_WAIT_L(8); PG8_BAR; PG8_WAIT_L(0); PG8_MMA(0, 0, At, B0); PG8_BAR; PG8_SCHED;
            PG8_LDB(B1, 1, 1); PG8_STAGE(PG8_SB(1, 0), b3, voffB);
            PG8_BAR; PG8_WAIT_L(0); PG8_MMA(0, 1, At, B1); PG8_BAR;
            PG8_LDA(At, 1, 1); PG8_STAGE(PG8_SA(1, 0), a3, voffA);
            PG8_BAR; PG8_WAIT_L(0); PG8_MMA(1, 0, At, B0); PG8_BAR; PG8_SCHED;
            PG8_STAGE(PG8_SB(1, 1), b3 + hstep, voffB);
            PG8_WAIT_V(6); PG8_BAR; PG8_MMA(1, 1, At, B1); PG8_BAR;
            }
        }
        if constexpr (ALIGN_EPI) { if (wr == 0) PG8_BAR; }
        if constexpr (!Epi::AFTER_DRAIN) { E(acc, cur, wr, wc, fr, fq); S.done(cur); }
        if (!has_next) break;
#pragma unroll
        for (int a = 0; a < 2; ++a)
#pragma unroll
            for (int b = 0; b < 2; ++b)
#pragma unroll
                for (int m = 0; m < 4; ++m)
#pragma unroll
                    for (int n = 0; n < 2; ++n) acc[a][b][m][n] = (f32x4){0.f, 0.f, 0.f, 0.f};
        cur = nxt; cA = nA; cB = nB; ++ui;
        if constexpr (ALIGN_EPI) { if (wr == 1) PG8_BAR; }
    }
    PG8_WAIT_V(0);
    if constexpr (!ALIGN_EPI) { if (wr == 0) PG8_BAR; }
    PG8_BAR;
    if constexpr (Epi::AFTER_DRAIN) { E.fused(acc, cur, wr, wc, fr, fq, lds, wid, lane); S.done(cur); }
#undef PG8_SA
#undef PG8_SB
#undef PG8_STAGE
#undef PG8_LDA
#undef PG8_LDB
#undef PG8_MMA
#undef PG8_WAIT_V
#undef PG8_WAIT_L
#undef PG8_BAR
#undef PG8_SCHED
}
}

constexpr int NB = 2, SEQ = 8192, DM = 1024, MTOK = NB * SEQ;
constexpr int NZ = 2304, NZP = 2560;
constexpr int NMEM = 256;
constexpr float EPS = 1e-6f;
constexpr float QSCALE = 0.125f * 1.4426950408889634f;
constexpr int ZC_XL = 0, ZC_GT = 512, ZC_Q = 1024, ZC_KC = 1536, ZC_VC = 1664, ZC_KS = 1792, ZC_VS = 1920, ZC_KW = 2048, ZC_VW = 2176, ZC_G = 2304;

constexpr size_t MiB = 1u << 20;
constexpr size_t WS_CTL = 0;
constexpr size_t WS_WIN = 1 * MiB, WS_WOUT = 6 * MiB, WS_WMQ = 8 * MiB, WS_WMK = 10 * MiB, WS_WMV = 12 * MiB, WS_WMO = 14 * MiB, WS_WPQ = 16 * MiB;
constexpr size_t WS_SKEY = 20 * MiB;
constexpr size_t WS_CW1T = WS_SKEY + 512 * 1024;
constexpr size_t WS_CW2T = WS_CW1T + 512 * 1024;
constexpr size_t WS_C1 = WS_CW2T + 16 * 1024;
constexpr size_t WS_WRGT = WS_C1 + 16 * 1024;
constexpr size_t WS_MEMN = 22 * MiB, WS_MEMK = 23 * MiB, WS_MEMVT = 24 * MiB;
constexpr size_t WS_KC = 26 * MiB;
constexpr size_t WS_VCT = WS_KC + 256 * 1024;
constexpr size_t WS_SUMM = 27 * MiB;
constexpr size_t WS_SSQ1 = 28 * MiB, WS_SSQ2 = 29 * MiB;
constexpr size_t WS_GATES = 30 * MiB;
constexpr size_t WS_SSQN = 31 * MiB + 512 * 1024;
constexpr size_t WS_U8 = 32 * MiB, WS_V8 = 48 * MiB;
constexpr size_t WS_SU = 64 * MiB, WS_SV = 64 * MiB + 65536;
constexpr size_t WS_SSQ3 = 65 * MiB;
constexpr size_t WS_W = 66 * MiB;
constexpr size_t WS_PART = 128 * MiB;
constexpr size_t WS_XN = 96 * MiB;
constexpr size_t WS_Z = 128 * MiB;
constexpr size_t WS_KSF = 240 * MiB, WS_VSF = 244 * MiB, WS_KWF = 248 * MiB, WS_VWF = 252 * MiB;
constexpr size_t WS_QM = 128 * MiB, WS_OM = 160 * MiB;
constexpr size_t WS_QP = 128 * MiB;
constexpr size_t WS_Y = 208 * MiB;
constexpr size_t WS_EID = 208 * MiB, WS_GW = 216 * MiB;
constexpr size_t WS_END = 256 * MiB;

constexpr int CW_KMAX = 12288;
constexpr int LDS_BYTES = 147456;

#define GAS __attribute__((address_space(1)))
#define LAS __attribute__((address_space(3)))
typedef unsigned short bf16;
typedef unsigned v4u __attribute__((ext_vector_type(4)));
typedef unsigned v2u __attribute__((ext_vector_type(2)));
typedef float f32x4 __attribute__((ext_vector_type(4)));
typedef float f32x16 __attribute__((ext_vector_type(16)));
typedef short bf16x8 __attribute__((ext_vector_type(8)));
typedef short bf16x4 __attribute__((ext_vector_type(4)));
__device__ __forceinline__ unsigned f2bf(float f) { unsigned u = __builtin_bit_cast(unsigned, f); return (u + 0x7fffu + ((u >> 16) & 1u)) >> 16; }
typedef float f32x2_ __attribute__((ext_vector_type(2))); typedef __bf16 bf16x2_ __attribute__((ext_vector_type(2)));
__device__ __forceinline__ unsigned pk2(float lo, float hi) { f32x2_ v = {lo, hi}; bf16x2_ b = __builtin_convertvector(v, bf16x2_); return __builtin_bit_cast(unsigned, b); }
__device__ __forceinline__ float bf2f(unsigned short h) { return __builtin_bit_cast(float, (unsigned)h << 16); }
__device__ __forceinline__ float bflo(unsigned w) { return __builtin_bit_cast(float, w << 16); }
__device__ __forceinline__ float bfhi(unsigned w) { return __builtin_bit_cast(float, w & 0xffff0000u); }
__device__ __forceinline__ void swap32(unsigned& a, unsigned& b) { asm("s_nop 1\n\tv_permlane32_swap_b32 %0, %1" : "+v"(a), "+v"(b)); }
__device__ __forceinline__ int maxswap32_i(int v) { unsigned a = (unsigned)v, b = (unsigned)v; swap32(a, b); return max((int)a, (int)b); }
__device__ __forceinline__ float maxswap32_f(float v) { unsigned a = __builtin_bit_cast(unsigned, v), b = a; swap32(a, b); return fmaxf(__builtin_bit_cast(float, a), __builtin_bit_cast(float, b)); }
__device__ __forceinline__ float addswap32_f(float v) { unsigned a = __builtin_bit_cast(unsigned, v), b = a; swap32(a, b); return __builtin_bit_cast(float, a) + __builtin_bit_cast(float, b); }
__device__ __forceinline__ float wave_sum(float v) {
#pragma unroll
    for (int o = 1; o < 64; o <<= 1) v += __shfl_xor(v, o);
    return v;
}

struct Args { const float* in[33]; float* out; unsigned char* ws; int ph_lo, ph_hi; };

struct Frame {
    int tid, lane, wave, vcu, G, gw, NGW;
};
__device__ __forceinline__ int lane_id() { int l; asm volatile("v_mbcnt_lo_u32_b32 %0, -1, 0\n\tv_mbcnt_hi_u32_b32 %0, -1, %0" : "=v"(l)); return l; }
#define REFRESH_LANE(F) do { (F).lane = lane_id(); (F).tid = (F).wave * 64 + (F).lane; } while (0)

__device__ __forceinline__ void transpose_item(const float* W, int K, int N, bf16* WT, int ldt, int row_off, const float* gain, int slo, int shi, float cs, LAS float* scr, int item, int lane, int kxor = 0) {
    const int nblk = (N + 31) / 32, kb = item / nblk, nb = item % nblk, k0 = 64 * kb, n0 = 32 * nb;
#pragma unroll 16
    for (int i = 0; i < 32; ++i) { const int kk = 2 * i + (lane >> 5), n = n0 + (lane & 31);
        float v = (n < N) ? __builtin_nontemporal_load(W + (size_t)(k0 + kk) * N + n) : 0.f; if (gain) v *= gain[k0 + kk]; if (n >= slo && n < shi) v *= cs;
        scr[kk * 33 + (lane & 31)] = v; }
    asm volatile("s_waitcnt lgkmcnt(0)" ::: "memory");
    const int c = lane & 7;
#pragma unroll
    for (int j = 0; j < 4; ++j) { const int n = (lane >> 3) + 8 * j; const LAS float* s = scr + (8 * c) * 33 + n;
        v4u o; o.x = pk2(s[0 * 33], s[1 * 33]); o.y = pk2(s[2 * 33], s[3 * 33]); o.z = pk2(s[4 * 33], s[5 * 33]); o.w = pk2(s[6 * 33], s[7 * 33]);
        *(v4u*)(WT + (size_t)(row_off + n0 + n) * ldt + (k0 ^ kxor) + 8 * c) = o; }
    asm volatile("s_waitcnt lgkmcnt(0)" ::: "memory");
}
__device__ __forceinline__ void rms_row_to_bf16(const float* xrow, bf16* orow, int lane) {
    const f32x4* xr = (const f32x4*)xrow + lane;
    f32x4 v[4]; float s = 0.f;
#pragma unroll
    for (int j = 0; j < 4; ++j) { v[j] = xr[64 * j]; s += (v[j].x * v[j].x + v[j].y * v[j].y) + (v[j].z * v[j].z + v[j].w * v[j].w); }
    const float rstd = rsqrtf(wave_sum(s) * (1.f / DM) + EPS);
    unsigned long long* o8 = (unsigned long long*)orow + lane;
#pragma unroll
    for (int j = 0; j < 4; ++j) o8[64 * j] = (unsigned long long)pk2(v[j].x * rstd, v[j].y * rstd) | ((unsigned long long)pk2(v[j].z * rstd, v[j].w * rstd) << 32);
}
__device__ __forceinline__ void quant_row_fp8(const float* src, const float* gain, unsigned char* dst, float* scale_out, int lane) {
    const f32x4* p = (const f32x4*)src + 4 * lane; f32x4 v[4]; float am = 0.f;
#pragma unroll
    for (int j = 0; j < 4; ++j) { v[j] = p[j]; if (gain) v[j] = v[j] * ((const f32x4*)gain)[4 * lane + j]; am = fmaxf(am, fmaxf(fmaxf(fabsf(v[j].x), fabsf(v[j].y)), fmaxf(fabsf(v[j].z), fabsf(v[j].w)))); }
#pragma unroll
    for (int o = 1; o < 64; o <<= 1) am = fmaxf(am, __shfl_xor(am, o));
    const float inv = am > 0.f ? 448.0f / am : 0.f;
    v4u o4;
#pragma unroll
    for (int j = 0; j < 4; ++j) { int w = 0; w = __builtin_amdgcn_cvt_pk_fp8_f32(v[j].x * inv, v[j].y * inv, w, false); w = __builtin_amdgcn_cvt_pk_fp8_f32(v[j].z * inv, v[j].w * inv, w, true); o4[j] = (unsigned)w; }
    *(v4u*)(dst + (size_t)(lane >> 3) * 16384 * 128 + (lane & 7) * 16) = o4;
    if (lane == 0) *scale_out = am * (1.0f / 448.0f);
}
__device__ __forceinline__ void rms_rows4_to_bf16(const float* x0, bf16* o0, size_t rstride  , int lane) {
    f32x4 v[4][4]; float s[4];
#pragma unroll
    for (int r = 0; r < 4; ++r)
#pragma unroll
        for (int j = 0; j < 4; ++j) v[r][j] = __builtin_nontemporal_load((const f32x4*)(x0 + r * rstride) + lane + 64 * j);
#pragma unroll
    for (int r = 0; r < 4; ++r) { s[r] = 0.f;
#pragma unroll
        for (int j = 0; j < 4; ++j) s[r] += (v[r][j].x * v[r][j].x + v[r][j].y * v[r][j].y) + (v[r][j].z * v[r][j].z + v[r][j].w * v[r][j].w); }
#pragma unroll
    for (int o = 1; o < 64; o <<= 1)
#pragma unroll
        for (int r = 0; r < 4; ++r) s[r] += __shfl_xor(s[r], o);
#pragma unroll
    for (int r = 0; r < 4; ++r) { const float rstd = rsqrtf(s[r] * (1.f / DM) + EPS); unsigned long long* o8 = (unsigned long long*)(o0 + r * rstride) + lane;
#pragma unroll
        for (int j = 0; j < 4; ++j) o8[64 * j] = (unsigned long long)pk2(v[r][j].x * rstd, v[r][j].y * rstd) | ((unsigned long long)pk2(v[r][j].z * rstd, v[r][j].w * rstd) << 32); }
}
__device__ __forceinline__ void quant_rows4_fp8(const float* src0, size_t rstride, const float* gain, unsigned char* dst0, float* scale0, int sstride, int lane) {
    f32x4 v[4][4]; float am[4];
#pragma unroll
    for (int r = 0; r < 4; ++r)
#pragma unroll
        for (int j = 0; j < 4; ++j) v[r][j] = __builtin_nontemporal_load((const f32x4*)(src0 + r * rstride) + 4 * lane + j);
    if (gain) {
#pragma unroll
        for (int j = 0; j < 4; ++j) { const f32x4 g = ((const f32x4*)gain)[4 * lane + j];
#pragma unroll
            for (int r = 0; r < 4; ++r) v[r][j] = v[r][j] * g; } }
#pragma unroll
    for (int r = 0; r < 4; ++r) { am[r] = 0.f;
#pragma unroll
        for (int j = 0; j < 4; ++j) am[r] = fmaxf(am[r], fmaxf(fmaxf(fabsf(v[r][j].x), fabsf(v[r][j].y)), fmaxf(fabsf(v[r][j].z), fabsf(v[r][j].w)))); }
#pragma unroll
    for (int o = 1; o < 64; o <<= 1)
#pragma unroll
        for (int r = 0; r < 4; ++r) am[r] = fmaxf(am[r], __shfl_xor(am[r], o));
#pragma unroll
    for (int r = 0; r < 4; ++r) { const float inv = am[r] > 0.f ? 448.0f / am[r] : 0.f; v4u o4;
#pragma unroll
        for (int j = 0; j < 4; ++j) { int w = 0; w = __builtin_amdgcn_cvt_pk_fp8_f32(v[r][j].x * inv, v[r][j].y * inv, w, false); w = __builtin_amdgcn_cvt_pk_fp8_f32(v[r][j].z * inv, v[r][j].w * inv, w, true); o4[j] = (unsigned)w; }
        __builtin_nontemporal_store(o4, (v4u*)(dst0 + (size_t)r * sstride * 128 + (size_t)(lane >> 3) * 16384 * 128 + (lane & 7) * 16));
        if (lane == 0) scale0[r * sstride] = am[r] * (1.0f / 448.0f); }
}
__device__ __forceinline__ void p0_prologue(const Frame& F, const Args& A, LAS unsigned char* lds) {
    unsigned char* ws = A.ws;
    LAS float* scr = (LAS float*)(lds + F.wave * 16384);
    const float* const* in = A.in;
    const int gw = F.gw, NGW = F.NGW;
    constexpr int I_IN = 16 * 73, I_SQ = 16 * 32, I_PQ = 16 * 64, I_C1 = 64, I_C2 = 2, I_RG = 2;
    constexpr int E_IN = I_IN, E_OUT = E_IN + I_SQ, E_MQ = E_OUT + I_SQ, E_MK = E_MQ + I_SQ, E_MV = E_MK + I_SQ, E_MO = E_MV + I_SQ, E_PQ = E_MO + I_PQ, E_C1 = E_PQ + 2 * I_C1, E_C2 = E_C1 + 2 * I_C2, E_RG = E_C2 + 16 * I_RG;
    for (int it = gw; it < E_RG; it += NGW) {
        if (it < E_IN) transpose_item(in[3], 1024, 2328, (bf16*)(ws + WS_WIN), 1024, 0, in[2], ZC_Q, ZC_KC, QSCALE, scr, it, F.lane);
        else if (it < E_OUT) { const int j = it - E_IN, kb = j / 32; transpose_item(in[20], 1024, 1024, (bf16*)(ws + WS_WOUT), 1024, 0, (kb < 8 ? in[18] : in[19] - 512), 0, 0, 1.f, scr, j, F.lane, 512); }
        else if (it < E_MQ) transpose_item(in[23], 1024, 1024, (bf16*)(ws + WS_WMQ), 1024, 0, in[21], 0, 1024, 0.0625f * 1.4426950408889634f, scr, it - E_OUT, F.lane);
        else if (it < E_MK) transpose_item(in[24], 1024, 1024, (bf16*)(ws + WS_WMK), 1024, 0, in[22], 0, 0, 1.f, scr, it - E_MQ, F.lane);
        else if (it < E_MV) transpose_item(in[25], 1024, 1024, (bf16*)(ws + WS_WMV), 1024, 0, in[22], 0, 0, 1.f, scr, it - E_MK, F.lane);
        else if (it < E_MO) transpose_item(in[26], 1024, 1024, (bf16*)(ws + WS_WMO), 1024, 0, nullptr, 0, 0, 1.f, scr, it - E_MV, F.lane);
        else if (it < E_PQ) transpose_item(in[28], 1024, 2048, (bf16*)(ws + WS_WPQ), 1024, 0, in[27], 0, 0, 1.f, scr, it - E_MO, F.lane);
        else if (it < E_C1) { const int j = it - E_PQ, kv = j / I_C1; transpose_item(in[kv ? 16 : 13], 2048, 64, (bf16*)(ws + WS_CW1T) + (size_t)kv * 64 * 2048, 2048, 0, nullptr, 0, 0, 1.f, scr, j % I_C1, F.lane); }
        else if (it < E_C2) { const int j = it - E_C1, kv = j / I_C2; transpose_item(in[kv ? 17 : 14], 64, 64, (bf16*)(ws + WS_CW2T) + (size_t)kv * 64 * 64, 64, 0, nullptr, 0, 0, 1.f, scr, j % I_C2, F.lane); }
        else { const int j = it - E_C2, ai = j / 16, h = (j / 2) % 8; transpose_item(in[ai ? 9 : 7] + (size_t)h * 4096, 64, 64, (bf16*)(ws + WS_WRGT) + (size_t)(ai * 8 + h) * 4096, 64, 0, nullptr, 0, 0, 1.f, scr, j % 2, F.lane); }
    }
    for (int i = gw * 64 + F.lane; i < (2560 - 2336) * 1024 / 8; i += NGW * 64) ((v4u*)((bf16*)(ws + WS_WIN) + (size_t)2336 * 1024))[i] = (v4u){0u, 0u, 0u, 0u};
    for (int it = NGW - 1 - gw; it < 32; it += NGW) { const int kv = it >> 4, ch = it & 15; const float* pos = in[kv ? 15 : 12] + 128 * ch; const float* w1 = in[kv ? 16 : 13] + (size_t)128 * ch * 64 + F.lane; float s = 0.f;
#pragma unroll 16
        for (int k = 0; k < 128; ++k) s += pos[k] * w1[(size_t)k * 64];
        ((float*)(ws + WS_C1))[it * 64 + F.lane] = s; }
    { const size_t i0 = (size_t)gw * 64 + F.lane, st = (size_t)NGW * 64;
      for (int r = gw; r < 32768; r += 4 * NGW) { const int tb = r >> 14, e = r & 16383;
          if ((16384 % (4 * NGW)) == 0) quant_rows4_fp8(in[30 + tb] + (size_t)e * DM, (size_t)NGW * DM, tb ? nullptr : in[27], ws + (tb ? WS_V8 : WS_U8) + (size_t)e * 128, (float*)(ws + (tb ? WS_SV : WS_SU)) + e, NGW, F.lane);
          else for (int q = 0; q < 4; ++q) { const int rr = r + q * NGW; if (rr < 32768) { const int t2 = rr >> 14, e2 = rr & 16383; quant_row_fp8(in[30 + t2] + (size_t)e2 * DM, t2 ? nullptr : in[27], ws + (t2 ? WS_V8 : WS_U8) + (size_t)e2 * 128, (float*)(ws + (t2 ? WS_SV : WS_SU)) + e2, F.lane); } } }
      for (size_t i = i0; i < (size_t)8 * 2 * 128 * 128 / 8; i += st) { const f32x4 a = ((const f32x4*)in[29])[2 * i], bq = ((const f32x4*)in[29])[2 * i + 1];
          v4u o; o.x = pk2(a.x, a.y); o.y = pk2(a.z, a.w); o.z = pk2(bq.x, bq.y); o.w = pk2(bq.z, bq.w);
          const size_t R = i >> 4, d0 = (i & 15) * 8;
          *(v4u*)((bf16*)(ws + WS_SKEY) + (R >> 5) * 4096 + (d0 >> 4) * 512 + ((d0 >> 3) & 1) * 256 + (R & 31) * 8) = o; } }
    if ((MTOK % (4 * NGW)) == 0) for (int m = gw; m < MTOK; m += 4 * NGW) rms_rows4_to_bf16(in[0] + (size_t)m * DM, (bf16*)(ws + WS_XN) + (size_t)m * DM, (size_t)NGW * DM, F.lane);
    else for (int m = gw; m < MTOK; m += NGW) rms_row_to_bf16(in[0] + (size_t)m * DM, (bf16*)(ws + WS_XN) + (size_t)m * DM, F.lane);
    for (int m = gw; m < NB * NMEM; m += NGW) rms_row_to_bf16(in[1] + (size_t)m * DM, (bf16*)(ws + WS_MEMN) + (size_t)m * DM, F.lane);
}

__device__ __forceinline__ int crow(int r, int hi) { return (r & 3) + 8 * (r >> 2) + 4 * hi; }
__device__ __forceinline__ float gelu_tanh(float x) {
    const float u = 0.7978845608028654f * (x + 0.044715f * x * x * x);
    const float t = 1.0f - 2.0f * __builtin_amdgcn_rcpf(__builtin_amdgcn_exp2f(2.0f * 1.4426950408889634f * u) + 1.0f);
    return 0.5f * x * (1.0f + t);
}
constexpr int XC_LD = 520;
__device__ __forceinline__ void lru_local_item(const Frame& F, const Args& A, LAS unsigned char* lds, int item) {
    unsigned char* ws = A.ws;
    const bf16* Z = (const bf16*)(ws + WS_Z);
    const int b = item >> 7, chunk = item & 127, s0 = chunk * 64; const size_t row0 = (size_t)b * SEQ + s0;
    LAS bf16* xcs = (LAS bf16*)lds;
    {
        const int c8 = F.tid & 63, tg = F.tid >> 6, c0 = 8 * c8;
        v4u xr[11];
#pragma unroll
        for (int r = 0; r < 11; ++r) { const long tok = (long)(8 * tg + r) - 3;
            if (s0 == 0 && tok < 0) xr[r] = (v4u){0u, 0u, 0u, 0u}; else xr[r] = *(const v4u*)(Z + (size_t)((long)row0 + tok) * NZ + c0); }
        const float* cw = A.in[5]; float w0[8], w1[8], w2[8], w3[8], cb[8];
#pragma unroll
        for (int j = 0; j < 2; ++j) { const f32x4 a = *(const f32x4*)(cw + c0 + 4 * j), b = *(const f32x4*)(cw + 512 + c0 + 4 * j), c = *(const f32x4*)(cw + 1024 + c0 + 4 * j), d = *(const f32x4*)(cw + 1536 + c0 + 4 * j), e2 = *(const f32x4*)(A.in[6] + c0 + 4 * j);
#pragma unroll
            for (int k = 0; k < 4; ++k) { w0[4 * j + k] = a[k]; w1[4 * j + k] = b[k]; w2[4 * j + k] = c[k]; w3[4 * j + k] = d[k]; cb[4 * j + k] = e2[k]; } }
#pragma unroll
        for (int tt = 0; tt < 8; ++tt) { float o[8];
#pragma unroll
            for (int q = 0; q < 4; ++q) { const unsigned a = xr[tt][q], b = xr[tt + 1][q], c = xr[tt + 2][q], d = xr[tt + 3][q];
                o[2 * q] = cb[2 * q] + w0[2 * q] * bflo(a) + w1[2 * q] * bflo(b) + w2[2 * q] * bflo(c) + w3[2 * q] * bflo(d);
                o[2 * q + 1] = cb[2 * q + 1] + w0[2 * q + 1] * bfhi(a) + w1[2 * q + 1] * bfhi(b) + w2[2 * q + 1] * bfhi(c) + w3[2 * q + 1] * bfhi(d); }
            v4u ov; ov.x = pk2(o[0], o[1]); ov.y = pk2(o[2], o[3]); ov.z = pk2(o[4], o[5]); ov.w = pk2(o[6], o[7]);
            *(LAS v4u*)(xcs + (8 * tg + tt) * XC_LD + c0) = ov; }
    }
    __syncthreads();
    const int h = F.wave, lane = F.lane, r32 = lane & 31, hi = lane >> 5;
    bf16x8 af[2][4];
#pragma unroll
    for (int tt = 0; tt < 2; ++tt)
#pragma unroll
        for (int ks = 0; ks < 4; ++ks) af[tt][ks] = *(const LAS bf16x8*)(xcs + (32 * tt + r32) * XC_LD + 64 * h + 16 * ks + 8 * hi);
    const bf16* WT = (const bf16*)(ws + WS_WRGT);
    float* SUMM = (float*)(ws + WS_SUMM);
    unsigned* HA = (unsigned*)A.out;
#pragma unroll 1
    for (int ct = 0; ct < 2; ++ct) {
        const int c = 64 * h + 32 * ct + r32;
        f32x16 ga[2], gi[2];
#pragma unroll
        for (int tt = 0; tt < 2; ++tt) { ga[tt] = f32x16{}; gi[tt] = f32x16{}; }
#pragma unroll
        for (int ks = 0; ks < 4; ++ks) {
            const bf16x8 ba = *(const bf16x8*)(WT + (size_t)(0 * 8 + h) * 4096 + (32 * ct + r32) * 64 + 16 * ks + 8 * hi);
            const bf16x8 bi = *(const bf16x8*)(WT + (size_t)(1 * 8 + h) * 4096 + (32 * ct + r32) * 64 + 16 * ks + 8 * hi);
#pragma unroll
            for (int tt = 0; tt < 2; ++tt) { ga[tt] = __builtin_amdgcn_mfma_f32_32x32x16_bf16(af[tt][ks], ba, ga[tt], 0, 0, 0); gi[tt] = __builtin_amdgcn_mfma_f32_32x32x16_bf16(af[tt][ks], bi, gi[tt], 0, 0, 0); }
        }
        const float ba_ = A.in[8][c], bi_ = A.in[10][c], lam = A.in[11][c];
        const float sp = (lam > 15.f) ? __expf(-lam) : log1pf(__expf(-lam));
#pragma unroll
        for (int tt = 0; tt < 2; ++tt)
#pragma unroll
            for (int r = 0; r < 16; ++r) { const int t = 32 * tt + crow(r, hi);
                const float rr = __builtin_amdgcn_rcpf(1.0f + __builtin_amdgcn_exp2f(-1.4426950408889634f * (ga[tt][r] + ba_))), ii = __builtin_amdgcn_rcpf(1.0f + __builtin_amdgcn_exp2f(-1.4426950408889634f * (gi[tt][r] + bi_)));
                const float a = __builtin_amdgcn_exp2f(-8.0f * 1.4426950408889634f * rr * sp);
                const float xcv = bf2f(xcs[t * XC_LD + c]);
                const float bb = __builtin_amdgcn_sqrtf(fmaxf(1.0f - a * a, 0.f)) * (ii * xcv);
                ga[tt][r] = a; gi[tt][r] = bb; }
        float SA[8], SB[8];
#pragma unroll
        for (int tt = 0; tt < 2; ++tt)
#pragma unroll
            for (int q = 0; q < 4; ++q) {
#pragma unroll
                for (int k = 1; k < 4; ++k) { const int r = 4 * q + k; gi[tt][r] = ga[tt][r] * gi[tt][r - 1] + gi[tt][r]; ga[tt][r] = ga[tt][r] * ga[tt][r - 1]; }
                SA[tt * 4 + q] = ga[tt][4 * q + 3]; SB[tt * 4 + q] = gi[tt][4 * q + 3]; }
        float CA = 1.f, CB = 0.f; float inA[8], inB[8];
#pragma unroll
        for (int s = 0; s < 8; ++s) {
            const float pA = __shfl_xor(SA[s], 32), pB = __shfl_xor(SB[s], 32);
            const float Ae = hi ? pA : SA[s], Be = hi ? pB : SB[s], Ao = hi ? SA[s] : pA, Bo = hi ? SB[s] : pB;
            if (!hi) { inA[s] = CA; inB[s] = CB; }
            CB = Ae * CB + Be; CA = Ae * CA;
            if (hi) { inA[s] = CA; inB[s] = CB; }
            CB = Ao * CB + Bo; CA = Ao * CA;
        }
        unsigned hoff = (unsigned)((row0 + 4 * hi) * 512 + c);
        if (hi == 0) { float* sp2 = SUMM + ((size_t)(b * 128 + chunk) * 512 + c) * 2; sp2[0] = CA; sp2[1] = CB; }
#pragma unroll
        for (int tt = 0; tt < 2; ++tt)
#pragma unroll
            for (int r = 0; r < 16; ++r) { const int s = tt * 4 + (r >> 2);
                const float acum = ga[tt][r] * inA[s], hloc = ga[tt][r] * inB[s] + gi[tt][r];
                asm volatile("" : "+v"(hoff));
                HA[hoff + (unsigned)((32 * tt + (r & 3) + 8 * (r >> 2)) * 512)] = f2bf(hloc) | (f2bf(acum) << 16); }
    }
    __syncthreads();
}
__device__ __forceinline__ void lru_fix_item(const Frame& F, const Args& A, LAS unsigned char* lds, int item, bool zero_nsa) {
    unsigned char* ws = A.ws;
    const int b = item >> 7, chunk = item & 127; const size_t row0 = (size_t)b * SEQ + chunk * 64;
    LAS float* carry = (LAS float*)lds;
    { const int c = F.tid; const float* SUMM = (const float*)(ws + WS_SUMM) + (size_t)b * 128 * 1024 + 2 * c; float hc = 0.f;
      int j = 0;
      for (; j + 8 <= chunk; j += 8) { float2 ab[8];
#pragma unroll
          for (int q = 0; q < 8; ++q) ab[q] = *(const float2*)(SUMM + (size_t)(j + q) * 1024);
#pragma unroll
          for (int q = 0; q < 8; ++q) hc = ab[q].x * hc + ab[q].y; }
      for (; j < chunk; ++j) { const float2 ab = *(const float2*)(SUMM + (size_t)j * 1024); hc = ab.x * hc + ab.y; }
      carry[c] = hc; }
    __syncthreads();
    const bf16* Z = (const bf16*)(ws + WS_Z); const unsigned* HA = (const unsigned*)A.out; bf16* Y = (bf16*)(ws + WS_Y);
    const int c0 = 8 * F.lane;
    float cr[8];
#pragma unroll
    for (int j = 0; j < 8; ++j) cr[j] = carry[c0 + j];
#pragma unroll 1
    for (int t4 = 0; t4 < 8; t4 += 4) {
        v4u h0[4], h1[4], gz[4]; float y[4][8], s[4];
#pragma unroll
        for (int q = 0; q < 4; ++q) { const size_t row = row0 + F.wave * 8 + t4 + q; h0[q] = *(const v4u*)(HA + row * 512 + c0); h1[q] = *(const v4u*)(HA + row * 512 + c0 + 4); gz[q] = *(const v4u*)(Z + row * NZ + ZC_GT + c0); }
#pragma unroll
        for (int q = 0; q < 4; ++q) { const unsigned hw[8] = {h0[q].x, h0[q].y, h0[q].z, h0[q].w, h1[q].x, h1[q].y, h1[q].z, h1[q].w};
            const float gt[8] = {bflo(gz[q].x), bfhi(gz[q].x), bflo(gz[q].y), bfhi(gz[q].y), bflo(gz[q].z), bfhi(gz[q].z), bflo(gz[q].w), bfhi(gz[q].w)};
            s[q] = 0.f;
#pragma unroll
            for (int j = 0; j < 8; ++j) { const float hv = bfhi(hw[j]) * cr[j] + bflo(hw[j]); y[q][j] = hv * gelu_tanh(gt[j]); s[q] += y[q][j] * y[q][j]; } }
#pragma unroll
        for (int o = 1; o < 64; o <<= 1)
#pragma unroll
            for (int q = 0; q < 4; ++q) s[q] += __shfl_xor(s[q], o);
#pragma unroll
        for (int q = 0; q < 4; ++q) { const size_t row = row0 + F.wave * 8 + t4 + q; const float rstd = rsqrtf(s[q] * (1.f / 512.f) + EPS);
            v4u o; o.x = pk2(y[q][0] * rstd, y[q][1] * rstd); o.y = pk2(y[q][2] * rstd, y[q][3] * rstd); o.z = pk2(y[q][4] * rstd, y[q][5] * rstd); o.w = pk2(y[q][6] * rstd, y[q][7] * rstd);
            *(v4u*)(Y + row * DM + 512 + c0) = o;
            if (zero_nsa) *(v4u*)(Y + row * DM + c0) = (v4u){0u, 0u, 0u, 0u}; }
    }
    __syncthreads();
}

__device__ __forceinline__ void kmax_item(const Frame& F, const Args& A, int item) {
    unsigned char* ws = A.ws; const int lane = lane_id();
    const int bk = item >> 9, br = (item >> 8) & 1, tile = item & 255;
    const unsigned char* K = ws + (br ? WS_KWF : WS_KSF) + ((size_t)bk * 256 + tile) * 4096 + 16 * lane;
    float s = 0.f;
#pragma unroll
    for (int ks = 0; ks < 4; ++ks) { const v4u w = *(const v4u*)(K + 1024 * ks); const unsigned ww[4] = {w.x, w.y, w.z, w.w};
#pragma unroll
        for (int k = 0; k < 4; ++k) { const float a = bflo(ww[k]), c = bfhi(ww[k]); s += a * a + c * c; } }
    s = addswap32_f(s);
#pragma unroll
    for (int o = 1; o < 32; o <<= 1) s = fmaxf(s, __shfl_xor(s, o));
    if (lane == 0) atomicMax((unsigned*)(ws + WS_CTL) + CW_KMAX + bk * 2 + br, __builtin_bit_cast(unsigned, s));
}
__device__ __forceinline__ void compress_item(const Frame& F, const Args& A, LAS unsigned char* lds, int item) {
    unsigned char* ws = A.ws;
    const int kv = item >> 6, b = (item >> 5) & 1, h = (item >> 4) & 1, nt = item & 15, n0 = 32 * nt;
    const int lane = F.lane, r32 = lane & 31, hi = lane >> 5, w = F.wave;
    const bf16* Z = (const bf16*)(ws + WS_Z); const bf16* W1T = (const bf16*)(ws + WS_CW1T) + (size_t)kv * 64 * 2048; const bf16* W2T = (const bf16*)(ws + WS_CW2T) + (size_t)kv * 4096;
    const int zc = (kv ? ZC_VC : ZC_KC) + h * 64;
    LAS float* part = (LAS float*)lds;
    LAS float* G = (LAS float*)(lds + 65536);
    {
        int n = n0 + r32; if (n > 510) n = 510;
        f32x16 acc[2]; acc[0] = f32x16{}; acc[1] = f32x16{};
#pragma unroll 4
        for (int kk = 0; kk < 16; ++kk) { const int ks = 16 * w + kk, l = ks >> 2, d0 = (ks & 3) * 16 + 8 * hi;
            const bf16x8 bfr = *(const bf16x8*)(Z + ((size_t)b * SEQ + 16 * n + l) * NZ + zc + d0);
            const bf16x8 a0 = *(const bf16x8*)(W1T + (size_t)(r32) * 2048 + ks * 16 + 8 * hi), a1 = *(const bf16x8*)(W1T + (size_t)(32 + r32) * 2048 + ks * 16 + 8 * hi);
            acc[0] = __builtin_amdgcn_mfma_f32_32x32x16_bf16(a0, bfr, acc[0], 0, 0, 0); acc[1] = __builtin_amdgcn_mfma_f32_32x32x16_bf16(a1, bfr, acc[1], 0, 0, 0); }
#pragma unroll
        for (int ot = 0; ot < 2; ++ot)
#pragma unroll
            for (int r = 0; r < 16; ++r) part[(w * 64 + 32 * ot + crow(r, hi)) * 32 + r32] = acc[ot][r];
    }
    __syncthreads();
    { const float* c1 = (const float*)(ws + WS_C1) + kv * 16 * 64;
#pragma unroll
      for (int i = 0; i < 4; ++i) { const int e = F.tid + 512 * i, o = e >> 5, n = e & 31; float s = 0.f;
#pragma unroll
          for (int ch = 0; ch < 16; ++ch) s += c1[ch * 64 + o];
#pragma unroll
          for (int ww = 0; ww < 8; ++ww) s += part[(ww * 64 + o) * 32 + n];
          G[o * 33 + n] = gelu_tanh(s); } }
    __syncthreads();
    if (w < 2) {
        f32x16 acc = f32x16{};
#pragma unroll
        for (int ks = 0; ks < 4; ++ks) { const bf16x8 a = *(const bf16x8*)(W2T + (size_t)(32 * w + r32) * 64 + 16 * ks + 8 * hi);
            v4u bw; const LAS float* gp = G + (16 * ks + 8 * hi) * 33 + r32;
            bw.x = pk2(gp[0], gp[33]); bw.y = pk2(gp[66], gp[99]); bw.z = pk2(gp[132], gp[165]); bw.w = pk2(gp[198], gp[231]);
            acc = __builtin_amdgcn_mfma_f32_32x32x16_bf16(a, __builtin_bit_cast(bf16x8, bw), acc, 0, 0, 0); }
        const int n = n0 + r32;
        const size_t tbase = ((size_t)(b * 2 + h) * 16 + nt) * 2048;
        if (kv == 0) { bf16* KC = (bf16*)(ws + WS_KC) + tbase;
#pragma unroll
            for (int q = 0; q < 4; ++q) { v2u o; o.x = pk2(acc[4 * q], acc[4 * q + 1]); o.y = pk2(acc[4 * q + 2], acc[4 * q + 3]); if (n > 510) { o.x = 0u; o.y = 0u; }
                *(v2u*)(KC + (2 * w + (q >> 1)) * 512 + (q & 1) * 256 + r32 * 8 + 4 * hi) = o; } }
        else { bf16* VC = (bf16*)(ws + WS_VCT) + tbase; const int kk = r32 & 15, vo = (r32 >> 4) * 512 + ((kk >> 2) & 1) * 256 + (kk & 3) + 4 * (kk >> 3);
#pragma unroll
            for (int r = 0; r < 16; ++r) VC[w * 1024 + crow(r, hi) * 8 + vo] = (n > 510) ? (bf16)0 : (bf16)f2bf(acc[r]); }
    }
    __syncthreads();
}

__device__ __forceinline__ void sort16_desc(int (&k)[16]) {
#define CX(i, j) { const int hi_ = max(k[i], k[j]), lo_ = min(k[i], k[j]); k[i] = hi_; k[j] = lo_; }
    CX(0, 1) CX(2, 3) CX(0, 2) CX(1, 3) CX(1, 2) CX(4, 5) CX(6, 7) CX(4, 6) CX(5, 7) CX(5, 6) CX(0, 4) CX(2, 6) CX(2, 4) CX(1, 5) CX(3, 7) CX(3, 5) CX(1, 2)
    CX(3, 4) CX(5, 6) CX(8, 9) CX(10, 11) CX(8, 10) CX(9, 11) CX(9, 10) CX(12, 13) CX(14, 15) CX(12, 14) CX(13, 15) CX(13, 14) CX(8, 12) CX(10, 14) CX(10, 12)
    CX(9, 13) CX(11, 15) CX(11, 13) CX(9, 10) CX(11, 12) CX(13, 14) CX(0, 8) CX(4, 12) CX(4, 8) CX(2, 10) CX(6, 14) CX(6, 10) CX(2, 4) CX(6, 8) CX(10, 12)
    CX(1, 9) CX(5, 13) CX(5, 9) CX(3, 11) CX(7, 15) CX(7, 11) CX(3, 5) CX(7, 9) CX(11, 13) CX(1, 2) CX(3, 4) CX(5, 6) CX(7, 8) CX(9, 10) CX(11, 12) CX(13, 14)
#undef CX
}
__device__ __forceinline__ void sort32_desc(int (&k)[32]) {
#define CX(i, j) { const int hi_ = max(k[i], k[j]), lo_ = min(k[i], k[j]); k[i] = hi_; k[j] = lo_; }
    CX(0, 1) CX(2, 3) CX(0, 2) CX(1, 3) CX(1, 2) CX(4, 5) CX(6, 7) CX(4, 6) CX(5, 7) CX(5, 6) CX(0, 4) CX(2, 6) CX(2, 4) CX(1, 5) CX(3, 7) CX(3, 5) CX(1, 2)
    CX(3, 4) CX(5, 6) CX(8, 9) CX(10, 11) CX(8, 10) CX(9, 11) CX(9, 10) CX(12, 13) CX(14, 15) CX(12, 14) CX(13, 15) CX(13, 14) CX(8, 12) CX(10, 14) CX(10, 12)
    CX(9, 13) CX(11, 15) CX(11, 13) CX(9, 10) CX(11, 12) CX(13, 14) CX(0, 8) CX(4, 12) CX(4, 8) CX(2, 10) CX(6, 14) CX(6, 10) CX(2, 4) CX(6, 8) CX(10, 12)
    CX(1, 9) CX(5, 13) CX(5, 9) CX(3, 11) CX(7, 15) CX(7, 11) CX(3, 5) CX(7, 9) CX(11, 13) CX(1, 2) CX(3, 4) CX(5, 6) CX(7, 8) CX(9, 10) CX(11, 12) CX(13, 14)
    CX(16, 17) CX(18, 19) CX(16, 18) CX(17, 19) CX(17, 18) CX(20, 21) CX(22, 23) CX(20, 22) CX(21, 23) CX(21, 22) CX(16, 20) CX(18, 22) CX(18, 20) CX(17, 21)
    CX(19, 23) CX(19, 21) CX(17, 18) CX(19, 20) CX(21, 22) CX(24, 25) CX(26, 27) CX(24, 26) CX(25, 27) CX(25, 26) CX(28, 29) CX(30, 31) CX(28, 30) CX(29, 31)
    CX(29, 30) CX(24, 28) CX(26, 30) CX(26, 28) CX(25, 29) CX(27, 31) CX(27, 29) CX(25, 26) CX(27, 28) CX(29, 30) CX(16, 24) CX(20, 28) CX(20, 24) CX(18, 26)
    CX(22, 30) CX(22, 26) CX(18, 20) CX(22, 24) CX(26, 28) CX(17, 25) CX(21, 29) CX(21, 25) CX(19, 27) CX(23, 31) CX(23, 27) CX(19, 21) CX(23, 25) CX(27, 29)
    CX(17, 18) CX(19, 20) CX(21, 22) CX(23, 24) CX(25, 26) CX(27, 28) CX(29, 30) CX(0, 16) CX(8, 24) CX(8, 16) CX(4, 20) CX(12, 28) CX(12, 20) CX(4, 8)
    CX(12, 16) CX(20, 24) CX(2, 18) CX(10, 26) CX(10, 18) CX(6, 22) CX(14, 30) CX(14, 22) CX(6, 10) CX(14, 18) CX(22, 26) CX(2, 4) CX(6, 8) CX(10, 12)
    CX(14, 16) CX(18, 20) CX(22, 24) CX(26, 28) CX(1, 17) CX(9, 25) CX(9, 17) CX(5, 21) CX(13, 29) CX(13, 21) CX(5, 9) CX(13, 17) CX(21, 25) CX(3, 19)
    CX(11, 27) CX(11, 19) CX(7, 23) CX(15, 31) CX(15, 23) CX(7, 11) CX(15, 19) CX(23, 27) CX(3, 5) CX(7, 9) CX(11, 13) CX(15, 17) CX(19, 21) CX(23, 25)
    CX(27, 29) CX(1, 2) CX(3, 4) CX(5, 6) CX(7, 8) CX(9, 10) CX(11, 12) CX(13, 14) CX(15, 16) CX(17, 18) CX(19, 20) CX(21, 22) CX(23, 24) CX(25, 26) CX(27, 28)
    CX(29, 30)
#undef CX
}
__device__ __forceinline__ void bitonic16_desc(int (&a)[16]) {
#pragma unroll
    for (int s = 8; s >= 1; s >>= 1)
#pragma unroll
        for (int i = 0; i < 16; ++i) if ((i & s) == 0) { const int hi_ = max(a[i], a[i + s]), lo_ = min(a[i], a[i + s]); a[i] = hi_; a[i + s] = lo_; }
}
__device__ __forceinline__ void merge16_desc(int (&a)[16], const int (&b)[16]) {
#pragma unroll
    for (int i = 0; i < 16; ++i) a[i] = max(a[i], b[15 - i]);
    bitonic16_desc(a);
}
struct AttnSt { float m, l; f32x16 o[2]; };
#define EX2(x) __builtin_amdgcn_exp2f(x)
struct KVF { bf16x8 k[4]; bf16x8 v[2][2]; };
struct KVF8 { bf16x8 k[4]; v4u v8[2]; };
__device__ __forceinline__ void kv_load8(KVF8& f, const bf16* Kt, const unsigned char* Vt8, unsigned lo16) {
    const char* kb = (const char*)Kt + lo16;
#pragma unroll
    for (int ks = 0; ks < 4; ++ks) f.k[ks] = *(const bf16x8*)(kb + 1024 * ks);
#pragma unroll
    for (int dt = 0; dt < 2; ++dt) f.v8[dt] = *(const v4u*)(Vt8 + lo16 + 1024 * dt);
}
typedef __bf16 bf16x2v __attribute__((ext_vector_type(2)));
__device__ __forceinline__ bf16x8 dq8(unsigned w0, unsigned w1) {
    v4u o; o.x = __builtin_bit_cast(unsigned, __builtin_amdgcn_cvt_scalef32_pk_bf16_fp8(w0, 1.0f, false)); o.y = __builtin_bit_cast(unsigned, __builtin_amdgcn_cvt_scalef32_pk_bf16_fp8(w0, 1.0f, true));
    o.z = __builtin_bit_cast(unsigned, __builtin_amdgcn_cvt_scalef32_pk_bf16_fp8(w1, 1.0f, false)); o.w = __builtin_bit_cast(unsigned, __builtin_amdgcn_cvt_scalef32_pk_bf16_fp8(w1, 1.0f, true));
    return __builtin_bit_cast(bf16x8, o); }
__device__ __forceinline__ void kv_load(KVF& f, const bf16* Kt, const bf16* Vt, unsigned lo16) {
    const char* kb = (const char*)Kt + lo16; const char* vb = (const char*)Vt + lo16;
#pragma unroll
    for (int ks = 0; ks < 4; ++ks) f.k[ks] = *(const bf16x8*)(kb + 1024 * ks);
#pragma unroll
    for (int dt = 0; dt < 2; ++dt)
#pragma unroll
        for (int s2 = 0; s2 < 2; ++s2) f.v[dt][s2] = *(const bf16x8*)(vb + 2048 * dt + 1024 * s2);
}
#define MAX3(a, b, c) __builtin_fmaxf(__builtin_fmaxf((a), (b)), (c))
__device__ __forceinline__ float max16(const f32x16& s) { const float a = MAX3(s[0], s[1], s[2]), b = MAX3(s[3], s[4], s[5]), c = MAX3(s[6], s[7], s[8]), d = MAX3(s[9], s[10], s[11]), e = MAX3(s[12], s[13], s[14]);
    return MAX3(MAX3(a, b, c), MAX3(d, e, s[15]), -1e30f); }
__device__ __forceinline__ float sum16(const f32x16& s) { return (((s[0] + s[1]) + (s[2] + s[3])) + ((s[4] + s[5]) + (s[6] + s[7]))) + (((s[8] + s[9]) + (s[10] + s[11])) + ((s[12] + s[13]) + (s[14] + s[15]))); }
template <int MODE, bool FIXED, class AllowF>
__device__ __forceinline__ void attn_compute(const KVF8& f, const bf16x8 (&qf)[4], const f32x16& negm, bool sel, AllowF allow, AttnSt& st) {
    f32x16 s = FIXED ? negm : f32x16{};
#pragma unroll
    for (int ks = 0; ks < 4; ++ks) s = __builtin_amdgcn_mfma_f32_32x32x16_bf16(f.k[ks], qf[ks], s, 0, 0, 0);
    if (MODE == 2) {
#pragma unroll
        for (int r = 0; r < 16; ++r) if (!allow(r)) s[r] = -1e30f; }
    if (!FIXED) {
        float mt = max16(s);
        if (MODE == 1) mt = sel ? mt : -1e30f;
        mt = maxswap32_f(mt);
        if (__any(mt > st.m)) {
            const float mn = fmaxf(st.m, mt), alpha = EX2(st.m - mn);
            st.m = mn; st.l *= alpha;
#pragma unroll
            for (int dt = 0; dt < 2; ++dt)
#pragma unroll
                for (int r = 0; r < 16; ++r) st.o[dt][r] *= alpha;
        }
        const float mref = (MODE == 1 && !sel) ? 1e30f : fmaxf(st.m, -1e29f);
#pragma unroll
        for (int r = 0; r < 16; ++r) s[r] = EX2(s[r] - mref);
        st.l += sum16(s);
    } else {
#pragma unroll
        for (int r = 0; r < 16; ++r) s[r] = EX2(s[r]);
        const float ps = sum16(s);
        st.l += (MODE == 1 && !sel) ? 0.f : ps;
    }
#pragma unroll
    for (int s2 = 0; s2 < 2; ++s2) { v4u pw; pw.x = pk2(s[8 * s2], s[8 * s2 + 1]); pw.y = pk2(s[8 * s2 + 2], s[8 * s2 + 3]); pw.z = pk2(s[8 * s2 + 4], s[8 * s2 + 5]); pw.w = pk2(s[8 * s2 + 6], s[8 * s2 + 7]);
        if (FIXED && MODE == 1) { pw.x = sel ? pw.x : 0u; pw.y = sel ? pw.y : 0u; pw.z = sel ? pw.z : 0u; pw.w = sel ? pw.w : 0u; }
        const bf16x8 pf = __builtin_bit_cast(bf16x8, pw);
#pragma unroll
        for (int dt = 0; dt < 2; ++dt) st.o[dt] = __builtin_amdgcn_mfma_f32_32x32x16_bf16(dq8(f.v8[dt][2 * s2], f.v8[dt][2 * s2 + 1]), pf, st.o[dt], 0, 0, 0); }
}
constexpr int IMP_LD = 132;
__device__ __forceinline__ void nsa_item(const Frame& F, const Args& A, LAS unsigned char* lds, int b, int kvh, int tb, int wsub) {
    unsigned char* ws = A.ws;
    int lane = lane_id(); asm volatile("" : "+v"(lane));
    const int r32 = lane & 31, hi = lane >> 5, w = F.wave;
    const int t0 = 64 * tb + 8 * wsub, ti = r32 & 7, g = r32 >> 3, t = t0 + ti, cur = tb;
    const size_t rowb = (size_t)b * SEQ;
    const bf16* Z = (const bf16*)(ws + WS_Z);
    LAS float* imp = (LAS float*)lds + w * 8 * IMP_LD;
    for (int i = lane; i < 8 * IMP_LD; i += 64) imp[i] = 0.f;
    bf16x8 qf[4];
#pragma unroll
    for (int ks = 0; ks < 4; ++ks) qf[ks] = *(const bf16x8*)(Z + (rowb + t) * NZ + ZC_Q + (kvh * 4 + g) * 64 + 16 * ks + 8 * hi);
    const float* gp = (const float*)(ws + WS_GATES) + (rowb + t) * 24 + (kvh * 4 + g) * 3;
    const float gate_c = gp[0], gate_s = gp[1], gate_w = gp[2];
    LAS float* oacc = (LAS float*)(lds + 8 * 8 * IMP_LD * 4) + w * 2048 + lane;
    {
        const bf16* KC = (const bf16*)(ws + WS_KC) + (size_t)(b * 2 + kvh) * 16 * 2048;
        const bf16* VCT = (const bf16*)(ws + WS_VCT) + (size_t)(b * 2 + kvh) * 16 * 2048;
        const int nv = (t >= 31) ? ((t - 31) >> 4) + 1 : 0;
        const int tl = t0 + 7, nvmax = (tl >= 31) ? ((tl - 31) >> 4) + 1 : 0;
        const unsigned lo16 = 16u * (unsigned)lane;
        float m1 = -1e30f, l1 = 0.f;
        {
            bf16x8 ka[4], kb[4];
#pragma unroll
            for (int ks = 0; ks < 4; ++ks) ka[ks] = *(const bf16x8*)((const char*)KC + lo16 + 1024 * ks);
            for (int n0 = 0; n0 < nvmax; n0 += 32) {
                if (n0 + 32 < nvmax) {
#pragma unroll
                    for (int ks = 0; ks < 4; ++ks) kb[ks] = *(const bf16x8*)((const char*)(KC + (size_t)(n0 + 32) * 64) + lo16 + 1024 * ks);
                }
                f32x16 s = f32x16{};
#pragma unroll
                for (int ks = 0; ks < 4; ++ks) s = __builtin_amdgcn_mfma_f32_32x32x16_bf16(ka[ks], qf[ks], s, 0, 0, 0);
                float mt = -1e30f;
#pragma unroll
                for (int r = 0; r < 16; ++r) { if (n0 + crow(r, hi) >= nv) s[r] = -1e30f; mt = fmaxf(mt, s[r]); }
                const float mn = fmaxf(m1, mt); float ps = 0.f;
#pragma unroll
                for (int r = 0; r < 16; ++r) ps += (s[r] > -1e29f) ? EX2(s[r] - mn) : 0.f;
                l1 = l1 * EX2(m1 - mn) + ps; m1 = mn;
#pragma unroll
                for (int ks = 0; ks < 4; ++ks) ka[ks] = kb[ks];
            }
        }
        { const float mo = __shfl_xor(m1, 32), lo = __shfl_xor(l1, 32); const float mn = fmaxf(m1, mo); l1 = l1 * EX2(m1 - mn) + lo * EX2(mo - mn); m1 = mn; }
        const float invl = (l1 > 0.f) ? 1.0f / l1 : 0.f;
        f32x16 o[2]; o[0] = f32x16{}; o[1] = f32x16{};
        KVF fa, fb;
        if (nvmax > 0) kv_load(fa, KC, VCT, lo16);
        for (int n0 = 0; n0 < nvmax; n0 += 32) {
            if (n0 + 32 < nvmax) kv_load(fb, KC + (size_t)(n0 + 32) * 64, VCT + (size_t)(n0 + 32) * 64, lo16);
            f32x16 s = f32x16{};
#pragma unroll
            for (int ks = 0; ks < 4; ++ks) s = __builtin_amdgcn_mfma_f32_32x32x16_bf16(fa.k[ks], qf[ks], s, 0, 0, 0);
#pragma unroll
            for (int r = 0; r < 16; ++r) s[r] = (n0 + crow(r, hi) < nv) ? EX2(s[r] - m1) * invl : 0.f;
            float bs[4], sp[4];
#pragma unroll
            for (int q = 0; q < 4; ++q) { bs[q] = (s[4 * q] + s[4 * q + 1]) + (s[4 * q + 2] + s[4 * q + 3]); sp[q] = s[4 * q + 3];
                bs[q] += __shfl_xor(bs[q], 8); bs[q] += __shfl_xor(bs[q], 16); sp[q] += __shfl_xor(sp[q], 8); sp[q] += __shfl_xor(sp[q], 16); }
            if (r32 < 8) {
                LAS float* ip = imp + r32 * IMP_LD + (n0 >> 2) + hi;
#pragma unroll
                for (int q = 0; q < 4; ++q) ip[2 * q] += bs[q];
                asm volatile("s_waitcnt lgkmcnt(0)" ::: "memory");
#pragma unroll
                for (int q = 0; q < 4; ++q) ip[2 * q + 1] += sp[q];
                asm volatile("s_waitcnt lgkmcnt(0)" ::: "memory");
            }
#pragma unroll
            for (int s2 = 0; s2 < 2; ++s2) { v4u pw; pw.x = pk2(s[8 * s2], s[8 * s2 + 1]); pw.y = pk2(s[8 * s2 + 2], s[8 * s2 + 3]); pw.z = pk2(s[8 * s2 + 4], s[8 * s2 + 5]); pw.w = pk2(s[8 * s2 + 6], s[8 * s2 + 7]);
                const bf16x8 pf = __builtin_bit_cast(bf16x8, pw);
#pragma unroll
                for (int dt = 0; dt < 2; ++dt) o[dt] = __builtin_amdgcn_mfma_f32_32x32x16_bf16(fa.v[dt][s2], pf, o[dt], 0, 0, 0); }
            if (n0 + 32 < nvmax) fa = fb;
        }
#pragma unroll
        for (int dt = 0; dt < 2; ++dt)
#pragma unroll
            for (int r = 0; r < 16; ++r) oacc[(dt * 16 + r) * 64] = gate_c * o[dt][r];
    }
    asm volatile("s_waitcnt lgkmcnt(0)" ::: "memory");
    unsigned mym[4] = {0u, 0u, 0u, 0u}, un[4] = {0u, 0u, 0u, 0u};
    if (cur < 16) { const unsigned mk = (2u << cur) - 1u; mym[0] = mk; un[0] = mk; }
    else {
        const int tq = lane >> 3, sub = lane & 7;
        int key[16];
#pragma unroll
        for (int i = 0; i < 16; ++i) { const int j = 16 * sub + i; const float v = imp[tq * IMP_LD + j];
            key[i] = (j >= 1 && j <= cur - 2) ? (int)((__builtin_bit_cast(unsigned, v) & ~0x7fu) | (unsigned)(127 - j)) : 0; }
        sort16_desc(key);
        { int ot[16];
#pragma unroll
          for (int i = 0; i < 16; ++i) ot[i] = __builtin_amdgcn_mov_dpp(key[i], 0xB1, 0xf, 0xf, true);
          merge16_desc(key, ot);
#pragma unroll
          for (int i = 0; i < 16; ++i) ot[i] = __builtin_amdgcn_mov_dpp(key[i], 0x4E, 0xf, 0xf, true);
          merge16_desc(key, ot);
#pragma unroll
          for (int i = 0; i < 16; ++i) ot[i] = __builtin_amdgcn_mov_dpp(key[i], 0x141, 0xf, 0xf, true);
          merge16_desc(key, ot); }
        unsigned mk[4] = {1u, 0u, 0u, 0u};
        { const int c1 = cur - 1; if (c1 < 32) mk[0] |= 1u << c1; else if (c1 < 64) mk[1] |= 1u << (c1 - 32); else if (c1 < 96) mk[2] |= 1u << (c1 - 64); else mk[3] |= 1u << (c1 - 96);
          if (cur < 32) mk[0] |= 1u << cur; else if (cur < 64) mk[1] |= 1u << (cur - 32); else if (cur < 96) mk[2] |= 1u << (cur - 64); else mk[3] |= 1u << (cur - 96); }
#pragma unroll
        for (int i = 0; i < 13; ++i) { const int j = 127 - (key[i] & 0x7f); const unsigned bit = (key[i] != 0) ? (1u << (j & 31)) : 0u; const int wd = j >> 5;
            mk[0] |= (wd == 0) ? bit : 0u; mk[1] |= (wd == 1) ? bit : 0u; mk[2] |= (wd == 2) ? bit : 0u; mk[3] |= (wd == 3) ? bit : 0u; }
#pragma unroll
        for (int i = 0; i < 4; ++i) { unsigned u = mk[i]; u |= (unsigned)__shfl_xor((int)u, 8); u |= (unsigned)__shfl_xor((int)u, 16); u |= (unsigned)__shfl_xor((int)u, 32); un[i] = u;
            mym[i] = (unsigned)__shfl((int)mk[i], 8 * ti); }
    }
    float q2 = 0.f;
#pragma unroll
    for (int ks = 0; ks < 4; ++ks) { const v4u qw = __builtin_bit_cast(v4u, qf[ks]); const unsigned ww[4] = {qw.x, qw.y, qw.z, qw.w};
#pragma unroll
        for (int k = 0; k < 4; ++k) { const float a = bflo(ww[k]), c = bfhi(ww[k]); q2 += a * a + c * c; } }
    q2 = addswap32_f(q2);
    const unsigned* KMX = (const unsigned*)(ws + WS_CTL) + CW_KMAX + (b * 2 + kvh) * 2;
    const float Ms = __builtin_amdgcn_sqrtf(q2 * __builtin_bit_cast(float, KMX[0])) * 1.0001f + 1e-3f, Mw = __builtin_amdgcn_sqrtf(q2 * __builtin_bit_cast(float, KMX[1])) * 1.0001f + 1e-3f;
    const bool fixed_ok = !__any(Ms >= 60.f || Mw >= 60.f);
    {
        AttnSt st; st.m = -1e30f; st.l = 0.f; st.o[0] = f32x16{}; st.o[1] = f32x16{};
        const bf16* KS = (const bf16*)(ws + WS_KSF) + (size_t)(b * 2 + kvh) * 256 * 2048; const unsigned char* VS = ws + WS_VSF + (size_t)(b * 2 + kvh) * 256 * 2048;
        const unsigned lo16 = 16u * (unsigned)lane;
        unsigned um0 = (unsigned)__builtin_amdgcn_readfirstlane((int)un[0]), um1 = (unsigned)__builtin_amdgcn_readfirstlane((int)un[1]), um2 = (unsigned)__builtin_amdgcn_readfirstlane((int)un[2]), um3 = (unsigned)__builtin_amdgcn_readfirstlane((int)un[3]);
#define NEXT_BLOCK(jv) do { if (um0) { jv = __builtin_ctz(um0); um0 &= um0 - 1u; } else if (um1) { jv = 32 + __builtin_ctz(um1); um1 &= um1 - 1u; } else if (um2) { jv = 64 + __builtin_ctz(um2); um2 &= um2 - 1u; } \
            else if (um3) { jv = 96 + __builtin_ctz(um3); um3 &= um3 - 1u; } else jv = -1; } while (0)
#define SLC_LOOP(FX) do { f32x16 negm; _Pragma("unroll") for (int r = 0; r < 16; ++r) negm[r] = -Ms; \
        KVF8 fa, fb; int j; NEXT_BLOCK(j); \
        if (j >= 0) kv_load8(fa, KS + (size_t)j * 4096, VS + (size_t)j * 4096, lo16); \
        while (j >= 0) { const int key0 = j * 64; \
            const unsigned mw = (j < 32) ? mym[0] : (j < 64) ? mym[1] : (j < 96) ? mym[2] : mym[3]; const bool sel = (mw >> (j & 31)) & 1u; \
            kv_load8(fb, KS + (size_t)j * 4096 + 2048, VS + (size_t)j * 4096 + 2048, lo16); \
            if (j == cur) attn_compute<2, FX>(fa, qf, negm, sel, [&](int r) { return sel && (key0 + crow(r, hi) <= t); }, st); \
            else attn_compute<1, FX>(fa, qf, negm, sel, [&](int) { return true; }, st); \
            int jn; NEXT_BLOCK(jn); \
            if (jn >= 0) kv_load8(fa, KS + (size_t)jn * 4096, VS + (size_t)jn * 4096, lo16); \
            if (j == cur) attn_compute<2, FX>(fb, qf, negm, sel, [&](int r) { return sel && (key0 + 32 + crow(r, hi) <= t); }, st); \
            else attn_compute<1, FX>(fb, qf, negm, sel, [&](int) { return true; }, st); \
            j = jn; } } while (0)
        if (fixed_ok) SLC_LOOP(true); else SLC_LOOP(false);
#undef SLC_LOOP
#undef NEXT_BLOCK
        const float l = addswap32_f(st.l); const float sc = gate_s / l;
#pragma unroll
        for (int dt = 0; dt < 2; ++dt)
#pragma unroll
            for (int r = 0; r < 16; ++r) oacc[(dt * 16 + r) * 64] += sc * st.o[dt][r];
    }
    f32x16 outv[2];
    {
        AttnSt st; st.m = -1e30f; st.l = 0.f; st.o[0] = f32x16{}; st.o[1] = f32x16{};
        const bf16* KW = (const bf16*)(ws + WS_KWF) + (size_t)(b * 2 + kvh) * 256 * 2048; const unsigned char* VW = ws + WS_VWF + (size_t)(b * 2 + kvh) * 256 * 2048;
        const unsigned lo16 = 16u * (unsigned)lane;
        const int klo = (t0 - 511 > 0) ? ((t0 - 511) & ~31) : 0, khi = (t0 + 7) & ~31;
#define WIN_LOOP(FX) do { f32x16 negm; _Pragma("unroll") for (int r = 0; r < 16; ++r) negm[r] = -Mw; \
        KVF8 fa, fb; kv_load8(fa, KW + (size_t)klo * 64, VW + (size_t)klo * 64, lo16); \
        _Pragma("unroll 1") for (int key0 = klo; key0 <= khi; key0 += 32) { \
            if (key0 + 32 <= khi) kv_load8(fb, KW + (size_t)(key0 + 32) * 64, VW + (size_t)(key0 + 32) * 64, lo16); \
            if (key0 + 31 > t0 || key0 <= t0 + 7 - 512) attn_compute<2, FX>(fa, qf, negm, true, [&](int r) { const int kp = key0 + crow(r, hi); return kp <= t && kp > t - 512; }, st); \
            else attn_compute<0, FX>(fa, qf, negm, true, [&](int) { return true; }, st); \
            if (key0 + 32 <= khi) fa = fb; } } while (0)
        if (fixed_ok) WIN_LOOP(true); else WIN_LOOP(false);
#undef WIN_LOOP
        const float l = addswap32_f(st.l); const float sc = gate_w / l;
#pragma unroll
        for (int dt = 0; dt < 2; ++dt)
#pragma unroll
            for (int r = 0; r < 16; ++r) outv[dt][r] = oacc[(dt * 16 + r) * 64] + sc * st.o[dt][r];
    }
    float ss = 0.f;
#pragma unroll
    for (int dt = 0; dt < 2; ++dt)
#pragma unroll
        for (int r = 0; r < 16; ++r) ss += outv[dt][r] * outv[dt][r];
    ss += __shfl_xor(ss, 32); ss += __shfl_xor(ss, 8); ss += __shfl_xor(ss, 16);
    if (lane < 8) ((float*)(ws + WS_SSQN))[(rowb + t0 + lane) * 2 + kvh] = ss;
    bf16* Yp = (bf16*)(ws + WS_Y) + (rowb + t) * DM + (kvh * 4 + g) * 64 + 4 * hi;
#pragma unroll
    for (int dt = 0; dt < 2; ++dt)
#pragma unroll
        for (int q = 0; q < 4; ++q) { v2u o; o.x = pk2(outv[dt][4 * q], outv[dt][4 * q + 1]); o.y = pk2(outv[dt][4 * q + 2], outv[dt][4 * q + 3]); *(v2u*)(Yp + 32 * dt + 8 * q) = o; }
}
__device__ __forceinline__ void memattn_item(const Frame& F, const Args& A, int item) {
    unsigned char* ws = A.ws;
    const int lane = F.lane, r32 = lane & 31, hi = lane >> 5;
    const int h = item & 3, tile = item >> 2; const size_t row0 = (size_t)tile * 32; const int b = (int)(row0 >> 13);
    const bf16* Q = (const bf16*)(ws + WS_QM) + (size_t)tile * 32 * DM + (size_t)(h * 16) * 512 + 8 * lane;
    const bf16* K = (const bf16*)(ws + WS_MEMK) + (size_t)(b * 8) * 32 * DM + (size_t)(h * 16) * 512 + 8 * lane;
    const bf16* VF = (const bf16*)(ws + WS_MEMVT) + (size_t)((b * 4 + h) * 8) * 8192 + 8 * lane;
    f32x16 s[8];
#pragma unroll
    for (int kt = 0; kt < 8; ++kt) s[kt] = f32x16{};
#define QK_LOAD(qv, kv, ks_) do { const int kk_ = (ks_) < 16 ? (ks_) : 15; qv = *(const bf16x8*)(Q + 512 * kk_); _Pragma("unroll") for (int kt = 0; kt < 8; ++kt) kv[kt] = *(const bf16x8*)(K + (size_t)kt * 32 * DM + 512 * kk_); } while (0)
#define QK_MMA(qv, kv) do { _Pragma("unroll") for (int kt = 0; kt < 8; ++kt) s[kt] = __builtin_amdgcn_mfma_f32_32x32x16_bf16(kv[kt], qv, s[kt], 0, 0, 0); } while (0)
    { bf16x8 qa, qb, ka[8], kb[8];
      QK_LOAD(qa, ka, 0);
#pragma unroll 1
      for (int ks = 0; ks < 16; ks += 2) {
          QK_LOAD(qb, kb, ks + 1); asm volatile("" ::: "memory");
          QK_MMA(qa, ka);
          QK_LOAD(qa, ka, ks + 2); asm volatile("" ::: "memory");
          QK_MMA(qb, kb); } }
#undef QK_LOAD
#undef QK_MMA
    float m = -1e30f;
#pragma unroll
    for (int kt = 0; kt < 8; ++kt) m = fmaxf(m, max16(s[kt]));
    m = maxswap32_f(m);
    float l = 0.f; v4u pw[8][2];
#pragma unroll
    for (int kt = 0; kt < 8; ++kt) {
#pragma unroll
        for (int r = 0; r < 16; ++r) s[kt][r] = EX2(s[kt][r] - m);
        l += sum16(s[kt]);
#pragma unroll
        for (int s2 = 0; s2 < 2; ++s2) { pw[kt][s2].x = pk2(s[kt][8 * s2], s[kt][8 * s2 + 1]); pw[kt][s2].y = pk2(s[kt][8 * s2 + 2], s[kt][8 * s2 + 3]); pw[kt][s2].z = pk2(s[kt][8 * s2 + 4], s[kt][8 * s2 + 5]); pw[kt][s2].w = pk2(s[kt][8 * s2 + 6], s[kt][8 * s2 + 7]); } }
    l = addswap32_f(l);
    const float invl = 1.0f / l;
    bf16* O = (bf16*)(ws + WS_OM) + (row0 + r32) * DM + h * 256 + 4 * hi;
#define PV_LOAD(vv, dt_) do { const int dd_ = (dt_) < 8 ? (dt_) : 7; _Pragma("unroll") for (int kt = 0; kt < 8; ++kt) _Pragma("unroll") for (int s2 = 0; s2 < 2; ++s2) vv[2 * kt + s2] = *(const bf16x8*)(VF + (size_t)kt * 8192 + dd_ * 1024 + s2 * 512); } while (0)
#define PV_MMA(vv, dt_) do { f32x16 o = f32x16{}; _Pragma("unroll") for (int kt = 0; kt < 8; ++kt) _Pragma("unroll") for (int s2 = 0; s2 < 2; ++s2) o = __builtin_amdgcn_mfma_f32_32x32x16_bf16(vv[2 * kt + s2], __builtin_bit_cast(bf16x8, pw[kt][s2]), o, 0, 0, 0); \
        _Pragma("unroll") for (int q = 0; q < 4; ++q) { v2u ov; ov.x = pk2(o[4 * q] * invl, o[4 * q + 1] * invl); ov.y = pk2(o[4 * q + 2] * invl, o[4 * q + 3] * invl); *(v2u*)(O + 32 * (dt_) + 8 * q) = ov; } } while (0)
    { bf16x8 va[16], vb[16];
      PV_LOAD(va, 0);
#pragma unroll 1
      for (int dt = 0; dt < 8; dt += 2) {
          PV_LOAD(vb, dt + 1); asm volatile("" ::: "memory");
          PV_MMA(va, dt);
          PV_LOAD(va, dt + 2); asm volatile("" ::: "memory");
          PV_MMA(vb, dt + 1); } }
#undef PV_LOAD
#undef PV_MMA
}

__device__ __forceinline__ int f2key(float f) { const int u = __builtin_bit_cast(int, f); return u ^ ((u >> 31) & 0x7fffffff); }
__device__ __forceinline__ float key2f(int k) { const int u = k ^ ((k >> 31) & 0x7fffffff); return __builtin_bit_cast(float, u); }
__device__ __forceinline__ void top16_of_128(f32x16 (&s)[4], int hi, int (&kv)[16]) {
    int key[4][16];
#pragma unroll
    for (int nt = 0; nt < 4; ++nt)
#pragma unroll
        for (int r = 0; r < 16; ++r) key[nt][r] = (f2key(s[nt][r]) & ~0x7f) | (127 - (32 * nt + crow(r, hi)));
#pragma unroll
    for (int nt = 0; nt < 4; ++nt) sort16_desc(key[nt]);
    merge16_desc(key[0], key[1]); merge16_desc(key[2], key[3]); merge16_desc(key[0], key[2]);
    unsigned a[16], b[16];
#pragma unroll
    for (int i = 0; i < 16; ++i) { a[i] = (unsigned)key[0][i]; b[i] = a[i]; swap32(a[i], b[i]); }
#pragma unroll
    for (int i = 0; i < 16; ++i) kv[i] = max((int)a[i], (int)b[15 - i]);
    bitonic16_desc(kv);
}
template <bool LDSK>
__device__ __forceinline__ void peer_topk_item(const Frame& F, const Args& A, int item, const LAS unsigned char* lds) {
    unsigned char* ws = A.ws;
    int lane = lane_id(); asm volatile("" : "+v"(lane));
    const int r32 = lane & 31, hi = lane >> 5;
    const int h = item & 7, tile = item >> 3; const size_t row = (size_t)tile * 32 + r32;
    const bf16* QP = (const bf16*)(ws + WS_QP) + (size_t)tile * 32 * 2048 + (size_t)(h * 16) * 512 + 8 * lane;
    int k1[16], k2[16];
#pragma unroll
    for (int i = 0; i < 16; ++i) { k1[i] = 0; k2[i] = 0; }
#pragma unroll 1
    for (int c = 0; c < 2; ++c) {
        const bf16* SK = (const bf16*)(ws + WS_SKEY) + (size_t)((h * 2 + c) * 4) * 4096 + 8 * lane;
        f32x16 s[4];
#pragma unroll
        for (int nt = 0; nt < 4; ++nt) s[nt] = f32x16{};
        bf16x8 qf[8];
#pragma unroll
        for (int ks = 0; ks < 8; ++ks) qf[ks] = *(const bf16x8*)(QP + (size_t)(c * 8 + ks) * 512);
#pragma unroll
        for (int ks = 0; ks < 8; ++ks) {
#pragma unroll
            for (int nt = 0; nt < 4; ++nt) { const bf16x8 kf = LDSK ? *(const LAS bf16x8*)(lds + ((c * 4 + nt) * 4096 + ks * 512) * 2 + lane * 16) : *(const bf16x8*)(SK + (size_t)nt * 4096 + ks * 512);
                s[nt] = __builtin_amdgcn_mfma_f32_32x32x16_bf16(kf, qf[ks], s[nt], 0, 0, 0); } }
        if (c == 0) top16_of_128(s, hi, k1); else top16_of_128(s, hi, k2);
    }
    float v1[16], v2[16];
#pragma unroll
    for (int i = 0; i < 16; ++i) { v1[i] = key2f(k1[i] & ~0x7f); v2[i] = key2f(k2[i] & ~0x7f); }
    int ck[32];
    {
        int idx = 0;
#pragma unroll
        for (int i = 0; i < 32; ++i) ck[i] = (int)0x80000000;
#pragma unroll
        for (int a = 0; a < 16; ++a)
#pragma unroll
            for (int bq = 0; bq < 16; ++bq) if ((a + 1) * (bq + 1) <= 16) {
                const int flat = a * 16 + bq; const int kk = (f2key(v1[a] + v2[bq]) & ~0xff) | (255 - flat);
                if ((idx & 1) == hi) ck[idx >> 1] = kk;
                ++idx; }
    }
    sort32_desc(ck);
    int tk[16];
    { unsigned a[16], b[16];
#pragma unroll
      for (int i = 0; i < 16; ++i) { a[i] = (unsigned)ck[i]; b[i] = a[i]; swap32(a[i], b[i]); }
#pragma unroll
      for (int i = 0; i < 16; ++i) tk[i] = max((int)a[i], (int)b[15 - i]);
      bitonic16_desc(tk); }
    int te[16];
    { LAS int* tab = (LAS int*)(lds + 65536 + F.wave * 8448) + lane * 33;
#pragma unroll
      for (int i = 0; i < 16; ++i) { tab[i] = 127 - (k1[i] & 0x7f); tab[16 + i] = 127 - (k2[i] & 0x7f); }
      asm volatile("s_waitcnt lgkmcnt(0)" ::: "memory");
#pragma unroll
      for (int i = 0; i < 16; ++i) { const int flat = 255 - (tk[i] & 0xff); te[i] = tab[flat >> 4] * 128 + tab[16 + (flat & 15)]; }
      asm volatile("s_waitcnt lgkmcnt(0)" ::: "memory"); }
    float gsm[16]; const float mx = key2f(tk[0] & ~0xff); float den = 0.f;
#pragma unroll
    for (int i = 0; i < 16; ++i) { gsm[i] = __expf(key2f(tk[i] & ~0xff) - mx); den += gsm[i]; }
    const float inv = 1.0f / den;
    if (hi == 0) {
        int* EID = (int*)(ws + WS_EID) + row * 128 + h * 16; float* GW = (float*)(ws + WS_GW) + row * 128 + h * 16;
#pragma unroll
        for (int q = 0; q < 4; ++q) { *(v4u*)(EID + 4 * q) = (v4u){(unsigned)te[4 * q], (unsigned)te[4 * q + 1], (unsigned)te[4 * q + 2], (unsigned)te[4 * q + 3]};
            *(f32x4*)(GW + 4 * q) = (f32x4){gsm[4 * q] * inv, gsm[4 * q + 1] * inv, gsm[4 * q + 2] * inv, gsm[4 * q + 3] * inv}; }
    }
}

typedef float f32x2 __attribute__((ext_vector_type(2)));
__device__ __forceinline__ float dot16_fp8(const v4u u, const f32x2 (&xn)[8]) {
    f32x2 a0 = {0.f, 0.f}, a1 = {0.f, 0.f};
#pragma unroll
    for (int j = 0; j < 4; ++j) { const f32x2 lo = __builtin_amdgcn_cvt_pk_f32_fp8((int)u[j], false), hi = __builtin_amdgcn_cvt_pk_f32_fp8((int)u[j], true);
        a0 = __builtin_elementwise_fma(lo, xn[2 * j], a0); a1 = __builtin_elementwise_fma(hi, xn[2 * j + 1], a1); }
    return (a0.x + a0.y) + (a1.x + a1.y);
}
__device__ __forceinline__ void axpy16_fp8(f32x2 (&acc)[8], const float w, const v4u u) {
    const f32x2 w2 = {w, w};
#pragma unroll
    for (int j = 0; j < 4; ++j) { const f32x2 lo = __builtin_amdgcn_cvt_pk_f32_fp8((int)u[j], false), hi = __builtin_amdgcn_cvt_pk_f32_fp8((int)u[j], true);
        acc[2 * j] = __builtin_elementwise_fma(lo, w2, acc[2 * j]); acc[2 * j + 1] = __builtin_elementwise_fma(hi, w2, acc[2 * j + 1]); }
}
#define TIE_ROW(val, nxt) asm volatile("" : "+v"(val), "+v"((nxt).x), "+v"((nxt).y), "+v"((nxt).z), "+v"((nxt).w))
constexpr int PQ_CHUNK = 128, PQ_NCHUNK = MTOK / PQ_CHUNK;
constexpr int CW_NQ = 10240;
constexpr int CW_PQ = 8192;
__device__ __forceinline__ int pq_pop(unsigned* ctl, int pass, int own, int& q_s, LAS int* bc, int wave) {
    __syncthreads();
    if (wave == 0 && lane_id() == 0) { int res = -1; int s = q_s;
        while (s < 8) { const int x = (own + s) & 7; const unsigned c = __hip_atomic_fetch_add(ctl + CW_PQ + 64 * (8 * pass + x), 1u, __ATOMIC_RELAXED, __HIP_MEMORY_SCOPE_AGENT);
            if (c < (unsigned)PQ_NCHUNK) { res = x * PQ_NCHUNK + (int)c; break; } ++s; }
        bc[0] = res; bc[1] = s; }
    __syncthreads();
    q_s = bc[1]; return bc[0];
}
template <int CTRL> __device__ __forceinline__ float dppf(float v) { return __builtin_bit_cast(float, __builtin_amdgcn_mov_dpp(__builtin_bit_cast(int, v), CTRL, 0xf, 0xf, true)); }
__device__ __forceinline__ float red8(float d) { d += dppf<0xB1>(d); d += dppf<0x4E>(d); d += dppf<0x141>(d); return d; }
__device__ __forceinline__ void peer_issue8(v4u (&rb)[8], const v4u ia, const v4u ib, const unsigned char* T  , unsigned c16) {
    const unsigned e[8] = {ia.x, ia.y, ia.z, ia.w, ib.x, ib.y, ib.z, ib.w};
#pragma unroll
    for (int i = 0; i < 8; ++i) rb[i] = *(const v4u*)(T + (e[i] * 128u + c16));
}
__device__ __forceinline__ void peer_u_chunk(const Frame& F, const Args& A, int x, int chunk) {
    unsigned char* ws = A.ws; int lane = lane_id(); asm volatile("" : "+v"(lane));
    const int tk = lane >> 3, c8 = lane & 7;
    const unsigned char* U = ws + WS_U8 + (size_t)x * 16384 * 128; const unsigned c16 = 16u * (unsigned)c8;
#pragma unroll 1
    for (int oc = 0; oc < 2; ++oc) {
        const unsigned row = (unsigned)(chunk * PQ_CHUNK + F.wave * 16 + oc * 8 + tk);
        const unsigned char* EIDb = ws + WS_EID; const unsigned eoff = row * 512u;
#define EID_LD(i_) (*(const v4u*)(EIDb + (eoff + 16u * (unsigned)(i_))))
        f32x2 xn[8];
        { const unsigned char* xb_ = ws + WS_XN; const unsigned xo = row * 2048u + 256u * (unsigned)x + 32u * (unsigned)c8; const v4u xa = *(const v4u*)(xb_ + xo), xb = *(const v4u*)(xb_ + (xo + 16u));
          const unsigned xw[8] = {xa.x, xa.y, xa.z, xa.w, xb.x, xb.y, xb.z, xb.w};
#pragma unroll
          for (int j = 0; j < 8; ++j) { xn[j].x = bflo(xw[j]); xn[j].y = bfhi(xw[j]); } }
        float rstd; { const f32x4* sp = (const f32x4*)(ws + WS_SSQ2 + (size_t)row * 64); const f32x4 a = sp[0], b = sp[1], c = sp[2], d = sp[3];
            rstd = rsqrtf((((a.x + a.y) + (a.z + a.w)) + ((b.x + b.y) + (b.z + b.w)) + ((c.x + c.y) + (c.z + c.w)) + ((d.x + d.y) + (d.z + d.w))) * (1.f / DM) + EPS); }
        unsigned char* ppb = ws + WS_PART; const unsigned po = ((unsigned)x * MTOK + row) * 256u + 32u * (unsigned)c8;
        v4u ra[8], rb[8]; v4u ia0 = EID_LD(0), ia1 = EID_LD(1), ib0 = EID_LD(2), ib1 = EID_LD(3);
        peer_issue8(ra, ia0, ia1, U, c16); ia0 = EID_LD(4); ia1 = EID_LD(5);
#pragma unroll 1
        for (int q = 0; q < 16; q += 2) {
            peer_issue8(rb, ib0, ib1, U, c16); { const int qn = (q + 3 < 16) ? q + 3 : 15; ib0 = EID_LD(2 * qn); ib1 = EID_LD(2 * qn + 1); }
            float k0 = 0.f, k1 = 0.f;
#pragma unroll
            for (int i = 0; i < 8; ++i) { float d = dot16_fp8(ra[i], xn); if (i < 7) TIE_ROW(d, ra[i + 1]); d = red8(d); k0 = (c8 == i) ? d : k0; }
            peer_issue8(ra, ia0, ia1, U, c16); { const int qn = (q + 4 < 16) ? q + 4 : 15; ia0 = EID_LD(2 * qn); ia1 = EID_LD(2 * qn + 1); }
#pragma unroll
            for (int i = 0; i < 8; ++i) { float d = dot16_fp8(rb[i], xn); if (i < 7) TIE_ROW(d, rb[i + 1]); d = red8(d); k1 = (c8 == i) ? d : k1; }
            *(unsigned*)(ppb + (po + 2u * (unsigned)q)) = pk2(k0 * rstd, k1 * rstd);
        }
    }
}
__device__ __forceinline__ void peer_w_rows(const Frame& F, const Args& A) {
    unsigned char* ws = A.ws; const int lane = lane_id();
    const float* SU = (const float*)(ws + WS_SU); const float* SV = (const float*)(ws + WS_SV);
    const int p0 = 2 * lane, k0 = 8 * (p0 & 15) + (p0 >> 4), k1 = k0 + 8;
    for (int m0 = F.gw; m0 < MTOK; m0 += 4 * F.NGW) {
        int e0[4], e1[4]; float g0[4], g1[4]; unsigned pw[4][8];
#pragma unroll
        for (int r = 0; r < 4; ++r) { const size_t row = (size_t)(m0 + r * F.NGW < MTOK ? m0 + r * F.NGW : m0);
            const int* EID = (const int*)(ws + WS_EID) + row * 128; const float* GW = (const float*)(ws + WS_GW) + row * 128;
            e0[r] = EID[k0]; e1[r] = EID[k1]; g0[r] = GW[k0]; g1[r] = GW[k1];
#pragma unroll
            for (int x = 0; x < 8; ++x) pw[r][x] = *(const unsigned*)((const bf16*)(ws + WS_PART) + ((size_t)x * MTOK + row) * 128 + p0); }
        float su0[4], su1[4], sv0[4], sv1[4];
#pragma unroll
        for (int r = 0; r < 4; ++r) { su0[r] = SU[e0[r]]; su1[r] = SU[e1[r]]; sv0[r] = SV[e0[r]]; sv1[r] = SV[e1[r]]; }
#pragma unroll
        for (int r = 0; r < 4; ++r) { if (m0 + r * F.NGW < MTOK) { const size_t row = (size_t)(m0 + r * F.NGW); float s0 = 0.f, s1 = 0.f;
#pragma unroll
            for (int x = 0; x < 8; ++x) { s0 += bflo(pw[r][x]); s1 += bfhi(pw[r][x]); }
            float* W = (float*)(ws + WS_W) + row * 128;
            W[k0] = gelu_tanh(s0 * su0[r]) * g0[r] * sv0[r]; W[k1] = gelu_tanh(s1 * su1[r]) * g1[r] * sv1[r]; } }
    }
}
__device__ __forceinline__ void peer_v_chunk(const Frame& F, const Args& A, int x, int chunk) {
    unsigned char* ws = A.ws; int lane = lane_id(); asm volatile("" : "+v"(lane));
    const int tk = lane >> 3, c8 = lane & 7;
    const unsigned char* V = ws + WS_V8 + (size_t)x * 16384 * 128; const unsigned c16 = 16u * (unsigned)c8;
#pragma unroll 1
    for (int oc = 0; oc < 2; ++oc) {
        const unsigned row = (unsigned)(chunk * PQ_CHUNK + F.wave * 16 + oc * 8 + tk);
        const unsigned char* EIDb = ws + WS_EID; const unsigned char* Wb = ws + WS_W; const unsigned eoff = row * 512u;
#define W_LD(i_) (*(const f32x4*)(Wb + (eoff + 16u * (unsigned)(i_))))
        f32x2 acc[8];
#pragma unroll
        for (int j = 0; j < 8; ++j) acc[j] = (f32x2){0.f, 0.f};
        v4u ra[8], rb[8]; v4u ia0 = EID_LD(0), ia1 = EID_LD(1), ib0 = EID_LD(2), ib1 = EID_LD(3); f32x4 wa0 = W_LD(0), wa1 = W_LD(1), wb0 = W_LD(2), wb1 = W_LD(3);
        peer_issue8(ra, ia0, ia1, V, c16); ia0 = EID_LD(4); ia1 = EID_LD(5);
#pragma unroll 1
        for (int q = 0; q < 16; q += 2) {
            peer_issue8(rb, ib0, ib1, V, c16); { const int qn = (q + 3 < 16) ? q + 3 : 15; ib0 = EID_LD(2 * qn); ib1 = EID_LD(2 * qn + 1); }
            { const float wv[8] = {wa0.x, wa0.y, wa0.z, wa0.w, wa1.x, wa1.y, wa1.z, wa1.w};
#pragma unroll
              for (int i = 0; i < 8; ++i) { axpy16_fp8(acc, wv[i], ra[i]); if (i < 7) TIE_ROW(acc[7].y, ra[i + 1]); } }
            { const int qn = (q + 2 < 16) ? q + 2 : 15; wa0 = W_LD(2 * qn); wa1 = W_LD(2 * qn + 1); }
            peer_issue8(ra, ia0, ia1, V, c16); { const int qn = (q + 4 < 16) ? q + 4 : 15; ia0 = EID_LD(2 * qn); ia1 = EID_LD(2 * qn + 1); }
            { const float wv[8] = {wb0.x, wb0.y, wb0.z, wb0.w, wb1.x, wb1.y, wb1.z, wb1.w};
#pragma unroll
              for (int i = 0; i < 8; ++i) { axpy16_fp8(acc, wv[i], rb[i]); if (i < 7) TIE_ROW(acc[7].y, rb[i + 1]); } }
            { const int qn = (q + 3 < 16) ? q + 3 : 15; wb0 = W_LD(2 * qn); wb1 = W_LD(2 * qn + 1); }
        }
        unsigned char* xr = ws + WS_XN + (row * 2048u + 256u * (unsigned)x + 32u * (unsigned)c8); float ss = 0.f;
        const v4u x2a = *(const v4u*)xr, x2b = *(const v4u*)(xr + 16);
        const unsigned xw[8] = {x2a.x, x2a.y, x2a.z, x2a.w, x2b.x, x2b.y, x2b.z, x2b.w};
        unsigned ow[8];
#pragma unroll
        for (int j = 0; j < 4; ++j) { f32x4 v; v.x = bflo(xw[2 * j]) + acc[2 * j].x; v.y = bfhi(xw[2 * j]) + acc[2 * j].y; v.z = bflo(xw[2 * j + 1]) + acc[2 * j + 1].x; v.w = bfhi(xw[2 * j + 1]) + acc[2 * j + 1].y;
            ss += (v.x * v.x + v.y * v.y) + (v.z * v.z + v.w * v.w); ow[2 * j] = pk2(v.x, v.y); ow[2 * j + 1] = pk2(v.z, v.w); }
        *(v4u*)xr = (v4u){ow[0], ow[1], ow[2], ow[3]}; *(v4u*)(xr + 16) = (v4u){ow[4], ow[5], ow[6], ow[7]};
        ss = red8(ss);
        if (c8 == 0) ((float*)(ws + WS_SSQ3))[row * 8 + x] = ss;
    }
#undef W_LD
#undef EID_LD
}
__device__ __forceinline__ void peer_final_rows(const Frame& F, const Args& A) {
    unsigned char* ws = A.ws; const int lane = lane_id(); const float* g = A.in[32];
    for (int m = F.gw; m < MTOK; m += F.NGW) {
        const f32x4 sa = *(const f32x4*)((const float*)(ws + WS_SSQ3) + (size_t)m * 8), sb = *(const f32x4*)((const float*)(ws + WS_SSQ3) + (size_t)m * 8 + 4);
        const float rstd = rsqrtf((((sa.x + sa.y) + (sa.z + sa.w)) + ((sb.x + sb.y) + (sb.z + sb.w))) * (1.f / DM) + EPS);
        f32x4* xr = (f32x4*)(A.out + (size_t)m * DM) + lane; const v2u* xb = (const v2u*)((const bf16*)(ws + WS_XN) + (size_t)m * DM) + lane;
#pragma unroll
        for (int j = 0; j < 4; ++j) { const v2u w = xb[64 * j]; const f32x4 gg = ((const f32x4*)g)[lane + 64 * j]; const f32x4 v = {bflo(w.x), bfhi(w.x), bflo(w.y), bfhi(w.y)}; __builtin_nontemporal_store(v * rstd * gg, xr + 64 * j); }
    }
}

typedef GAS unsigned gu32;
#define RLX_AGENT __ATOMIC_RELAXED, __HIP_MEMORY_SCOPE_AGENT
#define XB_TMO      128
#define XB_XCNT(j)  (256  + 64 * (j))
#define XB_XSUB(j)  (1280 + 64 * (j))
#define XB_XGEN(j)  (2304 + 64 * (j))
#define XB_TOP      3328
#define XB_TOPGEN   3392
#define XCD_BAR_WORDS 3456
#define XB_SPIN_CAP (1u << 18)

__device__ __forceinline__ unsigned xb_ld(unsigned* p)              { return __hip_atomic_load(p, __ATOMIC_RELAXED, __HIP_MEMORY_SCOPE_AGENT); }
__device__ __forceinline__ unsigned xb_add(unsigned* p, unsigned v) { return __hip_atomic_fetch_add(p, v, __ATOMIC_RELAXED, __HIP_MEMORY_SCOPE_AGENT); }
__device__ __forceinline__ unsigned xb_xcc_id() { return (unsigned)__builtin_amdgcn_s_getreg((3 << 11) | 20) & 0xFu; }
#define XB_SPIN(cond, bar) do { unsigned _sp = 0; while (cond) { __builtin_amdgcn_s_sleep(1); \
    if ((++_sp & 255u) == 0u) { if (xb_ld(&(bar)[XB_TMO])) break; if (_sp > XB_SPIN_CAP) { atomicAdd(&(bar)[XB_TMO], 1u); break; } } } } while (0)

struct XcdBarrier {
    unsigned* bar; unsigned x;
    volatile LAS unsigned* st;
};

__device__ __forceinline__ XcdBarrier xcd_barrier_post(unsigned* bar, volatile LAS unsigned* st) {
    XcdBarrier b; b.bar = bar; b.x = xb_xcc_id(); b.st = st;
    if (threadIdx.x == 0) (void)xb_add(&bar[XB_XCNT(b.x)], 1u);
    return b;
}
__device__ __forceinline__ void xcd_barrier_complete(unsigned* bar, unsigned x, unsigned& nloc, unsigned& nx) {
    const unsigned G = gridDim.x * gridDim.y * gridDim.z;
    unsigned sum, cnt, mine, sp = 0u;
    for (;;) {
        sum = 0u; cnt = 0u; mine = 0u;
#pragma unroll
        for (unsigned j = 0; j < 16; ++j) { const unsigned c = xb_ld(&bar[XB_XCNT(j)]); sum += c; cnt += (c > 0u) ? 1u : 0u; mine = (j == x) ? c : mine; }
        if (sum == G) break;
        __builtin_amdgcn_s_sleep(1);
        if ((++sp & 255u) == 0u) { if (xb_ld(&bar[XB_TMO])) break; if (sp > XB_SPIN_CAP) { atomicAdd(&bar[XB_TMO], 1u); break; } }
    }
    nloc = mine > 0u ? mine : 1u; nx = cnt > 0u ? cnt : 1u;
}

__device__ __forceinline__ void xcd_barrier(const XcdBarrier& b) {
    asm volatile("s_waitcnt vmcnt(0)" ::: "memory");
    __syncthreads();
    if (threadIdx.x == 0) {
        unsigned* bar = b.bar;
        __builtin_amdgcn_s_waitcnt(0);
        unsigned nloc = b.st[0], nx = b.st[1];
        if (nloc == 0u) { xcd_barrier_complete(bar, b.x, nloc, nx); b.st[0] = nloc; b.st[1] = nx; }
        const unsigned old = xb_add(&bar[XB_XSUB(b.x)], 1u);
        const unsigned gen = old / nloc;
        if (old + 1u == (gen + 1u) * nloc) {
            __builtin_amdgcn_fence(__ATOMIC_RELEASE, "agent");
            asm volatile("s_waitcnt vmcnt(0)" ::: "memory");
            const unsigned og = xb_add(&bar[XB_TOP], 1u);
            const unsigned tg = og / nx;
            if (og + 1u == (tg + 1u) * nx) xb_add(&bar[XB_TOPGEN], 1u);
            else XB_SPIN(xb_ld(&bar[XB_TOPGEN]) == tg, bar);
            __builtin_amdgcn_fence(__ATOMIC_ACQUIRE, "agent");
            xb_add(&bar[XB_XGEN(b.x)], 1u);
            asm volatile("s_waitcnt vmcnt(0)" ::: "memory");
        } else {
            XB_SPIN(xb_ld(&bar[XB_XGEN(b.x)]) == gen, bar);
            __builtin_amdgcn_fence(__ATOMIC_ACQUIRE, "agent");
            asm volatile("s_waitcnt vmcnt(0)" ::: "memory");
        }
    }
    __syncthreads();
}

#ifndef DBL_MASK
#define DBL_MASK 0
#endif
constexpr int NPHASE = 12;
__global__ void __launch_bounds__(512, 2) fwd_kernel(Args args) {
    extern __shared__ __attribute__((aligned(16))) unsigned char lds_raw[];
    LAS unsigned char* lds = (LAS unsigned char*)lds_raw;
    Frame F;
    F.tid = threadIdx.x; F.lane = F.tid & 63; F.wave = __builtin_amdgcn_readfirstlane(F.tid >> 6);
    F.G = gridDim.x; { const int bx = blockIdx.x; F.vcu = (F.G % 8 == 0) ? (bx % 8) * (F.G / 8) + bx / 8 : bx; }
    F.gw = F.vcu * 8 + F.wave; F.NGW = F.G * 8;
    unsigned char* ws = args.ws;
    const int lo = args.ph_lo, hi = args.ph_hi;
    volatile LAS unsigned* MISC = (volatile LAS unsigned*)(lds + LDS_BYTES - 64);
    if (F.tid < 16) MISC[F.tid] = 0u;
    __syncthreads();
    XcdBarrier bar = xcd_barrier_post((unsigned*)(ws + WS_CTL), MISC);
#define IN(k) (lo <= (k) && (k) < hi)
#define SEAM(k) do { if (IN(k) && IN((k) + 1)) xcd_barrier(bar); } while (0)

    if (IN(0)) for (int rep_ = 0; rep_ <= ((DBL_MASK >> 0) & 1); ++rep_) { if (rep_) xcd_barrier(bar); REFRESH_LANE(F); p0_prologue(F, args, lds); }
    SEAM(0);
    if (IN(1)) for (int rep_ = 0; rep_ <= ((DBL_MASK >> 1) & 1); ++rep_) { if (rep_) xcd_barrier(bar); REFRESH_LANE(F);
        { pg8::Gemm g{(const bf16*)(ws + WS_XN), (const bf16*)(ws + WS_WIN), MTOK, NZP, DM}; pg8::StaticOrder S; S.init(MTOK, NZP, F.G, (int)blockIdx.x);
          pg8::EpiZ E{(bf16*)(ws + WS_Z), (bf16*)(ws + WS_KSF), (bf16*)(ws + WS_VSF), (bf16*)(ws + WS_KWF), (bf16*)(ws + WS_VWF), (float*)(ws + WS_GATES), args.in[4]};
          pg8::gemm_phase<pg8::EpiZ, pg8::StaticOrder, true, true>(lds, g, S, E, F.wave); }
        { pg8::Gemm g{(const bf16*)(ws + WS_MEMN), (const bf16*)(ws + WS_WMK), NB * NMEM, DM, DM}; pg8::StaticOrder S; S.init(NB * NMEM, DM, F.G, ((int)blockIdx.x + 128) & 255);
          pg8::EpiStore E{(bf16*)(ws + WS_MEMK), DM, nullptr, 1};
          pg8::gemm_phase<pg8::EpiStore, pg8::StaticOrder, true, true>(lds, g, S, E, F.wave); }
        { pg8::Gemm g{(const bf16*)(ws + WS_WMV), (const bf16*)(ws + WS_MEMN), DM, NB * NMEM, DM}; pg8::StaticOrder S; S.init(DM, NB * NMEM, F.G, ((int)blockIdx.x + 120) & 255);
          pg8::EpiVFrag E{(bf16*)(ws + WS_MEMVT)};
          pg8::gemm_phase<pg8::EpiVFrag, pg8::StaticOrder, true, true>(lds, g, S, E, F.wave); }
    }
    SEAM(1);
    if (IN(2)) for (int rep_ = 0; rep_ <= ((DBL_MASK >> 2) & 1); ++rep_) { if (rep_) xcd_barrier(bar); REFRESH_LANE(F); for (int it = F.gw; it < 2048; it += F.NGW) kmax_item(F, args, it);
                 for (int it = F.vcu; it < 256; it += F.G) lru_local_item(F, args, lds, it);
                 for (int it = F.G - 1 - F.vcu; it < 128; it += F.G) compress_item(F, args, lds, it); }
    SEAM(2);
    if (IN(3)) for (int rep_ = 0; rep_ <= ((DBL_MASK >> 3) & 1); ++rep_) { if (rep_) xcd_barrier(bar); REFRESH_LANE(F);
                 { unsigned* ctl = (unsigned*)(ws + WS_CTL); const int own = (int)(((long)F.vcu * 8) / F.G) & 7; int qs = 0;
                   for (;;) { int id = -1;
                       if (lane_id() == 0) { while (qs < 8) { const int x = (own + qs) & 7; const unsigned c = __hip_atomic_fetch_add(ctl + CW_NQ + 64 * x, 1u, __ATOMIC_RELAXED, __HIP_MEMORY_SCOPE_AGENT);
                               if (c < 512u) { id = x * 512 + (int)c; break; } ++qs; } }
                       id = __builtin_amdgcn_readfirstlane(id); qs = __builtin_amdgcn_readfirstlane(qs);
                       if (id < 0) break;
                       const int x = id >> 9, i = id & 511; nsa_item(F, args, lds, x >> 2, (x >> 1) & 1, 2 * (63 - (i >> 3)) + (x & 1), 7 - (i & 7)); } }
                 __syncthreads(); REFRESH_LANE(F);
                 for (int it = F.vcu; it < 256; it += F.G) lru_fix_item(F, args, lds, it, false); }
    SEAM(3);
    if (IN(4)) for (int rep_ = 0; rep_ <= ((DBL_MASK >> 4) & 1); ++rep_) { if (rep_) xcd_barrier(bar); REFRESH_LANE(F);
        pg8::Gemm g{(const bf16*)(ws + WS_Y), (const bf16*)(ws + WS_WOUT), MTOK, DM, DM}; pg8::StaticOrder S; S.init(MTOK, DM, F.G, (int)blockIdx.x);
        pg8::EpiRes<true> E{args.in[0], nullptr, nullptr, (bf16*)(ws + WS_XN), (float*)(ws + WS_SSQ1), (const float*)(ws + WS_SSQN)};
        pg8::gemm_phase<pg8::EpiRes<true>, pg8::StaticOrder, true, true>(lds, g, S, E, F.wave);
    }
    SEAM(4);
    if (IN(5)) for (int rep_ = 0; rep_ <= ((DBL_MASK >> 5) & 1); ++rep_) { if (rep_) xcd_barrier(bar); REFRESH_LANE(F);
        pg8::Gemm g{(const bf16*)(ws + WS_XN), (const bf16*)(ws + WS_WMQ), MTOK, DM, DM}; pg8::StaticOrder S; S.init(MTOK, DM, F.G, (int)blockIdx.x);
        pg8::EpiStore E{(bf16*)(ws + WS_QM), DM, (const float*)(ws + WS_SSQ1), 1};
        pg8::gemm_phase<pg8::EpiStore, pg8::StaticOrder, true, true>(lds, g, S, E, F.wave);
    }
    SEAM(5);
    if (IN(6)) for (int rep_ = 0; rep_ <= ((DBL_MASK >> 6) & 1); ++rep_) { if (rep_) xcd_barrier(bar); REFRESH_LANE(F); for (int it = F.gw; it < 2048; it += F.NGW) memattn_item(F, args, it); }
    SEAM(6);
    if (IN(7)) for (int rep_ = 0; rep_ <= ((DBL_MASK >> 7) & 1); ++rep_) { if (rep_) xcd_barrier(bar); REFRESH_LANE(F);
        pg8::Gemm g{(const bf16*)(ws + WS_OM), (const bf16*)(ws + WS_WMO), MTOK, DM, DM}; pg8::StaticOrder S; S.init(MTOK, DM, F.G, (int)blockIdx.x);
        pg8::EpiRes<false> E{nullptr, (const bf16*)(ws + WS_XN), nullptr, (bf16*)(ws + WS_XN), (float*)(ws + WS_SSQ2), nullptr};
        pg8::gemm_phase<pg8::EpiRes<false>, pg8::StaticOrder, true, true>(lds, g, S, E, F.wave);
    }
    SEAM(7);
    if (IN(8)) for (int rep_ = 0; rep_ <= ((DBL_MASK >> 8) & 1); ++rep_) { if (rep_) xcd_barrier(bar); REFRESH_LANE(F);
        pg8::Gemm g{(const bf16*)(ws + WS_XN), (const bf16*)(ws + WS_WPQ), MTOK, 2048, DM}; pg8::StaticOrder S; S.init(MTOK, 2048, F.G, (int)blockIdx.x);
        pg8::EpiStore E{(bf16*)(ws + WS_QP), 2048, (const float*)(ws + WS_SSQ2), 1};
        pg8::gemm_phase<pg8::EpiStore, pg8::StaticOrder, true, true>(lds, g, S, E, F.wave);
    }
    SEAM(8);
    if (IN(9)) for (int rep_ = 0; rep_ <= ((DBL_MASK >> 9) & 1); ++rep_) { if (rep_) xcd_barrier(bar); REFRESH_LANE(F); for (int gi = F.vcu; gi < 256; gi += F.G) {
                     const int h = gi & 7, tgp = gi >> 3;
                     { const v4u* src = (const v4u*)((const bf16*)(ws + WS_SKEY) + (size_t)h * 8 * 4096); const int tid = F.wave * 64 + lane_id();
#pragma unroll
                       for (int i = 0; i < 8; ++i) ((LAS v4u*)lds)[tid + 512 * i] = src[tid + 512 * i]; }
                     __syncthreads();
                     peer_topk_item<true>(F, args, (tgp * 16 + F.wave) * 8 + h, lds); peer_topk_item<true>(F, args, (tgp * 16 + 8 + F.wave) * 8 + h, lds);
                     __syncthreads(); } }
    SEAM(9);
    if (IN(10)) {   REFRESH_LANE(F);
        LAS int* bc = (LAS int*)(lds + LDS_BYTES - 128); unsigned* ctl = (unsigned*)(ws + WS_CTL); const int own = (int)(bar.x & 7u);
        { int qs = 0; for (;;) { const int id = __builtin_amdgcn_readfirstlane(pq_pop(ctl, 0, own, qs, bc, F.wave)); if (id < 0) break; peer_u_chunk(F, args, id / PQ_NCHUNK, id % PQ_NCHUNK); } }
        xcd_barrier(bar);
        peer_w_rows(F, args);
        xcd_barrier(bar);
        { int qs = 0; for (;;) { const int id = __builtin_amdgcn_readfirstlane(pq_pop(ctl, 1, own, qs, bc, F.wave)); if (id < 0) break; peer_v_chunk(F, args, id / PQ_NCHUNK, id % PQ_NCHUNK); } }
        xcd_barrier(bar);
        peer_final_rows(F, args);
    }
#undef IN
#undef SEAM
}

extern "C" void kernel_launch(void* const* d_in, const int* in_sizes, int n_in, void* d_out, int out_size, void* d_ws, size_t ws_size, hipStream_t stream) {
    static int grid = 0;
    if (grid == 0) {
        if (n_in != 33 || out_size != MTOK * DM || ws_size < WS_END) { fprintf(stderr, "kernel_launch: unexpected problem (n_in %d, out %d, ws %zu)\n", n_in, out_size, ws_size); grid = -1; return; }
        int dev = 0, cus = 0, per_cu = 0;
        (void)hipGetDevice(&dev); (void)hipDeviceGetAttribute(&cus, hipDeviceAttributeMultiprocessorCount, dev);
        (void)hipFuncSetAttribute((const void*)fwd_kernel, hipFuncAttributeMaxDynamicSharedMemorySize, LDS_BYTES);
        (void)hipOccupancyMaxActiveBlocksPerMultiprocessor(&per_cu, (const void*)fwd_kernel, 512, LDS_BYTES);
        if (per_cu < 1) { fprintf(stderr, "kernel_launch: occupancy query says %d blocks per CU\n", per_cu); per_cu = 1; }
        grid = cus * 1;
        if (grid != 256) fprintf(stderr, "kernel_launch: %d CUs (built for 256)\n", cus);
    }
    if (grid < 0) return;
    (void)hipMemsetAsync((char*)d_ws + WS_CTL, 0, 65536, stream);
    Args a{};
    for (int i = 0; i < 33; ++i) a.in[i] = (const float*)d_in[i];
    a.out = (float*)d_out; a.ws = (unsigned char*)d_ws; a.ph_lo = 0; a.ph_hi = NPHASE;
    void* kargs[] = {&a};
    hipError_t e = hipLaunchCooperativeKernel((const void*)fwd_kernel, dim3(grid), dim3(512), kargs, LDS_BYTES, stream);
    if (e != hipSuccess) fprintf(stderr, "cooperative launch failed: %s (grid %d)\n", hipGetErrorString(e), grid);
}
```

```cpp
#include <hip/hip_runtime.h>
#include <cstdio>
#include <cstdint>

namespace pg8 {
#define PG8_LAS __attribute__((address_space(3)))
typedef unsigned short bf16_t;
typedef short bf16x8 __attribute__((ext_vector_type(8)));
typedef float f32x4 __attribute__((ext_vector_type(4)));
typedef unsigned u32x4 __attribute__((ext_vector_type(4)));
constexpr int BM = 256, BK = 64, HALF = 128, HTB = HALF * BK * 2  , STAGE_BYTES = 8 * HTB, NXCD = 8, WGM = 8;

__host__ __device__ __forceinline__ int lds_byte(int r, int c) { const int st = (r >> 4) * 2 + (c >> 5), rr = r & 15, cc = c & 31, ob = rr * 64 + cc * 2; return st * 1024 + (ob ^ (((ob >> 9) & 1) << 5)); }
__host__ __device__ __forceinline__ void stage_rc(int b, int& R, int& C) { const int st = b / 1024, sb = b % 1024, swz = sb ^ (((sb >> 9) & 1) << 5); R = (st >> 1) * 16 + swz / 64; C = (st & 1) * 32 + (swz % 64) / 2; }
__host__ __device__ __forceinline__ int perm32(int rho) { const int n = rho >> 4, i = rho & 15; return 8 * (i >> 2) + 4 * n + (i & 3); }

struct Unit { int pm, pn; };
struct Gemm { const bf16_t* A; const bf16_t* Bt; int M, N, K; };

struct StaticOrder {
    int nM, nN, nwg, G, c;
    __host__ __device__ void init(int M, int N, int G_, int c_) { nM = M / BM; nN = N / BM; nwg = nM * nN; G = G_; c = c_; }
    __host__ __device__ bool next(int i, Unit& u) const {
        const long L = (long)i * G + c; if (L >= nwg) return false;
        int wgid = (int)L; { const int q = nwg / NXCD, r = nwg % NXCD, xcd = wgid % NXCD, off = wgid / NXCD; wgid = (xcd < r ? xcd * (q + 1) : r * (q + 1) + (xcd - r) * q) + off; }
        const int nig = WGM * nN, gid = wgid / nig, fm = gid * WGM, gsz = (nM - fm) < WGM ? (nM - fm) : WGM;
        u.pm = fm + ((wgid % nig) % gsz); u.pn = (wgid % nig) / gsz; return true;
    }
    __device__ __forceinline__ void a_ready(const Unit&) const {}
    __device__ __forceinline__ void done(const Unit&) const {}
};

__device__ __forceinline__ unsigned cvt_pk_bf16(float lo, float hi) { unsigned r; asm volatile("v_cvt_pk_bf16_f32 %0, %1, %2" : "=v"(r) : "v"(lo), "v"(hi)); return r; }
typedef float f32x2 __attribute__((ext_vector_type(2)));
typedef unsigned u32x2 __attribute__((ext_vector_type(2)));
__device__ __forceinline__ unsigned short f2bf1(float f) { unsigned u = __builtin_bit_cast(unsigned, f); return (unsigned short)((u + 0x7fffu + ((u >> 16) & 1u)) >> 16); }
struct EpiZ {
    static constexpr bool PERM = true, AFTER_DRAIN = false, MIDSCALE = false;
    bf16_t* Z; bf16_t* KSF; bf16_t* VSF; bf16_t* KWF; bf16_t* VWF; float* GATES; const float* bgate;
    __device__ __forceinline__ void operator()(const f32x4 (&acc)[2][2][4][2], const Unit& u, int wr, int wc, int fr, int fq) const {
        const int row0 = u.pm * BM + wr * 64 + fr;
        if (u.pn < 9) {
            const int col0 = u.pn * BM + wc * 32 + 8 * fq;
#pragma unroll
            for (int ai = 0; ai < 2; ++ai)
#pragma unroll
                for (int m = 0; m < 4; ++m) { bf16_t* rowp = Z + (size_t)(row0 + ai * HALF + m * 16) * 2304 + col0;
#pragma unroll
                    for (int bj = 0; bj < 2; ++bj) { const f32x4 v0 = acc[ai][bj][m][0], v1 = acc[ai][bj][m][1];
                        u32x4 w; w.x = cvt_pk_bf16(v0[0], v0[1]); w.y = cvt_pk_bf16(v0[2], v0[3]); w.z = cvt_pk_bf16(v1[0], v1[1]); w.w = cvt_pk_bf16(v1[2], v1[3]);
                        *(u32x4*)(rowp + bj * HALF) = w; } }
            if (u.pn >= 7) {
                bf16_t* KF = (u.pn == 7) ? KSF : KWF; bf16_t* VF = (u.pn == 7) ? VSF : VWF;
                const int kvh = wc >> 1, dbase = 32 * (wc & 1) + 8 * fq;
#pragma unroll
                for (int ai = 0; ai < 2; ++ai)
#pragma unroll
                    for (int m = 0; m < 4; ++m) { const int row = row0 + ai * HALF + m * 16, b = row >> 13, s = row & 8191, tile = s >> 5, k = s & 31;
                        const size_t tb = ((size_t)(b * 2 + kvh) * 256 + tile) * 2048;
                        { const f32x4 v0 = acc[ai][0][m][0], v1 = acc[ai][0][m][1];
                          u32x4 w; w.x = cvt_pk_bf16(v0[0], v0[1]); w.y = cvt_pk_bf16(v0[2], v0[3]); w.z = cvt_pk_bf16(v1[0], v1[1]); w.w = cvt_pk_bf16(v1[2], v1[3]);
                          *(u32x4*)(KF + tb + (dbase >> 4) * 512 + ((dbase >> 3) & 1) * 256 + k * 8) = w; }
                        const int kk = k & 15, vo = ((kk >> 2) & 1) * 512 + (k >> 4) * 8 + (kk & 3) + 4 * (kk >> 3);
                        unsigned char* V8 = (unsigned char*)VF + ((size_t)(b * 2 + kvh) * 256 + tile) * 2048;
#pragma unroll
                        for (int n = 0; n < 2; ++n) { const f32x4 v = acc[ai][1][m][n]; int w = 0; w = __builtin_amdgcn_cvt_pk_fp8_f32(v[0], v[1], w, false); w = __builtin_amdgcn_cvt_pk_fp8_f32(v[2], v[3], w, true);
#pragma unroll
                            for (int e = 0; e < 4; ++e) { const int d = dbase + 4 * n + e; V8[(d >> 5) * 1024 + (d & 31) * 16 + vo] = (unsigned char)((unsigned)w >> (8 * e)); } }
                        asm volatile("" ::: "memory"); }
            }
        } else {
            if (wc == 0 && fq < 3) {
#pragma unroll
                for (int ai = 0; ai < 2; ++ai)
#pragma unroll
                    for (int m = 0; m < 4; ++m) { const int row = row0 + ai * HALF + m * 16;
#pragma unroll
                        for (int n = 0; n < 2; ++n)
#pragma unroll
                            for (int e = 0; e < 4; ++e) { const int c = 8 * fq + 4 * n + e; const float v = acc[ai][0][m][n][e] + bgate[c]; GATES[(size_t)row * 24 + c] = 1.0f / (1.0f + __expf(-v)); } }
            }
        }
    }
};
struct EpiStore {
    static constexpr bool PERM = true, AFTER_DRAIN = false, MIDSCALE = false;
    bf16_t* O; int ldc; const float* ssq; int frag;
    __device__ __forceinline__ void operator()(const f32x4 (&acc)[2][2][4][2], const Unit& u, int wr, int wc, int fr, int fq) const {
        const int row0 = u.pm * BM + wr * 64 + fr; const int col0 = u.pn * BM + wc * 32 + 8 * fq;
#pragma unroll
        for (int ai = 0; ai < 2; ++ai)
#pragma unroll
            for (int m = 0; m < 4; ++m) { const int row = row0 + ai * HALF + m * 16;
                bf16_t* rowp = frag ? O + (size_t)(row >> 5) * 32 * ldc + (size_t)(col0 >> 4) * 512 + ((col0 >> 3) & 1) * 256 + (row & 31) * 8 : O + (size_t)row * ldc + col0;
                const int bjstep = frag ? (HALF >> 4) * 512 : HALF;
                float sc = 1.f;
                if (ssq) { const f32x4* p = (const f32x4*)(ssq + (size_t)row * 16); const f32x4 a = p[0], b = p[1], c = p[2], d = p[3];
                    const float s = ((a[0] + a[1]) + (a[2] + a[3])) + ((b[0] + b[1]) + (b[2] + b[3])) + ((c[0] + c[1]) + (c[2] + c[3])) + ((d[0] + d[1]) + (d[2] + d[3]));
                    sc = rsqrtf(s * (1.0f / 1024.0f) + 1e-6f); }
#pragma unroll
                for (int bj = 0; bj < 2; ++bj) { const f32x4 v0 = acc[ai][bj][m][0] * sc, v1 = acc[ai][bj][m][1] * sc;
                    u32x4 w; w.x = cvt_pk_bf16(v0[0], v0[1]); w.y = cvt_pk_bf16(v0[2], v0[3]); w.z = cvt_pk_bf16(v1[0], v1[1]); w.w = cvt_pk_bf16(v1[2], v1[3]);
                    *(u32x4*)(rowp + bj * bjstep) = w; } }
    }
};
struct EpiVFrag {
    static constexpr bool PERM = true, AFTER_DRAIN = false, MIDSCALE = false;
    bf16_t* O;
    __device__ __forceinline__ void operator()(const f32x4 (&acc)[2][2][4][2], const Unit& u, int wr, int wc, int fr, int fq) const {
        const int row0 = u.pm * BM + wr * 64 + fr; const int col0 = u.pn * BM + wc * 32 + 8 * fq;
#pragma unroll
        for (int ai = 0; ai < 2; ++ai)
#pragma unroll
            for (int m = 0; m < 4; ++m) { const int D = row0 + ai * HALF + m * 16, h = D >> 8, dt = (D >> 5) & 7, r = D & 31;
#pragma unroll
                for (int bj = 0; bj < 2; ++bj) { const int K0 = col0 + bj * HALF, b = K0 >> 8, kt = (K0 >> 5) & 7, k0 = K0 & 31;
                    bf16_t* p = O + (size_t)((b * 4 + h) * 8 + kt) * 8192 + dt * 1024 + (k0 >> 4) * 512 + r * 8 + 4 * ((k0 >> 3) & 1);
                    const f32x4 v0 = acc[ai][bj][m][0], v1 = acc[ai][bj][m][1];
                    u32x2 w0, w1; w0.x = cvt_pk_bf16(v0[0], v0[1]); w0.y = cvt_pk_bf16(v0[2], v0[3]); w1.x = cvt_pk_bf16(v1[0], v1[1]); w1.y = cvt_pk_bf16(v1[2], v1[3]);
                    *(u32x2*)p = w0; *(u32x2*)(p + 256) = w1; } }
    }
};
template <bool MID> struct EpiRes {
    static constexpr bool PERM = false, AFTER_DRAIN = false, MIDSCALE = MID;
    const float* base; const bf16_t* base16; float* out; bf16_t* XB; float* ssq; const float* ssqn;
    __device__ __forceinline__ void midscale(f32x4 (&acc)[2][2][4][2], const Unit& u, int wr, int wc, int fr, int fq) const {
        const int row0 = u.pm * BM + wr * 64 + fr;
#pragma unroll
        for (int ai = 0; ai < 2; ++ai)
#pragma unroll
            for (int m = 0; m < 4; ++m) { const int row = row0 + ai * HALF + m * 16; const f32x2 sq = *(const f32x2*)(ssqn + (size_t)row * 2);
                const float sc = rsqrtf((sq[0] + sq[1]) * (1.0f / 512.0f) + 1e-6f);
#pragma unroll
                for (int bj = 0; bj < 2; ++bj)
#pragma unroll
                    for (int n = 0; n < 2; ++n) acc[ai][bj][m][n] = acc[ai][bj][m][n] * sc; }
    }
    __device__ __forceinline__ void operator()(const f32x4 (&acc)[2][2][4][2], const Unit& u, int wr, int wc, int fr, int fq) const {
        const int row0 = u.pm * BM + wr * 64 + fr; const int col0 = u.pn * BM + wc * 32 + 4 * fq;
#pragma unroll
        for (int ai = 0; ai < 2; ++ai)
#pragma unroll
            for (int m = 0; m < 4; ++m) { const int row = row0 + ai * HALF + m * 16; const size_t off = (size_t)row * 1024 + col0; float s = 0.f;
#pragma unroll
                for (int bj = 0; bj < 2; ++bj)
#pragma unroll
                    for (int n = 0; n < 2; ++n) { f32x4 b;
                        if (base) b = *(const f32x4*)(base + off + bj * HALF + n * 16);
                        else { const u32x2 w = *(const u32x2*)(base16 + off + bj * HALF + n * 16); b[0] = __builtin_bit_cast(float, w.x << 16); b[1] = __builtin_bit_cast(float, w.x & 0xffff0000u); b[2] = __builtin_bit_cast(float, w.y << 16); b[3] = __builtin_bit_cast(float, w.y & 0xffff0000u); }
                        const f32x4 v = b + acc[ai][bj][m][n];
                        if (out) *(f32x4*)(out + off + bj * HALF + n * 16) = v;
                        s += (v[0] * v[0] + v[1] * v[1]) + (v[2] * v[2] + v[3] * v[3]);
                        u32x2 w; w.x = cvt_pk_bf16(v[0], v[1]); w.y = cvt_pk_bf16(v[2], v[3]); *(u32x2*)(XB + off + bj * HALF + n * 16) = w; }
                s += __shfl_xor(s, 16); s += __shfl_xor(s, 32);
                if (fq == 0) ssq[(size_t)row * 16 + u.pn * 4 + wc] = s;
                asm volatile("" ::: "memory"); }
    }
};
template <class Epi, class Sched, bool ALIGN_EPI = false, bool SP2 = false>
__device__ __forceinline__ void gemm_phase(PG8_LAS unsigned char* lds, const Gemm g, const Sched& S, const Epi& E, int wave  ) {
    int lane; asm volatile("v_mbcnt_lo_u32_b32 %0, -1, 0\n\tv_mbcnt_hi_u32_b32 %0, -1, %0" : "=v"(lane));
    const int wid = wave, tid = wid * 64 + lane, wr = wid >> 2, wc = wid & 3, fr = lane & 15, fq = lane >> 4;
    const int K = g.K, nt = K / BK;
    unsigned voffA[2], voffB[2];
#pragma unroll
    for (int i = 0; i < 2; ++i) { int R, C; stage_rc(tid * 16 + i * 8192, R, C); const int Rb = Epi::PERM ? ((R & ~31) + perm32(R & 31)) : R;
        voffA[i] = (unsigned)(R * K + C) * 2u; voffB[i] = (unsigned)(Rb * K + C) * 2u; }
    const size_t kstep = (size_t)(BK * 2);
    const size_t hstep = (size_t)HALF * K * 2;
    const size_t tstep = 2 * hstep;
    const unsigned ldsw = (unsigned)wid * 1024u;
    const int aoff = lds_byte(wr * 64 + fr, fq * 8), boff = lds_byte(wc * 32 + fr, fq * 8);
#define PG8_SA(b, h) (((b) * 2 + (h)) * HTB)
#define PG8_SB(b, h) ((4 + (b) * 2 + (h)) * HTB)
#define PG8_STAGE(bufoff, gbase, voff) do { _Pragma("unroll") for (int _i = 0; _i < 2; ++_i) \
        __builtin_amdgcn_global_load_lds((const unsigned*)((const char*)(gbase) + (voff)[_i]), (PG8_LAS unsigned*)(lds + (bufoff) + ldsw + _i * 8192), 16, 0, 0); } while (0)
#define PG8_LDA(dst, b, h) do { _Pragma("unroll") for (int m = 0; m < 4; ++m) _Pragma("unroll") for (int k = 0; k < 2; ++k) dst[m][k] = *(const PG8_LAS bf16x8*)(lds + PG8_SA(b, h) + aoff + m * 2048 + k * 1024); } while (0)
#define PG8_LDB(dst, b, h) do { _Pragma("unroll") for (int n = 0; n < 2; ++n) _Pragma("unroll") for (int k = 0; k < 2; ++k) dst[n][k] = *(const PG8_LAS bf16x8*)(lds + PG8_SB(b, h) + boff + n * 2048 + k * 1024); } while (0)
#define PG8_MMA(ai, bj, At, Bt) do { __builtin_amdgcn_s_setprio(1); _Pragma("unroll") for (int m = 0; m < 4; ++m) _Pragma("unroll") for (int n = 0; n < 2; ++n) _Pragma("unroll") for (int k = 0; k < 2; ++k) \
        acc[ai][bj][m][n] = __builtin_amdgcn_mfma_f32_16x16x32_bf16(Bt[n][k], At[m][k], acc[ai][bj][m][n], 0, 0, 0); __builtin_amdgcn_s_setprio(0); } while (0)
#define PG8_WAIT_V(n) asm volatile("s_waitcnt vmcnt(" #n ")" ::: "memory")
#define PG8_WAIT_L(n) asm volatile("s_waitcnt lgkmcnt(" #n ")" ::: "memory")
#define PG8_BAR __builtin_amdgcn_s_barrier()
#define PG8_SCHED __builtin_amdgcn_sched_barrier(0)
    Unit cur, nxt; int ui = 0;
    if (!S.next(0, cur)) return;
    f32x4 acc[2][2][4][2];
#pragma unroll
    for (int a = 0; a < 2; ++a)
#pragma unroll
        for (int b = 0; b < 2; ++b)
#pragma unroll
            for (int m = 0; m < 4; ++m)
#pragma unroll
                for (int n = 0; n < 2; ++n) acc[a][b][m][n] = (f32x4){0.f, 0.f, 0.f, 0.f};
    bf16x8 At[4][2], B0[2][2], B1[2][2];
    const char* cA = (const char*)g.A + (size_t)cur.pm * tstep; const char* cB = (const char*)g.Bt + (size_t)cur.pn * tstep;
    S.a_ready(cur);
    if constexpr (SP2) {
        PG8_STAGE(PG8_SB(0, 0), cB, voffB); PG8_STAGE(PG8_SB(0, 1), cB + hstep, voffB); PG8_STAGE(PG8_SA(0, 0), cA, voffA); PG8_STAGE(PG8_SA(0, 1), cA + hstep, voffA);
        if (wr == 1) PG8_BAR;
        PG8_WAIT_V(2); PG8_BAR;
        PG8_STAGE(PG8_SB(1, 0), cB + kstep, voffB); PG8_STAGE(PG8_SA(1, 0), cA + kstep, voffA); PG8_STAGE(PG8_SB(1, 1), cB + hstep + kstep, voffB);
        PG8_WAIT_V(6); PG8_BAR;
    } else {
        PG8_STAGE(PG8_SB(0, 0), cB, voffB); PG8_STAGE(PG8_SA(0, 0), cA, voffA); PG8_STAGE(PG8_SB(0, 1), cB + hstep, voffB); PG8_STAGE(PG8_SA(0, 1), cA + hstep, voffA);
        if (wr == 1) PG8_BAR;
        PG8_WAIT_V(4); PG8_BAR;
        PG8_STAGE(PG8_SB(1, 0), cB + kstep, voffB); PG8_STAGE(PG8_SA(1, 0), cA + kstep, voffA); PG8_STAGE(PG8_SB(1, 1), cB + hstep + kstep, voffB);
        PG8_WAIT_V(6); PG8_BAR;
    }
    for (;;) {
        const bool has_next = S.next(ui + 1, nxt);
        const char* nA = has_next ? (const char*)g.A + (size_t)nxt.pm * tstep : cA; const char* nB = has_next ? (const char*)g.Bt + (size_t)nxt.pn * tstep : cB;
        for (int t = 0; t < nt; t += 2) {
            if constexpr (Epi::MIDSCALE) { if (t == nt / 2) E.midscale(acc, cur, wr, wc, fr, fq); }
            const bool last = (t == nt - 2);
            const char* a1 = cA + (size_t)(t + 1) * kstep;
            const char* a2 = last ? nA : cA + (size_t)(t + 2) * kstep; const char* b2 = last ? nB : cB + (size_t)(t + 2) * kstep;
            const char* a3 = a2 + kstep; const char* b3 = b2 + kstep;
            if (last && has_next) S.a_ready(nxt);
            if constexpr (SP2) {
            PG8_LDB(B0, 0, 0); PG8_LDB(B1, 0, 1); PG8_SCHED; PG8_LDA(At, 0, 0); PG8_STAGE(PG8_SA(1, 1), a1 + hstep, voffA);
            PG8_WAIT_V(8); PG8_WAIT_L(0); PG8_BAR; PG8_MMA(0, 0, At, B0); PG8_MMA(0, 1, At, B1); PG8_BAR; PG8_SCHED;
            PG8_LDA(At, 0, 1); PG8_STAGE(PG8_SB(0, 0), b2, voffB); PG8_STAGE(PG8_SB(0, 1), b2 + hstep, voffB); PG8_STAGE(PG8_SA(0, 0), a2, voffA);
            PG8_WAIT_V(8); PG8_WAIT_L(0); PG8_BAR; PG8_MMA(1, 0, At, B0); PG8_MMA(1, 1, At, B1); PG8_BAR; PG8_SCHED;
            PG8_LDB(B0, 1, 0); PG8_LDB(B1, 1, 1); PG8_SCHED; PG8_LDA(At, 1, 0); PG8_STAGE(PG8_SA(0, 1), a2 + hstep, voffA);
            PG8_WAIT_V(8); PG8_WAIT_L(0); PG8_BAR; PG8_MMA(0, 0, At, B0); PG8_MMA(0, 1, At, B1); PG8_BAR; PG8_SCHED;
            PG8_LDA(At, 1, 1); PG8_STAGE(PG8_SB(1, 0), b3, voffB); PG8_STAGE(PG8_SB(1, 1), b3 + hstep, voffB); PG8_STAGE(PG8_SA(1, 0), a3, voffA);
            PG8_WAIT_V(8); PG8_WAIT_L(0); PG8_BAR; PG8_MMA(1, 0, At, B0); PG8_MMA(1, 1, At, B1); PG8_BAR; PG8_SCHED;
            } else {
            PG8_LDB(B0, 0, 0); PG8_SCHED; PG8_LDA(At, 0, 0); PG8_STAGE(PG8_SA(1, 1), a1 + hstep, voffA);
            PG8_WAIT_L(8); PG8_BAR; PG8_WAIT_L(0); PG8_MMA(0, 0, At, B0); PG8_BAR; PG8_SCHED;
            PG8_LDB(B1, 0, 1); PG8_STAGE(PG8_SB(0, 0), b2, voffB);
            PG8_BAR; PG8_WAIT_L(0); PG8_MMA(0, 1, At, B1); PG8_BAR;
            PG8_LDA(At, 0, 1); PG8_STAGE(PG8_SA(0, 0), a2, voffA);
            PG8_BAR; PG8_WAIT_L(0); PG8_MMA(1, 0, At, B0); PG8_BAR; PG8_SCHED;
            PG8_STAGE(PG8_SB(0, 1), b2 + hstep, voffB);
            PG8_WAIT_V(6); PG8_BAR; PG8_MMA(1, 1, At, B1); PG8_BAR;
            PG8_LDB(B0, 1, 0); PG8_SCHED; PG8_LDA(At, 1, 0); PG8_STAGE(PG8_SA(0, 1), a2 + hstep, voffA);
            PG8_WAIT_L(8); PG8_BAR; PG8_WAIT_L(0); PG8_MMA(0, 0, At, B0); PG8_BAR; PG8_SCHED;
            PG8_LDB(B1, 1, 1); PG8_STAGE(PG8_SB(1, 0), b3, voffB);
            PG8_BAR; PG8_WAIT_L(0); PG8_MMA(0, 1, At, B1); PG8_BAR;
            PG8_LDA(At, 1, 1); PG8_STAGE(PG8_SA(1, 0), a3, voffA);
            PG8_BAR; PG8_WAIT_L(0); PG8_MMA(1, 0, At, B0); PG8_BAR; PG8_SCHED;
            PG8_STAGE(PG8_SB(1, 1), b3 + hstep, voffB);
            PG8_WAIT_V(6); PG8_BAR; PG8_MMA(1, 1, At, B1); PG8_BAR;
            }
        }
        if constexpr (ALIGN_EPI) { if (wr == 0) PG8_BAR; }
        if constexpr (!Epi::AFTER_DRAIN) { E(acc, cur, wr, wc, fr, fq); S.done(cur); }
        if (!has_next) break;
#pragma unroll
        for (int a = 0; a < 2; ++a)
#pragma unroll
            for (int b = 0; b < 2; ++b)
#pragma unroll
                for (int m = 0; m < 4; ++m)
#pragma unroll
                    for (int n = 0; n < 2; ++n) acc[a][b][m][n] = (f32x4){0.f, 0.f, 0.f, 0.f};
        cur = nxt; cA = nA; cB = nB; ++ui;
        if constexpr (ALIGN_EPI) { if (wr == 1) PG8_BAR; }
    }
    PG8_WAIT_V(0);
    if constexpr (!ALIGN_EPI) { if (wr == 0) PG8_BAR; }
    PG8_BAR;
    if constexpr (Epi::AFTER_DRAIN) { E.fused(acc, cur, wr, wc, fr, fq, lds, wid, lane); S.done(cur); }
#undef PG8_SA
#undef PG8_SB
#undef PG8_STAGE
#undef PG8_LDA
#undef PG8_LDB
#undef PG8_MMA
#undef PG8_WAIT_V
#undef PG8_WAIT_L
#undef PG8_BAR
#undef PG8_SCHED
}
}

constexpr int NB = 2, SEQ = 8192, DM = 1024, MTOK = NB * SEQ;
constexpr int NZ = 2304, NZP = 2560;
constexpr int NMEM = 256;
constexpr float EPS = 1e-6f;
constexpr float QSCALE = 0.125f * 1.4426950408889634f;
constexpr int ZC_XL = 0, ZC_GT = 512, ZC_Q = 1024, ZC_KC = 1536, ZC_VC = 1664, ZC_KS = 1792, ZC_VS = 1920, ZC_KW = 2048, ZC_VW = 2176, ZC_G = 2304;

constexpr size_t MiB = 1u << 20;
constexpr size_t WS_CTL = 0;
constexpr size_t WS_WIN = 1 * MiB, WS_WOUT = 6 * MiB, WS_WMQ = 8 * MiB, WS_WMK = 10 * MiB, WS_WMV = 12 * MiB, WS_WMO = 14 * MiB, WS_WPQ = 16 * MiB;
constexpr size_t WS_SKEY = 20 * MiB;
constexpr size_t WS_CW1T = WS_SKEY + 512 * 1024;
constexpr size_t WS_CW2T = WS_CW1T + 512 * 1024;
constexpr size_t WS_C1 = WS_CW2T + 16 * 1024;
constexpr size_t WS_WRGT = WS_C1 + 16 * 1024;
constexpr size_t WS_MEMN = 22 * MiB, WS_MEMK = 23 * MiB, WS_MEMVT = 24 * MiB;
constexpr size_t WS_KC = 26 * MiB;
constexpr size_t WS_VCT = WS_KC + 256 * 1024;
constexpr size_t WS_SUMM = 27 * MiB;
constexpr size_t WS_SSQ1 = 28 * MiB, WS_SSQ2 = 29 * MiB;
constexpr size_t WS_GATES = 30 * MiB;
constexpr size_t WS_SSQN = 31 * MiB + 512 * 1024;
constexpr size_t WS_U8 = 32 * MiB, WS_V8 = 48 * MiB;
constexpr size_t WS_SU = 64 * MiB, WS_SV = 64 * MiB + 65536;
constexpr size_t WS_SSQ3 = 65 * MiB;
constexpr size_t WS_W = 66 * MiB;
constexpr size_t WS_PART = 128 * MiB;
constexpr size_t WS_XN = 96 * MiB;
constexpr size_t WS_Z = 128 * MiB;
constexpr size_t WS_KSF = 240 * MiB, WS_VSF = 244 * MiB, WS_KWF = 248 * MiB, WS_VWF = 252 * MiB;
constexpr size_t WS_QM = 128 * MiB, WS_OM = 160 * MiB;
constexpr size_t WS_QP = 128 * MiB;
constexpr size_t WS_Y = 208 * MiB;
constexpr size_t WS_EID = 208 * MiB, WS_GW = 216 * MiB;
constexpr size_t WS_END = 256 * MiB;

constexpr int CW_KMAX = 12288;
constexpr int LDS_BYTES = 147456;

#define GAS __attribute__((address_space(1)))
#define LAS __attribute__((address_space(3)))
typedef unsigned short bf16;
typedef unsigned v4u __attribute__((ext_vector_type(4)));
typedef unsigned v2u __attribute__((ext_vector_type(2)));
typedef float f32x4 __attribute__((ext_vector_type(4)));
typedef float f32x16 __attribute__((ext_vector_type(16)));
typedef short bf16x8 __attribute__((ext_vector_type(8)));
typedef short bf16x4 __attribute__((ext_vector_type(4)));
__device__ __forceinline__ unsigned f2bf(float f) { unsigned u = __builtin_bit_cast(unsigned, f); return (u + 0x7fffu + ((u >> 16) & 1u)) >> 16; }
typedef float f32x2_ __attribute__((ext_vector_type(2))); typedef __bf16 bf16x2_ __attribute__((ext_vector_type(2)));
__device__ __forceinline__ unsigned pk2(float lo, float hi) { f32x2_ v = {lo, hi}; bf16x2_ b = __builtin_convertvector(v, bf16x2_); return __builtin_bit_cast(unsigned, b); }
__device__ __forceinline__ float bf2f(unsigned short h) { return __builtin_bit_cast(float, (unsigned)h << 16); }
__device__ __forceinline__ float bflo(unsigned w) { return __builtin_bit_cast(float, w << 16); }
__device__ __forceinline__ float bfhi(unsigned w) { return __builtin_bit_cast(float, w & 0xffff0000u); }
__device__ __forceinline__ void swap32(unsigned& a, unsigned& b) { asm("s_nop 1\n\tv_permlane32_swap_b32 %0, %1" : "+v"(a), "+v"(b)); }
__device__ __forceinline__ int maxswap32_i(int v) { unsigned a = (unsigned)v, b = (unsigned)v; swap32(a, b); return max((int)a, (int)b); }
__device__ __forceinline__ float maxswap32_f(float v) { unsigned a = __builtin_bit_cast(unsigned, v), b = a; swap32(a, b); return fmaxf(__builtin_bit_cast(float, a), __builtin_bit_cast(float, b)); }
__device__ __forceinline__ float addswap32_f(float v) { unsigned a = __builtin_bit_cast(unsigned, v), b = a; swap32(a, b); return __builtin_bit_cast(float, a) + __builtin_bit_cast(float, b); }
__device__ __forceinline__ float wave_sum(float v) {
#pragma unroll
    for (int o = 1; o < 64; o <<= 1) v += __shfl_xor(v, o);
    return v;
}

struct Args { const float* in[33]; float* out; unsigned char* ws; int ph_lo, ph_hi; };

struct Frame {
    int tid, lane, wave, vcu, G, gw, NGW;
};
__device__ __forceinline__ int lane_id() { int l; asm volatile("v_mbcnt_lo_u32_b32 %0, -1, 0\n\tv_mbcnt_hi_u32_b32 %0, -1, %0" : "=v"(l)); return l; }
#define REFRESH_LANE(F) do { (F).lane = lane_id(); (F).tid = (F).wave * 64 + (F).lane; } while (0)

__device__ __forceinline__ void transpose_item(const float* W, int K, int N, bf16* WT, int ldt, int row_off, const float* gain, int slo, int shi, float cs, LAS float* scr, int item, int lane, int kxor = 0) {
    const int nblk = (N + 31) / 32, kb = item / nblk, nb = item % nblk, k0 = 64 * kb, n0 = 32 * nb;
#pragma unroll 16
    for (int i = 0; i < 32; ++i) { const int kk = 2 * i + (lane >> 5), n = n0 + (lane & 31);
        float v = (n < N) ? __builtin_nontemporal_load(W + (size_t)(k0 + kk) * N + n) : 0.f; if (gain) v *= gain[k0 + kk]; if (n >= slo && n < shi) v *= cs;
        scr[kk * 33 + (lane & 31)] = v; }
    asm volatile("s_waitcnt lgkmcnt(0)" ::: "memory");
    const int c = lane & 7;
#pragma unroll
    for (int j = 0; j < 4; ++j) { const int n = (lane >> 3) + 8 * j; const LAS float* s = scr + (8 * c) * 33 + n;
        v4u o; o.x = pk2(s[0 * 33], s[1 * 33]); o.y = pk2(s[2 * 33], s[3 * 33]); o.z = pk2(s[4 * 33], s[5 * 33]); o.w = pk2(s[6 * 33], s[7 * 33]);
        *(v4u*)(WT + (size_t)(row_off + n0 + n) * ldt + (k0 ^ kxor) + 8 * c) = o; }
    asm volatile("s_waitcnt lgkmcnt(0)" ::: "memory");
}
__device__ __forceinline__ void rms_row_to_bf16(const float* xrow, bf16* orow, int lane) {
    const f32x4* xr = (const f32x4*)xrow + lane;
    f32x4 v[4]; float s = 0.f;
#pragma unroll
    for (int j = 0; j < 4; ++j) { v[j] = xr[64 * j]; s += (v[j].x * v[j].x + v[j].y * v[j].y) + (v[j].z * v[j].z + v[j].w * v[j].w); }
    const float rstd = rsqrtf(wave_sum(s) * (1.f / DM) + EPS);
    unsigned long long* o8 = (unsigned long long*)orow + lane;
#pragma unroll
    for (int j = 0; j < 4; ++j) o8[64 * j] = (unsigned long long)pk2(v[j].x * rstd, v[j].y * rstd) | ((unsigned long long)pk2(v[j].z * rstd, v[j].w * rstd) << 32);
}
__device__ __forceinline__ void quant_row_fp8(const float* src, const float* gain, unsigned char* dst, float* scale_out, int lane) {
    const f32x4* p = (const f32x4*)src + 4 * lane; f32x4 v[4]; float am = 0.f;
#pragma unroll
    for (int j = 0; j < 4; ++j) { v[j] = p[j]; if (gain) v[j] = v[j] * ((const f32x4*)gain)[4 * lane + j]; am = fmaxf(am, fmaxf(fmaxf(fabsf(v[j].x), fabsf(v[j].y)), fmaxf(fabsf(v[j].z), fabsf(v[j].w)))); }
#pragma unroll
    for (int o = 1; o < 64; o <<= 1) am = fmaxf(am, __shfl_xor(am, o));
    const float inv = am > 0.f ? 448.0f / am : 0.f;
    v4u o4;
#pragma unroll
    for (int j = 0; j < 4; ++j) { int w = 0; w = __builtin_amdgcn_cvt_pk_fp8_f32(v[j].x * inv, v[j].y * inv, w, false); w = __builtin_amdgcn_cvt_pk_fp8_f32(v[j].z * inv, v[j].w * inv, w, true); o4[j] = (unsigned)w; }
    *(v4u*)(dst + (size_t)(lane >> 3) * 16384 * 128 + (lane & 7) * 16) = o4;
    if (lane == 0) *scale_out = am * (1.0f / 448.0f);
}
__device__ __forceinline__ void rms_rows4_to_bf16(const float* x0, bf16* o0, size_t rstride  , int lane) {
    f32x4 v[4][4]; float s[4];
#pragma unroll
    for (int r = 0; r < 4; ++r)
#pragma unroll
        for (int j = 0; j < 4; ++j) v[r][j] = __builtin_nontemporal_load((const f32x4*)(x0 + r * rstride) + lane + 64 * j);
#pragma unroll
    for (int r = 0; r < 4; ++r) { s[r] = 0.f;
#pragma unroll
        for (int j = 0; j < 4; ++j) s[r] += (v[r][j].x * v[r][j].x + v[r][j].y * v[r][j].y) + (v[r][j].z * v[r][j].z + v[r][j].w * v[r][j].w); }
#pragma unroll
    for (int o = 1; o < 64; o <<= 1)
#pragma unroll
        for (int r = 0; r < 4; ++r) s[r] += __shfl_xor(s[r], o);
#pragma unroll
    for (int r = 0; r < 4; ++r) { const float rstd = rsqrtf(s[r] * (1.f / DM) + EPS); unsigned long long* o8 = (unsigned long long*)(o0 + r * rstride) + lane;
#pragma unroll
        for (int j = 0; j < 4; ++j) o8[64 * j] = (unsigned long long)pk2(v[r][j].x * rstd, v[r][j].y * rstd) | ((unsigned long long)pk2(v[r][j].z * rstd, v[r][j].w * rstd) << 32); }
}
__device__ __forceinline__ void quant_rows4_fp8(const float* src0, size_t rstride, const float* gain, unsigned char* dst0, float* scale0, int sstride, int lane) {
    f32x4 v[4][4]; float am[4];
#pragma unroll
    for (int r = 0; r < 4; ++r)
#pragma unroll
        for (int j = 0; j < 4; ++j) v[r][j] = __builtin_nontemporal_load((const f32x4*)(src0 + r * rstride) + 4 * lane + j);
    if (gain) {
#pragma unroll
        for (int j = 0; j < 4; ++j) { const f32x4 g = ((const f32x4*)gain)[4 * lane + j];
#pragma unroll
            for (int r = 0; r < 4; ++r) v[r][j] = v[r][j] * g; } }
#pragma unroll
    for (int r = 0; r < 4; ++r) { am[r] = 0.f;
#pragma unroll
        for (int j = 0; j < 4; ++j) am[r] = fmaxf(am[r], fmaxf(fmaxf(fabsf(v[r][j].x), fabsf(v[r][j].y)), fmaxf(fabsf(v[r][j].z), fabsf(v[r][j].w)))); }
#pragma unroll
    for (int o = 1; o < 64; o <<= 1)
#pragma unroll
        for (int r = 0; r < 4; ++r) am[r] = fmaxf(am[r], __shfl_xor(am[r], o));
#pragma unroll
    for (int r = 0; r < 4; ++r) { const float inv = am[r] > 0.f ? 448.0f / am[r] : 0.f; v4u o4;
#pragma unroll
        for (int j = 0; j < 4; ++j) { int w = 0; w = __builtin_amdgcn_cvt_pk_fp8_f32(v[r][j].x * inv, v[r][j].y * inv, w, false); w = __builtin_amdgcn_cvt_pk_fp8_f32(v[r][j].z * inv, v[r][j].w * inv, w, true); o4[j] = (unsigned)w; }
        __builtin_nontemporal_store(o4, (v4u*)(dst0 + (size_t)r * sstride * 128 + (size_t)(lane >> 3) * 16384 * 128 + (lane & 7) * 16));
        if (lane == 0) scale0[r * sstride] = am[r] * (1.0f / 448.0f); }
}
__device__ __forceinline__ void p0_prologue(const Frame& F, const Args& A, LAS unsigned char* lds) {
    unsigned char* ws = A.ws;
    LAS float* scr = (LAS float*)(lds + F.wave * 16384);
    const float* const* in = A.in;
    const int gw = F.gw, NGW = F.NGW;
    constexpr int I_IN = 16 * 73, I_SQ = 16 * 32, I_PQ = 16 * 64, I_C1 = 64, I_C2 = 2, I_RG = 2;
    constexpr int E_IN = I_IN, E_OUT = E_IN + I_SQ, E_MQ = E_OUT + I_SQ, E_MK = E_MQ + I_SQ, E_MV = E_MK + I_SQ, E_MO = E_MV + I_SQ, E_PQ = E_MO + I_PQ, E_C1 = E_PQ + 2 * I_C1, E_C2 = E_C1 + 2 * I_C2, E_RG = E_C2 + 16 * I_RG;
    for (int it = gw; it < E_RG; it += NGW) {
        if (it < E_IN) transpose_item(in[3], 1024, 2328, (bf16*)(ws + WS_WIN), 1024, 0, in[2], ZC_Q, ZC_KC, QSCALE, scr, it, F.lane);
        else if (it < E_OUT) { const int j = it - E_IN, kb = j / 32; transpose_item(in[20], 1024, 1024, (bf16*)(ws + WS_WOUT), 1024, 0, (kb < 8 ? in[18] : in[19] - 512), 0, 0, 1.f, scr, j, F.lane, 512); }
        else if (it < E_MQ) transpose_item(in[23], 1024, 1024, (bf16*)(ws + WS_WMQ), 1024, 0, in[21], 0, 1024, 0.0625f * 1.4426950408889634f, scr, it - E_OUT, F.lane);
        else if (it < E_MK) transpose_item(in[24], 1024, 1024, (bf16*)(ws + WS_WMK), 1024, 0, in[22], 0, 0, 1.f, scr, it - E_MQ, F.lane);
        else if (it < E_MV) transpose_item(in[25], 1024, 1024, (bf16*)(ws + WS_WMV), 1024, 0, in[22], 0, 0, 1.f, scr, it - E_MK, F.lane);
        else if (it < E_MO) transpose_item(in[26], 1024, 1024, (bf16*)(ws + WS_WMO), 1024, 0, nullptr, 0, 0, 1.f, scr, it - E_MV, F.lane);
        else if (it < E_PQ) transpose_item(in[28], 1024, 2048, (bf16*)(ws + WS_WPQ), 1024, 0, in[27], 0, 0, 1.f, scr, it - E_MO, F.lane);
        else if (it < E_C1) { const int j = it - E_PQ, kv = j / I_C1; transpose_item(in[kv ? 16 : 13], 2048, 64, (bf16*)(ws + WS_CW1T) + (size_t)kv * 64 * 2048, 2048, 0, nullptr, 0, 0, 1.f, scr, j % I_C1, F.lane); }
        else if (it < E_C2) { const int j = it - E_C1, kv = j / I_C2; transpose_item(in[kv ? 17 : 14], 64, 64, (bf16*)(ws + WS_CW2T) + (size_t)kv * 64 * 64, 64, 0, nullptr, 0, 0, 1.f, scr, j % I_C2, F.lane); }
        else { const int j = it - E_C2, ai = j / 16, h = (j / 2) % 8; transpose_item(in[ai ? 9 : 7] + (size_t)h * 4096, 64, 64, (bf16*)(ws + WS_WRGT) + (size_t)(ai * 8 + h) * 4096, 64, 0, nullptr, 0, 0, 1.f, scr, j % 2, F.lane); }
    }
    for (int i = gw * 64 + F.lane; i < (2560 - 2336) * 1024 / 8; i += NGW * 64) ((v4u*)((bf16*)(ws + WS_WIN) + (size_t)2336 * 1024))[i] = (v4u){0u, 0u, 0u, 0u};
    for (int it = NGW - 1 - gw; it < 32; it += NGW) { const int kv = it >> 4, ch = it & 15; const float* pos = in[kv ? 15 : 12] + 128 * ch; const float* w1 = in[kv ? 16 : 13] + (size_t)128 * ch * 64 + F.lane; float s = 0.f;
#pragma unroll 16
        for (int k = 0; k < 128; ++k) s += pos[k] * w1[(size_t)k * 64];
        ((float*)(ws + WS_C1))[it * 64 + F.lane] = s; }
    { const size_t i0 = (size_t)gw * 64 + F.lane, st = (size_t)NGW * 64;
      for (int r = gw; r < 32768; r += 4 * NGW) { const int tb = r >> 14, e = r & 16383;
          if ((16384 % (4 * NGW)) == 0) quant_rows4_fp8(in[30 + tb] + (size_t)e * DM, (size_t)NGW * DM, tb ? nullptr : in[27], ws + (tb ? WS_V8 : WS_U8) + (size_t)e * 128, (float*)(ws + (tb ? WS_SV : WS_SU)) + e, NGW, F.lane);
          else for (int q = 0; q < 4; ++q) { const int rr = r + q * NGW; if (rr < 32768) { const int t2 = rr >> 14, e2 = rr & 16383; quant_row_fp8(in[30 + t2] + (size_t)e2 * DM, t2 ? nullptr : in[27], ws + (t2 ? WS_V8 : WS_U8) + (size_t)e2 * 128, (float*)(ws + (t2 ? WS_SV : WS_SU)) + e2, F.lane); } } }
      for (size_t i = i0; i < (size_t)8 * 2 * 128 * 128 / 8; i += st) { const f32x4 a = ((const f32x4*)in[29])[2 * i], bq = ((const f32x4*)in[29])[2 * i + 1];
          v4u o; o.x = pk2(a.x, a.y); o.y = pk2(a.z, a.w); o.z = pk2(bq.x, bq.y); o.w = pk2(bq.z, bq.w);
          const size_t R = i >> 4, d0 = (i & 15) * 8;
          *(v4u*)((bf16*)(ws + WS_SKEY) + (R >> 5) * 4096 + (d0 >> 4) * 512 + ((d0 >> 3) & 1) * 256 + (R & 31) * 8) = o; } }
    if ((MTOK % (4 * NGW)) == 0) for (int m = gw; m < MTOK; m += 4 * NGW) rms_rows4_to_bf16(in[0] + (size_t)m * DM, (bf16*)(ws + WS_XN) + (size_t)m * DM, (size_t)NGW * DM, F.lane);
    else for (int m = gw; m < MTOK; m += NGW) rms_row_to_bf16(in[0] + (size_t)m * DM, (bf16*)(ws + WS_XN) + (size_t)m * DM, F.lane);
    for (int m = gw; m < NB * NMEM; m += NGW) rms_row_to_bf16(in[1] + (size_t)m * DM, (bf16*)(ws + WS_MEMN) + (size_t)m * DM, F.lane);
}

__device__ __forceinline__ int crow(int r, int hi) { return (r & 3) + 8 * (r >> 2) + 4 * hi; }
__device__ __forceinline__ float gelu_tanh(float x) {
    const float u = 0.7978845608028654f * (x + 0.044715f * x * x * x);
    const float t = 1.0f - 2.0f * __builtin_amdgcn_rcpf(__builtin_amdgcn_exp2f(2.0f * 1.4426950408889634f * u) + 1.0f);
    return 0.5f * x * (1.0f + t);
}
constexpr int XC_LD = 520;
__device__ __forceinline__ void lru_local_item(const Frame& F, const Args& A, LAS unsigned char* lds, int item) {
    unsigned char* ws = A.ws;
    const bf16* Z = (const bf16*)(ws + WS_Z);
    const int b = item >> 7, chunk = item & 127, s0 = chunk * 64; const size_t row0 = (size_t)b * SEQ + s0;
    LAS bf16* xcs = (LAS bf16*)lds;
    {
        const int c8 = F.tid & 63, tg = F.tid >> 6, c0 = 8 * c8;
        v4u xr[11];
#pragma unroll
        for (int r = 0; r < 11; ++r) { const long tok = (long)(8 * tg + r) - 3;
            if (s0 == 0 && tok < 0) xr[r] = (v4u){0u, 0u, 0u, 0u}; else xr[r] = *(const v4u*)(Z + (size_t)((long)row0 + tok) * NZ + c0); }
        const float* cw = A.in[5]; float w0[8], w1[8], w2[8], w3[8], cb[8];
#pragma unroll
        for (int j = 0; j < 2; ++j) { const f32x4 a = *(const f32x4*)(cw + c0 + 4 * j), b = *(const f32x4*)(cw + 512 + c0 + 4 * j), c = *(const f32x4*)(cw + 1024 + c0 + 4 * j), d = *(const f32x4*)(cw + 1536 + c0 + 4 * j), e2 = *(const f32x4*)(A.in[6] + c0 + 4 * j);
#pragma unroll
            for (int k = 0; k < 4; ++k) { w0[4 * j + k] = a[k]; w1[4 * j + k] = b[k]; w2[4 * j + k] = c[k]; w3[4 * j + k] = d[k]; cb[4 * j + k] = e2[k]; } }
#pragma unroll
        for (int tt = 0; tt < 8; ++tt) { float o[8];
#pragma unroll
            for (int q = 0; q < 4; ++q) { const unsigned a = xr[tt][q], b = xr[tt + 1][q], c = xr[tt + 2][q], d = xr[tt + 3][q];
                o[2 * q] = cb[2 * q] + w0[2 * q] * bflo(a) + w1[2 * q] * bflo(b) + w2[2 * q] * bflo(c) + w3[2 * q] * bflo(d);
                o[2 * q + 1] = cb[2 * q + 1] + w0[2 * q + 1] * bfhi(a) + w1[2 * q + 1] * bfhi(b) + w2[2 * q + 1] * bfhi(c) + w3[2 * q + 1] * bfhi(d); }
            v4u ov; ov.x = pk2(o[0], o[1]); ov.y = pk2(o[2], o[3]); ov.z = pk2(o[4], o[5]); ov.w = pk2(o[6], o[7]);
            *(LAS v4u*)(xcs + (8 * tg + tt) * XC_LD + c0) = ov; }
    }
    __syncthreads();
    const int h = F.wave, lane = F.lane, r32 = lane & 31, hi = lane >> 5;
    bf16x8 af[2][4];
#pragma unroll
    for (int tt = 0; tt < 2; ++tt)
#pragma unroll
        for (int ks = 0; ks < 4; ++ks) af[tt][ks] = *(const LAS bf16x8*)(xcs + (32 * tt + r32) * XC_LD + 64 * h + 16 * ks + 8 * hi);
    const bf16* WT = (const bf16*)(ws + WS_WRGT);
    float* SUMM = (float*)(ws + WS_SUMM);
    unsigned* HA = (unsigned*)A.out;
#pragma unroll 1
    for (int ct = 0; ct < 2; ++ct) {
        const int c = 64 * h + 32 * ct + r32;
        f32x16 ga[2], gi[2];
#pragma unroll
        for (int tt = 0; tt < 2; ++tt) { ga[tt] = f32x16{}; gi[tt] = f32x16{}; }
#pragma unroll
        for (int ks = 0; ks < 4; ++ks) {
            const bf16x8 ba = *(const bf16x8*)(WT + (size_t)(0 * 8 + h) * 4096 + (32 * ct + r32) * 64 + 16 * ks + 8 * hi);
            const bf16x8 bi = *(const bf16x8*)(WT + (size_t)(1 * 8 + h) * 4096 + (32 * ct + r32) * 64 + 16 * ks + 8 * hi);
#pragma unroll
            for (int tt = 0; tt < 2; ++tt) { ga[tt] = __builtin_amdgcn_mfma_f32_32x32x16_bf16(af[tt][ks], ba, ga[tt], 0, 0, 0); gi[tt] = __builtin_amdgcn_mfma_f32_32x32x16_bf16(af[tt][ks], bi, gi[tt], 0, 0, 0); }
        }
        const float ba_ = A.in[8][c], bi_ = A.in[10][c], lam = A.in[11][c];
        const float sp = (lam > 15.f) ? __expf(-lam) : log1pf(__expf(-lam));
#pragma unroll
        for (int tt = 0; tt < 2; ++tt)
#pragma unroll
            for (int r = 0; r < 16; ++r) { const int t = 32 * tt + crow(r, hi);
                const float rr = __builtin_amdgcn_rcpf(1.0f + __builtin_amdgcn_exp2f(-1.4426950408889634f * (ga[tt][r] + ba_))), ii = __builtin_amdgcn_rcpf(1.0f + __builtin_amdgcn_exp2f(-1.4426950408889634f * (gi[tt][r] + bi_)));
                const float a = __builtin_amdgcn_exp2f(-8.0f * 1.4426950408889634f * rr * sp);
                const float xcv = bf2f(xcs[t * XC_LD + c]);
                const float bb = __builtin_amdgcn_sqrtf(fmaxf(1.0f - a * a, 0.f)) * (ii * xcv);
                ga[tt][r] = a; gi[tt][r] = bb; }
        float SA[8], SB[8];
#pragma unroll
        for (int tt = 0; tt < 2; ++tt)
#pragma unroll
            for (int q = 0; q < 4; ++q) {
#pragma unroll
                for (int k = 1; k < 4; ++k) { const int r = 4 * q + k; gi[tt][r] = ga[tt][r] * gi[tt][r - 1] + gi[tt][r]; ga[tt][r] = ga[tt][r] * ga[tt][r - 1]; }
                SA[tt * 4 + q] = ga[tt][4 * q + 3]; SB[tt * 4 + q] = gi[tt][4 * q + 3]; }
        float CA = 1.f, CB = 0.f; float inA[8], inB[8];
#pragma unroll
        for (int s = 0; s < 8; ++s) {
            const float pA = __shfl_xor(SA[s], 32), pB = __shfl_xor(SB[s], 32);
            const float Ae = hi ? pA : SA[s], Be = hi ? pB : SB[s], Ao = hi ? SA[s] : pA, Bo = hi ? SB[s] : pB;
            if (!hi) { inA[s] = CA; inB[s] = CB; }
            CB = Ae * CB + Be; CA = Ae * CA;
            if (hi) { inA[s] = CA; inB[s] = CB; }
            CB = Ao * CB + Bo; CA = Ao * CA;
        }
        unsigned hoff = (unsigned)((row0 + 4 * hi) * 512 + c);
        if (hi == 0) { float* sp2 = SUMM + ((size_t)(b * 128 + chunk) * 512 + c) * 2; sp2[0] = CA; sp2[1] = CB; }
#pragma unroll
        for (int tt = 0; tt < 2; ++tt)
#pragma unroll
            for (int r = 0; r < 16; ++r) { const int s = tt * 4 + (r >> 2);
                const float acum = ga[tt][r] * inA[s], hloc = ga[tt][r] * inB[s] + gi[tt][r];
                asm volatile("" : "+v"(hoff));
                HA[hoff + (unsigned)((32 * tt + (r & 3) + 8 * (r >> 2)) * 512)] = f2bf(hloc) | (f2bf(acum) << 16); }
    }
    __syncthreads();
}
__device__ __forceinline__ void lru_fix_item(const Frame& F, const Args& A, LAS unsigned char* lds, int item, bool zero_nsa) {
    unsigned char* ws = A.ws;
    const int b = item >> 7, chunk = item & 127; const size_t row0 = (size_t)b * SEQ + chunk * 64;
    LAS float* carry = (LAS float*)lds;
    { const int c = F.tid; const float* SUMM = (const float*)(ws + WS_SUMM) + (size_t)b * 128 * 1024 + 2 * c; float hc = 0.f;
      int j = 0;
      for (; j + 8 <= chunk; j += 8) { float2 ab[8];
#pragma unroll
          for (int q = 0; q < 8; ++q) ab[q] = *(const float2*)(SUMM + (size_t)(j + q) * 1024);
#pragma unroll
          for (int q = 0; q < 8; ++q) hc = ab[q].x * hc + ab[q].y; }
      for (; j < chunk; ++j) { const float2 ab = *(const float2*)(SUMM + (size_t)j * 1024); hc = ab.x * hc + ab.y; }
      carry[c] = hc; }
    __syncthreads();
    const bf16* Z = (const bf16*)(ws + WS_Z); const unsigned* HA = (const unsigned*)A.out; bf16* Y = (bf16*)(ws + WS_Y);
    const int c0 = 8 * F.lane;
    float cr[8];
#pragma unroll
    for (int j = 0; j < 8; ++j) cr[j] = carry[c0 + j];
#pragma unroll 1
    for (int t4 = 0; t4 < 8; t4 += 4) {
        v4u h0[4], h1[4], gz[4]; float y[4][8], s[4];
#pragma unroll
        for (int q = 0; q < 4; ++q) { const size_t row = row0 + F.wave * 8 + t4 + q; h0[q] = *(const v4u*)(HA + row * 512 + c0); h1[q] = *(const v4u*)(HA + row * 512 + c0 + 4); gz[q] = *(const v4u*)(Z + row * NZ + ZC_GT + c0); }
#pragma unroll
        for (int q = 0; q < 4; ++q) { const unsigned hw[8] = {h0[q].x, h0[q].y, h0[q].z, h0[q].w, h1[q].x, h1[q].y, h1[q].z, h1[q].w};
            const float gt[8] = {bflo(gz[q].x), bfhi(gz[q].x), bflo(gz[q].y), bfhi(gz[q].y), bflo(gz[q].z), bfhi(gz[q].z), bflo(gz[q].w), bfhi(gz[q].w)};
            s[q] = 0.f;
#pragma unroll
            for (int j = 0; j < 8; ++j) { const float hv = bfhi(hw[j]) * cr[j] + bflo(hw[j]); y[q][j] = hv * gelu_tanh(gt[j]); s[q] += y[q][j] * y[q][j]; } }
#pragma unroll
        for (int o = 1; o < 64; o <<= 1)
#pragma unroll
            for (int q = 0; q < 4; ++q) s[q] += __shfl_xor(s[q], o);
#pragma unroll
        for (int q = 0; q < 4; ++q) { const size_t row = row0 + F.wave * 8 + t4 + q; const float rstd = rsqrtf(s[q] * (1.f / 512.f) + EPS);
            v4u o; o.x = pk2(y[q][0] * rstd, y[q][1] * rstd); o.y = pk2(y[q][2] * rstd, y[q][3] * rstd); o.z = pk2(y[q][4] * rstd, y[q][5] * rstd); o.w = pk2(y[q][6] * rstd, y[q][7] * rstd);
            *(v4u*)(Y + row * DM + 512 + c0) = o;
            if (zero_nsa) *(v4u*)(Y + row * DM + c0) = (v4u){0u, 0u, 0u, 0u}; }
    }
    __syncthreads();
}

__device__ __forceinline__ void kmax_item(const Frame& F, const Args& A, int item) {
    unsigned char* ws = A.ws; const int lane = lane_id();
    const int bk = item >> 9, br = (item >> 8) & 1, tile = item & 255;
    const unsigned char* K = ws + (br ? WS_KWF : WS_KSF) + ((size_t)bk * 256 + tile) * 4096 + 16 * lane;
    float s = 0.f;
#pragma unroll
    for (int ks = 0; ks < 4; ++ks) { const v4u w = *(const v4u*)(K + 1024 * ks); const unsigned ww[4] = {w.x, w.y, w.z, w.w};
#pragma unroll
        for (int k = 0; k < 4; ++k) { const float a = bflo(ww[k]), c = bfhi(ww[k]); s += a * a + c * c; } }
    s = addswap32_f(s);
#pragma unroll
    for (int o = 1; o < 32; o <<= 1) s = fmaxf(s, __shfl_xor(s, o));
    if (lane == 0) atomicMax((unsigned*)(ws + WS_CTL) + CW_KMAX + bk * 2 + br, __builtin_bit_cast(unsigned, s));
}
__device__ __forceinline__ void compress_item(const Frame& F, const Args& A, LAS unsigned char* lds, int item) {
    unsigned char* ws = A.ws;
    const int kv = item >> 6, b = (item >> 5) & 1, h = (item >> 4) & 1, nt = item & 15, n0 = 32 * nt;
    const int lane = F.lane, r32 = lane & 31, hi = lane >> 5, w = F.wave;
    const bf16* Z = (const bf16*)(ws + WS_Z); const bf16* W1T = (const bf16*)(ws + WS_CW1T) + (size_t)kv * 64 * 2048; const bf16* W2T = (const bf16*)(ws + WS_CW2T) + (size_t)kv * 4096;
    const int zc = (kv ? ZC_VC : ZC_KC) + h * 64;
    LAS float* part = (LAS float*)lds;
    LAS float* G = (LAS float*)(lds + 65536);
    {
        int n = n0 + r32; if (n > 510) n = 510;
        f32x16 acc[2]; acc[0] = f32x16{}; acc[1] = f32x16{};
#pragma unroll 4
        for (int kk = 0; kk < 16; ++kk) { const int ks = 16 * w + kk, l = ks >> 2, d0 = (ks & 3) * 16 + 8 * hi;
            const bf16x8 bfr = *(const bf16x8*)(Z + ((size_t)b * SEQ + 16 * n + l) * NZ + zc + d0);
            const bf16x8 a0 = *(const bf16x8*)(W1T + (size_t)(r32) * 2048 + ks * 16 + 8 * hi), a1 = *(const bf16x8*)(W1T + (size_t)(32 + r32) * 2048 + ks * 16 + 8 * hi);
            acc[0] = __builtin_amdgcn_mfma_f32_32x32x16_bf16(a0, bfr, acc[0], 0, 0, 0); acc[1] = __builtin_amdgcn_mfma_f32_32x32x16_bf16(a1, bfr, acc[1], 0, 0, 0); }
#pragma unroll
        for (int ot = 0; ot < 2; ++ot)
#pragma unroll
            for (int r = 0; r < 16; ++r) part[(w * 64 + 32 * ot + crow(r, hi)) * 32 + r32] = acc[ot][r];
    }
    __syncthreads();
    { const float* c1 = (const float*)(ws + WS_C1) + kv * 16 * 64;
#pragma unroll
      for (int i = 0; i < 4; ++i) { const int e = F.tid + 512 * i, o = e >> 5, n = e & 31; float s = 0.f;
#pragma unroll
          for (int ch = 0; ch < 16; ++ch) s += c1[ch * 64 + o];
#pragma unroll
          for (int ww = 0; ww < 8; ++ww) s += part[(ww * 64 + o) * 32 + n];
          G[o * 33 + n] = gelu_tanh(s); } }
    __syncthreads();
    if (w < 2) {
        f32x16 acc = f32x16{};
#pragma unroll
        for (int ks = 0; ks < 4; ++ks) { const bf16x8 a = *(const bf16x8*)(W2T + (size_t)(32 * w + r32) * 64 + 16 * ks + 8 * hi);
            v4u bw; const LAS float* gp = G + (16 * ks + 8 * hi) * 33 + r32;
            bw.x = pk2(gp[0], gp[33]); bw.y = pk2(gp[66], gp[99]); bw.z = pk2(gp[132], gp[165]); bw.w = pk2(gp[198], gp[231]);
            acc = __builtin_amdgcn_mfma_f32_32x32x16_bf16(a, __builtin_bit_cast(bf16x8, bw), acc, 0, 0, 0); }
        const int n = n0 + r32;
        const size_t tbase = ((size_t)(b * 2 + h) * 16 + nt) * 2048;
        if (kv == 0) { bf16* KC = (bf16*)(ws + WS_KC) + tbase;
#pragma unroll
            for (int q = 0; q < 4; ++q) { v2u o; o.x = pk2(acc[4 * q], acc[4 * q + 1]); o.y = pk2(acc[4 * q + 2], acc[4 * q + 3]); if (n > 510) { o.x = 0u; o.y = 0u; }
                *(v2u*)(KC + (2 * w + (q >> 1)) * 512 + (q & 1) * 256 + r32 * 8 + 4 * hi) = o; } }
        else { bf16* VC = (bf16*)(ws + WS_VCT) + tbase; const int kk = r32 & 15, vo = (r32 >> 4) * 512 + ((kk >> 2) & 1) * 256 + (kk & 3) + 4 * (kk >> 3);
#pragma unroll
            for (int r = 0; r < 16; ++r) VC[w * 1024 + crow(r, hi) * 8 + vo] = (n > 510) ? (bf16)0 : (bf16)f2bf(acc[r]); }
    }
    __syncthreads();
}

__device__ __forceinline__ void sort16_desc(int (&k)[16]) {
#define CX(i, j) { const int hi_ = max(k[i], k[j]), lo_ = min(k[i], k[j]); k[i] = hi_; k[j] = lo_; }
    CX(0, 1) CX(2, 3) CX(0, 2) CX(1, 3) CX(1, 2) CX(4, 5) CX(6, 7) CX(4, 6) CX(5, 7) CX(5, 6) CX(0, 4) CX(2, 6) CX(2, 4) CX(1, 5) CX(3, 7) CX(3, 5) CX(1, 2)
    CX(3, 4) CX(5, 6) CX(8, 9) CX(10, 11) CX(8, 10) CX(9, 11) CX(9, 10) CX(12, 13) CX(14, 15) CX(12, 14) CX(13, 15) CX(13, 14) CX(8, 12) CX(10, 14) CX(10, 12)
    CX(9, 13) CX(11, 15) CX(11, 13) CX(9, 10) CX(11, 12) CX(13, 14) CX(0, 8) CX(4, 12) CX(4, 8) CX(2, 10) CX(6, 14) CX(6, 10) CX(2, 4) CX(6, 8) CX(10, 12)
    CX(1, 9) CX(5, 13) CX(5, 9) CX(3, 11) CX(7, 15) CX(7, 11) CX(3, 5) CX(7, 9) CX(11, 13) CX(1, 2) CX(3, 4) CX(5, 6) CX(7, 8) CX(9, 10) CX(11, 12) CX(13, 14)
#undef CX
}
__device__ __forceinline__ void sort32_desc(int (&k)[32]) {
#define CX(i, j) { const int hi_ = max(k[i], k[j]), lo_ = min(k[i], k[j]); k[i] = hi_; k[j] = lo_; }
    CX(0, 1) CX(2, 3) CX(0, 2) CX(1, 3) CX(1, 2) CX(4, 5) CX(6, 7) CX(4, 6) CX(5, 7) CX(5, 6) CX(0, 4) CX(2, 6) CX(2, 4) CX(1, 5) CX(3, 7) CX(3, 5) CX(1, 2)
    CX(3, 4) CX(5, 6) CX(8, 9) CX(10, 11) CX(8, 10) CX(9, 11) CX(9, 10) CX(12, 13) CX(14, 15) CX(12, 14) CX(13, 15) CX(13, 14) CX(8, 12) CX(10, 14) CX(10, 12)
    CX(9, 13) CX(11, 15) CX(11, 13) CX(9, 10) CX(11, 12) CX(13, 14) CX(0, 8) CX(4, 12) CX(4, 8) CX(2, 10) CX(6, 14) CX(6, 10) CX(2, 4) CX(6, 8) CX(10, 12)
    CX(1, 9) CX(5, 13) CX(5, 9) CX(3, 11) CX(7, 15) CX(7, 11) CX(3, 5) CX(7, 9) CX(11, 13) CX(1, 2) CX(3, 4) CX(5, 6) CX(7, 8) CX(9, 10) CX(11, 12) CX(13, 14)
    CX(16, 17) CX(18, 19) CX(16, 18) CX(17, 19) CX(17, 18) CX(20, 21) CX(22, 23) CX(20, 22) CX(21, 23) CX(21, 22) CX(16, 20) CX(18, 22) CX(18, 20) CX(17, 21)
    CX(19, 23) CX(19, 21) CX(17, 18) CX(19, 20) CX(21, 22) CX(24, 25) CX(26, 27) CX(24, 26) CX(25, 27) CX(25, 26) CX(28, 29) CX(30, 31) CX(28, 30) CX(29, 31)
    CX(29, 30) CX(24, 28) CX(26, 30) CX(26, 28) CX(25, 29) CX(27, 31) CX(27, 29) CX(25, 26) CX(27, 28) CX(29, 30) CX(16, 24) CX(20, 28) CX(20, 24) CX(18, 26)
    CX(22, 30) CX(22, 26) CX(18, 20) CX(22, 24) CX(26, 28) CX(17, 25) CX(21, 29) CX(21, 25) CX(19, 27) CX(23, 31) CX(23, 27) CX(19, 21) CX(23, 25) CX(27, 29)
    CX(17, 18) CX(19, 20) CX(21, 22) CX(23, 24) CX(25, 26) CX(27, 28) CX(29, 30) CX(0, 16) CX(8, 24) CX(8, 16) CX(4, 20) CX(12, 28) CX(12, 20) CX(4, 8)
    CX(12, 16) CX(20, 24) CX(2, 18) CX(10, 26) CX(10, 18) CX(6, 22) CX(14, 30) CX(14, 22) CX(6, 10) CX(14, 18) CX(22, 26) CX(2, 4) CX(6, 8) CX(10, 12)
    CX(14, 16) CX(18, 20) CX(22, 24) CX(26, 28) CX(1, 17) CX(9, 25) CX(9, 17) CX(5, 21) CX(13, 29) CX(13, 21) CX(5, 9) CX(13, 17) CX(21, 25) CX(3, 19)
    CX(11, 27) CX(11, 19) CX(7, 23) CX(15, 31) CX(15, 23) CX(7, 11) CX(15, 19) CX(23, 27) CX(3, 5) CX(7, 9) CX(11, 13) CX(15, 17) CX(19, 21) CX(23, 25)
    CX(27, 29) CX(1, 2) CX(3, 4) CX(5, 6) CX(7, 8) CX(9, 10) CX(11, 12) CX(13, 14) CX(15, 16) CX(17, 18) CX(19, 20) CX(21, 22) CX(23, 24) CX(25, 26) CX(27, 28)
    CX(29, 30)
#undef CX
}
__device__ __forceinline__ void bitonic16_desc(int (&a)[16]) {
#pragma unroll
    for (int s = 8; s >= 1; s >>= 1)
#pragma unroll
        for (int i = 0; i < 16; ++i) if ((i & s) == 0) { const int hi_ = max(a[i], a[i + s]), lo_ = min(a[i], a[i + s]); a[i] = hi_; a[i + s] = lo_; }
}
__device__ __forceinline__ void merge16_desc(int (&a)[16], const int (&b)[16]) {
#pragma unroll
    for (int i = 0; i < 16; ++i) a[i] = max(a[i], b[15 - i]);
    bitonic16_desc(a);
}
struct AttnSt { float m, l; f32x16 o[2]; };
#define EX2(x) __builtin_amdgcn_exp2f(x)
struct KVF { bf16x8 k[4]; bf16x8 v[2][2]; };
struct KVF8 { bf16x8 k[4]; v4u v8[2]; };
__device__ __forceinline__ void kv_load8(KVF8& f, const bf16* Kt, const unsigned char* Vt8, unsigned lo16) {
    const char* kb = (const char*)Kt + lo16;
#pragma unroll
    for (int ks = 0; ks < 4; ++ks) f.k[ks] = *(const bf16x8*)(kb + 1024 * ks);
#pragma unroll
    for (int dt = 0; dt < 2; ++dt) f.v8[dt] = *(const v4u*)(Vt8 + lo16 + 1024 * dt);
}
typedef __bf16 bf16x2v __attribute__((ext_vector_type(2)));
__device__ __forceinline__ bf16x8 dq8(unsigned w0, unsigned w1) {
    v4u o; o.x = __builtin_bit_cast(unsigned, __builtin_amdgcn_cvt_scalef32_pk_bf16_fp8(w0, 1.0f, false)); o.y = __builtin_bit_cast(unsigned, __builtin_amdgcn_cvt_scalef32_pk_bf16_fp8(w0, 1.0f, true));
    o.z = __builtin_bit_cast(unsigned, __builtin_amdgcn_cvt_scalef32_pk_bf16_fp8(w1, 1.0f, false)); o.w = __builtin_bit_cast(unsigned, __builtin_amdgcn_cvt_scalef32_pk_bf16_fp8(w1, 1.0f, true));
    return __builtin_bit_cast(bf16x8, o); }
__device__ __forceinline__ void kv_load(KVF& f, const bf16* Kt, const bf16* Vt, unsigned lo16) {
    const char* kb = (const char*)Kt + lo16; const char* vb = (const char*)Vt + lo16;
#pragma unroll
    for (int ks = 0; ks < 4; ++ks) f.k[ks] = *(const bf16x8*)(kb + 1024 * ks);
#pragma unroll
    for (int dt = 0; dt < 2; ++dt)
#pragma unroll
        for (int s2 = 0; s2 < 2; ++s2) f.v[dt][s2] = *(const bf16x8*)(vb + 2048 * dt + 1024 * s2);
}
#define MAX3(a, b, c) __builtin_fmaxf(__builtin_fmaxf((a), (b)), (c))
__device__ __forceinline__ float max16(const f32x16& s) { const float a = MAX3(s[0], s[1], s[2]), b = MAX3(s[3], s[4], s[5]), c = MAX3(s[6], s[7], s[8]), d = MAX3(s[9], s[10], s[11]), e = MAX3(s[12], s[13], s[14]);
    return MAX3(MAX3(a, b, c), MAX3(d, e, s[15]), -1e30f); }
__device__ __forceinline__ float sum16(const f32x16& s) { return (((s[0] + s[1]) + (s[2] + s[3])) + ((s[4] + s[5]) + (s[6] + s[7]))) + (((s[8] + s[9]) + (s[10] + s[11])) + ((s[12] + s[13]) + (s[14] + s[15]))); }
template <int MODE, bool FIXED, class AllowF>
__device__ __forceinline__ void attn_compute(const KVF8& f, const bf16x8 (&qf)[4], const f32x16& negm, bool sel, AllowF allow, AttnSt& st) {
    f32x16 s = FIXED ? negm : f32x16{};
#pragma unroll
    for (int ks = 0; ks < 4; ++ks) s = __builtin_amdgcn_mfma_f32_32x32x16_bf16(f.k[ks], qf[ks], s, 0, 0, 0);
    if (MODE == 2) {
#pragma unroll
        for (int r = 0; r < 16; ++r) if (!allow(r)) s[r] = -1e30f; }
    if (!FIXED) {
        float mt = max16(s);
        if (MODE == 1) mt = sel ? mt : -1e30f;
        mt = maxswap32_f(mt);
        if (__any(mt > st.m)) {
            const float mn = fmaxf(st.m, mt), alpha = EX2(st.m - mn);
            st.m = mn; st.l *= alpha;
#pragma unroll
            for (int dt = 0; dt < 2; ++dt)
#pragma unroll
                for (int r = 0; r < 16; ++r) st.o[dt][r] *= alpha;
        }
        const float mref = (MODE == 1 && !sel) ? 1e30f : fmaxf(st.m, -1e29f);
#pragma unroll
        for (int r = 0; r < 16; ++r) s[r] = EX2(s[r] - mref);
        st.l += sum16(s);
    } else {
#pragma unroll
        for (int r = 0; r < 16; ++r) s[r] = EX2(s[r]);
        const float ps = sum16(s);
        st.l += (MODE == 1 && !sel) ? 0.f : ps;
    }
#pragma unroll
    for (int s2 = 0; s2 < 2; ++s2) { v4u pw; pw.x = pk2(s[8 * s2], s[8 * s2 + 1]); pw.y = pk2(s[8 * s2 + 2], s[8 * s2 + 3]); pw.z = pk2(s[8 * s2 + 4], s[8 * s2 + 5]); pw.w = pk2(s[8 * s2 + 6], s[8 * s2 + 7]);
        if (FIXED && MODE == 1) { pw.x = sel ? pw.x : 0u; pw.y = sel ? pw.y : 0u; pw.z = sel ? pw.z : 0u; pw.w = sel ? pw.w : 0u; }
        const bf16x8 pf = __builtin_bit_cast(bf16x8, pw);
#pragma unroll
        for (int dt = 0; dt < 2; ++dt) st.o[dt] = __builtin_amdgcn_mfma_f32_32x32x16_bf16(dq8(f.v8[dt][2 * s2], f.v8[dt][2 * s2 + 1]), pf, st.o[dt], 0, 0, 0); }
}
constexpr int IMP_LD = 132;
__device__ __forceinline__ void nsa_item(const Frame& F, const Args& A, LAS unsigned char* lds, int b, int kvh, int tb, int wsub) {
    unsigned char* ws = A.ws;
    int lane = lane_id(); asm volatile("" : "+v"(lane));
    const int r32 = lane & 31, hi = lane >> 5, w = F.wave;
    const int t0 = 64 * tb + 8 * wsub, ti = r32 & 7, g = r32 >> 3, t = t0 + ti, cur = tb;
    const size_t rowb = (size_t)b * SEQ;
    const bf16* Z = (const bf16*)(ws + WS_Z);
    LAS float* imp = (LAS float*)lds + w * 8 * IMP_LD;
    for (int i = lane; i < 8 * IMP_LD; i += 64) imp[i] = 0.f;
    bf16x8 qf[4];
#pragma unroll
    for (int ks = 0; ks < 4; ++ks) qf[ks] = *(const bf16x8*)(Z + (rowb + t) * NZ + ZC_Q + (kvh * 4 + g) * 64 + 16 * ks + 8 * hi);
    const float* gp = (const float*)(ws + WS_GATES) + (rowb + t) * 24 + (kvh * 4 + g) * 3;
    const float gate_c = gp[0], gate_s = gp[1], gate_w = gp[2];
    LAS float* oacc = (LAS float*)(lds + 8 * 8 * IMP_LD * 4) + w * 2048 + lane;
    {
        const bf16* KC = (const bf16*)(ws + WS_KC) + (size_t)(b * 2 + kvh) * 16 * 2048;
        const bf16* VCT = (const bf16*)(ws + WS_VCT) + (size_t)(b * 2 + kvh) * 16 * 2048;
        const int nv = (t >= 31) ? ((t - 31) >> 4) + 1 : 0;
        const int tl = t0 + 7, nvmax = (tl >= 31) ? ((tl - 31) >> 4) + 1 : 0;
        const unsigned lo16 = 16u * (unsigned)lane;
        float m1 = -1e30f, l1 = 0.f;
        {
            bf16x8 ka[4], kb[4];
#pragma unroll
            for (int ks = 0; ks < 4; ++ks) ka[ks] = *(const bf16x8*)((const char*)KC + lo16 + 1024 * ks);
            for (int n0 = 0; n0 < nvmax; n0 += 32) {
                if (n0 + 32 < nvmax) {
#pragma unroll
                    for (int ks = 0; ks < 4; ++ks) kb[ks] = *(const bf16x8*)((const char*)(KC + (size_t)(n0 + 32) * 64) + lo16 + 1024 * ks);
                }
                f32x16 s = f32x16{};
#pragma unroll
                for (int ks = 0; ks < 4; ++ks) s = __builtin_amdgcn_mfma_f32_32x32x16_bf16(ka[ks], qf[ks], s, 0, 0, 0);
                float mt = -1e30f;
#pragma unroll
                for (int r = 0; r < 16; ++r) { if (n0 + crow(r, hi) >= nv) s[r] = -1e30f; mt = fmaxf(mt, s[r]); }
                const float mn = fmaxf(m1, mt); float ps = 0.f;
#pragma unroll
                for (int r = 0; r < 16; ++r) ps += (s[r] > -1e29f) ? EX2(s[r] - mn) : 0.f;
                l1 = l1 * EX2(m1 - mn) + ps; m1 = mn;
#pragma unroll
                for (int ks = 0; ks < 4; ++ks) ka[ks] = kb[ks];
            }
        }
        { const float mo = __shfl_xor(m1, 32), lo = __shfl_xor(l1, 32); const float mn = fmaxf(m1, mo); l1 = l1 * EX2(m1 - mn) + lo * EX2(mo - mn); m1 = mn; }
        const float invl = (l1 > 0.f) ? 1.0f / l1 : 0.f;
        f32x16 o[2]; o[0] = f32x16{}; o[1] = f32x16{};
        KVF fa, fb;
        if (nvmax > 0) kv_load(fa, KC, VCT, lo16);
        for (int n0 = 0; n0 < nvmax; n0 += 32) {
            if (n0 + 32 < nvmax) kv_load(fb, KC + (size_t)(n0 + 32) * 64, VCT + (size_t)(n0 + 32) * 64, lo16);
            f32x16 s = f32x16{};
#pragma unroll
            for (int ks = 0; ks < 4; ++ks) s = __builtin_amdgcn_mfma_f32_32x32x16_bf16(fa.k[ks], qf[ks], s, 0, 0, 0);
#pragma unroll
            for (int r = 0; r < 16; ++r) s[r] = (n0 + crow(r, hi) < nv) ? EX2(s[r] - m1) * invl : 0.f;
            float bs[4], sp[4];
#pragma unroll
            for (int q = 0; q < 4; ++q) { bs[q] = (s[4 * q] + s[4 * q + 1]) + (s[4 * q + 2] + s[4 * q + 3]); sp[q] = s[4 * q + 3];
                bs[q] += __shfl_xor(bs[q], 8); bs[q] += __shfl_xor(bs[q], 16); sp[q] += __shfl_xor(sp[q], 8); sp[q] += __shfl_xor(sp[q], 16); }
            if (r32 < 8) {
                LAS float* ip = imp + r32 * IMP_LD + (n0 >> 2) + hi;
#pragma unroll
                for (int q = 0; q < 4; ++q) ip[2 * q] += bs[q];
                asm volatile("s_waitcnt lgkmcnt(0)" ::: "memory");
#pragma unroll
                for (int q = 0; q < 4; ++q) ip[2 * q + 1] += sp[q];
                asm volatile("s_waitcnt lgkmcnt(0)" ::: "memory");
            }
#pragma unroll
            for (int s2 = 0; s2 < 2; ++s2) { v4u pw; pw.x = pk2(s[8 * s2], s[8 * s2 + 1]); pw.y = pk2(s[8 * s2 + 2], s[8 * s2 + 3]); pw.z = pk2(s[8 * s2 + 4], s[8 * s2 + 5]); pw.w = pk2(s[8 * s2 + 6], s[8 * s2 + 7]);
                const bf16x8 pf = __builtin_bit_cast(bf16x8, pw);
#pragma unroll
                for (int dt = 0; dt < 2; ++dt) o[dt] = __builtin_amdgcn_mfma_f32_32x32x16_bf16(fa.v[dt][s2], pf, o[dt], 0, 0, 0); }
            if (n0 + 32 < nvmax) fa = fb;
        }
#pragma unroll
        for (int dt = 0; dt < 2; ++dt)
#pragma unroll
            for (int r = 0; r < 16; ++r) oacc[(dt * 16 + r) * 64] = gate_c * o[dt][r];
    }
    asm volatile("s_waitcnt lgkmcnt(0)" ::: "memory");
    unsigned mym[4] = {0u, 0u, 0u, 0u}, un[4] = {0u, 0u, 0u, 0u};
    if (cur < 16) { const unsigned mk = (2u << cur) - 1u; mym[0] = mk; un[0] = mk; }
    else {
        const int tq = lane >> 3, sub = lane & 7;
        int key[16];
#pragma unroll
        for (int i = 0; i < 16; ++i) { const int j = 16 * sub + i; const float v = imp[tq * IMP_LD + j];
            key[i] = (j >= 1 && j <= cur - 2) ? (int)((__builtin_bit_cast(unsigned, v) & ~0x7fu) | (unsigned)(127 - j)) : 0; }
        sort16_desc(key);
        { int ot[16];
#pragma unroll
          for (int i = 0; i < 16; ++i) ot[i] = __builtin_amdgcn_mov_dpp(key[i], 0xB1, 0xf, 0xf, true);
          merge16_desc(key, ot);
#pragma unroll
          for (int i = 0; i < 16; ++i) ot[i] = __builtin_amdgcn_mov_dpp(key[i], 0x4E, 0xf, 0xf, true);
          merge16_desc(key, ot);
#pragma unroll
          for (int i = 0; i < 16; ++i) ot[i] = __builtin_amdgcn_mov_dpp(key[i], 0x141, 0xf, 0xf, true);
          merge16_desc(key, ot); }
        unsigned mk[4] = {1u, 0u, 0u, 0u};
        { const int c1 = cur - 1; if (c1 < 32) mk[0] |= 1u << c1; else if (c1 < 64) mk[1] |= 1u << (c1 - 32); else if (c1 < 96) mk[2] |= 1u << (c1 - 64); else mk[3] |= 1u << (c1 - 96);
          if (cur < 32) mk[0] |= 1u << cur; else if (cur < 64) mk[1] |= 1u << (cur - 32); else if (cur < 96) mk[2] |= 1u << (cur - 64); else mk[3] |= 1u << (cur - 96); }
#pragma unroll
        for (int i = 0; i < 13; ++i) { const int j = 127 - (key[i] & 0x7f); const unsigned bit = (key[i] != 0) ? (1u << (j & 31)) : 0u; const int wd = j >> 5;
            mk[0] |= (wd == 0) ? bit : 0u; mk[1] |= (wd == 1) ? bit : 0u; mk[2] |= (wd == 2) ? bit : 0u; mk[3] |= (wd == 3) ? bit : 0u; }
#pragma unroll
        for (int i = 0; i < 4; ++i) { unsigned u = mk[i]; u |= (unsigned)__shfl_xor((int)u, 8); u |= (unsigned)__shfl_xor((int)u, 16); u |= (unsigned)__shfl_xor((int)u, 32); un[i] = u;
            mym[i] = (unsigned)__shfl((int)mk[i], 8 * ti); }
    }
    float q2 = 0.f;
#pragma unroll
    for (int ks = 0; ks < 4; ++ks) { const v4u qw = __builtin_bit_cast(v4u, qf[ks]); const unsigned ww[4] = {qw.x, qw.y, qw.z, qw.w};
#pragma unroll
        for (int k = 0; k < 4; ++k) { const float a = bflo(ww[k]), c = bfhi(ww[k]); q2 += a * a + c * c; } }
    q2 = addswap32_f(q2);
    const unsigned* KMX = (const unsigned*)(ws + WS_CTL) + CW_KMAX + (b * 2 + kvh) * 2;
    const float Ms = __builtin_amdgcn_sqrtf(q2 * __builtin_bit_cast(float, KMX[0])) * 1.0001f + 1e-3f, Mw = __builtin_amdgcn_sqrtf(q2 * __builtin_bit_cast(float, KMX[1])) * 1.0001f + 1e-3f;
    const bool fixed_ok = !__any(Ms >= 60.f || Mw >= 60.f);
    {
        AttnSt st; st.m = -1e30f; st.l = 0.f; st.o[0] = f32x16{}; st.o[1] = f32x16{};
        const bf16* KS = (const bf16*)(ws + WS_KSF) + (size_t)(b * 2 + kvh) * 256 * 2048; const unsigned char* VS = ws + WS_VSF + (size_t)(b * 2 + kvh) * 256 * 2048;
        const unsigned lo16 = 16u * (unsigned)lane;
        unsigned um0 = (unsigned)__builtin_amdgcn_readfirstlane((int)un[0]), um1 = (unsigned)__builtin_amdgcn_readfirstlane((int)un[1]), um2 = (unsigned)__builtin_amdgcn_readfirstlane((int)un[2]), um3 = (unsigned)__builtin_amdgcn_readfirstlane((int)un[3]);
#define NEXT_BLOCK(jv) do { if (um0) { jv = __builtin_ctz(um0); um0 &= um0 - 1u; } else if (um1) { jv = 32 + __builtin_ctz(um1); um1 &= um1 - 1u; } else if (um2) { jv = 64 + __builtin_ctz(um2); um2 &= um2 - 1u; } \
            else if (um3) { jv = 96 + __builtin_ctz(um3); um3 &= um3 - 1u; } else jv = -1; } while (0)
#define SLC_LOOP(FX) do { f32x16 negm; _Pragma("unroll") for (int r = 0; r < 16; ++r) negm[r] = -Ms; \
        KVF8 fa, fb; int j; NEXT_BLOCK(j); \
        if (j >= 0) kv_load8(fa, KS + (size_t)j * 4096, VS + (size_t)j * 4096, lo16); \
        while (j >= 0) { const int key0 = j * 64; \
            const unsigned mw = (j < 32) ? mym[0] : (j < 64) ? mym[1] : (j < 96) ? mym[2] : mym[3]; const bool sel = (mw >> (j & 31)) & 1u; \
            kv_load8(fb, KS + (size_t)j * 4096 + 2048, VS + (size_t)j * 4096 + 2048, lo16); \
            if (j == cur) attn_compute<2, FX>(fa, qf, negm, sel, [&](int r) { return sel && (key0 + crow(r, hi) <= t); }, st); \
            else attn_compute<1, FX>(fa, qf, negm, sel, [&](int) { return true; }, st); \
            int jn; NEXT_BLOCK(jn); \
            if (jn >= 0) kv_load8(fa, KS + (size_t)jn * 4096, VS + (size_t)jn * 4096, lo16); \
            if (j == cur) attn_compute<2, FX>(fb, qf, negm, sel, [&](int r) { return sel && (key0 + 32 + crow(r, hi) <= t); }, st); \
            else attn_compute<1, FX>(fb, qf, negm, sel, [&](int) { return true; }, st); \
            j = jn; } } while (0)
        if (fixed_ok) SLC_LOOP(true); else SLC_LOOP(false);
#undef SLC_LOOP
#undef NEXT_BLOCK
        const float l = addswap32_f(st.l); const float sc = gate_s / l;
#pragma unroll
        for (int dt = 0; dt < 2; ++dt)
#pragma unroll
            for (int r = 0; r < 16; ++r) oacc[(dt * 16 + r) * 64] += sc * st.o[dt][r];
    }
    f32x16 outv[2];
    {
        AttnSt st; st.m = -1e30f; st.l = 0.f; st.o[0] = f32x16{}; st.o[1] = f32x16{};
        const bf16* KW = (const bf16*)(ws + WS_KWF) + (size_t)(b * 2 + kvh) * 256 * 2048; const unsigned char* VW = ws + WS_VWF + (size_t)(b * 2 + kvh) * 256 * 2048;
        const unsigned lo16 = 16u * (unsigned)lane;
        const int klo = (t0 - 511 > 0) ? ((t0 - 511) & ~31) : 0, khi = (t0 + 7) & ~31;
#define WIN_LOOP(FX) do { f32x16 negm; _Pragma("unroll") for (int r = 0; r < 16; ++r) negm[r] = -Mw; \
        KVF8 fa, fb; kv_load8(fa, KW + (size_t)klo * 64, VW + (size_t)klo * 64, lo16); \
        _Pragma("unroll 1") for (int key0 = klo; key0 <= khi; key0 += 32) { \
            if (key0 + 32 <= khi) kv_load8(fb, KW + (size_t)(key0 + 32) * 64, VW + (size_t)(key0 + 32) * 64, lo16); \
            if (key0 + 31 > t0 || key0 <= t0 + 7 - 512) attn_compute<2, FX>(fa, qf, negm, true, [&](int r) { const int kp = key0 + crow(r, hi); return kp <= t && kp > t - 512; }, st); \
            else attn_compute<0, FX>(fa, qf, negm, true, [&](int) { return true; }, st); \
            if (key0 + 32 <= khi) fa = fb; } } while (0)
        if (fixed_ok) WIN_LOOP(true); else WIN_LOOP(false);
#undef WIN_LOOP
        const float l = addswap32_f(st.l); const float sc = gate_w / l;
#pragma unroll
        for (int dt = 0; dt < 2; ++dt)
#pragma unroll
            for (int r = 0; r < 16; ++r) outv[dt][r] = oacc[(dt * 16 + r) * 64] + sc * st.o[dt][r];
    }
    float ss = 0.f;
#pragma unroll
    for (int dt = 0; dt < 2; ++dt)
#pragma unroll
        for (int r = 0; r < 16; ++r) ss += outv[dt][r] * outv[dt][r];
    ss += __shfl_xor(ss, 32); ss += __shfl_xor(ss, 8); ss += __shfl_xor(ss, 16);
    if (lane < 8) ((float*)(ws + WS_SSQN))[(rowb + t0 + lane) * 2 + kvh] = ss;
    bf16* Yp = (bf16*)(ws + WS_Y) + (rowb + t) * DM + (kvh * 4 + g) * 64 + 4 * hi;
#pragma unroll
    for (int dt = 0; dt < 2; ++dt)
#pragma unroll
        for (int q = 0; q < 4; ++q) { v2u o; o.x = pk2(outv[dt][4 * q], outv[dt][4 * q + 1]); o.y = pk2(outv[dt][4 * q + 2], outv[dt][4 * q + 3]); *(v2u*)(Yp + 32 * dt + 8 * q) = o; }
}
__device__ __forceinline__ void memattn_item(const Frame& F, const Args& A, int item) {
    unsigned char* ws = A.ws;
    const int lane = F.lane, r32 = lane & 31, hi = lane >> 5;
    const int h = item & 3, tile = item >> 2; const size_t row0 = (size_t)tile * 32; const int b = (int)(row0 >> 13);
    const bf16* Q = (const bf16*)(ws + WS_QM) + (size_t)tile * 32 * DM + (size_t)(h * 16) * 512 + 8 * lane;
    const bf16* K = (const bf16*)(ws + WS_MEMK) + (size_t)(b * 8) * 32 * DM + (size_t)(h * 16) * 512 + 8 * lane;
    const bf16* VF = (const bf16*)(ws + WS_MEMVT) + (size_t)((b * 4 + h) * 8) * 8192 + 8 * lane;
    f32x16 s[8];
#pragma unroll
    for (int kt = 0; kt < 8; ++kt) s[kt] = f32x16{};
#define QK_LOAD(qv, kv, ks_) do { const int kk_ = (ks_) < 16 ? (ks_) : 15; qv = *(const bf16x8*)(Q + 512 * kk_); _Pragma("unroll") for (int kt = 0; kt < 8; ++kt) kv[kt] = *(const bf16x8*)(K + (size_t)kt * 32 * DM + 512 * kk_); } while (0)
#define QK_MMA(qv, kv) do { _Pragma("unroll") for (int kt = 0; kt < 8; ++kt) s[kt] = __builtin_amdgcn_mfma_f32_32x32x16_bf16(kv[kt], qv, s[kt], 0, 0, 0); } while (0)
    { bf16x8 qa, qb, ka[8], kb[8];
      QK_LOAD(qa, ka, 0);
#pragma unroll 1
      for (int ks = 0; ks < 16; ks += 2) {
          QK_LOAD(qb, kb, ks + 1); asm volatile("" ::: "memory");
          QK_MMA(qa, ka);
          QK_LOAD(qa, ka, ks + 2); asm volatile("" ::: "memory");
          QK_MMA(qb, kb); } }
#undef QK_LOAD
#undef QK_MMA
    float m = -1e30f;
#pragma unroll
    for (int kt = 0; kt < 8; ++kt) m = fmaxf(m, max16(s[kt]));
    m = maxswap32_f(m);
    float l = 0.f; v4u pw[8][2];
#pragma unroll
    for (int kt = 0; kt < 8; ++kt) {
#pragma unroll
        for (int r = 0; r < 16; ++r) s[kt][r] = EX2(s[kt][r] - m);
        l += sum16(s[kt]);
#pragma unroll
        for (int s2 = 0; s2 < 2; ++s2) { pw[kt][s2].x = pk2(s[kt][8 * s2], s[kt][8 * s2 + 1]); pw[kt][s2].y = pk2(s[kt][8 * s2 + 2], s[kt][8 * s2 + 3]); pw[kt][s2].z = pk2(s[kt][8 * s2 + 4], s[kt][8 * s2 + 5]); pw[kt][s2].w = pk2(s[kt][8 * s2 + 6], s[kt][8 * s2 + 7]); } }
    l = addswap32_f(l);
    const float invl = 1.0f / l;
    bf16* O = (bf16*)(ws + WS_OM) + (row0 + r32) * DM + h * 256 + 4 * hi;
#define PV_LOAD(vv, dt_) do { const int dd_ = (dt_) < 8 ? (dt_) : 7; _Pragma("unroll") for (int kt = 0; kt < 8; ++kt) _Pragma("unroll") for (int s2 = 0; s2 < 2; ++s2) vv[2 * kt + s2] = *(const bf16x8*)(VF + (size_t)kt * 8192 + dd_ * 1024 + s2 * 512); } while (0)
#define PV_MMA(vv, dt_) do { f32x16 o = f32x16{}; _Pragma("unroll") for (int kt = 0; kt < 8; ++kt) _Pragma("unroll") for (int s2 = 0; s2 < 2; ++s2) o = __builtin_amdgcn_mfma_f32_32x32x16_bf16(vv[2 * kt + s2], __builtin_bit_cast(bf16x8, pw[kt][s2]), o, 0, 0, 0); \
        _Pragma("unroll") for (int q = 0; q < 4; ++q) { v2u ov; ov.x = pk2(o[4 * q] * invl, o[4 * q + 1] * invl); ov.y = pk2(o[4 * q + 2] * invl, o[4 * q + 3] * invl); *(v2u*)(O + 32 * (dt_) + 8 * q) = ov; } } while (0)
    { bf16x8 va[16], vb[16];
      PV_LOAD(va, 0);
#pragma unroll 1
      for (int dt = 0; dt < 8; dt += 2) {
          PV_LOAD(vb, dt + 1); asm volatile("" ::: "memory");
          PV_MMA(va, dt);
          PV_LOAD(va, dt + 2); asm volatile("" ::: "memory");
          PV_MMA(vb, dt + 1); } }
#undef PV_LOAD
#undef PV_MMA
}

__device__ __forceinline__ int f2key(float f) { const int u = __builtin_bit_cast(int, f); return u ^ ((u >> 31) & 0x7fffffff); }
__device__ __forceinline__ float key2f(int k) { const int u = k ^ ((k >> 31) & 0x7fffffff); return __builtin_bit_cast(float, u); }
__device__ __forceinline__ void top16_of_128(f32x16 (&s)[4], int hi, int (&kv)[16]) {
    int key[4][16];
#pragma unroll
    for (int nt = 0; nt < 4; ++nt)
#pragma unroll
        for (int r = 0; r < 16; ++r) key[nt][r] = (f2key(s[nt][r]) & ~0x7f) | (127 - (32 * nt + crow(r, hi)));
#pragma unroll
    for (int nt = 0; nt < 4; ++nt) sort16_desc(key[nt]);
    merge16_desc(key[0], key[1]); merge16_desc(key[2], key[3]); merge16_desc(key[0], key[2]);
    unsigned a[16], b[16];
#pragma unroll
    for (int i = 0; i < 16; ++i) { a[i] = (unsigned)key[0][i]; b[i] = a[i]; swap32(a[i], b[i]); }
#pragma unroll
    for (int i = 0; i < 16; ++i) kv[i] = max((int)a[i], (int)b[15 - i]);
    bitonic16_desc(kv);
}
template <bool LDSK>
__device__ __forceinline__ void peer_topk_item(const Frame& F, const Args& A, int item, const LAS unsigned char* lds) {
    unsigned char* ws = A.ws;
    int lane = lane_id(); asm volatile("" : "+v"(lane));
    const int r32 = lane & 31, hi = lane >> 5;
    const int h = item & 7, tile = item >> 3; const size_t row = (size_t)tile * 32 + r32;
    const bf16* QP = (const bf16*)(ws + WS_QP) + (size_t)tile * 32 * 2048 + (size_t)(h * 16) * 512 + 8 * lane;
    int k1[16], k2[16];
#pragma unroll
    for (int i = 0; i < 16; ++i) { k1[i] = 0; k2[i] = 0; }
#pragma unroll 1
    for (int c = 0; c < 2; ++c) {
        const bf16* SK = (const bf16*)(ws + WS_SKEY) + (size_t)((h * 2 + c) * 4) * 4096 + 8 * lane;
        f32x16 s[4];
#pragma unroll
        for (int nt = 0; nt < 4; ++nt) s[nt] = f32x16{};
        bf16x8 qf[8];
#pragma unroll
        for (int ks = 0; ks < 8; ++ks) qf[ks] = *(const bf16x8*)(QP + (size_t)(c * 8 + ks) * 512);
#pragma unroll
        for (int ks = 0; ks < 8; ++ks) {
#pragma unroll
            for (int nt = 0; nt < 4; ++nt) { const bf16x8 kf = LDSK ? *(const LAS bf16x8*)(lds + ((c * 4 + nt) * 4096 + ks * 512) * 2 + lane * 16) : *(const bf16x8*)(SK + (size_t)nt * 4096 + ks * 512);
                s[nt] = __builtin_amdgcn_mfma_f32_32x32x16_bf16(kf, qf[ks], s[nt], 0, 0, 0); } }
        if (c == 0) top16_of_128(s, hi, k1); else top16_of_128(s, hi, k2);
    }
    float v1[16], v2[16];
#pragma unroll
    for (int i = 0; i < 16; ++i) { v1[i] = key2f(k1[i] & ~0x7f); v2[i] = key2f(k2[i] & ~0x7f); }
    int ck[32];
    {
        int idx = 0;
#pragma unroll
        for (int i = 0; i < 32; ++i) ck[i] = (int)0x80000000;
#pragma unroll
        for (int a = 0; a < 16; ++a)
#pragma unroll
            for (int bq = 0; bq < 16; ++bq) if ((a + 1) * (bq + 1) <= 16) {
                const int flat = a * 16 + bq; const int kk = (f2key(v1[a] + v2[bq]) & ~0xff) | (255 - flat);
                if ((idx & 1) == hi) ck[idx >> 1] = kk;
                ++idx; }
    }
    sort32_desc(ck);
    int tk[16];
    { unsigned a[16], b[16];
#pragma unroll
      for (int i = 0; i < 16; ++i) { a[i] = (unsigned)ck[i]; b[i] = a[i]; swap32(a[i], b[i]); }
#pragma unroll
      for (int i = 0; i < 16; ++i) tk[i] = max((int)a[i], (int)b[15 - i]);
      bitonic16_desc(tk); }
    int te[16];
    { LAS int* tab = (LAS int*)(lds + 65536 + F.wave * 8448) + lane * 33;
#pragma unroll
      for (int i = 0; i < 16; ++i) { tab[i] = 127 - (k1[i] & 0x7f); tab[16 + i] = 127 - (k2[i] & 0x7f); }
      asm volatile("s_waitcnt lgkmcnt(0)" ::: "memory");
#pragma unroll
      for (int i = 0; i < 16; ++i) { const int flat = 255 - (tk[i] & 0xff); te[i] = tab[flat >> 4] * 128 + tab[16 + (flat & 15)]; }
      asm volatile("s_waitcnt lgkmcnt(0)" ::: "memory"); }
    float gsm[16]; const float mx = key2f(tk[0] & ~0xff); float den = 0.f;
#pragma unroll
    for (int i = 0; i < 16; ++i) { gsm[i] = __expf(key2f(tk[i] & ~0xff) - mx); den += gsm[i]; }
    const float inv = 1.0f / den;
    if (hi == 0) {
        int* EID = (int*)(ws + WS_EID) + row * 128 + h * 16; float* GW = (float*)(ws + WS_GW) + row * 128 + h * 16;
#pragma unroll
        for (int q = 0; q < 4; ++q) { *(v4u*)(EID + 4 * q) = (v4u){(unsigned)te[4 * q], (unsigned)te[4 * q + 1], (unsigned)te[4 * q + 2], (unsigned)te[4 * q + 3]};
            *(f32x4*)(GW + 4 * q) = (f32x4){gsm[4 * q] * inv, gsm[4 * q + 1] * inv, gsm[4 * q + 2] * inv, gsm[4 * q + 3] * inv}; }
    }
}

typedef float f32x2 __attribute__((ext_vector_type(2)));
__device__ __forceinline__ float dot16_fp8(const v4u u, const f32x2 (&xn)[8]) {
    f32x2 a0 = {0.f, 0.f}, a1 = {0.f, 0.f};
#pragma unroll
    for (int j = 0; j < 4; ++j) { const f32x2 lo = __builtin_amdgcn_cvt_pk_f32_fp8((int)u[j], false), hi = __builtin_amdgcn_cvt_pk_f32_fp8((int)u[j], true);
        a0 = __builtin_elementwise_fma(lo, xn[2 * j], a0); a1 = __builtin_elementwise_fma(hi, xn[2 * j + 1], a1); }
    return (a0.x + a0.y) + (a1.x + a1.y);
}
__device__ __forceinline__ void axpy16_fp8(f32x2 (&acc)[8], const float w, const v4u u) {
    const f32x2 w2 = {w, w};
#pragma unroll
    for (int j = 0; j < 4; ++j) { const f32x2 lo = __builtin_amdgcn_cvt_pk_f32_fp8((int)u[j], false), hi = __builtin_amdgcn_cvt_pk_f32_fp8((int)u[j], true);
        acc[2 * j] = __builtin_elementwise_fma(lo, w2, acc[2 * j]); acc[2 * j + 1] = __builtin_elementwise_fma(hi, w2, acc[2 * j + 1]); }
}
#define TIE_ROW(val, nxt) asm volatile("" : "+v"(val), "+v"((nxt).x), "+v"((nxt).y), "+v"((nxt).z), "+v"((nxt).w))
constexpr int PQ_CHUNK = 128, PQ_NCHUNK = MTOK / PQ_CHUNK;
constexpr int CW_NQ = 10240;
constexpr int CW_PQ = 8192;
__device__ __forceinline__ int pq_pop(unsigned* ctl, int pass, int own, int& q_s, LAS int* bc, int wave) {
    __syncthreads();
    if (wave == 0 && lane_id() == 0) { int res = -1; int s = q_s;
        while (s < 8) { const int x = (own + s) & 7; const unsigned c = __hip_atomic_fetch_add(ctl + CW_PQ + 64 * (8 * pass + x), 1u, __ATOMIC_RELAXED, __HIP_MEMORY_SCOPE_AGENT);
            if (c < (unsigned)PQ_NCHUNK) { res = x * PQ_NCHUNK + (int)c; break; } ++s; }
        bc[0] = res; bc[1] = s; }
    __syncthreads();
    q_s = bc[1]; return bc[0];
}
template <int CTRL> __device__ __forceinline__ float dppf(float v) { return __builtin_bit_cast(float, __builtin_amdgcn_mov_dpp(__builtin_bit_cast(int, v), CTRL, 0xf, 0xf, true)); }
__device__ __forceinline__ float red8(float d) { d += dppf<0xB1>(d); d += dppf<0x4E>(d); d += dppf<0x141>(d); return d; }
__device__ __forceinline__ void peer_issue8(v4u (&rb)[8], const v4u ia, const v4u ib, const unsigned char* T  , unsigned c16) {
    const unsigned e[8] = {ia.x, ia.y, ia.z, ia.w, ib.x, ib.y, ib.z, ib.w};
#pragma unroll
    for (int i = 0; i < 8; ++i) rb[i] = *(const v4u*)(T + (e[i] * 128u + c16));
}
constexpr int PS_ROW = 528, PS_WAVE = 2 * 16 * PS_ROW;
__device__ __forceinline__ void peer_stage16(LAS unsigned char* st, const unsigned char* src  , int lane) {
    v4u e[8];
#pragma unroll
    for (int j = 0; j < 8; ++j) e[j] = __builtin_nontemporal_load((const v4u*)(src + (unsigned)(j * 1024 + lane * 16)));
#pragma unroll
    for (int j = 0; j < 8; ++j) *(LAS v4u*)(st + (2 * j + (lane >> 5)) * PS_ROW + (lane & 31) * 16) = e[j];
}
__device__ __forceinline__ void peer_u_chunk(const Frame& F, const Args& A, LAS unsigned char* lds, int x, int chunk) {
    unsigned char* ws = A.ws; int lane = lane_id(); asm volatile("" : "+v"(lane));
    const int tk = lane >> 3, c8 = lane & 7;
    const unsigned char* U = ws + WS_U8 + (size_t)x * 16384 * 128; const unsigned c16 = 16u * (unsigned)c8;
    LAS unsigned char* st = lds + F.wave * PS_WAVE;
    peer_stage16(st, ws + WS_EID + (size_t)(chunk * PQ_CHUNK + F.wave * 16) * 512, lane);
#pragma unroll 1
    for (int oc = 0; oc < 2; ++oc) {
        const unsigned row = (unsigned)(chunk * PQ_CHUNK + F.wave * 16 + oc * 8 + tk);
        const LAS unsigned char* est = st + (oc * 8 + tk) * PS_ROW;
#define EID_LD(i_) (*(const LAS v4u*)(est + 16 * (i_)))
        f32x2 xn[8];
        { const unsigned char* xb_ = ws + WS_XN; const unsigned xo = row * 2048u + 256u * (unsigned)x + 32u * (unsigned)c8; const v4u xa = *(const v4u*)(xb_ + xo), xb = *(const v4u*)(xb_ + (xo + 16u));
          const unsigned xw[8] = {xa.x, xa.y, xa.z, xa.w, xb.x, xb.y, xb.z, xb.w};
#pragma unroll
          for (int j = 0; j < 8; ++j) { xn[j].x = bflo(xw[j]); xn[j].y = bfhi(xw[j]); } }
        float rstd; { const f32x4* sp = (const f32x4*)(ws + WS_SSQ2 + (size_t)row * 64); const f32x4 a = sp[0], b = sp[1], c = sp[2], d = sp[3];
            rstd = rsqrtf((((a.x + a.y) + (a.z + a.w)) + ((b.x + b.y) + (b.z + b.w)) + ((c.x + c.y) + (c.z + c.w)) + ((d.x + d.y) + (d.z + d.w))) * (1.f / DM) + EPS); }
        unsigned char* ppb = ws + WS_PART; const unsigned po = ((unsigned)x * MTOK + row) * 256u + 32u * (unsigned)c8;
        v4u ra[8], rb[8]; v4u ia0 = EID_LD(0), ia1 = EID_LD(1), ib0 = EID_LD(2), ib1 = EID_LD(3);
        peer_issue8(ra, ia0, ia1, U, c16); ia0 = EID_LD(4); ia1 = EID_LD(5);
#pragma unroll 1
        for (int q = 0; q < 16; q += 2) {
            peer_issue8(rb, ib0, ib1, U, c16); { const int qn = (q + 3 < 16) ? q + 3 : 15; ib0 = EID_LD(2 * qn); ib1 = EID_LD(2 * qn + 1); }
            float k0 = 0.f, k1 = 0.f;
#pragma unroll
            for (int i = 0; i < 8; ++i) { float d = dot16_fp8(ra[i], xn); if (i < 7) TIE_ROW(d, ra[i + 1]); d = red8(d); k0 = (c8 == i) ? d : k0; }
            peer_issue8(ra, ia0, ia1, U, c16); { const int qn = (q + 4 < 16) ? q + 4 : 15; ia0 = EID_LD(2 * qn); ia1 = EID_LD(2 * qn + 1); }
#pragma unroll
            for (int i = 0; i < 8; ++i) { float d = dot16_fp8(rb[i], xn); if (i < 7) TIE_ROW(d, rb[i + 1]); d = red8(d); k1 = (c8 == i) ? d : k1; }
            *(unsigned*)(ppb + (po + 2u * (unsigned)q)) = pk2(k0 * rstd, k1 * rstd);
        }
    }
}
__device__ __forceinline__ void peer_w_rows(const Frame& F, const Args& A) {
    unsigned char* ws = A.ws; const int lane = lane_id();
    const float* SU = (const float*)(ws + WS_SU); const float* SV = (const float*)(ws + WS_SV);
    const int p0 = 2 * lane, k0 = 8 * (p0 & 15) + (p0 >> 4), k1 = k0 + 8;
    for (int m0 = F.gw; m0 < MTOK; m0 += 4 * F.NGW) {
        int e0[4], e1[4]; float g0[4], g1[4]; unsigned pw[4][8];
#pragma unroll
        for (int r = 0; r < 4; ++r) { const size_t row = (size_t)(m0 + r * F.NGW < MTOK ? m0 + r * F.NGW : m0);
            const int* EID = (const int*)(ws + WS_EID) + row * 128; const float* GW = (const float*)(ws + WS_GW) + row * 128;
            e0[r] = EID[k0]; e1[r] = EID[k1]; g0[r] = GW[k0]; g1[r] = GW[k1];
#pragma unroll
            for (int x = 0; x < 8; ++x) pw[r][x] = *(const unsigned*)((const bf16*)(ws + WS_PART) + ((size_t)x * MTOK + row) * 128 + p0); }
        float su0[4], su1[4], sv0[4], sv1[4];
#pragma unroll
        for (int r = 0; r < 4; ++r) { su0[r] = SU[e0[r]]; su1[r] = SU[e1[r]]; sv0[r] = SV[e0[r]]; sv1[r] = SV[e1[r]]; }
#pragma unroll
        for (int r = 0; r < 4; ++r) { if (m0 + r * F.NGW < MTOK) { const size_t row = (size_t)(m0 + r * F.NGW); float s0 = 0.f, s1 = 0.f;
#pragma unroll
            for (int x = 0; x < 8; ++x) { s0 += bflo(pw[r][x]); s1 += bfhi(pw[r][x]); }
            float* W = (float*)(ws + WS_W) + row * 128;
            W[k0] = gelu_tanh(s0 * su0[r]) * g0[r] * sv0[r]; W[k1] = gelu_tanh(s1 * su1[r]) * g1[r] * sv1[r]; } }
    }
}
__device__ __forceinline__ void peer_v_chunk(const Frame& F, const Args& A, LAS unsigned char* lds, int x, int chunk) {
    unsigned char* ws = A.ws; int lane = lane_id(); asm volatile("" : "+v"(lane));
    const int tk = lane >> 3, c8 = lane & 7;
    const unsigned char* V = ws + WS_V8 + (size_t)x * 16384 * 128; const unsigned c16 = 16u * (unsigned)c8;
    LAS unsigned char* st = lds + F.wave * PS_WAVE;
    peer_stage16(st, ws + WS_EID + (size_t)(chunk * PQ_CHUNK + F.wave * 16) * 512, lane);
    peer_stage16(st + 16 * PS_ROW, ws + WS_W + (size_t)(chunk * PQ_CHUNK + F.wave * 16) * 512, lane);
#pragma unroll 1
    for (int oc = 0; oc < 2; ++oc) {
        const unsigned row = (unsigned)(chunk * PQ_CHUNK + F.wave * 16 + oc * 8 + tk);
        const LAS unsigned char* est = st + (oc * 8 + tk) * PS_ROW;
#define W_LD(i_) (*(const LAS f32x4*)(est + 16 * PS_ROW + 16 * (i_)))
        f32x2 acc[8];
#pragma unroll
        for (int j = 0; j < 8; ++j) acc[j] = (f32x2){0.f, 0.f};
        v4u ra[8], rb[8]; v4u ia0 = EID_LD(0), ia1 = EID_LD(1), ib0 = EID_LD(2), ib1 = EID_LD(3); f32x4 wa0 = W_LD(0), wa1 = W_LD(1), wb0 = W_LD(2), wb1 = W_LD(3);
        peer_issue8(ra, ia0, ia1, V, c16); ia0 = EID_LD(4); ia1 = EID_LD(5);
#pragma unroll 1
        for (int q = 0; q < 16; q += 2) {
            peer_issue8(rb, ib0, ib1, V, c16); { const int qn = (q + 3 < 16) ? q + 3 : 15; ib0 = EID_LD(2 * qn); ib1 = EID_LD(2 * qn + 1); }
            { const float wv[8] = {wa0.x, wa0.y, wa0.z, wa0.w, wa1.x, wa1.y, wa1.z, wa1.w};
#pragma unroll
              for (int i = 0; i < 8; ++i) { axpy16_fp8(acc, wv[i], ra[i]); if (i < 7) TIE_ROW(acc[7].y, ra[i + 1]); } }
            { const int qn = (q + 2 < 16) ? q + 2 : 15; wa0 = W_LD(2 * qn); wa1 = W_LD(2 * qn + 1); }
            peer_issue8(ra, ia0, ia1, V, c16); { const int qn = (q + 4 < 16) ? q + 4 : 15; ia0 = EID_LD(2 * qn); ia1 = EID_LD(2 * qn + 1); }
            { const float wv[8] = {wb0.x, wb0.y, wb0.z, wb0.w, wb1.x, wb1.y, wb1.z, wb1.w};
#pragma unroll
              for (int i = 0; i < 8; ++i) { axpy16_fp8(acc, wv[i], rb[i]); if (i < 7) TIE_ROW(acc[7].y, rb[i + 1]); } }
            { const int qn = (q + 3 < 16) ? q + 3 : 15; wb0 = W_LD(2 * qn); wb1 = W_LD(2 * qn + 1); }
        }
        unsigned char* xr = ws + WS_XN + (row * 2048u + 256u * (unsigned)x + 32u * (unsigned)c8); float ss = 0.f;
        const v4u x2a = *(const v4u*)xr, x2b = *(const v4u*)(xr + 16);
        const unsigned xw[8] = {x2a.x, x2a.y, x2a.z, x2a.w, x2b.x, x2b.y, x2b.z, x2b.w};
        unsigned ow[8];
#pragma unroll
        for (int j = 0; j < 4; ++j) { f32x4 v; v.x = bflo(xw[2 * j]) + acc[2 * j].x; v.y = bfhi(xw[2 * j]) + acc[2 * j].y; v.z = bflo(xw[2 * j + 1]) + acc[2 * j + 1].x; v.w = bfhi(xw[2 * j + 1]) + acc[2 * j + 1].y;
            ss += (v.x * v.x + v.y * v.y) + (v.z * v.z + v.w * v.w); ow[2 * j] = pk2(v.x, v.y); ow[2 * j + 1] = pk2(v.z, v.w); }
        *(v4u*)xr = (v4u){ow[0], ow[1], ow[2], ow[3]}; *(v4u*)(xr + 16) = (v4u){ow[4], ow[5], ow[6], ow[7]};
        ss = red8(ss);
        if (c8 == 0) ((float*)(ws + WS_SSQ3))[row * 8 + x] = ss;
    }
#undef W_LD
#undef EID_LD
}
__device__ __forceinline__ void peer_final_rows(const Frame& F, const Args& A) {
    unsigned char* ws = A.ws; const int lane = lane_id(); const float* g = A.in[32];
    for (int m = F.gw; m < MTOK; m += F.NGW) {
        const f32x4 sa = *(const f32x4*)((const float*)(ws + WS_SSQ3) + (size_t)m * 8), sb = *(const f32x4*)((const float*)(ws + WS_SSQ3) + (size_t)m * 8 + 4);
        const float rstd = rsqrtf((((sa.x + sa.y) + (sa.z + sa.w)) + ((sb.x + sb.y) + (sb.z + sb.w))) * (1.f / DM) + EPS);
        f32x4* xr = (f32x4*)(A.out + (size_t)m * DM) + lane; const v2u* xb = (const v2u*)((const bf16*)(ws + WS_XN) + (size_t)m * DM) + lane;
#pragma unroll
        for (int j = 0; j < 4; ++j) { const v2u w = xb[64 * j]; const f32x4 gg = ((const f32x4*)g)[lane + 64 * j]; const f32x4 v = {bflo(w.x), bfhi(w.x), bflo(w.y), bfhi(w.y)}; __builtin_nontemporal_store(v * rstd * gg, xr + 64 * j); }
    }
}

typedef GAS unsigned gu32;
#define RLX_AGENT __ATOMIC_RELAXED, __HIP_MEMORY_SCOPE_AGENT
#define XB_TMO      128
#define XB_XCNT(j)  (256  + 64 * (j))
#define XB_XSUB(j)  (1280 + 64 * (j))
#define XB_XGEN(j)  (2304 + 64 * (j))
#define XB_TOP      3328
#define XB_TOPGEN   3392
#define XCD_BAR_WORDS 3456
#define XB_SPIN_CAP (1u << 18)

__device__ __forceinline__ unsigned xb_ld(unsigned* p)              { return __hip_atomic_load(p, __ATOMIC_RELAXED, __HIP_MEMORY_SCOPE_AGENT); }
__device__ __forceinline__ unsigned xb_add(unsigned* p, unsigned v) { return __hip_atomic_fetch_add(p, v, __ATOMIC_RELAXED, __HIP_MEMORY_SCOPE_AGENT); }
__device__ __forceinline__ unsigned xb_xcc_id() { return (unsigned)__builtin_amdgcn_s_getreg((3 << 11) | 20) & 0xFu; }
#define XB_SPIN(cond, bar) do { unsigned _sp = 0; while (cond) { __builtin_amdgcn_s_sleep(1); \
    if ((++_sp & 255u) == 0u) { if (xb_ld(&(bar)[XB_TMO])) break; if (_sp > XB_SPIN_CAP) { atomicAdd(&(bar)[XB_TMO], 1u); break; } } } } while (0)

struct XcdBarrier {
    unsigned* bar; unsigned x;
    volatile LAS unsigned* st;
};

__device__ __forceinline__ XcdBarrier xcd_barrier_post(unsigned* bar, volatile LAS unsigned* st) {
    XcdBarrier b; b.bar = bar; b.x = xb_xcc_id(); b.st = st;
    if (threadIdx.x == 0) (void)xb_add(&bar[XB_XCNT(b.x)], 1u);
    return b;
}
__device__ __forceinline__ void xcd_barrier_complete(unsigned* bar, unsigned x, unsigned& nloc, unsigned& nx) {
    const unsigned G = gridDim.x * gridDim.y * gridDim.z;
    unsigned sum, cnt, mine, sp = 0u;
    for (;;) {
        sum = 0u; cnt = 0u; mine = 0u;
#pragma unroll
        for (unsigned j = 0; j < 16; ++j) { const unsigned c = xb_ld(&bar[XB_XCNT(j)]); sum += c; cnt += (c > 0u) ? 1u : 0u; mine = (j == x) ? c : mine; }
        if (sum == G) break;
        __builtin_amdgcn_s_sleep(1);
        if ((++sp & 255u) == 0u) { if (xb_ld(&bar[XB_TMO])) break; if (sp > XB_SPIN_CAP) { atomicAdd(&bar[XB_TMO], 1u); break; } }
    }
    nloc = mine > 0u ? mine : 1u; nx = cnt > 0u ? cnt : 1u;
}

__device__ __forceinline__ void xcd_barrier(const XcdBarrier& b) {
    asm volatile("s_waitcnt vmcnt(0)" ::: "memory");
    __syncthreads();
    if (threadIdx.x == 0) {
        unsigned* bar = b.bar;
        __builtin_amdgcn_s_waitcnt(0);
        unsigned nloc = b.st[0], nx = b.st[1];
        if (nloc == 0u) { xcd_barrier_complete(bar, b.x, nloc, nx); b.st[0] = nloc; b.st[1] = nx; }
        const unsigned old = xb_add(&bar[XB_XSUB(b.x)], 1u);
        const unsigned gen = old / nloc;
        if (old + 1u == (gen + 1u) * nloc) {
            __builtin_amdgcn_fence(__ATOMIC_RELEASE, "agent");
            asm volatile("s_waitcnt vmcnt(0)" ::: "memory");
            const unsigned og = xb_add(&bar[XB_TOP], 1u);
            const unsigned tg = og / nx;
            if (og + 1u == (tg + 1u) * nx) xb_add(&bar[XB_TOPGEN], 1u);
            else XB_SPIN(xb_ld(&bar[XB_TOPGEN]) == tg, bar);
            __builtin_amdgcn_fence(__ATOMIC_ACQUIRE, "agent");
            xb_add(&bar[XB_XGEN(b.x)], 1u);
            asm volatile("s_waitcnt vmcnt(0)" ::: "memory");
        } else {
            XB_SPIN(xb_ld(&bar[XB_XGEN(b.x)]) == gen, bar);
            __builtin_amdgcn_fence(__ATOMIC_ACQUIRE, "agent");
            asm volatile("s_waitcnt vmcnt(0)" ::: "memory");
        }
    }
    __syncthreads();
}

#ifndef DBL_MASK
#define DBL_MASK 0
#endif
constexpr int NPHASE = 12;
__global__ void __launch_bounds__(512, 2) fwd_kernel(Args args) {
    extern __shared__ __attribute__((aligned(16))) unsigned char lds_raw[];
    LAS unsigned char* lds = (LAS unsigned char*)lds_raw;
    Frame F;
    F.tid = threadIdx.x; F.lane = F.tid & 63; F.wave = __builtin_amdgcn_readfirstlane(F.tid >> 6);
    F.G = gridDim.x; { const int bx = blockIdx.x; F.vcu = (F.G % 8 == 0) ? (bx % 8) * (F.G / 8) + bx / 8 : bx; }
    F.gw = F.vcu * 8 + F.wave; F.NGW = F.G * 8;
    unsigned char* ws = args.ws;
    const int lo = args.ph_lo, hi = args.ph_hi;
    volatile LAS unsigned* MISC = (volatile LAS unsigned*)(lds + LDS_BYTES - 64);
    if (F.tid < 16) MISC[F.tid] = 0u;
    __syncthreads();
    XcdBarrier bar = xcd_barrier_post((unsigned*)(ws + WS_CTL), MISC);
#define IN(k) (lo <= (k) && (k) < hi)
#define SEAM(k) do { if (IN(k) && IN((k) + 1)) xcd_barrier(bar); } while (0)

    if (IN(0)) for (int rep_ = 0; rep_ <= ((DBL_MASK >> 0) & 1); ++rep_) { if (rep_) xcd_barrier(bar); REFRESH_LANE(F); p0_prologue(F, args, lds); }
    SEAM(0);
    if (IN(1)) for (int rep_ = 0; rep_ <= ((DBL_MASK >> 1) & 1); ++rep_) { if (rep_) xcd_barrier(bar); REFRESH_LANE(F);
        { pg8::Gemm g{(const bf16*)(ws + WS_XN), (const bf16*)(ws + WS_WIN), MTOK, NZP, DM}; pg8::StaticOrder S; S.init(MTOK, NZP, F.G, (int)blockIdx.x);
          pg8::EpiZ E{(bf16*)(ws + WS_Z), (bf16*)(ws + WS_KSF), (bf16*)(ws + WS_VSF), (bf16*)(ws + WS_KWF), (bf16*)(ws + WS_VWF), (float*)(ws + WS_GATES), args.in[4]};
          pg8::gemm_phase<pg8::EpiZ, pg8::StaticOrder, true, true>(lds, g, S, E, F.wave); }
        { pg8::Gemm g{(const bf16*)(ws + WS_MEMN), (const bf16*)(ws + WS_WMK), NB * NMEM, DM, DM}; pg8::StaticOrder S; S.init(NB * NMEM, DM, F.G, ((int)blockIdx.x + 128) & 255);
          pg8::EpiStore E{(bf16*)(ws + WS_MEMK), DM, nullptr, 1};
          pg8::gemm_phase<pg8::EpiStore, pg8::StaticOrder, true, true>(lds, g, S, E, F.wave); }
        { pg8::Gemm g{(const bf16*)(ws + WS_WMV), (const bf16*)(ws + WS_MEMN), DM, NB * NMEM, DM}; pg8::StaticOrder S; S.init(DM, NB * NMEM, F.G, ((int)blockIdx.x + 120) & 255);
          pg8::EpiVFrag E{(bf16*)(ws + WS_MEMVT)};
          pg8::gemm_phase<pg8::EpiVFrag, pg8::StaticOrder, true, true>(lds, g, S, E, F.wave); }
    }
    SEAM(1);
    if (IN(2)) for (int rep_ = 0; rep_ <= ((DBL_MASK >> 2) & 1); ++rep_) { if (rep_) xcd_barrier(bar); REFRESH_LANE(F); for (int it = F.gw; it < 2048; it += F.NGW) kmax_item(F, args, it);
                 for (int it = F.vcu; it < 256; it += F.G) lru_local_item(F, args, lds, it);
                 for (int it = F.G - 1 - F.vcu; it < 128; it += F.G) compress_item(F, args, lds, it); }
    SEAM(2);
    if (IN(3)) for (int rep_ = 0; rep_ <= ((DBL_MASK >> 3) & 1); ++rep_) { if (rep_) xcd_barrier(bar); REFRESH_LANE(F);
                 { unsigned* ctl = (unsigned*)(ws + WS_CTL); const int own = (int)(((long)F.vcu * 8) / F.G) & 7; int qs = 0;
                   for (;;) { int id = -1;
                       if (lane_id() == 0) { while (qs < 8) { const int x = (own + qs) & 7; const unsigned c = __hip_atomic_fetch_add(ctl + CW_NQ + 64 * x, 1u, __ATOMIC_RELAXED, __HIP_MEMORY_SCOPE_AGENT);
                               if (c < 512u) { id = x * 512 + (int)c; break; } ++qs; } }
                       id = __builtin_amdgcn_readfirstlane(id); qs = __builtin_amdgcn_readfirstlane(qs);
                       if (id < 0) break;
                       const int x = id >> 9, i = id & 511; nsa_item(F, args, lds, x >> 2, (x >> 1) & 1, 2 * (63 - (i >> 3)) + (x & 1), 7 - (i & 7)); } }
                 __syncthreads(); REFRESH_LANE(F);
                 for (int it = F.vcu; it < 256; it += F.G) lru_fix_item(F, args, lds, it, false); }
    SEAM(3);
    if (IN(4)) for (int rep_ = 0; rep_ <= ((DBL_MASK >> 4) & 1); ++rep_) { if (rep_) xcd_barrier(bar); REFRESH_LANE(F);
        pg8::Gemm g{(const bf16*)(ws + WS_Y), (const bf16*)(ws + WS_WOUT), MTOK, DM, DM}; pg8::StaticOrder S; S.init(MTOK, DM, F.G, (int)blockIdx.x);
        pg8::EpiRes<true> E{args.in[0], nullptr, nullptr, (bf16*)(ws + WS_XN), (float*)(ws + WS_SSQ1), (const float*)(ws + WS_SSQN)};
        pg8::gemm_phase<pg8::EpiRes<true>, pg8::StaticOrder, true, true>(lds, g, S, E, F.wave);
    }
    SEAM(4);
    if (IN(5)) for (int rep_ = 0; rep_ <= ((DBL_MASK >> 5) & 1); ++rep_) { if (rep_) xcd_barrier(bar); REFRESH_LANE(F);
        pg8::Gemm g{(const bf16*)(ws + WS_XN), (const bf16*)(ws + WS_WMQ), MTOK, DM, DM}; pg8::StaticOrder S; S.init(MTOK, DM, F.G, (int)blockIdx.x);
        pg8::EpiStore E{(bf16*)(ws + WS_QM), DM, (const float*)(ws + WS_SSQ1), 1};
        pg8::gemm_phase<pg8::EpiStore, pg8::StaticOrder, true, true>(lds, g, S, E, F.wave);
    }
    SEAM(5);
    if (IN(6)) for (int rep_ = 0; rep_ <= ((DBL_MASK >> 6) & 1); ++rep_) { if (rep_) xcd_barrier(bar); REFRESH_LANE(F); for (int it = F.gw; it < 2048; it += F.NGW) memattn_item(F, args, it); }
    SEAM(6);
    if (IN(7)) for (int rep_ = 0; rep_ <= ((DBL_MASK >> 7) & 1); ++rep_) { if (rep_) xcd_barrier(bar); REFRESH_LANE(F);
        pg8::Gemm g{(const bf16*)(ws + WS_OM), (const bf16*)(ws + WS_WMO), MTOK, DM, DM}; pg8::StaticOrder S; S.init(MTOK, DM, F.G, (int)blockIdx.x);
        pg8::EpiRes<false> E{nullptr, (const bf16*)(ws + WS_XN), nullptr, (bf16*)(ws + WS_XN), (float*)(ws + WS_SSQ2), nullptr};
        pg8::gemm_phase<pg8::EpiRes<false>, pg8::StaticOrder, true, true>(lds, g, S, E, F.wave);
    }
    SEAM(7);
    if (IN(8)) for (int rep_ = 0; rep_ <= ((DBL_MASK >> 8) & 1); ++rep_) { if (rep_) xcd_barrier(bar); REFRESH_LANE(F);
        pg8::Gemm g{(const bf16*)(ws + WS_XN), (const bf16*)(ws + WS_WPQ), MTOK, 2048, DM}; pg8::StaticOrder S; S.init(MTOK, 2048, F.G, (int)blockIdx.x);
        pg8::EpiStore E{(bf16*)(ws + WS_QP), 2048, (const float*)(ws + WS_SSQ2), 1};
        pg8::gemm_phase<pg8::EpiStore, pg8::StaticOrder, true, true>(lds, g, S, E, F.wave);
    }
    SEAM(8);
    if (IN(9)) for (int rep_ = 0; rep_ <= ((DBL_MASK >> 9) & 1); ++rep_) { if (rep_) xcd_barrier(bar); REFRESH_LANE(F); for (int gi = F.vcu; gi < 256; gi += F.G) {
                     const int h = gi & 7, tgp = gi >> 3;
                     { const v4u* src = (const v4u*)((const bf16*)(ws + WS_SKEY) + (size_t)h * 8 * 4096); const int tid = F.wave * 64 + lane_id();
#pragma unroll
                       for (int i = 0; i < 8; ++i) ((LAS v4u*)lds)[tid + 512 * i] = src[tid + 512 * i]; }
                     __syncthreads();
                     peer_topk_item<true>(F, args, (tgp * 16 + F.wave) * 8 + h, lds); peer_topk_item<true>(F, args, (tgp * 16 + 8 + F.wave) * 8 + h, lds);
                     __syncthreads(); } }
    SEAM(9);
    if (IN(10)) {   REFRESH_LANE(F);
        LAS int* bc = (LAS int*)(lds + LDS_BYTES - 128); unsigned* ctl = (unsigned*)(ws + WS_CTL); const int own = (int)(bar.x & 7u);
        { int qs = 0; for (;;) { const int id = __builtin_amdgcn_readfirstlane(pq_pop(ctl, 0, own, qs, bc, F.wave)); if (id < 0) break; peer_u_chunk(F, args, lds, id / PQ_NCHUNK, id % PQ_NCHUNK); } }
        xcd_barrier(bar);
        peer_w_rows(F, args);
        xcd_barrier(bar);
        { int qs = 0; for (;;) { const int id = __builtin_amdgcn_readfirstlane(pq_pop(ctl, 1, own, qs, bc, F.wave)); if (id < 0) break; peer_v_chunk(F, args, lds, id / PQ_NCHUNK, id % PQ_NCHUNK); } }
        xcd_barrier(bar);
        peer_final_rows(F, args);
    }
#undef IN
#undef SEAM
}

extern "C" void kernel_launch(void* const* d_in, const int* in_sizes, int n_in, void* d_out, int out_size, void* d_ws, size_t ws_size, hipStream_t stream) {
    static int grid = 0;
    if (grid == 0) {
        if (n_in != 33 || out_size != MTOK * DM || ws_size < WS_END) { fprintf(stderr, "kernel_launch: unexpected problem (n_in %d, out %d, ws %zu)\n", n_in, out_size, ws_size); grid = -1; return; }
        int dev = 0, cus = 0, per_cu = 0;
        (void)hipGetDevice(&dev); (void)hipDeviceGetAttribute(&cus, hipDeviceAttributeMultiprocessorCount, dev);
        (void)hipFuncSetAttribute((const void*)fwd_kernel, hipFuncAttributeMaxDynamicSharedMemorySize, LDS_BYTES);
        (void)hipOccupancyMaxActiveBlocksPerMultiprocessor(&per_cu, (const void*)fwd_kernel, 512, LDS_BYTES);
        if (per_cu < 1) { fprintf(stderr, "kernel_launch: occupancy query says %d blocks per CU\n", per_cu); per_cu = 1; }
        grid = cus * 1;
        if (grid != 256) fprintf(stderr, "kernel_launch: %d CUs (built for 256)\n", cus);
    }
    if (grid < 0) return;
    (void)hipMemsetAsync((char*)d_ws + WS_CTL, 0, 65536, stream);
    Args a{};
    for (int i = 0; i < 33; ++i) a.in[i] = (const float*)d_in[i];
    a.out = (float*)d_out; a.ws = (unsigned char*)d_ws; a.ph_lo = 0; a.ph_hi = NPHASE;
    void* kargs[] = {&a};
    hipError_t e = hipLaunchCooperativeKernel((const void*)fwd_kernel, dim3(grid), dim3(512), kargs, LDS_BYTES, stream);
    if (e != hipSuccess) fprintf(stderr, "cooperative launch failed: %s (grid %d)\n", hipGetErrorString(e), grid);
}
```

```cpp
#include <hip/hip_runtime.h>
#include <cstdio>
#include <cstdint>

namespace pg8 {
#define PG8_LAS __attribute__((address_space(3)))
typedef unsigned short bf16_t;
typedef short bf16x8 __attribute__((ext_vector_type(8)));
typedef float f32x4 __attribute__((ext_vector_type(4)));
typedef unsigned u32x4 __attribute__((ext_vector_type(4)));
constexpr int BM = 256, BK = 64, HALF = 128, HTB = HALF * BK * 2  , STAGE_BYTES = 8 * HTB, NXCD = 8, WGM = 8;

__host__ __device__ __forceinline__ int lds_byte(int r, int c) { const int st = (r >> 4) * 2 + (c >> 5), rr = r & 15, cc = c & 31, ob = rr * 64 + cc * 2; return st * 1024 + (ob ^ (((ob >> 9) & 1) << 5)); }
__host__ __device__ __forceinline__ void stage_rc(int b, int& R, int& C) { const int st = b / 1024, sb = b % 1024, swz = sb ^ (((sb >> 9) & 1) << 5); R = (st >> 1) * 16 + swz / 64; C = (st & 1) * 32 + (swz % 64) / 2; }
__host__ __device__ __forceinline__ int perm32(int rho) { const int n = rho >> 4, i = rho & 15; return 8 * (i >> 2) + 4 * n + (i & 3); }

struct Unit { int pm, pn; };
struct Gemm { const bf16_t* A; const bf16_t* Bt; int M, N, K; };

struct StaticOrder {
    int nM, nN, nwg, G, c;
    __host__ __device__ void init(int M, int N, int G_, int c_) { nM = M / BM; nN = N / BM; nwg = nM * nN; G = G_; c = c_; }
    __host__ __device__ bool next(int i, Unit& u) const {
        const long L = (long)i * G + c; if (L >= nwg) return false;
        int wgid = (int)L; { const int q = nwg / NXCD, r = nwg % NXCD, xcd = wgid % NXCD, off = wgid / NXCD; wgid = (xcd < r ? xcd * (q + 1) : r * (q + 1) + (xcd - r) * q) + off; }
        const int nig = WGM * nN, gid = wgid / nig, fm = gid * WGM, gsz = (nM - fm) < WGM ? (nM - fm) : WGM;
        u.pm = fm + ((wgid % nig) % gsz); u.pn = (wgid % nig) / gsz; return true;
    }
    __device__ __forceinline__ void a_ready(const Unit&) const {}
    __device__ __forceinline__ void done(const Unit&) const {}
};

__device__ __forceinline__ unsigned cvt_pk_bf16(float lo, float hi) { unsigned r; asm volatile("v_cvt_pk_bf16_f32 %0, %1, %2" : "=v"(r) : "v"(lo), "v"(hi)); return r; }
typedef float f32x2 __attribute__((ext_vector_type(2)));
typedef unsigned u32x2 __attribute__((ext_vector_type(2)));
__device__ __forceinline__ unsigned short f2bf1(float f) { unsigned u = __builtin_bit_cast(unsigned, f); return (unsigned short)((u + 0x7fffu + ((u >> 16) & 1u)) >> 16); }
struct EpiZ {
    static constexpr bool PERM = true, AFTER_DRAIN = false, MIDSCALE = false;
    bf16_t* Z; bf16_t* KSF; bf16_t* VSF; bf16_t* KWF; bf16_t* VWF; float* GATES; const float* bgate;
    __device__ __forceinline__ void operator()(const f32x4 (&acc)[2][2][4][2], const Unit& u, int wr, int wc, int fr, int fq) const {
        const int row0 = u.pm * BM + wr * 64 + fr;
        if (u.pn < 9) {
            const int col0 = u.pn * BM + wc * 32 + 8 * fq;
#pragma unroll
            for (int ai = 0; ai < 2; ++ai)
#pragma unroll
                for (int m = 0; m < 4; ++m) { bf16_t* rowp = Z + (size_t)(row0 + ai * HALF + m * 16) * 2304 + col0;
#pragma unroll
                    for (int bj = 0; bj < 2; ++bj) { const f32x4 v0 = acc[ai][bj][m][0], v1 = acc[ai][bj][m][1];
                        u32x4 w; w.x = cvt_pk_bf16(v0[0], v0[1]); w.y = cvt_pk_bf16(v0[2], v0[3]); w.z = cvt_pk_bf16(v1[0], v1[1]); w.w = cvt_pk_bf16(v1[2], v1[3]);
                        *(u32x4*)(rowp + bj * HALF) = w; } }
            if (u.pn >= 7) {
                bf16_t* KF = (u.pn == 7) ? KSF : KWF; bf16_t* VF = (u.pn == 7) ? VSF : VWF;
                const int kvh = wc >> 1, dbase = 32 * (wc & 1) + 8 * fq;
#pragma unroll
                for (int ai = 0; ai < 2; ++ai)
#pragma unroll
                    for (int m = 0; m < 4; ++m) { const int row = row0 + ai * HALF + m * 16, b = row >> 13, s = row & 8191, tile = s >> 5, k = s & 31;
                        const size_t tb = ((size_t)(b * 2 + kvh) * 256 + tile) * 2048;
                        { const f32x4 v0 = acc[ai][0][m][0], v1 = acc[ai][0][m][1];
                          u32x4 w; w.x = cvt_pk_bf16(v0[0], v0[1]); w.y = cvt_pk_bf16(v0[2], v0[3]); w.z = cvt_pk_bf16(v1[0], v1[1]); w.w = cvt_pk_bf16(v1[2], v1[3]);
                          *(u32x4*)(KF + tb + (dbase >> 4) * 512 + ((dbase >> 3) & 1) * 256 + k * 8) = w; }
                        const int kk = k & 15, vo = ((kk >> 2) & 1) * 512 + (k >> 4) * 8 + (kk & 3) + 4 * (kk >> 3);
                        unsigned char* V8 = (unsigned char*)VF + ((size_t)(b * 2 + kvh) * 256 + tile) * 2048;
#pragma unroll
                        for (int n = 0; n < 2; ++n) { const f32x4 v = acc[ai][1][m][n]; int w = 0; w = __builtin_amdgcn_cvt_pk_fp8_f32(v[0], v[1], w, false); w = __builtin_amdgcn_cvt_pk_fp8_f32(v[2], v[3], w, true);
#pragma unroll
                            for (int e = 0; e < 4; ++e) { const int d = dbase + 4 * n + e; V8[(d >> 5) * 1024 + (d & 31) * 16 + vo] = (unsigned char)((unsigned)w >> (8 * e)); } }
                        asm volatile("" ::: "memory"); }
            }
        } else {
            if (wc == 0 && fq < 3) {
#pragma unroll
                for (int ai = 0; ai < 2; ++ai)
#pragma unroll
                    for (int m = 0; m < 4; ++m) { const int row = row0 + ai * HALF + m * 16;
#pragma unroll
                        for (int n = 0; n < 2; ++n)
#pragma unroll
                            for (int e = 0; e < 4; ++e) { const int c = 8 * fq + 4 * n + e; const float v = acc[ai][0][m][n][e] + bgate[c]; GATES[(size_t)row * 24 + c] = 1.0f / (1.0f + __expf(-v)); } }
            }
        }
    }
};
struct EpiStore {
    static constexpr bool PERM = true, AFTER_DRAIN = false, MIDSCALE = false;
    bf16_t* O; int ldc; const float* ssq; int frag;
    __device__ __forceinline__ void operator()(const f32x4 (&acc)[2][2][4][2], const Unit& u, int wr, int wc, int fr, int fq) const {
        const int row0 = u.pm * BM + wr * 64 + fr; const int col0 = u.pn * BM + wc * 32 + 8 * fq;
#pragma unroll
        for (int ai = 0; ai < 2; ++ai)
#pragma unroll
            for (int m = 0; m < 4; ++m) { const int row = row0 + ai * HALF + m * 16;
                bf16_t* rowp = frag ? O + (size_t)(row >> 5) * 32 * ldc + (size_t)(col0 >> 4) * 512 + ((col0 >> 3) & 1) * 256 + (row & 31) * 8 : O + (size_t)row * ldc + col0;
                const int bjstep = frag ? (HALF >> 4) * 512 : HALF;
                float sc = 1.f;
                if (ssq) { const f32x4* p = (const f32x4*)(ssq + (size_t)row * 16); const f32x4 a = p[0], b = p[1], c = p[2], d = p[3];
                    const float s = ((a[0] + a[1]) + (a[2] + a[3])) + ((b[0] + b[1]) + (b[2] + b[3])) + ((c[0] + c[1]) + (c[2] + c[3])) + ((d[0] + d[1]) + (d[2] + d[3]));
                    sc = rsqrtf(s * (1.0f / 1024.0f) + 1e-6f); }
#pragma unroll
                for (int bj = 0; bj < 2; ++bj) { const f32x4 v0 = acc[ai][bj][m][0] * sc, v1 = acc[ai][bj][m][1] * sc;
                    u32x4 w; w.x = cvt_pk_bf16(v0[0], v0[1]); w.y = cvt_pk_bf16(v0[2], v0[3]); w.z = cvt_pk_bf16(v1[0], v1[1]); w.w = cvt_pk_bf16(v1[2], v1[3]);
                    *(u32x4*)(rowp + bj * bjstep) = w; } }
    }
};
struct EpiVFrag {
    static constexpr bool PERM = true, AFTER_DRAIN = false, MIDSCALE = false;
    bf16_t* O;
    __device__ __forceinline__ void operator()(const f32x4 (&acc)[2][2][4][2], const Unit& u, int wr, int wc, int fr, int fq) const {
        const int row0 = u.pm * BM + wr * 64 + fr; const int col0 = u.pn * BM + wc * 32 + 8 * fq;
#pragma unroll
        for (int ai = 0; ai < 2; ++ai)
#pragma unroll
            for (int m = 0; m < 4; ++m) { const int D = row0 + ai * HALF + m * 16, h = D >> 8, dt = (D >> 5) & 7, r = D & 31;
#pragma unroll
                for (int bj = 0; bj < 2; ++bj) { const int K0 = col0 + bj * HALF, b = K0 >> 8, kt = (K0 >> 5) & 7, k0 = K0 & 31;
                    bf16_t* p = O + (size_t)((b * 4 + h) * 8 + kt) * 8192 + dt * 1024 + (k0 >> 4) * 512 + r * 8 + 4 * ((k0 >> 3) & 1);
                    const f32x4 v0 = acc[ai][bj][m][0], v1 = acc[ai][bj][m][1];
                    u32x2 w0, w1; w0.x = cvt_pk_bf16(v0[0], v0[1]); w0.y = cvt_pk_bf16(v0[2], v0[3]); w1.x = cvt_pk_bf16(v1[0], v1[1]); w1.y = cvt_pk_bf16(v1[2], v1[3]);
                    *(u32x2*)p = w0; *(u32x2*)(p + 256) = w1; } }
    }
};
template <bool MID> struct EpiRes {
    static constexpr bool PERM = false, AFTER_DRAIN = false, MIDSCALE = MID;
    const float* base; const bf16_t* base16; float* out; bf16_t* XB; float* ssq; const float* ssqn;
    __device__ __forceinline__ void midscale(f32x4 (&acc)[2][2][4][2], const Unit& u, int wr, int wc, int fr, int fq) const {
        const int row0 = u.pm * BM + wr * 64 + fr;
#pragma unroll
        for (int ai = 0; ai < 2; ++ai)
#pragma unroll
            for (int m = 0; m < 4; ++m) { const int row = row0 + ai * HALF + m * 16; const f32x2 sq = *(const f32x2*)(ssqn + (size_t)row * 2);
                const float sc = rsqrtf((sq[0] + sq[1]) * (1.0f / 512.0f) + 1e-6f);
#pragma unroll
                for (int bj = 0; bj < 2; ++bj)
#pragma unroll
                    for (int n = 0; n < 2; ++n) acc[ai][bj][m][n] = acc[ai][bj][m][n] * sc; }
    }
    __device__ __forceinline__ void operator()(const f32x4 (&acc)[2][2][4][2], const Unit& u, int wr, int wc, int fr, int fq) const {
        const int row0 = u.pm * BM + wr * 64 + fr; const int col0 = u.pn * BM + wc * 32 + 4 * fq;
#pragma unroll
        for (int ai = 0; ai < 2; ++ai)
#pragma unroll
            for (int m = 0; m < 4; ++m) { const int row = row0 + ai * HALF + m * 16; const size_t off = (size_t)row * 1024 + col0; float s = 0.f;
#pragma unroll
                for (int bj = 0; bj < 2; ++bj)
#pragma unroll
                    for (int n = 0; n < 2; ++n) { f32x4 b;
                        if (base) b = *(const f32x4*)(base + off + bj * HALF + n * 16);
                        else { const u32x2 w = *(const u32x2*)(base16 + off + bj * HALF + n * 16); b[0] = __builtin_bit_cast(float, w.x << 16); b[1] = __builtin_bit_cast(float, w.x & 0xffff0000u); b[2] = __builtin_bit_cast(float, w.y << 16); b[3] = __builtin_bit_cast(float, w.y & 0xffff0000u); }
                        const f32x4 v = b + acc[ai][bj][m][n];
                        if (out) *(f32x4*)(out + off + bj * HALF + n * 16) = v;
                        s += (v[0] * v[0] + v[1] * v[1]) + (v[2] * v[2] + v[3] * v[3]);
                        u32x2 w; w.x = cvt_pk_bf16(v[0], v[1]); w.y = cvt_pk_bf16(v[2], v[3]); *(u32x2*)(XB + off + bj * HALF + n * 16) = w; }
                s += __shfl_xor(s, 16); s += __shfl_xor(s, 32);
                if (fq == 0) ssq[(size_t)row * 16 + u.pn * 4 + wc] = s;
                asm volatile("" ::: "memory"); }
    }
};
template <class Epi, class Sched, bool ALIGN_EPI = false, bool SP2 = false>
__device__ __forceinline__ void gemm_phase(PG8_LAS unsigned char* lds, const Gemm g, const Sched& S, const Epi& E, int wave  ) {
    int lane; asm volatile("v_mbcnt_lo_u32_b32 %0, -1, 0\n\tv_mbcnt_hi_u32_b32 %0, -1, %0" : "=v"(lane));
    const int wid = wave, tid = wid * 64 + lane, wr = wid >> 2, wc = wid & 3, fr = lane & 15, fq = lane >> 4;
    const int K = g.K, nt = K / BK;
    unsigned voffA[2], voffB[2];
#pragma unroll
    for (int i = 0; i < 2; ++i) { int R, C; stage_rc(tid * 16 + i * 8192, R, C); const int Rb = Epi::PERM ? ((R & ~31) + perm32(R & 31)) : R;
        voffA[i] = (unsigned)(R * K + C) * 2u; voffB[i] = (unsigned)(Rb * K + C) * 2u; }
    const size_t kstep = (size_t)(BK * 2);
    const size_t hstep = (size_t)HALF * K * 2;
    const size_t tstep = 2 * hstep;
    const unsigned ldsw = (unsigned)wid * 1024u;
    const int aoff = lds_byte(wr * 64 + fr, fq * 8), boff = lds_byte(wc * 32 + fr, fq * 8);
#define PG8_SA(b, h) (((b) * 2 + (h)) * HTB)
#define PG8_SB(b, h) ((4 + (b) * 2 + (h)) * HTB)
#define PG8_STAGE(bufoff, gbase, voff) do { _Pragma("unroll") for (int _i = 0; _i < 2; ++_i) \
        __builtin_amdgcn_global_load_lds((const unsigned*)((const char*)(gbase) + (voff)[_i]), (PG8_LAS unsigned*)(lds + (bufoff) + ldsw + _i * 8192), 16, 0, 0); } while (0)
#define PG8_LDA(dst, b, h) do { _Pragma("unroll") for (int m = 0; m < 4; ++m) _Pragma("unroll") for (int k = 0; k < 2; ++k) dst[m][k] = *(const PG8_LAS bf16x8*)(lds + PG8_SA(b, h) + aoff + m * 2048 + k * 1024); } while (0)
#define PG8_LDB(dst, b, h) do { _Pragma("unroll") for (int n = 0; n < 2; ++n) _Pragma("unroll") for (int k = 0; k < 2; ++k) dst[n][k] = *(const PG8_LAS bf16x8*)(lds + PG8_SB(b, h) + boff + n * 2048 + k * 1024); } while (0)
#define PG8_MMA(ai, bj, At, Bt) do { __builtin_amdgcn_s_setprio(1); _Pragma("unroll") for (int m = 0; m < 4; ++m) _Pragma("unroll") for (int n = 0; n < 2; ++n) _Pragma("unroll") for (int k = 0; k < 2; ++k) \
        acc[ai][bj][m][n] = __builtin_amdgcn_mfma_f32_16x16x32_bf16(Bt[n][k], At[m][k], acc[ai][bj][m][n], 0, 0, 0); __builtin_amdgcn_s_setprio(0); } while (0)
#define PG8_WAIT_V(n) asm volatile("s_waitcnt vmcnt(" #n ")" ::: "memory")
#define PG8_WAIT_L(n) asm volatile("s_waitcnt lgkmcnt(" #n ")" ::: "memory")
#define PG8_BAR __builtin_amdgcn_s_barrier()
#define PG8_SCHED __builtin_amdgcn_sched_barrier(0)
    Unit cur, nxt; int ui = 0;
    if (!S.next(0, cur)) return;
    f32x4 acc[2][2][4][2];
#pragma unroll
    for (int a = 0; a < 2; ++a)
#pragma unroll
        for (int b = 0; b < 2; ++b)
#pragma unroll
            for (int m = 0; m < 4; ++m)
#pragma unroll
                for (int n = 0; n < 2; ++n) acc[a][b][m][n] = (f32x4){0.f, 0.f, 0.f, 0.f};
    bf16x8 At[4][2], B0[2][2], B1[2][2];
    const char* cA = (const char*)g.A + (size_t)cur.pm * tstep; const char* cB = (const char*)g.Bt + (size_t)cur.pn * tstep;
    S.a_ready(cur);
    if constexpr (SP2) {
        PG8_STAGE(PG8_SB(0, 0), cB, voffB); PG8_STAGE(PG8_SB(0, 1), cB + hstep, voffB); PG8_STAGE(PG8_SA(0, 0), cA, voffA); PG8_STAGE(PG8_SA(0, 1), cA + hstep, voffA);
        if (wr == 1) PG8_BAR;
        PG8_WAIT_V(2); PG8_BAR;
        PG8_STAGE(PG8_SB(1, 0), cB + kstep, voffB); PG8_STAGE(PG8_SA(1, 0), cA + kstep, voffA); PG8_STAGE(PG8_SB(1, 1), cB + hstep + kstep, voffB);
        PG8_WAIT_V(6); PG8_BAR;
    } else {
        PG8_STAGE(PG8_SB(0, 0), cB, voffB); PG8_STAGE(PG8_SA(0, 0), cA, voffA); PG8_STAGE(PG8_SB(0, 1), cB + hstep, voffB); PG8_STAGE(PG8_SA(0, 1), cA + hstep, voffA);
        if (wr == 1) PG8_BAR;
        PG8_WAIT_V(4); PG8_BAR;
        PG8_STAGE(PG8_SB(1, 0), cB + kstep, voffB); PG8_STAGE(PG8_SA(1, 0), cA + kstep, voffA); PG8_STAGE(PG8_SB(1, 1), cB + hstep + kstep, voffB);
        PG8_WAIT_V(6); PG8_BAR;
    }
    for (;;) {
        const bool has_next = S.next(ui + 1, nxt);
        const char* nA = has_next ? (const char*)g.A + (size_t)nxt.pm * tstep : cA; const char* nB = has_next ? (const char*)g.Bt + (size_t)nxt.pn * tstep : cB;
        for (int t = 0; t < nt; t += 2) {
            if constexpr (Epi::MIDSCALE) { if (t == nt / 2) E.midscale(acc, cur, wr, wc, fr, fq); }
            const bool last = (t == nt - 2);
            const char* a1 = cA + (size_t)(t + 1) * kstep;
            const char* a2 = last ? nA : cA + (size_t)(t + 2) * kstep; const char* b2 = last ? nB : cB + (size_t)(t + 2) * kstep;
            const char* a3 = a2 + kstep; const char* b3 = b2 + kstep;
            if (last && has_next) S.a_ready(nxt);
            if constexpr (SP2) {
            PG8_LDB(B0, 0, 0); PG8_LDB(B1, 0, 1); PG8_SCHED; PG8_LDA(At, 0, 0); PG8_STAGE(PG8_SA(1, 1), a1 + hstep, voffA);
            PG8_WAIT_V(8); PG8_WAIT_L(0); PG8_BAR; PG8_MMA(0, 0, At, B0); PG8_MMA(0, 1, At, B1); PG8_BAR; PG8_SCHED;
            PG8_LDA(At, 0, 1); PG8_STAGE(PG8_SB(0, 0), b2, voffB); PG8_STAGE(PG8_SB(0, 1), b2 + hstep, voffB); PG8_STAGE(PG8_SA(0, 0), a2, voffA);
            PG8_WAIT_V(8); PG8_WAIT_L(0); PG8_BAR; PG8_MMA(1, 0, At, B0); PG8_MMA(1, 1, At, B1); PG8_BAR; PG8_SCHED;
            PG8_LDB(B0, 1, 0); PG8_LDB(B1, 1, 1); PG8_SCHED; PG8_LDA(At, 1, 0); PG8_STAGE(PG8_SA(0, 1), a2 + hstep, voffA);
            PG8_WAIT_V(8); PG8_WAIT_L(0); PG8_BAR; PG8_MMA(0, 0, At, B0); PG8_MMA(0, 1, At, B1); PG8_BAR; PG8_SCHED;
            PG8_LDA(At, 1, 1); PG8_STAGE(PG8_SB(1, 0), b3, voffB); PG8_STAGE(PG8_SB(1, 1), b3 + hstep, voffB); PG8_STAGE(PG8_SA(1, 0), a3, voffA);
            PG8_WAIT_V(8); PG8_WAIT_L(0); PG8_BAR; PG8_MMA(1, 0, At, B0); PG8_MMA(1, 1, At, B1); PG8_BAR; PG8_SCHED;
            } else {
            PG8_LDB(B0, 0, 0); PG8_SCHED; PG8_LDA(At, 0, 0); PG8_STAGE(PG8_SA(1, 1), a1 + hstep, voffA);
            PG8_WAIT_L(8); PG8_BAR; PG8_WAIT_L(0); PG8_MMA(0, 0, At, B0); PG8_BAR; PG8_SCHED;
            PG8_LDB(B1, 0, 1); PG8_STAGE(PG8_SB(0, 0), b2, voffB);
            PG8_BAR; PG8_WAIT_L(0); PG8_MMA(0, 1, At, B1); PG8_BAR;
            PG8_LDA(At, 0, 1); PG8_STAGE(PG8_SA(0, 0), a2, voffA);
            PG8_BAR; PG8_WAIT_L(0); PG8_MMA(1, 0, At, B0); PG8_BAR; PG8_SCHED;
            PG8_STAGE(PG8_SB(0, 1), b2 + hstep, voffB);
            PG8_WAIT_V(6); PG8_BAR; PG8_MMA(1, 1, At, B1); PG8_BAR;
            PG8_LDB(B0, 1, 0); PG8_SCHED; PG8_LDA(At, 1, 0); PG8_STAGE(PG8_SA(0, 1), a2 + hstep, voffA);
            PG8_WAIT_L(8); PG8_BAR; PG8_WAIT_L(0); PG8_MMA(0, 0, At, B0); PG8_BAR; PG8_SCHED;
            PG8_LDB(B1, 1, 1); PG8_STAGE(PG8_SB(1, 0), b3, voffB);
            PG8_BAR; PG8_WAIT_L(0); PG8_MMA(0, 1, At, B1); PG8_BAR;
            PG8_LDA(At, 1, 1); PG8_STAGE(PG8_SA(1, 0), a3, voffA);
            PG8_BAR; PG8_WAIT_L(0); PG8_MMA(1, 0, At, B0); PG8_BAR; PG8_SCHED;
            PG8_STAGE(PG8_SB(1, 1), b3 + hstep, voffB);
            PG8_WAIT_V(6); PG8_BAR; PG8_MMA(1, 1, At, B1); PG8_BAR;
            }
        }
        if constexpr (ALIGN_EPI) { if (wr == 0) PG8_BAR; }
        if constexpr (!Epi::AFTER_DRAIN) { E(acc, cur, wr, wc, fr, fq); S.done(cur); }
        if (!has_next) break;
#pragma unroll
        for (int a = 0; a < 2; ++a)
#pragma unroll
            for (int b = 0; b < 2; ++b)
#pragma unroll
                for (int m = 0; m < 4; ++m)
#pragma unroll
                    for (int n = 0; n < 2; ++n) acc[a][b][m][n] = (f32x4){0.f, 0.f, 0.f, 0.f};
        cur = nxt; cA = nA; cB = nB; ++ui;
        if constexpr (ALIGN_EPI) { if (wr == 1) PG8_BAR; }
    }
    PG8_WAIT_V(0);
    if constexpr (!ALIGN_EPI) { if (wr == 0) PG8_BAR; }
    PG8_BAR;
    if constexpr (Epi::AFTER_DRAIN) { E.fused(acc, cur, wr, wc, fr, fq, lds, wid, lane); S.done(cur); }
#undef PG8_SA
#undef PG8_SB
#undef PG8_STAGE
#undef PG8_LDA
#undef PG8_LDB
#undef PG8_MMA
#undef PG8_WAIT_V
#undef PG8_WAIT_L
#undef PG8_BAR
#undef PG8_SCHED
}
}

constexpr int NB = 2, SEQ = 8192, DM = 1024, MTOK = NB * SEQ;
constexpr int NZ = 2304, NZP = 2560;
constexpr int NMEM = 256;
constexpr float EPS = 1e-6f;
constexpr float QSCALE = 0.125f * 1.4426950408889634f;
constexpr int ZC_XL = 0, ZC_GT = 512, ZC_Q = 1024, ZC_KC = 1536, ZC_VC = 1664, ZC_KS = 1792, ZC_VS = 1920, ZC_KW = 2048, ZC_VW = 2176, ZC_G = 2304;

constexpr size_t MiB = 1u << 20;
constexpr size_t WS_CTL = 0;
constexpr size_t WS_WIN = 1 * MiB, WS_WOUT = 6 * MiB, WS_WMQ = 8 * MiB, WS_WMK = 10 * MiB, WS_WMV = 12 * MiB, WS_WMO = 14 * MiB, WS_WPQ = 16 * MiB;
constexpr size_t WS_SKEY = 20 * MiB;
constexpr size_t WS_CW1T = WS_SKEY + 512 * 1024;
constexpr size_t WS_CW2T = WS_CW1T + 512 * 1024;
constexpr size_t WS_C1 = WS_CW2T + 16 * 1024;
constexpr size_t WS_WRGT = WS_C1 + 16 * 1024;
constexpr size_t WS_MEMN = 22 * MiB, WS_MEMK = 23 * MiB, WS_MEMVT = 24 * MiB;
constexpr size_t WS_KC = 26 * MiB;
constexpr size_t WS_VCT = WS_KC + 256 * 1024;
constexpr size_t WS_SUMM = 27 * MiB;
constexpr size_t WS_SSQ1 = 28 * MiB, WS_SSQ2 = 29 * MiB;
constexpr size_t WS_GATES = 30 * MiB;
constexpr size_t WS_SSQN = 31 * MiB + 512 * 1024;
constexpr size_t WS_U8 = 32 * MiB, WS_V8 = 48 * MiB;
constexpr size_t WS_SU = 64 * MiB, WS_SV = 64 * MiB + 65536;
constexpr size_t WS_SSQ3 = 65 * MiB;
constexpr size_t WS_W = 66 * MiB;
constexpr size_t WS_PART = 128 * MiB;
constexpr size_t WS_XN = 96 * MiB;
constexpr size_t WS_Z = 128 * MiB;
constexpr size_t WS_KSF = 240 * MiB, WS_VSF = 244 * MiB, WS_KWF = 248 * MiB, WS_VWF = 252 * MiB;
constexpr size_t WS_QM = 128 * MiB, WS_OM = 160 * MiB;
constexpr size_t WS_QP = 128 * MiB;
constexpr size_t WS_Y = 208 * MiB;
constexpr size_t WS_EID = 208 * MiB, WS_GW = 216 * MiB;
constexpr size_t WS_END = 256 * MiB;

constexpr int CW_KMAX = 12288;
constexpr int LDS_BYTES = 147456;

#define GAS __attribute__((address_space(1)))
#define LAS __attribute__((address_space(3)))
typedef unsigned short bf16;
typedef unsigned v4u __attribute__((ext_vector_type(4)));
typedef unsigned v2u __attribute__((ext_vector_type(2)));
typedef float f32x4 __attribute__((ext_vector_type(4)));
typedef float f32x16 __attribute__((ext_vector_type(16)));
typedef short bf16x8 __attribute__((ext_vector_type(8)));
typedef short bf16x4 __attribute__((ext_vector_type(4)));
__device__ __forceinline__ unsigned f2bf(float f) { unsigned u = __builtin_bit_cast(unsigned, f); return (u + 0x7fffu + ((u >> 16) & 1u)) >> 16; }
typedef float f32x2_ __attribute__((ext_vector_type(2))); typedef __bf16 bf16x2_ __attribute__((ext_vector_type(2)));
__device__ __forceinline__ unsigned pk2(float lo, float hi) { f32x2_ v = {lo, hi}; bf16x2_ b = __builtin_convertvector(v, bf16x2_); return __builtin_bit_cast(unsigned, b); }
__device__ __forceinline__ float bf2f(unsigned short h) { return __builtin_bit_cast(float, (unsigned)h << 16); }
__device__ __forceinline__ float bflo(unsigned w) { return __builtin_bit_cast(float, w << 16); }
__device__ __forceinline__ float bfhi(unsigned w) { return __builtin_bit_cast(float, w & 0xffff0000u); }
__device__ __forceinline__ void swap32(unsigned& a, unsigned& b) { asm("s_nop 1\n\tv_permlane32_swap_b32 %0, %1" : "+v"(a), "+v"(b)); }
__device__ __forceinline__ int maxswap32_i(int v) { unsigned a = (unsigned)v, b = (unsigned)v; swap32(a, b); return max((int)a, (int)b); }
__device__ __forceinline__ float maxswap32_f(float v) { unsigned a = __builtin_bit_cast(unsigned, v), b = a; swap32(a, b); return fmaxf(__builtin_bit_cast(float, a), __builtin_bit_cast(float, b)); }
__device__ __forceinline__ float addswap32_f(float v) { unsigned a = __builtin_bit_cast(unsigned, v), b = a; swap32(a, b); return __builtin_bit_cast(float, a) + __builtin_bit_cast(float, b); }
__device__ __forceinline__ float wave_sum(float v) {
#pragma unroll
    for (int o = 1; o < 64; o <<= 1) v += __shfl_xor(v, o);
    return v;
}

struct Args { const float* in[33]; float* out; unsigned char* ws; int ph_lo, ph_hi; };

struct Frame {
    int tid, lane, wave, vcu, G, gw, NGW;
};
__device__ __forceinline__ int lane_id() { int l; asm volatile("v_mbcnt_lo_u32_b32 %0, -1, 0\n\tv_mbcnt_hi_u32_b32 %0, -1, %0" : "=v"(l)); return l; }
#define REFRESH_LANE(F) do { (F).lane = lane_id(); (F).tid = (F).wave * 64 + (F).lane; } while (0)

__device__ __forceinline__ void transpose_item(const float* W, int K, int N, bf16* WT, int ldt, int row_off, const float* gain, int slo, int shi, float cs, LAS float* scr, int item, int lane, int kxor = 0) {
    const int nblk = (N + 31) / 32, kb = item / nblk, nb = item % nblk, k0 = 64 * kb, n0 = 32 * nb;
#pragma unroll 16
    for (int i = 0; i < 32; ++i) { const int kk = 2 * i + (lane >> 5), n = n0 + (lane & 31);
        float v = (n < N) ? __builtin_nontemporal_load(W + (size_t)(k0 + kk) * N + n) : 0.f; if (gain) v *= gain[k0 + kk]; if (n >= slo && n < shi) v *= cs;
        scr[kk * 33 + (lane & 31)] = v; }
    asm volatile("s_waitcnt lgkmcnt(0)" ::: "memory");
    const int c = lane & 7;
#pragma unroll
    for (int j = 0; j < 4; ++j) { const int n = (lane >> 3) + 8 * j; const LAS float* s = scr + (8 * c) * 33 + n;
        v4u o; o.x = pk2(s[0 * 33], s[1 * 33]); o.y = pk2(s[2 * 33], s[3 * 33]); o.z = pk2(s[4 * 33], s[5 * 33]); o.w = pk2(s[6 * 33], s[7 * 33]);
        *(v4u*)(WT + (size_t)(row_off + n0 + n) * ldt + (k0 ^ kxor) + 8 * c) = o; }
    asm volatile("s_waitcnt lgkmcnt(0)" ::: "memory");
}
__device__ __forceinline__ void rms_row_to_bf16(const float* xrow, bf16* orow, int lane) {
    const f32x4* xr = (const f32x4*)xrow + lane;
    f32x4 v[4]; float s = 0.f;
#pragma unroll
    for (int j = 0; j < 4; ++j) { v[j] = xr[64 * j]; s += (v[j].x * v[j].x + v[j].y * v[j].y) + (v[j].z * v[j].z + v[j].w * v[j].w); }
    const float rstd = rsqrtf(wave_sum(s) * (1.f / DM) + EPS);
    unsigned long long* o8 = (unsigned long long*)orow + lane;
#pragma unroll
    for (int j = 0; j < 4; ++j) o8[64 * j] = (unsigned long long)pk2(v[j].x * rstd, v[j].y * rstd) | ((unsigned long long)pk2(v[j].z * rstd, v[j].w * rstd) << 32);
}
__device__ __forceinline__ void quant_row_fp8(const float* src, const float* gain, unsigned char* dst, float* scale_out, int lane) {
    const f32x4* p = (const f32x4*)src + 4 * lane; f32x4 v[4]; float am = 0.f;
#pragma unroll
    for (int j = 0; j < 4; ++j) { v[j] = p[j]; if (gain) v[j] = v[j] * ((const f32x4*)gain)[4 * lane + j]; am = fmaxf(am, fmaxf(fmaxf(fabsf(v[j].x), fabsf(v[j].y)), fmaxf(fabsf(v[j].z), fabsf(v[j].w)))); }
#pragma unroll
    for (int o = 1; o < 64; o <<= 1) am = fmaxf(am, __shfl_xor(am, o));
    const float inv = am > 0.f ? 448.0f / am : 0.f;
    v4u o4;
#pragma unroll
    for (int j = 0; j < 4; ++j) { int w = 0; w = __builtin_amdgcn_cvt_pk_fp8_f32(v[j].x * inv, v[j].y * inv, w, false); w = __builtin_amdgcn_cvt_pk_fp8_f32(v[j].z * inv, v[j].w * inv, w, true); o4[j] = (unsigned)w; }
    *(v4u*)(dst + (size_t)(lane >> 3) * 16384 * 128 + (lane & 7) * 16) = o4;
    if (lane == 0) *scale_out = am * (1.0f / 448.0f);
}
__device__ __forceinline__ void rms_rows4_to_bf16(const float* x0, bf16* o0, size_t rstride  , int lane) {
    f32x4 v[4][4]; float s[4];
#pragma unroll
    for (int r = 0; r < 4; ++r)
#pragma unroll
        for (int j = 0; j < 4; ++j) v[r][j] = __builtin_nontemporal_load((const f32x4*)(x0 + r * rstride) + lane + 64 * j);
#pragma unroll
    for (int r = 0; r < 4; ++r) { s[r] = 0.f;
#pragma unroll
        for (int j = 0; j < 4; ++j) s[r] += (v[r][j].x * v[r][j].x + v[r][j].y * v[r][j].y) + (v[r][j].z * v[r][j].z + v[r][j].w * v[r][j].w); }
#pragma unroll
    for (int o = 1; o < 64; o <<= 1)
#pragma unroll
        for (int r = 0; r < 4; ++r) s[r] += __shfl_xor(s[r], o);
#pragma unroll
    for (int r = 0; r < 4; ++r) { const float rstd = rsqrtf(s[r] * (1.f / DM) + EPS); unsigned long long* o8 = (unsigned long long*)(o0 + r * rstride) + lane;
#pragma unroll
        for (int j = 0; j < 4; ++j) o8[64 * j] = (unsigned long long)pk2(v[r][j].x * rstd, v[r][j].y * rstd) | ((unsigned long long)pk2(v[r][j].z * rstd, v[r][j].w * rstd) << 32); }
}
__device__ __forceinline__ void quant_rows4_fp8(const float* src0, size_t rstride, const float* gain, unsigned char* dst0, float* scale0, int sstride, int lane) {
    f32x4 v[4][4]; float am[4];
#pragma unroll
    for (int r = 0; r < 4; ++r)
#pragma unroll
        for (int j = 0; j < 4; ++j) v[r][j] = __builtin_nontemporal_load((const f32x4*)(src0 + r * rstride) + 4 * lane + j);
    if (gain) {
#pragma unroll
        for (int j = 0; j < 4; ++j) { const f32x4 g = ((const f32x4*)gain)[4 * lane + j];
#pragma unroll
            for (int r = 0; r < 4; ++r) v[r][j] = v[r][j] * g; } }
#pragma unroll
    for (int r = 0; r < 4; ++r) { am[r] = 0.f;
#pragma unroll
        for (int j = 0; j < 4; ++j) am[r] = fmaxf(am[r], fmaxf(fmaxf(fabsf(v[r][j].x), fabsf(v[r][j].y)), fmaxf(fabsf(v[r][j].z), fabsf(v[r][j].w)))); }
#pragma unroll
    for (int o = 1; o < 64; o <<= 1)
#pragma unroll
        for (int r = 0; r < 4; ++r) am[r] = fmaxf(am[r], __shfl_xor(am[r], o));
#pragma unroll
    for (int r = 0; r < 4; ++r) { const float inv = am[r] > 0.f ? 448.0f / am[r] : 0.f; v4u o4;
#pragma unroll
        for (int j = 0; j < 4; ++j) { int w = 0; w = __builtin_amdgcn_cvt_pk_fp8_f32(v[r][j].x * inv, v[r][j].y * inv, w, false); w = __builtin_amdgcn_cvt_pk_fp8_f32(v[r][j].z * inv, v[r][j].w * inv, w, true); o4[j] = (unsigned)w; }
        __builtin_nontemporal_store(o4, (v4u*)(dst0 + (size_t)r * sstride * 128 + (size_t)(lane >> 3) * 16384 * 128 + (lane & 7) * 16));
        if (lane == 0) scale0[r * sstride] = am[r] * (1.0f / 448.0f); }
}
__device__ __forceinline__ void p0_prologue(const Frame& F, const Args& A, LAS unsigned char* lds) {
    unsigned char* ws = A.ws;
    LAS float* scr = (LAS float*)(lds + F.wave * 16384);
    const float* const* in = A.in;
    const int gw = F.gw, NGW = F.NGW;
    constexpr int I_IN = 16 * 73, I_SQ = 16 * 32, I_PQ = 16 * 64, I_C1 = 64, I_C2 = 2, I_RG = 2;
    constexpr int E_IN = I_IN, E_OUT = E_IN + I_SQ, E_MQ = E_OUT + I_SQ, E_MK = E_MQ + I_SQ, E_MV = E_MK + I_SQ, E_MO = E_MV + I_SQ, E_PQ = E_MO + I_PQ, E_C1 = E_PQ + 2 * I_C1, E_C2 = E_C1 + 2 * I_C2, E_RG = E_C2 + 16 * I_RG;
    for (int it = gw; it < E_RG; it += NGW) {
        if (it < E_IN) transpose_item(in[3], 1024, 2328, (bf16*)(ws + WS_WIN), 1024, 0, in[2], ZC_Q, ZC_KC, QSCALE, scr, it, F.lane);
        else if (it < E_OUT) { const int j = it - E_IN, kb = j / 32; transpose_item(in[20], 1024, 1024, (bf16*)(ws + WS_WOUT), 1024, 0, (kb < 8 ? in[18] : in[19] - 512), 0, 0, 1.f, scr, j, F.lane, 512); }
        else if (it < E_MQ) transpose_item(in[23], 1024, 1024, (bf16*)(ws + WS_WMQ), 1024, 0, in[21], 0, 1024, 0.0625f * 1.4426950408889634f, scr, it - E_OUT, F.lane);
        else if (it < E_MK) transpose_item(in[24], 1024, 1024, (bf16*)(ws + WS_WMK), 1024, 0, in[22], 0, 0, 1.f, scr, it - E_MQ, F.lane);
        else if (it < E_MV) transpose_item(in[25], 1024, 1024, (bf16*)(ws + WS_WMV), 1024, 0, in[22], 0, 0, 1.f, scr, it - E_MK, F.lane);
        else if (it < E_MO) transpose_item(in[26], 1024, 1024, (bf16*)(ws + WS_WMO), 1024, 0, nullptr, 0, 0, 1.f, scr, it - E_MV, F.lane);
        else if (it < E_PQ) transpose_item(in[28], 1024, 2048, (bf16*)(ws + WS_WPQ), 1024, 0, in[27], 0, 0, 1.f, scr, it - E_MO, F.lane);
        else if (it < E_C1) { const int j = it - E_PQ, kv = j / I_C1; transpose_item(in[kv ? 16 : 13], 2048, 64, (bf16*)(ws + WS_CW1T) + (size_t)kv * 64 * 2048, 2048, 0, nullptr, 0, 0, 1.f, scr, j % I_C1, F.lane); }
        else if (it < E_C2) { const int j = it - E_C1, kv = j / I_C2; transpose_item(in[kv ? 17 : 14], 64, 64, (bf16*)(ws + WS_CW2T) + (size_t)kv * 64 * 64, 64, 0, nullptr, 0, 0, 1.f, scr, j % I_C2, F.lane); }
        else { const int j = it - E_C2, ai = j / 16, h = (j / 2) % 8; transpose_item(in[ai ? 9 : 7] + (size_t)h * 4096, 64, 64, (bf16*)(ws + WS_WRGT) + (size_t)(ai * 8 + h) * 4096, 64, 0, nullptr, 0, 0, 1.f, scr, j % 2, F.lane); }
    }
    for (int i = gw * 64 + F.lane; i < (2560 - 2336) * 1024 / 8; i += NGW * 64) ((v4u*)((bf16*)(ws + WS_WIN) + (size_t)2336 * 1024))[i] = (v4u){0u, 0u, 0u, 0u};
    for (int it = NGW - 1 - gw; it < 32; it += NGW) { const int kv = it >> 4, ch = it & 15; const float* pos = in[kv ? 15 : 12] + 128 * ch; const float* w1 = in[kv ? 16 : 13] + (size_t)128 * ch * 64 + F.lane; float s = 0.f;
#pragma unroll 16
        for (int k = 0; k < 128; ++k) s += pos[k] * w1[(size_t)k * 64];
        ((float*)(ws + WS_C1))[it * 64 + F.lane] = s; }
    { const size_t i0 = (size_t)gw * 64 + F.lane, st = (size_t)NGW * 64;
      const int nrows0 = (F.G == 256) ? 16384 : 32768;
      for (int r = gw; r < nrows0; r += 4 * NGW) { const int tb = r >> 14, e = r & 16383;
          if ((16384 % (4 * NGW)) == 0) quant_rows4_fp8(in[30 + tb] + (size_t)e * DM, (size_t)NGW * DM, tb ? nullptr : in[27], ws + (tb ? WS_V8 : WS_U8) + (size_t)e * 128, (float*)(ws + (tb ? WS_SV : WS_SU)) + e, NGW, F.lane);
          else for (int q = 0; q < 4; ++q) { const int rr = r + q * NGW; if (rr < 32768) { const int t2 = rr >> 14, e2 = rr & 16383; quant_row_fp8(in[30 + t2] + (size_t)e2 * DM, t2 ? nullptr : in[27], ws + (t2 ? WS_V8 : WS_U8) + (size_t)e2 * 128, (float*)(ws + (t2 ? WS_SV : WS_SU)) + e2, F.lane); } } }
      for (size_t i = i0; i < (size_t)8 * 2 * 128 * 128 / 8; i += st) { const f32x4 a = ((const f32x4*)in[29])[2 * i], bq = ((const f32x4*)in[29])[2 * i + 1];
          v4u o; o.x = pk2(a.x, a.y); o.y = pk2(a.z, a.w); o.z = pk2(bq.x, bq.y); o.w = pk2(bq.z, bq.w);
          const size_t R = i >> 4, d0 = (i & 15) * 8;
          *(v4u*)((bf16*)(ws + WS_SKEY) + (R >> 5) * 4096 + (d0 >> 4) * 512 + ((d0 >> 3) & 1) * 256 + (R & 31) * 8) = o; } }
    if ((MTOK % (4 * NGW)) == 0) for (int m = gw; m < MTOK; m += 4 * NGW) rms_rows4_to_bf16(in[0] + (size_t)m * DM, (bf16*)(ws + WS_XN) + (size_t)m * DM, (size_t)NGW * DM, F.lane);
    else for (int m = gw; m < MTOK; m += NGW) rms_row_to_bf16(in[0] + (size_t)m * DM, (bf16*)(ws + WS_XN) + (size_t)m * DM, F.lane);
    for (int m = gw; m < NB * NMEM; m += NGW) rms_row_to_bf16(in[1] + (size_t)m * DM, (bf16*)(ws + WS_MEMN) + (size_t)m * DM, F.lane);
}

__device__ __forceinline__ int crow(int r, int hi) { return (r & 3) + 8 * (r >> 2) + 4 * hi; }
__device__ __forceinline__ float gelu_tanh(float x) {
    const float u = 0.7978845608028654f * (x + 0.044715f * x * x * x);
    const float t = 1.0f - 2.0f * __builtin_amdgcn_rcpf(__builtin_amdgcn_exp2f(2.0f * 1.4426950408889634f * u) + 1.0f);
    return 0.5f * x * (1.0f + t);
}
constexpr int XC_LD = 520;
__device__ __forceinline__ void lru_local_item(const Frame& F, const Args& A, LAS unsigned char* lds, int item) {
    unsigned char* ws = A.ws;
    const bf16* Z = (const bf16*)(ws + WS_Z);
    const int b = item >> 7, chunk = item & 127, s0 = chunk * 64; const size_t row0 = (size_t)b * SEQ + s0;
    LAS bf16* xcs = (LAS bf16*)lds;
    {
        const int c8 = F.tid & 63, tg = F.tid >> 6, c0 = 8 * c8;
        v4u xr[11];
#pragma unroll
        for (int r = 0; r < 11; ++r) { const long tok = (long)(8 * tg + r) - 3;
            if (s0 == 0 && tok < 0) xr[r] = (v4u){0u, 0u, 0u, 0u}; else xr[r] = *(const v4u*)(Z + (size_t)((long)row0 + tok) * NZ + c0); }
        const float* cw = A.in[5]; float w0[8], w1[8], w2[8], w3[8], cb[8];
#pragma unroll
        for (int j = 0; j < 2; ++j) { const f32x4 a = *(const f32x4*)(cw + c0 + 4 * j), b = *(const f32x4*)(cw + 512 + c0 + 4 * j), c = *(const f32x4*)(cw + 1024 + c0 + 4 * j), d = *(const f32x4*)(cw + 1536 + c0 + 4 * j), e2 = *(const f32x4*)(A.in[6] + c0 + 4 * j);
#pragma unroll
            for (int k = 0; k < 4; ++k) { w0[4 * j + k] = a[k]; w1[4 * j + k] = b[k]; w2[4 * j + k] = c[k]; w3[4 * j + k] = d[k]; cb[4 * j + k] = e2[k]; } }
#pragma unroll
        for (int tt = 0; tt < 8; ++tt) { float o[8];
#pragma unroll
            for (int q = 0; q < 4; ++q) { const unsigned a = xr[tt][q], b = xr[tt + 1][q], c = xr[tt + 2][q], d = xr[tt + 3][q];
                o[2 * q] = cb[2 * q] + w0[2 * q] * bflo(a) + w1[2 * q] * bflo(b) + w2[2 * q] * bflo(c) + w3[2 * q] * bflo(d);
                o[2 * q + 1] = cb[2 * q + 1] + w0[2 * q + 1] * bfhi(a) + w1[2 * q + 1] * bfhi(b) + w2[2 * q + 1] * bfhi(c) + w3[2 * q + 1] * bfhi(d); }
            v4u ov; ov.x = pk2(o[0], o[1]); ov.y = pk2(o[2], o[3]); ov.z = pk2(o[4], o[5]); ov.w = pk2(o[6], o[7]);
            *(LAS v4u*)(xcs + (8 * tg + tt) * XC_LD + c0) = ov; }
    }
    __syncthreads();
    const int h = F.wave, lane = F.lane, r32 = lane & 31, hi = lane >> 5;
    bf16x8 af[2][4];
#pragma unroll
    for (int tt = 0; tt < 2; ++tt)
#pragma unroll
        for (int ks = 0; ks < 4; ++ks) af[tt][ks] = *(const LAS bf16x8*)(xcs + (32 * tt + r32) * XC_LD + 64 * h + 16 * ks + 8 * hi);
    const bf16* WT = (const bf16*)(ws + WS_WRGT);
    float* SUMM = (float*)(ws + WS_SUMM);
    unsigned* HA = (unsigned*)A.out;
#pragma unroll 1
    for (int ct = 0; ct < 2; ++ct) {
        const int c = 64 * h + 32 * ct + r32;
        f32x16 ga[2], gi[2];
#pragma unroll
        for (int tt = 0; tt < 2; ++tt) { ga[tt] = f32x16{}; gi[tt] = f32x16{}; }
#pragma unroll
        for (int ks = 0; ks < 4; ++ks) {
            const bf16x8 ba = *(const bf16x8*)(WT + (size_t)(0 * 8 + h) * 4096 + (32 * ct + r32) * 64 + 16 * ks + 8 * hi);
            const bf16x8 bi = *(const bf16x8*)(WT + (size_t)(1 * 8 + h) * 4096 + (32 * ct + r32) * 64 + 16 * ks + 8 * hi);
#pragma unroll
            for (int tt = 0; tt < 2; ++tt) { ga[tt] = __builtin_amdgcn_mfma_f32_32x32x16_bf16(af[tt][ks], ba, ga[tt], 0, 0, 0); gi[tt] = __builtin_amdgcn_mfma_f32_32x32x16_bf16(af[tt][ks], bi, gi[tt], 0, 0, 0); }
        }
        const float ba_ = A.in[8][c], bi_ = A.in[10][c], lam = A.in[11][c];
        const float sp = (lam > 15.f) ? __expf(-lam) : log1pf(__expf(-lam));
#pragma unroll
        for (int tt = 0; tt < 2; ++tt)
#pragma unroll
            for (int r = 0; r < 16; ++r) { const int t = 32 * tt + crow(r, hi);
                const float rr = __builtin_amdgcn_rcpf(1.0f + __builtin_amdgcn_exp2f(-1.4426950408889634f * (ga[tt][r] + ba_))), ii = __builtin_amdgcn_rcpf(1.0f + __builtin_amdgcn_exp2f(-1.4426950408889634f * (gi[tt][r] + bi_)));
                const float a = __builtin_amdgcn_exp2f(-8.0f * 1.4426950408889634f * rr * sp);
                const float xcv = bf2f(xcs[t * XC_LD + c]);
                const float bb = __builtin_amdgcn_sqrtf(fmaxf(1.0f - a * a, 0.f)) * (ii * xcv);
                ga[tt][r] = a; gi[tt][r] = bb; }
        float SA[8], SB[8];
#pragma unroll
        for (int tt = 0; tt < 2; ++tt)
#pragma unroll
            for (int q = 0; q < 4; ++q) {
#pragma unroll
                for (int k = 1; k < 4; ++k) { const int r = 4 * q + k; gi[tt][r] = ga[tt][r] * gi[tt][r - 1] + gi[tt][r]; ga[tt][r] = ga[tt][r] * ga[tt][r - 1]; }
                SA[tt * 4 + q] = ga[tt][4 * q + 3]; SB[tt * 4 + q] = gi[tt][4 * q + 3]; }
        float CA = 1.f, CB = 0.f; float inA[8], inB[8];
#pragma unroll
        for (int s = 0; s < 8; ++s) {
            const float pA = __shfl_xor(SA[s], 32), pB = __shfl_xor(SB[s], 32);
            const float Ae = hi ? pA : SA[s], Be = hi ? pB : SB[s], Ao = hi ? SA[s] : pA, Bo = hi ? SB[s] : pB;
            if (!hi) { inA[s] = CA; inB[s] = CB; }
            CB = Ae * CB + Be; CA = Ae * CA;
            if (hi) { inA[s] = CA; inB[s] = CB; }
            CB = Ao * CB + Bo; CA = Ao * CA;
        }
        unsigned hoff = (unsigned)((row0 + 4 * hi) * 512 + c);
        if (hi == 0) { float* sp2 = SUMM + ((size_t)(b * 128 + chunk) * 512 + c) * 2; sp2[0] = CA; sp2[1] = CB; }
#pragma unroll
        for (int tt = 0; tt < 2; ++tt)
#pragma unroll
            for (int r = 0; r < 16; ++r) { const int s = tt * 4 + (r >> 2);
                const float acum = ga[tt][r] * inA[s], hloc = ga[tt][r] * inB[s] + gi[tt][r];
                asm volatile("" : "+v"(hoff));
                HA[hoff + (unsigned)((32 * tt + (r & 3) + 8 * (r >> 2)) * 512)] = f2bf(hloc) | (f2bf(acum) << 16); }
    }
    __syncthreads();
}
__device__ __forceinline__ void lru_fix_item(const Frame& F, const Args& A, LAS unsigned char* lds, int item, bool zero_nsa) {
    unsigned char* ws = A.ws;
    const int b = item >> 7, chunk = item & 127; const size_t row0 = (size_t)b * SEQ + chunk * 64;
    LAS float* carry = (LAS float*)lds;
    { const int c = F.tid; const float* SUMM = (const float*)(ws + WS_SUMM) + (size_t)b * 128 * 1024 + 2 * c; float hc = 0.f;
      int j = 0;
      for (; j + 8 <= chunk; j += 8) { float2 ab[8];
#pragma unroll
          for (int q = 0; q < 8; ++q) ab[q] = *(const float2*)(SUMM + (size_t)(j + q) * 1024);
#pragma unroll
          for (int q = 0; q < 8; ++q) hc = ab[q].x * hc + ab[q].y; }
      for (; j < chunk; ++j) { const float2 ab = *(const float2*)(SUMM + (size_t)j * 1024); hc = ab.x * hc + ab.y; }
      carry[c] = hc; }
    __syncthreads();
    const bf16* Z = (const bf16*)(ws + WS_Z); const unsigned* HA = (const unsigned*)A.out; bf16* Y = (bf16*)(ws + WS_Y);
    const int c0 = 8 * F.lane;
    float cr[8];
#pragma unroll
    for (int j = 0; j < 8; ++j) cr[j] = carry[c0 + j];
#pragma unroll 1
    for (int t4 = 0; t4 < 8; t4 += 4) {
        v4u h0[4], h1[4], gz[4]; float y[4][8], s[4];
#pragma unroll
        for (int q = 0; q < 4; ++q) { const size_t row = row0 + F.wave * 8 + t4 + q; h0[q] = *(const v4u*)(HA + row * 512 + c0); h1[q] = *(const v4u*)(HA + row * 512 + c0 + 4); gz[q] = *(const v4u*)(Z + row * NZ + ZC_GT + c0); }
#pragma unroll
        for (int q = 0; q < 4; ++q) { const unsigned hw[8] = {h0[q].x, h0[q].y, h0[q].z, h0[q].w, h1[q].x, h1[q].y, h1[q].z, h1[q].w};
            const float gt[8] = {bflo(gz[q].x), bfhi(gz[q].x), bflo(gz[q].y), bfhi(gz[q].y), bflo(gz[q].z), bfhi(gz[q].z), bflo(gz[q].w), bfhi(gz[q].w)};
            s[q] = 0.f;
#pragma unroll
            for (int j = 0; j < 8; ++j) { const float hv = bfhi(hw[j]) * cr[j] + bflo(hw[j]); y[q][j] = hv * gelu_tanh(gt[j]); s[q] += y[q][j] * y[q][j]; } }
#pragma unroll
        for (int o = 1; o < 64; o <<= 1)
#pragma unroll
            for (int q = 0; q < 4; ++q) s[q] += __shfl_xor(s[q], o);
#pragma unroll
        for (int q = 0; q < 4; ++q) { const size_t row = row0 + F.wave * 8 + t4 + q; const float rstd = rsqrtf(s[q] * (1.f / 512.f) + EPS);
            v4u o; o.x = pk2(y[q][0] * rstd, y[q][1] * rstd); o.y = pk2(y[q][2] * rstd, y[q][3] * rstd); o.z = pk2(y[q][4] * rstd, y[q][5] * rstd); o.w = pk2(y[q][6] * rstd, y[q][7] * rstd);
            *(v4u*)(Y + row * DM + 512 + c0) = o;
            if (zero_nsa) *(v4u*)(Y + row * DM + c0) = (v4u){0u, 0u, 0u, 0u}; }
    }
    __syncthreads();
}

__device__ __forceinline__ void kmax_item(const Frame& F, const Args& A, int item) {
    unsigned char* ws = A.ws; const int lane = lane_id();
    const int bk = item >> 9, br = (item >> 8) & 1, tile = item & 255;
    const unsigned char* K = ws + (br ? WS_KWF : WS_KSF) + ((size_t)bk * 256 + tile) * 4096 + 16 * lane;
    float s = 0.f;
#pragma unroll
    for (int ks = 0; ks < 4; ++ks) { const v4u w = *(const v4u*)(K + 1024 * ks); const unsigned ww[4] = {w.x, w.y, w.z, w.w};
#pragma unroll
        for (int k = 0; k < 4; ++k) { const float a = bflo(ww[k]), c = bfhi(ww[k]); s += a * a + c * c; } }
    s = addswap32_f(s);
#pragma unroll
    for (int o = 1; o < 32; o <<= 1) s = fmaxf(s, __shfl_xor(s, o));
    if (lane == 0) atomicMax((unsigned*)(ws + WS_CTL) + CW_KMAX + bk * 2 + br, __builtin_bit_cast(unsigned, s));
}
__device__ __forceinline__ void compress_item(const Frame& F, const Args& A, LAS unsigned char* lds, int item) {
    unsigned char* ws = A.ws;
    const int kv = item >> 6, b = (item >> 5) & 1, h = (item >> 4) & 1, nt = item & 15, n0 = 32 * nt;
    const int lane = F.lane, r32 = lane & 31, hi = lane >> 5, w = F.wave;
    const bf16* Z = (const bf16*)(ws + WS_Z); const bf16* W1T = (const bf16*)(ws + WS_CW1T) + (size_t)kv * 64 * 2048; const bf16* W2T = (const bf16*)(ws + WS_CW2T) + (size_t)kv * 4096;
    const int zc = (kv ? ZC_VC : ZC_KC) + h * 64;
    LAS float* part = (LAS float*)lds;
    LAS float* G = (LAS float*)(lds + 65536);
    {
        int n = n0 + r32; if (n > 510) n = 510;
        f32x16 acc[2]; acc[0] = f32x16{}; acc[1] = f32x16{};
#pragma unroll 4
        for (int kk = 0; kk < 16; ++kk) { const int ks = 16 * w + kk, l = ks >> 2, d0 = (ks & 3) * 16 + 8 * hi;
            const bf16x8 bfr = *(const bf16x8*)(Z + ((size_t)b * SEQ + 16 * n + l) * NZ + zc + d0);
            const bf16x8 a0 = *(const bf16x8*)(W1T + (size_t)(r32) * 2048 + ks * 16 + 8 * hi), a1 = *(const bf16x8*)(W1T + (size_t)(32 + r32) * 2048 + ks * 16 + 8 * hi);
            acc[0] = __builtin_amdgcn_mfma_f32_32x32x16_bf16(a0, bfr, acc[0], 0, 0, 0); acc[1] = __builtin_amdgcn_mfma_f32_32x32x16_bf16(a1, bfr, acc[1], 0, 0, 0); }
#pragma unroll
        for (int ot = 0; ot < 2; ++ot)
#pragma unroll
            for (int r = 0; r < 16; ++r) part[(w * 64 + 32 * ot + crow(r, hi)) * 32 + r32] = acc[ot][r];
    }
    __syncthreads();
    { const float* c1 = (const float*)(ws + WS_C1) + kv * 16 * 64;
#pragma unroll
      for (int i = 0; i < 4; ++i) { const int e = F.tid + 512 * i, o = e >> 5, n = e & 31; float s = 0.f;
#pragma unroll
          for (int ch = 0; ch < 16; ++ch) s += c1[ch * 64 + o];
#pragma unroll
          for (int ww = 0; ww < 8; ++ww) s += part[(ww * 64 + o) * 32 + n];
          G[o * 33 + n] = gelu_tanh(s); } }
    __syncthreads();
    if (w < 2) {
        f32x16 acc = f32x16{};
#pragma unroll
        for (int ks = 0; ks < 4; ++ks) { const bf16x8 a = *(const bf16x8*)(W2T + (size_t)(32 * w + r32) * 64 + 16 * ks + 8 * hi);
            v4u bw; const LAS float* gp = G + (16 * ks + 8 * hi) * 33 + r32;
            bw.x = pk2(gp[0], gp[33]); bw.y = pk2(gp[66], gp[99]); bw.z = pk2(gp[132], gp[165]); bw.w = pk2(gp[198], gp[231]);
            acc = __builtin_amdgcn_mfma_f32_32x32x16_bf16(a, __builtin_bit_cast(bf16x8, bw), acc, 0, 0, 0); }
        const int n = n0 + r32;
        const size_t tbase = ((size_t)(b * 2 + h) * 16 + nt) * 2048;
        if (kv == 0) { bf16* KC = (bf16*)(ws + WS_KC) + tbase;
#pragma unroll
            for (int q = 0; q < 4; ++q) { v2u o; o.x = pk2(acc[4 * q], acc[4 * q + 1]); o.y = pk2(acc[4 * q + 2], acc[4 * q + 3]); if (n > 510) { o.x = 0u; o.y = 0u; }
                *(v2u*)(KC + (2 * w + (q >> 1)) * 512 + (q & 1) * 256 + r32 * 8 + 4 * hi) = o; } }
        else { bf16* VC = (bf16*)(ws + WS_VCT) + tbase; const int kk = r32 & 15, vo = (r32 >> 4) * 512 + ((kk >> 2) & 1) * 256 + (kk & 3) + 4 * (kk >> 3);
#pragma unroll
            for (int r = 0; r < 16; ++r) VC[w * 1024 + crow(r, hi) * 8 + vo] = (n > 510) ? (bf16)0 : (bf16)f2bf(acc[r]); }
    }
    __syncthreads();
}

__device__ __forceinline__ void sort16_desc(int (&k)[16]) {
#define CX(i, j) { const int hi_ = max(k[i], k[j]), lo_ = min(k[i], k[j]); k[i] = hi_; k[j] = lo_; }
    CX(0, 1) CX(2, 3) CX(0, 2) CX(1, 3) CX(1, 2) CX(4, 5) CX(6, 7) CX(4, 6) CX(5, 7) CX(5, 6) CX(0, 4) CX(2, 6) CX(2, 4) CX(1, 5) CX(3, 7) CX(3, 5) CX(1, 2)
    CX(3, 4) CX(5, 6) CX(8, 9) CX(10, 11) CX(8, 10) CX(9, 11) CX(9, 10) CX(12, 13) CX(14, 15) CX(12, 14) CX(13, 15) CX(13, 14) CX(8, 12) CX(10, 14) CX(10, 12)
    CX(9, 13) CX(11, 15) CX(11, 13) CX(9, 10) CX(11, 12) CX(13, 14) CX(0, 8) CX(4, 12) CX(4, 8) CX(2, 10) CX(6, 14) CX(6, 10) CX(2, 4) CX(6, 8) CX(10, 12)
    CX(1, 9) CX(5, 13) CX(5, 9) CX(3, 11) CX(7, 15) CX(7, 11) CX(3, 5) CX(7, 9) CX(11, 13) CX(1, 2) CX(3, 4) CX(5, 6) CX(7, 8) CX(9, 10) CX(11, 12) CX(13, 14)
#undef CX
}
__device__ __forceinline__ void sort32_desc(int (&k)[32]) {
#define CX(i, j) { const int hi_ = max(k[i], k[j]), lo_ = min(k[i], k[j]); k[i] = hi_; k[j] = lo_; }
    CX(0, 1) CX(2, 3) CX(0, 2) CX(1, 3) CX(1, 2) CX(4, 5) CX(6, 7) CX(4, 6) CX(5, 7) CX(5, 6) CX(0, 4) CX(2, 6) CX(2, 4) CX(1, 5) CX(3, 7) CX(3, 5) CX(1, 2)
    CX(3, 4) CX(5, 6) CX(8, 9) CX(10, 11) CX(8, 10) CX(9, 11) CX(9, 10) CX(12, 13) CX(14, 15) CX(12, 14) CX(13, 15) CX(13, 14) CX(8, 12) CX(10, 14) CX(10, 12)
    CX(9, 13) CX(11, 15) CX(11, 13) CX(9, 10) CX(11, 12) CX(13, 14) CX(0, 8) CX(4, 12) CX(4, 8) CX(2, 10) CX(6, 14) CX(6, 10) CX(2, 4) CX(6, 8) CX(10, 12)
    CX(1, 9) CX(5, 13) CX(5, 9) CX(3, 11) CX(7, 15) CX(7, 11) CX(3, 5) CX(7, 9) CX(11, 13) CX(1, 2) CX(3, 4) CX(5, 6) CX(7, 8) CX(9, 10) CX(11, 12) CX(13, 14)
    CX(16, 17) CX(18, 19) CX(16, 18) CX(17, 19) CX(17, 18) CX(20, 21) CX(22, 23) CX(20, 22) CX(21, 23) CX(21, 22) CX(16, 20) CX(18, 22) CX(18, 20) CX(17, 21)
    CX(19, 23) CX(19, 21) CX(17, 18) CX(19, 20) CX(21, 22) CX(24, 25) CX(26, 27) CX(24, 26) CX(25, 27) CX(25, 26) CX(28, 29) CX(30, 31) CX(28, 30) CX(29, 31)
    CX(29, 30) CX(24, 28) CX(26, 30) CX(26, 28) CX(25, 29) CX(27, 31) CX(27, 29) CX(25, 26) CX(27, 28) CX(29, 30) CX(16, 24) CX(20, 28) CX(20, 24) CX(18, 26)
    CX(22, 30) CX(22, 26) CX(18, 20) CX(22, 24) CX(26, 28) CX(17, 25) CX(21, 29) CX(21, 25) CX(19, 27) CX(23, 31) CX(23, 27) CX(19, 21) CX(23, 25) CX(27, 29)
    CX(17, 18) CX(19, 20) CX(21, 22) CX(23, 24) CX(25, 26) CX(27, 28) CX(29, 30) CX(0, 16) CX(8, 24) CX(8, 16) CX(4, 20) CX(12, 28) CX(12, 20) CX(4, 8)
    CX(12, 16) CX(20, 24) CX(2, 18) CX(10, 26) CX(10, 18) CX(6, 22) CX(14, 30) CX(14, 22) CX(6, 10) CX(14, 18) CX(22, 26) CX(2, 4) CX(6, 8) CX(10, 12)
    CX(14, 16) CX(18, 20) CX(22, 24) CX(26, 28) CX(1, 17) CX(9, 25) CX(9, 17) CX(5, 21) CX(13, 29) CX(13, 21) CX(5, 9) CX(13, 17) CX(21, 25) CX(3, 19)
    CX(11, 27) CX(11, 19) CX(7, 23) CX(15, 31) CX(15, 23) CX(7, 11) CX(15, 19) CX(23, 27) CX(3, 5) CX(7, 9) CX(11, 13) CX(15, 17) CX(19, 21) CX(23, 25)
    CX(27, 29) CX(1, 2) CX(3, 4) CX(5, 6) CX(7, 8) CX(9, 10) CX(11, 12) CX(13, 14) CX(15, 16) CX(17, 18) CX(19, 20) CX(21, 22) CX(23, 24) CX(25, 26) CX(27, 28)
    CX(29, 30)
#undef CX
}
__device__ __forceinline__ void bitonic16_desc(int (&a)[16]) {
#pragma unroll
    for (int s = 8; s >= 1; s >>= 1)
#pragma unroll
        for (int i = 0; i < 16; ++i) if ((i & s) == 0) { const int hi_ = max(a[i], a[i + s]), lo_ = min(a[i], a[i + s]); a[i] = hi_; a[i + s] = lo_; }
}
__device__ __forceinline__ void merge16_desc(int (&a)[16], const int (&b)[16]) {
#pragma unroll
    for (int i = 0; i < 16; ++i) a[i] = max(a[i], b[15 - i]);
    bitonic16_desc(a);
}
struct AttnSt { float m, l; f32x16 o[2]; };
#define EX2(x) __builtin_amdgcn_exp2f(x)
struct KVF { bf16x8 k[4]; bf16x8 v[2][2]; };
struct KVF8 { bf16x8 k[4]; v4u v8[2]; };
__device__ __forceinline__ void kv_load8(KVF8& f, const bf16* Kt, const unsigned char* Vt8, unsigned lo16) {
    const char* kb = (const char*)Kt + lo16;
#pragma unroll
    for (int ks = 0; ks < 4; ++ks) f.k[ks] = *(const bf16x8*)(kb + 1024 * ks);
#pragma unroll
    for (int dt = 0; dt < 2; ++dt) f.v8[dt] = *(const v4u*)(Vt8 + lo16 + 1024 * dt);
}
typedef __bf16 bf16x2v __attribute__((ext_vector_type(2)));
__device__ __forceinline__ bf16x8 dq8(unsigned w0, unsigned w1) {
    v4u o; o.x = __builtin_bit_cast(unsigned, __builtin_amdgcn_cvt_scalef32_pk_bf16_fp8(w0, 1.0f, false)); o.y = __builtin_bit_cast(unsigned, __builtin_amdgcn_cvt_scalef32_pk_bf16_fp8(w0, 1.0f, true));
    o.z = __builtin_bit_cast(unsigned, __builtin_amdgcn_cvt_scalef32_pk_bf16_fp8(w1, 1.0f, false)); o.w = __builtin_bit_cast(unsigned, __builtin_amdgcn_cvt_scalef32_pk_bf16_fp8(w1, 1.0f, true));
    return __builtin_bit_cast(bf16x8, o); }
__device__ __forceinline__ void kv_load(KVF& f, const bf16* Kt, const bf16* Vt, unsigned lo16) {
    const char* kb = (const char*)Kt + lo16; const char* vb = (const char*)Vt + lo16;
#pragma unroll
    for (int ks = 0; ks < 4; ++ks) f.k[ks] = *(const bf16x8*)(kb + 1024 * ks);
#pragma unroll
    for (int dt = 0; dt < 2; ++dt)
#pragma unroll
        for (int s2 = 0; s2 < 2; ++s2) f.v[dt][s2] = *(const bf16x8*)(vb + 2048 * dt + 1024 * s2);
}
#define MAX3(a, b, c) __builtin_fmaxf(__builtin_fmaxf((a), (b)), (c))
__device__ __forceinline__ float max16(const f32x16& s) { const float a = MAX3(s[0], s[1], s[2]), b = MAX3(s[3], s[4], s[5]), c = MAX3(s[6], s[7], s[8]), d = MAX3(s[9], s[10], s[11]), e = MAX3(s[12], s[13], s[14]);
    return MAX3(MAX3(a, b, c), MAX3(d, e, s[15]), -1e30f); }
__device__ __forceinline__ float sum16(const f32x16& s) { return (((s[0] + s[1]) + (s[2] + s[3])) + ((s[4] + s[5]) + (s[6] + s[7]))) + (((s[8] + s[9]) + (s[10] + s[11])) + ((s[12] + s[13]) + (s[14] + s[15]))); }
template <int MODE, bool FIXED, class AllowF>
__device__ __forceinline__ void attn_compute(const KVF8& f, const bf16x8 (&qf)[4], const f32x16& negm, bool sel, AllowF allow, AttnSt& st) {
    f32x16 s = FIXED ? negm : f32x16{};
#pragma unroll
    for (int ks = 0; ks < 4; ++ks) s = __builtin_amdgcn_mfma_f32_32x32x16_bf16(f.k[ks], qf[ks], s, 0, 0, 0);
    if (MODE == 2) {
#pragma unroll
        for (int r = 0; r < 16; ++r) if (!allow(r)) s[r] = -1e30f; }
    if (!FIXED) {
        float mt = max16(s);
        if (MODE == 1) mt = sel ? mt : -1e30f;
        mt = maxswap32_f(mt);
        if (__any(mt > st.m)) {
            const float mn = fmaxf(st.m, mt), alpha = EX2(st.m - mn);
            st.m = mn; st.l *= alpha;
#pragma unroll
            for (int dt = 0; dt < 2; ++dt)
#pragma unroll
                for (int r = 0; r < 16; ++r) st.o[dt][r] *= alpha;
        }
        const float mref = (MODE == 1 && !sel) ? 1e30f : fmaxf(st.m, -1e29f);
#pragma unroll
        for (int r = 0; r < 16; ++r) s[r] = EX2(s[r] - mref);
        st.l += sum16(s);
    } else {
#pragma unroll
        for (int r = 0; r < 16; ++r) s[r] = EX2(s[r]);
        const float ps = sum16(s);
        st.l += (MODE == 1 && !sel) ? 0.f : ps;
    }
#pragma unroll
    for (int s2 = 0; s2 < 2; ++s2) { v4u pw; pw.x = pk2(s[8 * s2], s[8 * s2 + 1]); pw.y = pk2(s[8 * s2 + 2], s[8 * s2 + 3]); pw.z = pk2(s[8 * s2 + 4], s[8 * s2 + 5]); pw.w = pk2(s[8 * s2 + 6], s[8 * s2 + 7]);
        if (FIXED && MODE == 1) { pw.x = sel ? pw.x : 0u; pw.y = sel ? pw.y : 0u; pw.z = sel ? pw.z : 0u; pw.w = sel ? pw.w : 0u; }
        const bf16x8 pf = __builtin_bit_cast(bf16x8, pw);
#pragma unroll
        for (int dt = 0; dt < 2; ++dt) st.o[dt] = __builtin_amdgcn_mfma_f32_32x32x16_bf16(dq8(f.v8[dt][2 * s2], f.v8[dt][2 * s2 + 1]), pf, st.o[dt], 0, 0, 0); }
}
constexpr int IMP_LD = 132;
__device__ __forceinline__ void nsa_item(const Frame& F, const Args& A, LAS unsigned char* lds, int b, int kvh, int tb, int wsub) {
    unsigned char* ws = A.ws;
    int lane = lane_id(); asm volatile("" : "+v"(lane));
    const int r32 = lane & 31, hi = lane >> 5, w = F.wave;
    const int t0 = 64 * tb + 8 * wsub, ti = r32 & 7, g = r32 >> 3, t = t0 + ti, cur = tb;
    const size_t rowb = (size_t)b * SEQ;
    const bf16* Z = (const bf16*)(ws + WS_Z);
    LAS float* imp = (LAS float*)lds + w * 8 * IMP_LD;
    for (int i = lane; i < 8 * IMP_LD; i += 64) imp[i] = 0.f;
    bf16x8 qf[4];
#pragma unroll
    for (int ks = 0; ks < 4; ++ks) qf[ks] = *(const bf16x8*)(Z + (rowb + t) * NZ + ZC_Q + (kvh * 4 + g) * 64 + 16 * ks + 8 * hi);
    const float* gp = (const float*)(ws + WS_GATES) + (rowb + t) * 24 + (kvh * 4 + g) * 3;
    const float gate_c = gp[0], gate_s = gp[1], gate_w = gp[2];
    LAS float* oacc = (LAS float*)(lds + 8 * 8 * IMP_LD * 4) + w * 2048 + lane;
    {
        const bf16* KC = (const bf16*)(ws + WS_KC) + (size_t)(b * 2 + kvh) * 16 * 2048;
        const bf16* VCT = (const bf16*)(ws + WS_VCT) + (size_t)(b * 2 + kvh) * 16 * 2048;
        const int nv = (t >= 31) ? ((t - 31) >> 4) + 1 : 0;
        const int tl = t0 + 7, nvmax = (tl >= 31) ? ((tl - 31) >> 4) + 1 : 0;
        const unsigned lo16 = 16u * (unsigned)lane;
        float m1 = -1e30f, l1 = 0.f;
        {
            bf16x8 ka[4], kb[4];
#pragma unroll
            for (int ks = 0; ks < 4; ++ks) ka[ks] = *(const bf16x8*)((const char*)KC + lo16 + 1024 * ks);
            for (int n0 = 0; n0 < nvmax; n0 += 32) {
                if (n0 + 32 < nvmax) {
#pragma unroll
                    for (int ks = 0; ks < 4; ++ks) kb[ks] = *(const bf16x8*)((const char*)(KC + (size_t)(n0 + 32) * 64) + lo16 + 1024 * ks);
                }
                f32x16 s = f32x16{};
#pragma unroll
                for (int ks = 0; ks < 4; ++ks) s = __builtin_amdgcn_mfma_f32_32x32x16_bf16(ka[ks], qf[ks], s, 0, 0, 0);
                float mt = -1e30f;
#pragma unroll
                for (int r = 0; r < 16; ++r) { if (n0 + crow(r, hi) >= nv) s[r] = -1e30f; mt = fmaxf(mt, s[r]); }
                const float mn = fmaxf(m1, mt); float ps = 0.f;
#pragma unroll
                for (int r = 0; r < 16; ++r) ps += (s[r] > -1e29f) ? EX2(s[r] - mn) : 0.f;
                l1 = l1 * EX2(m1 - mn) + ps; m1 = mn;
#pragma unroll
                for (int ks = 0; ks < 4; ++ks) ka[ks] = kb[ks];
            }
        }
        { const float mo = __shfl_xor(m1, 32), lo = __shfl_xor(l1, 32); const float mn = fmaxf(m1, mo); l1 = l1 * EX2(m1 - mn) + lo * EX2(mo - mn); m1 = mn; }
        const float invl = (l1 > 0.f) ? 1.0f / l1 : 0.f;
        f32x16 o[2]; o[0] = f32x16{}; o[1] = f32x16{};
        KVF fa, fb;
        if (nvmax > 0) kv_load(fa, KC, VCT, lo16);
        for (int n0 = 0; n0 < nvmax; n0 += 32) {
            if (n0 + 32 < nvmax) kv_load(fb, KC + (size_t)(n0 + 32) * 64, VCT + (size_t)(n0 + 32) * 64, lo16);
            f32x16 s = f32x16{};
#pragma unroll
            for (int ks = 0; ks < 4; ++ks) s = __builtin_amdgcn_mfma_f32_32x32x16_bf16(fa.k[ks], qf[ks], s, 0, 0, 0);
#pragma unroll
            for (int r = 0; r < 16; ++r) s[r] = (n0 + crow(r, hi) < nv) ? EX2(s[r] - m1) * invl : 0.f;
            float bs[4], sp[4];
#pragma unroll
            for (int q = 0; q < 4; ++q) { bs[q] = (s[4 * q] + s[4 * q + 1]) + (s[4 * q + 2] + s[4 * q + 3]); sp[q] = s[4 * q + 3];
                bs[q] += __shfl_xor(bs[q], 8); bs[q] += __shfl_xor(bs[q], 16); sp[q] += __shfl_xor(sp[q], 8); sp[q] += __shfl_xor(sp[q], 16); }
            if (r32 < 8) {
                LAS float* ip = imp + r32 * IMP_LD + (n0 >> 2) + hi;
#pragma unroll
                for (int q = 0; q < 4; ++q) ip[2 * q] += bs[q];
                asm volatile("s_waitcnt lgkmcnt(0)" ::: "memory");
#pragma unroll
                for (int q = 0; q < 4; ++q) ip[2 * q + 1] += sp[q];
                asm volatile("s_waitcnt lgkmcnt(0)" ::: "memory");
            }
#pragma unroll
            for (int s2 = 0; s2 < 2; ++s2) { v4u pw; pw.x = pk2(s[8 * s2], s[8 * s2 + 1]); pw.y = pk2(s[8 * s2 + 2], s[8 * s2 + 3]); pw.z = pk2(s[8 * s2 + 4], s[8 * s2 + 5]); pw.w = pk2(s[8 * s2 + 6], s[8 * s2 + 7]);
                const bf16x8 pf = __builtin_bit_cast(bf16x8, pw);
#pragma unroll
                for (int dt = 0; dt < 2; ++dt) o[dt] = __builtin_amdgcn_mfma_f32_32x32x16_bf16(fa.v[dt][s2], pf, o[dt], 0, 0, 0); }
            if (n0 + 32 < nvmax) fa = fb;
        }
#pragma unroll
        for (int dt = 0; dt < 2; ++dt)
#pragma unroll
            for (int r = 0; r < 16; ++r) oacc[(dt * 16 + r) * 64] = gate_c * o[dt][r];
    }
    asm volatile("s_waitcnt lgkmcnt(0)" ::: "memory");
    unsigned mym[4] = {0u, 0u, 0u, 0u}, un[4] = {0u, 0u, 0u, 0u};
    if (cur < 16) { const unsigned mk = (2u << cur) - 1u; mym[0] = mk; un[0] = mk; }
    else {
        const int tq = lane >> 3, sub = lane & 7;
        int key[16];
#pragma unroll
        for (int i = 0; i < 16; ++i) { const int j = 16 * sub + i; const float v = imp[tq * IMP_LD + j];
            key[i] = (j >= 1 && j <= cur - 2) ? (int)((__builtin_bit_cast(unsigned, v) & ~0x7fu) | (unsigned)(127 - j)) : 0; }
        sort16_desc(key);
        { int ot[16];
#pragma unroll
          for (int i = 0; i < 16; ++i) ot[i] = __builtin_amdgcn_mov_dpp(key[i], 0xB1, 0xf, 0xf, true);
          merge16_desc(key, ot);
#pragma unroll
          for (int i = 0; i < 16; ++i) ot[i] = __builtin_amdgcn_mov_dpp(key[i], 0x4E, 0xf, 0xf, true);
          merge16_desc(key, ot);
#pragma unroll
          for (int i = 0; i < 16; ++i) ot[i] = __builtin_amdgcn_mov_dpp(key[i], 0x141, 0xf, 0xf, true);
          merge16_desc(key, ot); }
        unsigned mk[4] = {1u, 0u, 0u, 0u};
        { const int c1 = cur - 1; if (c1 < 32) mk[0] |= 1u << c1; else if (c1 < 64) mk[1] |= 1u << (c1 - 32); else if (c1 < 96) mk[2] |= 1u << (c1 - 64); else mk[3] |= 1u << (c1 - 96);
          if (cur < 32) mk[0] |= 1u << cur; else if (cur < 64) mk[1] |= 1u << (cur - 32); else if (cur < 96) mk[2] |= 1u << (cur - 64); else mk[3] |= 1u << (cur - 96); }
#pragma unroll
        for (int i = 0; i < 13; ++i) { const int j = 127 - (key[i] & 0x7f); const unsigned bit = (key[i] != 0) ? (1u << (j & 31)) : 0u; const int wd = j >> 5;
            mk[0] |= (wd == 0) ? bit : 0u; mk[1] |= (wd == 1) ? bit : 0u; mk[2] |= (wd == 2) ? bit : 0u; mk[3] |= (wd == 3) ? bit : 0u; }
#pragma unroll
        for (int i = 0; i < 4; ++i) { unsigned u = mk[i]; u |= (unsigned)__shfl_xor((int)u, 8); u |= (unsigned)__shfl_xor((int)u, 16); u |= (unsigned)__shfl_xor((int)u, 32); un[i] = u;
            mym[i] = (unsigned)__shfl((int)mk[i], 8 * ti); }
    }
    float q2 = 0.f;
#pragma unroll
    for (int ks = 0; ks < 4; ++ks) { const v4u qw = __builtin_bit_cast(v4u, qf[ks]); const unsigned ww[4] = {qw.x, qw.y, qw.z, qw.w};
#pragma unroll
        for (int k = 0; k < 4; ++k) { const float a = bflo(ww[k]), c = bfhi(ww[k]); q2 += a * a + c * c; } }
    q2 = addswap32_f(q2);
    const unsigned* KMX = (const unsigned*)(ws + WS_CTL) + CW_KMAX + (b * 2 + kvh) * 2;
    const float Ms = __builtin_amdgcn_sqrtf(q2 * __builtin_bit_cast(float, KMX[0])) * 1.0001f + 1e-3f, Mw = __builtin_amdgcn_sqrtf(q2 * __builtin_bit_cast(float, KMX[1])) * 1.0001f + 1e-3f;
    const bool fixed_ok = !__any(Ms >= 60.f || Mw >= 60.f);
    {
        AttnSt st; st.m = -1e30f; st.l = 0.f; st.o[0] = f32x16{}; st.o[1] = f32x16{};
        const bf16* KS = (const bf16*)(ws + WS_KSF) + (size_t)(b * 2 + kvh) * 256 * 2048; const unsigned char* VS = ws + WS_VSF + (size_t)(b * 2 + kvh) * 256 * 2048;
        const unsigned lo16 = 16u * (unsigned)lane;
        unsigned um0 = (unsigned)__builtin_amdgcn_readfirstlane((int)un[0]), um1 = (unsigned)__builtin_amdgcn_readfirstlane((int)un[1]), um2 = (unsigned)__builtin_amdgcn_readfirstlane((int)un[2]), um3 = (unsigned)__builtin_amdgcn_readfirstlane((int)un[3]);
#define NEXT_BLOCK(jv) do { if (um0) { jv = __builtin_ctz(um0); um0 &= um0 - 1u; } else if (um1) { jv = 32 + __builtin_ctz(um1); um1 &= um1 - 1u; } else if (um2) { jv = 64 + __builtin_ctz(um2); um2 &= um2 - 1u; } \
            else if (um3) { jv = 96 + __builtin_ctz(um3); um3 &= um3 - 1u; } else jv = -1; } while (0)
#define SLC_LOOP(FX) do { f32x16 negm; _Pragma("unroll") for (int r = 0; r < 16; ++r) negm[r] = -Ms; \
        KVF8 fa, fb; int j; NEXT_BLOCK(j); \
        if (j >= 0) kv_load8(fa, KS + (size_t)j * 4096, VS + (size_t)j * 4096, lo16); \
        while (j >= 0) { const int key0 = j * 64; \
            const unsigned mw = (j < 32) ? mym[0] : (j < 64) ? mym[1] : (j < 96) ? mym[2] : mym[3]; const bool sel = (mw >> (j & 31)) & 1u; \
            kv_load8(fb, KS + (size_t)j * 4096 + 2048, VS + (size_t)j * 4096 + 2048, lo16); \
            if (j == cur) attn_compute<2, FX>(fa, qf, negm, sel, [&](int r) { return sel && (key0 + crow(r, hi) <= t); }, st); \
            else attn_compute<1, FX>(fa, qf, negm, sel, [&](int) { return true; }, st); \
            int jn; NEXT_BLOCK(jn); \
            if (jn >= 0) kv_load8(fa, KS + (size_t)jn * 4096, VS + (size_t)jn * 4096, lo16); \
            if (j == cur) attn_compute<2, FX>(fb, qf, negm, sel, [&](int r) { return sel && (key0 + 32 + crow(r, hi) <= t); }, st); \
            else attn_compute<1, FX>(fb, qf, negm, sel, [&](int) { return true; }, st); \
            j = jn; } } while (0)
        if (fixed_ok) SLC_LOOP(true); else SLC_LOOP(false);
#undef SLC_LOOP
#undef NEXT_BLOCK
        const float l = addswap32_f(st.l); const float sc = gate_s / l;
#pragma unroll
        for (int dt = 0; dt < 2; ++dt)
#pragma unroll
            for (int r = 0; r < 16; ++r) oacc[(dt * 16 + r) * 64] += sc * st.o[dt][r];
    }
    f32x16 outv[2];
    {
        AttnSt st; st.m = -1e30f; st.l = 0.f; st.o[0] = f32x16{}; st.o[1] = f32x16{};
        const bf16* KW = (const bf16*)(ws + WS_KWF) + (size_t)(b * 2 + kvh) * 256 * 2048; const unsigned char* VW = ws + WS_VWF + (size_t)(b * 2 + kvh) * 256 * 2048;
        const unsigned lo16 = 16u * (unsigned)lane;
        const int klo = (t0 - 511 > 0) ? ((t0 - 511) & ~31) : 0, khi = (t0 + 7) & ~31;
#define WIN_LOOP(FX) do { f32x16 negm; _Pragma("unroll") for (int r = 0; r < 16; ++r) negm[r] = -Mw; \
        KVF8 fa, fb; kv_load8(fa, KW + (size_t)klo * 64, VW + (size_t)klo * 64, lo16); \
        _Pragma("unroll 1") for (int key0 = klo; key0 <= khi; key0 += 32) { \
            if (key0 + 32 <= khi) kv_load8(fb, KW + (size_t)(key0 + 32) * 64, VW + (size_t)(key0 + 32) * 64, lo16); \
            if (key0 + 31 > t0 || key0 <= t0 + 7 - 512) attn_compute<2, FX>(fa, qf, negm, true, [&](int r) { const int kp = key0 + crow(r, hi); return kp <= t && kp > t - 512; }, st); \
            else attn_compute<0, FX>(fa, qf, negm, true, [&](int) { return true; }, st); \
            if (key0 + 32 <= khi) fa = fb; } } while (0)
        if (fixed_ok) WIN_LOOP(true); else WIN_LOOP(false);
#undef WIN_LOOP
        const float l = addswap32_f(st.l); const float sc = gate_w / l;
#pragma unroll
        for (int dt = 0; dt < 2; ++dt)
#pragma unroll
            for (int r = 0; r < 16; ++r) outv[dt][r] = oacc[(dt * 16 + r) * 64] + sc * st.o[dt][r];
    }
    float ss = 0.f;
#pragma unroll
    for (int dt = 0; dt < 2; ++dt)
#pragma unroll
        for (int r = 0; r < 16; ++r) ss += outv[dt][r] * outv[dt][r];
    ss += __shfl_xor(ss, 32); ss += __shfl_xor(ss, 8); ss += __shfl_xor(ss, 16);
    if (lane < 8) ((float*)(ws + WS_SSQN))[(rowb + t0 + lane) * 2 + kvh] = ss;
    bf16* Yp = (bf16*)(ws + WS_Y) + (rowb + t) * DM + (kvh * 4 + g) * 64 + 4 * hi;
#pragma unroll
    for (int dt = 0; dt < 2; ++dt)
#pragma unroll
        for (int q = 0; q < 4; ++q) { v2u o; o.x = pk2(outv[dt][4 * q], outv[dt][4 * q + 1]); o.y = pk2(outv[dt][4 * q + 2], outv[dt][4 * q + 3]); *(v2u*)(Yp + 32 * dt + 8 * q) = o; }
}
__device__ __forceinline__ void memattn_item(const Frame& F, const Args& A, int item) {
    unsigned char* ws = A.ws;
    const int lane = F.lane, r32 = lane & 31, hi = lane >> 5;
    const int h = item & 3, tile = item >> 2; const size_t row0 = (size_t)tile * 32; const int b = (int)(row0 >> 13);
    const bf16* Q = (const bf16*)(ws + WS_QM) + (size_t)tile * 32 * DM + (size_t)(h * 16) * 512 + 8 * lane;
    const bf16* K = (const bf16*)(ws + WS_MEMK) + (size_t)(b * 8) * 32 * DM + (size_t)(h * 16) * 512 + 8 * lane;
    const bf16* VF = (const bf16*)(ws + WS_MEMVT) + (size_t)((b * 4 + h) * 8) * 8192 + 8 * lane;
    f32x16 s[8];
#pragma unroll
    for (int kt = 0; kt < 8; ++kt) s[kt] = f32x16{};
#define QK_LOAD(qv, kv, ks_) do { const int kk_ = (ks_) < 16 ? (ks_) : 15; qv = *(const bf16x8*)(Q + 512 * kk_); _Pragma("unroll") for (int kt = 0; kt < 8; ++kt) kv[kt] = *(const bf16x8*)(K + (size_t)kt * 32 * DM + 512 * kk_); } while (0)
#define QK_MMA(qv, kv) do { _Pragma("unroll") for (int kt = 0; kt < 8; ++kt) s[kt] = __builtin_amdgcn_mfma_f32_32x32x16_bf16(kv[kt], qv, s[kt], 0, 0, 0); } while (0)
    { bf16x8 qa, qb, ka[8], kb[8];
      QK_LOAD(qa, ka, 0);
#pragma unroll 1
      for (int ks = 0; ks < 16; ks += 2) {
          QK_LOAD(qb, kb, ks + 1); asm volatile("" ::: "memory");
          QK_MMA(qa, ka);
          QK_LOAD(qa, ka, ks + 2); asm volatile("" ::: "memory");
          QK_MMA(qb, kb); } }
#undef QK_LOAD
#undef QK_MMA
    float m = -1e30f;
#pragma unroll
    for (int kt = 0; kt < 8; ++kt) m = fmaxf(m, max16(s[kt]));
    m = maxswap32_f(m);
    float l = 0.f; v4u pw[8][2];
#pragma unroll
    for (int kt = 0; kt < 8; ++kt) {
#pragma unroll
        for (int r = 0; r < 16; ++r) s[kt][r] = EX2(s[kt][r] - m);
        l += sum16(s[kt]);
#pragma unroll
        for (int s2 = 0; s2 < 2; ++s2) { pw[kt][s2].x = pk2(s[kt][8 * s2], s[kt][8 * s2 + 1]); pw[kt][s2].y = pk2(s[kt][8 * s2 + 2], s[kt][8 * s2 + 3]); pw[kt][s2].z = pk2(s[kt][8 * s2 + 4], s[kt][8 * s2 + 5]); pw[kt][s2].w = pk2(s[kt][8 * s2 + 6], s[kt][8 * s2 + 7]); } }
    l = addswap32_f(l);
    const float invl = 1.0f / l;
    bf16* O = (bf16*)(ws + WS_OM) + (row0 + r32) * DM + h * 256 + 4 * hi;
#define PV_LOAD(vv, dt_) do { const int dd_ = (dt_) < 8 ? (dt_) : 7; _Pragma("unroll") for (int kt = 0; kt < 8; ++kt) _Pragma("unroll") for (int s2 = 0; s2 < 2; ++s2) vv[2 * kt + s2] = *(const bf16x8*)(VF + (size_t)kt * 8192 + dd_ * 1024 + s2 * 512); } while (0)
#define PV_MMA(vv, dt_) do { f32x16 o = f32x16{}; _Pragma("unroll") for (int kt = 0; kt < 8; ++kt) _Pragma("unroll") for (int s2 = 0; s2 < 2; ++s2) o = __builtin_amdgcn_mfma_f32_32x32x16_bf16(vv[2 * kt + s2], __builtin_bit_cast(bf16x8, pw[kt][s2]), o, 0, 0, 0); \
        _Pragma("unroll") for (int q = 0; q < 4; ++q) { v2u ov; ov.x = pk2(o[4 * q] * invl, o[4 * q + 1] * invl); ov.y = pk2(o[4 * q + 2] * invl, o[4 * q + 3] * invl); *(v2u*)(O + 32 * (dt_) + 8 * q) = ov; } } while (0)
    { bf16x8 va[16], vb[16];
      PV_LOAD(va, 0);
#pragma unroll 1
      for (int dt = 0; dt < 8; dt += 2) {
          PV_LOAD(vb, dt + 1); asm volatile("" ::: "memory");
          PV_MMA(va, dt);
          PV_LOAD(va, dt + 2); asm volatile("" ::: "memory");
          PV_MMA(vb, dt + 1); } }
#undef PV_LOAD
#undef PV_MMA
}

__device__ __forceinline__ int f2key(float f) { const int u = __builtin_bit_cast(int, f); return u ^ ((u >> 31) & 0x7fffffff); }
__device__ __forceinline__ float key2f(int k) { const int u = k ^ ((k >> 31) & 0x7fffffff); return __builtin_bit_cast(float, u); }
__device__ __forceinline__ void top16_of_128(f32x16 (&s)[4], int hi, int (&kv)[16]) {
    int key[4][16];
#pragma unroll
    for (int nt = 0; nt < 4; ++nt)
#pragma unroll
        for (int r = 0; r < 16; ++r) key[nt][r] = (f2key(s[nt][r]) & ~0x7f) | (127 - (32 * nt + crow(r, hi)));
#pragma unroll
    for (int nt = 0; nt < 4; ++nt) sort16_desc(key[nt]);
    merge16_desc(key[0], key[1]); merge16_desc(key[2], key[3]); merge16_desc(key[0], key[2]);
    unsigned a[16], b[16];
#pragma unroll
    for (int i = 0; i < 16; ++i) { a[i] = (unsigned)key[0][i]; b[i] = a[i]; swap32(a[i], b[i]); }
#pragma unroll
    for (int i = 0; i < 16; ++i) kv[i] = max((int)a[i], (int)b[15 - i]);
    bitonic16_desc(kv);
}
template <bool LDSK>
__device__ __forceinline__ void peer_topk_item(const Frame& F, const Args& A, int item, const LAS unsigned char* lds) {
    unsigned char* ws = A.ws;
    int lane = lane_id(); asm volatile("" : "+v"(lane));
    const int r32 = lane & 31, hi = lane >> 5;
    const int h = item & 7, tile = item >> 3; const size_t row = (size_t)tile * 32 + r32;
    const bf16* QP = (const bf16*)(ws + WS_QP) + (size_t)tile * 32 * 2048 + (size_t)(h * 16) * 512 + 8 * lane;
    int k1[16], k2[16];
#pragma unroll
    for (int i = 0; i < 16; ++i) { k1[i] = 0; k2[i] = 0; }
#pragma unroll 1
    for (int c = 0; c < 2; ++c) {
        const bf16* SK = (const bf16*)(ws + WS_SKEY) + (size_t)((h * 2 + c) * 4) * 4096 + 8 * lane;
        f32x16 s[4];
#pragma unroll
        for (int nt = 0; nt < 4; ++nt) s[nt] = f32x16{};
        bf16x8 qf[8];
#pragma unroll
        for (int ks = 0; ks < 8; ++ks) qf[ks] = *(const bf16x8*)(QP + (size_t)(c * 8 + ks) * 512);
#pragma unroll
        for (int ks = 0; ks < 8; ++ks) {
#pragma unroll
            for (int nt = 0; nt < 4; ++nt) { const bf16x8 kf = LDSK ? *(const LAS bf16x8*)(lds + ((c * 4 + nt) * 4096 + ks * 512) * 2 + lane * 16) : *(const bf16x8*)(SK + (size_t)nt * 4096 + ks * 512);
                s[nt] = __builtin_amdgcn_mfma_f32_32x32x16_bf16(kf, qf[ks], s[nt], 0, 0, 0); } }
        if (c == 0) top16_of_128(s, hi, k1); else top16_of_128(s, hi, k2);
    }
    float v1[16], v2[16];
#pragma unroll
    for (int i = 0; i < 16; ++i) { v1[i] = key2f(k1[i] & ~0x7f); v2[i] = key2f(k2[i] & ~0x7f); }
    int ck[32];
    {
        int idx = 0;
#pragma unroll
        for (int i = 0; i < 32; ++i) ck[i] = (int)0x80000000;
#pragma unroll
        for (int a = 0; a < 16; ++a)
#pragma unroll
            for (int bq = 0; bq < 16; ++bq) if ((a + 1) * (bq + 1) <= 16) {
                const int flat = a * 16 + bq; const int kk = (f2key(v1[a] + v2[bq]) & ~0xff) | (255 - flat);
                if ((idx & 1) == hi) ck[idx >> 1] = kk;
                ++idx; }
    }
    sort32_desc(ck);
    int tk[16];
    { unsigned a[16], b[16];
#pragma unroll
      for (int i = 0; i < 16; ++i) { a[i] = (unsigned)ck[i]; b[i] = a[i]; swap32(a[i], b[i]); }
#pragma unroll
      for (int i = 0; i < 16; ++i) tk[i] = max((int)a[i], (int)b[15 - i]);
      bitonic16_desc(tk); }
    int te[16];
    { LAS int* tab = (LAS int*)(lds + 65536 + F.wave * 8448) + lane * 33;
#pragma unroll
      for (int i = 0; i < 16; ++i) { tab[i] = 127 - (k1[i] & 0x7f); tab[16 + i] = 127 - (k2[i] & 0x7f); }
      asm volatile("s_waitcnt lgkmcnt(0)" ::: "memory");
#pragma unroll
      for (int i = 0; i < 16; ++i) { const int flat = 255 - (tk[i] & 0xff); te[i] = tab[flat >> 4] * 128 + tab[16 + (flat & 15)]; }
      asm volatile("s_waitcnt lgkmcnt(0)" ::: "memory"); }
    float gsm[16]; const float mx = key2f(tk[0] & ~0xff); float den = 0.f;
#pragma unroll
    for (int i = 0; i < 16; ++i) { gsm[i] = __expf(key2f(tk[i] & ~0xff) - mx); den += gsm[i]; }
    const float inv = 1.0f / den;
    if (hi == 0) {
        int* EID = (int*)(ws + WS_EID) + row * 128 + h * 16; float* GW = (float*)(ws + WS_GW) + row * 128 + h * 16;
#pragma unroll
        for (int q = 0; q < 4; ++q) { *(v4u*)(EID + 4 * q) = (v4u){(unsigned)te[4 * q], (unsigned)te[4 * q + 1], (unsigned)te[4 * q + 2], (unsigned)te[4 * q + 3]};
            *(f32x4*)(GW + 4 * q) = (f32x4){gsm[4 * q] * inv, gsm[4 * q + 1] * inv, gsm[4 * q + 2] * inv, gsm[4 * q + 3] * inv}; }
    }
}

typedef float f32x2 __attribute__((ext_vector_type(2)));
__device__ __forceinline__ float dot16_fp8(const v4u u, const f32x2 (&xn)[8]) {
    f32x2 a0 = {0.f, 0.f}, a1 = {0.f, 0.f};
#pragma unroll
    for (int j = 0; j < 4; ++j) { const f32x2 lo = __builtin_amdgcn_cvt_pk_f32_fp8((int)u[j], false), hi = __builtin_amdgcn_cvt_pk_f32_fp8((int)u[j], true);
        a0 = __builtin_elementwise_fma(lo, xn[2 * j], a0); a1 = __builtin_elementwise_fma(hi, xn[2 * j + 1], a1); }
    return (a0.x + a0.y) + (a1.x + a1.y);
}
__device__ __forceinline__ void axpy16_fp8(f32x2 (&acc)[8], const float w, const v4u u) {
    const f32x2 w2 = {w, w};
#pragma unroll
    for (int j = 0; j < 4; ++j) { const f32x2 lo = __builtin_amdgcn_cvt_pk_f32_fp8((int)u[j], false), hi = __builtin_amdgcn_cvt_pk_f32_fp8((int)u[j], true);
        acc[2 * j] = __builtin_elementwise_fma(lo, w2, acc[2 * j]); acc[2 * j + 1] = __builtin_elementwise_fma(hi, w2, acc[2 * j + 1]); }
}
#define TIE_ROW(val, nxt) asm volatile("" : "+v"(val), "+v"((nxt).x), "+v"((nxt).y), "+v"((nxt).z), "+v"((nxt).w))
constexpr int PQ_CHUNK = 128, PQ_NCHUNK = MTOK / PQ_CHUNK;
constexpr int CW_NQ = 10240;
constexpr int CW_PQ = 8192;
__device__ __forceinline__ int pq_pop(unsigned* ctl, int pass, int own, int& q_s, LAS int* bc, int wave) {
    __syncthreads();
    if (wave == 0 && lane_id() == 0) { int res = -1; int s = q_s;
        while (s < 8) { const int x = (own + s) & 7; const unsigned c = __hip_atomic_fetch_add(ctl + CW_PQ + 64 * (8 * pass + x), 1u, __ATOMIC_RELAXED, __HIP_MEMORY_SCOPE_AGENT);
            if (c < (unsigned)PQ_NCHUNK) { res = x * PQ_NCHUNK + (int)c; break; } ++s; }
        bc[0] = res; bc[1] = s; }
    __syncthreads();
    q_s = bc[1]; return bc[0];
}
template <int CTRL> __device__ __forceinline__ float dppf(float v) { return __builtin_bit_cast(float, __builtin_amdgcn_mov_dpp(__builtin_bit_cast(int, v), CTRL, 0xf, 0xf, true)); }
__device__ __forceinline__ float red8(float d) { d += dppf<0xB1>(d); d += dppf<0x4E>(d); d += dppf<0x141>(d); return d; }
__device__ __forceinline__ void peer_issue8(v4u (&rb)[8], const v4u ia, const v4u ib, const unsigned char* T  , unsigned c16) {
    const unsigned e[8] = {ia.x, ia.y, ia.z, ia.w, ib.x, ib.y, ib.z, ib.w};
#pragma unroll
    for (int i = 0; i < 8; ++i) rb[i] = *(const v4u*)(T + (e[i] * 128u + c16));
}
constexpr int PS_ROW = 528, PS_WAVE = 2 * 16 * PS_ROW;
__device__ __forceinline__ void peer_stage16(LAS unsigned char* st, const unsigned char* src  , int lane) {
    v4u e[8];
#pragma unroll
    for (int j = 0; j < 8; ++j) e[j] = __builtin_nontemporal_load((const v4u*)(src + (unsigned)(j * 1024 + lane * 16)));
#pragma unroll
    for (int j = 0; j < 8; ++j) *(LAS v4u*)(st + (2 * j + (lane >> 5)) * PS_ROW + (lane & 31) * 16) = e[j];
}
__device__ __forceinline__ void peer_u_chunk(const Frame& F, const Args& A, LAS unsigned char* lds, int x, int chunk) {
    unsigned char* ws = A.ws; int lane = lane_id(); asm volatile("" : "+v"(lane));
    const int tk = lane >> 3, c8 = lane & 7;
    const unsigned char* U = ws + WS_U8 + (size_t)x * 16384 * 128; const unsigned c16 = 16u * (unsigned)c8;
    LAS unsigned char* st = lds + F.wave * PS_WAVE;
    peer_stage16(st, ws + WS_EID + (size_t)(chunk * PQ_CHUNK + F.wave * 16) * 512, lane);
#pragma unroll 1
    for (int oc = 0; oc < 2; ++oc) {
        const unsigned row = (unsigned)(chunk * PQ_CHUNK + F.wave * 16 + oc * 8 + tk);
        const LAS unsigned char* est = st + (oc * 8 + tk) * PS_ROW;
#define EID_LD(i_) (*(const LAS v4u*)(est + 16 * (i_)))
        f32x2 xn[8];
        { const unsigned char* xb_ = ws + WS_XN; const unsigned xo = row * 2048u + 256u * (unsigned)x + 32u * (unsigned)c8; const v4u xa = *(const v4u*)(xb_ + xo), xb = *(const v4u*)(xb_ + (xo + 16u));
          const unsigned xw[8] = {xa.x, xa.y, xa.z, xa.w, xb.x, xb.y, xb.z, xb.w};
#pragma unroll
          for (int j = 0; j < 8; ++j) { xn[j].x = bflo(xw[j]); xn[j].y = bfhi(xw[j]); } }
        float rstd; { const f32x4* sp = (const f32x4*)(ws + WS_SSQ2 + (size_t)row * 64); const f32x4 a = sp[0], b = sp[1], c = sp[2], d = sp[3];
            rstd = rsqrtf((((a.x + a.y) + (a.z + a.w)) + ((b.x + b.y) + (b.z + b.w)) + ((c.x + c.y) + (c.z + c.w)) + ((d.x + d.y) + (d.z + d.w))) * (1.f / DM) + EPS); }
        unsigned char* ppb = ws + WS_PART; const unsigned po = ((unsigned)x * MTOK + row) * 256u + 32u * (unsigned)c8;
        v4u ra[8], rb[8]; v4u ia0 = EID_LD(0), ia1 = EID_LD(1), ib0 = EID_LD(2), ib1 = EID_LD(3);
        peer_issue8(ra, ia0, ia1, U, c16); ia0 = EID_LD(4); ia1 = EID_LD(5);
#pragma unroll 1
        for (int q = 0; q < 16; q += 2) {
            peer_issue8(rb, ib0, ib1, U, c16); { const int qn = (q + 3 < 16) ? q + 3 : 15; ib0 = EID_LD(2 * qn); ib1 = EID_LD(2 * qn + 1); }
            float k0 = 0.f, k1 = 0.f;
#pragma unroll
            for (int i = 0; i < 8; ++i) { float d = dot16_fp8(ra[i], xn); if (i < 7) TIE_ROW(d, ra[i + 1]); d = red8(d); k0 = (c8 == i) ? d : k0; }
            peer_issue8(ra, ia0, ia1, U, c16); { const int qn = (q + 4 < 16) ? q + 4 : 15; ia0 = EID_LD(2 * qn); ia1 = EID_LD(2 * qn + 1); }
#pragma unroll
            for (int i = 0; i < 8; ++i) { float d = dot16_fp8(rb[i], xn); if (i < 7) TIE_ROW(d, rb[i + 1]); d = red8(d); k1 = (c8 == i) ? d : k1; }
            *(unsigned*)(ppb + (po + 2u * (unsigned)q)) = pk2(k0 * rstd, k1 * rstd);
        }
    }
}
__device__ __forceinline__ void peer_w_rows(const Frame& F, const Args& A) {
    unsigned char* ws = A.ws; const int lane = lane_id();
    const float* SU = (const float*)(ws + WS_SU); const float* SV = (const float*)(ws + WS_SV);
    const int p0 = 2 * lane, k0 = 8 * (p0 & 15) + (p0 >> 4), k1 = k0 + 8;
    for (int m0 = F.gw; m0 < MTOK; m0 += 4 * F.NGW) {
        int e0[4], e1[4]; float g0[4], g1[4]; unsigned pw[4][8];
#pragma unroll
        for (int r = 0; r < 4; ++r) { const size_t row = (size_t)(m0 + r * F.NGW < MTOK ? m0 + r * F.NGW : m0);
            const int* EID = (const int*)(ws + WS_EID) + row * 128; const float* GW = (const float*)(ws + WS_GW) + row * 128;
            e0[r] = EID[k0]; e1[r] = EID[k1]; g0[r] = GW[k0]; g1[r] = GW[k1];
#pragma unroll
            for (int x = 0; x < 8; ++x) pw[r][x] = *(const unsigned*)((const bf16*)(ws + WS_PART) + ((size_t)x * MTOK + row) * 128 + p0); }
        float su0[4], su1[4], sv0[4], sv1[4];
#pragma unroll
        for (int r = 0; r < 4; ++r) { su0[r] = SU[e0[r]]; su1[r] = SU[e1[r]]; sv0[r] = SV[e0[r]]; sv1[r] = SV[e1[r]]; }
#pragma unroll
        for (int r = 0; r < 4; ++r) { if (m0 + r * F.NGW < MTOK) { const size_t row = (size_t)(m0 + r * F.NGW); float s0 = 0.f, s1 = 0.f;
#pragma unroll
            for (int x = 0; x < 8; ++x) { s0 += bflo(pw[r][x]); s1 += bfhi(pw[r][x]); }
            float* W = (float*)(ws + WS_W) + row * 128;
            W[k0] = gelu_tanh(s0 * su0[r]) * g0[r] * sv0[r]; W[k1] = gelu_tanh(s1 * su1[r]) * g1[r] * sv1[r]; } }
    }
}
__device__ __forceinline__ void peer_v_chunk(const Frame& F, const Args& A, LAS unsigned char* lds, int x, int chunk) {
    unsigned char* ws = A.ws; int lane = lane_id(); asm volatile("" : "+v"(lane));
    const int tk = lane >> 3, c8 = lane & 7;
    const unsigned char* V = ws + WS_V8 + (size_t)x * 16384 * 128; const unsigned c16 = 16u * (unsigned)c8;
    LAS unsigned char* st = lds + F.wave * PS_WAVE;
    peer_stage16(st, ws + WS_EID + (size_t)(chunk * PQ_CHUNK + F.wave * 16) * 512, lane);
    peer_stage16(st + 16 * PS_ROW, ws + WS_W + (size_t)(chunk * PQ_CHUNK + F.wave * 16) * 512, lane);
#pragma unroll 1
    for (int oc = 0; oc < 2; ++oc) {
        const unsigned row = (unsigned)(chunk * PQ_CHUNK + F.wave * 16 + oc * 8 + tk);
        const LAS unsigned char* est = st + (oc * 8 + tk) * PS_ROW;
#define W_LD(i_) (*(const LAS f32x4*)(est + 16 * PS_ROW + 16 * (i_)))
        f32x2 acc[8];
#pragma unroll
        for (int j = 0; j < 8; ++j) acc[j] = (f32x2){0.f, 0.f};
        v4u ra[8], rb[8]; v4u ia0 = EID_LD(0), ia1 = EID_LD(1), ib0 = EID_LD(2), ib1 = EID_LD(3); f32x4 wa0 = W_LD(0), wa1 = W_LD(1), wb0 = W_LD(2), wb1 = W_LD(3);
        peer_issue8(ra, ia0, ia1, V, c16); ia0 = EID_LD(4); ia1 = EID_LD(5);
#pragma unroll 1
        for (int q = 0; q < 16; q += 2) {
            peer_issue8(rb, ib0, ib1, V, c16); { const int qn = (q + 3 < 16) ? q + 3 : 15; ib0 = EID_LD(2 * qn); ib1 = EID_LD(2 * qn + 1); }
            { const float wv[8] = {wa0.x, wa0.y, wa0.z, wa0.w, wa1.x, wa1.y, wa1.z, wa1.w};
#pragma unroll
              for (int i = 0; i < 8; ++i) { axpy16_fp8(acc, wv[i], ra[i]); if (i < 7) TIE_ROW(acc[7].y, ra[i + 1]); } }
            { const int qn = (q + 2 < 16) ? q + 2 : 15; wa0 = W_LD(2 * qn); wa1 = W_LD(2 * qn + 1); }
            peer_issue8(ra, ia0, ia1, V, c16); { const int qn = (q + 4 < 16) ? q + 4 : 15; ia0 = EID_LD(2 * qn); ia1 = EID_LD(2 * qn + 1); }
            { const float wv[8] = {wb0.x, wb0.y, wb0.z, wb0.w, wb1.x, wb1.y, wb1.z, wb1.w};
#pragma unroll
              for (int i = 0; i < 8; ++i) { axpy16_fp8(acc, wv[i], rb[i]); if (i < 7) TIE_ROW(acc[7].y, rb[i + 1]); } }
            { const int qn = (q + 3 < 16) ? q + 3 : 15; wb0 = W_LD(2 * qn); wb1 = W_LD(2 * qn + 1); }
        }
        unsigned char* xr = ws + WS_XN + (row * 2048u + 256u * (unsigned)x + 32u * (unsigned)c8); float ss = 0.f;
        const v4u x2a = *(const v4u*)xr, x2b = *(const v4u*)(xr + 16);
        const unsigned xw[8] = {x2a.x, x2a.y, x2a.z, x2a.w, x2b.x, x2b.y, x2b.z, x2b.w};
        unsigned ow[8];
#pragma unroll
        for (int j = 0; j < 4; ++j) { f32x4 v; v.x = bflo(xw[2 * j]) + acc[2 * j].x; v.y = bfhi(xw[2 * j]) + acc[2 * j].y; v.z = bflo(xw[2 * j + 1]) + acc[2 * j + 1].x; v.w = bfhi(xw[2 * j + 1]) + acc[2 * j + 1].y;
            ss += (v.x * v.x + v.y * v.y) + (v.z * v.z + v.w * v.w); ow[2 * j] = pk2(v.x, v.y); ow[2 * j + 1] = pk2(v.z, v.w); }
        *(v4u*)xr = (v4u){ow[0], ow[1], ow[2], ow[3]}; *(v4u*)(xr + 16) = (v4u){ow[4], ow[5], ow[6], ow[7]};
        ss = red8(ss);
        if (c8 == 0) ((float*)(ws + WS_SSQ3))[row * 8 + x] = ss;
    }
#undef W_LD
#undef EID_LD
}
__device__ __forceinline__ void peer_final_rows(const Frame& F, const Args& A) {
    unsigned char* ws = A.ws; const int lane = lane_id(); const float* g = A.in[32];
    for (int m = F.gw; m < MTOK; m += F.NGW) {
        const f32x4 sa = *(const f32x4*)((const float*)(ws + WS_SSQ3) + (size_t)m * 8), sb = *(const f32x4*)((const float*)(ws + WS_SSQ3) + (size_t)m * 8 + 4);
        const float rstd = rsqrtf((((sa.x + sa.y) + (sa.z + sa.w)) + ((sb.x + sb.y) + (sb.z + sb.w))) * (1.f / DM) + EPS);
        f32x4* xr = (f32x4*)(A.out + (size_t)m * DM) + lane; const v2u* xb = (const v2u*)((const bf16*)(ws + WS_XN) + (size_t)m * DM) + lane;
#pragma unroll
        for (int j = 0; j < 4; ++j) { const v2u w = xb[64 * j]; const f32x4 gg = ((const f32x4*)g)[lane + 64 * j]; const f32x4 v = {bflo(w.x), bfhi(w.x), bflo(w.y), bfhi(w.y)}; __builtin_nontemporal_store(v * rstd * gg, xr + 64 * j); }
    }
}

typedef GAS unsigned gu32;
#define RLX_AGENT __ATOMIC_RELAXED, __HIP_MEMORY_SCOPE_AGENT
#define XB_TMO      128
#define XB_XCNT(j)  (256  + 64 * (j))
#define XB_XSUB(j)  (1280 + 64 * (j))
#define XB_XGEN(j)  (2304 + 64 * (j))
#define XB_TOP      3328
#define XB_TOPGEN   3392
#define XCD_BAR_WORDS 3456
#define XB_SPIN_CAP (1u << 18)

__device__ __forceinline__ unsigned xb_ld(unsigned* p)              { return __hip_atomic_load(p, __ATOMIC_RELAXED, __HIP_MEMORY_SCOPE_AGENT); }
__device__ __forceinline__ unsigned xb_add(unsigned* p, unsigned v) { return __hip_atomic_fetch_add(p, v, __ATOMIC_RELAXED, __HIP_MEMORY_SCOPE_AGENT); }
__device__ __forceinline__ unsigned xb_xcc_id() { return (unsigned)__builtin_amdgcn_s_getreg((3 << 11) | 20) & 0xFu; }
#define XB_SPIN(cond, bar) do { unsigned _sp = 0; while (cond) { __builtin_amdgcn_s_sleep(1); \
    if ((++_sp & 255u) == 0u) { if (xb_ld(&(bar)[XB_TMO])) break; if (_sp > XB_SPIN_CAP) { atomicAdd(&(bar)[XB_TMO], 1u); break; } } } } while (0)

struct XcdBarrier {
    unsigned* bar; unsigned x;
    volatile LAS unsigned* st;
};

__device__ __forceinline__ XcdBarrier xcd_barrier_post(unsigned* bar, volatile LAS unsigned* st) {
    XcdBarrier b; b.bar = bar; b.x = xb_xcc_id(); b.st = st;
    if (threadIdx.x == 0) (void)xb_add(&bar[XB_XCNT(b.x)], 1u);
    return b;
}
__device__ __forceinline__ void xcd_barrier_complete(unsigned* bar, unsigned x, unsigned& nloc, unsigned& nx) {
    const unsigned G = gridDim.x * gridDim.y * gridDim.z;
    unsigned sum, cnt, mine, sp = 0u;
    for (;;) {
        sum = 0u; cnt = 0u; mine = 0u;
#pragma unroll
        for (unsigned j = 0; j < 16; ++j) { const unsigned c = xb_ld(&bar[XB_XCNT(j)]); sum += c; cnt += (c > 0u) ? 1u : 0u; mine = (j == x) ? c : mine; }
        if (sum == G) break;
        __builtin_amdgcn_s_sleep(1);
        if ((++sp & 255u) == 0u) { if (xb_ld(&bar[XB_TMO])) break; if (sp > XB_SPIN_CAP) { atomicAdd(&bar[XB_TMO], 1u); break; } }
    }
    nloc = mine > 0u ? mine : 1u; nx = cnt > 0u ? cnt : 1u;
}

__device__ __forceinline__ void xcd_barrier(const XcdBarrier& b) {
    asm volatile("s_waitcnt vmcnt(0)" ::: "memory");
    __syncthreads();
    if (threadIdx.x == 0) {
        unsigned* bar = b.bar;
        __builtin_amdgcn_s_waitcnt(0);
        unsigned nloc = b.st[0], nx = b.st[1];
        if (nloc == 0u) { xcd_barrier_complete(bar, b.x, nloc, nx); b.st[0] = nloc; b.st[1] = nx; }
        const unsigned old = xb_add(&bar[XB_XSUB(b.x)], 1u);
        const unsigned gen = old / nloc;
        if (old + 1u == (gen + 1u) * nloc) {
            __builtin_amdgcn_fence(__ATOMIC_RELEASE, "agent");
            asm volatile("s_waitcnt vmcnt(0)" ::: "memory");
            const unsigned og = xb_add(&bar[XB_TOP], 1u);
            const unsigned tg = og / nx;
            if (og + 1u == (tg + 1u) * nx) xb_add(&bar[XB_TOPGEN], 1u);
            else XB_SPIN(xb_ld(&bar[XB_TOPGEN]) == tg, bar);
            __builtin_amdgcn_fence(__ATOMIC_ACQUIRE, "agent");
            xb_add(&bar[XB_XGEN(b.x)], 1u);
            asm volatile("s_waitcnt vmcnt(0)" ::: "memory");
        } else {
            XB_SPIN(xb_ld(&bar[XB_XGEN(b.x)]) == gen, bar);
            __builtin_amdgcn_fence(__ATOMIC_ACQUIRE, "agent");
            asm volatile("s_waitcnt vmcnt(0)" ::: "memory");
        }
    }
    __syncthreads();
}

#ifndef DBL_MASK
#define DBL_MASK 0
#endif
constexpr int NPHASE = 12;
__global__ void __launch_bounds__(512, 2) fwd_kernel(Args args) {
    extern __shared__ __attribute__((aligned(16))) unsigned char lds_raw[];
    LAS unsigned char* lds = (LAS unsigned char*)lds_raw;
    Frame F;
    F.tid = threadIdx.x; F.lane = F.tid & 63; F.wave = __builtin_amdgcn_readfirstlane(F.tid >> 6);
    F.G = gridDim.x; { const int bx = blockIdx.x; F.vcu = (F.G % 8 == 0) ? (bx % 8) * (F.G / 8) + bx / 8 : bx; }
    F.gw = F.vcu * 8 + F.wave; F.NGW = F.G * 8;
    unsigned char* ws = args.ws;
    const int lo = args.ph_lo, hi = args.ph_hi;
    volatile LAS unsigned* MISC = (volatile LAS unsigned*)(lds + LDS_BYTES - 64);
    if (F.tid < 16) MISC[F.tid] = 0u;
    __syncthreads();
    XcdBarrier bar = xcd_barrier_post((unsigned*)(ws + WS_CTL), MISC);
#define IN(k) (lo <= (k) && (k) < hi)
#define SEAM(k) do { if (IN(k) && IN((k) + 1)) xcd_barrier(bar); } while (0)

    if (IN(0)) for (int rep_ = 0; rep_ <= ((DBL_MASK >> 0) & 1); ++rep_) { if (rep_) xcd_barrier(bar); REFRESH_LANE(F); p0_prologue(F, args, lds); }
    SEAM(0);
    if (IN(1)) for (int rep_ = 0; rep_ <= ((DBL_MASK >> 1) & 1); ++rep_) { if (rep_) xcd_barrier(bar); REFRESH_LANE(F);
        { pg8::Gemm g{(const bf16*)(ws + WS_XN), (const bf16*)(ws + WS_WIN), MTOK, NZP, DM}; pg8::StaticOrder S; S.init(MTOK, NZP, F.G, (int)blockIdx.x);
          pg8::EpiZ E{(bf16*)(ws + WS_Z), (bf16*)(ws + WS_KSF), (bf16*)(ws + WS_VSF), (bf16*)(ws + WS_KWF), (bf16*)(ws + WS_VWF), (float*)(ws + WS_GATES), args.in[4]};
          pg8::gemm_phase<pg8::EpiZ, pg8::StaticOrder, true, true>(lds, g, S, E, F.wave); }
        { pg8::Gemm g{(const bf16*)(ws + WS_MEMN), (const bf16*)(ws + WS_WMK), NB * NMEM, DM, DM}; pg8::StaticOrder S; S.init(NB * NMEM, DM, F.G, ((int)blockIdx.x + 128) & 255);
          pg8::EpiStore E{(bf16*)(ws + WS_MEMK), DM, nullptr, 1};
          pg8::gemm_phase<pg8::EpiStore, pg8::StaticOrder, true, true>(lds, g, S, E, F.wave); }
        { pg8::Gemm g{(const bf16*)(ws + WS_WMV), (const bf16*)(ws + WS_MEMN), DM, NB * NMEM, DM}; pg8::StaticOrder S; S.init(DM, NB * NMEM, F.G, ((int)blockIdx.x + 120) & 255);
          pg8::EpiVFrag E{(bf16*)(ws + WS_MEMVT)};
          pg8::gemm_phase<pg8::EpiVFrag, pg8::StaticOrder, true, true>(lds, g, S, E, F.wave); }
    }
    SEAM(1);
    if (IN(2)) for (int rep_ = 0; rep_ <= ((DBL_MASK >> 2) & 1); ++rep_) { if (rep_) xcd_barrier(bar); REFRESH_LANE(F); for (int it = F.gw; it < 2048; it += F.NGW) kmax_item(F, args, it);
                 for (int it = F.vcu; it < 256; it += F.G) lru_local_item(F, args, lds, it);
                 for (int it = F.G - 1 - F.vcu; it < 128; it += F.G) compress_item(F, args, lds, it); }
    SEAM(2);
    if (IN(3)) for (int rep_ = 0; rep_ <= ((DBL_MASK >> 3) & 1); ++rep_) { if (rep_) xcd_barrier(bar); REFRESH_LANE(F);
                 { unsigned* ctl = (unsigned*)(ws + WS_CTL); const int own = (int)(((long)F.vcu * 8) / F.G) & 7; int qs = 0;
                   for (;;) { int id = -1;
                       if (lane_id() == 0) { while (qs < 8) { const int x = (own + qs) & 7; const unsigned c = __hip_atomic_fetch_add(ctl + CW_NQ + 64 * x, 1u, __ATOMIC_RELAXED, __HIP_MEMORY_SCOPE_AGENT);
                               if (c < 512u) { id = x * 512 + (int)c; break; } ++qs; } }
                       id = __builtin_amdgcn_readfirstlane(id); qs = __builtin_amdgcn_readfirstlane(qs);
                       if (id < 0) break;
                       if (F.G == 256) { quant_rows4_fp8(args.in[31] + (size_t)id * DM, (size_t)4096 * DM, nullptr, ws + WS_V8 + (size_t)id * 128, (float*)(ws + WS_SV) + id, 4096, lane_id());
 }
                       const int x = id >> 9, i = id & 511; nsa_item(F, args, lds, x >> 2, (x >> 1) & 1, 2 * (63 - (i >> 3)) + (x & 1), 7 - (i & 7)); } }
                 __syncthreads(); REFRESH_LANE(F);
                 for (int it = F.vcu; it < 256; it += F.G) lru_fix_item(F, args, lds, it, false); }
    SEAM(3);
    if (IN(4)) for (int rep_ = 0; rep_ <= ((DBL_MASK >> 4) & 1); ++rep_) { if (rep_) xcd_barrier(bar); REFRESH_LANE(F);
        pg8::Gemm g{(const bf16*)(ws + WS_Y), (const bf16*)(ws + WS_WOUT), MTOK, DM, DM}; pg8::StaticOrder S; S.init(MTOK, DM, F.G, (int)blockIdx.x);
        pg8::EpiRes<true> E{args.in[0], nullptr, nullptr, (bf16*)(ws + WS_XN), (float*)(ws + WS_SSQ1), (const float*)(ws + WS_SSQN)};
        pg8::gemm_phase<pg8::EpiRes<true>, pg8::StaticOrder, true, true>(lds, g, S, E, F.wave);
    }
    SEAM(4);
    if (IN(5)) for (int rep_ = 0; rep_ <= ((DBL_MASK >> 5) & 1); ++rep_) { if (rep_) xcd_barrier(bar); REFRESH_LANE(F);
        pg8::Gemm g{(const bf16*)(ws + WS_XN), (const bf16*)(ws + WS_WMQ), MTOK, DM, DM}; pg8::StaticOrder S; S.init(MTOK, DM, F.G, (int)blockIdx.x);
        pg8::EpiStore E{(bf16*)(ws + WS_QM), DM, (const float*)(ws + WS_SSQ1), 1};
        pg8::gemm_phase<pg8::EpiStore, pg8::StaticOrder, true, true>(lds, g, S, E, F.wave);
    }
    SEAM(5);
    if (IN(6)) for (int rep_ = 0; rep_ <= ((DBL_MASK >> 6) & 1); ++rep_) { if (rep_) xcd_barrier(bar); REFRESH_LANE(F); for (int it = F.gw; it < 2048; it += F.NGW) memattn_item(F, args, it); }
    SEAM(6);
    if (IN(7)) for (int rep_ = 0; rep_ <= ((DBL_MASK >> 7) & 1); ++rep_) { if (rep_) xcd_barrier(bar); REFRESH_LANE(F);
        pg8::Gemm g{(const bf16*)(ws + WS_OM), (const bf16*)(ws + WS_WMO), MTOK, DM, DM}; pg8::StaticOrder S; S.init(MTOK, DM, F.G, (int)blockIdx.x);
        pg8::EpiRes<false> E{nullptr, (const bf16*)(ws + WS_XN), nullptr, (bf16*)(ws + WS_XN), (float*)(ws + WS_SSQ2), nullptr};
        pg8::gemm_phase<pg8::EpiRes<false>, pg8::StaticOrder, true, true>(lds, g, S, E, F.wave);
    }
    SEAM(7);
    if (IN(8)) for (int rep_ = 0; rep_ <= ((DBL_MASK >> 8) & 1); ++rep_) { if (rep_) xcd_barrier(bar); REFRESH_LANE(F);
        pg8::Gemm g{(const bf16*)(ws + WS_XN), (const bf16*)(ws + WS_WPQ), MTOK, 2048, DM}; pg8::StaticOrder S; S.init(MTOK, 2048, F.G, (int)blockIdx.x);
        pg8::EpiStore E{(bf16*)(ws + WS_QP), 2048, (const float*)(ws + WS_SSQ2), 1};
        pg8::gemm_phase<pg8::EpiStore, pg8::StaticOrder, true, true>(lds, g, S, E, F.wave);
    }
    SEAM(8);
    if (IN(9)) for (int rep_ = 0; rep_ <= ((DBL_MASK >> 9) & 1); ++rep_) { if (rep_) xcd_barrier(bar); REFRESH_LANE(F); for (int gi = F.vcu; gi < 256; gi += F.G) {
                     const int h = gi & 7, tgp = gi >> 3;
                     { const v4u* src = (const v4u*)((const bf16*)(ws + WS_SKEY) + (size_t)h * 8 * 4096); const int tid = F.wave * 64 + lane_id();
#pragma unroll
                       for (int i = 0; i < 8; ++i) ((LAS v4u*)lds)[tid + 512 * i] = src[tid + 512 * i]; }
                     __syncthreads();
                     peer_topk_item<true>(F, args, (tgp * 16 + F.wave) * 8 + h, lds); peer_topk_item<true>(F, args, (tgp * 16 + 8 + F.wave) * 8 + h, lds);
                     __syncthreads(); } }
    SEAM(9);
    if (IN(10)) {   REFRESH_LANE(F);
        LAS int* bc = (LAS int*)(lds + LDS_BYTES - 128); unsigned* ctl = (unsigned*)(ws + WS_CTL); const int own = (int)(bar.x & 7u);
        { int qs = 0; for (;;) { const int id = __builtin_amdgcn_readfirstlane(pq_pop(ctl, 0, own, qs, bc, F.wave)); if (id < 0) break; peer_u_chunk(F, args, lds, id / PQ_NCHUNK, id % PQ_NCHUNK); } }
        xcd_barrier(bar);
        peer_w_rows(F, args);
        xcd_barrier(bar);
        { int qs = 0; for (;;) { const int id = __builtin_amdgcn_readfirstlane(pq_pop(ctl, 1, own, qs, bc, F.wave)); if (id < 0) break; peer_v_chunk(F, args, lds, id / PQ_NCHUNK, id % PQ_NCHUNK); } }
        xcd_barrier(bar);
        peer_final_rows(F, args);
    }
#undef IN
#undef SEAM
}

extern "C" void kernel_launch(void* const* d_in, const int* in_sizes, int n_in, void* d_out, int out_size, void* d_ws, size_t ws_size, hipStream_t stream) {
    static int grid = 0;
    if (grid == 0) {
        if (n_in != 33 || out_size != MTOK * DM || ws_size < WS_END) { fprintf(stderr, "kernel_launch: unexpected problem (n_in %d, out %d, ws %zu)\n", n_in, out_size, ws_size); grid = -1; return; }
        int dev = 0, cus = 0, per_cu = 0;
        (void)hipGetDevice(&dev); (void)hipDeviceGetAttribute(&cus, hipDeviceAttributeMultiprocessorCount, dev);
        (void)hipFuncSetAttribute((const void*)fwd_kernel, hipFuncAttributeMaxDynamicSharedMemorySize, LDS_BYTES);
        (void)hipOccupancyMaxActiveBlocksPerMultiprocessor(&per_cu, (const void*)fwd_kernel, 512, LDS_BYTES);
        if (per_cu < 1) { fprintf(stderr, "kernel_launch: occupancy query says %d blocks per CU\n", per_cu); per_cu = 1; }
        grid = cus * 1;
        if (grid != 256) fprintf(stderr, "kernel_launch: %d CUs (built for 256)\n", cus);
    }
    if (grid < 0) return;
    (void)hipMemsetAsync((char*)d_ws + WS_CTL, 0, 65536, stream);
    Args a{};
    for (int i = 0; i < 33; ++i) a.in[i] = (const float*)d_in[i];
    a.out = (float*)d_out; a.ws = (unsigned char*)d_ws; a.ph_lo = 0; a.ph_hi = NPHASE;
    void* kargs[] = {&a};
    hipError_t e = hipLaunchCooperativeKernel((const void*)fwd_kernel, dim3(grid), dim3(512), kargs, LDS_BYTES, stream);
    if (e != hipSuccess) fprintf(stderr, "cooperative launch failed: %s (grid %d)\n", hipGetErrorString(e), grid);
}
```

```cpp
#include <hip/hip_runtime.h>
#include <cstdio>
#include <cstdint>

namespace pg8 {
#define PG8_LAS __attribute__((address_space(3)))
typedef unsigned short bf16_t;
typedef short bf16x8 __attribute__((ext_vector_type(8)));
typedef float f32x4 __attribute__((ext_vector_type(4)));
typedef unsigned u32x4 __attribute__((ext_vector_type(4)));
constexpr int BM = 256, BK = 64, HALF = 128, HTB = HALF * BK * 2  , STAGE_BYTES = 8 * HTB, NXCD = 8, WGM = 8;

__host__ __device__ __forceinline__ int lds_byte(int r, int c) { const int st = (r >> 4) * 2 + (c >> 5), rr = r & 15, cc = c & 31, ob = rr * 64 + cc * 2; return st * 1024 + (ob ^ (((ob >> 9) & 1) << 5)); }
__host__ __device__ __forceinline__ void stage_rc(int b, int& R, int& C) { const int st = b / 1024, sb = b % 1024, swz = sb ^ (((sb >> 9) & 1) << 5); R = (st >> 1) * 16 + swz / 64; C = (st & 1) * 32 + (swz % 64) / 2; }
__host__ __device__ __forceinline__ int perm32(int rho) { const int n = rho >> 4, i = rho & 15; return 8 * (i >> 2) + 4 * n + (i & 3); }

struct Unit { int pm, pn; };
struct Gemm { const bf16_t* A; const bf16_t* Bt; int M, N, K; };

struct StaticOrder {
    int nM, nN, nwg, G, c;
    __host__ __device__ void init(int M, int N, int G_, int c_) { nM = M / BM; nN = N / BM; nwg = nM * nN; G = G_; c = c_; }
    __host__ __device__ bool next(int i, Unit& u) const {
        const long L = (long)i * G + c; if (L >= nwg) return false;
        int wgid = (int)L; { const int q = nwg / NXCD, r = nwg % NXCD, xcd = wgid % NXCD, off = wgid / NXCD; wgid = (xcd < r ? xcd * (q + 1) : r * (q + 1) + (xcd - r) * q) + off; }
        const int nig = WGM * nN, gid = wgid / nig, fm = gid * WGM, gsz = (nM - fm) < WGM ? (nM - fm) : WGM;
        u.pm = fm + ((wgid % nig) % gsz); u.pn = (wgid % nig) / gsz; return true;
    }
    __device__ __forceinline__ void a_ready(const Unit&) const {}
    __device__ __forceinline__ void done(const Unit&) const {}
};

__device__ __forceinline__ unsigned cvt_pk_bf16(float lo, float hi) { unsigned r; asm volatile("v_cvt_pk_bf16_f32 %0, %1, %2" : "=v"(r) : "v"(lo), "v"(hi)); return r; }
typedef float f32x2 __attribute__((ext_vector_type(2)));
typedef unsigned u32x2 __attribute__((ext_vector_type(2)));
__device__ __forceinline__ unsigned short f2bf1(float f) { unsigned u = __builtin_bit_cast(unsigned, f); return (unsigned short)((u + 0x7fffu + ((u >> 16) & 1u)) >> 16); }
struct EpiZ {
    static constexpr bool PERM = true, AFTER_DRAIN = false, MIDSCALE = false;
    bf16_t* Z; bf16_t* KSF; bf16_t* VSF; bf16_t* KWF; bf16_t* VWF; float* GATES; const float* bgate;
    __device__ __forceinline__ void operator()(const f32x4 (&acc)[2][2][4][2], const Unit& u, int wr, int wc, int fr, int fq) const {
        const int row0 = u.pm * BM + wr * 64 + fr;
        if (u.pn < 9) {
            const int col0 = u.pn * BM + wc * 32 + 8 * fq;
#pragma unroll
            for (int ai = 0; ai < 2; ++ai)
#pragma unroll
                for (int m = 0; m < 4; ++m) { bf16_t* rowp = Z + (size_t)(row0 + ai * HALF + m * 16) * 2304 + col0;
#pragma unroll
                    for (int bj = 0; bj < 2; ++bj) { const f32x4 v0 = acc[ai][bj][m][0], v1 = acc[ai][bj][m][1];
                        u32x4 w; w.x = cvt_pk_bf16(v0[0], v0[1]); w.y = cvt_pk_bf16(v0[2], v0[3]); w.z = cvt_pk_bf16(v1[0], v1[1]); w.w = cvt_pk_bf16(v1[2], v1[3]);
                        *(u32x4*)(rowp + bj * HALF) = w; } }
            if (u.pn >= 7) {
                bf16_t* KF = (u.pn == 7) ? KSF : KWF; bf16_t* VF = (u.pn == 7) ? VSF : VWF;
                const int kvh = wc >> 1, dbase = 32 * (wc & 1) + 8 * fq;
#pragma unroll
                for (int ai = 0; ai < 2; ++ai)
#pragma unroll
                    for (int m = 0; m < 4; ++m) { const int row = row0 + ai * HALF + m * 16, b = row >> 13, s = row & 8191, tile = s >> 5, k = s & 31;
                        const size_t tb = ((size_t)(b * 2 + kvh) * 256 + tile) * 2048;
                        { const f32x4 v0 = acc[ai][0][m][0], v1 = acc[ai][0][m][1];
                          u32x4 w; w.x = cvt_pk_bf16(v0[0], v0[1]); w.y = cvt_pk_bf16(v0[2], v0[3]); w.z = cvt_pk_bf16(v1[0], v1[1]); w.w = cvt_pk_bf16(v1[2], v1[3]);
                          *(u32x4*)(KF + tb + (dbase >> 4) * 512 + ((dbase >> 3) & 1) * 256 + k * 8) = w; }
                        const int kk = k & 15, vo = ((kk >> 2) & 1) * 512 + (k >> 4) * 8 + (kk & 3) + 4 * (kk >> 3);
                        unsigned char* V8 = (unsigned char*)VF + ((size_t)(b * 2 + kvh) * 256 + tile) * 2048;
#pragma unroll
                        for (int n = 0; n < 2; ++n) { const f32x4 v = acc[ai][1][m][n]; int w = 0; w = __builtin_amdgcn_cvt_pk_fp8_f32(v[0], v[1], w, false); w = __builtin_amdgcn_cvt_pk_fp8_f32(v[2], v[3], w, true);
#pragma unroll
                            for (int e = 0; e < 4; ++e) { const int d = dbase + 4 * n + e; V8[(d >> 5) * 1024 + (d & 31) * 16 + vo] = (unsigned char)((unsigned)w >> (8 * e)); } }
                        asm volatile("" ::: "memory"); }
            }
        } else {
            if (wc == 0 && fq < 3) {
#pragma unroll
                for (int ai = 0; ai < 2; ++ai)
#pragma unroll
                    for (int m = 0; m < 4; ++m) { const int row = row0 + ai * HALF + m * 16;
#pragma unroll
                        for (int n = 0; n < 2; ++n)
#pragma unroll
                            for (int e = 0; e < 4; ++e) { const int c = 8 * fq + 4 * n + e; const float v = acc[ai][0][m][n][e] + bgate[c]; GATES[(size_t)row * 24 + c] = 1.0f / (1.0f + __expf(-v)); } }
            }
        }
    }
};
struct EpiStore {
    static constexpr bool PERM = true, AFTER_DRAIN = false, MIDSCALE = false;
    bf16_t* O; int ldc; const float* ssq; int frag;
    __device__ __forceinline__ void operator()(const f32x4 (&acc)[2][2][4][2], const Unit& u, int wr, int wc, int fr, int fq) const {
        const int row0 = u.pm * BM + wr * 64 + fr; const int col0 = u.pn * BM + wc * 32 + 8 * fq;
#pragma unroll
        for (int ai = 0; ai < 2; ++ai)
#pragma unroll
            for (int m = 0; m < 4; ++m) { const int row = row0 + ai * HALF + m * 16;
                bf16_t* rowp = frag ? O + (size_t)(row >> 5) * 32 * ldc + (size_t)(col0 >> 4) * 512 + ((col0 >> 3) & 1) * 256 + (row & 31) * 8 : O + (size_t)row * ldc + col0;
                const int bjstep = frag ? (HALF >> 4) * 512 : HALF;
                float sc = 1.f;
                if (ssq) { const f32x4* p = (const f32x4*)(ssq + (size_t)row * 16); const f32x4 a = p[0], b = p[1], c = p[2], d = p[3];
                    const float s = ((a[0] + a[1]) + (a[2] + a[3])) + ((b[0] + b[1]) + (b[2] + b[3])) + ((c[0] + c[1]) + (c[2] + c[3])) + ((d[0] + d[1]) + (d[2] + d[3]));
                    sc = rsqrtf(s * (1.0f / 1024.0f) + 1e-6f); }
#pragma unroll
                for (int bj = 0; bj < 2; ++bj) { const f32x4 v0 = acc[ai][bj][m][0] * sc, v1 = acc[ai][bj][m][1] * sc;
                    u32x4 w; w.x = cvt_pk_bf16(v0[0], v0[1]); w.y = cvt_pk_bf16(v0[2], v0[3]); w.z = cvt_pk_bf16(v1[0], v1[1]); w.w = cvt_pk_bf16(v1[2], v1[3]);
                    *(u32x4*)(rowp + bj * bjstep) = w; } }
    }
};
struct EpiVFrag {
    static constexpr bool PERM = true, AFTER_DRAIN = false, MIDSCALE = false;
    bf16_t* O;
    __device__ __forceinline__ void operator()(const f32x4 (&acc)[2][2][4][2], const Unit& u, int wr, int wc, int fr, int fq) const {
        const int row0 = u.pm * BM + wr * 64 + fr; const int col0 = u.pn * BM + wc * 32 + 8 * fq;
#pragma unroll
        for (int ai = 0; ai < 2; ++ai)
#pragma unroll
            for (int m = 0; m < 4; ++m) { const int D = row0 + ai * HALF + m * 16, h = D >> 8, dt = (D >> 5) & 7, r = D & 31;
#pragma unroll
                for (int bj = 0; bj < 2; ++bj) { const int K0 = col0 + bj * HALF, b = K0 >> 8, kt = (K0 >> 5) & 7, k0 = K0 & 31;
                    bf16_t* p = O + (size_t)((b * 4 + h) * 8 + kt) * 8192 + dt * 1024 + (k0 >> 4) * 512 + r * 8 + 4 * ((k0 >> 3) & 1);
                    const f32x4 v0 = acc[ai][bj][m][0], v1 = acc[ai][bj][m][1];
                    u32x2 w0, w1; w0.x = cvt_pk_bf16(v0[0], v0[1]); w0.y = cvt_pk_bf16(v0[2], v0[3]); w1.x = cvt_pk_bf16(v1[0], v1[1]); w1.y = cvt_pk_bf16(v1[2], v1[3]);
                    *(u32x2*)p = w0; *(u32x2*)(p + 256) = w1; } }
    }
};
template <bool MID> struct EpiRes {
    static constexpr bool PERM = false, AFTER_DRAIN = false, MIDSCALE = MID;
    const float* base; const bf16_t* base16; float* out; bf16_t* XB; float* ssq; const float* ssqn;
    __device__ __forceinline__ void midscale(f32x4 (&acc)[2][2][4][2], const Unit& u, int wr, int wc, int fr, int fq) const {
        const int row0 = u.pm * BM + wr * 64 + fr;
#pragma unroll
        for (int ai = 0; ai < 2; ++ai)
#pragma unroll
            for (int m = 0; m < 4; ++m) { const int row = row0 + ai * HALF + m * 16; const f32x2 sq = *(const f32x2*)(ssqn + (size_t)row * 2);
                const float sc = rsqrtf((sq[0] + sq[1]) * (1.0f / 512.0f) + 1e-6f);
#pragma unroll
                for (int bj = 0; bj < 2; ++bj)
#pragma unroll
                    for (int n = 0; n < 2; ++n) acc[ai][bj][m][n] = acc[ai][bj][m][n] * sc; }
    }
    __device__ __forceinline__ void operator()(const f32x4 (&acc)[2][2][4][2], const Unit& u, int wr, int wc, int fr, int fq) const {
        const int row0 = u.pm * BM + wr * 64 + fr; const int col0 = u.pn * BM + wc * 32 + 4 * fq;
#pragma unroll
        for (int ai = 0; ai < 2; ++ai)
#pragma unroll
            for (int m = 0; m < 4; ++m) { const int row = row0 + ai * HALF + m * 16; const size_t off = (size_t)row * 1024 + col0; float s = 0.f;
#pragma unroll
                for (int bj = 0; bj < 2; ++bj)
#pragma unroll
                    for (int n = 0; n < 2; ++n) { f32x4 b;
                        if (base) b = *(const f32x4*)(base + off + bj * HALF + n * 16);
                        else { const u32x2 w = *(const u32x2*)(base16 + off + bj * HALF + n * 16); b[0] = __builtin_bit_cast(float, w.x << 16); b[1] = __builtin_bit_cast(float, w.x & 0xffff0000u); b[2] = __builtin_bit_cast(float, w.y << 16); b[3] = __builtin_bit_cast(float, w.y & 0xffff0000u); }
                        const f32x4 v = b + acc[ai][bj][m][n];
                        if (out) *(f32x4*)(out + off + bj * HALF + n * 16) = v;
                        s += (v[0] * v[0] + v[1] * v[1]) + (v[2] * v[2] + v[3] * v[3]);
                        u32x2 w; w.x = cvt_pk_bf16(v[0], v[1]); w.y = cvt_pk_bf16(v[2], v[3]); *(u32x2*)(XB + off + bj * HALF + n * 16) = w; }
                s += __shfl_xor(s, 16); s += __shfl_xor(s, 32);
                if (fq == 0) ssq[(size_t)row * 16 + u.pn * 4 + wc] = s;
                asm volatile("" ::: "memory"); }
    }
};
template <class Epi, class Sched, bool ALIGN_EPI = false, bool SP2 = false>
__device__ __forceinline__ void gemm_phase(PG8_LAS unsigned char* lds, const Gemm g, const Sched& S, const Epi& E, int wave  ) {
    int lane; asm volatile("v_mbcnt_lo_u32_b32 %0, -1, 0\n\tv_mbcnt_hi_u32_b32 %0, -1, %0" : "=v"(lane));
    const int wid = wave, tid = wid * 64 + lane, wr = wid >> 2, wc = wid & 3, fr = lane & 15, fq = lane >> 4;
    const int K = g.K, nt = K / BK;
    unsigned voffA[2], voffB[2];
#pragma unroll
    for (int i = 0; i < 2; ++i) { int R, C; stage_rc(tid * 16 + i * 8192, R, C); const int Rb = Epi::PERM ? ((R & ~31) + perm32(R & 31)) : R;
        voffA[i] = (unsigned)(R * K + C) * 2u; voffB[i] = (unsigned)(Rb * K + C) * 2u; }
    const size_t kstep = (size_t)(BK * 2);
    const size_t hstep = (size_t)HALF * K * 2;
    const size_t tstep = 2 * hstep;
    const unsigned ldsw = (unsigned)wid * 1024u;
    const int aoff = lds_byte(wr * 64 + fr, fq * 8), boff = lds_byte(wc * 32 + fr, fq * 8);
#define PG8_SA(b, h) (((b) * 2 + (h)) * HTB)
#define PG8_SB(b, h) ((4 + (b) * 2 + (h)) * HTB)
#define PG8_STAGE(bufoff, gbase, voff) do { _Pragma("unroll") for (int _i = 0; _i < 2; ++_i) \
        __builtin_amdgcn_global_load_lds((const unsigned*)((const char*)(gbase) + (voff)[_i]), (PG8_LAS unsigned*)(lds + (bufoff) + ldsw + _i * 8192), 16, 0, 0); } while (0)
#define PG8_LDA(dst, b, h) do { _Pragma("unroll") for (int m = 0; m < 4; ++m) _Pragma("unroll") for (int k = 0; k < 2; ++k) dst[m][k] = *(const PG8_LAS bf16x8*)(lds + PG8_SA(b, h) + aoff + m * 2048 + k * 1024); } while (0)
#define PG8_LDB(dst, b, h) do { _Pragma("unroll") for (int n = 0; n < 2; ++n) _Pragma("unroll") for (int k = 0; k < 2; ++k) dst[n][k] = *(const PG8_LAS bf16x8*)(lds + PG8_SB(b, h) + boff + n * 2048 + k * 1024); } while (0)
#define PG8_MMA(ai, bj, At, Bt) do { __builtin_amdgcn_s_setprio(1); _Pragma("unroll") for (int m = 0; m < 4; ++m) _Pragma("unroll") for (int n = 0; n < 2; ++n) _Pragma("unroll") for (int k = 0; k < 2; ++k) \
        acc[ai][bj][m][n] = __builtin_amdgcn_mfma_f32_16x16x32_bf16(Bt[n][k], At[m][k], acc[ai][bj][m][n], 0, 0, 0); __builtin_amdgcn_s_setprio(0); } while (0)
#define PG8_WAIT_V(n) asm volatile("s_waitcnt vmcnt(" #n ")" ::: "memory")
#define PG8_WAIT_L(n) asm volatile("s_waitcnt lgkmcnt(" #n ")" ::: "memory")
#define PG8_BAR __builtin_amdgcn_s_barrier()
#define PG8_SCHED __builtin_amdgcn_sched_barrier(0)
    Unit cur, nxt; int ui = 0;
    if (!S.next(0, cur)) return;
    f32x4 acc[2][2][4][2];
#pragma unroll
    for (int a = 0; a < 2; ++a)
#pragma unroll
        for (int b = 0; b < 2; ++b)
#pragma unroll
            for (int m = 0; m < 4; ++m)
#pragma unroll
                for (int n = 0; n < 2; ++n) acc[a][b][m][n] = (f32x4){0.f, 0.f, 0.f, 0.f};
    bf16x8 At[4][2], B0[2][2], B1[2][2];
    const char* cA = (const char*)g.A + (size_t)cur.pm * tstep; const char* cB = (const char*)g.Bt + (size_t)cur.pn * tstep;
    S.a_ready(cur);
    if constexpr (SP2) {
        PG8_STAGE(PG8_SB(0, 0), cB, voffB); PG8_STAGE(PG8_SB(0, 1), cB + hstep, voffB); PG8_STAGE(PG8_SA(0, 0), cA, voffA); PG8_STAGE(PG8_SA(0, 1), cA + hstep, voffA);
        if (wr == 1) PG8_BAR;
        PG8_WAIT_V(2); PG8_BAR;
        PG8_STAGE(PG8_SB(1, 0), cB + kstep, voffB); PG8_STAGE(PG8_SA(1, 0), cA + kstep, voffA); PG8_STAGE(PG8_SB(1, 1), cB + hstep + kstep, voffB);
        PG8_WAIT_V(6); PG8_BAR;
    } else {
        PG8_STAGE(PG8_SB(0, 0), cB, voffB); PG8_STAGE(PG8_SA(0, 0), cA, voffA); PG8_STAGE(PG8_SB(0, 1), cB + hstep, voffB); PG8_STAGE(PG8_SA(0, 1), cA + hstep, voffA);
        if (wr == 1) PG8_BAR;
        PG8_WAIT_V(4); PG8_BAR;
        PG8_STAGE(PG8_SB(1, 0), cB + kstep, voffB); PG8_STAGE(PG8_SA(1, 0), cA + kstep, voffA); PG8_STAGE(PG8_SB(1, 1), cB + hstep + kstep, voffB);
        PG8_WAIT_V(6); PG8_BAR;
    }
    for (;;) {
        const bool has_next = S.next(ui + 1, nxt);
        const char* nA = has_next ? (const char*)g.A + (size_t)nxt.pm * tstep : cA; const char* nB = has_next ? (const char*)g.Bt + (size_t)nxt.pn * tstep : cB;
        for (int t = 0; t < nt; t += 2) {
            if constexpr (Epi::MIDSCALE) { if (t == nt / 2) E.midscale(acc, cur, wr, wc, fr, fq); }
            const bool last = (t == nt - 2);
            const char* a1 = cA + (size_t)(t + 1) * kstep;
            const char* a2 = last ? nA : cA + (size_t)(t + 2) * kstep; const char* b2 = last ? nB : cB + (size_t)(t + 2) * kstep;
            const char* a3 = a2 + kstep; const char* b3 = b2 + kstep;
            if (last && has_next) S.a_ready(nxt);
            if constexpr (SP2) {
            PG8_LDB(B0, 0, 0); PG8_LDB(B1, 0, 1); PG8_SCHED; PG8_LDA(At, 0, 0); PG8_STAGE(PG8_SA(1, 1), a1 + hstep, voffA);
            PG8_WAIT_V(8); PG8_WAIT_L(0); PG8_BAR; PG8_MMA(0, 0, At, B0); PG8_MMA(0, 1, At, B1); PG8_BAR; PG8_SCHED;
            PG8_LDA(At, 0, 1); PG8_STAGE(PG8_SB(0, 0), b2, voffB); PG8_STAGE(PG8_SB(0, 1), b2 + hstep, voffB); PG8_STAGE(PG8_SA(0, 0), a2, voffA);
            PG8_WAIT_V(8); PG8_WAIT_L(0); PG8_BAR; PG8_MMA(1, 0, At, B0); PG8_MMA(1, 1, At, B1); PG8_BAR; PG8_SCHED;
            PG8_LDB(B0, 1, 0); PG8_LDB(B1, 1, 1); PG8_SCHED; PG8_LDA(At, 1, 0); PG8_STAGE(PG8_SA(0, 1), a2 + hstep, voffA);
            PG8_WAIT_V(8); PG8_WAIT_L(0); PG8_BAR; PG8_MMA(0, 0, At, B0); PG8_MMA(0, 1, At, B1); PG8_BAR; PG8_SCHED;
            PG8_LDA(At, 1, 1); PG8_STAGE(PG8_SB(1, 0), b3, voffB); PG8_STAGE(PG8_SB(1, 1), b3 + hstep, voffB); PG8_STAGE(PG8_SA(1, 0), a3, voffA);
            PG8_WAIT_V(8); PG8_WAIT_L(0); PG8_BAR; PG8_MMA(1, 0, At, B0); PG8_MMA(1, 1, At, B1); PG8_BAR; PG8_SCHED;
            } else {
            PG8_LDB(B0, 0, 0); PG8_SCHED; PG8_LDA(At, 0, 0); PG8_STAGE(PG8_SA(1, 1), a1 + hstep, voffA);
            PG8_WAIT_L(8); PG8_BAR; PG8_WAIT_L(0); PG8_MMA(0, 0, At, B0); PG8_BAR; PG8_SCHED;
            PG8_LDB(B1, 0, 1); PG8_STAGE(PG8_SB(0, 0), b2, voffB);
            PG8_BAR; PG8_WAIT_L(0); PG8_MMA(0, 1, At, B1); PG8_BAR;
            PG8_LDA(At, 0, 1); PG8_STAGE(PG8_SA(0, 0), a2, voffA);
            PG8_BAR; PG8_WAIT_L(0); PG8_MMA(1, 0, At, B0); PG8_BAR; PG8_SCHED;
            PG8_STAGE(PG8_SB(0, 1), b2 + hstep, voffB);
            PG8_WAIT_V(6); PG8_BAR; PG8_MMA(1, 1, At, B1); PG8_BAR;
            PG8_LDB(B0, 1, 0); PG8_SCHED; PG8_LDA(At, 1, 0); PG8_STAGE(PG8_SA(0, 1), a2 + hstep, voffA);
            PG8_WAIT_L(8); PG8_BAR; PG8_WAIT_L(0); PG8_MMA(0, 0, At, B0); PG8_BAR; PG8_SCHED;
            PG8_LDB(B1, 1, 1); PG8_STAGE(PG8_SB(1, 0), b3, voffB);
            PG8_BAR; PG8_WAIT_L(0); PG8_MMA(0, 1, At, B1); PG8_BAR;
            PG8_LDA(At, 1, 1); PG8_STAGE(PG8_SA(1, 0), a3, voffA);
            PG8_BAR; PG8_WAIT_L(0); PG8_MMA(1, 0, At, B0); PG8_BAR; PG8_SCHED;
            PG8_STAGE(PG8_SB(1, 1), b3 + hstep, voffB);
            PG8_WAIT_V(6); PG8_BAR; PG8_MMA(1, 1, At, B1); PG8_BAR;
            }
        }
        if constexpr (ALIGN_EPI) { if (wr == 0) PG8_BAR; }
        if constexpr (!Epi::AFTER_DRAIN) { E(acc, cur, wr, wc, fr, fq); S.done(cur); }
        if (!has_next) break;
#pragma unroll
        for (int a = 0; a < 2; ++a)
#pragma unroll
            for (int b = 0; b < 2; ++b)
#pragma unroll
                for (int m = 0; m < 4; ++m)
#pragma unroll
                    for (int n = 0; n < 2; ++n) acc[a][b][m][n] = (f32x4){0.f, 0.f, 0.f, 0.f};
        cur = nxt; cA = nA; cB = nB; ++ui;
        if constexpr (ALIGN_EPI) { if (wr == 1) PG8_BAR; }
    }
    PG8_WAIT_V(0);
    if constexpr (!ALIGN_EPI) { if (wr == 0) PG8_BAR; }
    PG8_BAR;
    if constexpr (Epi::AFTER_DRAIN) { E.fused(acc, cur, wr, wc, fr, fq, lds, wid, lane); S.done(cur); }
#undef PG8_SA
#undef PG8_SB
#undef PG8_STAGE
#undef PG8_LDA
#undef PG8_LDB
#undef PG8_MMA
#undef PG8_WAIT_V
#undef PG8_WAIT_L
#undef PG8_BAR
#undef PG8_SCHED
}
}

constexpr int NB = 2, SEQ = 8192, DM = 1024, MTOK = NB * SEQ;
constexpr int NZ = 2304, NZP = 2560;
constexpr int NMEM = 256;
constexpr float EPS = 1e-6f;
constexpr float QSCALE = 0.125f * 1.4426950408889634f;
constexpr int ZC_XL = 0, ZC_GT = 512, ZC_Q = 1024, ZC_KC = 1536, ZC_VC = 1664, ZC_KS = 1792, ZC_VS = 1920, ZC_KW = 2048, ZC_VW = 2176, ZC_G = 2304;

constexpr size_t MiB = 1u << 20;
constexpr size_t WS_CTL = 0;
constexpr size_t WS_WIN = 1 * MiB, WS_WOUT = 6 * MiB, WS_WMQ = 8 * MiB, WS_WMK = 10 * MiB, WS_WMV = 12 * MiB, WS_WMO = 14 * MiB, WS_WPQ = 16 * MiB;
constexpr size_t WS_SKEY = 20 * MiB;
constexpr size_t WS_CW1T = WS_SKEY + 512 * 1024;
constexpr size_t WS_CW2T = WS_CW1T + 512 * 1024;
constexpr size_t WS_C1 = WS_CW2T + 16 * 1024;
constexpr size_t WS_WRGT = WS_C1 + 16 * 1024;
constexpr size_t WS_MEMN = 22 * MiB, WS_MEMK = 23 * MiB, WS_MEMVT = 24 * MiB;
constexpr size_t WS_KC = 26 * MiB;
constexpr size_t WS_VCT = WS_KC + 256 * 1024;
constexpr size_t WS_SUMM = 27 * MiB;
constexpr size_t WS_SSQ1 = 28 * MiB, WS_SSQ2 = 29 * MiB;
constexpr size_t WS_GATES = 30 * MiB;
constexpr size_t WS_SSQN = 31 * MiB + 512 * 1024;
constexpr size_t WS_U8 = 32 * MiB, WS_V8 = 48 * MiB;
constexpr size_t WS_SU = 64 * MiB, WS_SV = 64 * MiB + 65536;
constexpr size_t WS_SSQ3 = 65 * MiB;
constexpr size_t WS_W = 66 * MiB;
constexpr size_t WS_PART = 128 * MiB;
constexpr size_t WS_XN = 96 * MiB;
constexpr size_t WS_Z = 128 * MiB;
constexpr size_t WS_KSF = 240 * MiB, WS_VSF = 244 * MiB, WS_KWF = 248 * MiB, WS_VWF = 252 * MiB;
constexpr size_t WS_QM = 128 * MiB, WS_OM = 160 * MiB;
constexpr size_t WS_QP = 128 * MiB;
constexpr size_t WS_Y = 208 * MiB;
constexpr size_t WS_EID = 208 * MiB, WS_GW = 216 * MiB;
constexpr size_t WS_END = 256 * MiB;

constexpr int CW_KMAX = 12288;
constexpr int LDS_BYTES = 147456;

#define GAS __attribute__((address_space(1)))
#define LAS __attribute__((address_space(3)))
typedef unsigned short bf16;
typedef unsigned v4u __attribute__((ext_vector_type(4)));
typedef unsigned v2u __attribute__((ext_vector_type(2)));
typedef float f32x4 __attribute__((ext_vector_type(4)));
typedef float f32x16 __attribute__((ext_vector_type(16)));
typedef short bf16x8 __attribute__((ext_vector_type(8)));
typedef short bf16x4 __attribute__((ext_vector_type(4)));
__device__ __forceinline__ unsigned f2bf(float f) { unsigned u = __builtin_bit_cast(unsigned, f); return (u + 0x7fffu + ((u >> 16) & 1u)) >> 16; }
typedef float f32x2_ __attribute__((ext_vector_type(2))); typedef __bf16 bf16x2_ __attribute__((ext_vector_type(2)));
__device__ __forceinline__ unsigned pk2(float lo, float hi) { f32x2_ v = {lo, hi}; bf16x2_ b = __builtin_convertvector(v, bf16x2_); return __builtin_bit_cast(unsigned, b); }
__device__ __forceinline__ float bf2f(unsigned short h) { return __builtin_bit_cast(float, (unsigned)h << 16); }
__device__ __forceinline__ float bflo(unsigned w) { return __builtin_bit_cast(float, w << 16); }
__device__ __forceinline__ float bfhi(unsigned w) { return __builtin_bit_cast(float, w & 0xffff0000u); }
__device__ __forceinline__ void swap32(unsigned& a, unsigned& b) { asm("s_nop 1\n\tv_permlane32_swap_b32 %0, %1" : "+v"(a), "+v"(b)); }
__device__ __forceinline__ int maxswap32_i(int v) { unsigned a = (unsigned)v, b = (unsigned)v; swap32(a, b); return max((int)a, (int)b); }
__device__ __forceinline__ float maxswap32_f(float v) { unsigned a = __builtin_bit_cast(unsigned, v), b = a; swap32(a, b); return fmaxf(__builtin_bit_cast(float, a), __builtin_bit_cast(float, b)); }
__device__ __forceinline__ float addswap32_f(float v) { unsigned a = __builtin_bit_cast(unsigned, v), b = a; swap32(a, b); return __builtin_bit_cast(float, a) + __builtin_bit_cast(float, b); }
__device__ __forceinline__ float wave_sum(float v) {
#pragma unroll
    for (int o = 1; o < 64; o <<= 1) v += __shfl_xor(v, o);
    return v;
}

struct Args { const float* in[33]; float* out; unsigned char* ws; int ph_lo, ph_hi; };

struct Frame {
    int tid, lane, wave, vcu, G, gw, NGW;
};
__device__ __forceinline__ int lane_id() { int l; asm volatile("v_mbcnt_lo_u32_b32 %0, -1, 0\n\tv_mbcnt_hi_u32_b32 %0, -1, %0" : "=v"(l)); return l; }
#define REFRESH_LANE(F) do { (F).lane = lane_id(); (F).tid = (F).wave * 64 + (F).lane; } while (0)

__device__ __forceinline__ void transpose_item(const float* W, int K, int N, bf16* WT, int ldt, int row_off, const float* gain, int slo, int shi, float cs, LAS float* scr, int item, int lane, int kxor = 0) {
    const int nblk = (N + 31) / 32, kb = item / nblk, nb = item % nblk, k0 = 64 * kb, n0 = 32 * nb;
#pragma unroll 16
    for (int i = 0; i < 32; ++i) { const int kk = 2 * i + (lane >> 5), n = n0 + (lane & 31);
        float v = (n < N) ? __builtin_nontemporal_load(W + (size_t)(k0 + kk) * N + n) : 0.f; if (gain) v *= gain[k0 + kk]; if (n >= slo && n < shi) v *= cs;
        scr[kk * 33 + (lane & 31)] = v; }
    asm volatile("s_waitcnt lgkmcnt(0)" ::: "memory");
    const int c = lane & 7;
#pragma unroll
    for (int j = 0; j < 4; ++j) { const int n = (lane >> 3) + 8 * j; const LAS float* s = scr + (8 * c) * 33 + n;
        v4u o; o.x = pk2(s[0 * 33], s[1 * 33]); o.y = pk2(s[2 * 33], s[3 * 33]); o.z = pk2(s[4 * 33], s[5 * 33]); o.w = pk2(s[6 * 33], s[7 * 33]);
        *(v4u*)(WT + (size_t)(row_off + n0 + n) * ldt + (k0 ^ kxor) + 8 * c) = o; }
    asm volatile("s_waitcnt lgkmcnt(0)" ::: "memory");
}
__device__ __forceinline__ void rms_row_to_bf16(const float* xrow, bf16* orow, int lane) {
    const f32x4* xr = (const f32x4*)xrow + lane;
    f32x4 v[4]; float s = 0.f;
#pragma unroll
    for (int j = 0; j < 4; ++j) { v[j] = xr[64 * j]; s += (v[j].x * v[j].x + v[j].y * v[j].y) + (v[j].z * v[j].z + v[j].w * v[j].w); }
    const float rstd = rsqrtf(wave_sum(s) * (1.f / DM) + EPS);
    unsigned long long* o8 = (unsigned long long*)orow + lane;
#pragma unroll
    for (int j = 0; j < 4; ++j) o8[64 * j] = (unsigned long long)pk2(v[j].x * rstd, v[j].y * rstd) | ((unsigned long long)pk2(v[j].z * rstd, v[j].w * rstd) << 32);
}
__device__ __forceinline__ void quant_row_fp8(const float* src, const float* gain, unsigned char* dst, float* scale_out, int lane) {
    const f32x4* p = (const f32x4*)src + 4 * lane; f32x4 v[4]; float am = 0.f;
#pragma unroll
    for (int j = 0; j < 4; ++j) { v[j] = p[j]; if (gain) v[j] = v[j] * ((const f32x4*)gain)[4 * lane + j]; am = fmaxf(am, fmaxf(fmaxf(fabsf(v[j].x), fabsf(v[j].y)), fmaxf(fabsf(v[j].z), fabsf(v[j].w)))); }
#pragma unroll
    for (int o = 1; o < 64; o <<= 1) am = fmaxf(am, __shfl_xor(am, o));
    const float inv = am > 0.f ? 448.0f / am : 0.f;
    v4u o4;
#pragma unroll
    for (int j = 0; j < 4; ++j) { int w = 0; w = __builtin_amdgcn_cvt_pk_fp8_f32(v[j].x * inv, v[j].y * inv, w, false); w = __builtin_amdgcn_cvt_pk_fp8_f32(v[j].z * inv, v[j].w * inv, w, true); o4[j] = (unsigned)w; }
    *(v4u*)(dst + (size_t)(lane >> 3) * 16384 * 128 + (lane & 7) * 16) = o4;
    if (lane == 0) *scale_out = am * (1.0f / 448.0f);
}
__device__ __forceinline__ void rms_rows4_to_bf16(const float* x0, bf16* o0, size_t rstride  , int lane) {
    f32x4 v[4][4]; float s[4];
#pragma unroll
    for (int r = 0; r < 4; ++r)
#pragma unroll
        for (int j = 0; j < 4; ++j) v[r][j] = __builtin_nontemporal_load((const f32x4*)(x0 + r * rstride) + lane + 64 * j);
#pragma unroll
    for (int r = 0; r < 4; ++r) { s[r] = 0.f;
#pragma unroll
        for (int j = 0; j < 4; ++j) s[r] += (v[r][j].x * v[r][j].x + v[r][j].y * v[r][j].y) + (v[r][j].z * v[r][j].z + v[r][j].w * v[r][j].w); }
#pragma unroll
    for (int o = 1; o < 64; o <<= 1)
#pragma unroll
        for (int r = 0; r < 4; ++r) s[r] += __shfl_xor(s[r], o);
#pragma unroll
    for (int r = 0; r < 4; ++r) { const float rstd = rsqrtf(s[r] * (1.f / DM) + EPS); unsigned long long* o8 = (unsigned long long*)(o0 + r * rstride) + lane;
#pragma unroll
        for (int j = 0; j < 4; ++j) o8[64 * j] = (unsigned long long)pk2(v[r][j].x * rstd, v[r][j].y * rstd) | ((unsigned long long)pk2(v[r][j].z * rstd, v[r][j].w * rstd) << 32); }
}
__device__ __forceinline__ void quant_rows4_fp8(const float* src0, size_t rstride, const float* gain, unsigned char* dst0, float* scale0, int sstride, int lane) {
    f32x4 v[4][4]; float am[4];
#pragma unroll
    for (int r = 0; r < 4; ++r)
#pragma unroll
        for (int j = 0; j < 4; ++j) v[r][j] = __builtin_nontemporal_load((const f32x4*)(src0 + r * rstride) + 4 * lane + j);
    if (gain) {
#pragma unroll
        for (int j = 0; j < 4; ++j) { const f32x4 g = ((const f32x4*)gain)[4 * lane + j];
#pragma unroll
            for (int r = 0; r < 4; ++r) v[r][j] = v[r][j] * g; } }
#pragma unroll
    for (int r = 0; r < 4; ++r) { am[r] = 0.f;
#pragma unroll
        for (int j = 0; j < 4; ++j) am[r] = fmaxf(am[r], fmaxf(fmaxf(fabsf(v[r][j].x), fabsf(v[r][j].y)), fmaxf(fabsf(v[r][j].z), fabsf(v[r][j].w)))); }
#pragma unroll
    for (int o = 1; o < 64; o <<= 1)
#pragma unroll
        for (int r = 0; r < 4; ++r) am[r] = fmaxf(am[r], __shfl_xor(am[r], o));
#pragma unroll
    for (int r = 0; r < 4; ++r) { const float inv = am[r] > 0.f ? 448.0f / am[r] : 0.f; v4u o4;
#pragma unroll
        for (int j = 0; j < 4; ++j) { int w = 0; w = __builtin_amdgcn_cvt_pk_fp8_f32(v[r][j].x * inv, v[r][j].y * inv, w, false); w = __builtin_amdgcn_cvt_pk_fp8_f32(v[r][j].z * inv, v[r][j].w * inv, w, true); o4[j] = (unsigned)w; }
        __builtin_nontemporal_store(o4, (v4u*)(dst0 + (size_t)r * sstride * 128 + (size_t)(lane >> 3) * 16384 * 128 + (lane & 7) * 16));
        if (lane == 0) scale0[r * sstride] = am[r] * (1.0f / 448.0f); }
}
__device__ __forceinline__ void p0_prologue(const Frame& F, const Args& A, LAS unsigned char* lds) {
    unsigned char* ws = A.ws;
    LAS float* scr = (LAS float*)(lds + F.wave * 16384);
    const float* const* in = A.in;
    const int gw = F.gw, NGW = F.NGW;
    constexpr int I_IN = 16 * 73, I_SQ = 16 * 32, I_PQ = 16 * 64, I_C1 = 64, I_C2 = 2, I_RG = 2;
    constexpr int E_IN = I_IN, E_OUT = E_IN + I_SQ, E_MQ = E_OUT + I_SQ, E_MK = E_MQ + I_SQ, E_MV = E_MK + I_SQ, E_MO = E_MV + I_SQ, E_PQ = E_MO + I_PQ, E_C1 = E_PQ + 2 * I_C1, E_C2 = E_C1 + 2 * I_C2, E_RG = E_C2 + 16 * I_RG;
    for (int it = gw; it < E_RG; it += NGW) {
        if (it < E_IN) transpose_item(in[3], 1024, 2328, (bf16*)(ws + WS_WIN), 1024, 0, in[2], ZC_Q, ZC_KC, QSCALE, scr, it, F.lane);
        else if (it < E_OUT) { const int j = it - E_IN, kb = j / 32; transpose_item(in[20], 1024, 1024, (bf16*)(ws + WS_WOUT), 1024, 0, (kb < 8 ? in[18] : in[19] - 512), 0, 0, 1.f, scr, j, F.lane, 512); }
        else if (it < E_MQ) transpose_item(in[23], 1024, 1024, (bf16*)(ws + WS_WMQ), 1024, 0, in[21], 0, 1024, 0.0625f * 1.4426950408889634f, scr, it - E_OUT, F.lane);
        else if (it < E_MK) transpose_item(in[24], 1024, 1024, (bf16*)(ws + WS_WMK), 1024, 0, in[22], 0, 0, 1.f, scr, it - E_MQ, F.lane);
        else if (it < E_MV) transpose_item(in[25], 1024, 1024, (bf16*)(ws + WS_WMV), 1024, 0, in[22], 0, 0, 1.f, scr, it - E_MK, F.lane);
        else if (it < E_MO) transpose_item(in[26], 1024, 1024, (bf16*)(ws + WS_WMO), 1024, 0, nullptr, 0, 0, 1.f, scr, it - E_MV, F.lane);
        else if (it < E_PQ) transpose_item(in[28], 1024, 2048, (bf16*)(ws + WS_WPQ), 1024, 0, in[27], 0, 0, 1.f, scr, it - E_MO, F.lane);
        else if (it < E_C1) { const int j = it - E_PQ, kv = j / I_C1; transpose_item(in[kv ? 16 : 13], 2048, 64, (bf16*)(ws + WS_CW1T) + (size_t)kv * 64 * 2048, 2048, 0, nullptr, 0, 0, 1.f, scr, j % I_C1, F.lane); }
        else if (it < E_C2) { const int j = it - E_C1, kv = j / I_C2; transpose_item(in[kv ? 17 : 14], 64, 64, (bf16*)(ws + WS_CW2T) + (size_t)kv * 64 * 64, 64, 0, nullptr, 0, 0, 1.f, scr, j % I_C2, F.lane); }
        else { const int j = it - E_C2, ai = j / 16, h = (j / 2) % 8; transpose_item(in[ai ? 9 : 7] + (size_t)h * 4096, 64, 64, (bf16*)(ws + WS_WRGT) + (size_t)(ai * 8 + h) * 4096, 64, 0, nullptr, 0, 0, 1.f, scr, j % 2, F.lane); }
    }
    for (int i = gw * 64 + F.lane; i < (2560 - 2336) * 1024 / 8; i += NGW * 64) ((v4u*)((bf16*)(ws + WS_WIN) + (size_t)2336 * 1024))[i] = (v4u){0u, 0u, 0u, 0u};
    for (int it = NGW - 1 - gw; it < 32; it += NGW) { const int kv = it >> 4, ch = it & 15; const float* pos = in[kv ? 15 : 12] + 128 * ch; const float* w1 = in[kv ? 16 : 13] + (size_t)128 * ch * 64 + F.lane; float s = 0.f;
#pragma unroll 16
        for (int k = 0; k < 128; ++k) s += pos[k] * w1[(size_t)k * 64];
        ((float*)(ws + WS_C1))[it * 64 + F.lane] = s; }
    { const size_t i0 = (size_t)gw * 64 + F.lane, st = (size_t)NGW * 64;
      const int nrows0 = (F.G == 256) ? 16384 : 32768;
      for (int r = gw; r < nrows0; r += 4 * NGW) { const int tb = r >> 14, e = r & 16383;
          if ((16384 % (4 * NGW)) == 0) quant_rows4_fp8(in[30 + tb] + (size_t)e * DM, (size_t)NGW * DM, tb ? nullptr : in[27], ws + (tb ? WS_V8 : WS_U8) + (size_t)e * 128, (float*)(ws + (tb ? WS_SV : WS_SU)) + e, NGW, F.lane);
          else for (int q = 0; q < 4; ++q) { const int rr = r + q * NGW; if (rr < 32768) { const int t2 = rr >> 14, e2 = rr & 16383; quant_row_fp8(in[30 + t2] + (size_t)e2 * DM, t2 ? nullptr : in[27], ws + (t2 ? WS_V8 : WS_U8) + (size_t)e2 * 128, (float*)(ws + (t2 ? WS_SV : WS_SU)) + e2, F.lane); } } }
      for (size_t i = i0; i < (size_t)8 * 2 * 128 * 128 / 8; i += st) { const f32x4 a = ((const f32x4*)in[29])[2 * i], bq = ((const f32x4*)in[29])[2 * i + 1];
          v4u o; o.x = pk2(a.x, a.y); o.y = pk2(a.z, a.w); o.z = pk2(bq.x, bq.y); o.w = pk2(bq.z, bq.w);
          const size_t R = i >> 4, d0 = (i & 15) * 8;
          *(v4u*)((bf16*)(ws + WS_SKEY) + (R >> 5) * 4096 + (d0 >> 4) * 512 + ((d0 >> 3) & 1) * 256 + (R & 31) * 8) = o; } }
    if ((MTOK % (4 * NGW)) == 0) for (int m = gw; m < MTOK; m += 4 * NGW) rms_rows4_to_bf16(in[0] + (size_t)m * DM, (bf16*)(ws + WS_XN) + (size_t)m * DM, (size_t)NGW * DM, F.lane);
    else for (int m = gw; m < MTOK; m += NGW) rms_row_to_bf16(in[0] + (size_t)m * DM, (bf16*)(ws + WS_XN) + (size_t)m * DM, F.lane);
    for (int m = gw; m < NB * NMEM; m += NGW) rms_row_to_bf16(in[1] + (size_t)m * DM, (bf16*)(ws + WS_MEMN) + (size_t)m * DM, F.lane);
}

__device__ __forceinline__ int crow(int r, int hi) { return (r & 3) + 8 * (r >> 2) + 4 * hi; }
__device__ __forceinline__ float gelu_tanh(float x) {
    const float u = 0.7978845608028654f * (x + 0.044715f * x * x * x);
    const float t = 1.0f - 2.0f * __builtin_amdgcn_rcpf(__builtin_amdgcn_exp2f(2.0f * 1.4426950408889634f * u) + 1.0f);
    return 0.5f * x * (1.0f + t);
}
constexpr int XC_LD = 520;
__device__ __forceinline__ void lru_local_item(const Frame& F, const Args& A, LAS unsigned char* lds, int item) {
    unsigned char* ws = A.ws;
    const bf16* Z = (const bf16*)(ws + WS_Z);
    const int b = item >> 7, chunk = item & 127, s0 = chunk * 64; const size_t row0 = (size_t)b * SEQ + s0;
    LAS bf16* xcs = (LAS bf16*)lds;
    {
        const int c8 = F.tid & 63, tg = F.tid >> 6, c0 = 8 * c8;
        v4u xr[11];
#pragma unroll
        for (int r = 0; r < 11; ++r) { const long tok = (long)(8 * tg + r) - 3;
            if (s0 == 0 && tok < 0) xr[r] = (v4u){0u, 0u, 0u, 0u}; else xr[r] = *(const v4u*)(Z + (size_t)((long)row0 + tok) * NZ + c0); }
        const float* cw = A.in[5]; float w0[8], w1[8], w2[8], w3[8], cb[8];
#pragma unroll
        for (int j = 0; j < 2; ++j) { const f32x4 a = *(const f32x4*)(cw + c0 + 4 * j), b = *(const f32x4*)(cw + 512 + c0 + 4 * j), c = *(const f32x4*)(cw + 1024 + c0 + 4 * j), d = *(const f32x4*)(cw + 1536 + c0 + 4 * j), e2 = *(const f32x4*)(A.in[6] + c0 + 4 * j);
#pragma unroll
            for (int k = 0; k < 4; ++k) { w0[4 * j + k] = a[k]; w1[4 * j + k] = b[k]; w2[4 * j + k] = c[k]; w3[4 * j + k] = d[k]; cb[4 * j + k] = e2[k]; } }
#pragma unroll
        for (int tt = 0; tt < 8; ++tt) { float o[8];
#pragma unroll
            for (int q = 0; q < 4; ++q) { const unsigned a = xr[tt][q], b = xr[tt + 1][q], c = xr[tt + 2][q], d = xr[tt + 3][q];
                o[2 * q] = cb[2 * q] + w0[2 * q] * bflo(a) + w1[2 * q] * bflo(b) + w2[2 * q] * bflo(c) + w3[2 * q] * bflo(d);
                o[2 * q + 1] = cb[2 * q + 1] + w0[2 * q + 1] * bfhi(a) + w1[2 * q + 1] * bfhi(b) + w2[2 * q + 1] * bfhi(c) + w3[2 * q + 1] * bfhi(d); }
            v4u ov; ov.x = pk2(o[0], o[1]); ov.y = pk2(o[2], o[3]); ov.z = pk2(o[4], o[5]); ov.w = pk2(o[6], o[7]);
            *(LAS v4u*)(xcs + (8 * tg + tt) * XC_LD + c0) = ov; }
    }
    __syncthreads();
    const int h = F.wave, lane = F.lane, r32 = lane & 31, hi = lane >> 5;
    bf16x8 af[2][4];
#pragma unroll
    for (int tt = 0; tt < 2; ++tt)
#pragma unroll
        for (int ks = 0; ks < 4; ++ks) af[tt][ks] = *(const LAS bf16x8*)(xcs + (32 * tt + r32) * XC_LD + 64 * h + 16 * ks + 8 * hi);
    const bf16* WT = (const bf16*)(ws + WS_WRGT);
    float* SUMM = (float*)(ws + WS_SUMM);
    unsigned* HA = (unsigned*)A.out;
#pragma unroll 1
    for (int ct = 0; ct < 2; ++ct) {
        const int c = 64 * h + 32 * ct + r32;
        f32x16 ga[2], gi[2];
#pragma unroll
        for (int tt = 0; tt < 2; ++tt) { ga[tt] = f32x16{}; gi[tt] = f32x16{}; }
#pragma unroll
        for (int ks = 0; ks < 4; ++ks) {
            const bf16x8 ba = *(const bf16x8*)(WT + (size_t)(0 * 8 + h) * 4096 + (32 * ct + r32) * 64 + 16 * ks + 8 * hi);
            const bf16x8 bi = *(const bf16x8*)(WT + (size_t)(1 * 8 + h) * 4096 + (32 * ct + r32) * 64 + 16 * ks + 8 * hi);
#pragma unroll
            for (int tt = 0; tt < 2; ++tt) { ga[tt] = __builtin_amdgcn_mfma_f32_32x32x16_bf16(af[tt][ks], ba, ga[tt], 0, 0, 0); gi[tt] = __builtin_amdgcn_mfma_f32_32x32x16_bf16(af[tt][ks], bi, gi[tt], 0, 0, 0); }
        }
        const float ba_ = A.in[8][c], bi_ = A.in[10][c], lam = A.in[11][c];
        const float sp = (lam > 15.f) ? __expf(-lam) : log1pf(__expf(-lam));
#pragma unroll
        for (int tt = 0; tt < 2; ++tt)
#pragma unroll
            for (int r = 0; r < 16; ++r) { const int t = 32 * tt + crow(r, hi);
                const float rr = __builtin_amdgcn_rcpf(1.0f + __builtin_amdgcn_exp2f(-1.4426950408889634f * (ga[tt][r] + ba_))), ii = __builtin_amdgcn_rcpf(1.0f + __builtin_amdgcn_exp2f(-1.4426950408889634f * (gi[tt][r] + bi_)));
                const float a = __builtin_amdgcn_exp2f(-8.0f * 1.4426950408889634f * rr * sp);
                const float xcv = bf2f(xcs[t * XC_LD + c]);
                const float bb = __builtin_amdgcn_sqrtf(fmaxf(1.0f - a * a, 0.f)) * (ii * xcv);
                ga[tt][r] = a; gi[tt][r] = bb; }
        float SA[8], SB[8];
#pragma unroll
        for (int tt = 0; tt < 2; ++tt)
#pragma unroll
            for (int q = 0; q < 4; ++q) {
#pragma unroll
                for (int k = 1; k < 4; ++k) { const int r = 4 * q + k; gi[tt][r] = ga[tt][r] * gi[tt][r - 1] + gi[tt][r]; ga[tt][r] = ga[tt][r] * ga[tt][r - 1]; }
                SA[tt * 4 + q] = ga[tt][4 * q + 3]; SB[tt * 4 + q] = gi[tt][4 * q + 3]; }
        float CA = 1.f, CB = 0.f; float inA[8], inB[8];
#pragma unroll
        for (int s = 0; s < 8; ++s) {
            const float pA = __shfl_xor(SA[s], 32), pB = __shfl_xor(SB[s], 32);
            const float Ae = hi ? pA : SA[s], Be = hi ? pB : SB[s], Ao = hi ? SA[s] : pA, Bo = hi ? SB[s] : pB;
            if (!hi) { inA[s] = CA; inB[s] = CB; }
            CB = Ae * CB + Be; CA = Ae * CA;
            if (hi) { inA[s] = CA; inB[s] = CB; }
            CB = Ao * CB + Bo; CA = Ao * CA;
        }
        unsigned hoff = (unsigned)((row0 + 4 * hi) * 512 + c);
        if (hi == 0) { float* sp2 = SUMM + ((size_t)(b * 128 + chunk) * 512 + c) * 2; sp2[0] = CA; sp2[1] = CB; }
#pragma unroll
        for (int tt = 0; tt < 2; ++tt)
#pragma unroll
            for (int r = 0; r < 16; ++r) { const int s = tt * 4 + (r >> 2);
                const float acum = ga[tt][r] * inA[s], hloc = ga[tt][r] * inB[s] + gi[tt][r];
                asm volatile("" : "+v"(hoff));
                HA[hoff + (unsigned)((32 * tt + (r & 3) + 8 * (r >> 2)) * 512)] = f2bf(hloc) | (f2bf(acum) << 16); }
    }
    __syncthreads();
}
__device__ __forceinline__ void lru_fix_item(const Frame& F, const Args& A, LAS unsigned char* lds, int item, bool zero_nsa) {
    unsigned char* ws = A.ws;
    const int b = item >> 7, chunk = item & 127; const size_t row0 = (size_t)b * SEQ + chunk * 64;
    LAS float* carry = (LAS float*)lds;
    { const int c = F.tid; const float* SUMM = (const float*)(ws + WS_SUMM) + (size_t)b * 128 * 1024 + 2 * c; float hc = 0.f;
      int j = 0;
      for (; j + 8 <= chunk; j += 8) { float2 ab[8];
#pragma unroll
          for (int q = 0; q < 8; ++q) ab[q] = *(const float2*)(SUMM + (size_t)(j + q) * 1024);
#pragma unroll
          for (int q = 0; q < 8; ++q) hc = ab[q].x * hc + ab[q].y; }
      for (; j < chunk; ++j) { const float2 ab = *(const float2*)(SUMM + (size_t)j * 1024); hc = ab.x * hc + ab.y; }
      carry[c] = hc; }
    __syncthreads();
    const bf16* Z = (const bf16*)(ws + WS_Z); const unsigned* HA = (const unsigned*)A.out; bf16* Y = (bf16*)(ws + WS_Y);
    const int c0 = 8 * F.lane;
    float cr[8];
#pragma unroll
    for (int j = 0; j < 8; ++j) cr[j] = carry[c0 + j];
#pragma unroll 1
    for (int t4 = 0; t4 < 8; t4 += 4) {
        v4u h0[4], h1[4], gz[4]; float y[4][8], s[4];
#pragma unroll
        for (int q = 0; q < 4; ++q) { const size_t row = row0 + F.wave * 8 + t4 + q; h0[q] = __builtin_nontemporal_load((const v4u*)(HA + row * 512 + c0)); h1[q] = __builtin_nontemporal_load((const v4u*)(HA + row * 512 + c0 + 4)); gz[q] = __builtin_nontemporal_load((const v4u*)(Z + row * NZ + ZC_GT + c0)); }
#pragma unroll
        for (int q = 0; q < 4; ++q) { const unsigned hw[8] = {h0[q].x, h0[q].y, h0[q].z, h0[q].w, h1[q].x, h1[q].y, h1[q].z, h1[q].w};
            const float gt[8] = {bflo(gz[q].x), bfhi(gz[q].x), bflo(gz[q].y), bfhi(gz[q].y), bflo(gz[q].z), bfhi(gz[q].z), bflo(gz[q].w), bfhi(gz[q].w)};
            s[q] = 0.f;
#pragma unroll
            for (int j = 0; j < 8; ++j) { const float hv = bfhi(hw[j]) * cr[j] + bflo(hw[j]); y[q][j] = hv * gelu_tanh(gt[j]); s[q] += y[q][j] * y[q][j]; } }
#pragma unroll
        for (int o = 1; o < 64; o <<= 1)
#pragma unroll
            for (int q = 0; q < 4; ++q) s[q] += __shfl_xor(s[q], o);
#pragma unroll
        for (int q = 0; q < 4; ++q) { const size_t row = row0 + F.wave * 8 + t4 + q; const float rstd = rsqrtf(s[q] * (1.f / 512.f) + EPS);
            v4u o; o.x = pk2(y[q][0] * rstd, y[q][1] * rstd); o.y = pk2(y[q][2] * rstd, y[q][3] * rstd); o.z = pk2(y[q][4] * rstd, y[q][5] * rstd); o.w = pk2(y[q][6] * rstd, y[q][7] * rstd);
            *(v4u*)(Y + row * DM + 512 + c0) = o;
            if (zero_nsa) *(v4u*)(Y + row * DM + c0) = (v4u){0u, 0u, 0u, 0u}; }
    }
    __syncthreads();
}

__device__ __forceinline__ void kmax_item(const Frame& F, const Args& A, int item) {
    unsigned char* ws = A.ws; const int lane = lane_id();
    const int bk = item >> 9, br = (item >> 8) & 1, tile = item & 255;
    const unsigned char* K = ws + (br ? WS_KWF : WS_KSF) + ((size_t)bk * 256 + tile) * 4096 + 16 * lane;
    float s = 0.f;
#pragma unroll
    for (int ks = 0; ks < 4; ++ks) { const v4u w = *(const v4u*)(K + 1024 * ks); const unsigned ww[4] = {w.x, w.y, w.z, w.w};
#pragma unroll
        for (int k = 0; k < 4; ++k) { const float a = bflo(ww[k]), c = bfhi(ww[k]); s += a * a + c * c; } }
    s = addswap32_f(s);
#pragma unroll
    for (int o = 1; o < 32; o <<= 1) s = fmaxf(s, __shfl_xor(s, o));
    if (lane == 0) atomicMax((unsigned*)(ws + WS_CTL) + CW_KMAX + bk * 2 + br, __builtin_bit_cast(unsigned, s));
}
__device__ __forceinline__ void compress_item(const Frame& F, const Args& A, LAS unsigned char* lds, int item) {
    unsigned char* ws = A.ws;
    const int kv = item >> 6, b = (item >> 5) & 1, h = (item >> 4) & 1, nt = item & 15, n0 = 32 * nt;
    const int lane = F.lane, r32 = lane & 31, hi = lane >> 5, w = F.wave;
    const bf16* Z = (const bf16*)(ws + WS_Z); const bf16* W1T = (const bf16*)(ws + WS_CW1T) + (size_t)kv * 64 * 2048; const bf16* W2T = (const bf16*)(ws + WS_CW2T) + (size_t)kv * 4096;
    const int zc = (kv ? ZC_VC : ZC_KC) + h * 64;
    LAS float* part = (LAS float*)lds;
    LAS float* G = (LAS float*)(lds + 65536);
    {
        int n = n0 + r32; if (n > 510) n = 510;
        f32x16 acc[2]; acc[0] = f32x16{}; acc[1] = f32x16{};
#pragma unroll 4
        for (int kk = 0; kk < 16; ++kk) { const int ks = 16 * w + kk, l = ks >> 2, d0 = (ks & 3) * 16 + 8 * hi;
            const bf16x8 bfr = *(const bf16x8*)(Z + ((size_t)b * SEQ + 16 * n + l) * NZ + zc + d0);
            const bf16x8 a0 = *(const bf16x8*)(W1T + (size_t)(r32) * 2048 + ks * 16 + 8 * hi), a1 = *(const bf16x8*)(W1T + (size_t)(32 + r32) * 2048 + ks * 16 + 8 * hi);
            acc[0] = __builtin_amdgcn_mfma_f32_32x32x16_bf16(a0, bfr, acc[0], 0, 0, 0); acc[1] = __builtin_amdgcn_mfma_f32_32x32x16_bf16(a1, bfr, acc[1], 0, 0, 0); }
#pragma unroll
        for (int ot = 0; ot < 2; ++ot)
#pragma unroll
            for (int r = 0; r < 16; ++r) part[(w * 64 + 32 * ot + crow(r, hi)) * 32 + r32] = acc[ot][r];
    }
    __syncthreads();
    { const float* c1 = (const float*)(ws + WS_C1) + kv * 16 * 64;
#pragma unroll
      for (int i = 0; i < 4; ++i) { const int e = F.tid + 512 * i, o = e >> 5, n = e & 31; float s = 0.f;
#pragma unroll
          for (int ch = 0; ch < 16; ++ch) s += c1[ch * 64 + o];
#pragma unroll
          for (int ww = 0; ww < 8; ++ww) s += part[(ww * 64 + o) * 32 + n];
          G[o * 33 + n] = gelu_tanh(s); } }
    __syncthreads();
    if (w < 2) {
        f32x16 acc = f32x16{};
#pragma unroll
        for (int ks = 0; ks < 4; ++ks) { const bf16x8 a = *(const bf16x8*)(W2T + (size_t)(32 * w + r32) * 64 + 16 * ks + 8 * hi);
            v4u bw; const LAS float* gp = G + (16 * ks + 8 * hi) * 33 + r32;
            bw.x = pk2(gp[0], gp[33]); bw.y = pk2(gp[66], gp[99]); bw.z = pk2(gp[132], gp[165]); bw.w = pk2(gp[198], gp[231]);
            acc = __builtin_amdgcn_mfma_f32_32x32x16_bf16(a, __builtin_bit_cast(bf16x8, bw), acc, 0, 0, 0); }
        const int n = n0 + r32;
        const size_t tbase = ((size_t)(b * 2 + h) * 16 + nt) * 2048;
        if (kv == 0) { bf16* KC = (bf16*)(ws + WS_KC) + tbase;
#pragma unroll
            for (int q = 0; q < 4; ++q) { v2u o; o.x = pk2(acc[4 * q], acc[4 * q + 1]); o.y = pk2(acc[4 * q + 2], acc[4 * q + 3]); if (n > 510) { o.x = 0u; o.y = 0u; }
                *(v2u*)(KC + (2 * w + (q >> 1)) * 512 + (q & 1) * 256 + r32 * 8 + 4 * hi) = o; } }
        else { bf16* VC = (bf16*)(ws + WS_VCT) + tbase; const int kk = r32 & 15, vo = (r32 >> 4) * 512 + ((kk >> 2) & 1) * 256 + (kk & 3) + 4 * (kk >> 3);
#pragma unroll
            for (int r = 0; r < 16; ++r) VC[w * 1024 + crow(r, hi) * 8 + vo] = (n > 510) ? (bf16)0 : (bf16)f2bf(acc[r]); }
    }
    __syncthreads();
}

__device__ __forceinline__ void sort16_desc(int (&k)[16]) {
#define CX(i, j) { const int hi_ = max(k[i], k[j]), lo_ = min(k[i], k[j]); k[i] = hi_; k[j] = lo_; }
    CX(0, 1) CX(2, 3) CX(0, 2) CX(1, 3) CX(1, 2) CX(4, 5) CX(6, 7) CX(4, 6) CX(5, 7) CX(5, 6) CX(0, 4) CX(2, 6) CX(2, 4) CX(1, 5) CX(3, 7) CX(3, 5) CX(1, 2)
    CX(3, 4) CX(5, 6) CX(8, 9) CX(10, 11) CX(8, 10) CX(9, 11) CX(9, 10) CX(12, 13) CX(14, 15) CX(12, 14) CX(13, 15) CX(13, 14) CX(8, 12) CX(10, 14) CX(10, 12)
    CX(9, 13) CX(11, 15) CX(11, 13) CX(9, 10) CX(11, 12) CX(13, 14) CX(0, 8) CX(4, 12) CX(4, 8) CX(2, 10) CX(6, 14) CX(6, 10) CX(2, 4) CX(6, 8) CX(10, 12)
    CX(1, 9) CX(5, 13) CX(5, 9) CX(3, 11) CX(7, 15) CX(7, 11) CX(3, 5) CX(7, 9) CX(11, 13) CX(1, 2) CX(3, 4) CX(5, 6) CX(7, 8) CX(9, 10) CX(11, 12) CX(13, 14)
#undef CX
}
__device__ __forceinline__ void sort32_desc(int (&k)[32]) {
#define CX(i, j) { const int hi_ = max(k[i], k[j]), lo_ = min(k[i], k[j]); k[i] = hi_; k[j] = lo_; }
    CX(0, 1) CX(2, 3) CX(0, 2) CX(1, 3) CX(1, 2) CX(4, 5) CX(6, 7) CX(4, 6) CX(5, 7) CX(5, 6) CX(0, 4) CX(2, 6) CX(2, 4) CX(1, 5) CX(3, 7) CX(3, 5) CX(1, 2)
    CX(3, 4) CX(5, 6) CX(8, 9) CX(10, 11) CX(8, 10) CX(9, 11) CX(9, 10) CX(12, 13) CX(14, 15) CX(12, 14) CX(13, 15) CX(13, 14) CX(8, 12) CX(10, 14) CX(10, 12)
    CX(9, 13) CX(11, 15) CX(11, 13) CX(9, 10) CX(11, 12) CX(13, 14) CX(0, 8) CX(4, 12) CX(4, 8) CX(2, 10) CX(6, 14) CX(6, 10) CX(2, 4) CX(6, 8) CX(10, 12)
    CX(1, 9) CX(5, 13) CX(5, 9) CX(3, 11) CX(7, 15) CX(7, 11) CX(3, 5) CX(7, 9) CX(11, 13) CX(1, 2) CX(3, 4) CX(5, 6) CX(7, 8) CX(9, 10) CX(11, 12) CX(13, 14)
    CX(16, 17) CX(18, 19) CX(16, 18) CX(17, 19) CX(17, 18) CX(20, 21) CX(22, 23) CX(20, 22) CX(21, 23) CX(21, 22) CX(16, 20) CX(18, 22) CX(18, 20) CX(17, 21)
    CX(19, 23) CX(19, 21) CX(17, 18) CX(19, 20) CX(21, 22) CX(24, 25) CX(26, 27) CX(24, 26) CX(25, 27) CX(25, 26) CX(28, 29) CX(30, 31) CX(28, 30) CX(29, 31)
    CX(29, 30) CX(24, 28) CX(26, 30) CX(26, 28) CX(25, 29) CX(27, 31) CX(27, 29) CX(25, 26) CX(27, 28) CX(29, 30) CX(16, 24) CX(20, 28) CX(20, 24) CX(18, 26)
    CX(22, 30) CX(22, 26) CX(18, 20) CX(22, 24) CX(26, 28) CX(17, 25) CX(21, 29) CX(21, 25) CX(19, 27) CX(23, 31) CX(23, 27) CX(19, 21) CX(23, 25) CX(27, 29)
    CX(17, 18) CX(19, 20) CX(21, 22) CX(23, 24) CX(25, 26) CX(27, 28) CX(29, 30) CX(0, 16) CX(8, 24) CX(8, 16) CX(4, 20) CX(12, 28) CX(12, 20) CX(4, 8)
    CX(12, 16) CX(20, 24) CX(2, 18) CX(10, 26) CX(10, 18) CX(6, 22) CX(14, 30) CX(14, 22) CX(6, 10) CX(14, 18) CX(22, 26) CX(2, 4) CX(6, 8) CX(10, 12)
    CX(14, 16) CX(18, 20) CX(22, 24) CX(26, 28) CX(1, 17) CX(9, 25) CX(9, 17) CX(5, 21) CX(13, 29) CX(13, 21) CX(5, 9) CX(13, 17) CX(21, 25) CX(3, 19)
    CX(11, 27) CX(11, 19) CX(7, 23) CX(15, 31) CX(15, 23) CX(7, 11) CX(15, 19) CX(23, 27) CX(3, 5) CX(7, 9) CX(11, 13) CX(15, 17) CX(19, 21) CX(23, 25)
    CX(27, 29) CX(1, 2) CX(3, 4) CX(5, 6) CX(7, 8) CX(9, 10) CX(11, 12) CX(13, 14) CX(15, 16) CX(17, 18) CX(19, 20) CX(21, 22) CX(23, 24) CX(25, 26) CX(27, 28)
    CX(29, 30)
#undef CX
}
__device__ __forceinline__ void bitonic16_desc(int (&a)[16]) {
#pragma unroll
    for (int s = 8; s >= 1; s >>= 1)
#pragma unroll
        for (int i = 0; i < 16; ++i) if ((i & s) == 0) { const int hi_ = max(a[i], a[i + s]), lo_ = min(a[i], a[i + s]); a[i] = hi_; a[i + s] = lo_; }
}
__device__ __forceinline__ void merge16_desc(int (&a)[16], const int (&b)[16]) {
#pragma unroll
    for (int i = 0; i < 16; ++i) a[i] = max(a[i], b[15 - i]);
    bitonic16_desc(a);
}
struct AttnSt { float m, l; f32x16 o[2]; };
#define EX2(x) __builtin_amdgcn_exp2f(x)
struct KVF { bf16x8 k[4]; bf16x8 v[2][2]; };
struct KVF8 { bf16x8 k[4]; v4u v8[2]; };
__device__ __forceinline__ void kv_load8(KVF8& f, const bf16* Kt, const unsigned char* Vt8, unsigned lo16) {
    const char* kb = (const char*)Kt + lo16;
#pragma unroll
    for (int ks = 0; ks < 4; ++ks) f.k[ks] = *(const bf16x8*)(kb + 1024 * ks);
#pragma unroll
    for (int dt = 0; dt < 2; ++dt) f.v8[dt] = *(const v4u*)(Vt8 + lo16 + 1024 * dt);
}
typedef __bf16 bf16x2v __attribute__((ext_vector_type(2)));
__device__ __forceinline__ bf16x8 dq8(unsigned w0, unsigned w1) {
    v4u o; o.x = __builtin_bit_cast(unsigned, __builtin_amdgcn_cvt_scalef32_pk_bf16_fp8(w0, 1.0f, false)); o.y = __builtin_bit_cast(unsigned, __builtin_amdgcn_cvt_scalef32_pk_bf16_fp8(w0, 1.0f, true));
    o.z = __builtin_bit_cast(unsigned, __builtin_amdgcn_cvt_scalef32_pk_bf16_fp8(w1, 1.0f, false)); o.w = __builtin_bit_cast(unsigned, __builtin_amdgcn_cvt_scalef32_pk_bf16_fp8(w1, 1.0f, true));
    return __builtin_bit_cast(bf16x8, o); }
__device__ __forceinline__ void kv_load(KVF& f, const bf16* Kt, const bf16* Vt, unsigned lo16) {
    const char* kb = (const char*)Kt + lo16; const char* vb = (const char*)Vt + lo16;
#pragma unroll
    for (int ks = 0; ks < 4; ++ks) f.k[ks] = *(const bf16x8*)(kb + 1024 * ks);
#pragma unroll
    for (int dt = 0; dt < 2; ++dt)
#pragma unroll
        for (int s2 = 0; s2 < 2; ++s2) f.v[dt][s2] = *(const bf16x8*)(vb + 2048 * dt + 1024 * s2);
}
#define MAX3(a, b, c) __builtin_fmaxf(__builtin_fmaxf((a), (b)), (c))
__device__ __forceinline__ float max16(const f32x16& s) { const float a = MAX3(s[0], s[1], s[2]), b = MAX3(s[3], s[4], s[5]), c = MAX3(s[6], s[7], s[8]), d = MAX3(s[9], s[10], s[11]), e = MAX3(s[12], s[13], s[14]);
    return MAX3(MAX3(a, b, c), MAX3(d, e, s[15]), -1e30f); }
__device__ __forceinline__ float sum16(const f32x16& s) { return (((s[0] + s[1]) + (s[2] + s[3])) + ((s[4] + s[5]) + (s[6] + s[7]))) + (((s[8] + s[9]) + (s[10] + s[11])) + ((s[12] + s[13]) + (s[14] + s[15]))); }
template <int MODE, bool FIXED, class AllowF>
__device__ __forceinline__ void attn_compute(const KVF8& f, const bf16x8 (&qf)[4], const f32x16& negm, bool sel, AllowF allow, AttnSt& st) {
    f32x16 s = FIXED ? negm : f32x16{};
#pragma unroll
    for (int ks = 0; ks < 4; ++ks) s = __builtin_amdgcn_mfma_f32_32x32x16_bf16(f.k[ks], qf[ks], s, 0, 0, 0);
    if (MODE == 2) {
#pragma unroll
        for (int r = 0; r < 16; ++r) if (!allow(r)) s[r] = -1e30f; }
    if (!FIXED) {
        float mt = max16(s);
        if (MODE == 1) mt = sel ? mt : -1e30f;
        mt = maxswap32_f(mt);
        if (__any(mt > st.m)) {
            const float mn = fmaxf(st.m, mt), alpha = EX2(st.m - mn);
            st.m = mn; st.l *= alpha;
#pragma unroll
            for (int dt = 0; dt < 2; ++dt)
#pragma unroll
                for (int r = 0; r < 16; ++r) st.o[dt][r] *= alpha;
        }
        const float mref = (MODE == 1 && !sel) ? 1e30f : fmaxf(st.m, -1e29f);
#pragma unroll
        for (int r = 0; r < 16; ++r) s[r] = EX2(s[r] - mref);
        st.l += sum16(s);
    } else {
#pragma unroll
        for (int r = 0; r < 16; ++r) s[r] = EX2(s[r]);
        const float ps = sum16(s);
        st.l += (MODE == 1 && !sel) ? 0.f : ps;
    }
#pragma unroll
    for (int s2 = 0; s2 < 2; ++s2) { v4u pw; pw.x = pk2(s[8 * s2], s[8 * s2 + 1]); pw.y = pk2(s[8 * s2 + 2], s[8 * s2 + 3]); pw.z = pk2(s[8 * s2 + 4], s[8 * s2 + 5]); pw.w = pk2(s[8 * s2 + 6], s[8 * s2 + 7]);
        if (FIXED && MODE == 1) { pw.x = sel ? pw.x : 0u; pw.y = sel ? pw.y : 0u; pw.z = sel ? pw.z : 0u; pw.w = sel ? pw.w : 0u; }
        const bf16x8 pf = __builtin_bit_cast(bf16x8, pw);
#pragma unroll
        for (int dt = 0; dt < 2; ++dt) st.o[dt] = __builtin_amdgcn_mfma_f32_32x32x16_bf16(dq8(f.v8[dt][2 * s2], f.v8[dt][2 * s2 + 1]), pf, st.o[dt], 0, 0, 0); }
}
constexpr int IMP_LD = 132;
__device__ __forceinline__ void nsa_item(const Frame& F, const Args& A, LAS unsigned char* lds, int b, int kvh, int tb, int wsub) {
    unsigned char* ws = A.ws;
    int lane = lane_id(); asm volatile("" : "+v"(lane));
    const int r32 = lane & 31, hi = lane >> 5, w = F.wave;
    const int t0 = 64 * tb + 8 * wsub, ti = r32 & 7, g = r32 >> 3, t = t0 + ti, cur = tb;
    const size_t rowb = (size_t)b * SEQ;
    const bf16* Z = (const bf16*)(ws + WS_Z);
    LAS float* imp = (LAS float*)lds + w * 8 * IMP_LD;
    for (int i = lane; i < 8 * IMP_LD; i += 64) imp[i] = 0.f;
    bf16x8 qf[4];
#pragma unroll
    for (int ks = 0; ks < 4; ++ks) qf[ks] = *(const bf16x8*)(Z + (rowb + t) * NZ + ZC_Q + (kvh * 4 + g) * 64 + 16 * ks + 8 * hi);
    const float* gp = (const float*)(ws + WS_GATES) + (rowb + t) * 24 + (kvh * 4 + g) * 3;
    const float gate_c = gp[0], gate_s = gp[1], gate_w = gp[2];
    LAS float* oacc = (LAS float*)(lds + 8 * 8 * IMP_LD * 4) + w * 2048 + lane;
    {
        const bf16* KC = (const bf16*)(ws + WS_KC) + (size_t)(b * 2 + kvh) * 16 * 2048;
        const bf16* VCT = (const bf16*)(ws + WS_VCT) + (size_t)(b * 2 + kvh) * 16 * 2048;
        const int nv = (t >= 31) ? ((t - 31) >> 4) + 1 : 0;
        const int tl = t0 + 7, nvmax = (tl >= 31) ? ((tl - 31) >> 4) + 1 : 0;
        const unsigned lo16 = 16u * (unsigned)lane;
        float m1 = -1e30f, l1 = 0.f;
        {
            bf16x8 ka[4], kb[4];
#pragma unroll
            for (int ks = 0; ks < 4; ++ks) ka[ks] = *(const bf16x8*)((const char*)KC + lo16 + 1024 * ks);
            for (int n0 = 0; n0 < nvmax; n0 += 32) {
                if (n0 + 32 < nvmax) {
#pragma unroll
                    for (int ks = 0; ks < 4; ++ks) kb[ks] = *(const bf16x8*)((const char*)(KC + (size_t)(n0 + 32) * 64) + lo16 + 1024 * ks);
                }
                f32x16 s = f32x16{};
#pragma unroll
                for (int ks = 0; ks < 4; ++ks) s = __builtin_amdgcn_mfma_f32_32x32x16_bf16(ka[ks], qf[ks], s, 0, 0, 0);
                float mt = -1e30f;
#pragma unroll
                for (int r = 0; r < 16; ++r) { if (n0 + crow(r, hi) >= nv) s[r] = -1e30f; mt = fmaxf(mt, s[r]); }
                const float mn = fmaxf(m1, mt); float ps = 0.f;
#pragma unroll
                for (int r = 0; r < 16; ++r) ps += (s[r] > -1e29f) ? EX2(s[r] - mn) : 0.f;
                l1 = l1 * EX2(m1 - mn) + ps; m1 = mn;
#pragma unroll
                for (int ks = 0; ks < 4; ++ks) ka[ks] = kb[ks];
            }
        }
        { const float mo = __shfl_xor(m1, 32), lo = __shfl_xor(l1, 32); const float mn = fmaxf(m1, mo); l1 = l1 * EX2(m1 - mn) + lo * EX2(mo - mn); m1 = mn; }
        const float invl = (l1 > 0.f) ? 1.0f / l1 : 0.f;
        f32x16 o[2]; o[0] = f32x16{}; o[1] = f32x16{};
        KVF fa, fb;
        if (nvmax > 0) kv_load(fa, KC, VCT, lo16);
        for (int n0 = 0; n0 < nvmax; n0 += 32) {
            if (n0 + 32 < nvmax) kv_load(fb, KC + (size_t)(n0 + 32) * 64, VCT + (size_t)(n0 + 32) * 64, lo16);
            f32x16 s = f32x16{};
#pragma unroll
            for (int ks = 0; ks < 4; ++ks) s = __builtin_amdgcn_mfma_f32_32x32x16_bf16(fa.k[ks], qf[ks], s, 0, 0, 0);
#pragma unroll
            for (int r = 0; r < 16; ++r) s[r] = (n0 + crow(r, hi) < nv) ? EX2(s[r] - m1) * invl : 0.f;
            float bs[4], sp[4];
#pragma unroll
            for (int q = 0; q < 4; ++q) { bs[q] = (s[4 * q] + s[4 * q + 1]) + (s[4 * q + 2] + s[4 * q + 3]); sp[q] = s[4 * q + 3];
                bs[q] += __shfl_xor(bs[q], 8); bs[q] += __shfl_xor(bs[q], 16); sp[q] += __shfl_xor(sp[q], 8); sp[q] += __shfl_xor(sp[q], 16); }
            if (r32 < 8) {
                LAS float* ip = imp + r32 * IMP_LD + (n0 >> 2) + hi;
#pragma unroll
                for (int q = 0; q < 4; ++q) ip[2 * q] += bs[q];
                asm volatile("s_waitcnt lgkmcnt(0)" ::: "memory");
#pragma unroll
                for (int q = 0; q < 4; ++q) ip[2 * q + 1] += sp[q];
                asm volatile("s_waitcnt lgkmcnt(0)" ::: "memory");
            }
#pragma unroll
            for (int s2 = 0; s2 < 2; ++s2) { v4u pw; pw.x = pk2(s[8 * s2], s[8 * s2 + 1]); pw.y = pk2(s[8 * s2 + 2], s[8 * s2 + 3]); pw.z = pk2(s[8 * s2 + 4], s[8 * s2 + 5]); pw.w = pk2(s[8 * s2 + 6], s[8 * s2 + 7]);
                const bf16x8 pf = __builtin_bit_cast(bf16x8, pw);
#pragma unroll
                for (int dt = 0; dt < 2; ++dt) o[dt] = __builtin_amdgcn_mfma_f32_32x32x16_bf16(fa.v[dt][s2], pf, o[dt], 0, 0, 0); }
            if (n0 + 32 < nvmax) fa = fb;
        }
#pragma unroll
        for (int dt = 0; dt < 2; ++dt)
#pragma unroll
            for (int r = 0; r < 16; ++r) oacc[(dt * 16 + r) * 64] = gate_c * o[dt][r];
    }
    asm volatile("s_waitcnt lgkmcnt(0)" ::: "memory");
    unsigned mym[4] = {0u, 0u, 0u, 0u}, un[4] = {0u, 0u, 0u, 0u};
    if (cur < 16) { const unsigned mk = (2u << cur) - 1u; mym[0] = mk; un[0] = mk; }
    else {
        const int tq = lane >> 3, sub = lane & 7;
        int key[16];
#pragma unroll
        for (int i = 0; i < 16; ++i) { const int j = 16 * sub + i; const float v = imp[tq * IMP_LD + j];
            key[i] = (j >= 1 && j <= cur - 2) ? (int)((__builtin_bit_cast(unsigned, v) & ~0x7fu) | (unsigned)(127 - j)) : 0; }
        sort16_desc(key);
        { int ot[16];
#pragma unroll
          for (int i = 0; i < 16; ++i) ot[i] = __builtin_amdgcn_mov_dpp(key[i], 0xB1, 0xf, 0xf, true);
          merge16_desc(key, ot);
#pragma unroll
          for (int i = 0; i < 16; ++i) ot[i] = __builtin_amdgcn_mov_dpp(key[i], 0x4E, 0xf, 0xf, true);
          merge16_desc(key, ot);
#pragma unroll
          for (int i = 0; i < 16; ++i) ot[i] = __builtin_amdgcn_mov_dpp(key[i], 0x141, 0xf, 0xf, true);
          merge16_desc(key, ot); }
        unsigned mk[4] = {1u, 0u, 0u, 0u};
        { const int c1 = cur - 1; if (c1 < 32) mk[0] |= 1u << c1; else if (c1 < 64) mk[1] |= 1u << (c1 - 32); else if (c1 < 96) mk[2] |= 1u << (c1 - 64); else mk[3] |= 1u << (c1 - 96);
          if (cur < 32) mk[0] |= 1u << cur; else if (cur < 64) mk[1] |= 1u << (cur - 32); else if (cur < 96) mk[2] |= 1u << (cur - 64); else mk[3] |= 1u << (cur - 96); }
#pragma unroll
        for (int i = 0; i < 13; ++i) { const int j = 127 - (key[i] & 0x7f); const unsigned bit = (key[i] != 0) ? (1u << (j & 31)) : 0u; const int wd = j >> 5;
            mk[0] |= (wd == 0) ? bit : 0u; mk[1] |= (wd == 1) ? bit : 0u; mk[2] |= (wd == 2) ? bit : 0u; mk[3] |= (wd == 3) ? bit : 0u; }
#pragma unroll
        for (int i = 0; i < 4; ++i) { unsigned u = mk[i]; u |= (unsigned)__shfl_xor((int)u, 8); u |= (unsigned)__shfl_xor((int)u, 16); u |= (unsigned)__shfl_xor((int)u, 32); un[i] = u;
            mym[i] = (unsigned)__shfl((int)mk[i], 8 * ti); }
    }
    float q2 = 0.f;
#pragma unroll
    for (int ks = 0; ks < 4; ++ks) { const v4u qw = __builtin_bit_cast(v4u, qf[ks]); const unsigned ww[4] = {qw.x, qw.y, qw.z, qw.w};
#pragma unroll
        for (int k = 0; k < 4; ++k) { const float a = bflo(ww[k]), c = bfhi(ww[k]); q2 += a * a + c * c; } }
    q2 = addswap32_f(q2);
    const unsigned* KMX = (const unsigned*)(ws + WS_CTL) + CW_KMAX + (b * 2 + kvh) * 2;
    const float Ms = __builtin_amdgcn_sqrtf(q2 * __builtin_bit_cast(float, KMX[0])) * 1.0001f + 1e-3f, Mw = __builtin_amdgcn_sqrtf(q2 * __builtin_bit_cast(float, KMX[1])) * 1.0001f + 1e-3f;
    const bool fixed_ok = !__any(Ms >= 60.f || Mw >= 60.f);
    {
        AttnSt st; st.m = -1e30f; st.l = 0.f; st.o[0] = f32x16{}; st.o[1] = f32x16{};
        const bf16* KS = (const bf16*)(ws + WS_KSF) + (size_t)(b * 2 + kvh) * 256 * 2048; const unsigned char* VS = ws + WS_VSF + (size_t)(b * 2 + kvh) * 256 * 2048;
        const unsigned lo16 = 16u * (unsigned)lane;
        unsigned um0 = (unsigned)__builtin_amdgcn_readfirstlane((int)un[0]), um1 = (unsigned)__builtin_amdgcn_readfirstlane((int)un[1]), um2 = (unsigned)__builtin_amdgcn_readfirstlane((int)un[2]), um3 = (unsigned)__builtin_amdgcn_readfirstlane((int)un[3]);
#define NEXT_BLOCK(jv) do { if (um0) { jv = __builtin_ctz(um0); um0 &= um0 - 1u; } else if (um1) { jv = 32 + __builtin_ctz(um1); um1 &= um1 - 1u; } else if (um2) { jv = 64 + __builtin_ctz(um2); um2 &= um2 - 1u; } \
            else if (um3) { jv = 96 + __builtin_ctz(um3); um3 &= um3 - 1u; } else jv = -1; } while (0)
#define SLC_LOOP(FX) do { f32x16 negm; _Pragma("unroll") for (int r = 0; r < 16; ++r) negm[r] = -Ms; \
        KVF8 fa, fb; int j; NEXT_BLOCK(j); \
        if (j >= 0) kv_load8(fa, KS + (size_t)j * 4096, VS + (size_t)j * 4096, lo16); \
        while (j >= 0) { const int key0 = j * 64; \
            const unsigned mw = (j < 32) ? mym[0] : (j < 64) ? mym[1] : (j < 96) ? mym[2] : mym[3]; const bool sel = (mw >> (j & 31)) & 1u; \
            kv_load8(fb, KS + (size_t)j * 4096 + 2048, VS + (size_t)j * 4096 + 2048, lo16); \
            if (j == cur) attn_compute<2, FX>(fa, qf, negm, sel, [&](int r) { return sel && (key0 + crow(r, hi) <= t); }, st); \
            else attn_compute<1, FX>(fa, qf, negm, sel, [&](int) { return true; }, st); \
            int jn; NEXT_BLOCK(jn); \
            if (jn >= 0) kv_load8(fa, KS + (size_t)jn * 4096, VS + (size_t)jn * 4096, lo16); \
            if (j == cur) attn_compute<2, FX>(fb, qf, negm, sel, [&](int r) { return sel && (key0 + 32 + crow(r, hi) <= t); }, st); \
            else attn_compute<1, FX>(fb, qf, negm, sel, [&](int) { return true; }, st); \
            j = jn; } } while (0)
        if (fixed_ok) SLC_LOOP(true); else SLC_LOOP(false);
#undef SLC_LOOP
#undef NEXT_BLOCK
        const float l = addswap32_f(st.l); const float sc = gate_s / l;
#pragma unroll
        for (int dt = 0; dt < 2; ++dt)
#pragma unroll
            for (int r = 0; r < 16; ++r) oacc[(dt * 16 + r) * 64] += sc * st.o[dt][r];
    }
    f32x16 outv[2];
    {
        AttnSt st; st.m = -1e30f; st.l = 0.f; st.o[0] = f32x16{}; st.o[1] = f32x16{};
        const bf16* KW = (const bf16*)(ws + WS_KWF) + (size_t)(b * 2 + kvh) * 256 * 2048; const unsigned char* VW = ws + WS_VWF + (size_t)(b * 2 + kvh) * 256 * 2048;
        const unsigned lo16 = 16u * (unsigned)lane;
        const int klo = (t0 - 511 > 0) ? ((t0 - 511) & ~31) : 0, khi = (t0 + 7) & ~31;
#define WIN_LOOP(FX) do { f32x16 negm; _Pragma("unroll") for (int r = 0; r < 16; ++r) negm[r] = -Mw; \
        KVF8 fa, fb; kv_load8(fa, KW + (size_t)klo * 64, VW + (size_t)klo * 64, lo16); \
        _Pragma("unroll 1") for (int key0 = klo; key0 <= khi; key0 += 32) { \
            if (key0 + 32 <= khi) kv_load8(fb, KW + (size_t)(key0 + 32) * 64, VW + (size_t)(key0 + 32) * 64, lo16); \
            if (key0 + 31 > t0 || key0 <= t0 + 7 - 512) attn_compute<2, FX>(fa, qf, negm, true, [&](int r) { const int kp = key0 + crow(r, hi); return kp <= t && kp > t - 512; }, st); \
            else attn_compute<0, FX>(fa, qf, negm, true, [&](int) { return true; }, st); \
            if (key0 + 32 <= khi) fa = fb; } } while (0)
        if (fixed_ok) WIN_LOOP(true); else WIN_LOOP(false);
#undef WIN_LOOP
        const float l = addswap32_f(st.l); const float sc = gate_w / l;
#pragma unroll
        for (int dt = 0; dt < 2; ++dt)
#pragma unroll
            for (int r = 0; r < 16; ++r) outv[dt][r] = oacc[(dt * 16 + r) * 64] + sc * st.o[dt][r];
    }
    float ss = 0.f;
#pragma unroll
    for (int dt = 0; dt < 2; ++dt)
#pragma unroll
        for (int r = 0; r < 16; ++r) ss += outv[dt][r] * outv[dt][r];
    ss += __shfl_xor(ss, 32); ss += __shfl_xor(ss, 8); ss += __shfl_xor(ss, 16);
    if (lane < 8) ((float*)(ws + WS_SSQN))[(rowb + t0 + lane) * 2 + kvh] = ss;
    bf16* Yp = (bf16*)(ws + WS_Y) + (rowb + t) * DM + (kvh * 4 + g) * 64 + 4 * hi;
#pragma unroll
    for (int dt = 0; dt < 2; ++dt)
#pragma unroll
        for (int q = 0; q < 4; ++q) { v2u o; o.x = pk2(outv[dt][4 * q], outv[dt][4 * q + 1]); o.y = pk2(outv[dt][4 * q + 2], outv[dt][4 * q + 3]); *(v2u*)(Yp + 32 * dt + 8 * q) = o; }
}
__device__ __forceinline__ void memattn_item(const Frame& F, const Args& A, int item) {
    unsigned char* ws = A.ws;
    const int lane = F.lane, r32 = lane & 31, hi = lane >> 5;
    const int h = item & 3, tile = item >> 2; const size_t row0 = (size_t)tile * 32; const int b = (int)(row0 >> 13);
    const bf16* Q = (const bf16*)(ws + WS_QM) + (size_t)tile * 32 * DM + (size_t)(h * 16) * 512 + 8 * lane;
    const bf16* K = (const bf16*)(ws + WS_MEMK) + (size_t)(b * 8) * 32 * DM + (size_t)(h * 16) * 512 + 8 * lane;
    const bf16* VF = (const bf16*)(ws + WS_MEMVT) + (size_t)((b * 4 + h) * 8) * 8192 + 8 * lane;
    f32x16 s[8];
#pragma unroll
    for (int kt = 0; kt < 8; ++kt) s[kt] = f32x16{};
#define QK_LOAD(qv, kv, ks_) do { const int kk_ = (ks_) < 16 ? (ks_) : 15; qv = __builtin_nontemporal_load((const bf16x8*)(Q + 512 * kk_)); _Pragma("unroll") for (int kt = 0; kt < 8; ++kt) kv[kt] = *(const bf16x8*)(K + (size_t)kt * 32 * DM + 512 * kk_); } while (0)
#define QK_MMA(qv, kv) do { _Pragma("unroll") for (int kt = 0; kt < 8; ++kt) s[kt] = __builtin_amdgcn_mfma_f32_32x32x16_bf16(kv[kt], qv, s[kt], 0, 0, 0); } while (0)
    { bf16x8 qa, qb, ka[8], kb[8];
      QK_LOAD(qa, ka, 0);
#pragma unroll 1
      for (int ks = 0; ks < 16; ks += 2) {
          QK_LOAD(qb, kb, ks + 1); asm volatile("" ::: "memory");
          QK_MMA(qa, ka);
          QK_LOAD(qa, ka, ks + 2); asm volatile("" ::: "memory");
          QK_MMA(qb, kb); } }
#undef QK_LOAD
#undef QK_MMA
    float m = -1e30f;
#pragma unroll
    for (int kt = 0; kt < 8; ++kt) m = fmaxf(m, max16(s[kt]));
    m = maxswap32_f(m);
    float l = 0.f; v4u pw[8][2];
#pragma unroll
    for (int kt = 0; kt < 8; ++kt) {
#pragma unroll
        for (int r = 0; r < 16; ++r) s[kt][r] = EX2(s[kt][r] - m);
        l += sum16(s[kt]);
#pragma unroll
        for (int s2 = 0; s2 < 2; ++s2) { pw[kt][s2].x = pk2(s[kt][8 * s2], s[kt][8 * s2 + 1]); pw[kt][s2].y = pk2(s[kt][8 * s2 + 2], s[kt][8 * s2 + 3]); pw[kt][s2].z = pk2(s[kt][8 * s2 + 4], s[kt][8 * s2 + 5]); pw[kt][s2].w = pk2(s[kt][8 * s2 + 6], s[kt][8 * s2 + 7]); } }
    l = addswap32_f(l);
    const float invl = 1.0f / l;
    bf16* O = (bf16*)(ws + WS_OM) + (row0 + r32) * DM + h * 256 + 4 * hi;
#define PV_LOAD(vv, dt_) do { const int dd_ = (dt_) < 8 ? (dt_) : 7; _Pragma("unroll") for (int kt = 0; kt < 8; ++kt) _Pragma("unroll") for (int s2 = 0; s2 < 2; ++s2) vv[2 * kt + s2] = *(const bf16x8*)(VF + (size_t)kt * 8192 + dd_ * 1024 + s2 * 512); } while (0)
#define PV_MMA(vv, dt_) do { f32x16 o = f32x16{}; _Pragma("unroll") for (int kt = 0; kt < 8; ++kt) _Pragma("unroll") for (int s2 = 0; s2 < 2; ++s2) o = __builtin_amdgcn_mfma_f32_32x32x16_bf16(vv[2 * kt + s2], __builtin_bit_cast(bf16x8, pw[kt][s2]), o, 0, 0, 0); \
        _Pragma("unroll") for (int q = 0; q < 4; ++q) { v2u ov; ov.x = pk2(o[4 * q] * invl, o[4 * q + 1] * invl); ov.y = pk2(o[4 * q + 2] * invl, o[4 * q + 3] * invl); *(v2u*)(O + 32 * (dt_) + 8 * q) = ov; } } while (0)
    { bf16x8 va[16], vb[16];
      PV_LOAD(va, 0);
#pragma unroll 1
      for (int dt = 0; dt < 8; dt += 2) {
          PV_LOAD(vb, dt + 1); asm volatile("" ::: "memory");
          PV_MMA(va, dt);
          PV_LOAD(va, dt + 2); asm volatile("" ::: "memory");
          PV_MMA(vb, dt + 1); } }
#undef PV_LOAD
#undef PV_MMA
}

__device__ __forceinline__ int f2key(float f) { const int u = __builtin_bit_cast(int, f); return u ^ ((u >> 31) & 0x7fffffff); }
__device__ __forceinline__ float key2f(int k) { const int u = k ^ ((k >> 31) & 0x7fffffff); return __builtin_bit_cast(float, u); }
__device__ __forceinline__ void top16_of_128(f32x16 (&s)[4], int hi, int (&kv)[16]) {
    int key[4][16];
#pragma unroll
    for (int nt = 0; nt < 4; ++nt)
#pragma unroll
        for (int r = 0; r < 16; ++r) key[nt][r] = (f2key(s[nt][r]) & ~0x7f) | (127 - (32 * nt + crow(r, hi)));
#pragma unroll
    for (int nt = 0; nt < 4; ++nt) sort16_desc(key[nt]);
    merge16_desc(key[0], key[1]); merge16_desc(key[2], key[3]); merge16_desc(key[0], key[2]);
    unsigned a[16], b[16];
#pragma unroll
    for (int i = 0; i < 16; ++i) { a[i] = (unsigned)key[0][i]; b[i] = a[i]; swap32(a[i], b[i]); }
#pragma unroll
    for (int i = 0; i < 16; ++i) kv[i] = max((int)a[i], (int)b[15 - i]);
    bitonic16_desc(kv);
}
template <bool LDSK>
__device__ __forceinline__ void peer_topk_item(const Frame& F, const Args& A, int item, const LAS unsigned char* lds) {
    unsigned char* ws = A.ws;
    int lane = lane_id(); asm volatile("" : "+v"(lane));
    const int r32 = lane & 31, hi = lane >> 5;
    const int h = item & 7, tile = item >> 3; const size_t row = (size_t)tile * 32 + r32;
    const bf16* QP = (const bf16*)(ws + WS_QP) + (size_t)tile * 32 * 2048 + (size_t)(h * 16) * 512 + 8 * lane;
    int k1[16], k2[16];
#pragma unroll
    for (int i = 0; i < 16; ++i) { k1[i] = 0; k2[i] = 0; }
#pragma unroll 1
    for (int c = 0; c < 2; ++c) {
        const bf16* SK = (const bf16*)(ws + WS_SKEY) + (size_t)((h * 2 + c) * 4) * 4096 + 8 * lane;
        f32x16 s[4];
#pragma unroll
        for (int nt = 0; nt < 4; ++nt) s[nt] = f32x16{};
        bf16x8 qf[8];
#pragma unroll
        for (int ks = 0; ks < 8; ++ks) qf[ks] = __builtin_nontemporal_load((const bf16x8*)(QP + (size_t)(c * 8 + ks) * 512));
#pragma unroll
        for (int ks = 0; ks < 8; ++ks) {
#pragma unroll
            for (int nt = 0; nt < 4; ++nt) { const bf16x8 kf = LDSK ? *(const LAS bf16x8*)(lds + ((c * 4 + nt) * 4096 + ks * 512) * 2 + lane * 16) : *(const bf16x8*)(SK + (size_t)nt * 4096 + ks * 512);
                s[nt] = __builtin_amdgcn_mfma_f32_32x32x16_bf16(kf, qf[ks], s[nt], 0, 0, 0); } }
        if (c == 0) top16_of_128(s, hi, k1); else top16_of_128(s, hi, k2);
    }
    float v1[16], v2[16];
#pragma unroll
    for (int i = 0; i < 16; ++i) { v1[i] = key2f(k1[i] & ~0x7f); v2[i] = key2f(k2[i] & ~0x7f); }
    int ck[32];
    {
        int idx = 0;
#pragma unroll
        for (int i = 0; i < 32; ++i) ck[i] = (int)0x80000000;
#pragma unroll
        for (int a = 0; a < 16; ++a)
#pragma unroll
            for (int bq = 0; bq < 16; ++bq) if ((a + 1) * (bq + 1) <= 16) {
                const int flat = a * 16 + bq; const int kk = (f2key(v1[a] + v2[bq]) & ~0xff) | (255 - flat);
                if ((idx & 1) == hi) ck[idx >> 1] = kk;
                ++idx; }
    }
    sort32_desc(ck);
    int tk[16];
    { unsigned a[16], b[16];
#pragma unroll
      for (int i = 0; i < 16; ++i) { a[i] = (unsigned)ck[i]; b[i] = a[i]; swap32(a[i], b[i]); }
#pragma unroll
      for (int i = 0; i < 16; ++i) tk[i] = max((int)a[i], (int)b[15 - i]);
      bitonic16_desc(tk); }
    int te[16];
    { LAS int* tab = (LAS int*)(lds + 65536 + F.wave * 8448) + lane * 33;
#pragma unroll
      for (int i = 0; i < 16; ++i) { tab[i] = 127 - (k1[i] & 0x7f); tab[16 + i] = 127 - (k2[i] & 0x7f); }
      asm volatile("s_waitcnt lgkmcnt(0)" ::: "memory");
#pragma unroll
      for (int i = 0; i < 16; ++i) { const int flat = 255 - (tk[i] & 0xff); te[i] = tab[flat >> 4] * 128 + tab[16 + (flat & 15)]; }
      asm volatile("s_waitcnt lgkmcnt(0)" ::: "memory"); }
    float gsm[16]; const float mx = key2f(tk[0] & ~0xff); float den = 0.f;
#pragma unroll
    for (int i = 0; i < 16; ++i) { gsm[i] = __expf(key2f(tk[i] & ~0xff) - mx); den += gsm[i]; }
    const float inv = 1.0f / den;
    if (hi == 0) {
        int* EID = (int*)(ws + WS_EID) + row * 128 + h * 16; float* GW = (float*)(ws + WS_GW) + row * 128 + h * 16;
#pragma unroll
        for (int q = 0; q < 4; ++q) { *(v4u*)(EID + 4 * q) = (v4u){(unsigned)te[4 * q], (unsigned)te[4 * q + 1], (unsigned)te[4 * q + 2], (unsigned)te[4 * q + 3]};
            *(f32x4*)(GW + 4 * q) = (f32x4){gsm[4 * q] * inv, gsm[4 * q + 1] * inv, gsm[4 * q + 2] * inv, gsm[4 * q + 3] * inv}; }
    }
}

typedef float f32x2 __attribute__((ext_vector_type(2)));
__device__ __forceinline__ float dot16_fp8(const v4u u, const f32x2 (&xn)[8]) {
    f32x2 a0 = {0.f, 0.f}, a1 = {0.f, 0.f};
#pragma unroll
    for (int j = 0; j < 4; ++j) { const f32x2 lo = __builtin_amdgcn_cvt_pk_f32_fp8((int)u[j], false), hi = __builtin_amdgcn_cvt_pk_f32_fp8((int)u[j], true);
        a0 = __builtin_elementwise_fma(lo, xn[2 * j], a0); a1 = __builtin_elementwise_fma(hi, xn[2 * j + 1], a1); }
    return (a0.x + a0.y) + (a1.x + a1.y);
}
__device__ __forceinline__ void axpy16_fp8(f32x2 (&acc)[8], const float w, const v4u u) {
    const f32x2 w2 = {w, w};
#pragma unroll
    for (int j = 0; j < 4; ++j) { const f32x2 lo = __builtin_amdgcn_cvt_pk_f32_fp8((int)u[j], false), hi = __builtin_amdgcn_cvt_pk_f32_fp8((int)u[j], true);
        acc[2 * j] = __builtin_elementwise_fma(lo, w2, acc[2 * j]); acc[2 * j + 1] = __builtin_elementwise_fma(hi, w2, acc[2 * j + 1]); }
}
#define TIE_ROW(val, nxt) asm volatile("" : "+v"(val), "+v"((nxt).x), "+v"((nxt).y), "+v"((nxt).z), "+v"((nxt).w))
constexpr int PQ_CHUNK = 128, PQ_NCHUNK = MTOK / PQ_CHUNK;
constexpr int CW_NQ = 10240;
constexpr int CW_PQ = 8192;
__device__ __forceinline__ int pq_pop(unsigned* ctl, int pass, int own, int& q_s, LAS int* bc, int wave) {
    __syncthreads();
    if (wave == 0 && lane_id() == 0) { int res = -1; int s = q_s;
        while (s < 8) { const int x = (own + s) & 7; const unsigned c = __hip_atomic_fetch_add(ctl + CW_PQ + 64 * (8 * pass + x), 1u, __ATOMIC_RELAXED, __HIP_MEMORY_SCOPE_AGENT);
            if (c < (unsigned)PQ_NCHUNK) { res = x * PQ_NCHUNK + (int)c; break; } ++s; }
        bc[0] = res; bc[1] = s; }
    __syncthreads();
    q_s = bc[1]; return bc[0];
}
template <int CTRL> __device__ __forceinline__ float dppf(float v) { return __builtin_bit_cast(float, __builtin_amdgcn_mov_dpp(__builtin_bit_cast(int, v), CTRL, 0xf, 0xf, true)); }
__device__ __forceinline__ float red8(float d) { d += dppf<0xB1>(d); d += dppf<0x4E>(d); d += dppf<0x141>(d); return d; }
__device__ __forceinline__ void peer_issue8(v4u (&rb)[8], const v4u ia, const v4u ib, const unsigned char* T  , unsigned c16) {
    const unsigned e[8] = {ia.x, ia.y, ia.z, ia.w, ib.x, ib.y, ib.z, ib.w};
#pragma unroll
    for (int i = 0; i < 8; ++i) rb[i] = *(const v4u*)(T + (e[i] * 128u + c16));
}
constexpr int PS_ROW = 528, PS_WAVE = 2 * 16 * PS_ROW;
__device__ __forceinline__ void peer_stage16(LAS unsigned char* st, const unsigned char* src  , int lane) {
    v4u e[8];
#pragma unroll
    for (int j = 0; j < 8; ++j) e[j] = __builtin_nontemporal_load((const v4u*)(src + (unsigned)(j * 1024 + lane * 16)));
#pragma unroll
    for (int j = 0; j < 8; ++j) *(LAS v4u*)(st + (2 * j + (lane >> 5)) * PS_ROW + (lane & 31) * 16) = e[j];
}
__device__ __forceinline__ void peer_u_chunk(const Frame& F, const Args& A, LAS unsigned char* lds, int x, int chunk) {
    unsigned char* ws = A.ws; int lane = lane_id(); asm volatile("" : "+v"(lane));
    const int tk = lane >> 3, c8 = lane & 7;
    const unsigned char* U = ws + WS_U8 + (size_t)x * 16384 * 128; const unsigned c16 = 16u * (unsigned)c8;
    LAS unsigned char* st = lds + F.wave * PS_WAVE;
    peer_stage16(st, ws + WS_EID + (size_t)(chunk * PQ_CHUNK + F.wave * 16) * 512, lane);
#pragma unroll 1
    for (int oc = 0; oc < 2; ++oc) {
        const unsigned row = (unsigned)(chunk * PQ_CHUNK + F.wave * 16 + oc * 8 + tk);
        const LAS unsigned char* est = st + (oc * 8 + tk) * PS_ROW;
#define EID_LD(i_) (*(const LAS v4u*)(est + 16 * (i_)))
        f32x2 xn[8];
        { const unsigned char* xb_ = ws + WS_XN; const unsigned xo = row * 2048u + 256u * (unsigned)x + 32u * (unsigned)c8; const v4u xa = *(const v4u*)(xb_ + xo), xb = *(const v4u*)(xb_ + (xo + 16u));
          const unsigned xw[8] = {xa.x, xa.y, xa.z, xa.w, xb.x, xb.y, xb.z, xb.w};
#pragma unroll
          for (int j = 0; j < 8; ++j) { xn[j].x = bflo(xw[j]); xn[j].y = bfhi(xw[j]); } }
        float rstd; { const f32x4* sp = (const f32x4*)(ws + WS_SSQ2 + (size_t)row * 64); const f32x4 a = sp[0], b = sp[1], c = sp[2], d = sp[3];
            rstd = rsqrtf((((a.x + a.y) + (a.z + a.w)) + ((b.x + b.y) + (b.z + b.w)) + ((c.x + c.y) + (c.z + c.w)) + ((d.x + d.y) + (d.z + d.w))) * (1.f / DM) + EPS); }
        unsigned char* ppb = ws + WS_PART; const unsigned po = ((unsigned)x * MTOK + row) * 256u + 32u * (unsigned)c8;
        v4u ra[8], rb[8]; v4u ia0 = EID_LD(0), ia1 = EID_LD(1), ib0 = EID_LD(2), ib1 = EID_LD(3);
        peer_issue8(ra, ia0, ia1, U, c16); ia0 = EID_LD(4); ia1 = EID_LD(5);
#pragma unroll 1
        for (int q = 0; q < 16; q += 2) {
            peer_issue8(rb, ib0, ib1, U, c16); { const int qn = (q + 3 < 16) ? q + 3 : 15; ib0 = EID_LD(2 * qn); ib1 = EID_LD(2 * qn + 1); }
            float k0 = 0.f, k1 = 0.f;
#pragma unroll
            for (int i = 0; i < 8; ++i) { float d = dot16_fp8(ra[i], xn); if (i < 7) TIE_ROW(d, ra[i + 1]); d = red8(d); k0 = (c8 == i) ? d : k0; }
            peer_issue8(ra, ia0, ia1, U, c16); { const int qn = (q + 4 < 16) ? q + 4 : 15; ia0 = EID_LD(2 * qn); ia1 = EID_LD(2 * qn + 1); }
#pragma unroll
            for (int i = 0; i < 8; ++i) { float d = dot16_fp8(rb[i], xn); if (i < 7) TIE_ROW(d, rb[i + 1]); d = red8(d); k1 = (c8 == i) ? d : k1; }
            *(unsigned*)(ppb + (po + 2u * (unsigned)q)) = pk2(k0 * rstd, k1 * rstd);
        }
    }
}
__device__ __forceinline__ void peer_w_rows(const Frame& F, const Args& A) {
    unsigned char* ws = A.ws; const int lane = lane_id();
    const float* SU = (const float*)(ws + WS_SU); const float* SV = (const float*)(ws + WS_SV);
    const int p0 = 2 * lane, k0 = 8 * (p0 & 15) + (p0 >> 4), k1 = k0 + 8;
    for (int m0 = F.gw; m0 < MTOK; m0 += 4 * F.NGW) {
        int e0[4], e1[4]; float g0[4], g1[4]; unsigned pw[4][8];
#pragma unroll
        for (int r = 0; r < 4; ++r) { const size_t row = (size_t)(m0 + r * F.NGW < MTOK ? m0 + r * F.NGW : m0);
            const int* EID = (const int*)(ws + WS_EID) + row * 128; const float* GW = (const float*)(ws + WS_GW) + row * 128;
            e0[r] = EID[k0]; e1[r] = EID[k1]; g0[r] = GW[k0]; g1[r] = GW[k1];
#pragma unroll
            for (int x = 0; x < 8; ++x) pw[r][x] = *(const unsigned*)((const bf16*)(ws + WS_PART) + ((size_t)x * MTOK + row) * 128 + p0); }
        float su0[4], su1[4], sv0[4], sv1[4];
#pragma unroll
        for (int r = 0; r < 4; ++r) { su0[r] = SU[e0[r]]; su1[r] = SU[e1[r]]; sv0[r] = SV[e0[r]]; sv1[r] = SV[e1[r]]; }
#pragma unroll
        for (int r = 0; r < 4; ++r) { if (m0 + r * F.NGW < MTOK) { const size_t row = (size_t)(m0 + r * F.NGW); float s0 = 0.f, s1 = 0.f;
#pragma unroll
            for (int x = 0; x < 8; ++x) { s0 += bflo(pw[r][x]); s1 += bfhi(pw[r][x]); }
            float* W = (float*)(ws + WS_W) + row * 128;
            W[k0] = gelu_tanh(s0 * su0[r]) * g0[r] * sv0[r]; W[k1] = gelu_tanh(s1 * su1[r]) * g1[r] * sv1[r]; } }
    }
}
__device__ __forceinline__ void peer_v_chunk(const Frame& F, const Args& A, LAS unsigned char* lds, int x, int chunk) {
    unsigned char* ws = A.ws; int lane = lane_id(); asm volatile("" : "+v"(lane));
    const int tk = lane >> 3, c8 = lane & 7;
    const unsigned char* V = ws + WS_V8 + (size_t)x * 16384 * 128; const unsigned c16 = 16u * (unsigned)c8;
    LAS unsigned char* st = lds + F.wave * PS_WAVE;
    peer_stage16(st, ws + WS_EID + (size_t)(chunk * PQ_CHUNK + F.wave * 16) * 512, lane);
    peer_stage16(st + 16 * PS_ROW, ws + WS_W + (size_t)(chunk * PQ_CHUNK + F.wave * 16) * 512, lane);
#pragma unroll 1
    for (int oc = 0; oc < 2; ++oc) {
        const unsigned row = (unsigned)(chunk * PQ_CHUNK + F.wave * 16 + oc * 8 + tk);
        const LAS unsigned char* est = st + (oc * 8 + tk) * PS_ROW;
#define W_LD(i_) (*(const LAS f32x4*)(est + 16 * PS_ROW + 16 * (i_)))
        f32x2 acc[8];
#pragma unroll
        for (int j = 0; j < 8; ++j) acc[j] = (f32x2){0.f, 0.f};
        v4u ra[8], rb[8]; v4u ia0 = EID_LD(0), ia1 = EID_LD(1), ib0 = EID_LD(2), ib1 = EID_LD(3); f32x4 wa0 = W_LD(0), wa1 = W_LD(1), wb0 = W_LD(2), wb1 = W_LD(3);
        peer_issue8(ra, ia0, ia1, V, c16); ia0 = EID_LD(4); ia1 = EID_LD(5);
#pragma unroll 1
        for (int q = 0; q < 16; q += 2) {
            peer_issue8(rb, ib0, ib1, V, c16); { const int qn = (q + 3 < 16) ? q + 3 : 15; ib0 = EID_LD(2 * qn); ib1 = EID_LD(2 * qn + 1); }
            { const float wv[8] = {wa0.x, wa0.y, wa0.z, wa0.w, wa1.x, wa1.y, wa1.z, wa1.w};
#pragma unroll
              for (int i = 0; i < 8; ++i) { axpy16_fp8(acc, wv[i], ra[i]); if (i < 7) TIE_ROW(acc[7].y, ra[i + 1]); } }
            { const int qn = (q + 2 < 16) ? q + 2 : 15; wa0 = W_LD(2 * qn); wa1 = W_LD(2 * qn + 1); }
            peer_issue8(ra, ia0, ia1, V, c16); { const int qn = (q + 4 < 16) ? q + 4 : 15; ia0 = EID_LD(2 * qn); ia1 = EID_LD(2 * qn + 1); }
            { const float wv[8] = {wb0.x, wb0.y, wb0.z, wb0.w, wb1.x, wb1.y, wb1.z, wb1.w};
#pragma unroll
              for (int i = 0; i < 8; ++i) { axpy16_fp8(acc, wv[i], rb[i]); if (i < 7) TIE_ROW(acc[7].y, rb[i + 1]); } }
            { const int qn = (q + 3 < 16) ? q + 3 : 15; wb0 = W_LD(2 * qn); wb1 = W_LD(2 * qn + 1); }
        }
        unsigned char* xr = ws + WS_XN + (row * 2048u + 256u * (unsigned)x + 32u * (unsigned)c8); float ss = 0.f;
        const v4u x2a = *(const v4u*)xr, x2b = *(const v4u*)(xr + 16);
        const unsigned xw[8] = {x2a.x, x2a.y, x2a.z, x2a.w, x2b.x, x2b.y, x2b.z, x2b.w};
        unsigned ow[8];
#pragma unroll
        for (int j = 0; j < 4; ++j) { f32x4 v; v.x = bflo(xw[2 * j]) + acc[2 * j].x; v.y = bfhi(xw[2 * j]) + acc[2 * j].y; v.z = bflo(xw[2 * j + 1]) + acc[2 * j + 1].x; v.w = bfhi(xw[2 * j + 1]) + acc[2 * j + 1].y;
            ss += (v.x * v.x + v.y * v.y) + (v.z * v.z + v.w * v.w); ow[2 * j] = pk2(v.x, v.y); ow[2 * j + 1] = pk2(v.z, v.w); }
        *(v4u*)xr = (v4u){ow[0], ow[1], ow[2], ow[3]}; *(v4u*)(xr + 16) = (v4u){ow[4], ow[5], ow[6], ow[7]};
        ss = red8(ss);
        if (c8 == 0) ((float*)(ws + WS_SSQ3))[row * 8 + x] = ss;
    }
#undef W_LD
#undef EID_LD
}
__device__ __forceinline__ void peer_final_rows(const Frame& F, const Args& A) {
    unsigned char* ws = A.ws; const int lane = lane_id(); const float* g = A.in[32];
    for (int m = F.gw; m < MTOK; m += F.NGW) {
        const f32x4 sa = *(const f32x4*)((const float*)(ws + WS_SSQ3) + (size_t)m * 8), sb = *(const f32x4*)((const float*)(ws + WS_SSQ3) + (size_t)m * 8 + 4);
        const float rstd = rsqrtf((((sa.x + sa.y) + (sa.z + sa.w)) + ((sb.x + sb.y) + (sb.z + sb.w))) * (1.f / DM) + EPS);
        f32x4* xr = (f32x4*)(A.out + (size_t)m * DM) + lane; const v2u* xb = (const v2u*)((const bf16*)(ws + WS_XN) + (size_t)m * DM) + lane;
#pragma unroll
        for (int j = 0; j < 4; ++j) { const v2u w = xb[64 * j]; const f32x4 gg = ((const f32x4*)g)[lane + 64 * j]; const f32x4 v = {bflo(w.x), bfhi(w.x), bflo(w.y), bfhi(w.y)}; __builtin_nontemporal_store(v * rstd * gg, xr + 64 * j); }
    }
}

typedef GAS unsigned gu32;
#define RLX_AGENT __ATOMIC_RELAXED, __HIP_MEMORY_SCOPE_AGENT
#define XB_TMO      128
#define XB_XCNT(j)  (256  + 64 * (j))
#define XB_XSUB(j)  (1280 + 64 * (j))
#define XB_XGEN(j)  (2304 + 64 * (j))
#define XB_TOP      3328
#define XB_TOPGEN   3392
#define XCD_BAR_WORDS 3456
#define XB_SPIN_CAP (1u << 18)

__device__ __forceinline__ unsigned xb_ld(unsigned* p)              { return __hip_atomic_load(p, __ATOMIC_RELAXED, __HIP_MEMORY_SCOPE_AGENT); }
__device__ __forceinline__ unsigned xb_add(unsigned* p, unsigned v) { return __hip_atomic_fetch_add(p, v, __ATOMIC_RELAXED, __HIP_MEMORY_SCOPE_AGENT); }
__device__ __forceinline__ unsigned xb_xcc_id() { return (unsigned)__builtin_amdgcn_s_getreg((3 << 11) | 20) & 0xFu; }
#define XB_SPIN(cond, bar) do { unsigned _sp = 0; while (cond) { __builtin_amdgcn_s_sleep(1); \
    if ((++_sp & 255u) == 0u) { if (xb_ld(&(bar)[XB_TMO])) break; if (_sp > XB_SPIN_CAP) { atomicAdd(&(bar)[XB_TMO], 1u); break; } } } } while (0)

struct XcdBarrier {
    unsigned* bar; unsigned x;
    volatile LAS unsigned* st;
};

__device__ __forceinline__ XcdBarrier xcd_barrier_post(unsigned* bar, volatile LAS unsigned* st) {
    XcdBarrier b; b.bar = bar; b.x = xb_xcc_id(); b.st = st;
    if (threadIdx.x == 0) (void)xb_add(&bar[XB_XCNT(b.x)], 1u);
    return b;
}
__device__ __forceinline__ void xcd_barrier_complete(unsigned* bar, unsigned x, unsigned& nloc, unsigned& nx) {
    const unsigned G = gridDim.x * gridDim.y * gridDim.z;
    unsigned sum, cnt, mine, sp = 0u;
    for (;;) {
        sum = 0u; cnt = 0u; mine = 0u;
#pragma unroll
        for (unsigned j = 0; j < 16; ++j) { const unsigned c = xb_ld(&bar[XB_XCNT(j)]); sum += c; cnt += (c > 0u) ? 1u : 0u; mine = (j == x) ? c : mine; }
        if (sum == G) break;
        __builtin_amdgcn_s_sleep(1);
        if ((++sp & 255u) == 0u) { if (xb_ld(&bar[XB_TMO])) break; if (sp > XB_SPIN_CAP) { atomicAdd(&bar[XB_TMO], 1u); break; } }
    }
    nloc = mine > 0u ? mine : 1u; nx = cnt > 0u ? cnt : 1u;
}

__device__ __forceinline__ void xcd_barrier(const XcdBarrier& b) {
    asm volatile("s_waitcnt vmcnt(0)" ::: "memory");
    __syncthreads();
    if (threadIdx.x == 0) {
        unsigned* bar = b.bar;
        __builtin_amdgcn_s_waitcnt(0);
        unsigned nloc = b.st[0], nx = b.st[1];
        if (nloc == 0u) { xcd_barrier_complete(bar, b.x, nloc, nx); b.st[0] = nloc; b.st[1] = nx; }
        const unsigned old = xb_add(&bar[XB_XSUB(b.x)], 1u);
        const unsigned gen = old / nloc;
        if (old + 1u == (gen + 1u) * nloc) {
            __builtin_amdgcn_fence(__ATOMIC_RELEASE, "agent");
            asm volatile("s_waitcnt vmcnt(0)" ::: "memory");
            const unsigned og = xb_add(&bar[XB_TOP], 1u);
            const unsigned tg = og / nx;
            if (og + 1u == (tg + 1u) * nx) xb_add(&bar[XB_TOPGEN], 1u);
            else XB_SPIN(xb_ld(&bar[XB_TOPGEN]) == tg, bar);
            __builtin_amdgcn_fence(__ATOMIC_ACQUIRE, "agent");
            xb_add(&bar[XB_XGEN(b.x)], 1u);
            asm volatile("s_waitcnt vmcnt(0)" ::: "memory");
        } else {
            XB_SPIN(xb_ld(&bar[XB_XGEN(b.x)]) == gen, bar);
            __builtin_amdgcn_fence(__ATOMIC_ACQUIRE, "agent");
            asm volatile("s_waitcnt vmcnt(0)" ::: "memory");
        }
    }
    __syncthreads();
}

#ifndef DBL_MASK
#define DBL_MASK 0
#endif
constexpr int NPHASE = 12;
__global__ void __launch_bounds__(512, 2) fwd_kernel(Args args) {
    extern __shared__ __attribute__((aligned(16))) unsigned char lds_raw[];
    LAS unsigned char* lds = (LAS unsigned char*)lds_raw;
    Frame F;
    F.tid = threadIdx.x; F.lane = F.tid & 63; F.wave = __builtin_amdgcn_readfirstlane(F.tid >> 6);
    F.G = gridDim.x; { const int bx = blockIdx.x; F.vcu = (F.G % 8 == 0) ? (bx % 8) * (F.G / 8) + bx / 8 : bx; }
    F.gw = F.vcu * 8 + F.wave; F.NGW = F.G * 8;
    unsigned char* ws = args.ws;
    const int lo = args.ph_lo, hi = args.ph_hi;
    volatile LAS unsigned* MISC = (volatile LAS unsigned*)(lds + LDS_BYTES - 64);
    if (F.tid < 16) MISC[F.tid] = 0u;
    __syncthreads();
    XcdBarrier bar = xcd_barrier_post((unsigned*)(ws + WS_CTL), MISC);
#define IN(k) (lo <= (k) && (k) < hi)
#define SEAM(k) do { if (IN(k) && IN((k) + 1)) xcd_barrier(bar); } while (0)

    if (IN(0)) for (int rep_ = 0; rep_ <= ((DBL_MASK >> 0) & 1); ++rep_) { if (rep_) xcd_barrier(bar); REFRESH_LANE(F); p0_prologue(F, args, lds); }
    SEAM(0);
    if (IN(1)) for (int rep_ = 0; rep_ <= ((DBL_MASK >> 1) & 1); ++rep_) { if (rep_) xcd_barrier(bar); REFRESH_LANE(F);
        { pg8::Gemm g{(const bf16*)(ws + WS_XN), (const bf16*)(ws + WS_WIN), MTOK, NZP, DM}; pg8::StaticOrder S; S.init(MTOK, NZP, F.G, (int)blockIdx.x);
          pg8::EpiZ E{(bf16*)(ws + WS_Z), (bf16*)(ws + WS_KSF), (bf16*)(ws + WS_VSF), (bf16*)(ws + WS_KWF), (bf16*)(ws + WS_VWF), (float*)(ws + WS_GATES), args.in[4]};
          pg8::gemm_phase<pg8::EpiZ, pg8::StaticOrder, true, true>(lds, g, S, E, F.wave); }
        { pg8::Gemm g{(const bf16*)(ws + WS_MEMN), (const bf16*)(ws + WS_WMK), NB * NMEM, DM, DM}; pg8::StaticOrder S; S.init(NB * NMEM, DM, F.G, ((int)blockIdx.x + 128) & 255);
          pg8::EpiStore E{(bf16*)(ws + WS_MEMK), DM, nullptr, 1};
          pg8::gemm_phase<pg8::EpiStore, pg8::StaticOrder, true, true>(lds, g, S, E, F.wave); }
        { pg8::Gemm g{(const bf16*)(ws + WS_WMV), (const bf16*)(ws + WS_MEMN), DM, NB * NMEM, DM}; pg8::StaticOrder S; S.init(DM, NB * NMEM, F.G, ((int)blockIdx.x + 120) & 255);
          pg8::EpiVFrag E{(bf16*)(ws + WS_MEMVT)};
          pg8::gemm_phase<pg8::EpiVFrag, pg8::StaticOrder, true, true>(lds, g, S, E, F.wave); }
    }
    SEAM(1);
    if (IN(2)) for (int rep_ = 0; rep_ <= ((DBL_MASK >> 2) & 1); ++rep_) { if (rep_) xcd_barrier(bar); REFRESH_LANE(F); for (int it = F.gw; it < 2048; it += F.NGW) kmax_item(F, args, it);
                 for (int it = F.vcu; it < 256; it += F.G) lru_local_item(F, args, lds, it);
                 for (int it = F.G - 1 - F.vcu; it < 128; it += F.G) compress_item(F, args, lds, it); }
    SEAM(2);
    if (IN(3)) for (int rep_ = 0; rep_ <= ((DBL_MASK >> 3) & 1); ++rep_) { if (rep_) xcd_barrier(bar); REFRESH_LANE(F);
                 { unsigned* ctl = (unsigned*)(ws + WS_CTL); const int own = (int)(((long)F.vcu * 8) / F.G) & 7; int qs = 0;
                   for (;;) { int id = -1;
                       if (lane_id() == 0) { while (qs < 8) { const int x = (own + qs) & 7; const unsigned c = __hip_atomic_fetch_add(ctl + CW_NQ + 64 * x, 1u, __ATOMIC_RELAXED, __HIP_MEMORY_SCOPE_AGENT);
                               if (c < 512u) { id = x * 512 + (int)c; break; } ++qs; } }
                       id = __builtin_amdgcn_readfirstlane(id); qs = __builtin_amdgcn_readfirstlane(qs);
                       if (id < 0) break;
                       if (F.G == 256) { quant_rows4_fp8(args.in[31] + (size_t)id * DM, (size_t)4096 * DM, nullptr, ws + WS_V8 + (size_t)id * 128, (float*)(ws + WS_SV) + id, 4096, lane_id());
 }
                       const int x = id >> 9, i = id & 511; nsa_item(F, args, lds, x >> 2, (x >> 1) & 1, 2 * (63 - (i >> 3)) + (x & 1), 7 - (i & 7)); } }
                 __syncthreads(); REFRESH_LANE(F);
                 for (int it = F.vcu; it < 256; it += F.G) lru_fix_item(F, args, lds, it, false); }
    SEAM(3);
    if (IN(4)) for (int rep_ = 0; rep_ <= ((DBL_MASK >> 4) & 1); ++rep_) { if (rep_) xcd_barrier(bar); REFRESH_LANE(F);
        pg8::Gemm g{(const bf16*)(ws + WS_Y), (const bf16*)(ws + WS_WOUT), MTOK, DM, DM}; pg8::StaticOrder S; S.init(MTOK, DM, F.G, (int)blockIdx.x);
        pg8::EpiRes<true> E{args.in[0], nullptr, nullptr, (bf16*)(ws + WS_XN), (float*)(ws + WS_SSQ1), (const float*)(ws + WS_SSQN)};
        pg8::gemm_phase<pg8::EpiRes<true>, pg8::StaticOrder, true, true>(lds, g, S, E, F.wave);
    }
    SEAM(4);
    if (IN(5)) for (int rep_ = 0; rep_ <= ((DBL_MASK >> 5) & 1); ++rep_) { if (rep_) xcd_barrier(bar); REFRESH_LANE(F);
        pg8::Gemm g{(const bf16*)(ws + WS_XN), (const bf16*)(ws + WS_WMQ), MTOK, DM, DM}; pg8::StaticOrder S; S.init(MTOK, DM, F.G, (int)blockIdx.x);
        pg8::EpiStore E{(bf16*)(ws + WS_QM), DM, (const float*)(ws + WS_SSQ1), 1};
        pg8::gemm_phase<pg8::EpiStore, pg8::StaticOrder, true, true>(lds, g, S, E, F.wave);
    }
    SEAM(5);
    if (IN(6)) for (int rep_ = 0; rep_ <= ((DBL_MASK >> 6) & 1); ++rep_) { if (rep_) xcd_barrier(bar); REFRESH_LANE(F); for (int it = F.gw; it < 2048; it += F.NGW) memattn_item(F, args, it); }
    SEAM(6);
    if (IN(7)) for (int rep_ = 0; rep_ <= ((DBL_MASK >> 7) & 1); ++rep_) { if (rep_) xcd_barrier(bar); REFRESH_LANE(F);
        pg8::Gemm g{(const bf16*)(ws + WS_OM), (const bf16*)(ws + WS_WMO), MTOK, DM, DM}; pg8::StaticOrder S; S.init(MTOK, DM, F.G, (int)blockIdx.x);
        pg8::EpiRes<false> E{nullptr, (const bf16*)(ws + WS_XN), nullptr, (bf16*)(ws + WS_XN), (float*)(ws + WS_SSQ2), nullptr};
        pg8::gemm_phase<pg8::EpiRes<false>, pg8::StaticOrder, true, true>(lds, g, S, E, F.wave);
    }
    SEAM(7);
    if (IN(8)) for (int rep_ = 0; rep_ <= ((DBL_MASK >> 8) & 1); ++rep_) { if (rep_) xcd_barrier(bar); REFRESH_LANE(F);
        pg8::Gemm g{(const bf16*)(ws + WS_XN), (const bf16*)(ws + WS_WPQ), MTOK, 2048, DM}; pg8::StaticOrder S; S.init(MTOK, 2048, F.G, (int)blockIdx.x);
        pg8::EpiStore E{(bf16*)(ws + WS_QP), 2048, (const float*)(ws + WS_SSQ2), 1};
        pg8::gemm_phase<pg8::EpiStore, pg8::StaticOrder, true, true>(lds, g, S, E, F.wave);
    }
    SEAM(8);
    if (IN(9)) for (int rep_ = 0; rep_ <= ((DBL_MASK >> 9) & 1); ++rep_) { if (rep_) xcd_barrier(bar); REFRESH_LANE(F); for (int gi = F.vcu; gi < 256; gi += F.G) {
                     const int h = gi & 7, tgp = gi >> 3;
                     { const v4u* src = (const v4u*)((const bf16*)(ws + WS_SKEY) + (size_t)h * 8 * 4096); const int tid = F.wave * 64 + lane_id();
#pragma unroll
                       for (int i = 0; i < 8; ++i) ((LAS v4u*)lds)[tid + 512 * i] = src[tid + 512 * i]; }
                     __syncthreads();
                     peer_topk_item<true>(F, args, (tgp * 16 + F.wave) * 8 + h, lds); peer_topk_item<true>(F, args, (tgp * 16 + 8 + F.wave) * 8 + h, lds);
                     __syncthreads(); } }
    SEAM(9);
    if (IN(10)) {   REFRESH_LANE(F);
        LAS int* bc = (LAS int*)(lds + LDS_BYTES - 128); unsigned* ctl = (unsigned*)(ws + WS_CTL); const int own = (int)(bar.x & 7u);
        { int qs = 0; for (;;) { const int id = __builtin_amdgcn_readfirstlane(pq_pop(ctl, 0, own, qs, bc, F.wave)); if (id < 0) break; peer_u_chunk(F, args, lds, id / PQ_NCHUNK, id % PQ_NCHUNK); } }
        xcd_barrier(bar);
        peer_w_rows(F, args);
        xcd_barrier(bar);
        { int qs = 0; for (;;) { const int id = __builtin_amdgcn_readfirstlane(pq_pop(ctl, 1, own, qs, bc, F.wave)); if (id < 0) break; peer_v_chunk(F, args, lds, id / PQ_NCHUNK, id % PQ_NCHUNK); } }
        xcd_barrier(bar);
        peer_final_rows(F, args);
    }
#undef IN
#undef SEAM
}

extern "C" void kernel_launch(void* const* d_in, const int* in_sizes, int n_in, void* d_out, int out_size, void* d_ws, size_t ws_size, hipStream_t stream) {
    static int grid = 0;
    if (grid == 0) {
        if (n_in != 33 || out_size != MTOK * DM || ws_size < WS_END) { fprintf(stderr, "kernel_launch: unexpected problem (n_in %d, out %d, ws %zu)\n", n_in, out_size, ws_size); grid = -1; return; }
        int dev = 0, cus = 0, per_cu = 0;
        (void)hipGetDevice(&dev); (void)hipDeviceGetAttribute(&cus, hipDeviceAttributeMultiprocessorCount, dev);
        (void)hipFuncSetAttribute((const void*)fwd_kernel, hipFuncAttributeMaxDynamicSharedMemorySize, LDS_BYTES);
        (void)hipOccupancyMaxActiveBlocksPerMultiprocessor(&per_cu, (const void*)fwd_kernel, 512, LDS_BYTES);
        if (per_cu < 1) { fprintf(stderr, "kernel_launch: occupancy query says %d blocks per CU\n", per_cu); per_cu = 1; }
        grid = cus * 1;
        if (grid != 256) fprintf(stderr, "kernel_launch: %d CUs (built for 256)\n", cus);
    }
    if (grid < 0) return;
    (void)hipMemsetAsync((char*)d_ws + WS_CTL, 0, 65536, stream);
    Args a{};
    for (int i = 0; i < 33; ++i) a.in[i] = (const float*)d_in[i];
    a.out = (float*)d_out; a.ws = (unsigned char*)d_ws; a.ph_lo = 0; a.ph_hi = NPHASE;
    void* kargs[] = {&a};
    hipError_t e = hipLaunchCooperativeKernel((const void*)fwd_kernel, dim3(grid), dim3(512), kargs, LDS_BYTES, stream);
    if (e != hipSuccess) fprintf(stderr, "cooperative launch failed: %s (grid %d)\n", hipGetErrorString(e), grid);
}
```

```cpp
#include <hip/hip_runtime.h>
#include <cstdio>
#include <cstdint>

namespace pg8 {
#define PG8_LAS __attribute__((address_space(3)))
typedef unsigned short bf16_t;
typedef short bf16x8 __attribute__((ext_vector_type(8)));
typedef float f32x4 __attribute__((ext_vector_type(4)));
typedef unsigned u32x4 __attribute__((ext_vector_type(4)));
constexpr int BM = 256, BK = 64, HALF = 128, HTB = HALF * BK * 2  , STAGE_BYTES = 8 * HTB, NXCD = 8, WGM = 8;

__host__ __device__ __forceinline__ int lds_byte(int r, int c) { const int st = (r >> 4) * 2 + (c >> 5), rr = r & 15, cc = c & 31, ob = rr * 64 + cc * 2; return st * 1024 + (ob ^ (((ob >> 9) & 1) << 5)); }
__host__ __device__ __forceinline__ void stage_rc(int b, int& R, int& C) { const int st = b / 1024, sb = b % 1024, swz = sb ^ (((sb >> 9) & 1) << 5); R = (st >> 1) * 16 + swz / 64; C = (st & 1) * 32 + (swz % 64) / 2; }
__host__ __device__ __forceinline__ int perm32(int rho) { const int n = rho >> 4, i = rho & 15; return 8 * (i >> 2) + 4 * n + (i & 3); }

struct Unit { int pm, pn; };
struct Gemm { const bf16_t* A; const bf16_t* Bt; int M, N, K; };

struct StaticOrder {
    int nM, nN, nwg, G, c;
    __host__ __device__ void init(int M, int N, int G_, int c_) { nM = M / BM; nN = N / BM; nwg = nM * nN; G = G_; c = c_; }
    __host__ __device__ bool next(int i, Unit& u) const {
        const long L = (long)i * G + c; if (L >= nwg) return false;
        int wgid = (int)L; { const int q = nwg / NXCD, r = nwg % NXCD, xcd = wgid % NXCD, off = wgid / NXCD; wgid = (xcd < r ? xcd * (q + 1) : r * (q + 1) + (xcd - r) * q) + off; }
        const int nig = WGM * nN, gid = wgid / nig, fm = gid * WGM, gsz = (nM - fm) < WGM ? (nM - fm) : WGM;
        u.pm = fm + ((wgid % nig) % gsz); u.pn = (wgid % nig) / gsz; return true;
    }
    __device__ __forceinline__ void a_ready(const Unit&) const {}
    __device__ __forceinline__ void done(const Unit&) const {}
};

__device__ __forceinline__ unsigned cvt_pk_bf16(float lo, float hi) { unsigned r; asm volatile("v_cvt_pk_bf16_f32 %0, %1, %2" : "=v"(r) : "v"(lo), "v"(hi)); return r; }
typedef float f32x2 __attribute__((ext_vector_type(2)));
typedef unsigned u32x2 __attribute__((ext_vector_type(2)));
__device__ __forceinline__ unsigned short f2bf1(float f) { unsigned u = __builtin_bit_cast(unsigned, f); return (unsigned short)((u + 0x7fffu + ((u >> 16) & 1u)) >> 16); }
struct EpiZ {
    static constexpr bool PERM = true, AFTER_DRAIN = false, MIDSCALE = false;
    bf16_t* Z; bf16_t* KSF; bf16_t* VSF; bf16_t* KWF; bf16_t* VWF; float* GATES; const float* bgate;
    __device__ __forceinline__ void operator()(const f32x4 (&acc)[2][2][4][2], const Unit& u, int wr, int wc, int fr, int fq) const {
        const int row0 = u.pm * BM + wr * 64 + fr;
        if (u.pn < 9) {
            const int col0 = u.pn * BM + wc * 32 + 8 * fq;
#pragma unroll
            for (int ai = 0; ai < 2; ++ai)
#pragma unroll
                for (int m = 0; m < 4; ++m) { bf16_t* rowp = Z + (size_t)(row0 + ai * HALF + m * 16) * 2304 + col0;
#pragma unroll
                    for (int bj = 0; bj < 2; ++bj) { const f32x4 v0 = acc[ai][bj][m][0], v1 = acc[ai][bj][m][1];
                        u32x4 w; w.x = cvt_pk_bf16(v0[0], v0[1]); w.y = cvt_pk_bf16(v0[2], v0[3]); w.z = cvt_pk_bf16(v1[0], v1[1]); w.w = cvt_pk_bf16(v1[2], v1[3]);
                        *(u32x4*)(rowp + bj * HALF) = w; } }
            if (u.pn >= 7) {
                bf16_t* KF = (u.pn == 7) ? KSF : KWF; bf16_t* VF = (u.pn == 7) ? VSF : VWF;
                const int kvh = wc >> 1, dbase = 32 * (wc & 1) + 8 * fq;
#pragma unroll
                for (int ai = 0; ai < 2; ++ai)
#pragma unroll
                    for (int m = 0; m < 4; ++m) { const int row = row0 + ai * HALF + m * 16, b = row >> 13, s = row & 8191, tile = s >> 5, k = s & 31;
                        const size_t tb = ((size_t)(b * 2 + kvh) * 256 + tile) * 2048;
                        { const f32x4 v0 = acc[ai][0][m][0], v1 = acc[ai][0][m][1];
                          u32x4 w; w.x = cvt_pk_bf16(v0[0], v0[1]); w.y = cvt_pk_bf16(v0[2], v0[3]); w.z = cvt_pk_bf16(v1[0], v1[1]); w.w = cvt_pk_bf16(v1[2], v1[3]);
                          *(u32x4*)(KF + tb + (dbase >> 4) * 512 + ((dbase >> 3) & 1) * 256 + k * 8) = w; }
                        const int kk = k & 15, vo = ((kk >> 2) & 1) * 512 + (k >> 4) * 8 + (kk & 3) + 4 * (kk >> 3);
                        unsigned char* V8 = (unsigned char*)VF + ((size_t)(b * 2 + kvh) * 256 + tile) * 2048;
#pragma unroll
                        for (int n = 0; n < 2; ++n) { const f32x4 v = acc[ai][1][m][n]; int w = 0; w = __builtin_amdgcn_cvt_pk_fp8_f32(v[0], v[1], w, false); w = __builtin_amdgcn_cvt_pk_fp8_f32(v[2], v[3], w, true);
#pragma unroll
                            for (int e = 0; e < 4; ++e) { const int d = dbase + 4 * n + e; V8[(d >> 5) * 1024 + (d & 31) * 16 + vo] = (unsigned char)((unsigned)w >> (8 * e)); } }
                        asm volatile("" ::: "memory"); }
            }
        } else {
            if (wc == 0 && fq < 3) {
#pragma unroll
                for (int ai = 0; ai < 2; ++ai)
#pragma unroll
                    for (int m = 0; m < 4; ++m) { const int row = row0 + ai * HALF + m * 16;
#pragma unroll
                        for (int n = 0; n < 2; ++n)
#pragma unroll
                            for (int e = 0; e < 4; ++e) { const int c = 8 * fq + 4 * n + e; const float v = acc[ai][0][m][n][e] + bgate[c]; GATES[(size_t)row * 24 + c] = 1.0f / (1.0f + __expf(-v)); } }
            }
        }
    }
};
struct EpiStore {
    static constexpr bool PERM = true, AFTER_DRAIN = false, MIDSCALE = false;
    bf16_t* O; int ldc; const float* ssq; int frag;
    __device__ __forceinline__ void operator()(const f32x4 (&acc)[2][2][4][2], const Unit& u, int wr, int wc, int fr, int fq) const {
        const int row0 = u.pm * BM + wr * 64 + fr; const int col0 = u.pn * BM + wc * 32 + 8 * fq;
#pragma unroll
        for (int ai = 0; ai < 2; ++ai)
#pragma unroll
            for (int m = 0; m < 4; ++m) { const int row = row0 + ai * HALF + m * 16;
                bf16_t* rowp = frag ? O + (size_t)(row >> 5) * 32 * ldc + (size_t)(col0 >> 4) * 512 + ((col0 >> 3) & 1) * 256 + (row & 31) * 8 : O + (size_t)row * ldc + col0;
                const int bjstep = frag ? (HALF >> 4) * 512 : HALF;
                float sc = 1.f;
                if (ssq) { const f32x4* p = (const f32x4*)(ssq + (size_t)row * 16); const f32x4 a = p[0], b = p[1], c = p[2], d = p[3];
                    const float s = ((a[0] + a[1]) + (a[2] + a[3])) + ((b[0] + b[1]) + (b[2] + b[3])) + ((c[0] + c[1]) + (c[2] + c[3])) + ((d[0] + d[1]) + (d[2] + d[3]));
                    sc = rsqrtf(s * (1.0f / 1024.0f) + 1e-6f); }
#pragma unroll
                for (int bj = 0; bj < 2; ++bj) { const f32x4 v0 = acc[ai][bj][m][0] * sc, v1 = acc[ai][bj][m][1] * sc;
                    u32x4 w; w.x = cvt_pk_bf16(v0[0], v0[1]); w.y = cvt_pk_bf16(v0[2], v0[3]); w.z = cvt_pk_bf16(v1[0], v1[1]); w.w = cvt_pk_bf16(v1[2], v1[3]);
                    *(u32x4*)(rowp + bj * bjstep) = w; } }
    }
};
struct EpiVFrag {
    static constexpr bool PERM = true, AFTER_DRAIN = false, MIDSCALE = false;
    bf16_t* O;
    __device__ __forceinline__ void operator()(const f32x4 (&acc)[2][2][4][2], const Unit& u, int wr, int wc, int fr, int fq) const {
        const int row0 = u.pm * BM + wr * 64 + fr; const int col0 = u.pn * BM + wc * 32 + 8 * fq;
#pragma unroll
        for (int ai = 0; ai < 2; ++ai)
#pragma unroll
            for (int m = 0; m < 4; ++m) { const int D = row0 + ai * HALF + m * 16, h = D >> 8, dt = (D >> 5) & 7, r = D & 31;
#pragma unroll
                for (int bj = 0; bj < 2; ++bj) { const int K0 = col0 + bj * HALF, b = K0 >> 8, kt = (K0 >> 5) & 7, k0 = K0 & 31;
                    bf16_t* p = O + (size_t)((b * 4 + h) * 8 + kt) * 8192 + dt * 1024 + (k0 >> 4) * 512 + r * 8 + 4 * ((k0 >> 3) & 1);
                    const f32x4 v0 = acc[ai][bj][m][0], v1 = acc[ai][bj][m][1];
                    u32x2 w0, w1; w0.x = cvt_pk_bf16(v0[0], v0[1]); w0.y = cvt_pk_bf16(v0[2], v0[3]); w1.x = cvt_pk_bf16(v1[0], v1[1]); w1.y = cvt_pk_bf16(v1[2], v1[3]);
                    *(u32x2*)p = w0; *(u32x2*)(p + 256) = w1; } }
    }
};
template <bool MID> struct EpiRes {
    static constexpr bool PERM = false, AFTER_DRAIN = false, MIDSCALE = MID;
    const float* base; const bf16_t* base16; float* out; bf16_t* XB; float* ssq; const float* ssqn;
    __device__ __forceinline__ void midscale(f32x4 (&acc)[2][2][4][2], const Unit& u, int wr, int wc, int fr, int fq) const {
        const int row0 = u.pm * BM + wr * 64 + fr;
#pragma unroll
        for (int ai = 0; ai < 2; ++ai)
#pragma unroll
            for (int m = 0; m < 4; ++m) { const int row = row0 + ai * HALF + m * 16; const f32x2 sq = *(const f32x2*)(ssqn + (size_t)row * 2);
                const float sc = rsqrtf((sq[0] + sq[1]) * (1.0f / 512.0f) + 1e-6f);
#pragma unroll
                for (int bj = 0; bj < 2; ++bj)
#pragma unroll
                    for (int n = 0; n < 2; ++n) acc[ai][bj][m][n] = acc[ai][bj][m][n] * sc; }
    }
    __device__ __forceinline__ void operator()(const f32x4 (&acc)[2][2][4][2], const Unit& u, int wr, int wc, int fr, int fq) const {
        const int row0 = u.pm * BM + wr * 64 + fr; const int col0 = u.pn * BM + wc * 32 + 4 * fq;
#pragma unroll
        for (int ai = 0; ai < 2; ++ai)
#pragma unroll
            for (int m = 0; m < 4; ++m) { const int row = row0 + ai * HALF + m * 16; const size_t off = (size_t)row * 1024 + col0; float s = 0.f;
#pragma unroll
                for (int bj = 0; bj < 2; ++bj)
#pragma unroll
                    for (int n = 0; n < 2; ++n) { f32x4 b;
                        if (base) b = *(const f32x4*)(base + off + bj * HALF + n * 16);
                        else { const u32x2 w = *(const u32x2*)(base16 + off + bj * HALF + n * 16); b[0] = __builtin_bit_cast(float, w.x << 16); b[1] = __builtin_bit_cast(float, w.x & 0xffff0000u); b[2] = __builtin_bit_cast(float, w.y << 16); b[3] = __builtin_bit_cast(float, w.y & 0xffff0000u); }
                        const f32x4 v = b + acc[ai][bj][m][n];
                        if (out) *(f32x4*)(out + off + bj * HALF + n * 16) = v;
                        s += (v[0] * v[0] + v[1] * v[1]) + (v[2] * v[2] + v[3] * v[3]);
                        u32x2 w; w.x = cvt_pk_bf16(v[0], v[1]); w.y = cvt_pk_bf16(v[2], v[3]); *(u32x2*)(XB + off + bj * HALF + n * 16) = w; }
                s += __shfl_xor(s, 16); s += __shfl_xor(s, 32);
                if (fq == 0) ssq[(size_t)row * 16 + u.pn * 4 + wc] = s;
                asm volatile("" ::: "memory"); }
    }
};
template <class Epi, class Sched, bool ALIGN_EPI = false, bool SP2 = false>
__device__ __forceinline__ void gemm_phase(PG8_LAS unsigned char* lds, const Gemm g, const Sched& S, const Epi& E, int wave  ) {
    int lane; asm volatile("v_mbcnt_lo_u32_b32 %0, -1, 0\n\tv_mbcnt_hi_u32_b32 %0, -1, %0" : "=v"(lane));
    const int wid = wave, tid = wid * 64 + lane, wr = wid >> 2, wc = wid & 3, fr = lane & 15, fq = lane >> 4;
    const int K = g.K, nt = K / BK;
    unsigned voffA[2], voffB[2];
#pragma unroll
    for (int i = 0; i < 2; ++i) { int R, C; stage_rc(tid * 16 + i * 8192, R, C); const int Rb = Epi::PERM ? ((R & ~31) + perm32(R & 31)) : R;
        voffA[i] = (unsigned)(R * K + C) * 2u; voffB[i] = (unsigned)(Rb * K + C) * 2u; }
    const size_t kstep = (size_t)(BK * 2);
    const size_t hstep = (size_t)HALF * K * 2;
    const size_t tstep = 2 * hstep;
    const unsigned ldsw = (unsigned)wid * 1024u;
    const int aoff = lds_byte(wr * 64 + fr, fq * 8), boff = lds_byte(wc * 32 + fr, fq * 8);
#define PG8_SA(b, h) (((b) * 2 + (h)) * HTB)
#define PG8_SB(b, h) ((4 + (b) * 2 + (h)) * HTB)
#define PG8_STAGE(bufoff, gbase, voff) do { _Pragma("unroll") for (int _i = 0; _i < 2; ++_i) \
        __builtin_amdgcn_global_load_lds((const unsigned*)((const char*)(gbase) + (voff)[_i]), (PG8_LAS unsigned*)(lds + (bufoff) + ldsw + _i * 8192), 16, 0, 0); } while (0)
#define PG8_LDA(dst, b, h) do { _Pragma("unroll") for (int m = 0; m < 4; ++m) _Pragma("unroll") for (int k = 0; k < 2; ++k) dst[m][k] = *(const PG8_LAS bf16x8*)(lds + PG8_SA(b, h) + aoff + m * 2048 + k * 1024); } while (0)
#define PG8_LDB(dst, b, h) do { _Pragma("unroll") for (int n = 0; n < 2; ++n) _Pragma("unroll") for (int k = 0; k < 2; ++k) dst[n][k] = *(const PG8_LAS bf16x8*)(lds + PG8_SB(b, h) + boff + n * 2048 + k * 1024); } while (0)
#define PG8_MMA(ai, bj, At, Bt) do { __builtin_amdgcn_s_setprio(1); _Pragma("unroll") for (int m = 0; m < 4; ++m) _Pragma("unroll") for (int n = 0; n < 2; ++n) _Pragma("unroll") for (int k = 0; k < 2; ++k) \
        acc[ai][bj][m][n] = __builtin_amdgcn_mfma_f32_16x16x32_bf16(Bt[n][k], At[m][k], acc[ai][bj][m][n], 0, 0, 0); __builtin_amdgcn_s_setprio(0); } while (0)
#define PG8_WAIT_V(n) asm volatile("s_waitcnt vmcnt(" #n ")" ::: "memory")
#define PG8_WAIT_L(n) asm volatile("s_waitcnt lgkmcnt(" #n ")" ::: "memory")
#define PG8_BAR __builtin_amdgcn_s_barrier()
#define PG8_SCHED __builtin_amdgcn_sched_barrier(0)
    Unit cur, nxt; int ui = 0;
    if (!S.next(0, cur)) return;
    f32x4 acc[2][2][4][2];
#pragma unroll
    for (int a = 0; a < 2; ++a)
#pragma unroll
        for (int b = 0; b < 2; ++b)
#pragma unroll
            for (int m = 0; m < 4; ++m)
#pragma unroll
                for (int n = 0; n < 2; ++n) acc[a][b][m][n] = (f32x4){0.f, 0.f, 0.f, 0.f};
    bf16x8 At[4][2], B0[2][2], B1[2][2];
    const char* cA = (const char*)g.A + (size_t)cur.pm * tstep; const char* cB = (const char*)g.Bt + (size_t)cur.pn * tstep;
    S.a_ready(cur);
    if constexpr (SP2) {
        PG8_STAGE(PG8_SB(0, 0), cB, voffB); PG8_STAGE(PG8_SB(0, 1), cB + hstep, voffB); PG8_STAGE(PG8_SA(0, 0), cA, voffA); PG8_STAGE(PG8_SA(0, 1), cA + hstep, voffA);
        if (wr == 1) PG8_BAR;
        PG8_WAIT_V(2); PG8_BAR;
        PG8_STAGE(PG8_SB(1, 0), cB + kstep, voffB); PG8_STAGE(PG8_SA(1, 0), cA + kstep, voffA); PG8_STAGE(PG8_SB(1, 1), cB + hstep + kstep, voffB);
        PG8_WAIT_V(6); PG8_BAR;
    } else {
        PG8_STAGE(PG8_SB(0, 0), cB, voffB); PG8_STAGE(PG8_SA(0, 0), cA, voffA); PG8_STAGE(PG8_SB(0, 1), cB + hstep, voffB); PG8_STAGE(PG8_SA(0, 1), cA + hstep, voffA);
        if (wr == 1) PG8_BAR;
        PG8_WAIT_V(4); PG8_BAR;
        PG8_STAGE(PG8_SB(1, 0), cB + kstep, voffB); PG8_STAGE(PG8_SA(1, 0), cA + kstep, voffA); PG8_STAGE(PG8_SB(1, 1), cB + hstep + kstep, voffB);
        PG8_WAIT_V(6); PG8_BAR;
    }
    for (;;) {
        const bool has_next = S.next(ui + 1, nxt);
        const char* nA = has_next ? (const char*)g.A + (size_t)nxt.pm * tstep : cA; const char* nB = has_next ? (const char*)g.Bt + (size_t)nxt.pn * tstep : cB;
        for (int t = 0; t < nt; t += 2) {
            if constexpr (Epi::MIDSCALE) { if (t == nt / 2) E.midscale(acc, cur, wr, wc, fr, fq); }
            const bool last = (t == nt - 2);
            const char* a1 = cA + (size_t)(t + 1) * kstep;
            const char* a2 = last ? nA : cA + (size_t)(t + 2) * kstep; const char* b2 = last ? nB : cB + (size_t)(t + 2) * kstep;
            const char* a3 = a2 + kstep; const char* b3 = b2 + kstep;
            if (last && has_next) S.a_ready(nxt);
            if constexpr (SP2) {
            PG8_LDB(B0, 0, 0); PG8_LDB(B1, 0, 1); PG8_SCHED; PG8_LDA(At, 0, 0); PG8_STAGE(PG8_SA(1, 1), a1 + hstep, voffA);
            PG8_WAIT_V(8); PG8_WAIT_L(0); PG8_BAR; PG8_MMA(0, 0, At, B0); PG8_MMA(0, 1, At, B1); PG8_BAR; PG8_SCHED;
            PG8_LDA(At, 0, 1); PG8_STAGE(PG8_SB(0, 0), b2, voffB); PG8_STAGE(PG8_SB(0, 1), b2 + hstep, voffB); PG8_STAGE(PG8_SA(0, 0), a2, voffA);
            PG8_WAIT_V(8); PG8_WAIT_L(0); PG8_BAR; PG8_MMA(1, 0, At, B0); PG8_MMA(1, 1, At, B1); PG8_BAR; PG8_SCHED;
            PG8_LDB(B0, 1, 0); PG8_LDB(B1, 1, 1); PG8_SCHED; PG8_LDA(At, 1, 0); PG8_STAGE(PG8_SA(0, 1), a2 + hstep, voffA);
            PG8_WAIT_V(8); PG8_WAIT_L(0); PG8_BAR; PG8_MMA(0, 0, At, B0); PG8_MMA(0, 1, At, B1); PG8_BAR; PG8_SCHED;
            PG8_LDA(At, 1, 1); PG8_STAGE(PG8_SB(1, 0), b3, voffB); PG8_STAGE(PG8_SB(1, 1), b3 + hstep, voffB); PG8_STAGE(PG8_SA(1, 0), a3, voffA);
            PG8_WAIT_V(8); PG8_WAIT_L(0); PG8_BAR; PG8_MMA(1, 0, At, B0); PG8_MMA(1, 1, At, B1); PG8_BAR; PG8_SCHED;
            } else {
            PG8_LDB(B0, 0, 0); PG8_SCHED; PG8_LDA(At, 0, 0); PG8_STAGE(PG8_SA(1, 1), a1 + hstep, voffA);
            PG8_WAIT_L(8); PG8_BAR; PG8_WAIT_L(0); PG8_MMA(0, 0, At, B0); PG8_BAR; PG8_SCHED;
            PG8_LDB(B1, 0, 1); PG8_STAGE(PG8_SB(0, 0), b2, voffB);
            PG8_BAR; PG8_WAIT_L(0); PG8_MMA(0, 1, At, B1); PG8_BAR;
            PG8_LDA(At, 0, 1); PG8_STAGE(PG8_SA(0, 0), a2, voffA);
            PG8_BAR; PG8_WAIT_L(0); PG8_MMA(1, 0, At, B0); PG8_BAR; PG8_SCHED;
            PG8_STAGE(PG8_SB(0, 1), b2 + hstep, voffB);
            PG8_WAIT_V(6); PG8_BAR; PG8_MMA(1, 1, At, B1); PG8_BAR;
            PG8_LDB(B0, 1, 0); PG8_SCHED; PG8_LDA(At, 1, 0); PG8_STAGE(PG8_SA(0, 1), a2 + hstep, voffA);
            PG8_WAIT_L(8); PG8_BAR; PG8_WAIT_L(0); PG8_MMA(0, 0, At, B0); PG8_BAR; PG8_SCHED;
            PG8_LDB(B1, 1, 1); PG8_STAGE(PG8_SB(1, 0), b3, voffB);
            PG8_BAR; PG8_WAIT_L(0); PG8_MMA(0, 1, At, B1); PG8_BAR;
            PG8_LDA(At, 1, 1); PG8_STAGE(PG8_SA(1, 0), a3, voffA);
            PG8_BAR; PG8_WAIT_L(0); PG8_MMA(1, 0, At, B0); PG8_BAR; PG8_SCHED;
            PG8_STAGE(PG8_SB(1, 1), b3 + hstep, voffB);
            PG8_WAIT_V(6); PG8_BAR; PG8_MMA(1, 1, At, B1); PG8_BAR;
            }
        }
        if constexpr (ALIGN_EPI) { if (wr == 0) PG8_BAR; }
        if constexpr (!Epi::AFTER_DRAIN) { E(acc, cur, wr, wc, fr, fq); S.done(cur); }
        if (!has_next) break;
#pragma unroll
        for (int a = 0; a < 2; ++a)
#pragma unroll
            for (int b = 0; b < 2; ++b)
#pragma unroll
                for (int m = 0; m < 4; ++m)
#pragma unroll
                    for (int n = 0; n < 2; ++n) acc[a][b][m][n] = (f32x4){0.f, 0.f, 0.f, 0.f};
        cur = nxt; cA = nA; cB = nB; ++ui;
        if constexpr (ALIGN_EPI) { if (wr == 1) PG8_BAR; }
    }
    PG8_WAIT_V(0);
    if constexpr (!ALIGN_EPI) { if (wr == 0) PG8_BAR; }
    PG8_BAR;
    if constexpr (Epi::AFTER_DRAIN) { E.fused(acc, cur, wr, wc, fr, fq, lds, wid, lane); S.done(cur); }
#undef PG8_SA
#undef PG8_SB
#undef PG8_STAGE
#undef PG8_LDA
#undef PG8_LDB
#undef PG8_MMA
#undef PG8_WAIT_V
#undef PG8_WAIT_L
#undef PG8_BAR
#undef PG8_SCHED
}
}

constexpr int NB = 2, SEQ = 8192, DM = 1024, MTOK = NB * SEQ;
constexpr int NZ = 2304, NZP = 2560;
constexpr int NMEM = 256;
constexpr float EPS = 1e-6f;
constexpr float QSCALE = 0.125f * 1.4426950408889634f;
constexpr int ZC_XL = 0, ZC_GT = 512, ZC_Q = 1024, ZC_KC = 1536, ZC_VC = 1664, ZC_KS = 1792, ZC_VS = 1920, ZC_KW = 2048, ZC_VW = 2176, ZC_G = 2304;

constexpr size_t MiB = 1u << 20;
constexpr size_t WS_CTL = 0;
constexpr size_t WS_WIN = 1 * MiB, WS_WOUT = 6 * MiB, WS_WMQ = 8 * MiB, WS_WMK = 10 * MiB, WS_WMV = 12 * MiB, WS_WMO = 14 * MiB, WS_WPQ = 16 * MiB;
constexpr size_t WS_SKEY = 20 * MiB;
constexpr size_t WS_CW1T = WS_SKEY + 512 * 1024;
constexpr size_t WS_CW2T = WS_CW1T + 512 * 1024;
constexpr size_t WS_C1 = WS_CW2T + 16 * 1024;
constexpr size_t WS_WRGT = WS_C1 + 16 * 1024;
constexpr size_t WS_MEMN = 22 * MiB, WS_MEMK = 23 * MiB, WS_MEMVT = 24 * MiB;
constexpr size_t WS_KC = 26 * MiB;
constexpr size_t WS_VCT = WS_KC + 256 * 1024;
constexpr size_t WS_SUMM = 27 * MiB;
constexpr size_t WS_SSQ1 = 28 * MiB, WS_SSQ2 = 29 * MiB;
constexpr size_t WS_GATES = 30 * MiB;
constexpr size_t WS_SSQN = 31 * MiB + 512 * 1024;
constexpr size_t WS_U8 = 32 * MiB, WS_V8 = 48 * MiB;
constexpr size_t WS_SU = 64 * MiB, WS_SV = 64 * MiB + 65536;
constexpr size_t WS_SSQ3 = 65 * MiB;
constexpr size_t WS_W = 66 * MiB;
constexpr size_t WS_PART = 128 * MiB;
constexpr size_t WS_XN = 96 * MiB;
constexpr size_t WS_Z = 128 * MiB;
constexpr size_t WS_KSF = 240 * MiB, WS_VSF = 244 * MiB, WS_KWF = 248 * MiB, WS_VWF = 252 * MiB;
constexpr size_t WS_QM = 128 * MiB, WS_OM = 160 * MiB;
constexpr size_t WS_QP = 128 * MiB;
constexpr size_t WS_Y = 208 * MiB;
constexpr size_t WS_EID = 208 * MiB, WS_GW = 216 * MiB;
constexpr size_t WS_END = 256 * MiB;

constexpr int CW_KMAX = 12288;
constexpr int LDS_BYTES = 147456;

#define GAS __attribute__((address_space(1)))
#define LAS __attribute__((address_space(3)))
typedef unsigned short bf16;
typedef unsigned v4u __attribute__((ext_vector_type(4)));
typedef unsigned v2u __attribute__((ext_vector_type(2)));
typedef float f32x4 __attribute__((ext_vector_type(4)));
typedef float f32x16 __attribute__((ext_vector_type(16)));
typedef short bf16x8 __attribute__((ext_vector_type(8)));
typedef short bf16x4 __attribute__((ext_vector_type(4)));
__device__ __forceinline__ unsigned f2bf(float f) { unsigned u = __builtin_bit_cast(unsigned, f); return (u + 0x7fffu + ((u >> 16) & 1u)) >> 16; }
typedef float f32x2_ __attribute__((ext_vector_type(2))); typedef __bf16 bf16x2_ __attribute__((ext_vector_type(2)));
__device__ __forceinline__ unsigned pk2(float lo, float hi) { f32x2_ v = {lo, hi}; bf16x2_ b = __builtin_convertvector(v, bf16x2_); return __builtin_bit_cast(unsigned, b); }
__device__ __forceinline__ float bf2f(unsigned short h) { return __builtin_bit_cast(float, (unsigned)h << 16); }
__device__ __forceinline__ float bflo(unsigned w) { return __builtin_bit_cast(float, w << 16); }
__device__ __forceinline__ float bfhi(unsigned w) { return __builtin_bit_cast(float, w & 0xffff0000u); }
__device__ __forceinline__ void swap32(unsigned& a, unsigned& b) { asm("s_nop 1\n\tv_permlane32_swap_b32 %0, %1" : "+v"(a), "+v"(b)); }
__device__ __forceinline__ int maxswap32_i(int v) { unsigned a = (unsigned)v, b = (unsigned)v; swap32(a, b); return max((int)a, (int)b); }
__device__ __forceinline__ float maxswap32_f(float v) { unsigned a = __builtin_bit_cast(unsigned, v), b = a; swap32(a, b); return fmaxf(__builtin_bit_cast(float, a), __builtin_bit_cast(float, b)); }
__device__ __forceinline__ float addswap32_f(float v) { unsigned a = __builtin_bit_cast(unsigned, v), b = a; swap32(a, b); return __builtin_bit_cast(float, a) + __builtin_bit_cast(float, b); }
__device__ __forceinline__ float wave_sum(float v) {
#pragma unroll
    for (int o = 1; o < 64; o <<= 1) v += __shfl_xor(v, o);
    return v;
}

struct Args { const float* in[33]; float* out; unsigned char* ws; int ph_lo, ph_hi; };

struct Frame {
    int tid, lane, wave, vcu, G, gw, NGW;
};
__device__ __forceinline__ int lane_id() { int l; asm volatile("v_mbcnt_lo_u32_b32 %0, -1, 0\n\tv_mbcnt_hi_u32_b32 %0, -1, %0" : "=v"(l)); return l; }
#define REFRESH_LANE(F) do { (F).lane = lane_id(); (F).tid = (F).wave * 64 + (F).lane; } while (0)

__device__ __forceinline__ void transpose_item(const float* W, int K, int N, bf16* WT, int ldt, int row_off, const float* gain, int slo, int shi, float cs, LAS float* scr, int item, int lane, int kxor = 0) {
    const int nblk = (N + 31) / 32, kb = item / nblk, nb = item % nblk, k0 = 64 * kb, n0 = 32 * nb;
#pragma unroll 16
    for (int i = 0; i < 32; ++i) { const int kk = 2 * i + (lane >> 5), n = n0 + (lane & 31);
        float v = (n < N) ? __builtin_nontemporal_load(W + (size_t)(k0 + kk) * N + n) : 0.f; if (gain) v *= gain[k0 + kk]; if (n >= slo && n < shi) v *= cs;
        scr[kk * 33 + (lane & 31)] = v; }
    asm volatile("s_waitcnt lgkmcnt(0)" ::: "memory");
    const int c = lane & 7;
#pragma unroll
    for (int j = 0; j < 4; ++j) { const int n = (lane >> 3) + 8 * j; const LAS float* s = scr + (8 * c) * 33 + n;
        v4u o; o.x = pk2(s[0 * 33], s[1 * 33]); o.y = pk2(s[2 * 33], s[3 * 33]); o.z = pk2(s[4 * 33], s[5 * 33]); o.w = pk2(s[6 * 33], s[7 * 33]);
        *(v4u*)(WT + (size_t)(row_off + n0 + n) * ldt + (k0 ^ kxor) + 8 * c) = o; }
    asm volatile("s_waitcnt lgkmcnt(0)" ::: "memory");
}
__device__ __forceinline__ void rms_row_to_bf16(const float* xrow, bf16* orow, int lane) {
    const f32x4* xr = (const f32x4*)xrow + lane;
    f32x4 v[4]; float s = 0.f;
#pragma unroll
    for (int j = 0; j < 4; ++j) { v[j] = xr[64 * j]; s += (v[j].x * v[j].x + v[j].y * v[j].y) + (v[j].z * v[j].z + v[j].w * v[j].w); }
    const float rstd = rsqrtf(wave_sum(s) * (1.f / DM) + EPS);
    unsigned long long* o8 = (unsigned long long*)orow + lane;
#pragma unroll
    for (int j = 0; j < 4; ++j) o8[64 * j] = (unsigned long long)pk2(v[j].x * rstd, v[j].y * rstd) | ((unsigned long long)pk2(v[j].z * rstd, v[j].w * rstd) << 32);
}
__device__ __forceinline__ void quant_row_fp8(const float* src, const float* gain, unsigned char* dst, float* scale_out, int lane) {
    const f32x4* p = (const f32x4*)src + 4 * lane; f32x4 v[4]; float am = 0.f;
#pragma unroll
    for (int j = 0; j < 4; ++j) { v[j] = p[j]; if (gain) v[j] = v[j] * ((const f32x4*)gain)[4 * lane + j]; am = fmaxf(am, fmaxf(fmaxf(fabsf(v[j].x), fabsf(v[j].y)), fmaxf(fabsf(v[j].z), fabsf(v[j].w)))); }
#pragma unroll
    for (int o = 1; o < 64; o <<= 1) am = fmaxf(am, __shfl_xor(am, o));
    const float inv = am > 0.f ? 448.0f / am : 0.f;
    v4u o4;
#pragma unroll
    for (int j = 0; j < 4; ++j) { int w = 0; w = __builtin_amdgcn_cvt_pk_fp8_f32(v[j].x * inv, v[j].y * inv, w, false); w = __builtin_amdgcn_cvt_pk_fp8_f32(v[j].z * inv, v[j].w * inv, w, true); o4[j] = (unsigned)w; }
    *(v4u*)(dst + (size_t)(lane >> 3) * 16384 * 128 + (lane & 7) * 16) = o4;
    if (lane == 0) *scale_out = am * (1.0f / 448.0f);
}
__device__ __forceinline__ void rms_rows4_to_bf16(const float* x0, bf16* o0, size_t rstride  , int lane) {
    f32x4 v[4][4]; float s[4];
#pragma unroll
    for (int r = 0; r < 4; ++r)
#pragma unroll
        for (int j = 0; j < 4; ++j) v[r][j] = __builtin_nontemporal_load((const f32x4*)(x0 + r * rstride) + lane + 64 * j);
#pragma unroll
    for (int r = 0; r < 4; ++r) { s[r] = 0.f;
#pragma unroll
        for (int j = 0; j < 4; ++j) s[r] += (v[r][j].x * v[r][j].x + v[r][j].y * v[r][j].y) + (v[r][j].z * v[r][j].z + v[r][j].w * v[r][j].w); }
#pragma unroll
    for (int o = 1; o < 64; o <<= 1)
#pragma unroll
        for (int r = 0; r < 4; ++r) s[r] += __shfl_xor(s[r], o);
#pragma unroll
    for (int r = 0; r < 4; ++r) { const float rstd = rsqrtf(s[r] * (1.f / DM) + EPS); unsigned long long* o8 = (unsigned long long*)(o0 + r * rstride) + lane;
#pragma unroll
        for (int j = 0; j < 4; ++j) o8[64 * j] = (unsigned long long)pk2(v[r][j].x * rstd, v[r][j].y * rstd) | ((unsigned long long)pk2(v[r][j].z * rstd, v[r][j].w * rstd) << 32); }
}
__device__ __forceinline__ void quant_rows4_fp8(const float* src0, size_t rstride, const float* gain, unsigned char* dst0, float* scale0, int sstride, int lane) {
    f32x4 v[4][4]; float am[4];
#pragma unroll
    for (int r = 0; r < 4; ++r)
#pragma unroll
        for (int j = 0; j < 4; ++j) v[r][j] = __builtin_nontemporal_load((const f32x4*)(src0 + r * rstride) + 4 * lane + j);
    if (gain) {
#pragma unroll
        for (int j = 0; j < 4; ++j) { const f32x4 g = ((const f32x4*)gain)[4 * lane + j];
#pragma unroll
            for (int r = 0; r < 4; ++r) v[r][j] = v[r][j] * g; } }
#pragma unroll
    for (int r = 0; r < 4; ++r) { am[r] = 0.f;
#pragma unroll
        for (int j = 0; j < 4; ++j) am[r] = fmaxf(am[r], fmaxf(fmaxf(fabsf(v[r][j].x), fabsf(v[r][j].y)), fmaxf(fabsf(v[r][j].z), fabsf(v[r][j].w)))); }
#pragma unroll
    for (int o = 1; o < 64; o <<= 1)
#pragma unroll
        for (int r = 0; r < 4; ++r) am[r] = fmaxf(am[r], __shfl_xor(am[r], o));
#pragma unroll
    for (int r = 0; r < 4; ++r) { const float inv = am[r] > 0.f ? 448.0f / am[r] : 0.f; v4u o4;
#pragma unroll
        for (int j = 0; j < 4; ++j) { int w = 0; w = __builtin_amdgcn_cvt_pk_fp8_f32(v[r][j].x * inv, v[r][j].y * inv, w, false); w = __builtin_amdgcn_cvt_pk_fp8_f32(v[r][j].z * inv, v[r][j].w * inv, w, true); o4[j] = (unsigned)w; }
        __builtin_nontemporal_store(o4, (v4u*)(dst0 + (size_t)r * sstride * 128 + (size_t)(lane >> 3) * 16384 * 128 + (lane & 7) * 16));
        if (lane == 0) scale0[r * sstride] = am[r] * (1.0f / 448.0f); }
}
__device__ __forceinline__ void p0_prologue(const Frame& F, const Args& A, LAS unsigned char* lds) {
    unsigned char* ws = A.ws;
    LAS float* scr = (LAS float*)(lds + F.wave * 16384);
    const float* const* in = A.in;
    const int gw = F.gw, NGW = F.NGW;
    constexpr int I_IN = 16 * 73, I_SQ = 16 * 32, I_PQ = 16 * 64, I_C1 = 64, I_C2 = 2, I_RG = 2;
    constexpr int E_IN = I_IN, E_OUT = E_IN + I_SQ, E_MQ = E_OUT + I_SQ, E_MK = E_MQ + I_SQ, E_MV = E_MK + I_SQ, E_MO = E_MV + I_SQ, E_PQ = E_MO + I_PQ, E_C1 = E_PQ + 2 * I_C1, E_C2 = E_C1 + 2 * I_C2, E_RG = E_C2 + 16 * I_RG;
    for (int it = gw; it < E_RG; it += NGW) {
        if (it < E_IN) transpose_item(in[3], 1024, 2328, (bf16*)(ws + WS_WIN), 1024, 0, in[2], ZC_Q, ZC_KC, QSCALE, scr, it, F.lane);
        else if (it < E_OUT) { const int j = it - E_IN, kb = j / 32; transpose_item(in[20], 1024, 1024, (bf16*)(ws + WS_WOUT), 1024, 0, (kb < 8 ? in[18] : in[19] - 512), 0, 0, 1.f, scr, j, F.lane, 512); }
        else if (it < E_MQ) transpose_item(in[23], 1024, 1024, (bf16*)(ws + WS_WMQ), 1024, 0, in[21], 0, 1024, 0.0625f * 1.4426950408889634f, scr, it - E_OUT, F.lane);
        else if (it < E_MK) transpose_item(in[24], 1024, 1024, (bf16*)(ws + WS_WMK), 1024, 0, in[22], 0, 0, 1.f, scr, it - E_MQ, F.lane);
        else if (it < E_MV) transpose_item(in[25], 1024, 1024, (bf16*)(ws + WS_WMV), 1024, 0, in[22], 0, 0, 1.f, scr, it - E_MK, F.lane);
        else if (it < E_MO) transpose_item(in[26], 1024, 1024, (bf16*)(ws + WS_WMO), 1024, 0, nullptr, 0, 0, 1.f, scr, it - E_MV, F.lane);
        else if (it < E_PQ) transpose_item(in[28], 1024, 2048, (bf16*)(ws + WS_WPQ), 1024, 0, in[27], 0, 0, 1.f, scr, it - E_MO, F.lane);
        else if (it < E_C1) { const int j = it - E_PQ, kv = j / I_C1; transpose_item(in[kv ? 16 : 13], 2048, 64, (bf16*)(ws + WS_CW1T) + (size_t)kv * 64 * 2048, 2048, 0, nullptr, 0, 0, 1.f, scr, j % I_C1, F.lane); }
        else if (it < E_C2) { const int j = it - E_C1, kv = j / I_C2; transpose_item(in[kv ? 17 : 14], 64, 64, (bf16*)(ws + WS_CW2T) + (size_t)kv * 64 * 64, 64, 0, nullptr, 0, 0, 1.f, scr, j % I_C2, F.lane); }
        else { const int j = it - E_C2, ai = j / 16, h = (j / 2) % 8; transpose_item(in[ai ? 9 : 7] + (size_t)h * 4096, 64, 64, (bf16*)(ws + WS_WRGT) + (size_t)(ai * 8 + h) * 4096, 64, 0, nullptr, 0, 0, 1.f, scr, j % 2, F.lane); }
    }
    for (int i = gw * 64 + F.lane; i < (2560 - 2336) * 1024 / 8; i += NGW * 64) ((v4u*)((bf16*)(ws + WS_WIN) + (size_t)2336 * 1024))[i] = (v4u){0u, 0u, 0u, 0u};
    for (int it = NGW - 1 - gw; it < 32; it += NGW) { const int kv = it >> 4, ch = it & 15; const float* pos = in[kv ? 15 : 12] + 128 * ch; const float* w1 = in[kv ? 16 : 13] + (size_t)128 * ch * 64 + F.lane; float s = 0.f;
#pragma unroll 16
        for (int k = 0; k < 128; ++k) s += pos[k] * w1[(size_t)k * 64];
        ((float*)(ws + WS_C1))[it * 64 + F.lane] = s; }
    { const size_t i0 = (size_t)gw * 64 + F.lane, st = (size_t)NGW * 64;
      const int nrows0 = (F.G == 256) ? 16384 : 32768;
      for (int r = gw; r < nrows0; r += 4 * NGW) { const int tb = r >> 14, e = r & 16383;
          if ((16384 % (4 * NGW)) == 0) quant_rows4_fp8(in[30 + tb] + (size_t)e * DM, (size_t)NGW * DM, tb ? nullptr : in[27], ws + (tb ? WS_V8 : WS_U8) + (size_t)e * 128, (float*)(ws + (tb ? WS_SV : WS_SU)) + e, NGW, F.lane);
          else for (int q = 0; q < 4; ++q) { const int rr = r + q * NGW; if (rr < 32768) { const int t2 = rr >> 14, e2 = rr & 16383; quant_row_fp8(in[30 + t2] + (size_t)e2 * DM, t2 ? nullptr : in[27], ws + (t2 ? WS_V8 : WS_U8) + (size_t)e2 * 128, (float*)(ws + (t2 ? WS_SV : WS_SU)) + e2, F.lane); } } }
      for (size_t i = i0; i < (size_t)8 * 2 * 128 * 128 / 8; i += st) { const f32x4 a = ((const f32x4*)in[29])[2 * i], bq = ((const f32x4*)in[29])[2 * i + 1];
          v4u o; o.x = pk2(a.x, a.y); o.y = pk2(a.z, a.w); o.z = pk2(bq.x, bq.y); o.w = pk2(bq.z, bq.w);
          const size_t R = i >> 4, d0 = (i & 15) * 8;
          *(v4u*)((bf16*)(ws + WS_SKEY) + (R >> 5) * 4096 + (d0 >> 4) * 512 + ((d0 >> 3) & 1) * 256 + (R & 31) * 8) = o; } }
    if ((MTOK % (4 * NGW)) == 0) for (int m = gw; m < MTOK; m += 4 * NGW) rms_rows4_to_bf16(in[0] + (size_t)m * DM, (bf16*)(ws + WS_XN) + (size_t)m * DM, (size_t)NGW * DM, F.lane);
    else for (int m = gw; m < MTOK; m += NGW) rms_row_to_bf16(in[0] + (size_t)m * DM, (bf16*)(ws + WS_XN) + (size_t)m * DM, F.lane);
    for (int m = gw; m < NB * NMEM; m += NGW) rms_row_to_bf16(in[1] + (size_t)m * DM, (bf16*)(ws + WS_MEMN) + (size_t)m * DM, F.lane);
}

__device__ __forceinline__ int crow(int r, int hi) { return (r & 3) + 8 * (r >> 2) + 4 * hi; }
__device__ __forceinline__ float gelu_tanh(float x) {
    const float u = 0.7978845608028654f * (x + 0.044715f * x * x * x);
    const float t = 1.0f - 2.0f * __builtin_amdgcn_rcpf(__builtin_amdgcn_exp2f(2.0f * 1.4426950408889634f * u) + 1.0f);
    return 0.5f * x * (1.0f + t);
}
constexpr int XC_LD = 520;
__device__ __forceinline__ void lru_local_item(const Frame& F, const Args& A, LAS unsigned char* lds, int item) {
    unsigned char* ws = A.ws;
    const bf16* Z = (const bf16*)(ws + WS_Z);
    const int b = item >> 7, chunk = item & 127, s0 = chunk * 64; const size_t row0 = (size_t)b * SEQ + s0;
    LAS bf16* xcs = (LAS bf16*)lds;
    {
        const int c8 = F.tid & 63, tg = F.tid >> 6, c0 = 8 * c8;
        v4u xr[11];
#pragma unroll
        for (int r = 0; r < 11; ++r) { const long tok = (long)(8 * tg + r) - 3;
            if (s0 == 0 && tok < 0) xr[r] = (v4u){0u, 0u, 0u, 0u}; else xr[r] = *(const v4u*)(Z + (size_t)((long)row0 + tok) * NZ + c0); }
        const float* cw = A.in[5]; float w0[8], w1[8], w2[8], w3[8], cb[8];
#pragma unroll
        for (int j = 0; j < 2; ++j) { const f32x4 a = *(const f32x4*)(cw + c0 + 4 * j), b = *(const f32x4*)(cw + 512 + c0 + 4 * j), c = *(const f32x4*)(cw + 1024 + c0 + 4 * j), d = *(const f32x4*)(cw + 1536 + c0 + 4 * j), e2 = *(const f32x4*)(A.in[6] + c0 + 4 * j);
#pragma unroll
            for (int k = 0; k < 4; ++k) { w0[4 * j + k] = a[k]; w1[4 * j + k] = b[k]; w2[4 * j + k] = c[k]; w3[4 * j + k] = d[k]; cb[4 * j + k] = e2[k]; } }
#pragma unroll
        for (int tt = 0; tt < 8; ++tt) { float o[8];
#pragma unroll
            for (int q = 0; q < 4; ++q) { const unsigned a = xr[tt][q], b = xr[tt + 1][q], c = xr[tt + 2][q], d = xr[tt + 3][q];
                o[2 * q] = cb[2 * q] + w0[2 * q] * bflo(a) + w1[2 * q] * bflo(b) + w2[2 * q] * bflo(c) + w3[2 * q] * bflo(d);
                o[2 * q + 1] = cb[2 * q + 1] + w0[2 * q + 1] * bfhi(a) + w1[2 * q + 1] * bfhi(b) + w2[2 * q + 1] * bfhi(c) + w3[2 * q + 1] * bfhi(d); }
            v4u ov; ov.x = pk2(o[0], o[1]); ov.y = pk2(o[2], o[3]); ov.z = pk2(o[4], o[5]); ov.w = pk2(o[6], o[7]);
            *(LAS v4u*)(xcs + (8 * tg + tt) * XC_LD + c0) = ov; }
    }
    __syncthreads();
    const int h = F.wave, lane = F.lane, r32 = lane & 31, hi = lane >> 5;
    bf16x8 af[2][4];
#pragma unroll
    for (int tt = 0; tt < 2; ++tt)
#pragma unroll
        for (int ks = 0; ks < 4; ++ks) af[tt][ks] = *(const LAS bf16x8*)(xcs + (32 * tt + r32) * XC_LD + 64 * h + 16 * ks + 8 * hi);
    const bf16* WT = (const bf16*)(ws + WS_WRGT);
    float* SUMM = (float*)(ws + WS_SUMM);
    unsigned* HA = (unsigned*)A.out;
#pragma unroll 1
    for (int ct = 0; ct < 2; ++ct) {
        const int c = 64 * h + 32 * ct + r32;
        f32x16 ga[2], gi[2];
#pragma unroll
        for (int tt = 0; tt < 2; ++tt) { ga[tt] = f32x16{}; gi[tt] = f32x16{}; }
#pragma unroll
        for (int ks = 0; ks < 4; ++ks) {
            const bf16x8 ba = *(const bf16x8*)(WT + (size_t)(0 * 8 + h) * 4096 + (32 * ct + r32) * 64 + 16 * ks + 8 * hi);
            const bf16x8 bi = *(const bf16x8*)(WT + (size_t)(1 * 8 + h) * 4096 + (32 * ct + r32) * 64 + 16 * ks + 8 * hi);
#pragma unroll
            for (int tt = 0; tt < 2; ++tt) { ga[tt] = __builtin_amdgcn_mfma_f32_32x32x16_bf16(af[tt][ks], ba, ga[tt], 0, 0, 0); gi[tt] = __builtin_amdgcn_mfma_f32_32x32x16_bf16(af[tt][ks], bi, gi[tt], 0, 0, 0); }
        }
        const float ba_ = A.in[8][c], bi_ = A.in[10][c], lam = A.in[11][c];
        const float sp = (lam > 15.f) ? __expf(-lam) : log1pf(__expf(-lam));
#pragma unroll
        for (int tt = 0; tt < 2; ++tt)
#pragma unroll
            for (int r = 0; r < 16; ++r) { const int t = 32 * tt + crow(r, hi);
                const float rr = __builtin_amdgcn_rcpf(1.0f + __builtin_amdgcn_exp2f(-1.4426950408889634f * (ga[tt][r] + ba_))), ii = __builtin_amdgcn_rcpf(1.0f + __builtin_amdgcn_exp2f(-1.4426950408889634f * (gi[tt][r] + bi_)));
                const float a = __builtin_amdgcn_exp2f(-8.0f * 1.4426950408889634f * rr * sp);
                const float xcv = bf2f(xcs[t * XC_LD + c]);
                const float bb = __builtin_amdgcn_sqrtf(fmaxf(1.0f - a * a, 0.f)) * (ii * xcv);
                ga[tt][r] = a; gi[tt][r] = bb; }
        float SA[8], SB[8];
#pragma unroll
        for (int tt = 0; tt < 2; ++tt)
#pragma unroll
            for (int q = 0; q < 4; ++q) {
#pragma unroll
                for (int k = 1; k < 4; ++k) { const int r = 4 * q + k; gi[tt][r] = ga[tt][r] * gi[tt][r - 1] + gi[tt][r]; ga[tt][r] = ga[tt][r] * ga[tt][r - 1]; }
                SA[tt * 4 + q] = ga[tt][4 * q + 3]; SB[tt * 4 + q] = gi[tt][4 * q + 3]; }
        float CA = 1.f, CB = 0.f; float inA[8], inB[8];
#pragma unroll
        for (int s = 0; s < 8; ++s) {
            const float pA = __shfl_xor(SA[s], 32), pB = __shfl_xor(SB[s], 32);
            const float Ae = hi ? pA : SA[s], Be = hi ? pB : SB[s], Ao = hi ? SA[s] : pA, Bo = hi ? SB[s] : pB;
            if (!hi) { inA[s] = CA; inB[s] = CB; }
            CB = Ae * CB + Be; CA = Ae * CA;
            if (hi) { inA[s] = CA; inB[s] = CB; }
            CB = Ao * CB + Bo; CA = Ao * CA;
        }
        unsigned hoff = (unsigned)((row0 + 4 * hi) * 512 + c);
        if (hi == 0) { float* sp2 = SUMM + ((size_t)(b * 128 + chunk) * 512 + c) * 2; sp2[0] = CA; sp2[1] = CB; }
#pragma unroll
        for (int tt = 0; tt < 2; ++tt)
#pragma unroll
            for (int r = 0; r < 16; ++r) { const int s = tt * 4 + (r >> 2);
                const float acum = ga[tt][r] * inA[s], hloc = ga[tt][r] * inB[s] + gi[tt][r];
                asm volatile("" : "+v"(hoff));
                HA[hoff + (unsigned)((32 * tt + (r & 3) + 8 * (r >> 2)) * 512)] = f2bf(hloc) | (f2bf(acum) << 16); }
    }
    __syncthreads();
}
__device__ __forceinline__ void lru_fix_item(const Frame& F, const Args& A, LAS unsigned char* lds, int item, bool zero_nsa) {
    unsigned char* ws = A.ws;
    const int b = item >> 7, chunk = item & 127; const size_t row0 = (size_t)b * SEQ + chunk * 64;
    LAS float* carry = (LAS float*)lds;
    { const int c = F.tid; const float* SUMM = (const float*)(ws + WS_SUMM) + (size_t)b * 128 * 1024 + 2 * c; float hc = 0.f;
      int j = 0;
      for (; j + 8 <= chunk; j += 8) { float2 ab[8];
#pragma unroll
          for (int q = 0; q < 8; ++q) ab[q] = *(const float2*)(SUMM + (size_t)(j + q) * 1024);
#pragma unroll
          for (int q = 0; q < 8; ++q) hc = ab[q].x * hc + ab[q].y; }
      for (; j < chunk; ++j) { const float2 ab = *(const float2*)(SUMM + (size_t)j * 1024); hc = ab.x * hc + ab.y; }
      carry[c] = hc; }
    __syncthreads();
    const bf16* Z = (const bf16*)(ws + WS_Z); const unsigned* HA = (const unsigned*)A.out; bf16* Y = (bf16*)(ws + WS_Y);
    const int c0 = 8 * F.lane;
    float cr[8];
#pragma unroll
    for (int j = 0; j < 8; ++j) cr[j] = carry[c0 + j];
#pragma unroll 1
    for (int t4 = 0; t4 < 8; t4 += 4) {
        v4u h0[4], h1[4], gz[4]; float y[4][8], s[4];
#pragma unroll
        for (int q = 0; q < 4; ++q) { const size_t row = row0 + F.wave * 8 + t4 + q; h0[q] = __builtin_nontemporal_load((const v4u*)(HA + row * 512 + c0)); h1[q] = __builtin_nontemporal_load((const v4u*)(HA + row * 512 + c0 + 4)); gz[q] = __builtin_nontemporal_load((const v4u*)(Z + row * NZ + ZC_GT + c0)); }
#pragma unroll
        for (int q = 0; q < 4; ++q) { const unsigned hw[8] = {h0[q].x, h0[q].y, h0[q].z, h0[q].w, h1[q].x, h1[q].y, h1[q].z, h1[q].w};
            const float gt[8] = {bflo(gz[q].x), bfhi(gz[q].x), bflo(gz[q].y), bfhi(gz[q].y), bflo(gz[q].z), bfhi(gz[q].z), bflo(gz[q].w), bfhi(gz[q].w)};
            s[q] = 0.f;
#pragma unroll
            for (int j = 0; j < 8; ++j) { const float hv = bfhi(hw[j]) * cr[j] + bflo(hw[j]); y[q][j] = hv * gelu_tanh(gt[j]); s[q] += y[q][j] * y[q][j]; } }
#pragma unroll
        for (int o = 1; o < 64; o <<= 1)
#pragma unroll
            for (int q = 0; q < 4; ++q) s[q] += __shfl_xor(s[q], o);
#pragma unroll
        for (int q = 0; q < 4; ++q) { const size_t row = row0 + F.wave * 8 + t4 + q; const float rstd = rsqrtf(s[q] * (1.f / 512.f) + EPS);
            v4u o; o.x = pk2(y[q][0] * rstd, y[q][1] * rstd); o.y = pk2(y[q][2] * rstd, y[q][3] * rstd); o.z = pk2(y[q][4] * rstd, y[q][5] * rstd); o.w = pk2(y[q][6] * rstd, y[q][7] * rstd);
            *(v4u*)(Y + row * DM + 512 + c0) = o;
            if (zero_nsa) *(v4u*)(Y + row * DM + c0) = (v4u){0u, 0u, 0u, 0u}; }
    }
    __syncthreads();
}

__device__ __forceinline__ void kmax_item(const Frame& F, const Args& A, int item) {
    unsigned char* ws = A.ws; const int lane = lane_id();
    const int bk = item >> 9, br = (item >> 8) & 1, tile = item & 255;
    const unsigned char* K = ws + (br ? WS_KWF : WS_KSF) + ((size_t)bk * 256 + tile) * 4096 + 16 * lane;
    float s = 0.f;
#pragma unroll
    for (int ks = 0; ks < 4; ++ks) { const v4u w = *(const v4u*)(K + 1024 * ks); const unsigned ww[4] = {w.x, w.y, w.z, w.w};
#pragma unroll
        for (int k = 0; k < 4; ++k) { const float a = bflo(ww[k]), c = bfhi(ww[k]); s += a * a + c * c; } }
    s = addswap32_f(s);
#pragma unroll
    for (int o = 1; o < 32; o <<= 1) s = fmaxf(s, __shfl_xor(s, o));
    if (lane == 0) atomicMax((unsigned*)(ws + WS_CTL) + CW_KMAX + bk * 2 + br, __builtin_bit_cast(unsigned, s));
}
__device__ __forceinline__ void compress_item(const Frame& F, const Args& A, LAS unsigned char* lds, int item) {
    unsigned char* ws = A.ws;
    const int kv = item >> 6, b = (item >> 5) & 1, h = (item >> 4) & 1, nt = item & 15, n0 = 32 * nt;
    const int lane = F.lane, r32 = lane & 31, hi = lane >> 5, w = F.wave;
    const bf16* Z = (const bf16*)(ws + WS_Z); const bf16* W1T = (const bf16*)(ws + WS_CW1T) + (size_t)kv * 64 * 2048; const bf16* W2T = (const bf16*)(ws + WS_CW2T) + (size_t)kv * 4096;
    const int zc = (kv ? ZC_VC : ZC_KC) + h * 64;
    LAS float* part = (LAS float*)lds;
    LAS float* G = (LAS float*)(lds + 65536);
    {
        int n = n0 + r32; if (n > 510) n = 510;
        f32x16 acc[2]; acc[0] = f32x16{}; acc[1] = f32x16{};
#pragma unroll 4
        for (int kk = 0; kk < 16; ++kk) { const int ks = 16 * w + kk, l = ks >> 2, d0 = (ks & 3) * 16 + 8 * hi;
            const bf16x8 bfr = *(const bf16x8*)(Z + ((size_t)b * SEQ + 16 * n + l) * NZ + zc + d0);
            const bf16x8 a0 = *(const bf16x8*)(W1T + (size_t)(r32) * 2048 + ks * 16 + 8 * hi), a1 = *(const bf16x8*)(W1T + (size_t)(32 + r32) * 2048 + ks * 16 + 8 * hi);
            acc[0] = __builtin_amdgcn_mfma_f32_32x32x16_bf16(a0, bfr, acc[0], 0, 0, 0); acc[1] = __builtin_amdgcn_mfma_f32_32x32x16_bf16(a1, bfr, acc[1], 0, 0, 0); }
#pragma unroll
        for (int ot = 0; ot < 2; ++ot)
#pragma unroll
            for (int r = 0; r < 16; ++r) part[(w * 64 + 32 * ot + crow(r, hi)) * 32 + r32] = acc[ot][r];
    }
    __syncthreads();
    { const float* c1 = (const float*)(ws + WS_C1) + kv * 16 * 64;
#pragma unroll
      for (int i = 0; i < 4; ++i) { const int e = F.tid + 512 * i, o = e >> 5, n = e & 31; float s = 0.f;
#pragma unroll
          for (int ch = 0; ch < 16; ++ch) s += c1[ch * 64 + o];
#pragma unroll
          for (int ww = 0; ww < 8; ++ww) s += part[(ww * 64 + o) * 32 + n];
          G[o * 33 + n] = gelu_tanh(s); } }
    __syncthreads();
    if (w < 2) {
        f32x16 acc = f32x16{};
#pragma unroll
        for (int ks = 0; ks < 4; ++ks) { const bf16x8 a = *(const bf16x8*)(W2T + (size_t)(32 * w + r32) * 64 + 16 * ks + 8 * hi);
            v4u bw; const LAS float* gp = G + (16 * ks + 8 * hi) * 33 + r32;
            bw.x = pk2(gp[0], gp[33]); bw.y = pk2(gp[66], gp[99]); bw.z = pk2(gp[132], gp[165]); bw.w = pk2(gp[198], gp[231]);
            acc = __builtin_amdgcn_mfma_f32_32x32x16_bf16(a, __builtin_bit_cast(bf16x8, bw), acc, 0, 0, 0); }
        const int n = n0 + r32;
        const size_t tbase = ((size_t)(b * 2 + h) * 16 + nt) * 2048;
        if (kv == 0) { bf16* KC = (bf16*)(ws + WS_KC) + tbase;
#pragma unroll
            for (int q = 0; q < 4; ++q) { v2u o; o.x = pk2(acc[4 * q], acc[4 * q + 1]); o.y = pk2(acc[4 * q + 2], acc[4 * q + 3]); if (n > 510) { o.x = 0u; o.y = 0u; }
                *(v2u*)(KC + (2 * w + (q >> 1)) * 512 + (q & 1) * 256 + r32 * 8 + 4 * hi) = o; } }
        else { bf16* VC = (bf16*)(ws + WS_VCT) + tbase; const int kk = r32 & 15, vo = (r32 >> 4) * 512 + ((kk >> 2) & 1) * 256 + (kk & 3) + 4 * (kk >> 3);
#pragma unroll
            for (int r = 0; r < 16; ++r) VC[w * 1024 + crow(r, hi) * 8 + vo] = (n > 510) ? (bf16)0 : (bf16)f2bf(acc[r]); }
    }
    __syncthreads();
}

__device__ __forceinline__ void sort16_desc(int (&k)[16]) {
#define CX(i, j) { const int hi_ = max(k[i], k[j]), lo_ = min(k[i], k[j]); k[i] = hi_; k[j] = lo_; }
    CX(0, 1) CX(2, 3) CX(0, 2) CX(1, 3) CX(1, 2) CX(4, 5) CX(6, 7) CX(4, 6) CX(5, 7) CX(5, 6) CX(0, 4) CX(2, 6) CX(2, 4) CX(1, 5) CX(3, 7) CX(3, 5) CX(1, 2)
    CX(3, 4) CX(5, 6) CX(8, 9) CX(10, 11) CX(8, 10) CX(9, 11) CX(9, 10) CX(12, 13) CX(14, 15) CX(12, 14) CX(13, 15) CX(13, 14) CX(8, 12) CX(10, 14) CX(10, 12)
    CX(9, 13) CX(11, 15) CX(11, 13) CX(9, 10) CX(11, 12) CX(13, 14) CX(0, 8) CX(4, 12) CX(4, 8) CX(2, 10) CX(6, 14) CX(6, 10) CX(2, 4) CX(6, 8) CX(10, 12)
    CX(1, 9) CX(5, 13) CX(5, 9) CX(3, 11) CX(7, 15) CX(7, 11) CX(3, 5) CX(7, 9) CX(11, 13) CX(1, 2) CX(3, 4) CX(5, 6) CX(7, 8) CX(9, 10) CX(11, 12) CX(13, 14)
#undef CX
}
__device__ __forceinline__ void sort32_desc(int (&k)[32]) {
#define CX(i, j) { const int hi_ = max(k[i], k[j]), lo_ = min(k[i], k[j]); k[i] = hi_; k[j] = lo_; }
    CX(0, 1) CX(2, 3) CX(0, 2) CX(1, 3) CX(1, 2) CX(4, 5) CX(6, 7) CX(4, 6) CX(5, 7) CX(5, 6) CX(0, 4) CX(2, 6) CX(2, 4) CX(1, 5) CX(3, 7) CX(3, 5) CX(1, 2)
    CX(3, 4) CX(5, 6) CX(8, 9) CX(10, 11) CX(8, 10) CX(9, 11) CX(9, 10) CX(12, 13) CX(14, 15) CX(12, 14) CX(13, 15) CX(13, 14) CX(8, 12) CX(10, 14) CX(10, 12)
    CX(9, 13) CX(11, 15) CX(11, 13) CX(9, 10) CX(11, 12) CX(13, 14) CX(0, 8) CX(4, 12) CX(4, 8) CX(2, 10) CX(6, 14) CX(6, 10) CX(2, 4) CX(6, 8) CX(10, 12)
    CX(1, 9) CX(5, 13) CX(5, 9) CX(3, 11) CX(7, 15) CX(7, 11) CX(3, 5) CX(7, 9) CX(11, 13) CX(1, 2) CX(3, 4) CX(5, 6) CX(7, 8) CX(9, 10) CX(11, 12) CX(13, 14)
    CX(16, 17) CX(18, 19) CX(16, 18) CX(17, 19) CX(17, 18) CX(20, 21) CX(22, 23) CX(20, 22) CX(21, 23) CX(21, 22) CX(16, 20) CX(18, 22) CX(18, 20) CX(17, 21)
    CX(19, 23) CX(19, 21) CX(17, 18) CX(19, 20) CX(21, 22) CX(24, 25) CX(26, 27) CX(24, 26) CX(25, 27) CX(25, 26) CX(28, 29) CX(30, 31) CX(28, 30) CX(29, 31)
    CX(29, 30) CX(24, 28) CX(26, 30) CX(26, 28) CX(25, 29) CX(27, 31) CX(27, 29) CX(25, 26) CX(27, 28) CX(29, 30) CX(16, 24) CX(20, 28) CX(20, 24) CX(18, 26)
    CX(22, 30) CX(22, 26) CX(18, 20) CX(22, 24) CX(26, 28) CX(17, 25) CX(21, 29) CX(21, 25) CX(19, 27) CX(23, 31) CX(23, 27) CX(19, 21) CX(23, 25) CX(27, 29)
    CX(17, 18) CX(19, 20) CX(21, 22) CX(23, 24) CX(25, 26) CX(27, 28) CX(29, 30) CX(0, 16) CX(8, 24) CX(8, 16) CX(4, 20) CX(12, 28) CX(12, 20) CX(4, 8)
    CX(12, 16) CX(20, 24) CX(2, 18) CX(10, 26) CX(10, 18) CX(6, 22) CX(14, 30) CX(14, 22) CX(6, 10) CX(14, 18) CX(22, 26) CX(2, 4) CX(6, 8) CX(10, 12)
    CX(14, 16) CX(18, 20) CX(22, 24) CX(26, 28) CX(1, 17) CX(9, 25) CX(9, 17) CX(5, 21) CX(13, 29) CX(13, 21) CX(5, 9) CX(13, 17) CX(21, 25) CX(3, 19)
    CX(11, 27) CX(11, 19) CX(7, 23) CX(15, 31) CX(15, 23) CX(7, 11) CX(15, 19) CX(23, 27) CX(3, 5) CX(7, 9) CX(11, 13) CX(15, 17) CX(19, 21) CX(23, 25)
    CX(27, 29) CX(1, 2) CX(3, 4) CX(5, 6) CX(7, 8) CX(9, 10) CX(11, 12) CX(13, 14) CX(15, 16) CX(17, 18) CX(19, 20) CX(21, 22) CX(23, 24) CX(25, 26) CX(27, 28)
    CX(29, 30)
#undef CX
}
__device__ __forceinline__ void bitonic16_desc(int (&a)[16]) {
#pragma unroll
    for (int s = 8; s >= 1; s >>= 1)
#pragma unroll
        for (int i = 0; i < 16; ++i) if ((i & s) == 0) { const int hi_ = max(a[i], a[i + s]), lo_ = min(a[i], a[i + s]); a[i] = hi_; a[i + s] = lo_; }
}
__device__ __forceinline__ void merge16_desc(int (&a)[16], const int (&b)[16]) {
#pragma unroll
    for (int i = 0; i < 16; ++i) a[i] = max(a[i], b[15 - i]);
    bitonic16_desc(a);
}
struct AttnSt { float m, l; f32x16 o[2]; };
#define EX2(x) __builtin_amdgcn_exp2f(x)
struct KVF { bf16x8 k[4]; bf16x8 v[2][2]; };
struct KVF8 { bf16x8 k[4]; v4u v8[2]; };
__device__ __forceinline__ void kv_load8(KVF8& f, const bf16* Kt, const unsigned char* Vt8, unsigned lo16) {
    const char* kb = (const char*)Kt + lo16;
#pragma unroll
    for (int ks = 0; ks < 4; ++ks) f.k[ks] = *(const bf16x8*)(kb + 1024 * ks);
#pragma unroll
    for (int dt = 0; dt < 2; ++dt) f.v8[dt] = *(const v4u*)(Vt8 + lo16 + 1024 * dt);
}
typedef __bf16 bf16x2v __attribute__((ext_vector_type(2)));
__device__ __forceinline__ bf16x8 dq8(unsigned w0, unsigned w1) {
    v4u o; o.x = __builtin_bit_cast(unsigned, __builtin_amdgcn_cvt_scalef32_pk_bf16_fp8(w0, 1.0f, false)); o.y = __builtin_bit_cast(unsigned, __builtin_amdgcn_cvt_scalef32_pk_bf16_fp8(w0, 1.0f, true));
    o.z = __builtin_bit_cast(unsigned, __builtin_amdgcn_cvt_scalef32_pk_bf16_fp8(w1, 1.0f, false)); o.w = __builtin_bit_cast(unsigned, __builtin_amdgcn_cvt_scalef32_pk_bf16_fp8(w1, 1.0f, true));
    return __builtin_bit_cast(bf16x8, o); }
__device__ __forceinline__ void kv_load(KVF& f, const bf16* Kt, const bf16* Vt, unsigned lo16) {
    const char* kb = (const char*)Kt + lo16; const char* vb = (const char*)Vt + lo16;
#pragma unroll
    for (int ks = 0; ks < 4; ++ks) f.k[ks] = *(const bf16x8*)(kb + 1024 * ks);
#pragma unroll
    for (int dt = 0; dt < 2; ++dt)
#pragma unroll
        for (int s2 = 0; s2 < 2; ++s2) f.v[dt][s2] = *(const bf16x8*)(vb + 2048 * dt + 1024 * s2);
}
#define MAX3(a, b, c) __builtin_fmaxf(__builtin_fmaxf((a), (b)), (c))
__device__ __forceinline__ float max16(const f32x16& s) { const float a = MAX3(s[0], s[1], s[2]), b = MAX3(s[3], s[4], s[5]), c = MAX3(s[6], s[7], s[8]), d = MAX3(s[9], s[10], s[11]), e = MAX3(s[12], s[13], s[14]);
    return MAX3(MAX3(a, b, c), MAX3(d, e, s[15]), -1e30f); }
__device__ __forceinline__ float sum16(const f32x16& s) { return (((s[0] + s[1]) + (s[2] + s[3])) + ((s[4] + s[5]) + (s[6] + s[7]))) + (((s[8] + s[9]) + (s[10] + s[11])) + ((s[12] + s[13]) + (s[14] + s[15]))); }
template <int MODE, bool FIXED, class AllowF>
__device__ __forceinline__ void attn_compute(const KVF8& f, const bf16x8 (&qf)[4], const f32x16& negm, bool sel, AllowF allow, AttnSt& st) {
    f32x16 s = FIXED ? negm : f32x16{};
#pragma unroll
    for (int ks = 0; ks < 4; ++ks) s = __builtin_amdgcn_mfma_f32_32x32x16_bf16(f.k[ks], qf[ks], s, 0, 0, 0);
    if (MODE == 2) {
#pragma unroll
        for (int r = 0; r < 16; ++r) if (!allow(r)) s[r] = -1e30f; }
    if (!FIXED) {
        float mt = max16(s);
        if (MODE == 1) mt = sel ? mt : -1e30f;
        mt = maxswap32_f(mt);
        if (__any(mt > st.m)) {
            const float mn = fmaxf(st.m, mt), alpha = EX2(st.m - mn);
            st.m = mn; st.l *= alpha;
#pragma unroll
            for (int dt = 0; dt < 2; ++dt)
#pragma unroll
                for (int r = 0; r < 16; ++r) st.o[dt][r] *= alpha;
        }
        const float mref = (MODE == 1 && !sel) ? 1e30f : fmaxf(st.m, -1e29f);
#pragma unroll
        for (int r = 0; r < 16; ++r) s[r] = EX2(s[r] - mref);
        st.l += sum16(s);
    } else {
#pragma unroll
        for (int r = 0; r < 16; ++r) s[r] = EX2(s[r]);
        const float ps = sum16(s);
        st.l += (MODE == 1 && !sel) ? 0.f : ps;
    }
#pragma unroll
    for (int s2 = 0; s2 < 2; ++s2) { v4u pw; pw.x = pk2(s[8 * s2], s[8 * s2 + 1]); pw.y = pk2(s[8 * s2 + 2], s[8 * s2 + 3]); pw.z = pk2(s[8 * s2 + 4], s[8 * s2 + 5]); pw.w = pk2(s[8 * s2 + 6], s[8 * s2 + 7]);
        if (FIXED && MODE == 1) { pw.x = sel ? pw.x : 0u; pw.y = sel ? pw.y : 0u; pw.z = sel ? pw.z : 0u; pw.w = sel ? pw.w : 0u; }
        const bf16x8 pf = __builtin_bit_cast(bf16x8, pw);
#pragma unroll
        for (int dt = 0; dt < 2; ++dt) st.o[dt] = __builtin_amdgcn_mfma_f32_32x32x16_bf16(dq8(f.v8[dt][2 * s2], f.v8[dt][2 * s2 + 1]), pf, st.o[dt], 0, 0, 0); }
}
constexpr int IMP_LD = 132;
__device__ __forceinline__ void nsa_item(const Frame& F, const Args& A, LAS unsigned char* lds, int b, int kvh, int tb, int wsub) {
    unsigned char* ws = A.ws;
    int lane = lane_id(); asm volatile("" : "+v"(lane));
    const int r32 = lane & 31, hi = lane >> 5, w = F.wave;
    const int t0 = 64 * tb + 8 * wsub, ti = r32 & 7, g = r32 >> 3, t = t0 + ti, cur = tb;
    const size_t rowb = (size_t)b * SEQ;
    const bf16* Z = (const bf16*)(ws + WS_Z);
    LAS float* imp = (LAS float*)lds + w * 8 * IMP_LD;
    for (int i = lane; i < 8 * IMP_LD; i += 64) imp[i] = 0.f;
    bf16x8 qf[4];
#pragma unroll
    for (int ks = 0; ks < 4; ++ks) qf[ks] = *(const bf16x8*)(Z + (rowb + t) * NZ + ZC_Q + (kvh * 4 + g) * 64 + 16 * ks + 8 * hi);
    const float* gp = (const float*)(ws + WS_GATES) + (rowb + t) * 24 + (kvh * 4 + g) * 3;
    const float gate_c = gp[0], gate_s = gp[1], gate_w = gp[2];
    LAS float* oacc = (LAS float*)(lds + 8 * 8 * IMP_LD * 4) + w * 2048 + lane;
    {
        const bf16* KC = (const bf16*)(ws + WS_KC) + (size_t)(b * 2 + kvh) * 16 * 2048;
        const bf16* VCT = (const bf16*)(ws + WS_VCT) + (size_t)(b * 2 + kvh) * 16 * 2048;
        const int nv = (t >= 31) ? ((t - 31) >> 4) + 1 : 0;
        const int tl = t0 + 7, nvmax = (tl >= 31) ? ((tl - 31) >> 4) + 1 : 0;
        const unsigned lo16 = 16u * (unsigned)lane;
        float m1 = -1e30f, l1 = 0.f;
        {
            bf16x8 ka[4], kb[4];
#pragma unroll
            for (int ks = 0; ks < 4; ++ks) ka[ks] = *(const bf16x8*)((const char*)KC + lo16 + 1024 * ks);
            for (int n0 = 0; n0 < nvmax; n0 += 32) {
                if (n0 + 32 < nvmax) {
#pragma unroll
                    for (int ks = 0; ks < 4; ++ks) kb[ks] = *(const bf16x8*)((const char*)(KC + (size_t)(n0 + 32) * 64) + lo16 + 1024 * ks);
                }
                f32x16 s = f32x16{};
#pragma unroll
                for (int ks = 0; ks < 4; ++ks) s = __builtin_amdgcn_mfma_f32_32x32x16_bf16(ka[ks], qf[ks], s, 0, 0, 0);
                float mt = -1e30f;
#pragma unroll
                for (int r = 0; r < 16; ++r) { if (n0 + crow(r, hi) >= nv) s[r] = -1e30f; mt = fmaxf(mt, s[r]); }
                const float mn = fmaxf(m1, mt); float ps = 0.f;
#pragma unroll
                for (int r = 0; r < 16; ++r) ps += (s[r] > -1e29f) ? EX2(s[r] - mn) : 0.f;
                l1 = l1 * EX2(m1 - mn) + ps; m1 = mn;
#pragma unroll
                for (int ks = 0; ks < 4; ++ks) ka[ks] = kb[ks];
            }
        }
        { const float mo = __shfl_xor(m1, 32), lo = __shfl_xor(l1, 32); const float mn = fmaxf(m1, mo); l1 = l1 * EX2(m1 - mn) + lo * EX2(mo - mn); m1 = mn; }
        const float invl = (l1 > 0.f) ? 1.0f / l1 : 0.f;
        f32x16 o[2]; o[0] = f32x16{}; o[1] = f32x16{};
        KVF fa, fb;
        if (nvmax > 0) kv_load(fa, KC, VCT, lo16);
        for (int n0 = 0; n0 < nvmax; n0 += 32) {
            if (n0 + 32 < nvmax) kv_load(fb, KC + (size_t)(n0 + 32) * 64, VCT + (size_t)(n0 + 32) * 64, lo16);
            f32x16 s = f32x16{};
#pragma unroll
            for (int ks = 0; ks < 4; ++ks) s = __builtin_amdgcn_mfma_f32_32x32x16_bf16(fa.k[ks], qf[ks], s, 0, 0, 0);
#pragma unroll
            for (int r = 0; r < 16; ++r) s[r] = (n0 + crow(r, hi) < nv) ? EX2(s[r] - m1) * invl : 0.f;
            float bs[4], sp[4];
#pragma unroll
            for (int q = 0; q < 4; ++q) { bs[q] = (s[4 * q] + s[4 * q + 1]) + (s[4 * q + 2] + s[4 * q + 3]); sp[q] = s[4 * q + 3];
                bs[q] += __shfl_xor(bs[q], 8); bs[q] += __shfl_xor(bs[q], 16); sp[q] += __shfl_xor(sp[q], 8); sp[q] += __shfl_xor(sp[q], 16); }
            if (r32 < 8) {
                LAS float* ip = imp + r32 * IMP_LD + (n0 >> 2) + hi;
#pragma unroll
                for (int q = 0; q < 4; ++q) ip[2 * q] += bs[q];
                asm volatile("s_waitcnt lgkmcnt(0)" ::: "memory");
#pragma unroll
                for (int q = 0; q < 4; ++q) ip[2 * q + 1] += sp[q];
                asm volatile("s_waitcnt lgkmcnt(0)" ::: "memory");
            }
#pragma unroll
            for (int s2 = 0; s2 < 2; ++s2) { v4u pw; pw.x = pk2(s[8 * s2], s[8 * s2 + 1]); pw.y = pk2(s[8 * s2 + 2], s[8 * s2 + 3]); pw.z = pk2(s[8 * s2 + 4], s[8 * s2 + 5]); pw.w = pk2(s[8 * s2 + 6], s[8 * s2 + 7]);
                const bf16x8 pf = __builtin_bit_cast(bf16x8, pw);
#pragma unroll
                for (int dt = 0; dt < 2; ++dt) o[dt] = __builtin_amdgcn_mfma_f32_32x32x16_bf16(fa.v[dt][s2], pf, o[dt], 0, 0, 0); }
            if (n0 + 32 < nvmax) fa = fb;
        }
#pragma unroll
        for (int dt = 0; dt < 2; ++dt)
#pragma unroll
            for (int r = 0; r < 16; ++r) oacc[(dt * 16 + r) * 64] = gate_c * o[dt][r];
    }
    asm volatile("s_waitcnt lgkmcnt(0)" ::: "memory");
    unsigned mym[4] = {0u, 0u, 0u, 0u}, un[4] = {0u, 0u, 0u, 0u};
    if (cur < 16) { const unsigned mk = (2u << cur) - 1u; mym[0] = mk; un[0] = mk; }
    else {
        const int tq = lane >> 3, sub = lane & 7;
        int key[16];
#pragma unroll
        for (int i = 0; i < 16; ++i) { const int j = 16 * sub + i; const float v = imp[tq * IMP_LD + j];
            key[i] = (j >= 1 && j <= cur - 2) ? (int)((__builtin_bit_cast(unsigned, v) & ~0x7fu) | (unsigned)(127 - j)) : 0; }
        sort16_desc(key);
        { int ot[16];
#pragma unroll
          for (int i = 0; i < 16; ++i) ot[i] = __builtin_amdgcn_mov_dpp(key[i], 0xB1, 0xf, 0xf, true);
          merge16_desc(key, ot);
#pragma unroll
          for (int i = 0; i < 16; ++i) ot[i] = __builtin_amdgcn_mov_dpp(key[i], 0x4E, 0xf, 0xf, true);
          merge16_desc(key, ot);
#pragma unroll
          for (int i = 0; i < 16; ++i) ot[i] = __builtin_amdgcn_mov_dpp(key[i], 0x141, 0xf, 0xf, true);
          merge16_desc(key, ot); }
        unsigned mk[4] = {1u, 0u, 0u, 0u};
        { const int c1 = cur - 1; if (c1 < 32) mk[0] |= 1u << c1; else if (c1 < 64) mk[1] |= 1u << (c1 - 32); else if (c1 < 96) mk[2] |= 1u << (c1 - 64); else mk[3] |= 1u << (c1 - 96);
          if (cur < 32) mk[0] |= 1u << cur; else if (cur < 64) mk[1] |= 1u << (cur - 32); else if (cur < 96) mk[2] |= 1u << (cur - 64); else mk[3] |= 1u << (cur - 96); }
#pragma unroll
        for (int i = 0; i < 13; ++i) { const int j = 127 - (key[i] & 0x7f); const unsigned bit = (key[i] != 0) ? (1u << (j & 31)) : 0u; const int wd = j >> 5;
            mk[0] |= (wd == 0) ? bit : 0u; mk[1] |= (wd == 1) ? bit : 0u; mk[2] |= (wd == 2) ? bit : 0u; mk[3] |= (wd == 3) ? bit : 0u; }
#pragma unroll
        for (int i = 0; i < 4; ++i) { unsigned u = mk[i]; u |= (unsigned)__shfl_xor((int)u, 8); u |= (unsigned)__shfl_xor((int)u, 16); u |= (unsigned)__shfl_xor((int)u, 32); un[i] = u;
            mym[i] = (unsigned)__shfl((int)mk[i], 8 * ti); }
    }
    float q2 = 0.f;
#pragma unroll
    for (int ks = 0; ks < 4; ++ks) { const v4u qw = __builtin_bit_cast(v4u, qf[ks]); const unsigned ww[4] = {qw.x, qw.y, qw.z, qw.w};
#pragma unroll
        for (int k = 0; k < 4; ++k) { const float a = bflo(ww[k]), c = bfhi(ww[k]); q2 += a * a + c * c; } }
    q2 = addswap32_f(q2);
    const unsigned* KMX = (const unsigned*)(ws + WS_CTL) + CW_KMAX + (b * 2 + kvh) * 2;
    const float Ms = __builtin_amdgcn_sqrtf(q2 * __builtin_bit_cast(float, KMX[0])) * 1.0001f + 1e-3f, Mw = __builtin_amdgcn_sqrtf(q2 * __builtin_bit_cast(float, KMX[1])) * 1.0001f + 1e-3f;
    const bool fixed_ok = !__any(Ms >= 60.f || Mw >= 60.f);
    {
        AttnSt st; st.m = -1e30f; st.l = 0.f; st.o[0] = f32x16{}; st.o[1] = f32x16{};
        const bf16* KS = (const bf16*)(ws + WS_KSF) + (size_t)(b * 2 + kvh) * 256 * 2048; const unsigned char* VS = ws + WS_VSF + (size_t)(b * 2 + kvh) * 256 * 2048;
        const unsigned lo16 = 16u * (unsigned)lane;
        unsigned um0 = (unsigned)__builtin_amdgcn_readfirstlane((int)un[0]), um1 = (unsigned)__builtin_amdgcn_readfirstlane((int)un[1]), um2 = (unsigned)__builtin_amdgcn_readfirstlane((int)un[2]), um3 = (unsigned)__builtin_amdgcn_readfirstlane((int)un[3]);
#define NEXT_BLOCK(jv) do { if (um0) { jv = __builtin_ctz(um0); um0 &= um0 - 1u; } else if (um1) { jv = 32 + __builtin_ctz(um1); um1 &= um1 - 1u; } else if (um2) { jv = 64 + __builtin_ctz(um2); um2 &= um2 - 1u; } \
            else if (um3) { jv = 96 + __builtin_ctz(um3); um3 &= um3 - 1u; } else jv = -1; } while (0)
#define SLC_LOOP(FX) do { f32x16 negm; _Pragma("unroll") for (int r = 0; r < 16; ++r) negm[r] = -Ms; \
        KVF8 fa, fb; int j; NEXT_BLOCK(j); \
        if (j >= 0) kv_load8(fa, KS + (size_t)j * 4096, VS + (size_t)j * 4096, lo16); \
        while (j >= 0) { const int key0 = j * 64; \
            const unsigned mw = (j < 32) ? mym[0] : (j < 64) ? mym[1] : (j < 96) ? mym[2] : mym[3]; const bool sel = (mw >> (j & 31)) & 1u; \
            kv_load8(fb, KS + (size_t)j * 4096 + 2048, VS + (size_t)j * 4096 + 2048, lo16); \
            if (j == cur) attn_compute<2, FX>(fa, qf, negm, sel, [&](int r) { return sel && (key0 + crow(r, hi) <= t); }, st); \
            else attn_compute<1, FX>(fa, qf, negm, sel, [&](int) { return true; }, st); \
            int jn; NEXT_BLOCK(jn); \
            if (jn >= 0) kv_load8(fa, KS + (size_t)jn * 4096, VS + (size_t)jn * 4096, lo16); \
            if (j == cur) attn_compute<2, FX>(fb, qf, negm, sel, [&](int r) { return sel && (key0 + 32 + crow(r, hi) <= t); }, st); \
            else attn_compute<1, FX>(fb, qf, negm, sel, [&](int) { return true; }, st); \
            j = jn; } } while (0)
        if (fixed_ok) SLC_LOOP(true); else SLC_LOOP(false);
#undef SLC_LOOP
#undef NEXT_BLOCK
        const float l = addswap32_f(st.l); const float sc = gate_s / l;
#pragma unroll
        for (int dt = 0; dt < 2; ++dt)
#pragma unroll
            for (int r = 0; r < 16; ++r) oacc[(dt * 16 + r) * 64] += sc * st.o[dt][r];
    }
    f32x16 outv[2];
    {
        AttnSt st; st.m = -1e30f; st.l = 0.f; st.o[0] = f32x16{}; st.o[1] = f32x16{};
        const bf16* KW = (const bf16*)(ws + WS_KWF) + (size_t)(b * 2 + kvh) * 256 * 2048; const unsigned char* VW = ws + WS_VWF + (size_t)(b * 2 + kvh) * 256 * 2048;
        const unsigned lo16 = 16u * (unsigned)lane;
        const int klo = (t0 - 511 > 0) ? ((t0 - 511) & ~31) : 0, khi = (t0 + 7) & ~31;
#define WIN_LOOP(FX) do { f32x16 negm; _Pragma("unroll") for (int r = 0; r < 16; ++r) negm[r] = -Mw; \
        KVF8 fa, fb; kv_load8(fa, KW + (size_t)klo * 64, VW + (size_t)klo * 64, lo16); \
        _Pragma("unroll 1") for (int key0 = klo; key0 <= khi; key0 += 32) { \
            if (key0 + 32 <= khi) kv_load8(fb, KW + (size_t)(key0 + 32) * 64, VW + (size_t)(key0 + 32) * 64, lo16); \
            if (key0 + 31 > t0 || key0 <= t0 + 7 - 512) attn_compute<2, FX>(fa, qf, negm, true, [&](int r) { const int kp = key0 + crow(r, hi); return kp <= t && kp > t - 512; }, st); \
            else attn_compute<0, FX>(fa, qf, negm, true, [&](int) { return true; }, st); \
            if (key0 + 32 <= khi) fa = fb; } } while (0)
        if (fixed_ok) WIN_LOOP(true); else WIN_LOOP(false);
#undef WIN_LOOP
        const float l = addswap32_f(st.l); const float sc = gate_w / l;
#pragma unroll
        for (int dt = 0; dt < 2; ++dt)
#pragma unroll
            for (int r = 0; r < 16; ++r) outv[dt][r] = oacc[(dt * 16 + r) * 64] + sc * st.o[dt][r];
    }
    float ss = 0.f;
#pragma unroll
    for (int dt = 0; dt < 2; ++dt)
#pragma unroll
        for (int r = 0; r < 16; ++r) ss += outv[dt][r] * outv[dt][r];
    ss += __shfl_xor(ss, 32); ss += __shfl_xor(ss, 8); ss += __shfl_xor(ss, 16);
    if (lane < 8) ((float*)(ws + WS_SSQN))[(rowb + t0 + lane) * 2 + kvh] = ss;
    bf16* Yp = (bf16*)(ws + WS_Y) + (rowb + t) * DM + (kvh * 4 + g) * 64 + 4 * hi;
#pragma unroll
    for (int dt = 0; dt < 2; ++dt)
#pragma unroll
        for (int q = 0; q < 4; ++q) { v2u o; o.x = pk2(outv[dt][4 * q], outv[dt][4 * q + 1]); o.y = pk2(outv[dt][4 * q + 2], outv[dt][4 * q + 3]); *(v2u*)(Yp + 32 * dt + 8 * q) = o; }
}
__device__ __forceinline__ void memattn_item(const Frame& F, const Args& A, int item) {
    unsigned char* ws = A.ws;
    const int lane = F.lane, r32 = lane & 31, hi = lane >> 5;
    const int h = item & 3, tile = item >> 2; const size_t row0 = (size_t)tile * 32; const int b = (int)(row0 >> 13);
    const bf16* Q = (const bf16*)(ws + WS_QM) + (size_t)tile * 32 * DM + (size_t)(h * 16) * 512 + 8 * lane;
    const bf16* K = (const bf16*)(ws + WS_MEMK) + (size_t)(b * 8) * 32 * DM + (size_t)(h * 16) * 512 + 8 * lane;
    const bf16* VF = (const bf16*)(ws + WS_MEMVT) + (size_t)((b * 4 + h) * 8) * 8192 + 8 * lane;
    f32x16 s[8];
#pragma unroll
    for (int kt = 0; kt < 8; ++kt) s[kt] = f32x16{};
#define QK_LOAD(qv, kv, ks_) do { const int kk_ = (ks_) < 16 ? (ks_) : 15; qv = __builtin_nontemporal_load((const bf16x8*)(Q + 512 * kk_)); _Pragma("unroll") for (int kt = 0; kt < 8; ++kt) kv[kt] = *(const bf16x8*)(K + (size_t)kt * 32 * DM + 512 * kk_); } while (0)
#define QK_MMA(qv, kv) do { _Pragma("unroll") for (int kt = 0; kt < 8; ++kt) s[kt] = __builtin_amdgcn_mfma_f32_32x32x16_bf16(kv[kt], qv, s[kt], 0, 0, 0); } while (0)
    { bf16x8 qa, qb, ka[8], kb[8];
      QK_LOAD(qa, ka, 0);
#pragma unroll 1
      for (int ks = 0; ks < 16; ks += 2) {
          QK_LOAD(qb, kb, ks + 1); asm volatile("" ::: "memory");
          QK_MMA(qa, ka);
          QK_LOAD(qa, ka, ks + 2); asm volatile("" ::: "memory");
          QK_MMA(qb, kb); } }
#undef QK_LOAD
#undef QK_MMA
    float m = -1e30f;
#pragma unroll
    for (int kt = 0; kt < 8; ++kt) m = fmaxf(m, max16(s[kt]));
    m = maxswap32_f(m);
    float l = 0.f; v4u pw[8][2];
#pragma unroll
    for (int kt = 0; kt < 8; ++kt) {
#pragma unroll
        for (int r = 0; r < 16; ++r) s[kt][r] = EX2(s[kt][r] - m);
        l += sum16(s[kt]);
#pragma unroll
        for (int s2 = 0; s2 < 2; ++s2) { pw[kt][s2].x = pk2(s[kt][8 * s2], s[kt][8 * s2 + 1]); pw[kt][s2].y = pk2(s[kt][8 * s2 + 2], s[kt][8 * s2 + 3]); pw[kt][s2].z = pk2(s[kt][8 * s2 + 4], s[kt][8 * s2 + 5]); pw[kt][s2].w = pk2(s[kt][8 * s2 + 6], s[kt][8 * s2 + 7]); } }
    l = addswap32_f(l);
    const float invl = 1.0f / l;
    bf16* O = (bf16*)(ws + WS_OM) + (row0 + r32) * DM + h * 256 + 4 * hi;
#define PV_LOAD(vv, dt_) do { const int dd_ = (dt_) < 8 ? (dt_) : 7; _Pragma("unroll") for (int kt = 0; kt < 8; ++kt) _Pragma("unroll") for (int s2 = 0; s2 < 2; ++s2) vv[2 * kt + s2] = *(const bf16x8*)(VF + (size_t)kt * 8192 + dd_ * 1024 + s2 * 512); } while (0)
#define PV_MMA(vv, dt_) do { f32x16 o = f32x16{}; _Pragma("unroll") for (int kt = 0; kt < 8; ++kt) _Pragma("unroll") for (int s2 = 0; s2 < 2; ++s2) o = __builtin_amdgcn_mfma_f32_32x32x16_bf16(vv[2 * kt + s2], __builtin_bit_cast(bf16x8, pw[kt][s2]), o, 0, 0, 0); \
        _Pragma("unroll") for (int q = 0; q < 4; ++q) { v2u ov; ov.x = pk2(o[4 * q] * invl, o[4 * q + 1] * invl); ov.y = pk2(o[4 * q + 2] * invl, o[4 * q + 3] * invl); *(v2u*)(O + 32 * (dt_) + 8 * q) = ov; } } while (0)
    { bf16x8 va[16], vb[16];
      PV_LOAD(va, 0);
#pragma unroll 1
      for (int dt = 0; dt < 8; dt += 2) {
          PV_LOAD(vb, dt + 1); asm volatile("" ::: "memory");
          PV_MMA(va, dt);
          PV_LOAD(va, dt + 2); asm volatile("" ::: "memory");
          PV_MMA(vb, dt + 1); } }
#undef PV_LOAD
#undef PV_MMA
}

__device__ __forceinline__ int f2key(float f) { const int u = __builtin_bit_cast(int, f); return u ^ ((u >> 31) & 0x7fffffff); }
__device__ __forceinline__ float key2f(int k) { const int u = k ^ ((k >> 31) & 0x7fffffff); return __builtin_bit_cast(float, u); }
__device__ __forceinline__ void top16_of_128(f32x16 (&s)[4], int hi, int (&kv)[16]) {
    int key[4][16];
#pragma unroll
    for (int nt = 0; nt < 4; ++nt)
#pragma unroll
        for (int r = 0; r < 16; ++r) key[nt][r] = (f2key(s[nt][r]) & ~0x7f) | (127 - (32 * nt + crow(r, hi)));
#pragma unroll
    for (int nt = 0; nt < 4; ++nt) sort16_desc(key[nt]);
    merge16_desc(key[0], key[1]); merge16_desc(key[2], key[3]); merge16_desc(key[0], key[2]);
    unsigned a[16], b[16];
#pragma unroll
    for (int i = 0; i < 16; ++i) { a[i] = (unsigned)key[0][i]; b[i] = a[i]; swap32(a[i], b[i]); }
#pragma unroll
    for (int i = 0; i < 16; ++i) kv[i] = max((int)a[i], (int)b[15 - i]);
    bitonic16_desc(kv);
}
template <bool LDSK>
__device__ __forceinline__ void peer_topk_item(const Frame& F, const Args& A, int item, const LAS unsigned char* lds) {
    unsigned char* ws = A.ws;
    int lane = lane_id(); asm volatile("" : "+v"(lane));
    const int r32 = lane & 31, hi = lane >> 5;
    const int h = item & 7, tile = item >> 3; const size_t row = (size_t)tile * 32 + r32;
    const bf16* QP = (const bf16*)(ws + WS_QP) + (size_t)tile * 32 * 2048 + (size_t)(h * 16) * 512 + 8 * lane;
    int k1[16], k2[16];
#pragma unroll
    for (int i = 0; i < 16; ++i) { k1[i] = 0; k2[i] = 0; }
#pragma unroll 1
    for (int c = 0; c < 2; ++c) {
        const bf16* SK = (const bf16*)(ws + WS_SKEY) + (size_t)((h * 2 + c) * 4) * 4096 + 8 * lane;
        f32x16 s[4];
#pragma unroll
        for (int nt = 0; nt < 4; ++nt) s[nt] = f32x16{};
        bf16x8 qf[8];
#pragma unroll
        for (int ks = 0; ks < 8; ++ks) qf[ks] = __builtin_nontemporal_load((const bf16x8*)(QP + (size_t)(c * 8 + ks) * 512));
#pragma unroll
        for (int ks = 0; ks < 8; ++ks) {
#pragma unroll
            for (int nt = 0; nt < 4; ++nt) { const bf16x8 kf = LDSK ? *(const LAS bf16x8*)(lds + ((c * 4 + nt) * 4096 + ks * 512) * 2 + lane * 16) : *(const bf16x8*)(SK + (size_t)nt * 4096 + ks * 512);
                s[nt] = __builtin_amdgcn_mfma_f32_32x32x16_bf16(kf, qf[ks], s[nt], 0, 0, 0); } }
        if (c == 0) top16_of_128(s, hi, k1); else top16_of_128(s, hi, k2);
    }
    float v1[16], v2[16];
#pragma unroll
    for (int i = 0; i < 16; ++i) { v1[i] = key2f(k1[i] & ~0x7f); v2[i] = key2f(k2[i] & ~0x7f); }
    int ck[32];
    {
        int idx = 0;
#pragma unroll
        for (int i = 0; i < 32; ++i) ck[i] = (int)0x80000000;
#pragma unroll
        for (int a = 0; a < 16; ++a)
#pragma unroll
            for (int bq = 0; bq < 16; ++bq) if ((a + 1) * (bq + 1) <= 16) {
                const int flat = a * 16 + bq; const int kk = (f2key(v1[a] + v2[bq]) & ~0xff) | (255 - flat);
                if ((idx & 1) == hi) ck[idx >> 1] = kk;
                ++idx; }
    }
    sort32_desc(ck);
    int tk[16];
    { unsigned a[16], b[16];
#pragma unroll
      for (int i = 0; i < 16; ++i) { a[i] = (unsigned)ck[i]; b[i] = a[i]; swap32(a[i], b[i]); }
#pragma unroll
      for (int i = 0; i < 16; ++i) tk[i] = max((int)a[i], (int)b[15 - i]);
      bitonic16_desc(tk); }
    int te[16];
    { LAS int* tab = (LAS int*)(lds + 65536 + F.wave * 8448) + lane * 33;
#pragma unroll
      for (int i = 0; i < 16; ++i) { tab[i] = 127 - (k1[i] & 0x7f); tab[16 + i] = 127 - (k2[i] & 0x7f); }
      asm volatile("s_waitcnt lgkmcnt(0)" ::: "memory");
#pragma unroll
      for (int i = 0; i < 16; ++i) { const int flat = 255 - (tk[i] & 0xff); te[i] = tab[flat >> 4] * 128 + tab[16 + (flat & 15)]; }
      asm volatile("s_waitcnt lgkmcnt(0)" ::: "memory"); }
    float gsm[16]; const float mx = key2f(tk[0] & ~0xff); float den = 0.f;
#pragma unroll
    for (int i = 0; i < 16; ++i) { gsm[i] = __expf(key2f(tk[i] & ~0xff) - mx); den += gsm[i]; }
    const float inv = 1.0f / den;
    if (hi == 0) {
        int* EID = (int*)(ws + WS_EID) + row * 128 + h * 16; float* GW = (float*)(ws + WS_GW) + row * 128 + h * 16;
#pragma unroll
        for (int q = 0; q < 4; ++q) { *(v4u*)(EID + 4 * q) = (v4u){(unsigned)te[4 * q], (unsigned)te[4 * q + 1], (unsigned)te[4 * q + 2], (unsigned)te[4 * q + 3]};
            *(f32x4*)(GW + 4 * q) = (f32x4){gsm[4 * q] * inv, gsm[4 * q + 1] * inv, gsm[4 * q + 2] * inv, gsm[4 * q + 3] * inv}; }
    }
}

typedef float f32x2 __attribute__((ext_vector_type(2)));
__device__ __forceinline__ float dot16_fp8(const v4u u, const f32x2 (&xn)[8]) {
    f32x2 a0 = {0.f, 0.f}, a1 = {0.f, 0.f};
#pragma unroll
    for (int j = 0; j < 4; ++j) { const f32x2 lo = __builtin_amdgcn_cvt_pk_f32_fp8((int)u[j], false), hi = __builtin_amdgcn_cvt_pk_f32_fp8((int)u[j], true);
        a0 = __builtin_elementwise_fma(lo, xn[2 * j], a0); a1 = __builtin_elementwise_fma(hi, xn[2 * j + 1], a1); }
    return (a0.x + a0.y) + (a1.x + a1.y);
}
__device__ __forceinline__ void axpy16_fp8(f32x2 (&acc)[8], const float w, const v4u u) {
    const f32x2 w2 = {w, w};
#pragma unroll
    for (int j = 0; j < 4; ++j) { const f32x2 lo = __builtin_amdgcn_cvt_pk_f32_fp8((int)u[j], false), hi = __builtin_amdgcn_cvt_pk_f32_fp8((int)u[j], true);
        acc[2 * j] = __builtin_elementwise_fma(lo, w2, acc[2 * j]); acc[2 * j + 1] = __builtin_elementwise_fma(hi, w2, acc[2 * j + 1]); }
}
#define TIE_ROW(val, nxt) asm volatile("" : "+v"(val), "+v"((nxt).x), "+v"((nxt).y), "+v"((nxt).z), "+v"((nxt).w))
constexpr int PQ_CHUNK = 128, PQ_NCHUNK = MTOK / PQ_CHUNK;
constexpr int CW_NQ = 10240;
constexpr int CW_PQ = 8192;
__device__ __forceinline__ int pq_pop(unsigned* ctl, int pass, int own, int& q_s, LAS int* bc, int wave) {
    __syncthreads();
    if (wave == 0 && lane_id() == 0) { int res = -1; int s = q_s;
        while (s < 8) { const int x = (own + s) & 7; const unsigned c = __hip_atomic_fetch_add(ctl + CW_PQ + 64 * (8 * pass + x), 1u, __ATOMIC_RELAXED, __HIP_MEMORY_SCOPE_AGENT);
            if (c < (unsigned)PQ_NCHUNK) { res = x * PQ_NCHUNK + (int)c; break; } ++s; }
        bc[0] = res; bc[1] = s; }
    __syncthreads();
    q_s = bc[1]; return bc[0];
}
#define PQ_TICKET(pass_, own_, qs_) (((qs_) < 8 && F.wave == 0 && lane_id() == 0) ? __hip_atomic_fetch_add(ctl + CW_PQ + 64 * (8 * (pass_) + (((own_) + (qs_)) & 7)), 1u, __ATOMIC_RELAXED, __HIP_MEMORY_SCOPE_AGENT) : 0u)
__device__ __forceinline__ int pq_resolve(unsigned* ctl, int pass, int own, int& q_s, unsigned ticket, LAS int* bc, int wave) {
    if (wave == 0 && lane_id() == 0) { int res = -1; int s = q_s;
        if (s < 8) { if (ticket < (unsigned)PQ_NCHUNK) res = ((own + s) & 7) * PQ_NCHUNK + (int)ticket;
                     else { ++s; while (s < 8) { const int x = (own + s) & 7; const unsigned c = __hip_atomic_fetch_add(ctl + CW_PQ + 64 * (8 * pass + x), 1u, __ATOMIC_RELAXED, __HIP_MEMORY_SCOPE_AGENT);
                                if (c < (unsigned)PQ_NCHUNK) { res = x * PQ_NCHUNK + (int)c; break; } ++s; } } }
        bc[0] = res; bc[1] = s; }
    __syncthreads();
    q_s = bc[1]; return bc[0];
}
template <int CTRL> __device__ __forceinline__ float dppf(float v) { return __builtin_bit_cast(float, __builtin_amdgcn_mov_dpp(__builtin_bit_cast(int, v), CTRL, 0xf, 0xf, true)); }
__device__ __forceinline__ float red8(float d) { d += dppf<0xB1>(d); d += dppf<0x4E>(d); d += dppf<0x141>(d); return d; }
__device__ __forceinline__ void peer_issue8(v4u (&rb)[8], const v4u ia, const v4u ib, const unsigned char* T  , unsigned c16) {
    const unsigned e[8] = {ia.x, ia.y, ia.z, ia.w, ib.x, ib.y, ib.z, ib.w};
#pragma unroll
    for (int i = 0; i < 8; ++i) rb[i] = *(const v4u*)(T + (e[i] * 128u + c16));
}
constexpr int PS_ROW = 528, PS_WAVE = 2 * 16 * PS_ROW;
__device__ __forceinline__ void peer_stage16(LAS unsigned char* st, const unsigned char* src  , int lane) {
    v4u e[8];
#pragma unroll
    for (int j = 0; j < 8; ++j) e[j] = __builtin_nontemporal_load((const v4u*)(src + (unsigned)(j * 1024 + lane * 16)));
#pragma unroll
    for (int j = 0; j < 8; ++j) *(LAS v4u*)(st + (2 * j + (lane >> 5)) * PS_ROW + (lane & 31) * 16) = e[j];
}
__device__ __forceinline__ void peer_u_chunk(const Frame& F, const Args& A, LAS unsigned char* lds, int x, int chunk) {
    unsigned char* ws = A.ws; int lane = lane_id(); asm volatile("" : "+v"(lane));
    const int tk = lane >> 3, c8 = lane & 7;
    const unsigned char* U = ws + WS_U8 + (size_t)x * 16384 * 128; const unsigned c16 = 16u * (unsigned)c8;
    LAS unsigned char* st = lds + F.wave * PS_WAVE;
    peer_stage16(st, ws + WS_EID + (size_t)(chunk * PQ_CHUNK + F.wave * 16) * 512, lane);
#pragma unroll 1
    for (int oc = 0; oc < 2; ++oc) {
        const unsigned row = (unsigned)(chunk * PQ_CHUNK + F.wave * 16 + oc * 8 + tk);
        const LAS unsigned char* est = st + (oc * 8 + tk) * PS_ROW;
#define EID_LD(i_) (*(const LAS v4u*)(est + 16 * (i_)))
        f32x2 xn[8];
        { const unsigned char* xb_ = ws + WS_XN; const unsigned xo = row * 2048u + 256u * (unsigned)x + 32u * (unsigned)c8; const v4u xa = *(const v4u*)(xb_ + xo), xb = *(const v4u*)(xb_ + (xo + 16u));
          const unsigned xw[8] = {xa.x, xa.y, xa.z, xa.w, xb.x, xb.y, xb.z, xb.w};
#pragma unroll
          for (int j = 0; j < 8; ++j) { xn[j].x = bflo(xw[j]); xn[j].y = bfhi(xw[j]); } }
        float rstd; { const f32x4* sp = (const f32x4*)(ws + WS_SSQ2 + (size_t)row * 64); const f32x4 a = sp[0], b = sp[1], c = sp[2], d = sp[3];
            rstd = rsqrtf((((a.x + a.y) + (a.z + a.w)) + ((b.x + b.y) + (b.z + b.w)) + ((c.x + c.y) + (c.z + c.w)) + ((d.x + d.y) + (d.z + d.w))) * (1.f / DM) + EPS); }
        unsigned char* ppb = ws + WS_PART; const unsigned po = ((unsigned)x * MTOK + row) * 256u + 32u * (unsigned)c8;
        v4u ra[8], rb[8]; v4u ia0 = EID_LD(0), ia1 = EID_LD(1), ib0 = EID_LD(2), ib1 = EID_LD(3);
        peer_issue8(ra, ia0, ia1, U, c16); ia0 = EID_LD(4); ia1 = EID_LD(5);
#pragma unroll 1
        for (int q = 0; q < 16; q += 2) {
            peer_issue8(rb, ib0, ib1, U, c16); { const int qn = (q + 3 < 16) ? q + 3 : 15; ib0 = EID_LD(2 * qn); ib1 = EID_LD(2 * qn + 1); }
            float k0 = 0.f, k1 = 0.f;
#pragma unroll
            for (int i = 0; i < 8; ++i) { float d = dot16_fp8(ra[i], xn); if (i < 7) TIE_ROW(d, ra[i + 1]); d = red8(d); k0 = (c8 == i) ? d : k0; }
            peer_issue8(ra, ia0, ia1, U, c16); { const int qn = (q + 4 < 16) ? q + 4 : 15; ia0 = EID_LD(2 * qn); ia1 = EID_LD(2 * qn + 1); }
#pragma unroll
            for (int i = 0; i < 8; ++i) { float d = dot16_fp8(rb[i], xn); if (i < 7) TIE_ROW(d, rb[i + 1]); d = red8(d); k1 = (c8 == i) ? d : k1; }
            *(unsigned*)(ppb + (po + 2u * (unsigned)q)) = pk2(k0 * rstd, k1 * rstd);
        }
    }
}
__device__ __forceinline__ void peer_w_rows(const Frame& F, const Args& A) {
    unsigned char* ws = A.ws; const int lane = lane_id();
    const float* SU = (const float*)(ws + WS_SU); const float* SV = (const float*)(ws + WS_SV);
    const int p0 = 2 * lane, k0 = 8 * (p0 & 15) + (p0 >> 4), k1 = k0 + 8;
    for (int m0 = F.gw; m0 < MTOK; m0 += 4 * F.NGW) {
        int e0[4], e1[4]; float g0[4], g1[4]; unsigned pw[4][8];
#pragma unroll
        for (int r = 0; r < 4; ++r) { const size_t row = (size_t)(m0 + r * F.NGW < MTOK ? m0 + r * F.NGW : m0);
            const int* EID = (const int*)(ws + WS_EID) + row * 128; const float* GW = (const float*)(ws + WS_GW) + row * 128;
            e0[r] = EID[k0]; e1[r] = EID[k1]; g0[r] = GW[k0]; g1[r] = GW[k1];
#pragma unroll
            for (int x = 0; x < 8; ++x) pw[r][x] = *(const unsigned*)((const bf16*)(ws + WS_PART) + ((size_t)x * MTOK + row) * 128 + p0); }
        float su0[4], su1[4], sv0[4], sv1[4];
#pragma unroll
        for (int r = 0; r < 4; ++r) { su0[r] = SU[e0[r]]; su1[r] = SU[e1[r]]; sv0[r] = SV[e0[r]]; sv1[r] = SV[e1[r]]; }
#pragma unroll
        for (int r = 0; r < 4; ++r) { if (m0 + r * F.NGW < MTOK) { const size_t row = (size_t)(m0 + r * F.NGW); float s0 = 0.f, s1 = 0.f;
#pragma unroll
            for (int x = 0; x < 8; ++x) { s0 += bflo(pw[r][x]); s1 += bfhi(pw[r][x]); }
            float* W = (float*)(ws + WS_W) + row * 128;
            W[k0] = gelu_tanh(s0 * su0[r]) * g0[r] * sv0[r]; W[k1] = gelu_tanh(s1 * su1[r]) * g1[r] * sv1[r]; } }
    }
}
__device__ __forceinline__ void peer_v_chunk(const Frame& F, const Args& A, LAS unsigned char* lds, int x, int chunk) {
    unsigned char* ws = A.ws; int lane = lane_id(); asm volatile("" : "+v"(lane));
    const int tk = lane >> 3, c8 = lane & 7;
    const unsigned char* V = ws + WS_V8 + (size_t)x * 16384 * 128; const unsigned c16 = 16u * (unsigned)c8;
    LAS unsigned char* st = lds + F.wave * PS_WAVE;
    peer_stage16(st, ws + WS_EID + (size_t)(chunk * PQ_CHUNK + F.wave * 16) * 512, lane);
    peer_stage16(st + 16 * PS_ROW, ws + WS_W + (size_t)(chunk * PQ_CHUNK + F.wave * 16) * 512, lane);
#pragma unroll 1
    for (int oc = 0; oc < 2; ++oc) {
        const unsigned row = (unsigned)(chunk * PQ_CHUNK + F.wave * 16 + oc * 8 + tk);
        const LAS unsigned char* est = st + (oc * 8 + tk) * PS_ROW;
#define W_LD(i_) (*(const LAS f32x4*)(est + 16 * PS_ROW + 16 * (i_)))
        f32x2 acc[8];
#pragma unroll
        for (int j = 0; j < 8; ++j) acc[j] = (f32x2){0.f, 0.f};
        v4u ra[8], rb[8]; v4u ia0 = EID_LD(0), ia1 = EID_LD(1), ib0 = EID_LD(2), ib1 = EID_LD(3); f32x4 wa0 = W_LD(0), wa1 = W_LD(1), wb0 = W_LD(2), wb1 = W_LD(3);
        peer_issue8(ra, ia0, ia1, V, c16); ia0 = EID_LD(4); ia1 = EID_LD(5);
#pragma unroll 1
        for (int q = 0; q < 16; q += 2) {
            peer_issue8(rb, ib0, ib1, V, c16); { const int qn = (q + 3 < 16) ? q + 3 : 15; ib0 = EID_LD(2 * qn); ib1 = EID_LD(2 * qn + 1); }
            { const float wv[8] = {wa0.x, wa0.y, wa0.z, wa0.w, wa1.x, wa1.y, wa1.z, wa1.w};
#pragma unroll
              for (int i = 0; i < 8; ++i) { axpy16_fp8(acc, wv[i], ra[i]); if (i < 7) TIE_ROW(acc[7].y, ra[i + 1]); } }
            { const int qn = (q + 2 < 16) ? q + 2 : 15; wa0 = W_LD(2 * qn); wa1 = W_LD(2 * qn + 1); }
            peer_issue8(ra, ia0, ia1, V, c16); { const int qn = (q + 4 < 16) ? q + 4 : 15; ia0 = EID_LD(2 * qn); ia1 = EID_LD(2 * qn + 1); }
            { const float wv[8] = {wb0.x, wb0.y, wb0.z, wb0.w, wb1.x, wb1.y, wb1.z, wb1.w};
#pragma unroll
              for (int i = 0; i < 8; ++i) { axpy16_fp8(acc, wv[i], rb[i]); if (i < 7) TIE_ROW(acc[7].y, rb[i + 1]); } }
            { const int qn = (q + 3 < 16) ? q + 3 : 15; wb0 = W_LD(2 * qn); wb1 = W_LD(2 * qn + 1); }
        }
        unsigned char* xr = ws + WS_XN + (row * 2048u + 256u * (unsigned)x + 32u * (unsigned)c8); float ss = 0.f;
        const v4u x2a = *(const v4u*)xr, x2b = *(const v4u*)(xr + 16);
        const unsigned xw[8] = {x2a.x, x2a.y, x2a.z, x2a.w, x2b.x, x2b.y, x2b.z, x2b.w};
        unsigned ow[8];
#pragma unroll
        for (int j = 0; j < 4; ++j) { f32x4 v; v.x = bflo(xw[2 * j]) + acc[2 * j].x; v.y = bfhi(xw[2 * j]) + acc[2 * j].y; v.z = bflo(xw[2 * j + 1]) + acc[2 * j + 1].x; v.w = bfhi(xw[2 * j + 1]) + acc[2 * j + 1].y;
            ss += (v.x * v.x + v.y * v.y) + (v.z * v.z + v.w * v.w); ow[2 * j] = pk2(v.x, v.y); ow[2 * j + 1] = pk2(v.z, v.w); }
        *(v4u*)xr = (v4u){ow[0], ow[1], ow[2], ow[3]}; *(v4u*)(xr + 16) = (v4u){ow[4], ow[5], ow[6], ow[7]};
        ss = red8(ss);
        if (c8 == 0) ((float*)(ws + WS_SSQ3))[row * 8 + x] = ss;
    }
#undef W_LD
#undef EID_LD
}
__device__ __forceinline__ void peer_final_rows(const Frame& F, const Args& A) {
    unsigned char* ws = A.ws; const int lane = lane_id(); const float* g = A.in[32];
    for (int m = F.gw; m < MTOK; m += F.NGW) {
        const f32x4 sa = *(const f32x4*)((const float*)(ws + WS_SSQ3) + (size_t)m * 8), sb = *(const f32x4*)((const float*)(ws + WS_SSQ3) + (size_t)m * 8 + 4);
        const float rstd = rsqrtf((((sa.x + sa.y) + (sa.z + sa.w)) + ((sb.x + sb.y) + (sb.z + sb.w))) * (1.f / DM) + EPS);
        f32x4* xr = (f32x4*)(A.out + (size_t)m * DM) + lane; const v2u* xb = (const v2u*)((const bf16*)(ws + WS_XN) + (size_t)m * DM) + lane;
#pragma unroll
        for (int j = 0; j < 4; ++j) { const v2u w = xb[64 * j]; const f32x4 gg = ((const f32x4*)g)[lane + 64 * j]; const f32x4 v = {bflo(w.x), bfhi(w.x), bflo(w.y), bfhi(w.y)}; __builtin_nontemporal_store(v * rstd * gg, xr + 64 * j); }
    }
}

typedef GAS unsigned gu32;
#define RLX_AGENT __ATOMIC_RELAXED, __HIP_MEMORY_SCOPE_AGENT
#define XB_TMO      128
#define XB_XCNT(j)  (256  + 64 * (j))
#define XB_XSUB(j)  (1280 + 64 * (j))
#define XB_XGEN(j)  (2304 + 64 * (j))
#define XB_TOP      3328
#define XB_TOPGEN   3392
#define XCD_BAR_WORDS 3456
#define XB_SPIN_CAP (1u << 18)

__device__ __forceinline__ unsigned xb_ld(unsigned* p)              { return __hip_atomic_load(p, __ATOMIC_RELAXED, __HIP_MEMORY_SCOPE_AGENT); }
__device__ __forceinline__ unsigned xb_add(unsigned* p, unsigned v) { return __hip_atomic_fetch_add(p, v, __ATOMIC_RELAXED, __HIP_MEMORY_SCOPE_AGENT); }
__device__ __forceinline__ unsigned xb_xcc_id() { return (unsigned)__builtin_amdgcn_s_getreg((3 << 11) | 20) & 0xFu; }
#define XB_SPIN(cond, bar) do { unsigned _sp = 0; while (cond) { __builtin_amdgcn_s_sleep(1); \
    if ((++_sp & 255u) == 0u) { if (xb_ld(&(bar)[XB_TMO])) break; if (_sp > XB_SPIN_CAP) { atomicAdd(&(bar)[XB_TMO], 1u); break; } } } } while (0)

struct XcdBarrier {
    unsigned* bar; unsigned x;
    volatile LAS unsigned* st;
};

__device__ __forceinline__ XcdBarrier xcd_barrier_post(unsigned* bar, volatile LAS unsigned* st) {
    XcdBarrier b; b.bar = bar; b.x = xb_xcc_id(); b.st = st;
    if (threadIdx.x == 0) (void)xb_add(&bar[XB_XCNT(b.x)], 1u);
    return b;
}
__device__ __forceinline__ void xcd_barrier_complete(unsigned* bar, unsigned x, unsigned& nloc, unsigned& nx) {
    const unsigned G = gridDim.x * gridDim.y * gridDim.z;
    unsigned sum, cnt, mine, sp = 0u;
    for (;;) {
        sum = 0u; cnt = 0u; mine = 0u;
#pragma unroll
        for (unsigned j = 0; j < 16; ++j) { const unsigned c = xb_ld(&bar[XB_XCNT(j)]); sum += c; cnt += (c > 0u) ? 1u : 0u; mine = (j == x) ? c : mine; }
        if (sum == G) break;
        __builtin_amdgcn_s_sleep(1);
        if ((++sp & 255u) == 0u) { if (xb_ld(&bar[XB_TMO])) break; if (sp > XB_SPIN_CAP) { atomicAdd(&bar[XB_TMO], 1u); break; } }
    }
    nloc = mine > 0u ? mine : 1u; nx = cnt > 0u ? cnt : 1u;
}

__device__ __forceinline__ void xcd_barrier(const XcdBarrier& b) {
    asm volatile("s_waitcnt vmcnt(0)" ::: "memory");
    __syncthreads();
    if (threadIdx.x == 0) {
        unsigned* bar = b.bar;
        __builtin_amdgcn_s_waitcnt(0);
        unsigned nloc = b.st[0], nx = b.st[1];
        if (nloc == 0u) { xcd_barrier_complete(bar, b.x, nloc, nx); b.st[0] = nloc; b.st[1] = nx; }
        const unsigned old = xb_add(&bar[XB_XSUB(b.x)], 1u);
        const unsigned gen = old / nloc;
        if (old + 1u == (gen + 1u) * nloc) {
            __builtin_amdgcn_fence(__ATOMIC_RELEASE, "agent");
            asm volatile("s_waitcnt vmcnt(0)" ::: "memory");
            const unsigned og = xb_add(&bar[XB_TOP], 1u);
            const unsigned tg = og / nx;
            if (og + 1u == (tg + 1u) * nx) xb_add(&bar[XB_TOPGEN], 1u);
            else XB_SPIN(xb_ld(&bar[XB_TOPGEN]) == tg, bar);
            __builtin_amdgcn_fence(__ATOMIC_ACQUIRE, "agent");
            xb_add(&bar[XB_XGEN(b.x)], 1u);
            asm volatile("s_waitcnt vmcnt(0)" ::: "memory");
        } else {
            XB_SPIN(xb_ld(&bar[XB_XGEN(b.x)]) == gen, bar);
            __builtin_amdgcn_fence(__ATOMIC_ACQUIRE, "agent");
            asm volatile("s_waitcnt vmcnt(0)" ::: "memory");
        }
    }
    __syncthreads();
}

#ifndef DBL_MASK
#define DBL_MASK 0
#endif
constexpr int NPHASE = 12;
__global__ void __launch_bounds__(512, 2) fwd_kernel(Args args) {
    extern __shared__ __attribute__((aligned(16))) unsigned char lds_raw[];
    LAS unsigned char* lds = (LAS unsigned char*)lds_raw;
    Frame F;
    F.tid = threadIdx.x; F.lane = F.tid & 63; F.wave = __builtin_amdgcn_readfirstlane(F.tid >> 6);
    F.G = gridDim.x; { const int bx = blockIdx.x; F.vcu = (F.G % 8 == 0) ? (bx % 8) * (F.G / 8) + bx / 8 : bx; }
    F.gw = F.vcu * 8 + F.wave; F.NGW = F.G * 8;
    unsigned char* ws = args.ws;
    const int lo = args.ph_lo, hi = args.ph_hi;
    volatile LAS unsigned* MISC = (volatile LAS unsigned*)(lds + LDS_BYTES - 64);
    if (F.tid < 16) MISC[F.tid] = 0u;
    __syncthreads();
    XcdBarrier bar = xcd_barrier_post((unsigned*)(ws + WS_CTL), MISC);
#define IN(k) (lo <= (k) && (k) < hi)
#define SEAM(k) do { if (IN(k) && IN((k) + 1)) xcd_barrier(bar); } while (0)

    if (IN(0)) for (int rep_ = 0; rep_ <= ((DBL_MASK >> 0) & 1); ++rep_) { if (rep_) xcd_barrier(bar); REFRESH_LANE(F); p0_prologue(F, args, lds); }
    SEAM(0);
    if (IN(1)) for (int rep_ = 0; rep_ <= ((DBL_MASK >> 1) & 1); ++rep_) { if (rep_) xcd_barrier(bar); REFRESH_LANE(F);
        { pg8::Gemm g{(const bf16*)(ws + WS_XN), (const bf16*)(ws + WS_WIN), MTOK, NZP, DM}; pg8::StaticOrder S; S.init(MTOK, NZP, F.G, (int)blockIdx.x);
          pg8::EpiZ E{(bf16*)(ws + WS_Z), (bf16*)(ws + WS_KSF), (bf16*)(ws + WS_VSF), (bf16*)(ws + WS_KWF), (bf16*)(ws + WS_VWF), (float*)(ws + WS_GATES), args.in[4]};
          pg8::gemm_phase<pg8::EpiZ, pg8::StaticOrder, true, true>(lds, g, S, E, F.wave); }
        { pg8::Gemm g{(const bf16*)(ws + WS_MEMN), (const bf16*)(ws + WS_WMK), NB * NMEM, DM, DM}; pg8::StaticOrder S; S.init(NB * NMEM, DM, F.G, ((int)blockIdx.x + 128) & 255);
          pg8::EpiStore E{(bf16*)(ws + WS_MEMK), DM, nullptr, 1};
          pg8::gemm_phase<pg8::EpiStore, pg8::StaticOrder, true, true>(lds, g, S, E, F.wave); }
        { pg8::Gemm g{(const bf16*)(ws + WS_WMV), (const bf16*)(ws + WS_MEMN), DM, NB * NMEM, DM}; pg8::StaticOrder S; S.init(DM, NB * NMEM, F.G, ((int)blockIdx.x + 120) & 255);
          pg8::EpiVFrag E{(bf16*)(ws + WS_MEMVT)};
          pg8::gemm_phase<pg8::EpiVFrag, pg8::StaticOrder, true, true>(lds, g, S, E, F.wave); }
    }
    SEAM(1);
    if (IN(2)) for (int rep_ = 0; rep_ <= ((DBL_MASK >> 2) & 1); ++rep_) { if (rep_) xcd_barrier(bar); REFRESH_LANE(F); for (int it = F.gw; it < 2048; it += F.NGW) kmax_item(F, args, it);
                 for (int it = F.vcu; it < 256; it += F.G) lru_local_item(F, args, lds, it);
                 for (int it = F.G - 1 - F.vcu; it < 128; it += F.G) compress_item(F, args, lds, it); }
    SEAM(2);
    if (IN(3)) for (int rep_ = 0; rep_ <= ((DBL_MASK >> 3) & 1); ++rep_) { if (rep_) xcd_barrier(bar); REFRESH_LANE(F);
                 { unsigned* ctl = (unsigned*)(ws + WS_CTL); const int own = (int)(((long)F.vcu * 8) / F.G) & 7; int qs = 0;
                   for (;;) { int id = -1;
                       if (lane_id() == 0) { while (qs < 8) { const int x = (own + qs) & 7; const unsigned c = __hip_atomic_fetch_add(ctl + CW_NQ + 64 * x, 1u, __ATOMIC_RELAXED, __HIP_MEMORY_SCOPE_AGENT);
                               if (c < 512u) { id = x * 512 + (int)c; break; } ++qs; } }
                       id = __builtin_amdgcn_readfirstlane(id); qs = __builtin_amdgcn_readfirstlane(qs);
                       if (id < 0) break;
                       if (F.G == 256) { quant_rows4_fp8(args.in[31] + (size_t)id * DM, (size_t)4096 * DM, nullptr, ws + WS_V8 + (size_t)id * 128, (float*)(ws + WS_SV) + id, 4096, lane_id());
 }
                       const int x = id >> 9, i = id & 511; nsa_item(F, args, lds, x >> 2, (x >> 1) & 1, 2 * (63 - (i >> 3)) + (x & 1), 7 - (i & 7)); } }
                 __syncthreads(); REFRESH_LANE(F);
                 for (int it = F.vcu; it < 256; it += F.G) lru_fix_item(F, args, lds, it, false); }
    SEAM(3);
    if (IN(4)) for (int rep_ = 0; rep_ <= ((DBL_MASK >> 4) & 1); ++rep_) { if (rep_) xcd_barrier(bar); REFRESH_LANE(F);
        pg8::Gemm g{(const bf16*)(ws + WS_Y), (const bf16*)(ws + WS_WOUT), MTOK, DM, DM}; pg8::StaticOrder S; S.init(MTOK, DM, F.G, (int)blockIdx.x);
        pg8::EpiRes<true> E{args.in[0], nullptr, nullptr, (bf16*)(ws + WS_XN), (float*)(ws + WS_SSQ1), (const float*)(ws + WS_SSQN)};
        pg8::gemm_phase<pg8::EpiRes<true>, pg8::StaticOrder, true, true>(lds, g, S, E, F.wave);
    }
    SEAM(4);
    if (IN(5)) for (int rep_ = 0; rep_ <= ((DBL_MASK >> 5) & 1); ++rep_) { if (rep_) xcd_barrier(bar); REFRESH_LANE(F);
        pg8::Gemm g{(const bf16*)(ws + WS_XN), (const bf16*)(ws + WS_WMQ), MTOK, DM, DM}; pg8::StaticOrder S; S.init(MTOK, DM, F.G, (int)blockIdx.x);
        pg8::EpiStore E{(bf16*)(ws + WS_QM), DM, (const float*)(ws + WS_SSQ1), 1};
        pg8::gemm_phase<pg8::EpiStore, pg8::StaticOrder, true, true>(lds, g, S, E, F.wave);
    }
    SEAM(5);
    if (IN(6)) for (int rep_ = 0; rep_ <= ((DBL_MASK >> 6) & 1); ++rep_) { if (rep_) xcd_barrier(bar); REFRESH_LANE(F); for (int it = F.gw; it < 2048; it += F.NGW) memattn_item(F, args, it); }
    SEAM(6);
    if (IN(7)) for (int rep_ = 0; rep_ <= ((DBL_MASK >> 7) & 1); ++rep_) { if (rep_) xcd_barrier(bar); REFRESH_LANE(F);
        pg8::Gemm g{(const bf16*)(ws + WS_OM), (const bf16*)(ws + WS_WMO), MTOK, DM, DM}; pg8::StaticOrder S; S.init(MTOK, DM, F.G, (int)blockIdx.x);
        pg8::EpiRes<false> E{nullptr, (const bf16*)(ws + WS_XN), nullptr, (bf16*)(ws + WS_XN), (float*)(ws + WS_SSQ2), nullptr};
        pg8::gemm_phase<pg8::EpiRes<false>, pg8::StaticOrder, true, true>(lds, g, S, E, F.wave);
    }
    SEAM(7);
    if (IN(8)) for (int rep_ = 0; rep_ <= ((DBL_MASK >> 8) & 1); ++rep_) { if (rep_) xcd_barrier(bar); REFRESH_LANE(F);
        pg8::Gemm g{(const bf16*)(ws + WS_XN), (const bf16*)(ws + WS_WPQ), MTOK, 2048, DM}; pg8::StaticOrder S; S.init(MTOK, 2048, F.G, (int)blockIdx.x);
        pg8::EpiStore E{(bf16*)(ws + WS_QP), 2048, (const float*)(ws + WS_SSQ2), 1};
        pg8::gemm_phase<pg8::EpiStore, pg8::StaticOrder, true, true>(lds, g, S, E, F.wave);
    }
    SEAM(8);
    if (IN(9)) for (int rep_ = 0; rep_ <= ((DBL_MASK >> 9) & 1); ++rep_) { if (rep_) xcd_barrier(bar); REFRESH_LANE(F); for (int gi = F.vcu; gi < 256; gi += F.G) {
                     const int h = gi & 7, tgp = gi >> 3;
                     { const v4u* src = (const v4u*)((const bf16*)(ws + WS_SKEY) + (size_t)h * 8 * 4096); const int tid = F.wave * 64 + lane_id();
#pragma unroll
                       for (int i = 0; i < 8; ++i) ((LAS v4u*)lds)[tid + 512 * i] = src[tid + 512 * i]; }
                     __syncthreads();
                     peer_topk_item<true>(F, args, (tgp * 16 + F.wave) * 8 + h, lds); peer_topk_item<true>(F, args, (tgp * 16 + 8 + F.wave) * 8 + h, lds);
                     __syncthreads(); } }
    SEAM(9);
    if (IN(10)) {   REFRESH_LANE(F);
        LAS int* bc = (LAS int*)(lds + LDS_BYTES - 128); unsigned* ctl = (unsigned*)(ws + WS_CTL); const int own = (int)(bar.x & 7u);
        { int qs = 0; int id = __builtin_amdgcn_readfirstlane(pq_pop(ctl, 0, own, qs, bc, F.wave)); int par = 0;
          while (id >= 0) { const unsigned tk_ = PQ_TICKET(0, own, qs); peer_u_chunk(F, args, lds, id / PQ_NCHUNK, id % PQ_NCHUNK); par ^= 2; id = __builtin_amdgcn_readfirstlane(pq_resolve(ctl, 0, own, qs, tk_, bc + par, F.wave)); } }
        xcd_barrier(bar);
        peer_w_rows(F, args);
        xcd_barrier(bar);
        { int qs = 0; int id = __builtin_amdgcn_readfirstlane(pq_pop(ctl, 1, own, qs, bc, F.wave)); int par = 0;
          while (id >= 0) { const unsigned tk_ = PQ_TICKET(1, own, qs); peer_v_chunk(F, args, lds, id / PQ_NCHUNK, id % PQ_NCHUNK); par ^= 2; id = __builtin_amdgcn_readfirstlane(pq_resolve(ctl, 1, own, qs, tk_, bc + par, F.wave)); } }
        xcd_barrier(bar);
        peer_final_rows(F, args);
    }
#undef IN
#undef SEAM
}

extern "C" void kernel_launch(void* const* d_in, const int* in_sizes, int n_in, void* d_out, int out_size, void* d_ws, size_t ws_size, hipStream_t stream) {
    static int grid = 0;
    if (grid == 0) {
        if (n_in != 33 || out_size != MTOK * DM || ws_size < WS_END) { fprintf(stderr, "kernel_launch: unexpected problem (n_in %d, out %d, ws %zu)\n", n_in, out_size, ws_size); grid = -1; return; }
        int dev = 0, cus = 0, per_cu = 0;
        (void)hipGetDevice(&dev); (void)hipDeviceGetAttribute(&cus, hipDeviceAttributeMultiprocessorCount, dev);
        (void)hipFuncSetAttribute((const void*)fwd_kernel, hipFuncAttributeMaxDynamicSharedMemorySize, LDS_BYTES);
        (void)hipOccupancyMaxActiveBlocksPerMultiprocessor(&per_cu, (const void*)fwd_kernel, 512, LDS_BYTES);
        if (per_cu < 1) { fprintf(stderr, "kernel_launch: occupancy query says %d blocks per CU\n", per_cu); per_cu = 1; }
        grid = cus * 1;
        if (grid != 256) fprintf(stderr, "kernel_launch: %d CUs (built for 256)\n", cus);
    }
    if (grid < 0) return;
    (void)hipMemsetAsync((char*)d_ws + WS_CTL, 0, 65536, stream);
    Args a{};
    for (int i = 0; i < 33; ++i) a.in[i] = (const float*)d_in[i];
    a.out = (float*)d_out; a.ws = (unsigned char*)d_ws; a.ph_lo = 0; a.ph_hi = NPHASE;
    void* kargs[] = {&a};
    hipError_t e = hipLaunchCooperativeKernel((const void*)fwd_kernel, dim3(grid), dim3(512), kargs, LDS_BYTES, stream);
    if (e != hipSuccess) fprintf(stderr, "cooperative launch failed: %s (grid %d)\n", hipGetErrorString(e), grid);
}
```

```cpp
#include <hip/hip_runtime.h>
#include <cstdio>
#include <cstdint>

namespace pg8 {
#define PG8_LAS __attribute__((address_space(3)))
typedef unsigned short bf16_t;
typedef short bf16x8 __attribute__((ext_vector_type(8)));
typedef float f32x4 __attribute__((ext_vector_type(4)));
typedef unsigned u32x4 __attribute__((ext_vector_type(4)));
constexpr int BM = 256, BK = 64, HALF = 128, HTB = HALF * BK * 2  , STAGE_BYTES = 8 * HTB, NXCD = 8, WGM = 8;

__host__ __device__ __forceinline__ int lds_byte(int r, int c) { const int st = (r >> 4) * 2 + (c >> 5), rr = r & 15, cc = c & 31, ob = rr * 64 + cc * 2; return st * 1024 + (ob ^ (((ob >> 9) & 1) << 5)); }
__host__ __device__ __forceinline__ void stage_rc(int b, int& R, int& C) { const int st = b / 1024, sb = b % 1024, swz = sb ^ (((sb >> 9) & 1) << 5); R = (st >> 1) * 16 + swz / 64; C = (st & 1) * 32 + (swz % 64) / 2; }
__host__ __device__ __forceinline__ int perm32(int rho) { const int n = rho >> 4, i = rho & 15; return 8 * (i >> 2) + 4 * n + (i & 3); }

struct Unit { int pm, pn; };
struct Gemm { const bf16_t* A; const bf16_t* Bt; int M, N, K; };

struct StaticOrder {
    int nM, nN, nwg, G, c;
    __host__ __device__ void init(int M, int N, int G_, int c_) { nM = M / BM; nN = N / BM; nwg = nM * nN; G = G_; c = c_; }
    __host__ __device__ bool next(int i, Unit& u) const {
        const long L = (long)i * G + c; if (L >= nwg) return false;
        int wgid = (int)L; { const int q = nwg / NXCD, r = nwg % NXCD, xcd = wgid % NXCD, off = wgid / NXCD; wgid = (xcd < r ? xcd * (q + 1) : r * (q + 1) + (xcd - r) * q) + off; }
        const int nig = WGM * nN, gid = wgid / nig, fm = gid * WGM, gsz = (nM - fm) < WGM ? (nM - fm) : WGM;
        u.pm = fm + ((wgid % nig) % gsz); u.pn = (wgid % nig) / gsz; return true;
    }
    __device__ __forceinline__ void a_ready(const Unit&) const {}
    __device__ __forceinline__ void done(const Unit&) const {}
};

__device__ __forceinline__ unsigned cvt_pk_bf16(float lo, float hi) { unsigned r; asm volatile("v_cvt_pk_bf16_f32 %0, %1, %2" : "=v"(r) : "v"(lo), "v"(hi)); return r; }
typedef float f32x2 __attribute__((ext_vector_type(2)));
typedef unsigned u32x2 __attribute__((ext_vector_type(2)));
__device__ __forceinline__ unsigned short f2bf1(float f) { unsigned u = __builtin_bit_cast(unsigned, f); return (unsigned short)((u + 0x7fffu + ((u >> 16) & 1u)) >> 16); }
struct EpiZ {
    static constexpr bool PERM = true, AFTER_DRAIN = false, MIDSCALE = false;
    bf16_t* Z; bf16_t* KSF; bf16_t* VSF; bf16_t* KWF; bf16_t* VWF; float* GATES; const float* bgate;
    __device__ __forceinline__ void operator()(const f32x4 (&acc)[2][2][4][2], const Unit& u, int wr, int wc, int fr, int fq) const {
        const int row0 = u.pm * BM + wr * 64 + fr;
        if (u.pn < 9) {
            const int col0 = u.pn * BM + wc * 32 + 8 * fq;
#pragma unroll
            for (int ai = 0; ai < 2; ++ai)
#pragma unroll
                for (int m = 0; m < 4; ++m) { bf16_t* rowp = Z + (size_t)(row0 + ai * HALF + m * 16) * 2304 + col0;
#pragma unroll
                    for (int bj = 0; bj < 2; ++bj) { const f32x4 v0 = acc[ai][bj][m][0], v1 = acc[ai][bj][m][1];
                        u32x4 w; w.x = cvt_pk_bf16(v0[0], v0[1]); w.y = cvt_pk_bf16(v0[2], v0[3]); w.z = cvt_pk_bf16(v1[0], v1[1]); w.w = cvt_pk_bf16(v1[2], v1[3]);
                        *(u32x4*)(rowp + bj * HALF) = w; } }
            if (u.pn >= 7) {
                bf16_t* KF = (u.pn == 7) ? KSF : KWF; bf16_t* VF = (u.pn == 7) ? VSF : VWF;
                const int kvh = wc >> 1, dbase = 32 * (wc & 1) + 8 * fq;
#pragma unroll
                for (int ai = 0; ai < 2; ++ai)
#pragma unroll
                    for (int m = 0; m < 4; ++m) { const int row = row0 + ai * HALF + m * 16, b = row >> 13, s = row & 8191, tile = s >> 5, k = s & 31;
                        const size_t tb = ((size_t)(b * 2 + kvh) * 256 + tile) * 2048;
                        { const f32x4 v0 = acc[ai][0][m][0], v1 = acc[ai][0][m][1];
                          u32x4 w; w.x = cvt_pk_bf16(v0[0], v0[1]); w.y = cvt_pk_bf16(v0[2], v0[3]); w.z = cvt_pk_bf16(v1[0], v1[1]); w.w = cvt_pk_bf16(v1[2], v1[3]);
                          *(u32x4*)(KF + tb + (dbase >> 4) * 512 + ((dbase >> 3) & 1) * 256 + k * 8) = w; }
                        const int kk = k & 15, vo = ((kk >> 2) & 1) * 512 + (k >> 4) * 8 + (kk & 3) + 4 * (kk >> 3);
                        unsigned char* V8 = (unsigned char*)VF + ((size_t)(b * 2 + kvh) * 256 + tile) * 2048;
#pragma unroll
                        for (int n = 0; n < 2; ++n) { const f32x4 v = acc[ai][1][m][n]; int w = 0; w = __builtin_amdgcn_cvt_pk_fp8_f32(v[0], v[1], w, false); w = __builtin_amdgcn_cvt_pk_fp8_f32(v[2], v[3], w, true);
#pragma unroll
                            for (int e = 0; e < 4; ++e) { const int d = dbase + 4 * n + e; V8[(d >> 5) * 1024 + (d & 31) * 16 + vo] = (unsigned char)((unsigned)w >> (8 * e)); } }
                        asm volatile("" ::: "memory"); }
            }
        } else {
            if (wc == 0 && fq < 3) {
#pragma unroll
                for (int ai = 0; ai < 2; ++ai)
#pragma unroll
                    for (int m = 0; m < 4; ++m) { const int row = row0 + ai * HALF + m * 16;
#pragma unroll
                        for (int n = 0; n < 2; ++n)
#pragma unroll
                            for (int e = 0; e < 4; ++e) { const int c = 8 * fq + 4 * n + e; const float v = acc[ai][0][m][n][e] + bgate[c]; GATES[(size_t)row * 24 + c] = 1.0f / (1.0f + __expf(-v)); } }
            }
        }
    }
};
struct EpiStore {
    static constexpr bool PERM = true, AFTER_DRAIN = false, MIDSCALE = false;
    bf16_t* O; int ldc; const float* ssq; int frag;
    __device__ __forceinline__ void operator()(const f32x4 (&acc)[2][2][4][2], const Unit& u, int wr, int wc, int fr, int fq) const {
        const int row0 = u.pm * BM + wr * 64 + fr; const int col0 = u.pn * BM + wc * 32 + 8 * fq;
#pragma unroll
        for (int ai = 0; ai < 2; ++ai)
#pragma unroll
            for (int m = 0; m < 4; ++m) { const int row = row0 + ai * HALF + m * 16;
                bf16_t* rowp = frag ? O + (size_t)(row >> 5) * 32 * ldc + (size_t)(col0 >> 4) * 512 + ((col0 >> 3) & 1) * 256 + (row & 31) * 8 : O + (size_t)row * ldc + col0;
                const int bjstep = frag ? (HALF >> 4) * 512 : HALF;
                float sc = 1.f;
                if (ssq) { const f32x4* p = (const f32x4*)(ssq + (size_t)row * 16); const f32x4 a = p[0], b = p[1], c = p[2], d = p[3];
                    const float s = ((a[0] + a[1]) + (a[2] + a[3])) + ((b[0] + b[1]) + (b[2] + b[3])) + ((c[0] + c[1]) + (c[2] + c[3])) + ((d[0] + d[1]) + (d[2] + d[3]));
                    sc = rsqrtf(s * (1.0f / 1024.0f) + 1e-6f); }
#pragma unroll
                for (int bj = 0; bj < 2; ++bj) { const f32x4 v0 = acc[ai][bj][m][0] * sc, v1 = acc[ai][bj][m][1] * sc;
                    u32x4 w; w.x = cvt_pk_bf16(v0[0], v0[1]); w.y = cvt_pk_bf16(v0[2], v0[3]); w.z = cvt_pk_bf16(v1[0], v1[1]); w.w = cvt_pk_bf16(v1[2], v1[3]);
                    *(u32x4*)(rowp + bj * bjstep) = w; } }
    }
};
struct EpiVFrag {
    static constexpr bool PERM = true, AFTER_DRAIN = false, MIDSCALE = false;
    bf16_t* O;
    __device__ __forceinline__ void operator()(const f32x4 (&acc)[2][2][4][2], const Unit& u, int wr, int wc, int fr, int fq) const {
        const int row0 = u.pm * BM + wr * 64 + fr; const int col0 = u.pn * BM + wc * 32 + 8 * fq;
#pragma unroll
        for (int ai = 0; ai < 2; ++ai)
#pragma unroll
            for (int m = 0; m < 4; ++m) { const int D = row0 + ai * HALF + m * 16, h = D >> 8, dt = (D >> 5) & 7, r = D & 31;
#pragma unroll
                for (int bj = 0; bj < 2; ++bj) { const int K0 = col0 + bj * HALF, b = K0 >> 8, kt = (K0 >> 5) & 7, k0 = K0 & 31;
                    bf16_t* p = O + (size_t)((b * 4 + h) * 8 + kt) * 8192 + dt * 1024 + (k0 >> 4) * 512 + r * 8 + 4 * ((k0 >> 3) & 1);
                    const f32x4 v0 = acc[ai][bj][m][0], v1 = acc[ai][bj][m][1];
                    u32x2 w0, w1; w0.x = cvt_pk_bf16(v0[0], v0[1]); w0.y = cvt_pk_bf16(v0[2], v0[3]); w1.x = cvt_pk_bf16(v1[0], v1[1]); w1.y = cvt_pk_bf16(v1[2], v1[3]);
                    *(u32x2*)p = w0; *(u32x2*)(p + 256) = w1; } }
    }
};
template <bool MID> struct EpiRes {
    static constexpr bool PERM = false, AFTER_DRAIN = false, MIDSCALE = MID;
    const float* base; const bf16_t* base16; float* out; bf16_t* XB; float* ssq; const float* ssqn;
    __device__ __forceinline__ void midscale(f32x4 (&acc)[2][2][4][2], const Unit& u, int wr, int wc, int fr, int fq) const {
        const int row0 = u.pm * BM + wr * 64 + fr;
#pragma unroll
        for (int ai = 0; ai < 2; ++ai)
#pragma unroll
            for (int m = 0; m < 4; ++m) { const int row = row0 + ai * HALF + m * 16; const f32x2 sq = *(const f32x2*)(ssqn + (size_t)row * 2);
                const float sc = rsqrtf((sq[0] + sq[1]) * (1.0f / 512.0f) + 1e-6f);
#pragma unroll
                for (int bj = 0; bj < 2; ++bj)
#pragma unroll
                    for (int n = 0; n < 2; ++n) acc[ai][bj][m][n] = acc[ai][bj][m][n] * sc; }
    }
    __device__ __forceinline__ void operator()(const f32x4 (&acc)[2][2][4][2], const Unit& u, int wr, int wc, int fr, int fq) const {
        const int row0 = u.pm * BM + wr * 64 + fr; const int col0 = u.pn * BM + wc * 32 + 4 * fq;
#pragma unroll
        for (int ai = 0; ai < 2; ++ai)
#pragma unroll
            for (int m = 0; m < 4; ++m) { const int row = row0 + ai * HALF + m * 16; const size_t off = (size_t)row * 1024 + col0; float s = 0.f;
#pragma unroll
                for (int bj = 0; bj < 2; ++bj)
#pragma unroll
                    for (int n = 0; n < 2; ++n) { f32x4 b;
                        if (base) b = *(const f32x4*)(base + off + bj * HALF + n * 16);
                        else { const u32x2 w = *(const u32x2*)(base16 + off + bj * HALF + n * 16); b[0] = __builtin_bit_cast(float, w.x << 16); b[1] = __builtin_bit_cast(float, w.x & 0xffff0000u); b[2] = __builtin_bit_cast(float, w.y << 16); b[3] = __builtin_bit_cast(float, w.y & 0xffff0000u); }
                        const f32x4 v = b + acc[ai][bj][m][n];
                        if (out) *(f32x4*)(out + off + bj * HALF + n * 16) = v;
                        s += (v[0] * v[0] + v[1] * v[1]) + (v[2] * v[2] + v[3] * v[3]);
                        u32x2 w; w.x = cvt_pk_bf16(v[0], v[1]); w.y = cvt_pk_bf16(v[2], v[3]); *(u32x2*)(XB + off + bj * HALF + n * 16) = w; }
                s += __shfl_xor(s, 16); s += __shfl_xor(s, 32);
                if (fq == 0) ssq[(size_t)row * 16 + u.pn * 4 + wc] = s;
                asm volatile("" ::: "memory"); }
    }
};
template <class Epi, class Sched, bool ALIGN_EPI = false, bool SP2 = false>
__device__ __forceinline__ void gemm_phase(PG8_LAS unsigned char* lds, const Gemm g, const Sched& S, const Epi& E, int wave  ) {
    int lane; asm volatile("v_mbcnt_lo_u32_b32 %0, -1, 0\n\tv_mbcnt_hi_u32_b32 %0, -1, %0" : "=v"(lane));
    const int wid = wave, tid = wid * 64 + lane, wr = wid >> 2, wc = wid & 3, fr = lane & 15, fq = lane >> 4;
    const int K = g.K, nt = K / BK;
    unsigned voffA[2], voffB[2];
#pragma unroll
    for (int i = 0; i < 2; ++i) { int R, C; stage_rc(tid * 16 + i * 8192, R, C); const int Rb = Epi::PERM ? ((R & ~31) + perm32(R & 31)) : R;
        voffA[i] = (unsigned)(R * K + C) * 2u; voffB[i] = (unsigned)(Rb * K + C) * 2u; }
    const size_t kstep = (size_t)(BK * 2);
    const size_t hstep = (size_t)HALF * K * 2;
    const size_t tstep = 2 * hstep;
    const unsigned ldsw = (unsigned)wid * 1024u;
    const int aoff = lds_byte(wr * 64 + fr, fq * 8), boff = lds_byte(wc * 32 + fr, fq * 8);
#define PG8_SA(b, h) (((b) * 2 + (h)) * HTB)
#define PG8_SB(b, h) ((4 + (b) * 2 + (h)) * HTB)
#define PG8_STAGE(bufoff, gbase, voff) do { _Pragma("unroll") for (int _i = 0; _i < 2; ++_i) \
        __builtin_amdgcn_global_load_lds((const unsigned*)((const char*)(gbase) + (voff)[_i]), (PG8_LAS unsigned*)(lds + (bufoff) + ldsw + _i * 8192), 16, 0, 0); } while (0)
#define PG8_LDA(dst, b, h) do { _Pragma("unroll") for (int m = 0; m < 4; ++m) _Pragma("unroll") for (int k = 0; k < 2; ++k) dst[m][k] = *(const PG8_LAS bf16x8*)(lds + PG8_SA(b, h) + aoff + m * 2048 + k * 1024); } while (0)
#define PG8_LDB(dst, b, h) do { _Pragma("unroll") for (int n = 0; n < 2; ++n) _Pragma("unroll") for (int k = 0; k < 2; ++k) dst[n][k] = *(const PG8_LAS bf16x8*)(lds + PG8_SB(b, h) + boff + n * 2048 + k * 1024); } while (0)
#define PG8_MMA(ai, bj, At, Bt) do { __builtin_amdgcn_s_setprio(1); _Pragma("unroll") for (int m = 0; m < 4; ++m) _Pragma("unroll") for (int n = 0; n < 2; ++n) _Pragma("unroll") for (int k = 0; k < 2; ++k) \
        acc[ai][bj][m][n] = __builtin_amdgcn_mfma_f32_16x16x32_bf16(Bt[n][k], At[m][k], acc[ai][bj][m][n], 0, 0, 0); __builtin_amdgcn_s_setprio(0); } while (0)
#define PG8_WAIT_V(n) asm volatile("s_waitcnt vmcnt(" #n ")" ::: "memory")
#define PG8_WAIT_L(n) asm volatile("s_waitcnt lgkmcnt(" #n ")" ::: "memory")
#define PG8_BAR __builtin_amdgcn_s_barrier()
#define PG8_SCHED __builtin_amdgcn_sched_barrier(0)
    Unit cur, nxt; int ui = 0;
    if (!S.next(0, cur)) return;
    f32x4 acc[2][2][4][2];
#pragma unroll
    for (int a = 0; a < 2; ++a)
#pragma unroll
        for (int b = 0; b < 2; ++b)
#pragma unroll
            for (int m = 0; m < 4; ++m)
#pragma unroll
                for (int n = 0; n < 2; ++n) acc[a][b][m][n] = (f32x4){0.f, 0.f, 0.f, 0.f};
    bf16x8 At[4][2], B0[2][2], B1[2][2];
    const char* cA = (const char*)g.A + (size_t)cur.pm * tstep; const char* cB = (const char*)g.Bt + (size_t)cur.pn * tstep;
    S.a_ready(cur);
    if constexpr (SP2) {
        PG8_STAGE(PG8_SB(0, 0), cB, voffB); PG8_STAGE(PG8_SB(0, 1), cB + hstep, voffB); PG8_STAGE(PG8_SA(0, 0), cA, voffA); PG8_STAGE(PG8_SA(0, 1), cA + hstep, voffA);
        if (wr == 1) PG8_BAR;
        PG8_WAIT_V(2); PG8_BAR;
        PG8_STAGE(PG8_SB(1, 0), cB + kstep, voffB); PG8_STAGE(PG8_SA(1, 0), cA + kstep, voffA); PG8_STAGE(PG8_SB(1, 1), cB + hstep + kstep, voffB);
        PG8_WAIT_V(6); PG8_BAR;
    } else {
        PG8_STAGE(PG8_SB(0, 0), cB, voffB); PG8_STAGE(PG8_SA(0, 0), cA, voffA); PG8_STAGE(PG8_SB(0, 1), cB + hstep, voffB); PG8_STAGE(PG8_SA(0, 1), cA + hstep, voffA);
        if (wr == 1) PG8_BAR;
        PG8_WAIT_V(4); PG8_BAR;
        PG8_STAGE(PG8_SB(1, 0), cB + kstep, voffB); PG8_STAGE(PG8_SA(1, 0), cA + kstep, voffA); PG8_STAGE(PG8_SB(1, 1), cB + hstep + kstep, voffB);
        PG8_WAIT_V(6); PG8_BAR;
    }
    for (;;) {
        const bool has_next = S.next(ui + 1, nxt);
        const char* nA = has_next ? (const char*)g.A + (size_t)nxt.pm * tstep : cA; const char* nB = has_next ? (const char*)g.Bt + (size_t)nxt.pn * tstep : cB;
        for (int t = 0; t < nt; t += 2) {
            if constexpr (Epi::MIDSCALE) { if (t == nt / 2) E.midscale(acc, cur, wr, wc, fr, fq); }
            const bool last = (t == nt - 2);
            const char* a1 = cA + (size_t)(t + 1) * kstep;
            const char* a2 = last ? nA : cA + (size_t)(t + 2) * kstep; const char* b2 = last ? nB : cB + (size_t)(t + 2) * kstep;
            const char* a3 = a2 + kstep; const char* b3 = b2 + kstep;
            if (last && has_next) S.a_ready(nxt);
            if constexpr (SP2) {
            PG8_LDB(B0, 0, 0); PG8_LDB(B1, 0, 1); PG8_SCHED; PG8_LDA(At, 0, 0); PG8_STAGE(PG8_SA(1, 1), a1 + hstep, voffA);
            PG8_WAIT_V(8); PG8_WAIT_L(0); PG8_BAR; PG8_MMA(0, 0, At, B0); PG8_MMA(0, 1, At, B1); PG8_BAR; PG8_SCHED;
            PG8_LDA(At, 0, 1); PG8_STAGE(PG8_SB(0, 0), b2, voffB); PG8_STAGE(PG8_SB(0, 1), b2 + hstep, voffB); PG8_STAGE(PG8_SA(0, 0), a2, voffA);
            PG8_WAIT_V(8); PG8_WAIT_L(0); PG8_BAR; PG8_MMA(1, 0, At, B0); PG8_MMA(1, 1, At, B1); PG8_BAR; PG8_SCHED;
            PG8_LDB(B0, 1, 0); PG8_LDB(B1, 1, 1); PG8_SCHED; PG8_LDA(At, 1, 0); PG8_STAGE(PG8_SA(0, 1), a2 + hstep, voffA);
            PG8_WAIT_V(8); PG8_WAIT_L(0); PG8_BAR; PG8_MMA(0, 0, At, B0); PG8_MMA(0, 1, At, B1); PG8_BAR; PG8_SCHED;
            PG8_LDA(At, 1, 1); PG8_STAGE(PG8_SB(1, 0), b3, voffB); PG8_STAGE(PG8_SB(1, 1), b3 + hstep, voffB); PG8_STAGE(PG8_SA(1, 0), a3, voffA);
            PG8_WAIT_V(8); PG8_WAIT_L(0); PG8_BAR; PG8_MMA(1, 0, At, B0); PG8_MMA(1, 1, At, B1); PG8_BAR; PG8_SCHED;
            } else {
            PG8_LDB(B0, 0, 0); PG8_SCHED; PG8_LDA(At, 0, 0); PG8_STAGE(PG8_SA(1, 1), a1 + hstep, voffA);
            PG8_WAIT_L(8); PG8_BAR; PG8_WAIT_L(0); PG8_MMA(0, 0, At, B0); PG8_BAR; PG8_SCHED;
            PG8_LDB(B1, 0, 1); PG8_STAGE(PG8_SB(0, 0), b2, voffB);
            PG8_BAR; PG8_WAIT_L(0); PG8_MMA(0, 1, At, B1); PG8_BAR;
            PG8_LDA(At, 0, 1); PG8_STAGE(PG8_SA(0, 0), a2, voffA);
            PG8_BAR; PG8_WAIT_L(0); PG8_MMA(1, 0, At, B0); PG8_BAR; PG8_SCHED;
            PG8_STAGE(PG8_SB(0, 1), b2 + hstep, voffB);
            PG8_WAIT_V(6); PG8_BAR; PG8_MMA(1, 1, At, B1); PG8_BAR;
            PG8_LDB(B0, 1, 0); PG8_SCHED; PG8_LDA(At, 1, 0); PG8_STAGE(PG8_SA(0, 1), a2 + hstep, voffA);
            PG8_WAIT_L(8); PG8_BAR; PG8_WAIT_L(0); PG8_MMA(0, 0, At, B0); PG8_BAR; PG8_SCHED;
            PG8_LDB(B1, 1, 1); PG8_STAGE(PG8_SB(1, 0), b3, voffB);
            PG8_BAR; PG8_WAIT_L(0); PG8_MMA(0, 1, At, B1); PG8_BAR;
            PG8_LDA(At, 1, 1); PG8_STAGE(PG8_SA(1, 0), a3, voffA);
            PG8_BAR; PG8_WAIT_L(0); PG8_MMA(1, 0, At, B0); PG8_BAR; PG8_SCHED;
            PG8_STAGE(PG8_SB(1, 1), b3 + hstep, voffB);
            PG8_WAIT_V(6); PG8_BAR; PG8_MMA(1, 1, At, B1); PG8_BAR;
            }
        }
        if constexpr (ALIGN_EPI) { if (wr == 0) PG8_BAR; }
        if constexpr (!Epi::AFTER_DRAIN) { E(acc, cur, wr, wc, fr, fq); S.done(cur); }
        if (!has_next) break;
#pragma unroll
        for (int a = 0; a < 2; ++a)
#pragma unroll
            for (int b = 0; b < 2; ++b)
#pragma unroll
                for (int m = 0; m < 4; ++m)
#pragma unroll
                    for (int n = 0; n < 2; ++n) acc[a][b][m][n] = (f32x4){0.f, 0.f, 0.f, 0.f};
        cur = nxt; cA = nA; cB = nB; ++ui;
        if constexpr (ALIGN_EPI) { if (wr == 1) PG8_BAR; }
    }
    PG8_WAIT_V(0);
    if constexpr (!ALIGN_EPI) { if (wr == 0) PG8_BAR; }
    PG8_BAR;
    if constexpr (Epi::AFTER_DRAIN) { E.fused(acc, cur, wr, wc, fr, fq, lds, wid, lane); S.done(cur); }
#undef PG8_SA
#undef PG8_SB
#undef PG8_STAGE
#undef PG8_LDA
#undef PG8_LDB
#undef PG8_MMA
#undef PG8_WAIT_V
#undef PG8_WAIT_L
#undef PG8_BAR
#undef PG8_SCHED
}
}

constexpr int NB = 2, SEQ = 8192, DM = 1024, MTOK = NB * SEQ;
constexpr int NZ = 2304, NZP = 2560;
constexpr int NMEM = 256;
constexpr float EPS = 1e-6f;
constexpr float QSCALE = 0.125f * 1.4426950408889634f;
constexpr int ZC_XL = 0, ZC_GT = 512, ZC_Q = 1024, ZC_KC = 1536, ZC_VC = 1664, ZC_KS = 1792, ZC_VS = 1920, ZC_KW = 2048, ZC_VW = 2176, ZC_G = 2304;

constexpr size_t MiB = 1u << 20;
constexpr size_t WS_CTL = 0;
constexpr size_t WS_WIN = 1 * MiB, WS_WOUT = 6 * MiB, WS_WMQ = 8 * MiB, WS_WMK = 10 * MiB, WS_WMV = 12 * MiB, WS_WMO = 14 * MiB, WS_WPQ = 16 * MiB;
constexpr size_t WS_SKEY = 20 * MiB;
constexpr size_t WS_CW1T = WS_SKEY + 512 * 1024;
constexpr size_t WS_CW2T = WS_CW1T + 512 * 1024;
constexpr size_t WS_C1 = WS_CW2T + 16 * 1024;
constexpr size_t WS_WRGT = WS_C1 + 16 * 1024;
constexpr size_t WS_MEMN = 22 * MiB, WS_MEMK = 23 * MiB, WS_MEMVT = 24 * MiB;
constexpr size_t WS_KC = 26 * MiB;
constexpr size_t WS_VCT = WS_KC + 256 * 1024;
constexpr size_t WS_SUMM = 27 * MiB;
constexpr size_t WS_SSQ1 = 28 * MiB, WS_SSQ2 = 29 * MiB;
constexpr size_t WS_GATES = 30 * MiB;
constexpr size_t WS_SSQN = 31 * MiB + 512 * 1024;
constexpr size_t WS_U8 = 32 * MiB, WS_V8 = 48 * MiB;
constexpr size_t WS_SU = 64 * MiB, WS_SV = 64 * MiB + 65536;
constexpr size_t WS_SSQ3 = 65 * MiB;
constexpr size_t WS_W = 66 * MiB;
constexpr size_t WS_PART = 128 * MiB;
constexpr size_t WS_XN = 96 * MiB;
constexpr size_t WS_Z = 128 * MiB;
constexpr size_t WS_KSF = 240 * MiB, WS_VSF = 244 * MiB, WS_KWF = 248 * MiB, WS_VWF = 252 * MiB;
constexpr size_t WS_QM = 128 * MiB, WS_OM = 160 * MiB;
constexpr size_t WS_QP = 128 * MiB;
constexpr size_t WS_Y = 208 * MiB;
constexpr size_t WS_EID = 208 * MiB, WS_GW = 216 * MiB;
constexpr size_t WS_END = 256 * MiB;

constexpr int CW_KMAX = 12288;
constexpr int LDS_BYTES = 147456;

#define GAS __attribute__((address_space(1)))
#define LAS __attribute__((address_space(3)))
typedef unsigned short bf16;
typedef unsigned v4u __attribute__((ext_vector_type(4)));
typedef unsigned v2u __attribute__((ext_vector_type(2)));
typedef float f32x4 __attribute__((ext_vector_type(4)));
typedef float f32x16 __attribute__((ext_vector_type(16)));
typedef short bf16x8 __attribute__((ext_vector_type(8)));
typedef short bf16x4 __attribute__((ext_vector_type(4)));
__device__ __forceinline__ unsigned f2bf(float f) { unsigned u = __builtin_bit_cast(unsigned, f); return (u + 0x7fffu + ((u >> 16) & 1u)) >> 16; }
typedef float f32x2_ __attribute__((ext_vector_type(2))); typedef __bf16 bf16x2_ __attribute__((ext_vector_type(2)));
__device__ __forceinline__ unsigned pk2(float lo, float hi) { f32x2_ v = {lo, hi}; bf16x2_ b = __builtin_convertvector(v, bf16x2_); return __builtin_bit_cast(unsigned, b); }
__device__ __forceinline__ float bf2f(unsigned short h) { return __builtin_bit_cast(float, (unsigned)h << 16); }
__device__ __forceinline__ float bflo(unsigned w) { return __builtin_bit_cast(float, w << 16); }
__device__ __forceinline__ float bfhi(unsigned w) { return __builtin_bit_cast(float, w & 0xffff0000u); }
__device__ __forceinline__ void swap32(unsigned& a, unsigned& b) { asm("s_nop 1\n\tv_permlane32_swap_b32 %0, %1" : "+v"(a), "+v"(b)); }
__device__ __forceinline__ int maxswap32_i(int v) { unsigned a = (unsigned)v, b = (unsigned)v; swap32(a, b); return max((int)a, (int)b); }
__device__ __forceinline__ float maxswap32_f(float v) { unsigned a = __builtin_bit_cast(unsigned, v), b = a; swap32(a, b); return fmaxf(__builtin_bit_cast(float, a), __builtin_bit_cast(float, b)); }
__device__ __forceinline__ float addswap32_f(float v) { unsigned a = __builtin_bit_cast(unsigned, v), b = a; swap32(a, b); return __builtin_bit_cast(float, a) + __builtin_bit_cast(float, b); }
__device__ __forceinline__ float wave_sum(float v) {
#pragma unroll
    for (int o = 1; o < 64; o <<= 1) v += __shfl_xor(v, o);
    return v;
}

struct Args { const float* in[33]; float* out; unsigned char* ws; int ph_lo, ph_hi; };

struct Frame {
    int tid, lane, wave, vcu, G, gw, NGW;
};
__device__ __forceinline__ int lane_id() { int l; asm volatile("v_mbcnt_lo_u32_b32 %0, -1, 0\n\tv_mbcnt_hi_u32_b32 %0, -1, %0" : "=v"(l)); return l; }
#define REFRESH_LANE(F) do { (F).lane = lane_id(); (F).tid = (F).wave * 64 + (F).lane; } while (0)

__device__ __forceinline__ void transpose_item(const float* W, int K, int N, bf16* WT, int ldt, int row_off, const float* gain, int slo, int shi, float cs, LAS float* scr, int item, int lane, int kxor = 0) {
    const int nblk = (N + 31) / 32, kb = item / nblk, nb = item % nblk, k0 = 64 * kb, n0 = 32 * nb;
#pragma unroll 16
    for (int i = 0; i < 32; ++i) { const int kk = 2 * i + (lane >> 5), n = n0 + (lane & 31);
        float v = (n < N) ? __builtin_nontemporal_load(W + (size_t)(k0 + kk) * N + n) : 0.f; if (gain) v *= gain[k0 + kk]; if (n >= slo && n < shi) v *= cs;
        scr[kk * 33 + (lane & 31)] = v; }
    asm volatile("s_waitcnt lgkmcnt(0)" ::: "memory");
    const int c = lane & 7;
#pragma unroll
    for (int j = 0; j < 4; ++j) { const int n = (lane >> 3) + 8 * j; const LAS float* s = scr + (8 * c) * 33 + n;
        v4u o; o.x = pk2(s[0 * 33], s[1 * 33]); o.y = pk2(s[2 * 33], s[3 * 33]); o.z = pk2(s[4 * 33], s[5 * 33]); o.w = pk2(s[6 * 33], s[7 * 33]);
        *(v4u*)(WT + (size_t)(row_off + n0 + n) * ldt + (k0 ^ kxor) + 8 * c) = o; }
    asm volatile("s_waitcnt lgkmcnt(0)" ::: "memory");
}
__device__ __forceinline__ void rms_row_to_bf16(const float* xrow, bf16* orow, int lane) {
    const f32x4* xr = (const f32x4*)xrow + lane;
    f32x4 v[4]; float s = 0.f;
#pragma unroll
    for (int j = 0; j < 4; ++j) { v[j] = xr[64 * j]; s += (v[j].x * v[j].x + v[j].y * v[j].y) + (v[j].z * v[j].z + v[j].w * v[j].w); }
    const float rstd = rsqrtf(wave_sum(s) * (1.f / DM) + EPS);
    unsigned long long* o8 = (unsigned long long*)orow + lane;
#pragma unroll
    for (int j = 0; j < 4; ++j) o8[64 * j] = (unsigned long long)pk2(v[j].x * rstd, v[j].y * rstd) | ((unsigned long long)pk2(v[j].z * rstd, v[j].w * rstd) << 32);
}
__device__ __forceinline__ void quant_row_fp8(const float* src, const float* gain, unsigned char* dst, float* scale_out, int lane) {
    const f32x4* p = (const f32x4*)src + 4 * lane; f32x4 v[4]; float am = 0.f;
#pragma unroll
    for (int j = 0; j < 4; ++j) { v[j] = p[j]; if (gain) v[j] = v[j] * ((const f32x4*)gain)[4 * lane + j]; am = fmaxf(am, fmaxf(fmaxf(fabsf(v[j].x), fabsf(v[j].y)), fmaxf(fabsf(v[j].z), fabsf(v[j].w)))); }
#pragma unroll
    for (int o = 1; o < 64; o <<= 1) am = fmaxf(am, __shfl_xor(am, o));
    const float inv = am > 0.f ? 448.0f / am : 0.f;
    v4u o4;
#pragma unroll
    for (int j = 0; j < 4; ++j) { int w = 0; w = __builtin_amdgcn_cvt_pk_fp8_f32(v[j].x * inv, v[j].y * inv, w, false); w = __builtin_amdgcn_cvt_pk_fp8_f32(v[j].z * inv, v[j].w * inv, w, true); o4[j] = (unsigned)w; }
    *(v4u*)(dst + (size_t)(lane >> 3) * 16384 * 128 + (lane & 7) * 16) = o4;
    if (lane == 0) *scale_out = am * (1.0f / 448.0f);
}
__device__ __forceinline__ void rms_rows4_to_bf16(const float* x0, bf16* o0, size_t rstride  , int lane) {
    f32x4 v[4][4]; float s[4];
#pragma unroll
    for (int r = 0; r < 4; ++r)
#pragma unroll
        for (int j = 0; j < 4; ++j) v[r][j] = __builtin_nontemporal_load((const f32x4*)(x0 + r * rstride) + lane + 64 * j);
#pragma unroll
    for (int r = 0; r < 4; ++r) { s[r] = 0.f;
#pragma unroll
        for (int j = 0; j < 4; ++j) s[r] += (v[r][j].x * v[r][j].x + v[r][j].y * v[r][j].y) + (v[r][j].z * v[r][j].z + v[r][j].w * v[r][j].w); }
#pragma unroll
    for (int o = 1; o < 64; o <<= 1)
#pragma unroll
        for (int r = 0; r < 4; ++r) s[r] += __shfl_xor(s[r], o);
#pragma unroll
    for (int r = 0; r < 4; ++r) { const float rstd = rsqrtf(s[r] * (1.f / DM) + EPS); unsigned long long* o8 = (unsigned long long*)(o0 + r * rstride) + lane;
#pragma unroll
        for (int j = 0; j < 4; ++j) o8[64 * j] = (unsigned long long)pk2(v[r][j].x * rstd, v[r][j].y * rstd) | ((unsigned long long)pk2(v[r][j].z * rstd, v[r][j].w * rstd) << 32); }
}
__device__ __forceinline__ void quant_rows4_fp8(const float* src0, size_t rstride, const float* gain, unsigned char* dst0, float* scale0, int sstride, int lane) {
    f32x4 v[4][4]; float am[4];
#pragma unroll
    for (int r = 0; r < 4; ++r)
#pragma unroll
        for (int j = 0; j < 4; ++j) v[r][j] = __builtin_nontemporal_load((const f32x4*)(src0 + r * rstride) + 4 * lane + j);
    if (gain) {
#pragma unroll
        for (int j = 0; j < 4; ++j) { const f32x4 g = ((const f32x4*)gain)[4 * lane + j];
#pragma unroll
            for (int r = 0; r < 4; ++r) v[r][j] = v[r][j] * g; } }
#pragma unroll
    for (int r = 0; r < 4; ++r) { am[r] = 0.f;
#pragma unroll
        for (int j = 0; j < 4; ++j) am[r] = fmaxf(am[r], fmaxf(fmaxf(fabsf(v[r][j].x), fabsf(v[r][j].y)), fmaxf(fabsf(v[r][j].z), fabsf(v[r][j].w)))); }
#pragma unroll
    for (int o = 1; o < 64; o <<= 1)
#pragma unroll
        for (int r = 0; r < 4; ++r) am[r] = fmaxf(am[r], __shfl_xor(am[r], o));
#pragma unroll
    for (int r = 0; r < 4; ++r) { const float inv = am[r] > 0.f ? 448.0f / am[r] : 0.f; v4u o4;
#pragma unroll
        for (int j = 0; j < 4; ++j) { int w = 0; w = __builtin_amdgcn_cvt_pk_fp8_f32(v[r][j].x * inv, v[r][j].y * inv, w, false); w = __builtin_amdgcn_cvt_pk_fp8_f32(v[r][j].z * inv, v[r][j].w * inv, w, true); o4[j] = (unsigned)w; }
        __builtin_nontemporal_store(o4, (v4u*)(dst0 + (size_t)r * sstride * 128 + (size_t)(lane >> 3) * 16384 * 128 + (lane & 7) * 16));
        if (lane == 0) scale0[r * sstride] = am[r] * (1.0f / 448.0f); }
}
__device__ __forceinline__ void p0_prologue(const Frame& F, const Args& A, LAS unsigned char* lds) {
    unsigned char* ws = A.ws;
    LAS float* scr = (LAS float*)(lds + F.wave * 16384);
    const float* const* in = A.in;
    const int gw = F.gw, NGW = F.NGW;
    constexpr int I_IN = 16 * 73, I_SQ = 16 * 32, I_PQ = 16 * 64, I_C1 = 64, I_C2 = 2, I_RG = 2;
    constexpr int E_IN = I_IN, E_OUT = E_IN + I_SQ, E_MQ = E_OUT + I_SQ, E_MK = E_MQ + I_SQ, E_MV = E_MK + I_SQ, E_MO = E_MV + I_SQ, E_PQ = E_MO + I_PQ, E_C1 = E_PQ + 2 * I_C1, E_C2 = E_C1 + 2 * I_C2, E_RG = E_C2 + 16 * I_RG;
    for (int it = gw; it < E_RG; it += NGW) {
        if (it < E_IN) transpose_item(in[3], 1024, 2328, (bf16*)(ws + WS_WIN), 1024, 0, in[2], ZC_Q, ZC_KC, QSCALE, scr, it, F.lane);
        else if (it < E_OUT) { const int j = it - E_IN, kb = j / 32; transpose_item(in[20], 1024, 1024, (bf16*)(ws + WS_WOUT), 1024, 0, (kb < 8 ? in[18] : in[19] - 512), 0, 0, 1.f, scr, j, F.lane, 512); }
        else if (it < E_MQ) transpose_item(in[23], 1024, 1024, (bf16*)(ws + WS_WMQ), 1024, 0, in[21], 0, 1024, 0.0625f * 1.4426950408889634f, scr, it - E_OUT, F.lane);
        else if (it < E_MK) transpose_item(in[24], 1024, 1024, (bf16*)(ws + WS_WMK), 1024, 0, in[22], 0, 0, 1.f, scr, it - E_MQ, F.lane);
        else if (it < E_MV) transpose_item(in[25], 1024, 1024, (bf16*)(ws + WS_WMV), 1024, 0, in[22], 0, 0, 1.f, scr, it - E_MK, F.lane);
        else if (it < E_MO) transpose_item(in[26], 1024, 1024, (bf16*)(ws + WS_WMO), 1024, 0, nullptr, 0, 0, 1.f, scr, it - E_MV, F.lane);
        else if (it < E_PQ) transpose_item(in[28], 1024, 2048, (bf16*)(ws + WS_WPQ), 1024, 0, in[27], 0, 0, 1.f, scr, it - E_MO, F.lane);
        else if (it < E_C1) { const int j = it - E_PQ, kv = j / I_C1; transpose_item(in[kv ? 16 : 13], 2048, 64, (bf16*)(ws + WS_CW1T) + (size_t)kv * 64 * 2048, 2048, 0, nullptr, 0, 0, 1.f, scr, j % I_C1, F.lane); }
        else if (it < E_C2) { const int j = it - E_C1, kv = j / I_C2; transpose_item(in[kv ? 17 : 14], 64, 64, (bf16*)(ws + WS_CW2T) + (size_t)kv * 64 * 64, 64, 0, nullptr, 0, 0, 1.f, scr, j % I_C2, F.lane); }
        else { const int j = it - E_C2, ai = j / 16, h = (j / 2) % 8; transpose_item(in[ai ? 9 : 7] + (size_t)h * 4096, 64, 64, (bf16*)(ws + WS_WRGT) + (size_t)(ai * 8 + h) * 4096, 64, 0, nullptr, 0, 0, 1.f, scr, j % 2, F.lane); }
    }
    for (int i = gw * 64 + F.lane; i < (2560 - 2336) * 1024 / 8; i += NGW * 64) ((v4u*)((bf16*)(ws + WS_WIN) + (size_t)2336 * 1024))[i] = (v4u){0u, 0u, 0u, 0u};
    for (int it = NGW - 1 - gw; it < 32; it += NGW) { const int kv = it >> 4, ch = it & 15; const float* pos = in[kv ? 15 : 12] + 128 * ch; const float* w1 = in[kv ? 16 : 13] + (size_t)128 * ch * 64 + F.lane; float s = 0.f;
#pragma unroll 16
        for (int k = 0; k < 128; ++k) s += pos[k] * w1[(size_t)k * 64];
        ((float*)(ws + WS_C1))[it * 64 + F.lane] = s; }
    { const size_t i0 = (size_t)gw * 64 + F.lane, st = (size_t)NGW * 64;
      const int nrows0 = (F.G == 256) ? 16384 : 32768;
      for (int r = gw; r < nrows0; r += 4 * NGW) { const int tb = r >> 14, e = r & 16383;
          if ((16384 % (4 * NGW)) == 0) quant_rows4_fp8(in[30 + tb] + (size_t)e * DM, (size_t)NGW * DM, tb ? nullptr : in[27], ws + (tb ? WS_V8 : WS_U8) + (size_t)e * 128, (float*)(ws + (tb ? WS_SV : WS_SU)) + e, NGW, F.lane);
          else for (int q = 0; q < 4; ++q) { const int rr = r + q * NGW; if (rr < 32768) { const int t2 = rr >> 14, e2 = rr & 16383; quant_row_fp8(in[30 + t2] + (size_t)e2 * DM, t2 ? nullptr : in[27], ws + (t2 ? WS_V8 : WS_U8) + (size_t)e2 * 128, (float*)(ws + (t2 ? WS_SV : WS_SU)) + e2, F.lane); } } }
      for (size_t i = i0; i < (size_t)8 * 2 * 128 * 128 / 8; i += st) { const f32x4 a = ((const f32x4*)in[29])[2 * i], bq = ((const f32x4*)in[29])[2 * i + 1];
          v4u o; o.x = pk2(a.x, a.y); o.y = pk2(a.z, a.w); o.z = pk2(bq.x, bq.y); o.w = pk2(bq.z, bq.w);
          const size_t R = i >> 4, d0 = (i & 15) * 8;
          *(v4u*)((bf16*)(ws + WS_SKEY) + (R >> 5) * 4096 + (d0 >> 4) * 512 + ((d0 >> 3) & 1) * 256 + (R & 31) * 8) = o; } }
    if ((MTOK % (4 * NGW)) == 0) for (int m = gw; m < MTOK; m += 4 * NGW) rms_rows4_to_bf16(in[0] + (size_t)m * DM, (bf16*)(ws + WS_XN) + (size_t)m * DM, (size_t)NGW * DM, F.lane);
    else for (int m = gw; m < MTOK; m += NGW) rms_row_to_bf16(in[0] + (size_t)m * DM, (bf16*)(ws + WS_XN) + (size_t)m * DM, F.lane);
    for (int m = gw; m < NB * NMEM; m += NGW) rms_row_to_bf16(in[1] + (size_t)m * DM, (bf16*)(ws + WS_MEMN) + (size_t)m * DM, F.lane);
}

__device__ __forceinline__ int crow(int r, int hi) { return (r & 3) + 8 * (r >> 2) + 4 * hi; }
__device__ __forceinline__ float gelu_tanh(float x) {
    const float u = 0.7978845608028654f * (x + 0.044715f * x * x * x);
    const float t = 1.0f - 2.0f * __builtin_amdgcn_rcpf(__builtin_amdgcn_exp2f(2.0f * 1.4426950408889634f * u) + 1.0f);
    return 0.5f * x * (1.0f + t);
}
constexpr int XC_LD = 520;
__device__ __forceinline__ void lru_local_item(const Frame& F, const Args& A, LAS unsigned char* lds, int item) {
    unsigned char* ws = A.ws;
    const bf16* Z = (const bf16*)(ws + WS_Z);
    const int b = item >> 7, chunk = item & 127, s0 = chunk * 64; const size_t row0 = (size_t)b * SEQ + s0;
    LAS bf16* xcs = (LAS bf16*)lds;
    {
        const int c8 = F.tid & 63, tg = F.tid >> 6, c0 = 8 * c8;
        v4u xr[11];
#pragma unroll
        for (int r = 0; r < 11; ++r) { const long tok = (long)(8 * tg + r) - 3;
            if (s0 == 0 && tok < 0) xr[r] = (v4u){0u, 0u, 0u, 0u}; else xr[r] = *(const v4u*)(Z + (size_t)((long)row0 + tok) * NZ + c0); }
        const float* cw = A.in[5]; float w0[8], w1[8], w2[8], w3[8], cb[8];
#pragma unroll
        for (int j = 0; j < 2; ++j) { const f32x4 a = *(const f32x4*)(cw + c0 + 4 * j), b = *(const f32x4*)(cw + 512 + c0 + 4 * j), c = *(const f32x4*)(cw + 1024 + c0 + 4 * j), d = *(const f32x4*)(cw + 1536 + c0 + 4 * j), e2 = *(const f32x4*)(A.in[6] + c0 + 4 * j);
#pragma unroll
            for (int k = 0; k < 4; ++k) { w0[4 * j + k] = a[k]; w1[4 * j + k] = b[k]; w2[4 * j + k] = c[k]; w3[4 * j + k] = d[k]; cb[4 * j + k] = e2[k]; } }
#pragma unroll
        for (int tt = 0; tt < 8; ++tt) { float o[8];
#pragma unroll
            for (int q = 0; q < 4; ++q) { const unsigned a = xr[tt][q], b = xr[tt + 1][q], c = xr[tt + 2][q], d = xr[tt + 3][q];
                o[2 * q] = cb[2 * q] + w0[2 * q] * bflo(a) + w1[2 * q] * bflo(b) + w2[2 * q] * bflo(c) + w3[2 * q] * bflo(d);
                o[2 * q + 1] = cb[2 * q + 1] + w0[2 * q + 1] * bfhi(a) + w1[2 * q + 1] * bfhi(b) + w2[2 * q + 1] * bfhi(c) + w3[2 * q + 1] * bfhi(d); }
            v4u ov; ov.x = pk2(o[0], o[1]); ov.y = pk2(o[2], o[3]); ov.z = pk2(o[4], o[5]); ov.w = pk2(o[6], o[7]);
            *(LAS v4u*)(xcs + (8 * tg + tt) * XC_LD + c0) = ov; }
    }
    __syncthreads();
    const int h = F.wave, lane = F.lane, r32 = lane & 31, hi = lane >> 5;
    bf16x8 af[2][4];
#pragma unroll
    for (int tt = 0; tt < 2; ++tt)
#pragma unroll
        for (int ks = 0; ks < 4; ++ks) af[tt][ks] = *(const LAS bf16x8*)(xcs + (32 * tt + r32) * XC_LD + 64 * h + 16 * ks + 8 * hi);
    const bf16* WT = (const bf16*)(ws + WS_WRGT);
    float* SUMM = (float*)(ws + WS_SUMM);
    unsigned* HA = (unsigned*)A.out;
#pragma unroll 1
    for (int ct = 0; ct < 2; ++ct) {
        const int c = 64 * h + 32 * ct + r32;
        f32x16 ga[2], gi[2];
#pragma unroll
        for (int tt = 0; tt < 2; ++tt) { ga[tt] = f32x16{}; gi[tt] = f32x16{}; }
#pragma unroll
        for (int ks = 0; ks < 4; ++ks) {
            const bf16x8 ba = *(const bf16x8*)(WT + (size_t)(0 * 8 + h) * 4096 + (32 * ct + r32) * 64 + 16 * ks + 8 * hi);
            const bf16x8 bi = *(const bf16x8*)(WT + (size_t)(1 * 8 + h) * 4096 + (32 * ct + r32) * 64 + 16 * ks + 8 * hi);
#pragma unroll
            for (int tt = 0; tt < 2; ++tt) { ga[tt] = __builtin_amdgcn_mfma_f32_32x32x16_bf16(af[tt][ks], ba, ga[tt], 0, 0, 0); gi[tt] = __builtin_amdgcn_mfma_f32_32x32x16_bf16(af[tt][ks], bi, gi[tt], 0, 0, 0); }
        }
        const float ba_ = A.in[8][c], bi_ = A.in[10][c], lam = A.in[11][c];
        const float sp = (lam > 15.f) ? __expf(-lam) : log1pf(__expf(-lam));
#pragma unroll
        for (int tt = 0; tt < 2; ++tt)
#pragma unroll
            for (int r = 0; r < 16; ++r) { const int t = 32 * tt + crow(r, hi);
                const float rr = __builtin_amdgcn_rcpf(1.0f + __builtin_amdgcn_exp2f(-1.4426950408889634f * (ga[tt][r] + ba_))), ii = __builtin_amdgcn_rcpf(1.0f + __builtin_amdgcn_exp2f(-1.4426950408889634f * (gi[tt][r] + bi_)));
                const float a = __builtin_amdgcn_exp2f(-8.0f * 1.4426950408889634f * rr * sp);
                const float xcv = bf2f(xcs[t * XC_LD + c]);
                const float bb = __builtin_amdgcn_sqrtf(fmaxf(1.0f - a * a, 0.f)) * (ii * xcv);
                ga[tt][r] = a; gi[tt][r] = bb; }
        float SA[8], SB[8];
#pragma unroll
        for (int tt = 0; tt < 2; ++tt)
#pragma unroll
            for (int q = 0; q < 4; ++q) {
#pragma unroll
                for (int k = 1; k < 4; ++k) { const int r = 4 * q + k; gi[tt][r] = ga[tt][r] * gi[tt][r - 1] + gi[tt][r]; ga[tt][r] = ga[tt][r] * ga[tt][r - 1]; }
                SA[tt * 4 + q] = ga[tt][4 * q + 3]; SB[tt * 4 + q] = gi[tt][4 * q + 3]; }
        float CA = 1.f, CB = 0.f; float inA[8], inB[8];
#pragma unroll
        for (int s = 0; s < 8; ++s) {
            const float pA = __shfl_xor(SA[s], 32), pB = __shfl_xor(SB[s], 32);
            const float Ae = hi ? pA : SA[s], Be = hi ? pB : SB[s], Ao = hi ? SA[s] : pA, Bo = hi ? SB[s] : pB;
            if (!hi) { inA[s] = CA; inB[s] = CB; }
            CB = Ae * CB + Be; CA = Ae * CA;
            if (hi) { inA[s] = CA; inB[s] = CB; }
            CB = Ao * CB + Bo; CA = Ao * CA;
        }
        unsigned hoff = (unsigned)((row0 + 4 * hi) * 512 + c);
        if (hi == 0) { float* sp2 = SUMM + ((size_t)(b * 128 + chunk) * 512 + c) * 2; sp2[0] = CA; sp2[1] = CB; }
#pragma unroll
        for (int tt = 0; tt < 2; ++tt)
#pragma unroll
            for (int r = 0; r < 16; ++r) { const int s = tt * 4 + (r >> 2);
                const float acum = ga[tt][r] * inA[s], hloc = ga[tt][r] * inB[s] + gi[tt][r];
                asm volatile("" : "+v"(hoff));
                HA[hoff + (unsigned)((32 * tt + (r & 3) + 8 * (r >> 2)) * 512)] = f2bf(hloc) | (f2bf(acum) << 16); }
    }
    __syncthreads();
}
__device__ __forceinline__ void lru_fix_item(const Frame& F, const Args& A, LAS unsigned char* lds, int item, bool zero_nsa) {
    unsigned char* ws = A.ws;
    const int b = item >> 7, chunk = item & 127; const size_t row0 = (size_t)b * SEQ + chunk * 64;
    LAS float* carry = (LAS float*)lds;
    { const int c = F.tid; const float* SUMM = (const float*)(ws + WS_SUMM) + (size_t)b * 128 * 1024 + 2 * c; float hc = 0.f;
      int j = 0;
      for (; j + 8 <= chunk; j += 8) { float2 ab[8];
#pragma unroll
          for (int q = 0; q < 8; ++q) ab[q] = *(const float2*)(SUMM + (size_t)(j + q) * 1024);
#pragma unroll
          for (int q = 0; q < 8; ++q) hc = ab[q].x * hc + ab[q].y; }
      for (; j < chunk; ++j) { const float2 ab = *(const float2*)(SUMM + (size_t)j * 1024); hc = ab.x * hc + ab.y; }
      carry[c] = hc; }
    __syncthreads();
    const bf16* Z = (const bf16*)(ws + WS_Z); const unsigned* HA = (const unsigned*)A.out; bf16* Y = (bf16*)(ws + WS_Y);
    const int c0 = 8 * F.lane;
    float cr[8];
#pragma unroll
    for (int j = 0; j < 8; ++j) cr[j] = carry[c0 + j];
#pragma unroll 1
    for (int t4 = 0; t4 < 8; t4 += 4) {
        v4u h0[4], h1[4], gz[4]; float y[4][8], s[4];
#pragma unroll
        for (int q = 0; q < 4; ++q) { const size_t row = row0 + F.wave * 8 + t4 + q; h0[q] = __builtin_nontemporal_load((const v4u*)(HA + row * 512 + c0)); h1[q] = __builtin_nontemporal_load((const v4u*)(HA + row * 512 + c0 + 4)); gz[q] = __builtin_nontemporal_load((const v4u*)(Z + row * NZ + ZC_GT + c0)); }
#pragma unroll
        for (int q = 0; q < 4; ++q) { const unsigned hw[8] = {h0[q].x, h0[q].y, h0[q].z, h0[q].w, h1[q].x, h1[q].y, h1[q].z, h1[q].w};
            const float gt[8] = {bflo(gz[q].x), bfhi(gz[q].x), bflo(gz[q].y), bfhi(gz[q].y), bflo(gz[q].z), bfhi(gz[q].z), bflo(gz[q].w), bfhi(gz[q].w)};
            s[q] = 0.f;
#pragma unroll
            for (int j = 0; j < 8; ++j) { const float hv = bfhi(hw[j]) * cr[j] + bflo(hw[j]); y[q][j] = hv * gelu_tanh(gt[j]); s[q] += y[q][j] * y[q][j]; } }
#pragma unroll
        for (int o = 1; o < 64; o <<= 1)
#pragma unroll
            for (int q = 0; q < 4; ++q) s[q] += __shfl_xor(s[q], o);
#pragma unroll
        for (int q = 0; q < 4; ++q) { const size_t row = row0 + F.wave * 8 + t4 + q; const float rstd = rsqrtf(s[q] * (1.f / 512.f) + EPS);
            v4u o; o.x = pk2(y[q][0] * rstd, y[q][1] * rstd); o.y = pk2(y[q][2] * rstd, y[q][3] * rstd); o.z = pk2(y[q][4] * rstd, y[q][5] * rstd); o.w = pk2(y[q][6] * rstd, y[q][7] * rstd);
            *(v4u*)(Y + row * DM + 512 + c0) = o;
            if (zero_nsa) *(v4u*)(Y + row * DM + c0) = (v4u){0u, 0u, 0u, 0u}; }
    }
    __syncthreads();
}

__device__ __forceinline__ void kmax_item(const Frame& F, const Args& A, int item) {
    unsigned char* ws = A.ws; const int lane = lane_id();
    const int bk = item >> 9, br = (item >> 8) & 1, tile = item & 255;
    const unsigned char* K = ws + (br ? WS_KWF : WS_KSF) + ((size_t)bk * 256 + tile) * 4096 + 16 * lane;
    float s = 0.f;
#pragma unroll
    for (int ks = 0; ks < 4; ++ks) { const v4u w = *(const v4u*)(K + 1024 * ks); const unsigned ww[4] = {w.x, w.y, w.z, w.w};
#pragma unroll
        for (int k = 0; k < 4; ++k) { const float a = bflo(ww[k]), c = bfhi(ww[k]); s += a * a + c * c; } }
    s = addswap32_f(s);
#pragma unroll
    for (int o = 1; o < 32; o <<= 1) s = fmaxf(s, __shfl_xor(s, o));
    if (lane == 0) atomicMax((unsigned*)(ws + WS_CTL) + CW_KMAX + bk * 2 + br, __builtin_bit_cast(unsigned, s));
}
__device__ __forceinline__ void compress_item(const Frame& F, const Args& A, LAS unsigned char* lds, int item) {
    unsigned char* ws = A.ws;
    const int kv = item >> 6, b = (item >> 5) & 1, h = (item >> 4) & 1, nt = item & 15, n0 = 32 * nt;
    const int lane = F.lane, r32 = lane & 31, hi = lane >> 5, w = F.wave;
    const bf16* Z = (const bf16*)(ws + WS_Z); const bf16* W1T = (const bf16*)(ws + WS_CW1T) + (size_t)kv * 64 * 2048; const bf16* W2T = (const bf16*)(ws + WS_CW2T) + (size_t)kv * 4096;
    const int zc = (kv ? ZC_VC : ZC_KC) + h * 64;
    LAS float* part = (LAS float*)lds;
    LAS float* G = (LAS float*)(lds + 65536);
    {
        int n = n0 + r32; if (n > 510) n = 510;
        f32x16 acc[2]; acc[0] = f32x16{}; acc[1] = f32x16{};
#pragma unroll 4
        for (int kk = 0; kk < 16; ++kk) { const int ks = 16 * w + kk, l = ks >> 2, d0 = (ks & 3) * 16 + 8 * hi;
            const bf16x8 bfr = *(const bf16x8*)(Z + ((size_t)b * SEQ + 16 * n + l) * NZ + zc + d0);
            const bf16x8 a0 = *(const bf16x8*)(W1T + (size_t)(r32) * 2048 + ks * 16 + 8 * hi), a1 = *(const bf16x8*)(W1T + (size_t)(32 + r32) * 2048 + ks * 16 + 8 * hi);
            acc[0] = __builtin_amdgcn_mfma_f32_32x32x16_bf16(a0, bfr, acc[0], 0, 0, 0); acc[1] = __builtin_amdgcn_mfma_f32_32x32x16_bf16(a1, bfr, acc[1], 0, 0, 0); }
#pragma unroll
        for (int ot = 0; ot < 2; ++ot)
#pragma unroll
            for (int r = 0; r < 16; ++r) part[(w * 64 + 32 * ot + crow(r, hi)) * 32 + r32] = acc[ot][r];
    }
    __syncthreads();
    { const float* c1 = (const float*)(ws + WS_C1) + kv * 16 * 64;
#pragma unroll
      for (int i = 0; i < 4; ++i) { const int e = F.tid + 512 * i, o = e >> 5, n = e & 31; float s = 0.f;
#pragma unroll
          for (int ch = 0; ch < 16; ++ch) s += c1[ch * 64 + o];
#pragma unroll
          for (int ww = 0; ww < 8; ++ww) s += part[(ww * 64 + o) * 32 + n];
          G[o * 33 + n] = gelu_tanh(s); } }
    __syncthreads();
    if (w < 2) {
        f32x16 acc = f32x16{};
#pragma unroll
        for (int ks = 0; ks < 4; ++ks) { const bf16x8 a = *(const bf16x8*)(W2T + (size_t)(32 * w + r32) * 64 + 16 * ks + 8 * hi);
            v4u bw; const LAS float* gp = G + (16 * ks + 8 * hi) * 33 + r32;
            bw.x = pk2(gp[0], gp[33]); bw.y = pk2(gp[66], gp[99]); bw.z = pk2(gp[132], gp[165]); bw.w = pk2(gp[198], gp[231]);
            acc = __builtin_amdgcn_mfma_f32_32x32x16_bf16(a, __builtin_bit_cast(bf16x8, bw), acc, 0, 0, 0); }
        const int n = n0 + r32;
        const size_t tbase = ((size_t)(b * 2 + h) * 16 + nt) * 2048;
        if (kv == 0) { bf16* KC = (bf16*)(ws + WS_KC) + tbase;
#pragma unroll
            for (int q = 0; q < 4; ++q) { v2u o; o.x = pk2(acc[4 * q], acc[4 * q + 1]); o.y = pk2(acc[4 * q + 2], acc[4 * q + 3]); if (n > 510) { o.x = 0u; o.y = 0u; }
                *(v2u*)(KC + (2 * w + (q >> 1)) * 512 + (q & 1) * 256 + r32 * 8 + 4 * hi) = o; } }
        else { bf16* VC = (bf16*)(ws + WS_VCT) + tbase; const int kk = r32 & 15, vo = (r32 >> 4) * 512 + ((kk >> 2) & 1) * 256 + (kk & 3) + 4 * (kk >> 3);
#pragma unroll
            for (int r = 0; r < 16; ++r) VC[w * 1024 + crow(r, hi) * 8 + vo] = (n > 510) ? (bf16)0 : (bf16)f2bf(acc[r]); }
    }
    __syncthreads();
}

__device__ __forceinline__ void sort16_desc(int (&k)[16]) {
#define CX(i, j) { const int hi_ = max(k[i], k[j]), lo_ = min(k[i], k[j]); k[i] = hi_; k[j] = lo_; }
    CX(0, 1) CX(2, 3) CX(0, 2) CX(1, 3) CX(1, 2) CX(4, 5) CX(6, 7) CX(4, 6) CX(5, 7) CX(5, 6) CX(0, 4) CX(2, 6) CX(2, 4) CX(1, 5) CX(3, 7) CX(3, 5) CX(1, 2)
    CX(3, 4) CX(5, 6) CX(8, 9) CX(10, 11) CX(8, 10) CX(9, 11) CX(9, 10) CX(12, 13) CX(14, 15) CX(12, 14) CX(13, 15) CX(13, 14) CX(8, 12) CX(10, 14) CX(10, 12)
    CX(9, 13) CX(11, 15) CX(11, 13) CX(9, 10) CX(11, 12) CX(13, 14) CX(0, 8) CX(4, 12) CX(4, 8) CX(2, 10) CX(6, 14) CX(6, 10) CX(2, 4) CX(6, 8) CX(10, 12)
    CX(1, 9) CX(5, 13) CX(5, 9) CX(3, 11) CX(7, 15) CX(7, 11) CX(3, 5) CX(7, 9) CX(11, 13) CX(1, 2) CX(3, 4) CX(5, 6) CX(7, 8) CX(9, 10) CX(11, 12) CX(13, 14)
#undef CX
}
__device__ __forceinline__ void sort32_desc(int (&k)[32]) {
#define CX(i, j) { const int hi_ = max(k[i], k[j]), lo_ = min(k[i], k[j]); k[i] = hi_; k[j] = lo_; }
    CX(0, 1) CX(2, 3) CX(0, 2) CX(1, 3) CX(1, 2) CX(4, 5) CX(6, 7) CX(4, 6) CX(5, 7) CX(5, 6) CX(0, 4) CX(2, 6) CX(2, 4) CX(1, 5) CX(3, 7) CX(3, 5) CX(1, 2)
    CX(3, 4) CX(5, 6) CX(8, 9) CX(10, 11) CX(8, 10) CX(9, 11) CX(9, 10) CX(12, 13) CX(14, 15) CX(12, 14) CX(13, 15) CX(13, 14) CX(8, 12) CX(10, 14) CX(10, 12)
    CX(9, 13) CX(11, 15) CX(11, 13) CX(9, 10) CX(11, 12) CX(13, 14) CX(0, 8) CX(4, 12) CX(4, 8) CX(2, 10) CX(6, 14) CX(6, 10) CX(2, 4) CX(6, 8) CX(10, 12)
    CX(1, 9) CX(5, 13) CX(5, 9) CX(3, 11) CX(7, 15) CX(7, 11) CX(3, 5) CX(7, 9) CX(11, 13) CX(1, 2) CX(3, 4) CX(5, 6) CX(7, 8) CX(9, 10) CX(11, 12) CX(13, 14)
    CX(16, 17) CX(18, 19) CX(16, 18) CX(17, 19) CX(17, 18) CX(20, 21) CX(22, 23) CX(20, 22) CX(21, 23) CX(21, 22) CX(16, 20) CX(18, 22) CX(18, 20) CX(17, 21)
    CX(19, 23) CX(19, 21) CX(17, 18) CX(19, 20) CX(21, 22) CX(24, 25) CX(26, 27) CX(24, 26) CX(25, 27) CX(25, 26) CX(28, 29) CX(30, 31) CX(28, 30) CX(29, 31)
    CX(29, 30) CX(24, 28) CX(26, 30) CX(26, 28) CX(25, 29) CX(27, 31) CX(27, 29) CX(25, 26) CX(27, 28) CX(29, 30) CX(16, 24) CX(20, 28) CX(20, 24) CX(18, 26)
    CX(22, 30) CX(22, 26) CX(18, 20) CX(22, 24) CX(26, 28) CX(17, 25) CX(21, 29) CX(21, 25) CX(19, 27) CX(23, 31) CX(23, 27) CX(19, 21) CX(23, 25) CX(27, 29)
    CX(17, 18) CX(19, 20) CX(21, 22) CX(23, 24) CX(25, 26) CX(27, 28) CX(29, 30) CX(0, 16) CX(8, 24) CX(8, 16) CX(4, 20) CX(12, 28) CX(12, 20) CX(4, 8)
    CX(12, 16) CX(20, 24) CX(2, 18) CX(10, 26) CX(10, 18) CX(6, 22) CX(14, 30) CX(14, 22) CX(6, 10) CX(14, 18) CX(22, 26) CX(2, 4) CX(6, 8) CX(10, 12)
    CX(14, 16) CX(18, 20) CX(22, 24) CX(26, 28) CX(1, 17) CX(9, 25) CX(9, 17) CX(5, 21) CX(13, 29) CX(13, 21) CX(5, 9) CX(13, 17) CX(21, 25) CX(3, 19)
    CX(11, 27) CX(11, 19) CX(7, 23) CX(15, 31) CX(15, 23) CX(7, 11) CX(15, 19) CX(23, 27) CX(3, 5) CX(7, 9) CX(11, 13) CX(15, 17) CX(19, 21) CX(23, 25)
    CX(27, 29) CX(1, 2) CX(3, 4) CX(5, 6) CX(7, 8) CX(9, 10) CX(11, 12) CX(13, 14) CX(15, 16) CX(17, 18) CX(19, 20) CX(21, 22) CX(23, 24) CX(25, 26) CX(27, 28)
    CX(29, 30)
#undef CX
}
__device__ __forceinline__ void bitonic16_desc(int (&a)[16]) {
#pragma unroll
    for (int s = 8; s >= 1; s >>= 1)
#pragma unroll
        for (int i = 0; i < 16; ++i) if ((i & s) == 0) { const int hi_ = max(a[i], a[i + s]), lo_ = min(a[i], a[i + s]); a[i] = hi_; a[i + s] = lo_; }
}
__device__ __forceinline__ void merge16_desc(int (&a)[16], const int (&b)[16]) {
#pragma unroll
    for (int i = 0; i < 16; ++i) a[i] = max(a[i], b[15 - i]);
    bitonic16_desc(a);
}
struct AttnSt { float m, l; f32x16 o[2]; };
#define EX2(x) __builtin_amdgcn_exp2f(x)
struct KVF { bf16x8 k[4]; bf16x8 v[2][2]; };
struct KVF8 { bf16x8 k[4]; v4u v8[2]; };
__device__ __forceinline__ void kv_load8(KVF8& f, const bf16* Kt, const unsigned char* Vt8, unsigned lo16) {
    const char* kb = (const char*)Kt + lo16;
#pragma unroll
    for (int ks = 0; ks < 4; ++ks) f.k[ks] = *(const bf16x8*)(kb + 1024 * ks);
#pragma unroll
    for (int dt = 0; dt < 2; ++dt) f.v8[dt] = *(const v4u*)(Vt8 + lo16 + 1024 * dt);
}
typedef __bf16 bf16x2v __attribute__((ext_vector_type(2)));
__device__ __forceinline__ bf16x8 dq8(unsigned w0, unsigned w1) {
    v4u o; o.x = __builtin_bit_cast(unsigned, __builtin_amdgcn_cvt_scalef32_pk_bf16_fp8(w0, 1.0f, false)); o.y = __builtin_bit_cast(unsigned, __builtin_amdgcn_cvt_scalef32_pk_bf16_fp8(w0, 1.0f, true));
    o.z = __builtin_bit_cast(unsigned, __builtin_amdgcn_cvt_scalef32_pk_bf16_fp8(w1, 1.0f, false)); o.w = __builtin_bit_cast(unsigned, __builtin_amdgcn_cvt_scalef32_pk_bf16_fp8(w1, 1.0f, true));
    return __builtin_bit_cast(bf16x8, o); }
__device__ __forceinline__ void kv_load(KVF& f, const bf16* Kt, const bf16* Vt, unsigned lo16) {
    const char* kb = (const char*)Kt + lo16; const char* vb = (const char*)Vt + lo16;
#pragma unroll
    for (int ks = 0; ks < 4; ++ks) f.k[ks] = *(const bf16x8*)(kb + 1024 * ks);
#pragma unroll
    for (int dt = 0; dt < 2; ++dt)
#pragma unroll
        for (int s2 = 0; s2 < 2; ++s2) f.v[dt][s2] = *(const bf16x8*)(vb + 2048 * dt + 1024 * s2);
}
#define MAX3(a, b, c) __builtin_fmaxf(__builtin_fmaxf((a), (b)), (c))
__device__ __forceinline__ float max16(const f32x16& s) { const float a = MAX3(s[0], s[1], s[2]), b = MAX3(s[3], s[4], s[5]), c = MAX3(s[6], s[7], s[8]), d = MAX3(s[9], s[10], s[11]), e = MAX3(s[12], s[13], s[14]);
    return MAX3(MAX3(a, b, c), MAX3(d, e, s[15]), -1e30f); }
__device__ __forceinline__ float sum16(const f32x16& s) { return (((s[0] + s[1]) + (s[2] + s[3])) + ((s[4] + s[5]) + (s[6] + s[7]))) + (((s[8] + s[9]) + (s[10] + s[11])) + ((s[12] + s[13]) + (s[14] + s[15]))); }
template <int MODE, bool FIXED, class AllowF>
__device__ __forceinline__ void attn_compute(const KVF8& f, const bf16x8 (&qf)[4], const f32x16& negm, bool sel, AllowF allow, AttnSt& st) {
    f32x16 s = FIXED ? negm : f32x16{};
#pragma unroll
    for (int ks = 0; ks < 4; ++ks) s = __builtin_amdgcn_mfma_f32_32x32x16_bf16(f.k[ks], qf[ks], s, 0, 0, 0);
    if (MODE == 2) {
#pragma unroll
        for (int r = 0; r < 16; ++r) if (!allow(r)) s[r] = -1e30f; }
    if (!FIXED) {
        float mt = max16(s);
        if (MODE == 1) mt = sel ? mt : -1e30f;
        mt = maxswap32_f(mt);
        if (__any(mt > st.m)) {
            const float mn = fmaxf(st.m, mt), alpha = EX2(st.m - mn);
            st.m = mn; st.l *= alpha;
#pragma unroll
            for (int dt = 0; dt < 2; ++dt)
#pragma unroll
                for (int r = 0; r < 16; ++r) st.o[dt][r] *= alpha;
        }
        const float mref = (MODE == 1 && !sel) ? 1e30f : fmaxf(st.m, -1e29f);
#pragma unroll
        for (int r = 0; r < 16; ++r) s[r] = EX2(s[r] - mref);
        st.l += sum16(s);
    } else {
#pragma unroll
        for (int r = 0; r < 16; ++r) s[r] = EX2(s[r]);
        const float ps = sum16(s);
        st.l += (MODE == 1 && !sel) ? 0.f : ps;
    }
#pragma unroll
    for (int s2 = 0; s2 < 2; ++s2) { v4u pw; pw.x = pk2(s[8 * s2], s[8 * s2 + 1]); pw.y = pk2(s[8 * s2 + 2], s[8 * s2 + 3]); pw.z = pk2(s[8 * s2 + 4], s[8 * s2 + 5]); pw.w = pk2(s[8 * s2 + 6], s[8 * s2 + 7]);
        if (FIXED && MODE == 1) { pw.x = sel ? pw.x : 0u; pw.y = sel ? pw.y : 0u; pw.z = sel ? pw.z : 0u; pw.w = sel ? pw.w : 0u; }
        const bf16x8 pf = __builtin_bit_cast(bf16x8, pw);
#pragma unroll
        for (int dt = 0; dt < 2; ++dt) st.o[dt] = __builtin_amdgcn_mfma_f32_32x32x16_bf16(dq8(f.v8[dt][2 * s2], f.v8[dt][2 * s2 + 1]), pf, st.o[dt], 0, 0, 0); }
}
constexpr int IMP_LD = 132;
__device__ __forceinline__ void nsa_item(const Frame& F, const Args& A, LAS unsigned char* lds, int b, int kvh, int tb, int wsub) {
    unsigned char* ws = A.ws;
    int lane = lane_id(); asm volatile("" : "+v"(lane));
    const int r32 = lane & 31, hi = lane >> 5, w = F.wave;
    const int t0 = 64 * tb + 8 * wsub, ti = r32 & 7, g = r32 >> 3, t = t0 + ti, cur = tb;
    const size_t rowb = (size_t)b * SEQ;
    const bf16* Z = (const bf16*)(ws + WS_Z);
    LAS float* imp = (LAS float*)lds + w * 8 * IMP_LD;
    for (int i = lane; i < 8 * IMP_LD; i += 64) imp[i] = 0.f;
    bf16x8 qf[4];
#pragma unroll
    for (int ks = 0; ks < 4; ++ks) qf[ks] = *(const bf16x8*)(Z + (rowb + t) * NZ + ZC_Q + (kvh * 4 + g) * 64 + 16 * ks + 8 * hi);
    const float* gp = (const float*)(ws + WS_GATES) + (rowb + t) * 24 + (kvh * 4 + g) * 3;
    const float gate_c = gp[0], gate_s = gp[1], gate_w = gp[2];
    LAS float* oacc = (LAS float*)(lds + 8 * 8 * IMP_LD * 4) + w * 2048 + lane;
    {
        const bf16* KC = (const bf16*)(ws + WS_KC) + (size_t)(b * 2 + kvh) * 16 * 2048;
        const bf16* VCT = (const bf16*)(ws + WS_VCT) + (size_t)(b * 2 + kvh) * 16 * 2048;
        const int nv = (t >= 31) ? ((t - 31) >> 4) + 1 : 0;
        const int tl = t0 + 7, nvmax = (tl >= 31) ? ((tl - 31) >> 4) + 1 : 0;
        const unsigned lo16 = 16u * (unsigned)lane;
        float m1 = -1e30f, l1 = 0.f;
        {
            bf16x8 ka[4], kb[4];
#pragma unroll
            for (int ks = 0; ks < 4; ++ks) ka[ks] = *(const bf16x8*)((const char*)KC + lo16 + 1024 * ks);
            for (int n0 = 0; n0 < nvmax; n0 += 32) {
                if (n0 + 32 < nvmax) {
#pragma unroll
                    for (int ks = 0; ks < 4; ++ks) kb[ks] = *(const bf16x8*)((const char*)(KC + (size_t)(n0 + 32) * 64) + lo16 + 1024 * ks);
                }
                f32x16 s = f32x16{};
#pragma unroll
                for (int ks = 0; ks < 4; ++ks) s = __builtin_amdgcn_mfma_f32_32x32x16_bf16(ka[ks], qf[ks], s, 0, 0, 0);
                float mt = -1e30f;
#pragma unroll
                for (int r = 0; r < 16; ++r) { if (n0 + crow(r, hi) >= nv) s[r] = -1e30f; mt = fmaxf(mt, s[r]); }
                const float mn = fmaxf(m1, mt); float ps = 0.f;
#pragma unroll
                for (int r = 0; r < 16; ++r) ps += (s[r] > -1e29f) ? EX2(s[r] - mn) : 0.f;
                l1 = l1 * EX2(m1 - mn) + ps; m1 = mn;
#pragma unroll
                for (int ks = 0; ks < 4; ++ks) ka[ks] = kb[ks];
            }
        }
        { const float mo = __shfl_xor(m1, 32), lo = __shfl_xor(l1, 32); const float mn = fmaxf(m1, mo); l1 = l1 * EX2(m1 - mn) + lo * EX2(mo - mn); m1 = mn; }
        const float invl = (l1 > 0.f) ? 1.0f / l1 : 0.f;
        f32x16 o[2]; o[0] = f32x16{}; o[1] = f32x16{};
        KVF fa, fb;
        if (nvmax > 0) kv_load(fa, KC, VCT, lo16);
        for (int n0 = 0; n0 < nvmax; n0 += 32) {
            if (n0 + 32 < nvmax) kv_load(fb, KC + (size_t)(n0 + 32) * 64, VCT + (size_t)(n0 + 32) * 64, lo16);
            f32x16 s = f32x16{};
#pragma unroll
            for (int ks = 0; ks < 4; ++ks) s = __builtin_amdgcn_mfma_f32_32x32x16_bf16(fa.k[ks], qf[ks], s, 0, 0, 0);
#pragma unroll
            for (int r = 0; r < 16; ++r) s[r] = (n0 + crow(r, hi) < nv) ? EX2(s[r] - m1) * invl : 0.f;
            float bs[4], sp[4];
#pragma unroll
            for (int q = 0; q < 4; ++q) { bs[q] = (s[4 * q] + s[4 * q + 1]) + (s[4 * q + 2] + s[4 * q + 3]); sp[q] = s[4 * q + 3];
                bs[q] += __shfl_xor(bs[q], 8); bs[q] += __shfl_xor(bs[q], 16); sp[q] += __shfl_xor(sp[q], 8); sp[q] += __shfl_xor(sp[q], 16); }
            if (r32 < 8) {
                LAS float* ip = imp + r32 * IMP_LD + (n0 >> 2) + hi;
#pragma unroll
                for (int q = 0; q < 4; ++q) ip[2 * q] += bs[q];
                asm volatile("s_waitcnt lgkmcnt(0)" ::: "memory");
#pragma unroll
                for (int q = 0; q < 4; ++q) ip[2 * q + 1] += sp[q];
                asm volatile("s_waitcnt lgkmcnt(0)" ::: "memory");
            }
#pragma unroll
            for (int s2 = 0; s2 < 2; ++s2) { v4u pw; pw.x = pk2(s[8 * s2], s[8 * s2 + 1]); pw.y = pk2(s[8 * s2 + 2], s[8 * s2 + 3]); pw.z = pk2(s[8 * s2 + 4], s[8 * s2 + 5]); pw.w = pk2(s[8 * s2 + 6], s[8 * s2 + 7]);
                const bf16x8 pf = __builtin_bit_cast(bf16x8, pw);
#pragma unroll
                for (int dt = 0; dt < 2; ++dt) o[dt] = __builtin_amdgcn_mfma_f32_32x32x16_bf16(fa.v[dt][s2], pf, o[dt], 0, 0, 0); }
            if (n0 + 32 < nvmax) fa = fb;
        }
#pragma unroll
        for (int dt = 0; dt < 2; ++dt)
#pragma unroll
            for (int r = 0; r < 16; ++r) oacc[(dt * 16 + r) * 64] = gate_c * o[dt][r];
    }
    asm volatile("s_waitcnt lgkmcnt(0)" ::: "memory");
    unsigned mym[4] = {0u, 0u, 0u, 0u}, un[4] = {0u, 0u, 0u, 0u};
    if (cur < 16) { const unsigned mk = (2u << cur) - 1u; mym[0] = mk; un[0] = mk; }
    else {
        const int tq = lane >> 3, sub = lane & 7;
        int key[16];
#pragma unroll
        for (int i = 0; i < 16; ++i) { const int j = 16 * sub + i; const float v = imp[tq * IMP_LD + j];
            key[i] = (j >= 1 && j <= cur - 2) ? (int)((__builtin_bit_cast(unsigned, v) & ~0x7fu) | (unsigned)(127 - j)) : 0; }
        sort16_desc(key);
        { int ot[16];
#pragma unroll
          for (int i = 0; i < 16; ++i) ot[i] = __builtin_amdgcn_mov_dpp(key[i], 0xB1, 0xf, 0xf, true);
          merge16_desc(key, ot);
#pragma unroll
          for (int i = 0; i < 16; ++i) ot[i] = __builtin_amdgcn_mov_dpp(key[i], 0x4E, 0xf, 0xf, true);
          merge16_desc(key, ot);
#pragma unroll
          for (int i = 0; i < 16; ++i) ot[i] = __builtin_amdgcn_mov_dpp(key[i], 0x141, 0xf, 0xf, true);
          merge16_desc(key, ot); }
        unsigned mk[4] = {1u, 0u, 0u, 0u};
        { const int c1 = cur - 1; if (c1 < 32) mk[0] |= 1u << c1; else if (c1 < 64) mk[1] |= 1u << (c1 - 32); else if (c1 < 96) mk[2] |= 1u << (c1 - 64); else mk[3] |= 1u << (c1 - 96);
          if (cur < 32) mk[0] |= 1u << cur; else if (cur < 64) mk[1] |= 1u << (cur - 32); else if (cur < 96) mk[2] |= 1u << (cur - 64); else mk[3] |= 1u << (cur - 96); }
#pragma unroll
        for (int i = 0; i < 13; ++i) { const int j = 127 - (key[i] & 0x7f); const unsigned bit = (key[i] != 0) ? (1u << (j & 31)) : 0u; const int wd = j >> 5;
            mk[0] |= (wd == 0) ? bit : 0u; mk[1] |= (wd == 1) ? bit : 0u; mk[2] |= (wd == 2) ? bit : 0u; mk[3] |= (wd == 3) ? bit : 0u; }
#pragma unroll
        for (int i = 0; i < 4; ++i) { unsigned u = mk[i]; u |= (unsigned)__shfl_xor((int)u, 8); u |= (unsigned)__shfl_xor((int)u, 16); u |= (unsigned)__shfl_xor((int)u, 32); un[i] = u;
            mym[i] = (unsigned)__shfl((int)mk[i], 8 * ti); }
    }
    float q2 = 0.f;
#pragma unroll
    for (int ks = 0; ks < 4; ++ks) { const v4u qw = __builtin_bit_cast(v4u, qf[ks]); const unsigned ww[4] = {qw.x, qw.y, qw.z, qw.w};
#pragma unroll
        for (int k = 0; k < 4; ++k) { const float a = bflo(ww[k]), c = bfhi(ww[k]); q2 += a * a + c * c; } }
    q2 = addswap32_f(q2);
    const unsigned* KMX = (const unsigned*)(ws + WS_CTL) + CW_KMAX + (b * 2 + kvh) * 2;
    const float Ms = __builtin_amdgcn_sqrtf(q2 * __builtin_bit_cast(float, KMX[0])) * 1.0001f + 1e-3f, Mw = __builtin_amdgcn_sqrtf(q2 * __builtin_bit_cast(float, KMX[1])) * 1.0001f + 1e-3f;
    const bool fixed_ok = !__any(Ms >= 60.f || Mw >= 60.f);
    {
        AttnSt st; st.m = -1e30f; st.l = 0.f; st.o[0] = f32x16{}; st.o[1] = f32x16{};
        const bf16* KS = (const bf16*)(ws + WS_KSF) + (size_t)(b * 2 + kvh) * 256 * 2048; const unsigned char* VS = ws + WS_VSF + (size_t)(b * 2 + kvh) * 256 * 2048;
        const unsigned lo16 = 16u * (unsigned)lane;
        unsigned um0 = (unsigned)__builtin_amdgcn_readfirstlane((int)un[0]), um1 = (unsigned)__builtin_amdgcn_readfirstlane((int)un[1]), um2 = (unsigned)__builtin_amdgcn_readfirstlane((int)un[2]), um3 = (unsigned)__builtin_amdgcn_readfirstlane((int)un[3]);
#define NEXT_BLOCK(jv) do { if (um0) { jv = __builtin_ctz(um0); um0 &= um0 - 1u; } else if (um1) { jv = 32 + __builtin_ctz(um1); um1 &= um1 - 1u; } else if (um2) { jv = 64 + __builtin_ctz(um2); um2 &= um2 - 1u; } \
            else if (um3) { jv = 96 + __builtin_ctz(um3); um3 &= um3 - 1u; } else jv = -1; } while (0)
#define SLC_LOOP(FX) do { f32x16 negm; _Pragma("unroll") for (int r = 0; r < 16; ++r) negm[r] = -Ms; \
        KVF8 fa, fb; int j; NEXT_BLOCK(j); \
        if (j >= 0) kv_load8(fa, KS + (size_t)j * 4096, VS + (size_t)j * 4096, lo16); \
        while (j >= 0) { const int key0 = j * 64; \
            const unsigned mw = (j < 32) ? mym[0] : (j < 64) ? mym[1] : (j < 96) ? mym[2] : mym[3]; const bool sel = (mw >> (j & 31)) & 1u; \
            kv_load8(fb, KS + (size_t)j * 4096 + 2048, VS + (size_t)j * 4096 + 2048, lo16); \
            if (j == cur) attn_compute<2, FX>(fa, qf, negm, sel, [&](int r) { return sel && (key0 + crow(r, hi) <= t); }, st); \
            else attn_compute<1, FX>(fa, qf, negm, sel, [&](int) { return true; }, st); \
            int jn; NEXT_BLOCK(jn); \
            if (jn >= 0) kv_load8(fa, KS + (size_t)jn * 4096, VS + (size_t)jn * 4096, lo16); \
            if (j == cur) attn_compute<2, FX>(fb, qf, negm, sel, [&](int r) { return sel && (key0 + 32 + crow(r, hi) <= t); }, st); \
            else attn_compute<1, FX>(fb, qf, negm, sel, [&](int) { return true; }, st); \
            j = jn; } } while (0)
        if (fixed_ok) SLC_LOOP(true); else SLC_LOOP(false);
#undef SLC_LOOP
#undef NEXT_BLOCK
        const float l = addswap32_f(st.l); const float sc = gate_s / l;
#pragma unroll
        for (int dt = 0; dt < 2; ++dt)
#pragma unroll
            for (int r = 0; r < 16; ++r) oacc[(dt * 16 + r) * 64] += sc * st.o[dt][r];
    }
    f32x16 outv[2];
    {
        AttnSt st; st.m = -1e30f; st.l = 0.f; st.o[0] = f32x16{}; st.o[1] = f32x16{};
        const bf16* KW = (const bf16*)(ws + WS_KWF) + (size_t)(b * 2 + kvh) * 256 * 2048; const unsigned char* VW = ws + WS_VWF + (size_t)(b * 2 + kvh) * 256 * 2048;
        const unsigned lo16 = 16u * (unsigned)lane;
        const int klo = (t0 - 511 > 0) ? ((t0 - 511) & ~31) : 0, khi = (t0 + 7) & ~31;
#define WIN_LOOP(FX) do { f32x16 negm; _Pragma("unroll") for (int r = 0; r < 16; ++r) negm[r] = -Mw; \
        KVF8 fa, fb; kv_load8(fa, KW + (size_t)klo * 64, VW + (size_t)klo * 64, lo16); \
        _Pragma("unroll 1") for (int key0 = klo; key0 <= khi; key0 += 32) { \
            if (key0 + 32 <= khi) kv_load8(fb, KW + (size_t)(key0 + 32) * 64, VW + (size_t)(key0 + 32) * 64, lo16); \
            if (key0 + 31 > t0 || key0 <= t0 + 7 - 512) attn_compute<2, FX>(fa, qf, negm, true, [&](int r) { const int kp = key0 + crow(r, hi); return kp <= t && kp > t - 512; }, st); \
            else attn_compute<0, FX>(fa, qf, negm, true, [&](int) { return true; }, st); \
            if (key0 + 32 <= khi) fa = fb; } } while (0)
        if (fixed_ok) WIN_LOOP(true); else WIN_LOOP(false);
#undef WIN_LOOP
        const float l = addswap32_f(st.l); const float sc = gate_w / l;
#pragma unroll
        for (int dt = 0; dt < 2; ++dt)
#pragma unroll
            for (int r = 0; r < 16; ++r) outv[dt][r] = oacc[(dt * 16 + r) * 64] + sc * st.o[dt][r];
    }
    float ss = 0.f;
#pragma unroll
    for (int dt = 0; dt < 2; ++dt)
#pragma unroll
        for (int r = 0; r < 16; ++r) ss += outv[dt][r] * outv[dt][r];
    ss += __shfl_xor(ss, 32); ss += __shfl_xor(ss, 8); ss += __shfl_xor(ss, 16);
    if (lane < 8) ((float*)(ws + WS_SSQN))[(rowb + t0 + lane) * 2 + kvh] = ss;
    bf16* Yp = (bf16*)(ws + WS_Y) + (rowb + t) * DM + (kvh * 4 + g) * 64 + 4 * hi;
#pragma unroll
    for (int dt = 0; dt < 2; ++dt)
#pragma unroll
        for (int q = 0; q < 4; ++q) { v2u o; o.x = pk2(outv[dt][4 * q], outv[dt][4 * q + 1]); o.y = pk2(outv[dt][4 * q + 2], outv[dt][4 * q + 3]); *(v2u*)(Yp + 32 * dt + 8 * q) = o; }
}
__device__ __forceinline__ void memattn_block(const Frame& F, const Args& A, LAS unsigned char* lds, int item) {
    unsigned char* ws = A.ws;
    const int lane = F.lane, r32 = lane & 31, hi = lane >> 5, w = F.wave;
    const int h = item & 3, tg = item >> 2, b = tg >> 5, tile = tg * 8 + w; const size_t row0 = (size_t)tile * 32;
    const bf16* Q = (const bf16*)(ws + WS_QM) + (size_t)tile * 32 * DM + (size_t)(h * 16) * 512 + 8 * lane;
    { const char* Kg = (const char*)((const bf16*)(ws + WS_MEMK) + (size_t)(b * 8 + w) * 32 * DM + (size_t)(h * 16) * 512) + 16 * lane;
#pragma unroll
      for (int j = 0; j < 16; ++j) __builtin_amdgcn_global_load_lds((const unsigned*)(Kg + j * 1024), (LAS unsigned*)(lds + (w * 16 + j) * 1024), 16, 0, 0); }
    f32x16 s[8];
#pragma unroll
    for (int kt = 0; kt < 8; ++kt) s[kt] = f32x16{};
    const LAS unsigned char* lf = lds + 16 * lane;
    asm volatile("s_waitcnt vmcnt(0)" ::: "memory");
    __syncthreads();
#define QK_LOAD(qv, kv, ks_) do { const int kk_ = (ks_) < 16 ? (ks_) : 15; qv = __builtin_nontemporal_load((const bf16x8*)(Q + 512 * kk_)); _Pragma("unroll") for (int kt = 0; kt < 8; ++kt) kv[kt] = *(const LAS bf16x8*)(lf + (kt * 16 + kk_) * 1024); } while (0)
#define QK_MMA(qv, kv) do { _Pragma("unroll") for (int kt = 0; kt < 8; ++kt) s[kt] = __builtin_amdgcn_mfma_f32_32x32x16_bf16(kv[kt], qv, s[kt], 0, 0, 0); } while (0)
    { bf16x8 qa, qb, ka[8], kb[8];
      QK_LOAD(qa, ka, 0);
#pragma unroll 1
      for (int ks = 0; ks < 16; ks += 2) {
          QK_LOAD(qb, kb, ks + 1); asm volatile("" ::: "memory");
          QK_MMA(qa, ka);
          QK_LOAD(qa, ka, ks + 2); asm volatile("" ::: "memory");
          QK_MMA(qb, kb); } }
#undef QK_LOAD
#undef QK_MMA
    asm volatile("s_waitcnt vmcnt(0) lgkmcnt(0)" ::: "memory");
    __syncthreads();
    { const char* Vg = (const char*)((const bf16*)(ws + WS_MEMVT) + (size_t)((b * 4 + h) * 8 + w) * 8192) + 16 * lane;
#pragma unroll
      for (int j = 0; j < 16; ++j) __builtin_amdgcn_global_load_lds((const unsigned*)(Vg + j * 1024), (LAS unsigned*)(lds + (w * 16 + j) * 1024), 16, 0, 0); }
    float m = -1e30f;
#pragma unroll
    for (int kt = 0; kt < 8; ++kt) m = fmaxf(m, max16(s[kt]));
    m = maxswap32_f(m);
    float l = 0.f; v4u pw[8][2];
#pragma unroll
    for (int kt = 0; kt < 8; ++kt) {
#pragma unroll
        for (int r = 0; r < 16; ++r) s[kt][r] = EX2(s[kt][r] - m);
        l += sum16(s[kt]);
#pragma unroll
        for (int s2 = 0; s2 < 2; ++s2) { pw[kt][s2].x = pk2(s[kt][8 * s2], s[kt][8 * s2 + 1]); pw[kt][s2].y = pk2(s[kt][8 * s2 + 2], s[kt][8 * s2 + 3]); pw[kt][s2].z = pk2(s[kt][8 * s2 + 4], s[kt][8 * s2 + 5]); pw[kt][s2].w = pk2(s[kt][8 * s2 + 6], s[kt][8 * s2 + 7]); } }
    l = addswap32_f(l);
    const float invl = 1.0f / l;
    bf16* O = (bf16*)(ws + WS_OM) + (row0 + r32) * DM + h * 256 + 4 * hi;
    asm volatile("s_waitcnt vmcnt(0)" ::: "memory");
    __syncthreads();
#define PV_LOAD(vv, dt_) do { const int dd_ = (dt_) < 8 ? (dt_) : 7; _Pragma("unroll") for (int kt = 0; kt < 8; ++kt) _Pragma("unroll") for (int s2 = 0; s2 < 2; ++s2) vv[2 * kt + s2] = *(const LAS bf16x8*)(lf + (kt * 16 + dd_ * 2 + s2) * 1024); } while (0)
#define PV_MMA(vv, dt_) do { f32x16 o = f32x16{}; _Pragma("unroll") for (int kt = 0; kt < 8; ++kt) _Pragma("unroll") for (int s2 = 0; s2 < 2; ++s2) o = __builtin_amdgcn_mfma_f32_32x32x16_bf16(vv[2 * kt + s2], __builtin_bit_cast(bf16x8, pw[kt][s2]), o, 0, 0, 0); \
        _Pragma("unroll") for (int q = 0; q < 4; ++q) { v2u ov; ov.x = pk2(o[4 * q] * invl, o[4 * q + 1] * invl); ov.y = pk2(o[4 * q + 2] * invl, o[4 * q + 3] * invl); *(v2u*)(O + 32 * (dt_) + 8 * q) = ov; } } while (0)
    { bf16x8 va[16], vb[16];
      PV_LOAD(va, 0);
#pragma unroll 1
      for (int dt = 0; dt < 8; dt += 2) {
          PV_LOAD(vb, dt + 1); asm volatile("" ::: "memory");
          PV_MMA(va, dt);
          PV_LOAD(va, dt + 2); asm volatile("" ::: "memory");
          PV_MMA(vb, dt + 1); } }
#undef PV_LOAD
#undef PV_MMA
    asm volatile("s_waitcnt lgkmcnt(0)" ::: "memory");
    __syncthreads();
}

__device__ __forceinline__ int f2key(float f) { const int u = __builtin_bit_cast(int, f); return u ^ ((u >> 31) & 0x7fffffff); }
__device__ __forceinline__ float key2f(int k) { const int u = k ^ ((k >> 31) & 0x7fffffff); return __builtin_bit_cast(float, u); }
__device__ __forceinline__ void top16_of_128(f32x16 (&s)[4], int hi, int (&kv)[16]) {
    int key[4][16];
#pragma unroll
    for (int nt = 0; nt < 4; ++nt)
#pragma unroll
        for (int r = 0; r < 16; ++r) key[nt][r] = (f2key(s[nt][r]) & ~0x7f) | (127 - (32 * nt + crow(r, hi)));
#pragma unroll
    for (int nt = 0; nt < 4; ++nt) sort16_desc(key[nt]);
    merge16_desc(key[0], key[1]); merge16_desc(key[2], key[3]); merge16_desc(key[0], key[2]);
    unsigned a[16], b[16];
#pragma unroll
    for (int i = 0; i < 16; ++i) { a[i] = (unsigned)key[0][i]; b[i] = a[i]; swap32(a[i], b[i]); }
#pragma unroll
    for (int i = 0; i < 16; ++i) kv[i] = max((int)a[i], (int)b[15 - i]);
    bitonic16_desc(kv);
}
template <bool LDSK>
__device__ __forceinline__ void peer_topk_item(const Frame& F, const Args& A, int item, const LAS unsigned char* lds) {
    unsigned char* ws = A.ws;
    int lane = lane_id(); asm volatile("" : "+v"(lane));
    const int r32 = lane & 31, hi = lane >> 5;
    const int h = item & 7, tile = item >> 3; const size_t row = (size_t)tile * 32 + r32;
    const bf16* QP = (const bf16*)(ws + WS_QP) + (size_t)tile * 32 * 2048 + (size_t)(h * 16) * 512 + 8 * lane;
    int k1[16], k2[16];
#pragma unroll
    for (int i = 0; i < 16; ++i) { k1[i] = 0; k2[i] = 0; }
#pragma unroll 1
    for (int c = 0; c < 2; ++c) {
        const bf16* SK = (const bf16*)(ws + WS_SKEY) + (size_t)((h * 2 + c) * 4) * 4096 + 8 * lane;
        f32x16 s[4];
#pragma unroll
        for (int nt = 0; nt < 4; ++nt) s[nt] = f32x16{};
        bf16x8 qf[8];
#pragma unroll
        for (int ks = 0; ks < 8; ++ks) qf[ks] = __builtin_nontemporal_load((const bf16x8*)(QP + (size_t)(c * 8 + ks) * 512));
#pragma unroll
        for (int ks = 0; ks < 8; ++ks) {
#pragma unroll
            for (int nt = 0; nt < 4; ++nt) { const bf16x8 kf = LDSK ? *(const LAS bf16x8*)(lds + ((c * 4 + nt) * 4096 + ks * 512) * 2 + lane * 16) : *(const bf16x8*)(SK + (size_t)nt * 4096 + ks * 512);
                s[nt] = __builtin_amdgcn_mfma_f32_32x32x16_bf16(kf, qf[ks], s[nt], 0, 0, 0); } }
        if (c == 0) top16_of_128(s, hi, k1); else top16_of_128(s, hi, k2);
    }
    float v1[16], v2[16];
#pragma unroll
    for (int i = 0; i < 16; ++i) { v1[i] = key2f(k1[i] & ~0x7f); v2[i] = key2f(k2[i] & ~0x7f); }
    int ck[32];
    {
        int idx = 0;
#pragma unroll
        for (int i = 0; i < 32; ++i) ck[i] = (int)0x80000000;
#pragma unroll
        for (int a = 0; a < 16; ++a)
#pragma unroll
            for (int bq = 0; bq < 16; ++bq) if ((a + 1) * (bq + 1) <= 16) {
                const int flat = a * 16 + bq; const int kk = (f2key(v1[a] + v2[bq]) & ~0xff) | (255 - flat);
                if ((idx & 1) == hi) ck[idx >> 1] = kk;
                ++idx; }
    }
    sort32_desc(ck);
    int tk[16];
    { unsigned a[16], b[16];
#pragma unroll
      for (int i = 0; i < 16; ++i) { a[i] = (unsigned)ck[i]; b[i] = a[i]; swap32(a[i], b[i]); }
#pragma unroll
      for (int i = 0; i < 16; ++i) tk[i] = max((int)a[i], (int)b[15 - i]);
      bitonic16_desc(tk); }
    int te[16];
    { LAS int* tab = (LAS int*)(lds + 65536 + F.wave * 8448) + lane * 33;
#pragma unroll
      for (int i = 0; i < 16; ++i) { tab[i] = 127 - (k1[i] & 0x7f); tab[16 + i] = 127 - (k2[i] & 0x7f); }
      asm volatile("s_waitcnt lgkmcnt(0)" ::: "memory");
#pragma unroll
      for (int i = 0; i < 16; ++i) { const int flat = 255 - (tk[i] & 0xff); te[i] = tab[flat >> 4] * 128 + tab[16 + (flat & 15)]; }
      asm volatile("s_waitcnt lgkmcnt(0)" ::: "memory"); }
    float gsm[16]; const float mx = key2f(tk[0] & ~0xff); float den = 0.f;
#pragma unroll
    for (int i = 0; i < 16; ++i) { gsm[i] = __expf(key2f(tk[i] & ~0xff) - mx); den += gsm[i]; }
    const float inv = 1.0f / den;
    if (hi == 0) {
        int* EID = (int*)(ws + WS_EID) + row * 128 + h * 16; float* GW = (float*)(ws + WS_GW) + row * 128 + h * 16;
#pragma unroll
        for (int q = 0; q < 4; ++q) { *(v4u*)(EID + 4 * q) = (v4u){(unsigned)te[4 * q], (unsigned)te[4 * q + 1], (unsigned)te[4 * q + 2], (unsigned)te[4 * q + 3]};
            *(f32x4*)(GW + 4 * q) = (f32x4){gsm[4 * q] * inv, gsm[4 * q + 1] * inv, gsm[4 * q + 2] * inv, gsm[4 * q + 3] * inv}; }
    }
}

typedef float f32x2 __attribute__((ext_vector_type(2)));
__device__ __forceinline__ float dot16_fp8(const v4u u, const f32x2 (&xn)[8]) {
    f32x2 a0 = {0.f, 0.f}, a1 = {0.f, 0.f};
#pragma unroll
    for (int j = 0; j < 4; ++j) { const f32x2 lo = __builtin_amdgcn_cvt_pk_f32_fp8((int)u[j], false), hi = __builtin_amdgcn_cvt_pk_f32_fp8((int)u[j], true);
        a0 = __builtin_elementwise_fma(lo, xn[2 * j], a0); a1 = __builtin_elementwise_fma(hi, xn[2 * j + 1], a1); }
    return (a0.x + a0.y) + (a1.x + a1.y);
}
__device__ __forceinline__ void axpy16_fp8(f32x2 (&acc)[8], const float w, const v4u u) {
    const f32x2 w2 = {w, w};
#pragma unroll
    for (int j = 0; j < 4; ++j) { const f32x2 lo = __builtin_amdgcn_cvt_pk_f32_fp8((int)u[j], false), hi = __builtin_amdgcn_cvt_pk_f32_fp8((int)u[j], true);
        acc[2 * j] = __builtin_elementwise_fma(lo, w2, acc[2 * j]); acc[2 * j + 1] = __builtin_elementwise_fma(hi, w2, acc[2 * j + 1]); }
}
#define TIE_ROW(val, nxt) asm volatile("" : "+v"(val), "+v"((nxt).x), "+v"((nxt).y), "+v"((nxt).z), "+v"((nxt).w))
constexpr int PQ_CHUNK = 128, PQ_NCHUNK = MTOK / PQ_CHUNK;
constexpr int CW_NQ = 10240;
constexpr int CW_PQ = 8192;
__device__ __forceinline__ int pq_pop(unsigned* ctl, int pass, int own, int& q_s, LAS int* bc, int wave) {
    __syncthreads();
    if (wave == 0 && lane_id() == 0) { int res = -1; int s = q_s;
        while (s < 8) { const int x = (own + s) & 7; const unsigned c = __hip_atomic_fetch_add(ctl + CW_PQ + 64 * (8 * pass + x), 1u, __ATOMIC_RELAXED, __HIP_MEMORY_SCOPE_AGENT);
            if (c < (unsigned)PQ_NCHUNK) { res = x * PQ_NCHUNK + (int)c; break; } ++s; }
        bc[0] = res; bc[1] = s; }
    __syncthreads();
    q_s = bc[1]; return bc[0];
}
#define PQ_TICKET(pass_, own_, qs_) (((qs_) < 8 && F.wave == 0 && lane_id() == 0) ? __hip_atomic_fetch_add(ctl + CW_PQ + 64 * (8 * (pass_) + (((own_) + (qs_)) & 7)), 1u, __ATOMIC_RELAXED, __HIP_MEMORY_SCOPE_AGENT) : 0u)
__device__ __forceinline__ int pq_resolve(unsigned* ctl, int pass, int own, int& q_s, unsigned ticket, LAS int* bc, int wave) {
    if (wave == 0 && lane_id() == 0) { int res = -1; int s = q_s;
        if (s < 8) { if (ticket < (unsigned)PQ_NCHUNK) res = ((own + s) & 7) * PQ_NCHUNK + (int)ticket;
                     else { ++s; while (s < 8) { const int x = (own + s) & 7; const unsigned c = __hip_atomic_fetch_add(ctl + CW_PQ + 64 * (8 * pass + x), 1u, __ATOMIC_RELAXED, __HIP_MEMORY_SCOPE_AGENT);
                                if (c < (unsigned)PQ_NCHUNK) { res = x * PQ_NCHUNK + (int)c; break; } ++s; } } }
        bc[0] = res; bc[1] = s; }
    __syncthreads();
    q_s = bc[1]; return bc[0];
}
template <int CTRL> __device__ __forceinline__ float dppf(float v) { return __builtin_bit_cast(float, __builtin_amdgcn_mov_dpp(__builtin_bit_cast(int, v), CTRL, 0xf, 0xf, true)); }
__device__ __forceinline__ float red8(float d) { d += dppf<0xB1>(d); d += dppf<0x4E>(d); d += dppf<0x141>(d); return d; }
__device__ __forceinline__ void peer_issue8(v4u (&rb)[8], const v4u ia, const v4u ib, const unsigned char* T  , unsigned c16) {
    const unsigned e[8] = {ia.x, ia.y, ia.z, ia.w, ib.x, ib.y, ib.z, ib.w};
#pragma unroll
    for (int i = 0; i < 8; ++i) rb[i] = *(const v4u*)(T + (e[i] * 128u + c16));
}
constexpr int PS_ROW = 528, PS_WAVE = 2 * 16 * PS_ROW;
__device__ __forceinline__ void peer_stage16(LAS unsigned char* st, const unsigned char* src  , int lane) {
    v4u e[8];
#pragma unroll
    for (int j = 0; j < 8; ++j) e[j] = __builtin_nontemporal_load((const v4u*)(src + (unsigned)(j * 1024 + lane * 16)));
#pragma unroll
    for (int j = 0; j < 8; ++j) *(LAS v4u*)(st + (2 * j + (lane >> 5)) * PS_ROW + (lane & 31) * 16) = e[j];
}
__device__ __forceinline__ void peer_u_chunk(const Frame& F, const Args& A, LAS unsigned char* lds, int x, int chunk) {
    unsigned char* ws = A.ws; int lane = lane_id(); asm volatile("" : "+v"(lane));
    const int tk = lane >> 3, c8 = lane & 7;
    const unsigned char* U = ws + WS_U8 + (size_t)x * 16384 * 128; const unsigned c16 = 16u * (unsigned)c8;
    LAS unsigned char* st = lds + F.wave * PS_WAVE;
    peer_stage16(st, ws + WS_EID + (size_t)(chunk * PQ_CHUNK + F.wave * 16) * 512, lane);
#pragma unroll 1
    for (int oc = 0; oc < 2; ++oc) {
        const unsigned row = (unsigned)(chunk * PQ_CHUNK + F.wave * 16 + oc * 8 + tk);
        const LAS unsigned char* est = st + (oc * 8 + tk) * PS_ROW;
#define EID_LD(i_) (*(const LAS v4u*)(est + 16 * (i_)))
        f32x2 xn[8];
        { const unsigned char* xb_ = ws + WS_XN; const unsigned xo = row * 2048u + 256u * (unsigned)x + 32u * (unsigned)c8; const v4u xa = *(const v4u*)(xb_ + xo), xb = *(const v4u*)(xb_ + (xo + 16u));
          const unsigned xw[8] = {xa.x, xa.y, xa.z, xa.w, xb.x, xb.y, xb.z, xb.w};
#pragma unroll
          for (int j = 0; j < 8; ++j) { xn[j].x = bflo(xw[j]); xn[j].y = bfhi(xw[j]); } }
        float rstd; { const f32x4* sp = (const f32x4*)(ws + WS_SSQ2 + (size_t)row * 64); const f32x4 a = sp[0], b = sp[1], c = sp[2], d = sp[3];
            rstd = rsqrtf((((a.x + a.y) + (a.z + a.w)) + ((b.x + b.y) + (b.z + b.w)) + ((c.x + c.y) + (c.z + c.w)) + ((d.x + d.y) + (d.z + d.w))) * (1.f / DM) + EPS); }
        unsigned char* ppb = ws + WS_PART; const unsigned po = ((unsigned)x * MTOK + row) * 256u + 32u * (unsigned)c8;
        v4u ra[8], rb[8]; v4u ia0 = EID_LD(0), ia1 = EID_LD(1), ib0 = EID_LD(2), ib1 = EID_LD(3);
        peer_issue8(ra, ia0, ia1, U, c16); ia0 = EID_LD(4); ia1 = EID_LD(5);
#pragma unroll 1
        for (int q = 0; q < 16; q += 2) {
            peer_issue8(rb, ib0, ib1, U, c16); { const int qn = (q + 3 < 16) ? q + 3 : 15; ib0 = EID_LD(2 * qn); ib1 = EID_LD(2 * qn + 1); }
            float k0 = 0.f, k1 = 0.f;
#pragma unroll
            for (int i = 0; i < 8; ++i) { float d = dot16_fp8(ra[i], xn); if (i < 7) TIE_ROW(d, ra[i + 1]); d = red8(d); k0 = (c8 == i) ? d : k0; }
            peer_issue8(ra, ia0, ia1, U, c16); { const int qn = (q + 4 < 16) ? q + 4 : 15; ia0 = EID_LD(2 * qn); ia1 = EID_LD(2 * qn + 1); }
#pragma unroll
            for (int i = 0; i < 8; ++i) { float d = dot16_fp8(rb[i], xn); if (i < 7) TIE_ROW(d, rb[i + 1]); d = red8(d); k1 = (c8 == i) ? d : k1; }
            *(unsigned*)(ppb + (po + 2u * (unsigned)q)) = pk2(k0 * rstd, k1 * rstd);
        }
    }
}
__device__ __forceinline__ void peer_w_rows(const Frame& F, const Args& A) {
    unsigned char* ws = A.ws; const int lane = lane_id();
    const float* SU = (const float*)(ws + WS_SU); const float* SV = (const float*)(ws + WS_SV);
    const int p0 = 2 * lane, k0 = 8 * (p0 & 15) + (p0 >> 4), k1 = k0 + 8;
    for (int m0 = F.gw; m0 < MTOK; m0 += 4 * F.NGW) {
        int e0[4], e1[4]; float g0[4], g1[4]; unsigned pw[4][8];
#pragma unroll
        for (int r = 0; r < 4; ++r) { const size_t row = (size_t)(m0 + r * F.NGW < MTOK ? m0 + r * F.NGW : m0);
            const int* EID = (const int*)(ws + WS_EID) + row * 128; const float* GW = (const float*)(ws + WS_GW) + row * 128;
            e0[r] = EID[k0]; e1[r] = EID[k1]; g0[r] = GW[k0]; g1[r] = GW[k1];
#pragma unroll
            for (int x = 0; x < 8; ++x) pw[r][x] = *(const unsigned*)((const bf16*)(ws + WS_PART) + ((size_t)x * MTOK + row) * 128 + p0); }
        float su0[4], su1[4], sv0[4], sv1[4];
#pragma unroll
        for (int r = 0; r < 4; ++r) { su0[r] = SU[e0[r]]; su1[r] = SU[e1[r]]; sv0[r] = SV[e0[r]]; sv1[r] = SV[e1[r]]; }
#pragma unroll
        for (int r = 0; r < 4; ++r) { if (m0 + r * F.NGW < MTOK) { const size_t row = (size_t)(m0 + r * F.NGW); float s0 = 0.f, s1 = 0.f;
#pragma unroll
            for (int x = 0; x < 8; ++x) { s0 += bflo(pw[r][x]); s1 += bfhi(pw[r][x]); }
            float* W = (float*)(ws + WS_W) + row * 128;
            W[k0] = gelu_tanh(s0 * su0[r]) * g0[r] * sv0[r]; W[k1] = gelu_tanh(s1 * su1[r]) * g1[r] * sv1[r]; } }
    }
}
__device__ __forceinline__ void peer_v_chunk(const Frame& F, const Args& A, LAS unsigned char* lds, int x, int chunk) {
    unsigned char* ws = A.ws; int lane = lane_id(); asm volatile("" : "+v"(lane));
    const int tk = lane >> 3, c8 = lane & 7;
    const unsigned char* V = ws + WS_V8 + (size_t)x * 16384 * 128; const unsigned c16 = 16u * (unsigned)c8;
    LAS unsigned char* st = lds + F.wave * PS_WAVE;
    peer_stage16(st, ws + WS_EID + (size_t)(chunk * PQ_CHUNK + F.wave * 16) * 512, lane);
    peer_stage16(st + 16 * PS_ROW, ws + WS_W + (size_t)(chunk * PQ_CHUNK + F.wave * 16) * 512, lane);
#pragma unroll 1
    for (int oc = 0; oc < 2; ++oc) {
        const unsigned row = (unsigned)(chunk * PQ_CHUNK + F.wave * 16 + oc * 8 + tk);
        const LAS unsigned char* est = st + (oc * 8 + tk) * PS_ROW;
#define W_LD(i_) (*(const LAS f32x4*)(est + 16 * PS_ROW + 16 * (i_)))
        f32x2 acc[8];
#pragma unroll
        for (int j = 0; j < 8; ++j) acc[j] = (f32x2){0.f, 0.f};
        v4u ra[8], rb[8]; v4u ia0 = EID_LD(0), ia1 = EID_LD(1), ib0 = EID_LD(2), ib1 = EID_LD(3); f32x4 wa0 = W_LD(0), wa1 = W_LD(1), wb0 = W_LD(2), wb1 = W_LD(3);
        peer_issue8(ra, ia0, ia1, V, c16); ia0 = EID_LD(4); ia1 = EID_LD(5);
#pragma unroll 1
        for (int q = 0; q < 16; q += 2) {
            peer_issue8(rb, ib0, ib1, V, c16); { const int qn = (q + 3 < 16) ? q + 3 : 15; ib0 = EID_LD(2 * qn); ib1 = EID_LD(2 * qn + 1); }
            { const float wv[8] = {wa0.x, wa0.y, wa0.z, wa0.w, wa1.x, wa1.y, wa1.z, wa1.w};
#pragma unroll
              for (int i = 0; i < 8; ++i) { axpy16_fp8(acc, wv[i], ra[i]); if (i < 7) TIE_ROW(acc[7].y, ra[i + 1]); } }
            { const int qn = (q + 2 < 16) ? q + 2 : 15; wa0 = W_LD(2 * qn); wa1 = W_LD(2 * qn + 1); }
            peer_issue8(ra, ia0, ia1, V, c16); { const int qn = (q + 4 < 16) ? q + 4 : 15; ia0 = EID_LD(2 * qn); ia1 = EID_LD(2 * qn + 1); }
            { const float wv[8] = {wb0.x, wb0.y, wb0.z, wb0.w, wb1.x, wb1.y, wb1.z, wb1.w};
#pragma unroll
              for (int i = 0; i < 8; ++i) { axpy16_fp8(acc, wv[i], rb[i]); if (i < 7) TIE_ROW(acc[7].y, rb[i + 1]); } }
            { const int qn = (q + 3 < 16) ? q + 3 : 15; wb0 = W_LD(2 * qn); wb1 = W_LD(2 * qn + 1); }
        }
        unsigned char* xr = ws + WS_XN + (row * 2048u + 256u * (unsigned)x + 32u * (unsigned)c8); float ss = 0.f;
        const v4u x2a = *(const v4u*)xr, x2b = *(const v4u*)(xr + 16);
        const unsigned xw[8] = {x2a.x, x2a.y, x2a.z, x2a.w, x2b.x, x2b.y, x2b.z, x2b.w};
        unsigned ow[8];
#pragma unroll
        for (int j = 0; j < 4; ++j) { f32x4 v; v.x = bflo(xw[2 * j]) + acc[2 * j].x; v.y = bfhi(xw[2 * j]) + acc[2 * j].y; v.z = bflo(xw[2 * j + 1]) + acc[2 * j + 1].x; v.w = bfhi(xw[2 * j + 1]) + acc[2 * j + 1].y;
            ss += (v.x * v.x + v.y * v.y) + (v.z * v.z + v.w * v.w); ow[2 * j] = pk2(v.x, v.y); ow[2 * j + 1] = pk2(v.z, v.w); }
        *(v4u*)xr = (v4u){ow[0], ow[1], ow[2], ow[3]}; *(v4u*)(xr + 16) = (v4u){ow[4], ow[5], ow[6], ow[7]};
        ss = red8(ss);
        if (c8 == 0) ((float*)(ws + WS_SSQ3))[row * 8 + x] = ss;
    }
#undef W_LD
#undef EID_LD
}
__device__ __forceinline__ void peer_final_rows(const Frame& F, const Args& A) {
    unsigned char* ws = A.ws; const int lane = lane_id(); const float* g = A.in[32];
    for (int m = F.gw; m < MTOK; m += F.NGW) {
        const f32x4 sa = *(const f32x4*)((const float*)(ws + WS_SSQ3) + (size_t)m * 8), sb = *(const f32x4*)((const float*)(ws + WS_SSQ3) + (size_t)m * 8 + 4);
        const float rstd = rsqrtf((((sa.x + sa.y) + (sa.z + sa.w)) + ((sb.x + sb.y) + (sb.z + sb.w))) * (1.f / DM) + EPS);
        f32x4* xr = (f32x4*)(A.out + (size_t)m * DM) + lane; const v2u* xb = (const v2u*)((const bf16*)(ws + WS_XN) + (size_t)m * DM) + lane;
#pragma unroll
        for (int j = 0; j < 4; ++j) { const v2u w = xb[64 * j]; const f32x4 gg = ((const f32x4*)g)[lane + 64 * j]; const f32x4 v = {bflo(w.x), bfhi(w.x), bflo(w.y), bfhi(w.y)}; __builtin_nontemporal_store(v * rstd * gg, xr + 64 * j); }
    }
}

typedef GAS unsigned gu32;
#define RLX_AGENT __ATOMIC_RELAXED, __HIP_MEMORY_SCOPE_AGENT
#define XB_TMO      128
#define XB_XCNT(j)  (256  + 64 * (j))
#define XB_XSUB(j)  (1280 + 64 * (j))
#define XB_XGEN(j)  (2304 + 64 * (j))
#define XB_TOP      3328
#define XB_TOPGEN   3392
#define XCD_BAR_WORDS 3456
#define XB_SPIN_CAP (1u << 18)

__device__ __forceinline__ unsigned xb_ld(unsigned* p)              { return __hip_atomic_load(p, __ATOMIC_RELAXED, __HIP_MEMORY_SCOPE_AGENT); }
__device__ __forceinline__ unsigned xb_add(unsigned* p, unsigned v) { return __hip_atomic_fetch_add(p, v, __ATOMIC_RELAXED, __HIP_MEMORY_SCOPE_AGENT); }
__device__ __forceinline__ unsigned xb_xcc_id() { return (unsigned)__builtin_amdgcn_s_getreg((3 << 11) | 20) & 0xFu; }
#define XB_SPIN(cond, bar) do { unsigned _sp = 0; while (cond) { __builtin_amdgcn_s_sleep(1); \
    if ((++_sp & 255u) == 0u) { if (xb_ld(&(bar)[XB_TMO])) break; if (_sp > XB_SPIN_CAP) { atomicAdd(&(bar)[XB_TMO], 1u); break; } } } } while (0)

struct XcdBarrier {
    unsigned* bar; unsigned x;
    volatile LAS unsigned* st;
};

__device__ __forceinline__ XcdBarrier xcd_barrier_post(unsigned* bar, volatile LAS unsigned* st) {
    XcdBarrier b; b.bar = bar; b.x = xb_xcc_id(); b.st = st;
    if (threadIdx.x == 0) (void)xb_add(&bar[XB_XCNT(b.x)], 1u);
    return b;
}
__device__ __forceinline__ void xcd_barrier_complete(unsigned* bar, unsigned x, unsigned& nloc, unsigned& nx) {
    const unsigned G = gridDim.x * gridDim.y * gridDim.z;
    unsigned sum, cnt, mine, sp = 0u;
    for (;;) {
        sum = 0u; cnt = 0u; mine = 0u;
#pragma unroll
        for (unsigned j = 0; j < 16; ++j) { const unsigned c = xb_ld(&bar[XB_XCNT(j)]); sum += c; cnt += (c > 0u) ? 1u : 0u; mine = (j == x) ? c : mine; }
        if (sum == G) break;
        __builtin_amdgcn_s_sleep(1);
        if ((++sp & 255u) == 0u) { if (xb_ld(&bar[XB_TMO])) break; if (sp > XB_SPIN_CAP) { atomicAdd(&bar[XB_TMO], 1u); break; } }
    }
    nloc = mine > 0u ? mine : 1u; nx = cnt > 0u ? cnt : 1u;
}

__device__ __forceinline__ void xcd_barrier(const XcdBarrier& b) {
    asm volatile("s_waitcnt vmcnt(0)" ::: "memory");
    __syncthreads();
    if (threadIdx.x == 0) {
        unsigned* bar = b.bar;
        __builtin_amdgcn_s_waitcnt(0);
        unsigned nloc = b.st[0], nx = b.st[1];
        if (nloc == 0u) { xcd_barrier_complete(bar, b.x, nloc, nx); b.st[0] = nloc; b.st[1] = nx; }
        const unsigned old = xb_add(&bar[XB_XSUB(b.x)], 1u);
        const unsigned gen = old / nloc;
        if (old + 1u == (gen + 1u) * nloc) {
            __builtin_amdgcn_fence(__ATOMIC_RELEASE, "agent");
            asm volatile("s_waitcnt vmcnt(0)" ::: "memory");
            const unsigned og = xb_add(&bar[XB_TOP], 1u);
            const unsigned tg = og / nx;
            if (og + 1u == (tg + 1u) * nx) xb_add(&bar[XB_TOPGEN], 1u);
            else XB_SPIN(xb_ld(&bar[XB_TOPGEN]) == tg, bar);
            __builtin_amdgcn_fence(__ATOMIC_ACQUIRE, "agent");
            xb_add(&bar[XB_XGEN(b.x)], 1u);
            asm volatile("s_waitcnt vmcnt(0)" ::: "memory");
        } else {
            XB_SPIN(xb_ld(&bar[XB_XGEN(b.x)]) == gen, bar);
            __builtin_amdgcn_fence(__ATOMIC_ACQUIRE, "agent");
            asm volatile("s_waitcnt vmcnt(0)" ::: "memory");
        }
    }
    __syncthreads();
}

#ifndef DBL_MASK
#define DBL_MASK 0
#endif
constexpr int NPHASE = 12;
__global__ void __launch_bounds__(512, 2) fwd_kernel(Args args) {
    extern __shared__ __attribute__((aligned(16))) unsigned char lds_raw[];
    LAS unsigned char* lds = (LAS unsigned char*)lds_raw;
    Frame F;
    F.tid = threadIdx.x; F.lane = F.tid & 63; F.wave = __builtin_amdgcn_readfirstlane(F.tid >> 6);
    F.G = gridDim.x; { const int bx = blockIdx.x; F.vcu = (F.G % 8 == 0) ? (bx % 8) * (F.G / 8) + bx / 8 : bx; }
    F.gw = F.vcu * 8 + F.wave; F.NGW = F.G * 8;
    unsigned char* ws = args.ws;
    const int lo = args.ph_lo, hi = args.ph_hi;
    volatile LAS unsigned* MISC = (volatile LAS unsigned*)(lds + LDS_BYTES - 64);
    if (F.tid < 16) MISC[F.tid] = 0u;
    __syncthreads();
    XcdBarrier bar = xcd_barrier_post((unsigned*)(ws + WS_CTL), MISC);
#define IN(k) (lo <= (k) && (k) < hi)
#define SEAM(k) do { if (IN(k) && IN((k) + 1)) xcd_barrier(bar); } while (0)

    if (IN(0)) for (int rep_ = 0; rep_ <= ((DBL_MASK >> 0) & 1); ++rep_) { if (rep_) xcd_barrier(bar); REFRESH_LANE(F); p0_prologue(F, args, lds); }
    SEAM(0);
    if (IN(1)) for (int rep_ = 0; rep_ <= ((DBL_MASK >> 1) & 1); ++rep_) { if (rep_) xcd_barrier(bar); REFRESH_LANE(F);
        { pg8::Gemm g{(const bf16*)(ws + WS_XN), (const bf16*)(ws + WS_WIN), MTOK, NZP, DM}; pg8::StaticOrder S; S.init(MTOK, NZP, F.G, (int)blockIdx.x);
          pg8::EpiZ E{(bf16*)(ws + WS_Z), (bf16*)(ws + WS_KSF), (bf16*)(ws + WS_VSF), (bf16*)(ws + WS_KWF), (bf16*)(ws + WS_VWF), (float*)(ws + WS_GATES), args.in[4]};
          pg8::gemm_phase<pg8::EpiZ, pg8::StaticOrder, true, true>(lds, g, S, E, F.wave); }
        { pg8::Gemm g{(const bf16*)(ws + WS_MEMN), (const bf16*)(ws + WS_WMK), NB * NMEM, DM, DM}; pg8::StaticOrder S; S.init(NB * NMEM, DM, F.G, ((int)blockIdx.x + 128) & 255);
          pg8::EpiStore E{(bf16*)(ws + WS_MEMK), DM, nullptr, 1};
          pg8::gemm_phase<pg8::EpiStore, pg8::StaticOrder, true, true>(lds, g, S, E, F.wave); }
        { pg8::Gemm g{(const bf16*)(ws + WS_WMV), (const bf16*)(ws + WS_MEMN), DM, NB * NMEM, DM}; pg8::StaticOrder S; S.init(DM, NB * NMEM, F.G, ((int)blockIdx.x + 120) & 255);
          pg8::EpiVFrag E{(bf16*)(ws + WS_MEMVT)};
          pg8::gemm_phase<pg8::EpiVFrag, pg8::StaticOrder, true, true>(lds, g, S, E, F.wave); }
    }
    SEAM(1);
    if (IN(2)) for (int rep_ = 0; rep_ <= ((DBL_MASK >> 2) & 1); ++rep_) { if (rep_) xcd_barrier(bar); REFRESH_LANE(F); for (int it = F.gw; it < 2048; it += F.NGW) kmax_item(F, args, it);
                 for (int it = F.vcu; it < 256; it += F.G) lru_local_item(F, args, lds, it);
                 for (int it = F.G - 1 - F.vcu; it < 128; it += F.G) compress_item(F, args, lds, it); }
    SEAM(2);
    if (IN(3)) for (int rep_ = 0; rep_ <= ((DBL_MASK >> 3) & 1); ++rep_) { if (rep_) xcd_barrier(bar); REFRESH_LANE(F);
                 { unsigned* ctl = (unsigned*)(ws + WS_CTL); const int own = (int)(((long)F.vcu * 8) / F.G) & 7; int qs = 0;
                   for (;;) { int id = -1;
                       if (lane_id() == 0) { while (qs < 8) { const int x = (own + qs) & 7; const unsigned c = __hip_atomic_fetch_add(ctl + CW_NQ + 64 * x, 1u, __ATOMIC_RELAXED, __HIP_MEMORY_SCOPE_AGENT);
                               if (c < 512u) { id = x * 512 + (int)c; break; } ++qs; } }
                       id = __builtin_amdgcn_readfirstlane(id); qs = __builtin_amdgcn_readfirstlane(qs);
                       if (id < 0) break;
                       if (F.G == 256) { quant_rows4_fp8(args.in[31] + (size_t)id * DM, (size_t)4096 * DM, nullptr, ws + WS_V8 + (size_t)id * 128, (float*)(ws + WS_SV) + id, 4096, lane_id());
 }
                       const int x = id >> 9, i = id & 511; nsa_item(F, args, lds, x >> 2, (x >> 1) & 1, 2 * (63 - (i >> 3)) + (x & 1), 7 - (i & 7)); } }
                 __syncthreads(); REFRESH_LANE(F);
                 for (int it = F.vcu; it < 256; it += F.G) lru_fix_item(F, args, lds, it, false); }
    SEAM(3);
    if (IN(4)) for (int rep_ = 0; rep_ <= ((DBL_MASK >> 4) & 1); ++rep_) { if (rep_) xcd_barrier(bar); REFRESH_LANE(F);
        pg8::Gemm g{(const bf16*)(ws + WS_Y), (const bf16*)(ws + WS_WOUT), MTOK, DM, DM}; pg8::StaticOrder S; S.init(MTOK, DM, F.G, (int)blockIdx.x);
        pg8::EpiRes<true> E{args.in[0], nullptr, nullptr, (bf16*)(ws + WS_XN), (float*)(ws + WS_SSQ1), (const float*)(ws + WS_SSQN)};
        pg8::gemm_phase<pg8::EpiRes<true>, pg8::StaticOrder, true, true>(lds, g, S, E, F.wave);
    }
    SEAM(4);
    if (IN(5)) for (int rep_ = 0; rep_ <= ((DBL_MASK >> 5) & 1); ++rep_) { if (rep_) xcd_barrier(bar); REFRESH_LANE(F);
        pg8::Gemm g{(const bf16*)(ws + WS_XN), (const bf16*)(ws + WS_WMQ), MTOK, DM, DM}; pg8::StaticOrder S; S.init(MTOK, DM, F.G, (int)blockIdx.x);
        pg8::EpiStore E{(bf16*)(ws + WS_QM), DM, (const float*)(ws + WS_SSQ1), 1};
        pg8::gemm_phase<pg8::EpiStore, pg8::StaticOrder, true, true>(lds, g, S, E, F.wave);
    }
    SEAM(5);
    if (IN(6)) for (int rep_ = 0; rep_ <= ((DBL_MASK >> 6) & 1); ++rep_) { if (rep_) xcd_barrier(bar); REFRESH_LANE(F); for (int it = F.vcu; it < 256; it += F.G) memattn_block(F, args, lds, it); }
    SEAM(6);
    if (IN(7)) for (int rep_ = 0; rep_ <= ((DBL_MASK >> 7) & 1); ++rep_) { if (rep_) xcd_barrier(bar); REFRESH_LANE(F);
        pg8::Gemm g{(const bf16*)(ws + WS_OM), (const bf16*)(ws + WS_WMO), MTOK, DM, DM}; pg8::StaticOrder S; S.init(MTOK, DM, F.G, (int)blockIdx.x);
        pg8::EpiRes<false> E{nullptr, (const bf16*)(ws + WS_XN), nullptr, (bf16*)(ws + WS_XN), (float*)(ws + WS_SSQ2), nullptr};
        pg8::gemm_phase<pg8::EpiRes<false>, pg8::StaticOrder, true, true>(lds, g, S, E, F.wave);
    }
    SEAM(7);
    if (IN(8)) for (int rep_ = 0; rep_ <= ((DBL_MASK >> 8) & 1); ++rep_) { if (rep_) xcd_barrier(bar); REFRESH_LANE(F);
        pg8::Gemm g{(const bf16*)(ws + WS_XN), (const bf16*)(ws + WS_WPQ), MTOK, 2048, DM}; pg8::StaticOrder S; S.init(MTOK, 2048, F.G, (int)blockIdx.x);
        pg8::EpiStore E{(bf16*)(ws + WS_QP), 2048, (const float*)(ws + WS_SSQ2), 1};
        pg8::gemm_phase<pg8::EpiStore, pg8::StaticOrder, true, true>(lds, g, S, E, F.wave);
    }
    SEAM(8);
    if (IN(9)) for (int rep_ = 0; rep_ <= ((DBL_MASK >> 9) & 1); ++rep_) { if (rep_) xcd_barrier(bar); REFRESH_LANE(F); for (int gi = F.vcu; gi < 256; gi += F.G) {
                     const int h = gi & 7, tgp = gi >> 3;
                     { const v4u* src = (const v4u*)((const bf16*)(ws + WS_SKEY) + (size_t)h * 8 * 4096); const int tid = F.wave * 64 + lane_id();
#pragma unroll
                       for (int i = 0; i < 8; ++i) ((LAS v4u*)lds)[tid + 512 * i] = src[tid + 512 * i]; }
                     __syncthreads();
                     peer_topk_item<true>(F, args, (tgp * 16 + F.wave) * 8 + h, lds); peer_topk_item<true>(F, args, (tgp * 16 + 8 + F.wave) * 8 + h, lds);
                     __syncthreads(); } }
    SEAM(9);
    if (IN(10)) {   REFRESH_LANE(F);
        LAS int* bc = (LAS int*)(lds + LDS_BYTES - 128); unsigned* ctl = (unsigned*)(ws + WS_CTL); const int own = (int)(bar.x & 7u);
        { int qs = 0; int id = __builtin_amdgcn_readfirstlane(pq_pop(ctl, 0, own, qs, bc, F.wave)); int par = 0;
          while (id >= 0) { const unsigned tk_ = PQ_TICKET(0, own, qs); peer_u_chunk(F, args, lds, id / PQ_NCHUNK, id % PQ_NCHUNK); par ^= 2; id = __builtin_amdgcn_readfirstlane(pq_resolve(ctl, 0, own, qs, tk_, bc + par, F.wave)); } }
        xcd_barrier(bar);
        peer_w_rows(F, args);
        xcd_barrier(bar);
        { int qs = 0; int id = __builtin_amdgcn_readfirstlane(pq_pop(ctl, 1, own, qs, bc, F.wave)); int par = 0;
          while (id >= 0) { const unsigned tk_ = PQ_TICKET(1, own, qs); peer_v_chunk(F, args, lds, id / PQ_NCHUNK, id % PQ_NCHUNK); par ^= 2; id = __builtin_amdgcn_readfirstlane(pq_resolve(ctl, 1, own, qs, tk_, bc + par, F.wave)); } }
        xcd_barrier(bar);
        peer_final_rows(F, args);
    }
#undef IN
#undef SEAM
}

extern "C" void kernel_launch(void* const* d_in, const int* in_sizes, int n_in, void* d_out, int out_size, void* d_ws, size_t ws_size, hipStream_t stream) {
    static int grid = 0;
    if (grid == 0) {
        if (n_in != 33 || out_size != MTOK * DM || ws_size < WS_END) { fprintf(stderr, "kernel_launch: unexpected problem (n_in %d, out %d, ws %zu)\n", n_in, out_size, ws_size); grid = -1; return; }
        int dev = 0, cus = 0, per_cu = 0;
        (void)hipGetDevice(&dev); (void)hipDeviceGetAttribute(&cus, hipDeviceAttributeMultiprocessorCount, dev);
        (void)hipFuncSetAttribute((const void*)fwd_kernel, hipFuncAttributeMaxDynamicSharedMemorySize, LDS_BYTES);
        (void)hipOccupancyMaxActiveBlocksPerMultiprocessor(&per_cu, (const void*)fwd_kernel, 512, LDS_BYTES);
        if (per_cu < 1) { fprintf(stderr, "kernel_launch: occupancy query says %d blocks per CU\n", per_cu); per_cu = 1; }
        grid = cus * 1;
        if (grid != 256) fprintf(stderr, "kernel_launch: %d CUs (built for 256)\n", cus);
    }
    if (grid < 0) return;
    (void)hipMemsetAsync((char*)d_ws + WS_CTL, 0, 65536, stream);
    Args a{};
    for (int i = 0; i < 33; ++i) a.in[i] = (const float*)d_in[i];
    a.out = (float*)d_out; a.ws = (unsigned char*)d_ws; a.ph_lo = 0; a.ph_hi = NPHASE;
    void* kargs[] = {&a};
    hipError_t e = hipLaunchCooperativeKernel((const void*)fwd_kernel, dim3(grid), dim3(512), kargs, LDS_BYTES, stream);
    if (e != hipSuccess) fprintf(stderr, "cooperative launch failed: %s (grid %d)\n", hipGetErrorString(e), grid);
}
```

```cpp
#include <hip/hip_runtime.h>
#include <cstdio>
#include <cstdint>

namespace pg8 {
#define PG8_LAS __attribute__((address_space(3)))
typedef unsigned short bf16_t;
typedef short bf16x8 __attribute__((ext_vector_type(8)));
typedef float f32x4 __attribute__((ext_vector_type(4)));
typedef unsigned u32x4 __attribute__((ext_vector_type(4)));
constexpr int BM = 256, BK = 64, HALF = 128, HTB = HALF * BK * 2  , STAGE_BYTES = 8 * HTB, NXCD = 8, WGM = 8;

__host__ __device__ __forceinline__ int lds_byte(int r, int c) { const int st = (r >> 4) * 2 + (c >> 5), rr = r & 15, cc = c & 31, ob = rr * 64 + cc * 2; return st * 1024 + (ob ^ (((ob >> 9) & 1) << 5)); }
__host__ __device__ __forceinline__ void stage_rc(int b, int& R, int& C) { const int st = b / 1024, sb = b % 1024, swz = sb ^ (((sb >> 9) & 1) << 5); R = (st >> 1) * 16 + swz / 64; C = (st & 1) * 32 + (swz % 64) / 2; }
__host__ __device__ __forceinline__ int perm32(int rho) { const int n = rho >> 4, i = rho & 15; return 8 * (i >> 2) + 4 * n + (i & 3); }

struct Unit { int pm, pn; };
struct Gemm { const bf16_t* A; const bf16_t* Bt; int M, N, K; };

struct StaticOrder {
    int nM, nN, nwg, G, c;
    __host__ __device__ void init(int M, int N, int G_, int c_) { nM = M / BM; nN = N / BM; nwg = nM * nN; G = G_; c = c_; }
    __host__ __device__ bool next(int i, Unit& u) const {
        const long L = (long)i * G + c; if (L >= nwg) return false;
        int wgid = (int)L; { const int q = nwg / NXCD, r = nwg % NXCD, xcd = wgid % NXCD, off = wgid / NXCD; wgid = (xcd < r ? xcd * (q + 1) : r * (q + 1) + (xcd - r) * q) + off; }
        const int nig = WGM * nN, gid = wgid / nig, fm = gid * WGM, gsz = (nM - fm) < WGM ? (nM - fm) : WGM;
        u.pm = fm + ((wgid % nig) % gsz); u.pn = (wgid % nig) / gsz; return true;
    }
    __device__ __forceinline__ void a_ready(const Unit&) const {}
    __device__ __forceinline__ void done(const Unit&) const {}
};

__device__ __forceinline__ unsigned cvt_pk_bf16(float lo, float hi) { unsigned r; asm volatile("v_cvt_pk_bf16_f32 %0, %1, %2" : "=v"(r) : "v"(lo), "v"(hi)); return r; }
typedef float f32x2 __attribute__((ext_vector_type(2)));
typedef unsigned u32x2 __attribute__((ext_vector_type(2)));
__device__ __forceinline__ unsigned short f2bf1(float f) { unsigned u = __builtin_bit_cast(unsigned, f); return (unsigned short)((u + 0x7fffu + ((u >> 16) & 1u)) >> 16); }
struct EpiZ {
    static constexpr bool PERM = true, AFTER_DRAIN = false, MIDSCALE = false;
    bf16_t* Z; bf16_t* KSF; bf16_t* VSF; bf16_t* KWF; bf16_t* VWF; float* GATES; const float* bgate;
    __device__ __forceinline__ void operator()(const f32x4 (&acc)[2][2][4][2], const Unit& u, int wr, int wc, int fr, int fq) const {
        const int row0 = u.pm * BM + wr * 64 + fr;
        if (u.pn < 9) {
            const int col0 = u.pn * BM + wc * 32 + 8 * fq;
#pragma unroll
            for (int ai = 0; ai < 2; ++ai)
#pragma unroll
                for (int m = 0; m < 4; ++m) { bf16_t* rowp = Z + (size_t)(row0 + ai * HALF + m * 16) * 2304 + col0;
#pragma unroll
                    for (int bj = 0; bj < 2; ++bj) { const f32x4 v0 = acc[ai][bj][m][0], v1 = acc[ai][bj][m][1];
                        u32x4 w; w.x = cvt_pk_bf16(v0[0], v0[1]); w.y = cvt_pk_bf16(v0[2], v0[3]); w.z = cvt_pk_bf16(v1[0], v1[1]); w.w = cvt_pk_bf16(v1[2], v1[3]);
                        *(u32x4*)(rowp + bj * HALF) = w; } }
            if (u.pn >= 7) {
                bf16_t* KF = (u.pn == 7) ? KSF : KWF; bf16_t* VF = (u.pn == 7) ? VSF : VWF;
                const int kvh = wc >> 1, dbase = 32 * (wc & 1) + 8 * fq;
#pragma unroll
                for (int ai = 0; ai < 2; ++ai)
#pragma unroll
                    for (int m = 0; m < 4; ++m) { const int row = row0 + ai * HALF + m * 16, b = row >> 13, s = row & 8191, tile = s >> 5, k = s & 31;
                        const size_t tb = ((size_t)(b * 2 + kvh) * 256 + tile) * 2048;
                        { const f32x4 v0 = acc[ai][0][m][0], v1 = acc[ai][0][m][1];
                          u32x4 w; w.x = cvt_pk_bf16(v0[0], v0[1]); w.y = cvt_pk_bf16(v0[2], v0[3]); w.z = cvt_pk_bf16(v1[0], v1[1]); w.w = cvt_pk_bf16(v1[2], v1[3]);
                          *(u32x4*)(KF + tb + (dbase >> 4) * 512 + ((dbase >> 3) & 1) * 256 + k * 8) = w; }
                        const int kk = k & 15, vo = ((kk >> 2) & 1) * 512 + (k >> 4) * 8 + (kk & 3) + 4 * (kk >> 3);
                        unsigned char* V8 = (unsigned char*)VF + ((size_t)(b * 2 + kvh) * 256 + tile) * 2048;
#pragma unroll
                        for (int n = 0; n < 2; ++n) { const f32x4 v = acc[ai][1][m][n]; int w = 0; w = __builtin_amdgcn_cvt_pk_fp8_f32(v[0], v[1], w, false); w = __builtin_amdgcn_cvt_pk_fp8_f32(v[2], v[3], w, true);
#pragma unroll
                            for (int e = 0; e < 4; ++e) { const int d = dbase + 4 * n + e; V8[(d >> 5) * 1024 + (d & 31) * 16 + vo] = (unsigned char)((unsigned)w >> (8 * e)); } }
                        asm volatile("" ::: "memory"); }
            }
        } else {
            if (wc == 0 && fq < 3) {
#pragma unroll
                for (int ai = 0; ai < 2; ++ai)
#pragma unroll
                    for (int m = 0; m < 4; ++m) { const int row = row0 + ai * HALF + m * 16;
#pragma unroll
                        for (int n = 0; n < 2; ++n)
#pragma unroll
                            for (int e = 0; e < 4; ++e) { const int c = 8 * fq + 4 * n + e; const float v = acc[ai][0][m][n][e] + bgate[c]; GATES[(size_t)row * 24 + c] = 1.0f / (1.0f + __expf(-v)); } }
            }
        }
    }
};
struct EpiStore {
    static constexpr bool PERM = true, AFTER_DRAIN = false, MIDSCALE = false;
    bf16_t* O; int ldc; const float* ssq; int frag;
    __device__ __forceinline__ void operator()(const f32x4 (&acc)[2][2][4][2], const Unit& u, int wr, int wc, int fr, int fq) const {
        const int row0 = u.pm * BM + wr * 64 + fr; const int col0 = u.pn * BM + wc * 32 + 8 * fq;
#pragma unroll
        for (int ai = 0; ai < 2; ++ai)
#pragma unroll
            for (int m = 0; m < 4; ++m) { const int row = row0 + ai * HALF + m * 16;
                bf16_t* rowp = frag ? O + (size_t)(row >> 5) * 32 * ldc + (size_t)(col0 >> 4) * 512 + ((col0 >> 3) & 1) * 256 + (row & 31) * 8 : O + (size_t)row * ldc + col0;
                const int bjstep = frag ? (HALF >> 4) * 512 : HALF;
                float sc = 1.f;
                if (ssq) { const f32x4* p = (const f32x4*)(ssq + (size_t)row * 16); const f32x4 a = p[0], b = p[1], c = p[2], d = p[3];
                    const float s = ((a[0] + a[1]) + (a[2] + a[3])) + ((b[0] + b[1]) + (b[2] + b[3])) + ((c[0] + c[1]) + (c[2] + c[3])) + ((d[0] + d[1]) + (d[2] + d[3]));
                    sc = rsqrtf(s * (1.0f / 1024.0f) + 1e-6f); }
#pragma unroll
                for (int bj = 0; bj < 2; ++bj) { const f32x4 v0 = acc[ai][bj][m][0] * sc, v1 = acc[ai][bj][m][1] * sc;
                    u32x4 w; w.x = cvt_pk_bf16(v0[0], v0[1]); w.y = cvt_pk_bf16(v0[2], v0[3]); w.z = cvt_pk_bf16(v1[0], v1[1]); w.w = cvt_pk_bf16(v1[2], v1[3]);
                    *(u32x4*)(rowp + bj * bjstep) = w; } }
    }
};
struct EpiVFrag {
    static constexpr bool PERM = true, AFTER_DRAIN = false, MIDSCALE = false;
    bf16_t* O;
    __device__ __forceinline__ void operator()(const f32x4 (&acc)[2][2][4][2], const Unit& u, int wr, int wc, int fr, int fq) const {
        const int row0 = u.pm * BM + wr * 64 + fr; const int col0 = u.pn * BM + wc * 32 + 8 * fq;
#pragma unroll
        for (int ai = 0; ai < 2; ++ai)
#pragma unroll
            for (int m = 0; m < 4; ++m) { const int D = row0 + ai * HALF + m * 16, h = D >> 8, dt = (D >> 5) & 7, r = D & 31;
#pragma unroll
                for (int bj = 0; bj < 2; ++bj) { const int K0 = col0 + bj * HALF, b = K0 >> 8, kt = (K0 >> 5) & 7, k0 = K0 & 31;
                    bf16_t* p = O + (size_t)((b * 4 + h) * 8 + kt) * 8192 + dt * 1024 + (k0 >> 4) * 512 + r * 8 + 4 * ((k0 >> 3) & 1);
                    const f32x4 v0 = acc[ai][bj][m][0], v1 = acc[ai][bj][m][1];
                    u32x2 w0, w1; w0.x = cvt_pk_bf16(v0[0], v0[1]); w0.y = cvt_pk_bf16(v0[2], v0[3]); w1.x = cvt_pk_bf16(v1[0], v1[1]); w1.y = cvt_pk_bf16(v1[2], v1[3]);
                    *(u32x2*)p = w0; *(u32x2*)(p + 256) = w1; } }
    }
};
template <bool MID> struct EpiRes {
    static constexpr bool PERM = false, AFTER_DRAIN = false, MIDSCALE = MID;
    const float* base; const bf16_t* base16; float* out; bf16_t* XB; float* ssq; const float* ssqn;
    __device__ __forceinline__ void midscale(f32x4 (&acc)[2][2][4][2], const Unit& u, int wr, int wc, int fr, int fq) const {
        const int row0 = u.pm * BM + wr * 64 + fr;
#pragma unroll
        for (int ai = 0; ai < 2; ++ai)
#pragma unroll
            for (int m = 0; m < 4; ++m) { const int row = row0 + ai * HALF + m * 16; const f32x2 sq = *(const f32x2*)(ssqn + (size_t)row * 2);
                const float sc = rsqrtf((sq[0] + sq[1]) * (1.0f / 512.0f) + 1e-6f);
#pragma unroll
                for (int bj = 0; bj < 2; ++bj)
#pragma unroll
                    for (int n = 0; n < 2; ++n) acc[ai][bj][m][n] = acc[ai][bj][m][n] * sc; }
    }
    __device__ __forceinline__ void operator()(const f32x4 (&acc)[2][2][4][2], const Unit& u, int wr, int wc, int fr, int fq) const {
        const int row0 = u.pm * BM + wr * 64 + fr; const int col0 = u.pn * BM + wc * 32 + 4 * fq;
#pragma unroll
        for (int ai = 0; ai < 2; ++ai)
#pragma unroll
            for (int m = 0; m < 4; ++m) { const int row = row0 + ai * HALF + m * 16; const size_t off = (size_t)row * 1024 + col0; float s = 0.f;
#pragma unroll
                for (int bj = 0; bj < 2; ++bj)
#pragma unroll
                    for (int n = 0; n < 2; ++n) { f32x4 b;
                        if (base) b = *(const f32x4*)(base + off + bj * HALF + n * 16);
                        else { const u32x2 w = *(const u32x2*)(base16 + off + bj * HALF + n * 16); b[0] = __builtin_bit_cast(float, w.x << 16); b[1] = __builtin_bit_cast(float, w.x & 0xffff0000u); b[2] = __builtin_bit_cast(float, w.y << 16); b[3] = __builtin_bit_cast(float, w.y & 0xffff0000u); }
                        const f32x4 v = b + acc[ai][bj][m][n];
                        if (out) *(f32x4*)(out + off + bj * HALF + n * 16) = v;
                        s += (v[0] * v[0] + v[1] * v[1]) + (v[2] * v[2] + v[3] * v[3]);
                        u32x2 w; w.x = cvt_pk_bf16(v[0], v[1]); w.y = cvt_pk_bf16(v[2], v[3]); *(u32x2*)(XB + off + bj * HALF + n * 16) = w; }
                s += __shfl_xor(s, 16); s += __shfl_xor(s, 32);
                if (fq == 0) ssq[(size_t)row * 16 + u.pn * 4 + wc] = s;
                asm volatile("" ::: "memory"); }
    }
};
template <class Epi, class Sched, bool ALIGN_EPI = false, bool SP2 = false>
__device__ __forceinline__ void gemm_phase(PG8_LAS unsigned char* lds, const Gemm g, const Sched& S, const Epi& E, int wave  ) {
    int lane; asm volatile("v_mbcnt_lo_u32_b32 %0, -1, 0\n\tv_mbcnt_hi_u32_b32 %0, -1, %0" : "=v"(lane));
    const int wid = wave, tid = wid * 64 + lane, wr = wid >> 2, wc = wid & 3, fr = lane & 15, fq = lane >> 4;
    const int K = g.K, nt = K / BK;
    unsigned voffA[2], voffB[2];
#pragma unroll
    for (int i = 0; i < 2; ++i) { int R, C; stage_rc(tid * 16 + i * 8192, R, C); const int Rb = Epi::PERM ? ((R & ~31) + perm32(R & 31)) : R;
        voffA[i] = (unsigned)(R * K + C) * 2u; voffB[i] = (unsigned)(Rb * K + C) * 2u; }
    const size_t kstep = (size_t)(BK * 2);
    const size_t hstep = (size_t)HALF * K * 2;
    const size_t tstep = 2 * hstep;
    const unsigned ldsw = (unsigned)wid * 1024u;
    const int aoff = lds_byte(wr * 64 + fr, fq * 8), boff = lds_byte(wc * 32 + fr, fq * 8);
#define PG8_SA(b, h) (((b) * 2 + (h)) * HTB)
#define PG8_SB(b, h) ((4 + (b) * 2 + (h)) * HTB)
#define PG8_STAGE(bufoff, gbase, voff) do { _Pragma("unroll") for (int _i = 0; _i < 2; ++_i) \
        __builtin_amdgcn_global_load_lds((const unsigned*)((const char*)(gbase) + (voff)[_i]), (PG8_LAS unsigned*)(lds + (bufoff) + ldsw + _i * 8192), 16, 0, 0); } while (0)
#define PG8_LDA(dst, b, h) do { _Pragma("unroll") for (int m = 0; m < 4; ++m) _Pragma("unroll") for (int k = 0; k < 2; ++k) dst[m][k] = *(const PG8_LAS bf16x8*)(lds + PG8_SA(b, h) + aoff + m * 2048 + k * 1024); } while (0)
#define PG8_LDB(dst, b, h) do { _Pragma("unroll") for (int n = 0; n < 2; ++n) _Pragma("unroll") for (int k = 0; k < 2; ++k) dst[n][k] = *(const PG8_LAS bf16x8*)(lds + PG8_SB(b, h) + boff + n * 2048 + k * 1024); } while (0)
#define PG8_MMA(ai, bj, At, Bt) do { __builtin_amdgcn_s_setprio(1); _Pragma("unroll") for (int m = 0; m < 4; ++m) _Pragma("unroll") for (int n = 0; n < 2; ++n) _Pragma("unroll") for (int k = 0; k < 2; ++k) \
        acc[ai][bj][m][n] = __builtin_amdgcn_mfma_f32_16x16x32_bf16(Bt[n][k], At[m][k], acc[ai][bj][m][n], 0, 0, 0); __builtin_amdgcn_s_setprio(0); } while (0)
#define PG8_WAIT_V(n) asm volatile("s_waitcnt vmcnt(" #n ")" ::: "memory")
#define PG8_WAIT_L(n) asm volatile("s_waitcnt lgkmcnt(" #n ")" ::: "memory")
#define PG8_BAR __builtin_amdgcn_s_barrier()
#define PG8_SCHED __builtin_amdgcn_sched_barrier(0)
    Unit cur, nxt; int ui = 0;
    if (!S.next(0, cur)) return;
    f32x4 acc[2][2][4][2];
#pragma unroll
    for (int a = 0; a < 2; ++a)
#pragma unroll
        for (int b = 0; b < 2; ++b)
#pragma unroll
            for (int m = 0; m < 4; ++m)
#pragma unroll
                for (int n = 0; n < 2; ++n) acc[a][b][m][n] = (f32x4){0.f, 0.f, 0.f, 0.f};
    bf16x8 At[4][2], B0[2][2], B1[2][2];
    const char* cA = (const char*)g.A + (size_t)cur.pm * tstep; const char* cB = (const char*)g.Bt + (size_t)cur.pn * tstep;
    S.a_ready(cur);
    if constexpr (SP2) {
        PG8_STAGE(PG8_SB(0, 0), cB, voffB); PG8_STAGE(PG8_SB(0, 1), cB + hstep, voffB); PG8_STAGE(PG8_SA(0, 0), cA, voffA); PG8_STAGE(PG8_SA(0, 1), cA + hstep, voffA);
        if (wr == 1) PG8_BAR;
        PG8_WAIT_V(2); PG8_BAR;
        PG8_STAGE(PG8_SB(1, 0), cB + kstep, voffB); PG8_STAGE(PG8_SA(1, 0), cA + kstep, voffA); PG8_STAGE(PG8_SB(1, 1), cB + hstep + kstep, voffB);
        PG8_WAIT_V(6); PG8_BAR;
    } else {
        PG8_STAGE(PG8_SB(0, 0), cB, voffB); PG8_STAGE(PG8_SA(0, 0), cA, voffA); PG8_STAGE(PG8_SB(0, 1), cB + hstep, voffB); PG8_STAGE(PG8_SA(0, 1), cA + hstep, voffA);
        if (wr == 1) PG8_BAR;
        PG8_WAIT_V(4); PG8_BAR;
        PG8_STAGE(PG8_SB(1, 0), cB + kstep, voffB); PG8_STAGE(PG8_SA(1, 0), cA + kstep, voffA); PG8_STAGE(PG8_SB(1, 1), cB + hstep + kstep, voffB);
        PG8_WAIT_V(6); PG8_BAR;
    }
    for (;;) {
        const bool has_next = S.next(ui + 1, nxt);
        const char* nA = has_next ? (const char*)g.A + (size_t)nxt.pm * tstep : cA; const char* nB = has_next ? (const char*)g.Bt + (size_t)nxt.pn * tstep : cB;
        for (int t = 0; t < nt; t += 2) {
            if constexpr (Epi::MIDSCALE) { if (t == nt / 2) E.midscale(acc, cur, wr, wc, fr, fq); }
            const bool last = (t == nt - 2);
            const char* a1 = cA + (size_t)(t + 1) * kstep;
            const char* a2 = last ? nA : cA + (size_t)(t + 2) * kstep; const char* b2 = last ? nB : cB + (size_t)(t + 2) * kstep;
            const char* a3 = a2 + kstep; const char* b3 = b2 + kstep;
            if (last && has_next) S.a_ready(nxt);
            if constexpr (SP2) {
            PG8_LDB(B0, 0, 0); PG8_LDB(B1, 0, 1); PG8_SCHED; PG8_LDA(At, 0, 0); PG8_STAGE(PG8_SA(1, 1), a1 + hstep, voffA);
            PG8_WAIT_V(8); PG8_WAIT_L(0); PG8_BAR; PG8_MMA(0, 0, At, B0); PG8_MMA(0, 1, At, B1); PG8_BAR; PG8_SCHED;
            PG8_LDA(At, 0, 1); PG8_STAGE(PG8_SB(0, 0), b2, voffB); PG8_STAGE(PG8_SB(0, 1), b2 + hstep, voffB); PG8_STAGE(PG8_SA(0, 0), a2, voffA);
            PG8_WAIT_V(8); PG8_WAIT_L(0); PG8_BAR; PG8_MMA(1, 0, At, B0); PG8_MMA(1, 1, At, B1); PG8_BAR; PG8_SCHED;
            PG8_LDB(B0, 1, 0); PG8_LDB(B1, 1, 1); PG8_SCHED; PG8_LDA(At, 1, 0); PG8_STAGE(PG8_SA(0, 1), a2 + hstep, voffA);
            PG8_WAIT_V(8); PG8_WAIT_L(0); PG8_BAR; PG8_MMA(0, 0, At, B0); PG8_MMA(0, 1, At, B1); PG8_BAR; PG8_SCHED;
            PG8_LDA(At, 1, 1); PG8_STAGE(PG8_SB(1, 0), b3, voffB); PG8_STAGE(PG8_SB(1, 1), b3 + hstep, voffB); PG8_STAGE(PG8_SA(1, 0), a3, voffA);
            PG8_WAIT_V(8); PG8_WAIT_L(0); PG8_BAR; PG8_MMA(1, 0, At, B0); PG8_MMA(1, 1, At, B1); PG8_BAR; PG8_SCHED;
            } else {
            PG8_LDB(B0, 0, 0); PG8_SCHED; PG8_LDA(At, 0, 0); PG8_STAGE(PG8_SA(1, 1), a1 + hstep, voffA);
            PG8_WAIT_L(8); PG8_BAR; PG8_WAIT_L(0); PG8_MMA(0, 0, At, B0); PG8_BAR; PG8_SCHED;
            PG8_LDB(B1, 0, 1); PG8_STAGE(PG8_SB(0, 0), b2, voffB);
            PG8_BAR; PG8_WAIT_L(0); PG8_MMA(0, 1, At, B1); PG8_BAR;
            PG8_LDA(At, 0, 1); PG8_STAGE(PG8_SA(0, 0), a2, voffA);
            PG8_BAR; PG8_WAIT_L(0); PG8_MMA(1, 0, At, B0); PG8_BAR; PG8_SCHED;
            PG8_STAGE(PG8_SB(0, 1), b2 + hstep, voffB);
            PG8_WAIT_V(6); PG8_BAR; PG8_MMA(1, 1, At, B1); PG8_BAR;
            PG8_LDB(B0, 1, 0); PG8_SCHED; PG8_LDA(At, 1, 0); PG8_STAGE(PG8_SA(0, 1), a2 + hstep, voffA);
            PG8_WAIT_L(8); PG8_BAR; PG8_WAIT_L(0); PG8_MMA(0, 0, At, B0); PG8_BAR; PG8_SCHED;
            PG8_LDB(B1, 1, 1); PG8_STAGE(PG8_SB(1, 0), b3, voffB);
            PG8_BAR; PG8_WAIT_L(0); PG8_MMA(0, 1, At, B1); PG8_BAR;
            PG8_LDA(At, 1, 1); PG8_STAGE(PG8_SA(1, 0), a3, voffA);
            PG8_BAR; PG8_WAIT_L(0); PG8_MMA(1, 0, At, B0); PG8_BAR; PG8_SCHED;
            PG8_STAGE(PG8_SB(1, 1), b3 + hstep, voffB);
            PG8_WAIT_V(6); PG8_BAR; PG8_MMA(1, 1, At, B1); PG8_BAR;
            }
        }
        if constexpr (ALIGN_EPI) { if (wr == 0) PG8_BAR; }
        if constexpr (!Epi::AFTER_DRAIN) { E(acc, cur, wr, wc, fr, fq); S.done(cur); }
        if (!has_next) break;
#pragma unroll
        for (int a = 0; a < 2; ++a)
#pragma unroll
            for (int b = 0; b < 2; ++b)
#pragma unroll
                for (int m = 0; m < 4; ++m)
#pragma unroll
                    for (int n = 0; n < 2; ++n) acc[a][b][m][n] = (f32x4){0.f, 0.f, 0.f, 0.f};
        cur = nxt; cA = nA; cB = nB; ++ui;
        if constexpr (ALIGN_EPI) { if (wr == 1) PG8_BAR; }
    }
    PG8_WAIT_V(0);
    if constexpr (!ALIGN_EPI) { if (wr == 0) PG8_BAR; }
    PG8_BAR;
    if constexpr (Epi::AFTER_DRAIN) { E.fused(acc, cur, wr, wc, fr, fq, lds, wid, lane); S.done(cur); }
#undef PG8_SA
#undef PG8_SB
#undef PG8_STAGE
#undef PG8_LDA
#undef PG8_LDB
#undef PG8_MMA
#undef PG8_WAIT_V
#undef PG8_WAIT_L
#undef PG8_BAR
#undef PG8_SCHED
}
}

constexpr int NB = 2, SEQ = 8192, DM = 1024, MTOK = NB * SEQ;
constexpr int NZ = 2304, NZP = 2560;
constexpr int NMEM = 256;
constexpr float EPS = 1e-6f;
constexpr float QSCALE = 0.125f * 1.4426950408889634f;
constexpr int ZC_XL = 0, ZC_GT = 512, ZC_Q = 1024, ZC_KC = 1536, ZC_VC = 1664, ZC_KS = 1792, ZC_VS = 1920, ZC_KW = 2048, ZC_VW = 2176, ZC_G = 2304;

constexpr size_t MiB = 1u << 20;
constexpr size_t WS_CTL = 0;
constexpr size_t WS_WIN = 1 * MiB, WS_WOUT = 6 * MiB, WS_WMQ = 8 * MiB, WS_WMK = 10 * MiB, WS_WMV = 12 * MiB, WS_WMO = 14 * MiB, WS_WPQ = 16 * MiB;
constexpr size_t WS_SKEY = 20 * MiB;
constexpr size_t WS_CW1T = WS_SKEY + 512 * 1024;
constexpr size_t WS_CW2T = WS_CW1T + 512 * 1024;
constexpr size_t WS_C1 = WS_CW2T + 16 * 1024;
constexpr size_t WS_WRGT = WS_C1 + 16 * 1024;
constexpr size_t WS_MEMN = 22 * MiB, WS_MEMK = 23 * MiB, WS_MEMVT = 24 * MiB;
constexpr size_t WS_KC = 26 * MiB;
constexpr size_t WS_VCT = WS_KC + 256 * 1024;
constexpr size_t WS_SUMM = 27 * MiB;
constexpr size_t WS_SSQ1 = 28 * MiB, WS_SSQ2 = 29 * MiB;
constexpr size_t WS_GATES = 30 * MiB;
constexpr size_t WS_SSQN = 31 * MiB + 512 * 1024;
constexpr size_t WS_U8 = 32 * MiB, WS_V8 = 48 * MiB;
constexpr size_t WS_SU = 64 * MiB, WS_SV = 64 * MiB + 65536;
constexpr size_t WS_SSQ3 = 65 * MiB;
constexpr size_t WS_W = 66 * MiB;
constexpr size_t WS_PART = 128 * MiB;
constexpr size_t WS_XN = 96 * MiB;
constexpr size_t WS_Z = 128 * MiB;
constexpr size_t WS_KSF = 240 * MiB, WS_VSF = 244 * MiB, WS_KWF = 248 * MiB, WS_VWF = 252 * MiB;
constexpr size_t WS_QM = 128 * MiB, WS_OM = 160 * MiB;
constexpr size_t WS_QP = 128 * MiB;
constexpr size_t WS_Y = 208 * MiB;
constexpr size_t WS_EID = 208 * MiB, WS_GW = 216 * MiB;
constexpr size_t WS_END = 256 * MiB;

constexpr int CW_KMAX = 12288;
constexpr int LDS_BYTES = 147456;

#define GAS __attribute__((address_space(1)))
#define LAS __attribute__((address_space(3)))
typedef unsigned short bf16;
typedef unsigned v4u __attribute__((ext_vector_type(4)));
typedef unsigned v2u __attribute__((ext_vector_type(2)));
typedef float f32x4 __attribute__((ext_vector_type(4)));
typedef float f32x16 __attribute__((ext_vector_type(16)));
typedef short bf16x8 __attribute__((ext_vector_type(8)));
typedef short bf16x4 __attribute__((ext_vector_type(4)));
__device__ __forceinline__ unsigned f2bf(float f) { unsigned u = __builtin_bit_cast(unsigned, f); return (u + 0x7fffu + ((u >> 16) & 1u)) >> 16; }
typedef float f32x2_ __attribute__((ext_vector_type(2))); typedef __bf16 bf16x2_ __attribute__((ext_vector_type(2)));
__device__ __forceinline__ unsigned pk2(float lo, float hi) { f32x2_ v = {lo, hi}; bf16x2_ b = __builtin_convertvector(v, bf16x2_); return __builtin_bit_cast(unsigned, b); }
__device__ __forceinline__ float bf2f(unsigned short h) { return __builtin_bit_cast(float, (unsigned)h << 16); }
__device__ __forceinline__ float bflo(unsigned w) { return __builtin_bit_cast(float, w << 16); }
__device__ __forceinline__ float bfhi(unsigned w) { return __builtin_bit_cast(float, w & 0xffff0000u); }
__device__ __forceinline__ void swap32(unsigned& a, unsigned& b) { asm("s_nop 1\n\tv_permlane32_swap_b32 %0, %1" : "+v"(a), "+v"(b)); }
__device__ __forceinline__ int maxswap32_i(int v) { unsigned a = (unsigned)v, b = (unsigned)v; swap32(a, b); return max((int)a, (int)b); }
__device__ __forceinline__ float maxswap32_f(float v) { unsigned a = __builtin_bit_cast(unsigned, v), b = a; swap32(a, b); return fmaxf(__builtin_bit_cast(float, a), __builtin_bit_cast(float, b)); }
__device__ __forceinline__ float addswap32_f(float v) { unsigned a = __builtin_bit_cast(unsigned, v), b = a; swap32(a, b); return __builtin_bit_cast(float, a) + __builtin_bit_cast(float, b); }
__device__ __forceinline__ float wave_sum(float v) {
#pragma unroll
    for (int o = 1; o < 64; o <<= 1) v += __shfl_xor(v, o);
    return v;
}

struct Args { const float* in[33]; float* out; unsigned char* ws; int ph_lo, ph_hi; };

struct Frame {
    int tid, lane, wave, vcu, G, gw, NGW;
};
__device__ __forceinline__ int lane_id() { int l; asm volatile("v_mbcnt_lo_u32_b32 %0, -1, 0\n\tv_mbcnt_hi_u32_b32 %0, -1, %0" : "=v"(l)); return l; }
#define REFRESH_LANE(F) do { (F).lane = lane_id(); (F).tid = (F).wave * 64 + (F).lane; } while (0)

__device__ __forceinline__ void transpose_item(const float* W, int K, int N, bf16* WT, int ldt, int row_off, const float* gain, int slo, int shi, float cs, LAS float* scr, int item, int lane, int kxor = 0) {
    const int nblk = (N + 31) / 32, kb = item / nblk, nb = item % nblk, k0 = 64 * kb, n0 = 32 * nb;
#pragma unroll 16
    for (int i = 0; i < 32; ++i) { const int kk = 2 * i + (lane >> 5), n = n0 + (lane & 31);
        float v = (n < N) ? __builtin_nontemporal_load(W + (size_t)(k0 + kk) * N + n) : 0.f; if (gain) v *= gain[k0 + kk]; if (n >= slo && n < shi) v *= cs;
        scr[kk * 33 + (lane & 31)] = v; }
    asm volatile("s_waitcnt lgkmcnt(0)" ::: "memory");
    const int c = lane & 7;
#pragma unroll
    for (int j = 0; j < 4; ++j) { const int n = (lane >> 3) + 8 * j; const LAS float* s = scr + (8 * c) * 33 + n;
        v4u o; o.x = pk2(s[0 * 33], s[1 * 33]); o.y = pk2(s[2 * 33], s[3 * 33]); o.z = pk2(s[4 * 33], s[5 * 33]); o.w = pk2(s[6 * 33], s[7 * 33]);
        *(v4u*)(WT + (size_t)(row_off + n0 + n) * ldt + (k0 ^ kxor) + 8 * c) = o; }
    asm volatile("s_waitcnt lgkmcnt(0)" ::: "memory");
}
__device__ __forceinline__ void rms_row_to_bf16(const float* xrow, bf16* orow, int lane) {
    const f32x4* xr = (const f32x4*)xrow + lane;
    f32x4 v[4]; float s = 0.f;
#pragma unroll
    for (int j = 0; j < 4; ++j) { v[j] = xr[64 * j]; s += (v[j].x * v[j].x + v[j].y * v[j].y) + (v[j].z * v[j].z + v[j].w * v[j].w); }
    const float rstd = rsqrtf(wave_sum(s) * (1.f / DM) + EPS);
    unsigned long long* o8 = (unsigned long long*)orow + lane;
#pragma unroll
    for (int j = 0; j < 4; ++j) o8[64 * j] = (unsigned long long)pk2(v[j].x * rstd, v[j].y * rstd) | ((unsigned long long)pk2(v[j].z * rstd, v[j].w * rstd) << 32);
}
__device__ __forceinline__ void quant_row_fp8(const float* src, const float* gain, unsigned char* dst, float* scale_out, int lane) {
    const f32x4* p = (const f32x4*)src + 4 * lane; f32x4 v[4]; float am = 0.f;
#pragma unroll
    for (int j = 0; j < 4; ++j) { v[j] = p[j]; if (gain) v[j] = v[j] * ((const f32x4*)gain)[4 * lane + j]; am = fmaxf(am, fmaxf(fmaxf(fabsf(v[j].x), fabsf(v[j].y)), fmaxf(fabsf(v[j].z), fabsf(v[j].w)))); }
#pragma unroll
    for (int o = 1; o < 64; o <<= 1) am = fmaxf(am, __shfl_xor(am, o));
    const float inv = am > 0.f ? 448.0f / am : 0.f;
    v4u o4;
#pragma unroll
    for (int j = 0; j < 4; ++j) { int w = 0; w = __builtin_amdgcn_cvt_pk_fp8_f32(v[j].x * inv, v[j].y * inv, w, false); w = __builtin_amdgcn_cvt_pk_fp8_f32(v[j].z * inv, v[j].w * inv, w, true); o4[j] = (unsigned)w; }
    *(v4u*)(dst + (size_t)(lane >> 3) * 16384 * 128 + (lane & 7) * 16) = o4;
    if (lane == 0) *scale_out = am * (1.0f / 448.0f);
}
__device__ __forceinline__ void rms_rows4_to_bf16(const float* x0, bf16* o0, size_t rstride  , int lane) {
    f32x4 v[4][4]; float s[4];
#pragma unroll
    for (int r = 0; r < 4; ++r)
#pragma unroll
        for (int j = 0; j < 4; ++j) v[r][j] = __builtin_nontemporal_load((const f32x4*)(x0 + r * rstride) + lane + 64 * j);
#pragma unroll
    for (int r = 0; r < 4; ++r) { s[r] = 0.f;
#pragma unroll
        for (int j = 0; j < 4; ++j) s[r] += (v[r][j].x * v[r][j].x + v[r][j].y * v[r][j].y) + (v[r][j].z * v[r][j].z + v[r][j].w * v[r][j].w); }
#pragma unroll
    for (int o = 1; o < 64; o <<= 1)
#pragma unroll
        for (int r = 0; r < 4; ++r) s[r] += __shfl_xor(s[r], o);
#pragma unroll
    for (int r = 0; r < 4; ++r) { const float rstd = rsqrtf(s[r] * (1.f / DM) + EPS); unsigned long long* o8 = (unsigned long long*)(o0 + r * rstride) + lane;
#pragma unroll
        for (int j = 0; j < 4; ++j) o8[64 * j] = (unsigned long long)pk2(v[r][j].x * rstd, v[r][j].y * rstd) | ((unsigned long long)pk2(v[r][j].z * rstd, v[r][j].w * rstd) << 32); }
}
__device__ __forceinline__ void quant_rows4_fp8(const float* src0, size_t rstride, const float* gain, unsigned char* dst0, float* scale0, int sstride, int lane) {
    f32x4 v[4][4]; float am[4];
#pragma unroll
    for (int r = 0; r < 4; ++r)
#pragma unroll
        for (int j = 0; j < 4; ++j) v[r][j] = __builtin_nontemporal_load((const f32x4*)(src0 + r * rstride) + 4 * lane + j);
    if (gain) {
#pragma unroll
        for (int j = 0; j < 4; ++j) { const f32x4 g = ((const f32x4*)gain)[4 * lane + j];
#pragma unroll
            for (int r = 0; r < 4; ++r) v[r][j] = v[r][j] * g; } }
#pragma unroll
    for (int r = 0; r < 4; ++r) { am[r] = 0.f;
#pragma unroll
        for (int j = 0; j < 4; ++j) am[r] = fmaxf(am[r], fmaxf(fmaxf(fabsf(v[r][j].x), fabsf(v[r][j].y)), fmaxf(fabsf(v[r][j].z), fabsf(v[r][j].w)))); }
#pragma unroll
    for (int o = 1; o < 64; o <<= 1)
#pragma unroll
        for (int r = 0; r < 4; ++r) am[r] = fmaxf(am[r], __shfl_xor(am[r], o));
#pragma unroll
    for (int r = 0; r < 4; ++r) { const float inv = am[r] > 0.f ? 448.0f / am[r] : 0.f; v4u o4;
#pragma unroll
        for (int j = 0; j < 4; ++j) { int w = 0; w = __builtin_amdgcn_cvt_pk_fp8_f32(v[r][j].x * inv, v[r][j].y * inv, w, false); w = __builtin_amdgcn_cvt_pk_fp8_f32(v[r][j].z * inv, v[r][j].w * inv, w, true); o4[j] = (unsigned)w; }
        __builtin_nontemporal_store(o4, (v4u*)(dst0 + (size_t)r * sstride * 128 + (size_t)(lane >> 3) * 16384 * 128 + (lane & 7) * 16));
        if (lane == 0) scale0[r * sstride] = am[r] * (1.0f / 448.0f); }
}
__device__ __forceinline__ void p0_prologue(const Frame& F, const Args& A, LAS unsigned char* lds) {
    unsigned char* ws = A.ws;
    LAS float* scr = (LAS float*)(lds + F.wave * 16384);
    const float* const* in = A.in;
    const int gw = F.gw, NGW = F.NGW;
    constexpr int I_IN = 16 * 73, I_SQ = 16 * 32, I_PQ = 16 * 64, I_C1 = 64, I_C2 = 2, I_RG = 2;
    constexpr int E_IN = I_IN, E_OUT = E_IN + I_SQ, E_MQ = E_OUT + I_SQ, E_MK = E_MQ + I_SQ, E_MV = E_MK + I_SQ, E_MO = E_MV + I_SQ, E_PQ = E_MO + I_PQ, E_C1 = E_PQ + 2 * I_C1, E_C2 = E_C1 + 2 * I_C2, E_RG = E_C2 + 16 * I_RG;
    for (int it = gw; it < E_RG; it += NGW) {
        if (it < E_IN) transpose_item(in[3], 1024, 2328, (bf16*)(ws + WS_WIN), 1024, 0, in[2], ZC_Q, ZC_KC, QSCALE, scr, it, F.lane);
        else if (it < E_OUT) { const int j = it - E_IN, kb = j / 32; transpose_item(in[20], 1024, 1024, (bf16*)(ws + WS_WOUT), 1024, 0, (kb < 8 ? in[18] : in[19] - 512), 0, 0, 1.f, scr, j, F.lane, 512); }
        else if (it < E_MQ) transpose_item(in[23], 1024, 1024, (bf16*)(ws + WS_WMQ), 1024, 0, in[21], 0, 1024, 0.0625f * 1.4426950408889634f, scr, it - E_OUT, F.lane);
        else if (it < E_MK) transpose_item(in[24], 1024, 1024, (bf16*)(ws + WS_WMK), 1024, 0, in[22], 0, 0, 1.f, scr, it - E_MQ, F.lane);
        else if (it < E_MV) transpose_item(in[25], 1024, 1024, (bf16*)(ws + WS_WMV), 1024, 0, in[22], 0, 0, 1.f, scr, it - E_MK, F.lane);
        else if (it < E_MO) transpose_item(in[26], 1024, 1024, (bf16*)(ws + WS_WMO), 1024, 0, nullptr, 0, 0, 1.f, scr, it - E_MV, F.lane);
        else if (it < E_PQ) transpose_item(in[28], 1024, 2048, (bf16*)(ws + WS_WPQ), 1024, 0, in[27], 0, 0, 1.f, scr, it - E_MO, F.lane);
        else if (it < E_C1) { const int j = it - E_PQ, kv = j / I_C1; transpose_item(in[kv ? 16 : 13], 2048, 64, (bf16*)(ws + WS_CW1T) + (size_t)kv * 64 * 2048, 2048, 0, nullptr, 0, 0, 1.f, scr, j % I_C1, F.lane); }
        else if (it < E_C2) { const int j = it - E_C1, kv = j / I_C2; transpose_item(in[kv ? 17 : 14], 64, 64, (bf16*)(ws + WS_CW2T) + (size_t)kv * 64 * 64, 64, 0, nullptr, 0, 0, 1.f, scr, j % I_C2, F.lane); }
        else { const int j = it - E_C2, ai = j / 16, h = (j / 2) % 8; transpose_item(in[ai ? 9 : 7] + (size_t)h * 4096, 64, 64, (bf16*)(ws + WS_WRGT) + (size_t)(ai * 8 + h) * 4096, 64, 0, nullptr, 0, 0, 1.f, scr, j % 2, F.lane); }
    }
    for (int i = gw * 64 + F.lane; i < (2560 - 2336) * 1024 / 8; i += NGW * 64) ((v4u*)((bf16*)(ws + WS_WIN) + (size_t)2336 * 1024))[i] = (v4u){0u, 0u, 0u, 0u};
    for (int it = NGW - 1 - gw; it < 32; it += NGW) { const int kv = it >> 4, ch = it & 15; const float* pos = in[kv ? 15 : 12] + 128 * ch; const float* w1 = in[kv ? 16 : 13] + (size_t)128 * ch * 64 + F.lane; float s = 0.f;
#pragma unroll 16
        for (int k = 0; k < 128; ++k) s += pos[k] * w1[(size_t)k * 64];
        ((float*)(ws + WS_C1))[it * 64 + F.lane] = s; }
    { const size_t i0 = (size_t)gw * 64 + F.lane, st = (size_t)NGW * 64;
      const int nrows0 = (F.G == 256) ? 0 : 32768;
      for (int r = gw; r < nrows0; r += 4 * NGW) { const int tb = r >> 14, e = r & 16383;
          if ((16384 % (4 * NGW)) == 0) quant_rows4_fp8(in[30 + tb] + (size_t)e * DM, (size_t)NGW * DM, tb ? nullptr : in[27], ws + (tb ? WS_V8 : WS_U8) + (size_t)e * 128, (float*)(ws + (tb ? WS_SV : WS_SU)) + e, NGW, F.lane);
          else for (int q = 0; q < 4; ++q) { const int rr = r + q * NGW; if (rr < 32768) { const int t2 = rr >> 14, e2 = rr & 16383; quant_row_fp8(in[30 + t2] + (size_t)e2 * DM, t2 ? nullptr : in[27], ws + (t2 ? WS_V8 : WS_U8) + (size_t)e2 * 128, (float*)(ws + (t2 ? WS_SV : WS_SU)) + e2, F.lane); } } }
      for (size_t i = i0; i < (size_t)8 * 2 * 128 * 128 / 8; i += st) { const f32x4 a = ((const f32x4*)in[29])[2 * i], bq = ((const f32x4*)in[29])[2 * i + 1];
          v4u o; o.x = pk2(a.x, a.y); o.y = pk2(a.z, a.w); o.z = pk2(bq.x, bq.y); o.w = pk2(bq.z, bq.w);
          const size_t R = i >> 4, d0 = (i & 15) * 8;
          *(v4u*)((bf16*)(ws + WS_SKEY) + (R >> 5) * 4096 + (d0 >> 4) * 512 + ((d0 >> 3) & 1) * 256 + (R & 31) * 8) = o; } }
    if ((MTOK % (4 * NGW)) == 0) for (int m = gw; m < MTOK; m += 4 * NGW) rms_rows4_to_bf16(in[0] + (size_t)m * DM, (bf16*)(ws + WS_XN) + (size_t)m * DM, (size_t)NGW * DM, F.lane);
    else for (int m = gw; m < MTOK; m += NGW) rms_row_to_bf16(in[0] + (size_t)m * DM, (bf16*)(ws + WS_XN) + (size_t)m * DM, F.lane);
    for (int m = gw; m < NB * NMEM; m += NGW) rms_row_to_bf16(in[1] + (size_t)m * DM, (bf16*)(ws + WS_MEMN) + (size_t)m * DM, F.lane);
}

__device__ __forceinline__ int crow(int r, int hi) { return (r & 3) + 8 * (r >> 2) + 4 * hi; }
__device__ __forceinline__ float gelu_tanh(float x) {
    const float u = 0.7978845608028654f * (x + 0.044715f * x * x * x);
    const float t = 1.0f - 2.0f * __builtin_amdgcn_rcpf(__builtin_amdgcn_exp2f(2.0f * 1.4426950408889634f * u) + 1.0f);
    return 0.5f * x * (1.0f + t);
}
constexpr int XC_LD = 520;
__device__ __forceinline__ void lru_local_item(const Frame& F, const Args& A, LAS unsigned char* lds, int item) {
    unsigned char* ws = A.ws;
    const bf16* Z = (const bf16*)(ws + WS_Z);
    const int b = item >> 7, chunk = item & 127, s0 = chunk * 64; const size_t row0 = (size_t)b * SEQ + s0;
    LAS bf16* xcs = (LAS bf16*)lds;
    {
        const int c8 = F.tid & 63, tg = F.tid >> 6, c0 = 8 * c8;
        v4u xr[11];
#pragma unroll
        for (int r = 0; r < 11; ++r) { const long tok = (long)(8 * tg + r) - 3;
            if (s0 == 0 && tok < 0) xr[r] = (v4u){0u, 0u, 0u, 0u}; else xr[r] = *(const v4u*)(Z + (size_t)((long)row0 + tok) * NZ + c0); }
        const float* cw = A.in[5]; float w0[8], w1[8], w2[8], w3[8], cb[8];
#pragma unroll
        for (int j = 0; j < 2; ++j) { const f32x4 a = *(const f32x4*)(cw + c0 + 4 * j), b = *(const f32x4*)(cw + 512 + c0 + 4 * j), c = *(const f32x4*)(cw + 1024 + c0 + 4 * j), d = *(const f32x4*)(cw + 1536 + c0 + 4 * j), e2 = *(const f32x4*)(A.in[6] + c0 + 4 * j);
#pragma unroll
            for (int k = 0; k < 4; ++k) { w0[4 * j + k] = a[k]; w1[4 * j + k] = b[k]; w2[4 * j + k] = c[k]; w3[4 * j + k] = d[k]; cb[4 * j + k] = e2[k]; } }
#pragma unroll
        for (int tt = 0; tt < 8; ++tt) { float o[8];
#pragma unroll
            for (int q = 0; q < 4; ++q) { const unsigned a = xr[tt][q], b = xr[tt + 1][q], c = xr[tt + 2][q], d = xr[tt + 3][q];
                o[2 * q] = cb[2 * q] + w0[2 * q] * bflo(a) + w1[2 * q] * bflo(b) + w2[2 * q] * bflo(c) + w3[2 * q] * bflo(d);
                o[2 * q + 1] = cb[2 * q + 1] + w0[2 * q + 1] * bfhi(a) + w1[2 * q + 1] * bfhi(b) + w2[2 * q + 1] * bfhi(c) + w3[2 * q + 1] * bfhi(d); }
            v4u ov; ov.x = pk2(o[0], o[1]); ov.y = pk2(o[2], o[3]); ov.z = pk2(o[4], o[5]); ov.w = pk2(o[6], o[7]);
            *(LAS v4u*)(xcs + (8 * tg + tt) * XC_LD + c0) = ov; }
    }
    __syncthreads();
    const int h = F.wave, lane = F.lane, r32 = lane & 31, hi = lane >> 5;
    bf16x8 af[2][4];
#pragma unroll
    for (int tt = 0; tt < 2; ++tt)
#pragma unroll
        for (int ks = 0; ks < 4; ++ks) af[tt][ks] = *(const LAS bf16x8*)(xcs + (32 * tt + r32) * XC_LD + 64 * h + 16 * ks + 8 * hi);
    const bf16* WT = (const bf16*)(ws + WS_WRGT);
    float* SUMM = (float*)(ws + WS_SUMM);
    unsigned* HA = (unsigned*)A.out;
#pragma unroll 1
    for (int ct = 0; ct < 2; ++ct) {
        const int c = 64 * h + 32 * ct + r32;
        f32x16 ga[2], gi[2];
#pragma unroll
        for (int tt = 0; tt < 2; ++tt) { ga[tt] = f32x16{}; gi[tt] = f32x16{}; }
#pragma unroll
        for (int ks = 0; ks < 4; ++ks) {
            const bf16x8 ba = *(const bf16x8*)(WT + (size_t)(0 * 8 + h) * 4096 + (32 * ct + r32) * 64 + 16 * ks + 8 * hi);
            const bf16x8 bi = *(const bf16x8*)(WT + (size_t)(1 * 8 + h) * 4096 + (32 * ct + r32) * 64 + 16 * ks + 8 * hi);
#pragma unroll
            for (int tt = 0; tt < 2; ++tt) { ga[tt] = __builtin_amdgcn_mfma_f32_32x32x16_bf16(af[tt][ks], ba, ga[tt], 0, 0, 0); gi[tt] = __builtin_amdgcn_mfma_f32_32x32x16_bf16(af[tt][ks], bi, gi[tt], 0, 0, 0); }
        }
        const float ba_ = A.in[8][c], bi_ = A.in[10][c], lam = A.in[11][c];
        const float sp = (lam > 15.f) ? __expf(-lam) : log1pf(__expf(-lam));
#pragma unroll
        for (int tt = 0; tt < 2; ++tt)
#pragma unroll
            for (int r = 0; r < 16; ++r) { const int t = 32 * tt + crow(r, hi);
                const float rr = __builtin_amdgcn_rcpf(1.0f + __builtin_amdgcn_exp2f(-1.4426950408889634f * (ga[tt][r] + ba_))), ii = __builtin_amdgcn_rcpf(1.0f + __builtin_amdgcn_exp2f(-1.4426950408889634f * (gi[tt][r] + bi_)));
                const float a = __builtin_amdgcn_exp2f(-8.0f * 1.4426950408889634f * rr * sp);
                const float xcv = bf2f(xcs[t * XC_LD + c]);
                const float bb = __builtin_amdgcn_sqrtf(fmaxf(1.0f - a * a, 0.f)) * (ii * xcv);
                ga[tt][r] = a; gi[tt][r] = bb; }
        float SA[8], SB[8];
#pragma unroll
        for (int tt = 0; tt < 2; ++tt)
#pragma unroll
            for (int q = 0; q < 4; ++q) {
#pragma unroll
                for (int k = 1; k < 4; ++k) { const int r = 4 * q + k; gi[tt][r] = ga[tt][r] * gi[tt][r - 1] + gi[tt][r]; ga[tt][r] = ga[tt][r] * ga[tt][r - 1]; }
                SA[tt * 4 + q] = ga[tt][4 * q + 3]; SB[tt * 4 + q] = gi[tt][4 * q + 3]; }
        float CA = 1.f, CB = 0.f; float inA[8], inB[8];
#pragma unroll
        for (int s = 0; s < 8; ++s) {
            const float pA = __shfl_xor(SA[s], 32), pB = __shfl_xor(SB[s], 32);
            const float Ae = hi ? pA : SA[s], Be = hi ? pB : SB[s], Ao = hi ? SA[s] : pA, Bo = hi ? SB[s] : pB;
            if (!hi) { inA[s] = CA; inB[s] = CB; }
            CB = Ae * CB + Be; CA = Ae * CA;
            if (hi) { inA[s] = CA; inB[s] = CB; }
            CB = Ao * CB + Bo; CA = Ao * CA;
        }
        unsigned hoff = (unsigned)((row0 + 4 * hi) * 512 + c);
        if (hi == 0) { float* sp2 = SUMM + ((size_t)(b * 128 + chunk) * 512 + c) * 2; sp2[0] = CA; sp2[1] = CB; }
#pragma unroll
        for (int tt = 0; tt < 2; ++tt)
#pragma unroll
            for (int r = 0; r < 16; ++r) { const int s = tt * 4 + (r >> 2);
                const float acum = ga[tt][r] * inA[s], hloc = ga[tt][r] * inB[s] + gi[tt][r];
                asm volatile("" : "+v"(hoff));
                HA[hoff + (unsigned)((32 * tt + (r & 3) + 8 * (r >> 2)) * 512)] = f2bf(hloc) | (f2bf(acum) << 16); }
    }
    __syncthreads();
}
__device__ __forceinline__ void lru_fix_item(const Frame& F, const Args& A, LAS unsigned char* lds, int item, bool zero_nsa) {
    unsigned char* ws = A.ws;
    const int b = item >> 7, chunk = item & 127; const size_t row0 = (size_t)b * SEQ + chunk * 64;
    LAS float* carry = (LAS float*)lds;
    { const int c = F.tid; const float* SUMM = (const float*)(ws + WS_SUMM) + (size_t)b * 128 * 1024 + 2 * c; float hc = 0.f;
      int j = 0;
      for (; j + 8 <= chunk; j += 8) { float2 ab[8];
#pragma unroll
          for (int q = 0; q < 8; ++q) ab[q] = *(const float2*)(SUMM + (size_t)(j + q) * 1024);
#pragma unroll
          for (int q = 0; q < 8; ++q) hc = ab[q].x * hc + ab[q].y; }
      for (; j < chunk; ++j) { const float2 ab = *(const float2*)(SUMM + (size_t)j * 1024); hc = ab.x * hc + ab.y; }
      carry[c] = hc; }
    __syncthreads();
    const bf16* Z = (const bf16*)(ws + WS_Z); const unsigned* HA = (const unsigned*)A.out; bf16* Y = (bf16*)(ws + WS_Y);
    const int c0 = 8 * F.lane;
    float cr[8];
#pragma unroll
    for (int j = 0; j < 8; ++j) cr[j] = carry[c0 + j];
#pragma unroll 1
    for (int t4 = 0; t4 < 8; t4 += 4) {
        v4u h0[4], h1[4], gz[4]; float y[4][8], s[4];
#pragma unroll
        for (int q = 0; q < 4; ++q) { const size_t row = row0 + F.wave * 8 + t4 + q; h0[q] = __builtin_nontemporal_load((const v4u*)(HA + row * 512 + c0)); h1[q] = __builtin_nontemporal_load((const v4u*)(HA + row * 512 + c0 + 4)); gz[q] = __builtin_nontemporal_load((const v4u*)(Z + row * NZ + ZC_GT + c0)); }
#pragma unroll
        for (int q = 0; q < 4; ++q) { const unsigned hw[8] = {h0[q].x, h0[q].y, h0[q].z, h0[q].w, h1[q].x, h1[q].y, h1[q].z, h1[q].w};
            const float gt[8] = {bflo(gz[q].x), bfhi(gz[q].x), bflo(gz[q].y), bfhi(gz[q].y), bflo(gz[q].z), bfhi(gz[q].z), bflo(gz[q].w), bfhi(gz[q].w)};
            s[q] = 0.f;
#pragma unroll
            for (int j = 0; j < 8; ++j) { const float hv = bfhi(hw[j]) * cr[j] + bflo(hw[j]); y[q][j] = hv * gelu_tanh(gt[j]); s[q] += y[q][j] * y[q][j]; } }
#pragma unroll
        for (int o = 1; o < 64; o <<= 1)
#pragma unroll
            for (int q = 0; q < 4; ++q) s[q] += __shfl_xor(s[q], o);
#pragma unroll
        for (int q = 0; q < 4; ++q) { const size_t row = row0 + F.wave * 8 + t4 + q; const float rstd = rsqrtf(s[q] * (1.f / 512.f) + EPS);
            v4u o; o.x = pk2(y[q][0] * rstd, y[q][1] * rstd); o.y = pk2(y[q][2] * rstd, y[q][3] * rstd); o.z = pk2(y[q][4] * rstd, y[q][5] * rstd); o.w = pk2(y[q][6] * rstd, y[q][7] * rstd);
            *(v4u*)(Y + row * DM + 512 + c0) = o;
            if (zero_nsa) *(v4u*)(Y + row * DM + c0) = (v4u){0u, 0u, 0u, 0u}; }
    }
    __syncthreads();
}

__device__ __forceinline__ void kmax_item(const Frame& F, const Args& A, int item) {
    unsigned char* ws = A.ws; const int lane = lane_id();
    const int bk = item >> 9, br = (item >> 8) & 1, tile = item & 255;
    const unsigned char* K = ws + (br ? WS_KWF : WS_KSF) + ((size_t)bk * 256 + tile) * 4096 + 16 * lane;
    float s = 0.f;
#pragma unroll
    for (int ks = 0; ks < 4; ++ks) { const v4u w = *(const v4u*)(K + 1024 * ks); const unsigned ww[4] = {w.x, w.y, w.z, w.w};
#pragma unroll
        for (int k = 0; k < 4; ++k) { const float a = bflo(ww[k]), c = bfhi(ww[k]); s += a * a + c * c; } }
    s = addswap32_f(s);
#pragma unroll
    for (int o = 1; o < 32; o <<= 1) s = fmaxf(s, __shfl_xor(s, o));
    if (lane == 0) atomicMax((unsigned*)(ws + WS_CTL) + CW_KMAX + bk * 2 + br, __builtin_bit_cast(unsigned, s));
}
__device__ __forceinline__ void compress_item(const Frame& F, const Args& A, LAS unsigned char* lds, int item) {
    unsigned char* ws = A.ws;
    const int kv = item >> 6, b = (item >> 5) & 1, h = (item >> 4) & 1, nt = item & 15, n0 = 32 * nt;
    const int lane = F.lane, r32 = lane & 31, hi = lane >> 5, w = F.wave;
    const bf16* Z = (const bf16*)(ws + WS_Z); const bf16* W1T = (const bf16*)(ws + WS_CW1T) + (size_t)kv * 64 * 2048; const bf16* W2T = (const bf16*)(ws + WS_CW2T) + (size_t)kv * 4096;
    const int zc = (kv ? ZC_VC : ZC_KC) + h * 64;
    LAS float* part = (LAS float*)lds;
    LAS float* G = (LAS float*)(lds + 65536);
    {
        int n = n0 + r32; if (n > 510) n = 510;
        f32x16 acc[2]; acc[0] = f32x16{}; acc[1] = f32x16{};
#pragma unroll 4
        for (int kk = 0; kk < 16; ++kk) { const int ks = 16 * w + kk, l = ks >> 2, d0 = (ks & 3) * 16 + 8 * hi;
            const bf16x8 bfr = *(const bf16x8*)(Z + ((size_t)b * SEQ + 16 * n + l) * NZ + zc + d0);
            const bf16x8 a0 = *(const bf16x8*)(W1T + (size_t)(r32) * 2048 + ks * 16 + 8 * hi), a1 = *(const bf16x8*)(W1T + (size_t)(32 + r32) * 2048 + ks * 16 + 8 * hi);
            acc[0] = __builtin_amdgcn_mfma_f32_32x32x16_bf16(a0, bfr, acc[0], 0, 0, 0); acc[1] = __builtin_amdgcn_mfma_f32_32x32x16_bf16(a1, bfr, acc[1], 0, 0, 0); }
#pragma unroll
        for (int ot = 0; ot < 2; ++ot)
#pragma unroll
            for (int r = 0; r < 16; ++r) part[(w * 64 + 32 * ot + crow(r, hi)) * 32 + r32] = acc[ot][r];
    }
    __syncthreads();
    { const float* c1 = (const float*)(ws + WS_C1) + kv * 16 * 64;
#pragma unroll
      for (int i = 0; i < 4; ++i) { const int e = F.tid + 512 * i, o = e >> 5, n = e & 31; float s = 0.f;
#pragma unroll
          for (int ch = 0; ch < 16; ++ch) s += c1[ch * 64 + o];
#pragma unroll
          for (int ww = 0; ww < 8; ++ww) s += part[(ww * 64 + o) * 32 + n];
          G[o * 33 + n] = gelu_tanh(s); } }
    __syncthreads();
    if (w < 2) {
        f32x16 acc = f32x16{};
#pragma unroll
        for (int ks = 0; ks < 4; ++ks) { const bf16x8 a = *(const bf16x8*)(W2T + (size_t)(32 * w + r32) * 64 + 16 * ks + 8 * hi);
            v4u bw; const LAS float* gp = G + (16 * ks + 8 * hi) * 33 + r32;
            bw.x = pk2(gp[0], gp[33]); bw.y = pk2(gp[66], gp[99]); bw.z = pk2(gp[132], gp[165]); bw.w = pk2(gp[198], gp[231]);
            acc = __builtin_amdgcn_mfma_f32_32x32x16_bf16(a, __builtin_bit_cast(bf16x8, bw), acc, 0, 0, 0); }
        const int n = n0 + r32;
        const size_t tbase = ((size_t)(b * 2 + h) * 16 + nt) * 2048;
        if (kv == 0) { bf16* KC = (bf16*)(ws + WS_KC) + tbase;
#pragma unroll
            for (int q = 0; q < 4; ++q) { v2u o; o.x = pk2(acc[4 * q], acc[4 * q + 1]); o.y = pk2(acc[4 * q + 2], acc[4 * q + 3]); if (n > 510) { o.x = 0u; o.y = 0u; }
                *(v2u*)(KC + (2 * w + (q >> 1)) * 512 + (q & 1) * 256 + r32 * 8 + 4 * hi) = o; } }
        else { bf16* VC = (bf16*)(ws + WS_VCT) + tbase; const int kk = r32 & 15, vo = (r32 >> 4) * 512 + ((kk >> 2) & 1) * 256 + (kk & 3) + 4 * (kk >> 3);
#pragma unroll
            for (int r = 0; r < 16; ++r) VC[w * 1024 + crow(r, hi) * 8 + vo] = (n > 510) ? (bf16)0 : (bf16)f2bf(acc[r]); }
    }
    __syncthreads();
}

__device__ __forceinline__ void sort16_desc(int (&k)[16]) {
#define CX(i, j) { const int hi_ = max(k[i], k[j]), lo_ = min(k[i], k[j]); k[i] = hi_; k[j] = lo_; }
    CX(0, 1) CX(2, 3) CX(0, 2) CX(1, 3) CX(1, 2) CX(4, 5) CX(6, 7) CX(4, 6) CX(5, 7) CX(5, 6) CX(0, 4) CX(2, 6) CX(2, 4) CX(1, 5) CX(3, 7) CX(3, 5) CX(1, 2)
    CX(3, 4) CX(5, 6) CX(8, 9) CX(10, 11) CX(8, 10) CX(9, 11) CX(9, 10) CX(12, 13) CX(14, 15) CX(12, 14) CX(13, 15) CX(13, 14) CX(8, 12) CX(10, 14) CX(10, 12)
    CX(9, 13) CX(11, 15) CX(11, 13) CX(9, 10) CX(11, 12) CX(13, 14) CX(0, 8) CX(4, 12) CX(4, 8) CX(2, 10) CX(6, 14) CX(6, 10) CX(2, 4) CX(6, 8) CX(10, 12)
    CX(1, 9) CX(5, 13) CX(5, 9) CX(3, 11) CX(7, 15) CX(7, 11) CX(3, 5) CX(7, 9) CX(11, 13) CX(1, 2) CX(3, 4) CX(5, 6) CX(7, 8) CX(9, 10) CX(11, 12) CX(13, 14)
#undef CX
}
__device__ __forceinline__ void sort32_desc(int (&k)[32]) {
#define CX(i, j) { const int hi_ = max(k[i], k[j]), lo_ = min(k[i], k[j]); k[i] = hi_; k[j] = lo_; }
    CX(0, 1) CX(2, 3) CX(0, 2) CX(1, 3) CX(1, 2) CX(4, 5) CX(6, 7) CX(4, 6) CX(5, 7) CX(5, 6) CX(0, 4) CX(2, 6) CX(2, 4) CX(1, 5) CX(3, 7) CX(3, 5) CX(1, 2)
    CX(3, 4) CX(5, 6) CX(8, 9) CX(10, 11) CX(8, 10) CX(9, 11) CX(9, 10) CX(12, 13) CX(14, 15) CX(12, 14) CX(13, 15) CX(13, 14) CX(8, 12) CX(10, 14) CX(10, 12)
    CX(9, 13) CX(11, 15) CX(11, 13) CX(9, 10) CX(11, 12) CX(13, 14) CX(0, 8) CX(4, 12) CX(4, 8) CX(2, 10) CX(6, 14) CX(6, 10) CX(2, 4) CX(6, 8) CX(10, 12)
    CX(1, 9) CX(5, 13) CX(5, 9) CX(3, 11) CX(7, 15) CX(7, 11) CX(3, 5) CX(7, 9) CX(11, 13) CX(1, 2) CX(3, 4) CX(5, 6) CX(7, 8) CX(9, 10) CX(11, 12) CX(13, 14)
    CX(16, 17) CX(18, 19) CX(16, 18) CX(17, 19) CX(17, 18) CX(20, 21) CX(22, 23) CX(20, 22) CX(21, 23) CX(21, 22) CX(16, 20) CX(18, 22) CX(18, 20) CX(17, 21)
    CX(19, 23) CX(19, 21) CX(17, 18) CX(19, 20) CX(21, 22) CX(24, 25) CX(26, 27) CX(24, 26) CX(25, 27) CX(25, 26) CX(28, 29) CX(30, 31) CX(28, 30) CX(29, 31)
    CX(29, 30) CX(24, 28) CX(26, 30) CX(26, 28) CX(25, 29) CX(27, 31) CX(27, 29) CX(25, 26) CX(27, 28) CX(29, 30) CX(16, 24) CX(20, 28) CX(20, 24) CX(18, 26)
    CX(22, 30) CX(22, 26) CX(18, 20) CX(22, 24) CX(26, 28) CX(17, 25) CX(21, 29) CX(21, 25) CX(19, 27) CX(23, 31) CX(23, 27) CX(19, 21) CX(23, 25) CX(27, 29)
    CX(17, 18) CX(19, 20) CX(21, 22) CX(23, 24) CX(25, 26) CX(27, 28) CX(29, 30) CX(0, 16) CX(8, 24) CX(8, 16) CX(4, 20) CX(12, 28) CX(12, 20) CX(4, 8)
    CX(12, 16) CX(20, 24) CX(2, 18) CX(10, 26) CX(10, 18) CX(6, 22) CX(14, 30) CX(14, 22) CX(6, 10) CX(14, 18) CX(22, 26) CX(2, 4) CX(6, 8) CX(10, 12)
    CX(14, 16) CX(18, 20) CX(22, 24) CX(26, 28) CX(1, 17) CX(9, 25) CX(9, 17) CX(5, 21) CX(13, 29) CX(13, 21) CX(5, 9) CX(13, 17) CX(21, 25) CX(3, 19)
    CX(11, 27) CX(11, 19) CX(7, 23) CX(15, 31) CX(15, 23) CX(7, 11) CX(15, 19) CX(23, 27) CX(3, 5) CX(7, 9) CX(11, 13) CX(15, 17) CX(19, 21) CX(23, 25)
    CX(27, 29) CX(1, 2) CX(3, 4) CX(5, 6) CX(7, 8) CX(9, 10) CX(11, 12) CX(13, 14) CX(15, 16) CX(17, 18) CX(19, 20) CX(21, 22) CX(23, 24) CX(25, 26) CX(27, 28)
    CX(29, 30)
#undef CX
}
__device__ __forceinline__ void bitonic16_desc(int (&a)[16]) {
#pragma unroll
    for (int s = 8; s >= 1; s >>= 1)
#pragma unroll
        for (int i = 0; i < 16; ++i) if ((i & s) == 0) { const int hi_ = max(a[i], a[i + s]), lo_ = min(a[i], a[i + s]); a[i] = hi_; a[i + s] = lo_; }
}
__device__ __forceinline__ void merge16_desc(int (&a)[16], const int (&b)[16]) {
#pragma unroll
    for (int i = 0; i < 16; ++i) a[i] = max(a[i], b[15 - i]);
    bitonic16_desc(a);
}
struct AttnSt { float m, l; f32x16 o[2]; };
#define EX2(x) __builtin_amdgcn_exp2f(x)
struct KVF { bf16x8 k[4]; bf16x8 v[2][2]; };
struct KVF8 { bf16x8 k[4]; v4u v8[2]; };
__device__ __forceinline__ void kv_load8(KVF8& f, const bf16* Kt, const unsigned char* Vt8, unsigned lo16) {
    const char* kb = (const char*)Kt + lo16;
#pragma unroll
    for (int ks = 0; ks < 4; ++ks) f.k[ks] = *(const bf16x8*)(kb + 1024 * ks);
#pragma unroll
    for (int dt = 0; dt < 2; ++dt) f.v8[dt] = *(const v4u*)(Vt8 + lo16 + 1024 * dt);
}
typedef __bf16 bf16x2v __attribute__((ext_vector_type(2)));
__device__ __forceinline__ bf16x8 dq8(unsigned w0, unsigned w1) {
    v4u o; o.x = __builtin_bit_cast(unsigned, __builtin_amdgcn_cvt_scalef32_pk_bf16_fp8(w0, 1.0f, false)); o.y = __builtin_bit_cast(unsigned, __builtin_amdgcn_cvt_scalef32_pk_bf16_fp8(w0, 1.0f, true));
    o.z = __builtin_bit_cast(unsigned, __builtin_amdgcn_cvt_scalef32_pk_bf16_fp8(w1, 1.0f, false)); o.w = __builtin_bit_cast(unsigned, __builtin_amdgcn_cvt_scalef32_pk_bf16_fp8(w1, 1.0f, true));
    return __builtin_bit_cast(bf16x8, o); }
__device__ __forceinline__ void kv_load(KVF& f, const bf16* Kt, const bf16* Vt, unsigned lo16) {
    const char* kb = (const char*)Kt + lo16; const char* vb = (const char*)Vt + lo16;
#pragma unroll
    for (int ks = 0; ks < 4; ++ks) f.k[ks] = *(const bf16x8*)(kb + 1024 * ks);
#pragma unroll
    for (int dt = 0; dt < 2; ++dt)
#pragma unroll
        for (int s2 = 0; s2 < 2; ++s2) f.v[dt][s2] = *(const bf16x8*)(vb + 2048 * dt + 1024 * s2);
}
#define MAX3(a, b, c) __builtin_fmaxf(__builtin_fmaxf((a), (b)), (c))
__device__ __forceinline__ float max16(const f32x16& s) { const float a = MAX3(s[0], s[1], s[2]), b = MAX3(s[3], s[4], s[5]), c = MAX3(s[6], s[7], s[8]), d = MAX3(s[9], s[10], s[11]), e = MAX3(s[12], s[13], s[14]);
    return MAX3(MAX3(a, b, c), MAX3(d, e, s[15]), -1e30f); }
__device__ __forceinline__ float sum16(const f32x16& s) { return (((s[0] + s[1]) + (s[2] + s[3])) + ((s[4] + s[5]) + (s[6] + s[7]))) + (((s[8] + s[9]) + (s[10] + s[11])) + ((s[12] + s[13]) + (s[14] + s[15]))); }
template <int MODE, bool FIXED, class AllowF>
__device__ __forceinline__ void attn_compute(const KVF8& f, const bf16x8 (&qf)[4], const f32x16& negm, bool sel, AllowF allow, AttnSt& st) {
    f32x16 s = FIXED ? negm : f32x16{};
#pragma unroll
    for (int ks = 0; ks < 4; ++ks) s = __builtin_amdgcn_mfma_f32_32x32x16_bf16(f.k[ks], qf[ks], s, 0, 0, 0);
    if (MODE == 2) {
#pragma unroll
        for (int r = 0; r < 16; ++r) if (!allow(r)) s[r] = -1e30f; }
    if (!FIXED) {
        float mt = max16(s);
        if (MODE == 1) mt = sel ? mt : -1e30f;
        mt = maxswap32_f(mt);
        if (__any(mt > st.m)) {
            const float mn = fmaxf(st.m, mt), alpha = EX2(st.m - mn);
            st.m = mn; st.l *= alpha;
#pragma unroll
            for (int dt = 0; dt < 2; ++dt)
#pragma unroll
                for (int r = 0; r < 16; ++r) st.o[dt][r] *= alpha;
        }
        const float mref = (MODE == 1 && !sel) ? 1e30f : fmaxf(st.m, -1e29f);
#pragma unroll
        for (int r = 0; r < 16; ++r) s[r] = EX2(s[r] - mref);
        st.l += sum16(s);
    } else {
#pragma unroll
        for (int r = 0; r < 16; ++r) s[r] = EX2(s[r]);
        const float ps = sum16(s);
        st.l += (MODE == 1 && !sel) ? 0.f : ps;
    }
#pragma unroll
    for (int s2 = 0; s2 < 2; ++s2) { v4u pw; pw.x = pk2(s[8 * s2], s[8 * s2 + 1]); pw.y = pk2(s[8 * s2 + 2], s[8 * s2 + 3]); pw.z = pk2(s[8 * s2 + 4], s[8 * s2 + 5]); pw.w = pk2(s[8 * s2 + 6], s[8 * s2 + 7]);
        if (FIXED && MODE == 1) { pw.x = sel ? pw.x : 0u; pw.y = sel ? pw.y : 0u; pw.z = sel ? pw.z : 0u; pw.w = sel ? pw.w : 0u; }
        const bf16x8 pf = __builtin_bit_cast(bf16x8, pw);
#pragma unroll
        for (int dt = 0; dt < 2; ++dt) st.o[dt] = __builtin_amdgcn_mfma_f32_32x32x16_bf16(dq8(f.v8[dt][2 * s2], f.v8[dt][2 * s2 + 1]), pf, st.o[dt], 0, 0, 0); }
}
constexpr int IMP_LD = 132;
__device__ __forceinline__ void nsa_item(const Frame& F, const Args& A, LAS unsigned char* lds, int b, int kvh, int tb, int wsub) {
    unsigned char* ws = A.ws;
    int lane = lane_id(); asm volatile("" : "+v"(lane));
    const int r32 = lane & 31, hi = lane >> 5, w = F.wave;
    const int t0 = 64 * tb + 8 * wsub, ti = r32 & 7, g = r32 >> 3, t = t0 + ti, cur = tb;
    const size_t rowb = (size_t)b * SEQ;
    const bf16* Z = (const bf16*)(ws + WS_Z);
    LAS float* imp = (LAS float*)lds + w * 8 * IMP_LD;
    for (int i = lane; i < 8 * IMP_LD; i += 64) imp[i] = 0.f;
    bf16x8 qf[4];
#pragma unroll
    for (int ks = 0; ks < 4; ++ks) qf[ks] = *(const bf16x8*)(Z + (rowb + t) * NZ + ZC_Q + (kvh * 4 + g) * 64 + 16 * ks + 8 * hi);
    const float* gp = (const float*)(ws + WS_GATES) + (rowb + t) * 24 + (kvh * 4 + g) * 3;
    const float gate_c = gp[0], gate_s = gp[1], gate_w = gp[2];
    LAS float* oacc = (LAS float*)(lds + 8 * 8 * IMP_LD * 4) + w * 2048 + lane;
    {
        const bf16* KC = (const bf16*)(ws + WS_KC) + (size_t)(b * 2 + kvh) * 16 * 2048;
        const bf16* VCT = (const bf16*)(ws + WS_VCT) + (size_t)(b * 2 + kvh) * 16 * 2048;
        const int nv = (t >= 31) ? ((t - 31) >> 4) + 1 : 0;
        const int tl = t0 + 7, nvmax = (tl >= 31) ? ((tl - 31) >> 4) + 1 : 0;
        const unsigned lo16 = 16u * (unsigned)lane;
        float m1 = -1e30f, l1 = 0.f;
        {
            bf16x8 ka[4], kb[4];
#pragma unroll
            for (int ks = 0; ks < 4; ++ks) ka[ks] = *(const bf16x8*)((const char*)KC + lo16 + 1024 * ks);
            for (int n0 = 0; n0 < nvmax; n0 += 32) {
                if (n0 + 32 < nvmax) {
#pragma unroll
                    for (int ks = 0; ks < 4; ++ks) kb[ks] = *(const bf16x8*)((const char*)(KC + (size_t)(n0 + 32) * 64) + lo16 + 1024 * ks);
                }
                f32x16 s = f32x16{};
#pragma unroll
                for (int ks = 0; ks < 4; ++ks) s = __builtin_amdgcn_mfma_f32_32x32x16_bf16(ka[ks], qf[ks], s, 0, 0, 0);
                float mt = -1e30f;
#pragma unroll
                for (int r = 0; r < 16; ++r) { if (n0 + crow(r, hi) >= nv) s[r] = -1e30f; mt = fmaxf(mt, s[r]); }
                const float mn = fmaxf(m1, mt); float ps = 0.f;
#pragma unroll
                for (int r = 0; r < 16; ++r) ps += (s[r] > -1e29f) ? EX2(s[r] - mn) : 0.f;
                l1 = l1 * EX2(m1 - mn) + ps; m1 = mn;
#pragma unroll
                for (int ks = 0; ks < 4; ++ks) ka[ks] = kb[ks];
            }
        }
        { const float mo = __shfl_xor(m1, 32), lo = __shfl_xor(l1, 32); const float mn = fmaxf(m1, mo); l1 = l1 * EX2(m1 - mn) + lo * EX2(mo - mn); m1 = mn; }
        const float invl = (l1 > 0.f) ? 1.0f / l1 : 0.f;
        f32x16 o[2]; o[0] = f32x16{}; o[1] = f32x16{};
        KVF fa, fb;
        if (nvmax > 0) kv_load(fa, KC, VCT, lo16);
        for (int n0 = 0; n0 < nvmax; n0 += 32) {
            if (n0 + 32 < nvmax) kv_load(fb, KC + (size_t)(n0 + 32) * 64, VCT + (size_t)(n0 + 32) * 64, lo16);
            f32x16 s = f32x16{};
#pragma unroll
            for (int ks = 0; ks < 4; ++ks) s = __builtin_amdgcn_mfma_f32_32x32x16_bf16(fa.k[ks], qf[ks], s, 0, 0, 0);
#pragma unroll
            for (int r = 0; r < 16; ++r) s[r] = (n0 + crow(r, hi) < nv) ? EX2(s[r] - m1) * invl : 0.f;
            float bs[4], sp[4];
#pragma unroll
            for (int q = 0; q < 4; ++q) { bs[q] = (s[4 * q] + s[4 * q + 1]) + (s[4 * q + 2] + s[4 * q + 3]); sp[q] = s[4 * q + 3];
                bs[q] += __shfl_xor(bs[q], 8); bs[q] += __shfl_xor(bs[q], 16); sp[q] += __shfl_xor(sp[q], 8); sp[q] += __shfl_xor(sp[q], 16); }
            if (r32 < 8) {
                LAS float* ip = imp + r32 * IMP_LD + (n0 >> 2) + hi;
#pragma unroll
                for (int q = 0; q < 4; ++q) ip[2 * q] += bs[q];
                asm volatile("s_waitcnt lgkmcnt(0)" ::: "memory");
#pragma unroll
                for (int q = 0; q < 4; ++q) ip[2 * q + 1] += sp[q];
                asm volatile("s_waitcnt lgkmcnt(0)" ::: "memory");
            }
#pragma unroll
            for (int s2 = 0; s2 < 2; ++s2) { v4u pw; pw.x = pk2(s[8 * s2], s[8 * s2 + 1]); pw.y = pk2(s[8 * s2 + 2], s[8 * s2 + 3]); pw.z = pk2(s[8 * s2 + 4], s[8 * s2 + 5]); pw.w = pk2(s[8 * s2 + 6], s[8 * s2 + 7]);
                const bf16x8 pf = __builtin_bit_cast(bf16x8, pw);
#pragma unroll
                for (int dt = 0; dt < 2; ++dt) o[dt] = __builtin_amdgcn_mfma_f32_32x32x16_bf16(fa.v[dt][s2], pf, o[dt], 0, 0, 0); }
            if (n0 + 32 < nvmax) fa = fb;
        }
#pragma unroll
        for (int dt = 0; dt < 2; ++dt)
#pragma unroll
            for (int r = 0; r < 16; ++r) oacc[(dt * 16 + r) * 64] = gate_c * o[dt][r];
    }
    asm volatile("s_waitcnt lgkmcnt(0)" ::: "memory");
    unsigned mym[4] = {0u, 0u, 0u, 0u}, un[4] = {0u, 0u, 0u, 0u};
    if (cur < 16) { const unsigned mk = (2u << cur) - 1u; mym[0] = mk; un[0] = mk; }
    else {
        const int tq = lane >> 3, sub = lane & 7;
        int key[16];
#pragma unroll
        for (int i = 0; i < 16; ++i) { const int j = 16 * sub + i; const float v = imp[tq * IMP_LD + j];
            key[i] = (j >= 1 && j <= cur - 2) ? (int)((__builtin_bit_cast(unsigned, v) & ~0x7fu) | (unsigned)(127 - j)) : 0; }
        sort16_desc(key);
        { int ot[16];
#pragma unroll
          for (int i = 0; i < 16; ++i) ot[i] = __builtin_amdgcn_mov_dpp(key[i], 0xB1, 0xf, 0xf, true);
          merge16_desc(key, ot);
#pragma unroll
          for (int i = 0; i < 16; ++i) ot[i] = __builtin_amdgcn_mov_dpp(key[i], 0x4E, 0xf, 0xf, true);
          merge16_desc(key, ot);
#pragma unroll
          for (int i = 0; i < 16; ++i) ot[i] = __builtin_amdgcn_mov_dpp(key[i], 0x141, 0xf, 0xf, true);
          merge16_desc(key, ot); }
        unsigned mk[4] = {1u, 0u, 0u, 0u};
        { const int c1 = cur - 1; if (c1 < 32) mk[0] |= 1u << c1; else if (c1 < 64) mk[1] |= 1u << (c1 - 32); else if (c1 < 96) mk[2] |= 1u << (c1 - 64); else mk[3] |= 1u << (c1 - 96);
          if (cur < 32) mk[0] |= 1u << cur; else if (cur < 64) mk[1] |= 1u << (cur - 32); else if (cur < 96) mk[2] |= 1u << (cur - 64); else mk[3] |= 1u << (cur - 96); }
#pragma unroll
        for (int i = 0; i < 13; ++i) { const int j = 127 - (key[i] & 0x7f); const unsigned bit = (key[i] != 0) ? (1u << (j & 31)) : 0u; const int wd = j >> 5;
            mk[0] |= (wd == 0) ? bit : 0u; mk[1] |= (wd == 1) ? bit : 0u; mk[2] |= (wd == 2) ? bit : 0u; mk[3] |= (wd == 3) ? bit : 0u; }
#pragma unroll
        for (int i = 0; i < 4; ++i) { unsigned u = mk[i]; u |= (unsigned)__shfl_xor((int)u, 8); u |= (unsigned)__shfl_xor((int)u, 16); u |= (unsigned)__shfl_xor((int)u, 32); un[i] = u;
            mym[i] = (unsigned)__shfl((int)mk[i], 8 * ti); }
    }
    float q2 = 0.f;
#pragma unroll
    for (int ks = 0; ks < 4; ++ks) { const v4u qw = __builtin_bit_cast(v4u, qf[ks]); const unsigned ww[4] = {qw.x, qw.y, qw.z, qw.w};
#pragma unroll
        for (int k = 0; k < 4; ++k) { const float a = bflo(ww[k]), c = bfhi(ww[k]); q2 += a * a + c * c; } }
    q2 = addswap32_f(q2);
    const unsigned* KMX = (const unsigned*)(ws + WS_CTL) + CW_KMAX + (b * 2 + kvh) * 2;
    const float Ms = __builtin_amdgcn_sqrtf(q2 * __builtin_bit_cast(float, KMX[0])) * 1.0001f + 1e-3f, Mw = __builtin_amdgcn_sqrtf(q2 * __builtin_bit_cast(float, KMX[1])) * 1.0001f + 1e-3f;
    const bool fixed_ok = !__any(Ms >= 60.f || Mw >= 60.f);
    {
        AttnSt st; st.m = -1e30f; st.l = 0.f; st.o[0] = f32x16{}; st.o[1] = f32x16{};
        const bf16* KS = (const bf16*)(ws + WS_KSF) + (size_t)(b * 2 + kvh) * 256 * 2048; const unsigned char* VS = ws + WS_VSF + (size_t)(b * 2 + kvh) * 256 * 2048;
        const unsigned lo16 = 16u * (unsigned)lane;
        unsigned um0 = (unsigned)__builtin_amdgcn_readfirstlane((int)un[0]), um1 = (unsigned)__builtin_amdgcn_readfirstlane((int)un[1]), um2 = (unsigned)__builtin_amdgcn_readfirstlane((int)un[2]), um3 = (unsigned)__builtin_amdgcn_readfirstlane((int)un[3]);
#define NEXT_BLOCK(jv) do { if (um0) { jv = __builtin_ctz(um0); um0 &= um0 - 1u; } else if (um1) { jv = 32 + __builtin_ctz(um1); um1 &= um1 - 1u; } else if (um2) { jv = 64 + __builtin_ctz(um2); um2 &= um2 - 1u; } \
            else if (um3) { jv = 96 + __builtin_ctz(um3); um3 &= um3 - 1u; } else jv = -1; } while (0)
#define SLC_LOOP(FX) do { f32x16 negm; _Pragma("unroll") for (int r = 0; r < 16; ++r) negm[r] = -Ms; \
        KVF8 fa, fb; int j; NEXT_BLOCK(j); \
        if (j >= 0) kv_load8(fa, KS + (size_t)j * 4096, VS + (size_t)j * 4096, lo16); \
        while (j >= 0) { const int key0 = j * 64; \
            const unsigned mw = (j < 32) ? mym[0] : (j < 64) ? mym[1] : (j < 96) ? mym[2] : mym[3]; const bool sel = (mw >> (j & 31)) & 1u; \
            kv_load8(fb, KS + (size_t)j * 4096 + 2048, VS + (size_t)j * 4096 + 2048, lo16); \
            if (j == cur) attn_compute<2, FX>(fa, qf, negm, sel, [&](int r) { return sel && (key0 + crow(r, hi) <= t); }, st); \
            else attn_compute<1, FX>(fa, qf, negm, sel, [&](int) { return true; }, st); \
            int jn; NEXT_BLOCK(jn); \
            if (jn >= 0) kv_load8(fa, KS + (size_t)jn * 4096, VS + (size_t)jn * 4096, lo16); \
            if (j == cur) attn_compute<2, FX>(fb, qf, negm, sel, [&](int r) { return sel && (key0 + 32 + crow(r, hi) <= t); }, st); \
            else attn_compute<1, FX>(fb, qf, negm, sel, [&](int) { return true; }, st); \
            j = jn; } } while (0)
        if (fixed_ok) SLC_LOOP(true); else SLC_LOOP(false);
#undef SLC_LOOP
#undef NEXT_BLOCK
        const float l = addswap32_f(st.l); const float sc = gate_s / l;
#pragma unroll
        for (int dt = 0; dt < 2; ++dt)
#pragma unroll
            for (int r = 0; r < 16; ++r) oacc[(dt * 16 + r) * 64] += sc * st.o[dt][r];
    }
    f32x16 outv[2];
    {
        AttnSt st; st.m = -1e30f; st.l = 0.f; st.o[0] = f32x16{}; st.o[1] = f32x16{};
        const bf16* KW = (const bf16*)(ws + WS_KWF) + (size_t)(b * 2 + kvh) * 256 * 2048; const unsigned char* VW = ws + WS_VWF + (size_t)(b * 2 + kvh) * 256 * 2048;
        const unsigned lo16 = 16u * (unsigned)lane;
        const int klo = (t0 - 511 > 0) ? ((t0 - 511) & ~31) : 0, khi = (t0 + 7) & ~31;
#define WIN_LOOP(FX) do { f32x16 negm; _Pragma("unroll") for (int r = 0; r < 16; ++r) negm[r] = -Mw; \
        KVF8 fa, fb; kv_load8(fa, KW + (size_t)klo * 64, VW + (size_t)klo * 64, lo16); \
        _Pragma("unroll 1") for (int key0 = klo; key0 <= khi; key0 += 32) { \
            if (key0 + 32 <= khi) kv_load8(fb, KW + (size_t)(key0 + 32) * 64, VW + (size_t)(key0 + 32) * 64, lo16); \
            if (key0 + 31 > t0 || key0 <= t0 + 7 - 512) attn_compute<2, FX>(fa, qf, negm, true, [&](int r) { const int kp = key0 + crow(r, hi); return kp <= t && kp > t - 512; }, st); \
            else attn_compute<0, FX>(fa, qf, negm, true, [&](int) { return true; }, st); \
            if (key0 + 32 <= khi) fa = fb; } } while (0)
        if (fixed_ok) WIN_LOOP(true); else WIN_LOOP(false);
#undef WIN_LOOP
        const float l = addswap32_f(st.l); const float sc = gate_w / l;
#pragma unroll
        for (int dt = 0; dt < 2; ++dt)
#pragma unroll
            for (int r = 0; r < 16; ++r) outv[dt][r] = oacc[(dt * 16 + r) * 64] + sc * st.o[dt][r];
    }
    float ss = 0.f;
#pragma unroll
    for (int dt = 0; dt < 2; ++dt)
#pragma unroll
        for (int r = 0; r < 16; ++r) ss += outv[dt][r] * outv[dt][r];
    ss += __shfl_xor(ss, 32); ss += __shfl_xor(ss, 8); ss += __shfl_xor(ss, 16);
    if (lane < 8) ((float*)(ws + WS_SSQN))[(rowb + t0 + lane) * 2 + kvh] = ss;
    bf16* Yp = (bf16*)(ws + WS_Y) + (rowb + t) * DM + (kvh * 4 + g) * 64 + 4 * hi;
#pragma unroll
    for (int dt = 0; dt < 2; ++dt)
#pragma unroll
        for (int q = 0; q < 4; ++q) { v2u o; o.x = pk2(outv[dt][4 * q], outv[dt][4 * q + 1]); o.y = pk2(outv[dt][4 * q + 2], outv[dt][4 * q + 3]); *(v2u*)(Yp + 32 * dt + 8 * q) = o; }
}
__device__ __forceinline__ void memattn_block(const Frame& F, const Args& A, LAS unsigned char* lds, int item) {
    unsigned char* ws = A.ws;
    const int lane = F.lane, r32 = lane & 31, hi = lane >> 5, w = F.wave;
    const int h = item & 3, tg = item >> 2, b = tg >> 5, tile = tg * 8 + w; const size_t row0 = (size_t)tile * 32;
    const bf16* Q = (const bf16*)(ws + WS_QM) + (size_t)tile * 32 * DM + (size_t)(h * 16) * 512 + 8 * lane;
    { const char* Kg = (const char*)((const bf16*)(ws + WS_MEMK) + (size_t)(b * 8 + w) * 32 * DM + (size_t)(h * 16) * 512) + 16 * lane;
#pragma unroll
      for (int j = 0; j < 16; ++j) __builtin_amdgcn_global_load_lds((const unsigned*)(Kg + j * 1024), (LAS unsigned*)(lds + (w * 16 + j) * 1024), 16, 0, 0); }
    f32x16 s[8];
#pragma unroll
    for (int kt = 0; kt < 8; ++kt) s[kt] = f32x16{};
    const LAS unsigned char* lf = lds + 16 * lane;
    asm volatile("s_waitcnt vmcnt(0)" ::: "memory");
    __syncthreads();
#define QK_LOAD(qv, kv, ks_) do { const int kk_ = (ks_) < 16 ? (ks_) : 15; qv = __builtin_nontemporal_load((const bf16x8*)(Q + 512 * kk_)); _Pragma("unroll") for (int kt = 0; kt < 8; ++kt) kv[kt] = *(const LAS bf16x8*)(lf + (kt * 16 + kk_) * 1024); } while (0)
#define QK_MMA(qv, kv) do { _Pragma("unroll") for (int kt = 0; kt < 8; ++kt) s[kt] = __builtin_amdgcn_mfma_f32_32x32x16_bf16(kv[kt], qv, s[kt], 0, 0, 0); } while (0)
    { bf16x8 qa, qb, ka[8], kb[8];
      QK_LOAD(qa, ka, 0);
#pragma unroll 1
      for (int ks = 0; ks < 16; ks += 2) {
          QK_LOAD(qb, kb, ks + 1); asm volatile("" ::: "memory");
          QK_MMA(qa, ka);
          QK_LOAD(qa, ka, ks + 2); asm volatile("" ::: "memory");
          QK_MMA(qb, kb); } }
#undef QK_LOAD
#undef QK_MMA
    asm volatile("s_waitcnt vmcnt(0) lgkmcnt(0)" ::: "memory");
    __syncthreads();
    { const char* Vg = (const char*)((const bf16*)(ws + WS_MEMVT) + (size_t)((b * 4 + h) * 8 + w) * 8192) + 16 * lane;
#pragma unroll
      for (int j = 0; j < 16; ++j) __builtin_amdgcn_global_load_lds((const unsigned*)(Vg + j * 1024), (LAS unsigned*)(lds + (w * 16 + j) * 1024), 16, 0, 0); }
    float m = -1e30f;
#pragma unroll
    for (int kt = 0; kt < 8; ++kt) m = fmaxf(m, max16(s[kt]));
    m = maxswap32_f(m);
    float l = 0.f; v4u pw[8][2];
#pragma unroll
    for (int kt = 0; kt < 8; ++kt) {
#pragma unroll
        for (int r = 0; r < 16; ++r) s[kt][r] = EX2(s[kt][r] - m);
        l += sum16(s[kt]);
#pragma unroll
        for (int s2 = 0; s2 < 2; ++s2) { pw[kt][s2].x = pk2(s[kt][8 * s2], s[kt][8 * s2 + 1]); pw[kt][s2].y = pk2(s[kt][8 * s2 + 2], s[kt][8 * s2 + 3]); pw[kt][s2].z = pk2(s[kt][8 * s2 + 4], s[kt][8 * s2 + 5]); pw[kt][s2].w = pk2(s[kt][8 * s2 + 6], s[kt][8 * s2 + 7]); } }
    l = addswap32_f(l);
    const float invl = 1.0f / l;
    bf16* O = (bf16*)(ws + WS_OM) + (row0 + r32) * DM + h * 256 + 4 * hi;
    asm volatile("s_waitcnt vmcnt(0)" ::: "memory");
    __syncthreads();
#define PV_LOAD(vv, dt_) do { const int dd_ = (dt_) < 8 ? (dt_) : 7; _Pragma("unroll") for (int kt = 0; kt < 8; ++kt) _Pragma("unroll") for (int s2 = 0; s2 < 2; ++s2) vv[2 * kt + s2] = *(const LAS bf16x8*)(lf + (kt * 16 + dd_ * 2 + s2) * 1024); } while (0)
#define PV_MMA(vv, dt_) do { f32x16 o = f32x16{}; _Pragma("unroll") for (int kt = 0; kt < 8; ++kt) _Pragma("unroll") for (int s2 = 0; s2 < 2; ++s2) o = __builtin_amdgcn_mfma_f32_32x32x16_bf16(vv[2 * kt + s2], __builtin_bit_cast(bf16x8, pw[kt][s2]), o, 0, 0, 0); \
        _Pragma("unroll") for (int q = 0; q < 4; ++q) { v2u ov; ov.x = pk2(o[4 * q] * invl, o[4 * q + 1] * invl); ov.y = pk2(o[4 * q + 2] * invl, o[4 * q + 3] * invl); *(v2u*)(O + 32 * (dt_) + 8 * q) = ov; } } while (0)
    { bf16x8 va[16], vb[16];
      PV_LOAD(va, 0);
#pragma unroll 1
      for (int dt = 0; dt < 8; dt += 2) {
          PV_LOAD(vb, dt + 1); asm volatile("" ::: "memory");
          PV_MMA(va, dt);
          PV_LOAD(va, dt + 2); asm volatile("" ::: "memory");
          PV_MMA(vb, dt + 1); } }
#undef PV_LOAD
#undef PV_MMA
    asm volatile("s_waitcnt lgkmcnt(0)" ::: "memory");
    __syncthreads();
}

__device__ __forceinline__ int f2key(float f) { const int u = __builtin_bit_cast(int, f); return u ^ ((u >> 31) & 0x7fffffff); }
__device__ __forceinline__ float key2f(int k) { const int u = k ^ ((k >> 31) & 0x7fffffff); return __builtin_bit_cast(float, u); }
__device__ __forceinline__ void top16_of_128(f32x16 (&s)[4], int hi, int (&kv)[16]) {
    int key[4][16];
#pragma unroll
    for (int nt = 0; nt < 4; ++nt)
#pragma unroll
        for (int r = 0; r < 16; ++r) key[nt][r] = (f2key(s[nt][r]) & ~0x7f) | (127 - (32 * nt + crow(r, hi)));
#pragma unroll
    for (int nt = 0; nt < 4; ++nt) sort16_desc(key[nt]);
    merge16_desc(key[0], key[1]); merge16_desc(key[2], key[3]); merge16_desc(key[0], key[2]);
    unsigned a[16], b[16];
#pragma unroll
    for (int i = 0; i < 16; ++i) { a[i] = (unsigned)key[0][i]; b[i] = a[i]; swap32(a[i], b[i]); }
#pragma unroll
    for (int i = 0; i < 16; ++i) kv[i] = max((int)a[i], (int)b[15 - i]);
    bitonic16_desc(kv);
}
template <bool LDSK>
__device__ __forceinline__ void peer_topk_item(const Frame& F, const Args& A, int item, const LAS unsigned char* lds) {
    unsigned char* ws = A.ws;
    int lane = lane_id(); asm volatile("" : "+v"(lane));
    const int r32 = lane & 31, hi = lane >> 5;
    const int h = item & 7, tile = item >> 3; const size_t row = (size_t)tile * 32 + r32;
    const bf16* QP = (const bf16*)(ws + WS_QP) + (size_t)tile * 32 * 2048 + (size_t)(h * 16) * 512 + 8 * lane;
    int k1[16], k2[16];
#pragma unroll
    for (int i = 0; i < 16; ++i) { k1[i] = 0; k2[i] = 0; }
#pragma unroll 1
    for (int c = 0; c < 2; ++c) {
        const bf16* SK = (const bf16*)(ws + WS_SKEY) + (size_t)((h * 2 + c) * 4) * 4096 + 8 * lane;
        f32x16 s[4];
#pragma unroll
        for (int nt = 0; nt < 4; ++nt) s[nt] = f32x16{};
        bf16x8 qf[8];
#pragma unroll
        for (int ks = 0; ks < 8; ++ks) qf[ks] = __builtin_nontemporal_load((const bf16x8*)(QP + (size_t)(c * 8 + ks) * 512));
#pragma unroll
        for (int ks = 0; ks < 8; ++ks) {
#pragma unroll
            for (int nt = 0; nt < 4; ++nt) { const bf16x8 kf = LDSK ? *(const LAS bf16x8*)(lds + ((c * 4 + nt) * 4096 + ks * 512) * 2 + lane * 16) : *(const bf16x8*)(SK + (size_t)nt * 4096 + ks * 512);
                s[nt] = __builtin_amdgcn_mfma_f32_32x32x16_bf16(kf, qf[ks], s[nt], 0, 0, 0); } }
        if (c == 0) top16_of_128(s, hi, k1); else top16_of_128(s, hi, k2);
    }
    float v1[16], v2[16];
#pragma unroll
    for (int i = 0; i < 16; ++i) { v1[i] = key2f(k1[i] & ~0x7f); v2[i] = key2f(k2[i] & ~0x7f); }
    int ck[32];
    {
        int idx = 0;
#pragma unroll
        for (int i = 0; i < 32; ++i) ck[i] = (int)0x80000000;
#pragma unroll
        for (int a = 0; a < 16; ++a)
#pragma unroll
            for (int bq = 0; bq < 16; ++bq) if ((a + 1) * (bq + 1) <= 16) {
                const int flat = a * 16 + bq; const int kk = (f2key(v1[a] + v2[bq]) & ~0xff) | (255 - flat);
                if ((idx & 1) == hi) ck[idx >> 1] = kk;
                ++idx; }
    }
    sort32_desc(ck);
    int tk[16];
    { unsigned a[16], b[16];
#pragma unroll
      for (int i = 0; i < 16; ++i) { a[i] = (unsigned)ck[i]; b[i] = a[i]; swap32(a[i], b[i]); }
#pragma unroll
      for (int i = 0; i < 16; ++i) tk[i] = max((int)a[i], (int)b[15 - i]);
      bitonic16_desc(tk); }
    int te[16];
    { LAS int* tab = (LAS int*)(lds + 65536 + F.wave * 8448) + lane * 33;
#pragma unroll
      for (int i = 0; i < 16; ++i) { tab[i] = 127 - (k1[i] & 0x7f); tab[16 + i] = 127 - (k2[i] & 0x7f); }
      asm volatile("s_waitcnt lgkmcnt(0)" ::: "memory");
#pragma unroll
      for (int i = 0; i < 16; ++i) { const int flat = 255 - (tk[i] & 0xff); te[i] = tab[flat >> 4] * 128 + tab[16 + (flat & 15)]; }
      asm volatile("s_waitcnt lgkmcnt(0)" ::: "memory"); }
    float gsm[16]; const float mx = key2f(tk[0] & ~0xff); float den = 0.f;
#pragma unroll
    for (int i = 0; i < 16; ++i) { gsm[i] = __expf(key2f(tk[i] & ~0xff) - mx); den += gsm[i]; }
    const float inv = 1.0f / den;
    if (hi == 0) {
        int* EID = (int*)(ws + WS_EID) + row * 128 + h * 16; float* GW = (float*)(ws + WS_GW) + row * 128 + h * 16;
#pragma unroll
        for (int q = 0; q < 4; ++q) { *(v4u*)(EID + 4 * q) = (v4u){(unsigned)te[4 * q], (unsigned)te[4 * q + 1], (unsigned)te[4 * q + 2], (unsigned)te[4 * q + 3]};
            *(f32x4*)(GW + 4 * q) = (f32x4){gsm[4 * q] * inv, gsm[4 * q + 1] * inv, gsm[4 * q + 2] * inv, gsm[4 * q + 3] * inv}; }
    }
}

typedef float f32x2 __attribute__((ext_vector_type(2)));
__device__ __forceinline__ float dot16_fp8(const v4u u, const f32x2 (&xn)[8]) {
    f32x2 a0 = {0.f, 0.f}, a1 = {0.f, 0.f};
#pragma unroll
    for (int j = 0; j < 4; ++j) { const f32x2 lo = __builtin_amdgcn_cvt_pk_f32_fp8((int)u[j], false), hi = __builtin_amdgcn_cvt_pk_f32_fp8((int)u[j], true);
        a0 = __builtin_elementwise_fma(lo, xn[2 * j], a0); a1 = __builtin_elementwise_fma(hi, xn[2 * j + 1], a1); }
    return (a0.x + a0.y) + (a1.x + a1.y);
}
__device__ __forceinline__ void axpy16_fp8(f32x2 (&acc)[8], const float w, const v4u u) {
    const f32x2 w2 = {w, w};
#pragma unroll
    for (int j = 0; j < 4; ++j) { const f32x2 lo = __builtin_amdgcn_cvt_pk_f32_fp8((int)u[j], false), hi = __builtin_amdgcn_cvt_pk_f32_fp8((int)u[j], true);
        acc[2 * j] = __builtin_elementwise_fma(lo, w2, acc[2 * j]); acc[2 * j + 1] = __builtin_elementwise_fma(hi, w2, acc[2 * j + 1]); }
}
#define TIE_ROW(val, nxt) asm volatile("" : "+v"(val), "+v"((nxt).x), "+v"((nxt).y), "+v"((nxt).z), "+v"((nxt).w))
constexpr int PQ_CHUNK = 128, PQ_NCHUNK = MTOK / PQ_CHUNK;
constexpr int CW_NQ = 10240;
constexpr int CW_PQ = 8192;
__device__ __forceinline__ int pq_pop(unsigned* ctl, int pass, int own, int& q_s, LAS int* bc, int wave) {
    __syncthreads();
    if (wave == 0 && lane_id() == 0) { int res = -1; int s = q_s;
        while (s < 8) { const int x = (own + s) & 7; const unsigned c = __hip_atomic_fetch_add(ctl + CW_PQ + 64 * (8 * pass + x), 1u, __ATOMIC_RELAXED, __HIP_MEMORY_SCOPE_AGENT);
            if (c < (unsigned)PQ_NCHUNK) { res = x * PQ_NCHUNK + (int)c; break; } ++s; }
        bc[0] = res; bc[1] = s; }
    __syncthreads();
    q_s = bc[1]; return bc[0];
}
#define PQ_TICKET(pass_, own_, qs_) (((qs_) < 8 && F.wave == 0 && lane_id() == 0) ? __hip_atomic_fetch_add(ctl + CW_PQ + 64 * (8 * (pass_) + (((own_) + (qs_)) & 7)), 1u, __ATOMIC_RELAXED, __HIP_MEMORY_SCOPE_AGENT) : 0u)
__device__ __forceinline__ int pq_resolve(unsigned* ctl, int pass, int own, int& q_s, unsigned ticket, LAS int* bc, int wave) {
    if (wave == 0 && lane_id() == 0) { int res = -1; int s = q_s;
        if (s < 8) { if (ticket < (unsigned)PQ_NCHUNK) res = ((own + s) & 7) * PQ_NCHUNK + (int)ticket;
                     else { ++s; while (s < 8) { const int x = (own + s) & 7; const unsigned c = __hip_atomic_fetch_add(ctl + CW_PQ + 64 * (8 * pass + x), 1u, __ATOMIC_RELAXED, __HIP_MEMORY_SCOPE_AGENT);
                                if (c < (unsigned)PQ_NCHUNK) { res = x * PQ_NCHUNK + (int)c; break; } ++s; } } }
        bc[0] = res; bc[1] = s; }
    __syncthreads();
    q_s = bc[1]; return bc[0];
}
template <int CTRL> __device__ __forceinline__ float dppf(float v) { return __builtin_bit_cast(float, __builtin_amdgcn_mov_dpp(__builtin_bit_cast(int, v), CTRL, 0xf, 0xf, true)); }
__device__ __forceinline__ float red8(float d) { d += dppf<0xB1>(d); d += dppf<0x4E>(d); d += dppf<0x141>(d); return d; }
__device__ __forceinline__ void peer_issue8(v4u (&rb)[8], const v4u ia, const v4u ib, const unsigned char* T  , unsigned c16) {
    const unsigned e[8] = {ia.x, ia.y, ia.z, ia.w, ib.x, ib.y, ib.z, ib.w};
#pragma unroll
    for (int i = 0; i < 8; ++i) rb[i] = *(const v4u*)(T + (e[i] * 128u + c16));
}
constexpr int PS_ROW = 528, PS_WAVE = 2 * 16 * PS_ROW;
__device__ __forceinline__ void peer_stage16(LAS unsigned char* st, const unsigned char* src  , int lane) {
    v4u e[8];
#pragma unroll
    for (int j = 0; j < 8; ++j) e[j] = __builtin_nontemporal_load((const v4u*)(src + (unsigned)(j * 1024 + lane * 16)));
#pragma unroll
    for (int j = 0; j < 8; ++j) *(LAS v4u*)(st + (2 * j + (lane >> 5)) * PS_ROW + (lane & 31) * 16) = e[j];
}
__device__ __forceinline__ void peer_u_chunk(const Frame& F, const Args& A, LAS unsigned char* lds, int x, int chunk) {
    unsigned char* ws = A.ws; int lane = lane_id(); asm volatile("" : "+v"(lane));
    const int tk = lane >> 3, c8 = lane & 7;
    const unsigned char* U = ws + WS_U8 + (size_t)x * 16384 * 128; const unsigned c16 = 16u * (unsigned)c8;
    LAS unsigned char* st = lds + F.wave * PS_WAVE;
    peer_stage16(st, ws + WS_EID + (size_t)(chunk * PQ_CHUNK + F.wave * 16) * 512, lane);
#pragma unroll 1
    for (int oc = 0; oc < 2; ++oc) {
        const unsigned row = (unsigned)(chunk * PQ_CHUNK + F.wave * 16 + oc * 8 + tk);
        const LAS unsigned char* est = st + (oc * 8 + tk) * PS_ROW;
#define EID_LD(i_) (*(const LAS v4u*)(est + 16 * (i_)))
        f32x2 xn[8];
        { const unsigned char* xb_ = ws + WS_XN; const unsigned xo = row * 2048u + 256u * (unsigned)x + 32u * (unsigned)c8; const v4u xa = *(const v4u*)(xb_ + xo), xb = *(const v4u*)(xb_ + (xo + 16u));
          const unsigned xw[8] = {xa.x, xa.y, xa.z, xa.w, xb.x, xb.y, xb.z, xb.w};
#pragma unroll
          for (int j = 0; j < 8; ++j) { xn[j].x = bflo(xw[j]); xn[j].y = bfhi(xw[j]); } }
        float rstd; { const f32x4* sp = (const f32x4*)(ws + WS_SSQ2 + (size_t)row * 64); const f32x4 a = sp[0], b = sp[1], c = sp[2], d = sp[3];
            rstd = rsqrtf((((a.x + a.y) + (a.z + a.w)) + ((b.x + b.y) + (b.z + b.w)) + ((c.x + c.y) + (c.z + c.w)) + ((d.x + d.y) + (d.z + d.w))) * (1.f / DM) + EPS); }
        unsigned char* ppb = ws + WS_PART; const unsigned po = ((unsigned)x * MTOK + row) * 256u + 32u * (unsigned)c8;
        v4u ra[8], rb[8]; v4u ia0 = EID_LD(0), ia1 = EID_LD(1), ib0 = EID_LD(2), ib1 = EID_LD(3);
        peer_issue8(ra, ia0, ia1, U, c16); ia0 = EID_LD(4); ia1 = EID_LD(5);
#pragma unroll 1
        for (int q = 0; q < 16; q += 2) {
            peer_issue8(rb, ib0, ib1, U, c16); { const int qn = (q + 3 < 16) ? q + 3 : 15; ib0 = EID_LD(2 * qn); ib1 = EID_LD(2 * qn + 1); }
            float k0 = 0.f, k1 = 0.f;
#pragma unroll
            for (int i = 0; i < 8; ++i) { float d = dot16_fp8(ra[i], xn); if (i < 7) TIE_ROW(d, ra[i + 1]); d = red8(d); k0 = (c8 == i) ? d : k0; }
            peer_issue8(ra, ia0, ia1, U, c16); { const int qn = (q + 4 < 16) ? q + 4 : 15; ia0 = EID_LD(2 * qn); ia1 = EID_LD(2 * qn + 1); }
#pragma unroll
            for (int i = 0; i < 8; ++i) { float d = dot16_fp8(rb[i], xn); if (i < 7) TIE_ROW(d, rb[i + 1]); d = red8(d); k1 = (c8 == i) ? d : k1; }
            *(unsigned*)(ppb + (po + 2u * (unsigned)q)) = pk2(k0 * rstd, k1 * rstd);
        }
    }
}
__device__ __forceinline__ void peer_w_rows(const Frame& F, const Args& A) {
    unsigned char* ws = A.ws; const int lane = lane_id();
    const float* SU = (const float*)(ws + WS_SU); const float* SV = (const float*)(ws + WS_SV);
    const int p0 = 2 * lane, k0 = 8 * (p0 & 15) + (p0 >> 4), k1 = k0 + 8;
    for (int m0 = F.gw; m0 < MTOK; m0 += 4 * F.NGW) {
        int e0[4], e1[4]; float g0[4], g1[4]; unsigned pw[4][8];
#pragma unroll
        for (int r = 0; r < 4; ++r) { const size_t row = (size_t)(m0 + r * F.NGW < MTOK ? m0 + r * F.NGW : m0);
            const int* EID = (const int*)(ws + WS_EID) + row * 128; const float* GW = (const float*)(ws + WS_GW) + row * 128;
            e0[r] = EID[k0]; e1[r] = EID[k1]; g0[r] = GW[k0]; g1[r] = GW[k1];
#pragma unroll
            for (int x = 0; x < 8; ++x) pw[r][x] = *(const unsigned*)((const bf16*)(ws + WS_PART) + ((size_t)x * MTOK + row) * 128 + p0); }
        float su0[4], su1[4], sv0[4], sv1[4];
#pragma unroll
        for (int r = 0; r < 4; ++r) { su0[r] = SU[e0[r]]; su1[r] = SU[e1[r]]; sv0[r] = SV[e0[r]]; sv1[r] = SV[e1[r]]; }
#pragma unroll
        for (int r = 0; r < 4; ++r) { if (m0 + r * F.NGW < MTOK) { const size_t row = (size_t)(m0 + r * F.NGW); float s0 = 0.f, s1 = 0.f;
#pragma unroll
            for (int x = 0; x < 8; ++x) { s0 += bflo(pw[r][x]); s1 += bfhi(pw[r][x]); }
            float* W = (float*)(ws + WS_W) + row * 128;
            W[k0] = gelu_tanh(s0 * su0[r]) * g0[r] * sv0[r]; W[k1] = gelu_tanh(s1 * su1[r]) * g1[r] * sv1[r]; } }
    }
}
__device__ __forceinline__ void peer_v_chunk(const Frame& F, const Args& A, LAS unsigned char* lds, int x, int chunk) {
    unsigned char* ws = A.ws; int lane = lane_id(); asm volatile("" : "+v"(lane));
    const int tk = lane >> 3, c8 = lane & 7;
    const unsigned char* V = ws + WS_V8 + (size_t)x * 16384 * 128; const unsigned c16 = 16u * (unsigned)c8;
    LAS unsigned char* st = lds + F.wave * PS_WAVE;
    peer_stage16(st, ws + WS_EID + (size_t)(chunk * PQ_CHUNK + F.wave * 16) * 512, lane);
    peer_stage16(st + 16 * PS_ROW, ws + WS_W + (size_t)(chunk * PQ_CHUNK + F.wave * 16) * 512, lane);
#pragma unroll 1
    for (int oc = 0; oc < 2; ++oc) {
        const unsigned row = (unsigned)(chunk * PQ_CHUNK + F.wave * 16 + oc * 8 + tk);
        const LAS unsigned char* est = st + (oc * 8 + tk) * PS_ROW;
#define W_LD(i_) (*(const LAS f32x4*)(est + 16 * PS_ROW + 16 * (i_)))
        f32x2 acc[8];
#pragma unroll
        for (int j = 0; j < 8; ++j) acc[j] = (f32x2){0.f, 0.f};
        v4u ra[8], rb[8]; v4u ia0 = EID_LD(0), ia1 = EID_LD(1), ib0 = EID_LD(2), ib1 = EID_LD(3); f32x4 wa0 = W_LD(0), wa1 = W_LD(1), wb0 = W_LD(2), wb1 = W_LD(3);
        peer_issue8(ra, ia0, ia1, V, c16); ia0 = EID_LD(4); ia1 = EID_LD(5);
#pragma unroll 1
        for (int q = 0; q < 16; q += 2) {
            peer_issue8(rb, ib0, ib1, V, c16); { const int qn = (q + 3 < 16) ? q + 3 : 15; ib0 = EID_LD(2 * qn); ib1 = EID_LD(2 * qn + 1); }
            { const float wv[8] = {wa0.x, wa0.y, wa0.z, wa0.w, wa1.x, wa1.y, wa1.z, wa1.w};
#pragma unroll
              for (int i = 0; i < 8; ++i) { axpy16_fp8(acc, wv[i], ra[i]); if (i < 7) TIE_ROW(acc[7].y, ra[i + 1]); } }
            { const int qn = (q + 2 < 16) ? q + 2 : 15; wa0 = W_LD(2 * qn); wa1 = W_LD(2 * qn + 1); }
            peer_issue8(ra, ia0, ia1, V, c16); { const int qn = (q + 4 < 16) ? q + 4 : 15; ia0 = EID_LD(2 * qn); ia1 = EID_LD(2 * qn + 1); }
            { const float wv[8] = {wb0.x, wb0.y, wb0.z, wb0.w, wb1.x, wb1.y, wb1.z, wb1.w};
#pragma unroll
              for (int i = 0; i < 8; ++i) { axpy16_fp8(acc, wv[i], rb[i]); if (i < 7) TIE_ROW(acc[7].y, rb[i + 1]); } }
            { const int qn = (q + 3 < 16) ? q + 3 : 15; wb0 = W_LD(2 * qn); wb1 = W_LD(2 * qn + 1); }
        }
        unsigned char* xr = ws + WS_XN + (row * 2048u + 256u * (unsigned)x + 32u * (unsigned)c8); float ss = 0.f;
        const v4u x2a = *(const v4u*)xr, x2b = *(const v4u*)(xr + 16);
        const unsigned xw[8] = {x2a.x, x2a.y, x2a.z, x2a.w, x2b.x, x2b.y, x2b.z, x2b.w};
        unsigned ow[8];
#pragma unroll
        for (int j = 0; j < 4; ++j) { f32x4 v; v.x = bflo(xw[2 * j]) + acc[2 * j].x; v.y = bfhi(xw[2 * j]) + acc[2 * j].y; v.z = bflo(xw[2 * j + 1]) + acc[2 * j + 1].x; v.w = bfhi(xw[2 * j + 1]) + acc[2 * j + 1].y;
            ss += (v.x * v.x + v.y * v.y) + (v.z * v.z + v.w * v.w); ow[2 * j] = pk2(v.x, v.y); ow[2 * j + 1] = pk2(v.z, v.w); }
        *(v4u*)xr = (v4u){ow[0], ow[1], ow[2], ow[3]}; *(v4u*)(xr + 16) = (v4u){ow[4], ow[5], ow[6], ow[7]};
        ss = red8(ss);
        if (c8 == 0) ((float*)(ws + WS_SSQ3))[row * 8 + x] = ss;
    }
#undef W_LD
#undef EID_LD
}
__device__ __forceinline__ void peer_final_rows(const Frame& F, const Args& A) {
    unsigned char* ws = A.ws; const int lane = lane_id(); const float* g = A.in[32];
    for (int m = F.gw; m < MTOK; m += F.NGW) {
        const f32x4 sa = *(const f32x4*)((const float*)(ws + WS_SSQ3) + (size_t)m * 8), sb = *(const f32x4*)((const float*)(ws + WS_SSQ3) + (size_t)m * 8 + 4);
        const float rstd = rsqrtf((((sa.x + sa.y) + (sa.z + sa.w)) + ((sb.x + sb.y) + (sb.z + sb.w))) * (1.f / DM) + EPS);
        f32x4* xr = (f32x4*)(A.out + (size_t)m * DM) + lane; const v2u* xb = (const v2u*)((const bf16*)(ws + WS_XN) + (size_t)m * DM) + lane;
#pragma unroll
        for (int j = 0; j < 4; ++j) { const v2u w = xb[64 * j]; const f32x4 gg = ((const f32x4*)g)[lane + 64 * j]; const f32x4 v = {bflo(w.x), bfhi(w.x), bflo(w.y), bfhi(w.y)}; __builtin_nontemporal_store(v * rstd * gg, xr + 64 * j); }
    }
}

typedef GAS unsigned gu32;
#define RLX_AGENT __ATOMIC_RELAXED, __HIP_MEMORY_SCOPE_AGENT
#define XB_TMO      128
#define XB_XCNT(j)  (256  + 64 * (j))
#define XB_XSUB(j)  (1280 + 64 * (j))
#define XB_XGEN(j)  (2304 + 64 * (j))
#define XB_TOP      3328
#define XB_TOPGEN   3392
#define XCD_BAR_WORDS 3456
#define XB_SPIN_CAP (1u << 18)

__device__ __forceinline__ unsigned xb_ld(unsigned* p)              { return __hip_atomic_load(p, __ATOMIC_RELAXED, __HIP_MEMORY_SCOPE_AGENT); }
__device__ __forceinline__ unsigned xb_add(unsigned* p, unsigned v) { return __hip_atomic_fetch_add(p, v, __ATOMIC_RELAXED, __HIP_MEMORY_SCOPE_AGENT); }
__device__ __forceinline__ unsigned xb_xcc_id() { return (unsigned)__builtin_amdgcn_s_getreg((3 << 11) | 20) & 0xFu; }
#define XB_SPIN(cond, bar) do { unsigned _sp = 0; while (cond) { __builtin_amdgcn_s_sleep(1); \
    if ((++_sp & 255u) == 0u) { if (xb_ld(&(bar)[XB_TMO])) break; if (_sp > XB_SPIN_CAP) { atomicAdd(&(bar)[XB_TMO], 1u); break; } } } } while (0)

struct XcdBarrier {
    unsigned* bar; unsigned x;
    volatile LAS unsigned* st;
};

__device__ __forceinline__ XcdBarrier xcd_barrier_post(unsigned* bar, volatile LAS unsigned* st) {
    XcdBarrier b; b.bar = bar; b.x = xb_xcc_id(); b.st = st;
    if (threadIdx.x == 0) (void)xb_add(&bar[XB_XCNT(b.x)], 1u);
    return b;
}
__device__ __forceinline__ void xcd_barrier_complete(unsigned* bar, unsigned x, unsigned& nloc, unsigned& nx) {
    const unsigned G = gridDim.x * gridDim.y * gridDim.z;
    unsigned sum, cnt, mine, sp = 0u;
    for (;;) {
        sum = 0u; cnt = 0u; mine = 0u;
#pragma unroll
        for (unsigned j = 0; j < 16; ++j) { const unsigned c = xb_ld(&bar[XB_XCNT(j)]); sum += c; cnt += (c > 0u) ? 1u : 0u; mine = (j == x) ? c : mine; }
        if (sum == G) break;
        __builtin_amdgcn_s_sleep(1);
        if ((++sp & 255u) == 0u) { if (xb_ld(&bar[XB_TMO])) break; if (sp > XB_SPIN_CAP) { atomicAdd(&bar[XB_TMO], 1u); break; } }
    }
    nloc = mine > 0u ? mine : 1u; nx = cnt > 0u ? cnt : 1u;
}

__device__ __forceinline__ void xcd_barrier(const XcdBarrier& b) {
    asm volatile("s_waitcnt vmcnt(0)" ::: "memory");
    __syncthreads();
    if (threadIdx.x == 0) {
        unsigned* bar = b.bar;
        __builtin_amdgcn_s_waitcnt(0);
        unsigned nloc = b.st[0], nx = b.st[1];
        if (nloc == 0u) { xcd_barrier_complete(bar, b.x, nloc, nx); b.st[0] = nloc; b.st[1] = nx; }
        const unsigned old = xb_add(&bar[XB_XSUB(b.x)], 1u);
        const unsigned gen = old / nloc;
        if (old + 1u == (gen + 1u) * nloc) {
            __builtin_amdgcn_fence(__ATOMIC_RELEASE, "agent");
            asm volatile("s_waitcnt vmcnt(0)" ::: "memory");
            const unsigned og = xb_add(&bar[XB_TOP], 1u);
            const unsigned tg = og / nx;
            if (og + 1u == (tg + 1u) * nx) xb_add(&bar[XB_TOPGEN], 1u);
            else XB_SPIN(xb_ld(&bar[XB_TOPGEN]) == tg, bar);
            __builtin_amdgcn_fence(__ATOMIC_ACQUIRE, "agent");
            xb_add(&bar[XB_XGEN(b.x)], 1u);
            asm volatile("s_waitcnt vmcnt(0)" ::: "memory");
        } else {
            XB_SPIN(xb_ld(&bar[XB_XGEN(b.x)]) == gen, bar);
            __builtin_amdgcn_fence(__ATOMIC_ACQUIRE, "agent");
            asm volatile("s_waitcnt vmcnt(0)" ::: "memory");
        }
    }
    __syncthreads();
}

#ifndef DBL_MASK
#define DBL_MASK 0
#endif
constexpr int NPHASE = 12;
__global__ void __launch_bounds__(512, 2) fwd_kernel(Args args) {
    extern __shared__ __attribute__((aligned(16))) unsigned char lds_raw[];
    LAS unsigned char* lds = (LAS unsigned char*)lds_raw;
    Frame F;
    F.tid = threadIdx.x; F.lane = F.tid & 63; F.wave = __builtin_amdgcn_readfirstlane(F.tid >> 6);
    F.G = gridDim.x; { const int bx = blockIdx.x; F.vcu = (F.G % 8 == 0) ? (bx % 8) * (F.G / 8) + bx / 8 : bx; }
    F.gw = F.vcu * 8 + F.wave; F.NGW = F.G * 8;
    unsigned char* ws = args.ws;
    const int lo = args.ph_lo, hi = args.ph_hi;
    volatile LAS unsigned* MISC = (volatile LAS unsigned*)(lds + LDS_BYTES - 64);
    if (F.tid < 16) MISC[F.tid] = 0u;
    __syncthreads();
    XcdBarrier bar = xcd_barrier_post((unsigned*)(ws + WS_CTL), MISC);
#define IN(k) (lo <= (k) && (k) < hi)
#define SEAM(k) do { if (IN(k) && IN((k) + 1)) xcd_barrier(bar); } while (0)

    if (IN(0)) for (int rep_ = 0; rep_ <= ((DBL_MASK >> 0) & 1); ++rep_) { if (rep_) xcd_barrier(bar); REFRESH_LANE(F); p0_prologue(F, args, lds); }
    SEAM(0);
    if (IN(1)) for (int rep_ = 0; rep_ <= ((DBL_MASK >> 1) & 1); ++rep_) { if (rep_) xcd_barrier(bar); REFRESH_LANE(F);
        { pg8::Gemm g{(const bf16*)(ws + WS_XN), (const bf16*)(ws + WS_WIN), MTOK, NZP, DM}; pg8::StaticOrder S; S.init(MTOK, NZP, F.G, (int)blockIdx.x);
          pg8::EpiZ E{(bf16*)(ws + WS_Z), (bf16*)(ws + WS_KSF), (bf16*)(ws + WS_VSF), (bf16*)(ws + WS_KWF), (bf16*)(ws + WS_VWF), (float*)(ws + WS_GATES), args.in[4]};
          pg8::gemm_phase<pg8::EpiZ, pg8::StaticOrder, true, true>(lds, g, S, E, F.wave); }
        { pg8::Gemm g{(const bf16*)(ws + WS_MEMN), (const bf16*)(ws + WS_WMK), NB * NMEM, DM, DM}; pg8::StaticOrder S; S.init(NB * NMEM, DM, F.G, ((int)blockIdx.x + 128) & 255);
          pg8::EpiStore E{(bf16*)(ws + WS_MEMK), DM, nullptr, 1};
          pg8::gemm_phase<pg8::EpiStore, pg8::StaticOrder, true, true>(lds, g, S, E, F.wave); }
        { pg8::Gemm g{(const bf16*)(ws + WS_WMV), (const bf16*)(ws + WS_MEMN), DM, NB * NMEM, DM}; pg8::StaticOrder S; S.init(DM, NB * NMEM, F.G, ((int)blockIdx.x + 120) & 255);
          pg8::EpiVFrag E{(bf16*)(ws + WS_MEMVT)};
          pg8::gemm_phase<pg8::EpiVFrag, pg8::StaticOrder, true, true>(lds, g, S, E, F.wave); }
    }
    SEAM(1);
    if (IN(2)) for (int rep_ = 0; rep_ <= ((DBL_MASK >> 2) & 1); ++rep_) { if (rep_) xcd_barrier(bar); REFRESH_LANE(F); for (int it = F.gw; it < 2048; it += F.NGW) kmax_item(F, args, it);
                 for (int it = F.vcu; it < 256; it += F.G) lru_local_item(F, args, lds, it);
                 for (int it = F.G - 1 - F.vcu; it < 128; it += F.G) compress_item(F, args, lds, it); }
    SEAM(2);
    if (IN(3)) for (int rep_ = 0; rep_ <= ((DBL_MASK >> 3) & 1); ++rep_) { if (rep_) xcd_barrier(bar); REFRESH_LANE(F);
                 { unsigned* ctl = (unsigned*)(ws + WS_CTL); const int own = (int)(((long)F.vcu * 8) / F.G) & 7; int qs = 0;
                   for (;;) { int id = -1;
                       if (lane_id() == 0) { while (qs < 8) { const int x = (own + qs) & 7; const unsigned c = __hip_atomic_fetch_add(ctl + CW_NQ + 64 * x, 1u, __ATOMIC_RELAXED, __HIP_MEMORY_SCOPE_AGENT);
                               if (c < 512u) { id = x * 512 + (int)c; break; } ++qs; } }
                       id = __builtin_amdgcn_readfirstlane(id); qs = __builtin_amdgcn_readfirstlane(qs);
                       if (id < 0) break;
                       if (F.G == 256 && (id & 511) < 256) { const int qi = (id >> 9) * 256 + (id & 255);
                           quant_rows4_fp8(args.in[31] + (size_t)qi * DM, (size_t)2048 * DM, nullptr, ws + WS_V8 + (size_t)qi * 128, (float*)(ws + WS_SV) + qi, 2048, lane_id());
                           quant_rows4_fp8(args.in[31] + (size_t)(qi + 8192) * DM, (size_t)2048 * DM, nullptr, ws + WS_V8 + (size_t)(qi + 8192) * 128, (float*)(ws + WS_SV) + qi + 8192, 2048, lane_id());
                           quant_rows4_fp8(args.in[30] + (size_t)qi * DM, (size_t)2048 * DM, args.in[27], ws + WS_U8 + (size_t)qi * 128, (float*)(ws + WS_SU) + qi, 2048, lane_id());
                           quant_rows4_fp8(args.in[30] + (size_t)(qi + 8192) * DM, (size_t)2048 * DM, args.in[27], ws + WS_U8 + (size_t)(qi + 8192) * 128, (float*)(ws + WS_SU) + qi + 8192, 2048, lane_id()); }
                       const int x = id >> 9, i = id & 511; nsa_item(F, args, lds, x >> 2, (x >> 1) & 1, 2 * (63 - (i >> 3)) + (x & 1), 7 - (i & 7)); } }
                 __syncthreads(); REFRESH_LANE(F);
                 for (int it = F.vcu; it < 256; it += F.G) lru_fix_item(F, args, lds, it, false); }
    SEAM(3);
    if (IN(4)) for (int rep_ = 0; rep_ <= ((DBL_MASK >> 4) & 1); ++rep_) { if (rep_) xcd_barrier(bar); REFRESH_LANE(F);
        pg8::Gemm g{(const bf16*)(ws + WS_Y), (const bf16*)(ws + WS_WOUT), MTOK, DM, DM}; pg8::StaticOrder S; S.init(MTOK, DM, F.G, (int)blockIdx.x);
        pg8::EpiRes<true> E{args.in[0], nullptr, nullptr, (bf16*)(ws + WS_XN), (float*)(ws + WS_SSQ1), (const float*)(ws + WS_SSQN)};
        pg8::gemm_phase<pg8::EpiRes<true>, pg8::StaticOrder, true, true>(lds, g, S, E, F.wave);
    }
    SEAM(4);
    if (IN(5)) for (int rep_ = 0; rep_ <= ((DBL_MASK >> 5) & 1); ++rep_) { if (rep_) xcd_barrier(bar); REFRESH_LANE(F);
        pg8::Gemm g{(const bf16*)(ws + WS_XN), (const bf16*)(ws + WS_WMQ), MTOK, DM, DM}; pg8::StaticOrder S; S.init(MTOK, DM, F.G, (int)blockIdx.x);
        pg8::EpiStore E{(bf16*)(ws + WS_QM), DM, (const float*)(ws + WS_SSQ1), 1};
        pg8::gemm_phase<pg8::EpiStore, pg8::StaticOrder, true, true>(lds, g, S, E, F.wave);
    }
    SEAM(5);
    if (IN(6)) for (int rep_ = 0; rep_ <= ((DBL_MASK >> 6) & 1); ++rep_) { if (rep_) xcd_barrier(bar); REFRESH_LANE(F); for (int it = F.vcu; it < 256; it += F.G) memattn_block(F, args, lds, it); }
    SEAM(6);
    if (IN(7)) for (int rep_ = 0; rep_ <= ((DBL_MASK >> 7) & 1); ++rep_) { if (rep_) xcd_barrier(bar); REFRESH_LANE(F);
        pg8::Gemm g{(const bf16*)(ws + WS_OM), (const bf16*)(ws + WS_WMO), MTOK, DM, DM}; pg8::StaticOrder S; S.init(MTOK, DM, F.G, (int)blockIdx.x);
        pg8::EpiRes<false> E{nullptr, (const bf16*)(ws + WS_XN), nullptr, (bf16*)(ws + WS_XN), (float*)(ws + WS_SSQ2), nullptr};
        pg8::gemm_phase<pg8::EpiRes<false>, pg8::StaticOrder, true, true>(lds, g, S, E, F.wave);
    }
    SEAM(7);
    if (IN(8)) for (int rep_ = 0; rep_ <= ((DBL_MASK >> 8) & 1); ++rep_) { if (rep_) xcd_barrier(bar); REFRESH_LANE(F);
        pg8::Gemm g{(const bf16*)(ws + WS_XN), (const bf16*)(ws + WS_WPQ), MTOK, 2048, DM}; pg8::StaticOrder S; S.init(MTOK, 2048, F.G, (int)blockIdx.x);
        pg8::EpiStore E{(bf16*)(ws + WS_QP), 2048, (const float*)(ws + WS_SSQ2), 1};
        pg8::gemm_phase<pg8::EpiStore, pg8::StaticOrder, true, true>(lds, g, S, E, F.wave);
    }
    SEAM(8);
    if (IN(9)) for (int rep_ = 0; rep_ <= ((DBL_MASK >> 9) & 1); ++rep_) { if (rep_) xcd_barrier(bar); REFRESH_LANE(F); for (int gi = F.vcu; gi < 256; gi += F.G) {
                     const int h = gi & 7, tgp = gi >> 3;
                     { const v4u* src = (const v4u*)((const bf16*)(ws + WS_SKEY) + (size_t)h * 8 * 4096); const int tid = F.wave * 64 + lane_id();
#pragma unroll
                       for (int i = 0; i < 8; ++i) ((LAS v4u*)lds)[tid + 512 * i] = src[tid + 512 * i]; }
                     __syncthreads();
                     peer_topk_item<true>(F, args, (tgp * 16 + F.wave) * 8 + h, lds); peer_topk_item<true>(F, args, (tgp * 16 + 8 + F.wave) * 8 + h, lds);
                     __syncthreads(); } }
    SEAM(9);
    if (IN(10)) {   REFRESH_LANE(F);
        LAS int* bc = (LAS int*)(lds + LDS_BYTES - 128); unsigned* ctl = (unsigned*)(ws + WS_CTL); const int own = (int)(bar.x & 7u);
        { int qs = 0; int id = __builtin_amdgcn_readfirstlane(pq_pop(ctl, 0, own, qs, bc, F.wave)); int par = 0;
          while (id >= 0) { const unsigned tk_ = PQ_TICKET(0, own, qs); peer_u_chunk(F, args, lds, id / PQ_NCHUNK, id % PQ_NCHUNK); par ^= 2; id = __builtin_amdgcn_readfirstlane(pq_resolve(ctl, 0, own, qs, tk_, bc + par, F.wave)); } }
        xcd_barrier(bar);
        peer_w_rows(F, args);
        xcd_barrier(bar);
        { int qs = 0; int id = __builtin_amdgcn_readfirstlane(pq_pop(ctl, 1, own, qs, bc, F.wave)); int par = 0;
          while (id >= 0) { const unsigned tk_ = PQ_TICKET(1, own, qs); peer_v_chunk(F, args, lds, id / PQ_NCHUNK, id % PQ_NCHUNK); par ^= 2; id = __builtin_amdgcn_readfirstlane(pq_resolve(ctl, 1, own, qs, tk_, bc + par, F.wave)); } }
        xcd_barrier(bar);
        peer_final_rows(F, args);
    }
#undef IN
#undef SEAM
}

extern "C" void kernel_launch(void* const* d_in, const int* in_sizes, int n_in, void* d_out, int out_size, void* d_ws, size_t ws_size, hipStream_t stream) {
    static int grid = 0;
    if (grid == 0) {
        if (n_in != 33 || out_size != MTOK * DM || ws_size < WS_END) { fprintf(stderr, "kernel_launch: unexpected problem (n_in %d, out %d, ws %zu)\n", n_in, out_size, ws_size); grid = -1; return; }
        int dev = 0, cus = 0, per_cu = 0;
        (void)hipGetDevice(&dev); (void)hipDeviceGetAttribute(&cus, hipDeviceAttributeMultiprocessorCount, dev);
        (void)hipFuncSetAttribute((const void*)fwd_kernel, hipFuncAttributeMaxDynamicSharedMemorySize, LDS_BYTES);
        (void)hipOccupancyMaxActiveBlocksPerMultiprocessor(&per_cu, (const void*)fwd_kernel, 512, LDS_BYTES);
        if (per_cu < 1) { fprintf(stderr, "kernel_launch: occupancy query says %d blocks per CU\n", per_cu); per_cu = 1; }
        grid = cus * 1;
        if (grid != 256) fprintf(stderr, "kernel_launch: %d CUs (built for 256)\n", cus);
    }
    if (grid < 0) return;
    (void)hipMemsetAsync((char*)d_ws + WS_CTL, 0, 65536, stream);
    Args a{};
    for (int i = 0; i < 33; ++i) a.in[i] = (const float*)d_in[i];
    a.out = (float*)d_out; a.ws = (unsigned char*)d_ws; a.ph_lo = 0; a.ph_hi = NPHASE;
    void* kargs[] = {&a};
    hipError_t e = hipLaunchCooperativeKernel((const void*)fwd_kernel, dim3(grid), dim3(512), kargs, LDS_BYTES, stream);
    if (e != hipSuccess) fprintf(stderr, "cooperative launch failed: %s (grid %d)\n", hipGetErrorString(e), grid);
}
```

```cpp
#include <hip/hip_runtime.h>
#include <cstdio>
#include <cstdint>

namespace pg8 {
#define PG8_LAS __attribute__((address_space(3)))
typedef unsigned short bf16_t;
typedef short bf16x8 __attribute__((ext_vector_type(8)));
typedef float f32x4 __attribute__((ext_vector_type(4)));
typedef unsigned u32x4 __attribute__((ext_vector_type(4)));
constexpr int BM = 256, BK = 64, HALF = 128, HTB = HALF * BK * 2  , STAGE_BYTES = 8 * HTB, NXCD = 8, WGM = 8;

__host__ __device__ __forceinline__ int lds_byte(int r, int c) { const int st = (r >> 4) * 2 + (c >> 5), rr = r & 15, cc = c & 31, ob = rr * 64 + cc * 2; return st * 1024 + (ob ^ (((ob >> 9) & 1) << 5)); }
__host__ __device__ __forceinline__ void stage_rc(int b, int& R, int& C) { const int st = b / 1024, sb = b % 1024, swz = sb ^ (((sb >> 9) & 1) << 5); R = (st >> 1) * 16 + swz / 64; C = (st & 1) * 32 + (swz % 64) / 2; }
__host__ __device__ __forceinline__ int perm32(int rho) { const int n = rho >> 4, i = rho & 15; return 8 * (i >> 2) + 4 * n + (i & 3); }

struct Unit { int pm, pn; };
struct Gemm { const bf16_t* A; const bf16_t* Bt; int M, N, K; };

struct StaticOrder {
    int nM, nN, nwg, G, c;
    __host__ __device__ void init(int M, int N, int G_, int c_) { nM = M / BM; nN = N / BM; nwg = nM * nN; G = G_; c = c_; }
    __host__ __device__ bool next(int i, Unit& u) const {
        const long L = (long)i * G + c; if (L >= nwg) return false;
        int wgid = (int)L; { const int q = nwg / NXCD, r = nwg % NXCD, xcd = wgid % NXCD, off = wgid / NXCD; wgid = (xcd < r ? xcd * (q + 1) : r * (q + 1) + (xcd - r) * q) + off; }
        const int nig = WGM * nN, gid = wgid / nig, fm = gid * WGM, gsz = (nM - fm) < WGM ? (nM - fm) : WGM;
        u.pm = fm + ((wgid % nig) % gsz); u.pn = (wgid % nig) / gsz; return true;
    }
    __device__ __forceinline__ void a_ready(const Unit&) const {}
    __device__ __forceinline__ void done(const Unit&) const {}
};

__device__ __forceinline__ unsigned cvt_pk_bf16(float lo, float hi) { unsigned r; asm volatile("v_cvt_pk_bf16_f32 %0, %1, %2" : "=v"(r) : "v"(lo), "v"(hi)); return r; }
typedef float f32x2 __attribute__((ext_vector_type(2)));
typedef unsigned u32x2 __attribute__((ext_vector_type(2)));
__device__ __forceinline__ unsigned short f2bf1(float f) { unsigned u = __builtin_bit_cast(unsigned, f); return (unsigned short)((u + 0x7fffu + ((u >> 16) & 1u)) >> 16); }
struct EpiZ {
    static constexpr bool PERM = true, AFTER_DRAIN = false, MIDSCALE = false;
    bf16_t* Z; bf16_t* KSF; bf16_t* VSF; bf16_t* KWF; bf16_t* VWF; float* GATES; const float* bgate;
    __device__ __forceinline__ void operator()(const f32x4 (&acc)[2][2][4][2], const Unit& u, int wr, int wc, int fr, int fq) const {
        const int row0 = u.pm * BM + wr * 64 + fr;
        if (u.pn < 9) {
            const int col0 = u.pn * BM + wc * 32 + 8 * fq;
#pragma unroll
            for (int ai = 0; ai < 2; ++ai)
#pragma unroll
                for (int m = 0; m < 4; ++m) { bf16_t* rowp = Z + (size_t)(row0 + ai * HALF + m * 16) * 2304 + col0;
#pragma unroll
                    for (int bj = 0; bj < 2; ++bj) { const f32x4 v0 = acc[ai][bj][m][0], v1 = acc[ai][bj][m][1];
                        u32x4 w; w.x = cvt_pk_bf16(v0[0], v0[1]); w.y = cvt_pk_bf16(v0[2], v0[3]); w.z = cvt_pk_bf16(v1[0], v1[1]); w.w = cvt_pk_bf16(v1[2], v1[3]);
                        *(u32x4*)(rowp + bj * HALF) = w; } }
            if (u.pn >= 7) {
                bf16_t* KF = (u.pn == 7) ? KSF : KWF; bf16_t* VF = (u.pn == 7) ? VSF : VWF;
                const int kvh = wc >> 1, dbase = 32 * (wc & 1) + 8 * fq;
#pragma unroll
                for (int ai = 0; ai < 2; ++ai)
#pragma unroll
                    for (int m = 0; m < 4; ++m) { const int row = row0 + ai * HALF + m * 16, b = row >> 13, s = row & 8191, tile = s >> 5, k = s & 31;
                        const size_t tb = ((size_t)(b * 2 + kvh) * 256 + tile) * 2048;
                        { const f32x4 v0 = acc[ai][0][m][0], v1 = acc[ai][0][m][1];
                          u32x4 w; w.x = cvt_pk_bf16(v0[0], v0[1]); w.y = cvt_pk_bf16(v0[2], v0[3]); w.z = cvt_pk_bf16(v1[0], v1[1]); w.w = cvt_pk_bf16(v1[2], v1[3]);
                          *(u32x4*)(KF + tb + (dbase >> 4) * 512 + ((dbase >> 3) & 1) * 256 + k * 8) = w; }
                        const int kk = k & 15, vo = ((kk >> 2) & 1) * 512 + (k >> 4) * 8 + (kk & 3) + 4 * (kk >> 3);
                        unsigned char* V8 = (unsigned char*)VF + ((size_t)(b * 2 + kvh) * 256 + tile) * 2048;
#pragma unroll
                        for (int n = 0; n < 2; ++n) { const f32x4 v = acc[ai][1][m][n]; int w = 0; w = __builtin_amdgcn_cvt_pk_fp8_f32(v[0], v[1], w, false); w = __builtin_amdgcn_cvt_pk_fp8_f32(v[2], v[3], w, true);
#pragma unroll
                            for (int e = 0; e < 4; ++e) { const int d = dbase + 4 * n + e; V8[(d >> 5) * 1024 + (d & 31) * 16 + vo] = (unsigned char)((unsigned)w >> (8 * e)); } }
                        asm volatile("" ::: "memory"); }
            }
        } else {
            if (wc == 0 && fq < 3) {
#pragma unroll
                for (int ai = 0; ai < 2; ++ai)
#pragma unroll
                    for (int m = 0; m < 4; ++m) { const int row = row0 + ai * HALF + m * 16;
#pragma unroll
                        for (int n = 0; n < 2; ++n)
#pragma unroll
                            for (int e = 0; e < 4; ++e) { const int c = 8 * fq + 4 * n + e; const float v = acc[ai][0][m][n][e] + bgate[c]; GATES[(size_t)row * 24 + c] = 1.0f / (1.0f + __expf(-v)); } }
            }
        }
    }
};
struct EpiStore {
    static constexpr bool PERM = true, AFTER_DRAIN = false, MIDSCALE = false;
    bf16_t* O; int ldc; const float* ssq; int frag;
    __device__ __forceinline__ void operator()(const f32x4 (&acc)[2][2][4][2], const Unit& u, int wr, int wc, int fr, int fq) const {
        const int row0 = u.pm * BM + wr * 64 + fr; const int col0 = u.pn * BM + wc * 32 + 8 * fq;
#pragma unroll
        for (int ai = 0; ai < 2; ++ai)
#pragma unroll
            for (int m = 0; m < 4; ++m) { const int row = row0 + ai * HALF + m * 16;
                bf16_t* rowp = frag ? O + (size_t)(row >> 5) * 32 * ldc + (size_t)(col0 >> 4) * 512 + ((col0 >> 3) & 1) * 256 + (row & 31) * 8 : O + (size_t)row * ldc + col0;
                const int bjstep = frag ? (HALF >> 4) * 512 : HALF;
                float sc = 1.f;
                if (ssq) { const f32x4* p = (const f32x4*)(ssq + (size_t)row * 16); const f32x4 a = p[0], b = p[1], c = p[2], d = p[3];
                    const float s = ((a[0] + a[1]) + (a[2] + a[3])) + ((b[0] + b[1]) + (b[2] + b[3])) + ((c[0] + c[1]) + (c[2] + c[3])) + ((d[0] + d[1]) + (d[2] + d[3]));
                    sc = rsqrtf(s * (1.0f / 1024.0f) + 1e-6f); }
#pragma unroll
                for (int bj = 0; bj < 2; ++bj) { const f32x4 v0 = acc[ai][bj][m][0] * sc, v1 = acc[ai][bj][m][1] * sc;
                    u32x4 w; w.x = cvt_pk_bf16(v0[0], v0[1]); w.y = cvt_pk_bf16(v0[2], v0[3]); w.z = cvt_pk_bf16(v1[0], v1[1]); w.w = cvt_pk_bf16(v1[2], v1[3]);
                    *(u32x4*)(rowp + bj * bjstep) = w; } }
    }
};
struct EpiVFrag {
    static constexpr bool PERM = true, AFTER_DRAIN = false, MIDSCALE = false;
    bf16_t* O;
    __device__ __forceinline__ void operator()(const f32x4 (&acc)[2][2][4][2], const Unit& u, int wr, int wc, int fr, int fq) const {
        const int row0 = u.pm * BM + wr * 64 + fr; const int col0 = u.pn * BM + wc * 32 + 8 * fq;
#pragma unroll
        for (int ai = 0; ai < 2; ++ai)
#pragma unroll
            for (int m = 0; m < 4; ++m) { const int D = row0 + ai * HALF + m * 16, h = D >> 8, dt = (D >> 5) & 7, r = D & 31;
#pragma unroll
                for (int bj = 0; bj < 2; ++bj) { const int K0 = col0 + bj * HALF, b = K0 >> 8, kt = (K0 >> 5) & 7, k0 = K0 & 31;
                    bf16_t* p = O + (size_t)((b * 4 + h) * 8 + kt) * 8192 + dt * 1024 + (k0 >> 4) * 512 + r * 8 + 4 * ((k0 >> 3) & 1);
                    const f32x4 v0 = acc[ai][bj][m][0], v1 = acc[ai][bj][m][1];
                    u32x2 w0, w1; w0.x = cvt_pk_bf16(v0[0], v0[1]); w0.y = cvt_pk_bf16(v0[2], v0[3]); w1.x = cvt_pk_bf16(v1[0], v1[1]); w1.y = cvt_pk_bf16(v1[2], v1[3]);
                    *(u32x2*)p = w0; *(u32x2*)(p + 256) = w1; } }
    }
};
template <bool MID> struct EpiRes {
    static constexpr bool PERM = false, AFTER_DRAIN = false, MIDSCALE = MID;
    const float* base; const bf16_t* base16; float* out; bf16_t* XB; float* ssq; const float* ssqn;
    __device__ __forceinline__ void midscale(f32x4 (&acc)[2][2][4][2], const Unit& u, int wr, int wc, int fr, int fq) const {
        const int row0 = u.pm * BM + wr * 64 + fr;
#pragma unroll
        for (int ai = 0; ai < 2; ++ai)
#pragma unroll
            for (int m = 0; m < 4; ++m) { const int row = row0 + ai * HALF + m * 16; const f32x2 sq = *(const f32x2*)(ssqn + (size_t)row * 2);
                const float sc = rsqrtf((sq[0] + sq[1]) * (1.0f / 512.0f) + 1e-6f);
#pragma unroll
                for (int bj = 0; bj < 2; ++bj)
#pragma unroll
                    for (int n = 0; n < 2; ++n) acc[ai][bj][m][n] = acc[ai][bj][m][n] * sc; }
    }
    __device__ __forceinline__ void operator()(const f32x4 (&acc)[2][2][4][2], const Unit& u, int wr, int wc, int fr, int fq) const {
        const int row0 = u.pm * BM + wr * 64 + fr; const int col0 = u.pn * BM + wc * 32 + 4 * fq;
#pragma unroll
        for (int ai = 0; ai < 2; ++ai)
#pragma unroll
            for (int m = 0; m < 4; ++m) { const int row = row0 + ai * HALF + m * 16; const size_t off = (size_t)row * 1024 + col0; float s = 0.f;
#pragma unroll
                for (int bj = 0; bj < 2; ++bj)
#pragma unroll
                    for (int n = 0; n < 2; ++n) { f32x4 b;
                        if (base) b = *(const f32x4*)(base + off + bj * HALF + n * 16);
                        else { const u32x2 w = *(const u32x2*)(base16 + off + bj * HALF + n * 16); b[0] = __builtin_bit_cast(float, w.x << 16); b[1] = __builtin_bit_cast(float, w.x & 0xffff0000u); b[2] = __builtin_bit_cast(float, w.y << 16); b[3] = __builtin_bit_cast(float, w.y & 0xffff0000u); }
                        const f32x4 v = b + acc[ai][bj][m][n];
                        if (out) *(f32x4*)(out + off + bj * HALF + n * 16) = v;
                        s += (v[0] * v[0] + v[1] * v[1]) + (v[2] * v[2] + v[3] * v[3]);
                        u32x2 w; w.x = cvt_pk_bf16(v[0], v[1]); w.y = cvt_pk_bf16(v[2], v[3]); *(u32x2*)(XB + off + bj * HALF + n * 16) = w; }
                s += __shfl_xor(s, 16); s += __shfl_xor(s, 32);
                if (fq == 0) ssq[(size_t)row * 16 + u.pn * 4 + wc] = s;
                asm volatile("" ::: "memory"); }
    }
};
template <class Epi, class Sched, bool ALIGN_EPI = false, bool SP2 = false>
__device__ __forceinline__ void gemm_phase(PG8_LAS unsigned char* lds, const Gemm g, const Sched& S, const Epi& E, int wave  ) {
    int lane; asm volatile("v_mbcnt_lo_u32_b32 %0, -1, 0\n\tv_mbcnt_hi_u32_b32 %0, -1, %0" : "=v"(lane));
    const int wid = wave, tid = wid * 64 + lane, wr = wid >> 2, wc = wid & 3, fr = lane & 15, fq = lane >> 4;
    const int K = g.K, nt = K / BK;
    unsigned voffA[2], voffB[2];
#pragma unroll
    for (int i = 0; i < 2; ++i) { int R, C; stage_rc(tid * 16 + i * 8192, R, C); const int Rb = Epi::PERM ? ((R & ~31) + perm32(R & 31)) : R;
        voffA[i] = (unsigned)(R * K + C) * 2u; voffB[i] = (unsigned)(Rb * K + C) * 2u; }
    const size_t kstep = (size_t)(BK * 2);
    const size_t hstep = (size_t)HALF * K * 2;
    const size_t tstep = 2 * hstep;
    const unsigned ldsw = (unsigned)wid * 1024u;
    const int aoff = lds_byte(wr * 64 + fr, fq * 8), boff = lds_byte(wc * 32 + fr, fq * 8);
#define PG8_SA(b, h) (((b) * 2 + (h)) * HTB)
#define PG8_SB(b, h) ((4 + (b) * 2 + (h)) * HTB)
#define PG8_STAGE(bufoff, gbase, voff) do { _Pragma("unroll") for (int _i = 0; _i < 2; ++_i) \
        __builtin_amdgcn_global_load_lds((const unsigned*)((const char*)(gbase) + (voff)[_i]), (PG8_LAS unsigned*)(lds + (bufoff) + ldsw + _i * 8192), 16, 0, 0); } while (0)
#define PG8_LDA(dst, b, h) do { _Pragma("unroll") for (int m = 0; m < 4; ++m) _Pragma("unroll") for (int k = 0; k < 2; ++k) dst[m][k] = *(const PG8_LAS bf16x8*)(lds + PG8_SA(b, h) + aoff + m * 2048 + k * 1024); } while (0)
#define PG8_LDB(dst, b, h) do { _Pragma("unroll") for (int n = 0; n < 2; ++n) _Pragma("unroll") for (int k = 0; k < 2; ++k) dst[n][k] = *(const PG8_LAS bf16x8*)(lds + PG8_SB(b, h) + boff + n * 2048 + k * 1024); } while (0)
#define PG8_MMA(ai, bj, At, Bt) do { __builtin_amdgcn_s_setprio(1); _Pragma("unroll") for (int m = 0; m < 4; ++m) _Pragma("unroll") for (int n = 0; n < 2; ++n) _Pragma("unroll") for (int k = 0; k < 2; ++k) \
        acc[ai][bj][m][n] = __builtin_amdgcn_mfma_f32_16x16x32_bf16(Bt[n][k], At[m][k], acc[ai][bj][m][n], 0, 0, 0); __builtin_amdgcn_s_setprio(0); } while (0)
#define PG8_WAIT_V(n) asm volatile("s_waitcnt vmcnt(" #n ")" ::: "memory")
#define PG8_WAIT_L(n) asm volatile("s_waitcnt lgkmcnt(" #n ")" ::: "memory")
#define PG8_BAR __builtin_amdgcn_s_barrier()
#define PG8_SCHED __builtin_amdgcn_sched_barrier(0)
    Unit cur, nxt; int ui = 0;
    if (!S.next(0, cur)) return;
    f32x4 acc[2][2][4][2];
#pragma unroll
    for (int a = 0; a < 2; ++a)
#pragma unroll
        for (int b = 0; b < 2; ++b)
#pragma unroll
            for (int m = 0; m < 4; ++m)
#pragma unroll
                for (int n = 0; n < 2; ++n) acc[a][b][m][n] = (f32x4){0.f, 0.f, 0.f, 0.f};
    bf16x8 At[4][2], B0[2][2], B1[2][2];
    const char* cA = (const char*)g.A + (size_t)cur.pm * tstep; const char* cB = (const char*)g.Bt + (size_t)cur.pn * tstep;
    S.a_ready(cur);
    if constexpr (SP2) {
        PG8_STAGE(PG8_SB(0, 0), cB, voffB); PG8_STAGE(PG8_SB(0, 1), cB + hstep, voffB); PG8_STAGE(PG8_SA(0, 0), cA, voffA); PG8_STAGE(PG8_SA(0, 1), cA + hstep, voffA);
        if (wr == 1) PG8_BAR;
        PG8_WAIT_V(2); PG8_BAR;
        PG8_STAGE(PG8_SB(1, 0), cB + kstep, voffB); PG8_STAGE(PG8_SA(1, 0), cA + kstep, voffA); PG8_STAGE(PG8_SB(1, 1), cB + hstep + kstep, voffB);
        PG8_WAIT_V(6); PG8_BAR;
    } else {
        PG8_STAGE(PG8_SB(0, 0), cB, voffB); PG8_STAGE(PG8_SA(0, 0), cA, voffA); PG8_STAGE(PG8_SB(0, 1), cB + hstep, voffB); PG8_STAGE(PG8_SA(0, 1), cA + hstep, voffA);
        if (wr == 1) PG8_BAR;
        PG8_WAIT_V(4); PG8_BAR;
        PG8_STAGE(PG8_SB(1, 0), cB + kstep, voffB); PG8_STAGE(PG8_SA(1, 0), cA + kstep, voffA); PG8_STAGE(PG8_SB(1, 1), cB + hstep + kstep, voffB);
        PG8_WAIT_V(6); PG8_BAR;
    }
    for (;;) {
        const bool has_next = S.next(ui + 1, nxt);
        const char* nA = has_next ? (const char*)g.A + (size_t)nxt.pm * tstep : cA; const char* nB = has_next ? (const char*)g.Bt + (size_t)nxt.pn * tstep : cB;
        for (int t = 0; t < nt; t += 2) {
            if constexpr (Epi::MIDSCALE) { if (t == nt / 2) E.midscale(acc, cur, wr, wc, fr, fq); }
            const bool last = (t == nt - 2);
            const char* a1 = cA + (size_t)(t + 1) * kstep;
            const char* a2 = last ? nA : cA + (size_t)(t + 2) * kstep; const char* b2 = last ? nB : cB + (size_t)(t + 2) * kstep;
            const char* a3 = a2 + kstep; const char* b3 = b2 + kstep;
            if (last && has_next) S.a_ready(nxt);
            if constexpr (SP2) {
            PG8_LDB(B0, 0, 0); PG8_LDB(B1, 0, 1); PG8_SCHED; PG8_LDA(At, 0, 0); PG8_STAGE(PG8_SA(1, 1), a1 + hstep, voffA);
            PG8_WAIT_V(8); PG8_WAIT_L(0); PG8_BAR; PG8_MMA(0, 0, At, B0); PG8_MMA(0, 1, At, B1); PG8_BAR; PG8_SCHED;
            PG8_LDA(At, 0, 1); PG8_STAGE(PG8_SB(0, 0), b2, voffB); PG8_STAGE(PG8_SB(0, 1), b2 + hstep, voffB); PG8_STAGE(PG8_SA(0, 0), a2, voffA);
            PG8_WAIT_V(8); PG8_WAIT_L(0); PG8_BAR; PG8_MMA(1, 0, At, B0); PG8_MMA(1, 1, At, B1); PG8_BAR; PG8_SCHED;
            PG8_LDB(B0, 1, 0); PG8_LDB(B1, 1, 1); PG8_SCHED; PG8_LDA(At, 1, 0); PG8_STAGE(PG8_SA(0, 1), a2 + hstep, voffA);
            PG8_WAIT_V(8); PG8_WAIT_L(0); PG8_BAR; PG8_MMA(0, 0, At, B0); PG8_MMA(0, 1, At, B1); PG8_BAR; PG8_SCHED;
            PG8_LDA(At, 1, 1); PG8_STAGE(PG8_SB(1, 0), b3, voffB); PG8_STAGE(PG8_SB(1, 1), b3 + hstep, voffB); PG8_STAGE(PG8_SA(1, 0), a3, voffA);
            PG8_WAIT_V(8); PG8_WAIT_L(0); PG8_BAR; PG8_MMA(1, 0, At, B0); PG8_MMA(1, 1, At, B1); PG8_BAR; PG8_SCHED;
            } else {
            PG8_LDB(B0, 0, 0); PG8_SCHED; PG8_LDA(At, 0, 0); PG8_STAGE(PG8_SA(1, 1), a1 + hstep, voffA);
            PG8_WAIT_L(8); PG8_BAR; PG8_WAIT_L(0); PG8_MMA(0, 0, At, B0); PG8_BAR; PG8_SCHED;
            PG8_LDB(B1, 0, 1); PG8_STAGE(PG8_SB(0, 0), b2, voffB);
            PG8_BAR; PG8_WAIT_L(0); PG8_MMA(0, 1, At, B1); PG8_BAR;
            PG8_LDA(At, 0, 1); PG8_STAGE(PG8_SA(0, 0), a2, voffA);
            PG8_BAR; PG8_WAIT_L(0); PG8_MMA(1, 0, At, B0); PG8_BAR; PG8_SCHED;
            PG8_STAGE(PG8_SB(0, 1), b2 + hstep, voffB);
            PG8_WAIT_V(6); PG8_BAR; PG8_MMA(1, 1, At, B1); PG8_BAR;
            PG8_LDB(B0, 1, 0); PG8_SCHED; PG8_LDA(At, 1, 0); PG8_STAGE(PG8_SA(0, 1), a2 + hstep, voffA);
            PG8_WAIT_L(8); PG8_BAR; PG8_WAIT_L(0); PG8_MMA(0, 0, At, B0); PG8_BAR; PG8_SCHED;
            PG8_LDB(B1, 1, 1); PG8_STAGE(PG8_SB(1, 0), b3, voffB);
            PG8_BAR; PG8_WAIT_L(0); PG8_MMA(0, 1, At, B1); PG8_BAR;
            PG8_LDA(At, 1, 1); PG8_STAGE(PG8_SA(1, 0), a3, voffA);
            PG8_BAR; PG8_WAIT_L(0); PG8_MMA(1, 0, At, B0); PG8_BAR; PG8_SCHED;
            PG8_STAGE(PG8_SB(1, 1), b3 + hstep, voffB);
            PG8_WAIT_V(6); PG8_BAR; PG8_MMA(1, 1, At, B1); PG8_BAR;
            }
        }
        if constexpr (ALIGN_EPI) { if (wr == 0) PG8_BAR; }
        if constexpr (!Epi::AFTER_DRAIN) { E(acc, cur, wr, wc, fr, fq); S.done(cur); }
        if (!has_next) break;
#pragma unroll
        for (int a = 0; a < 2; ++a)
#pragma unroll
            for (int b = 0; b < 2; ++b)
#pragma unroll
                for (int m = 0; m < 4; ++m)
#pragma unroll
                    for (int n = 0; n < 2; ++n) acc[a][b][m][n] = (f32x4){0.f, 0.f, 0.f, 0.f};
        cur = nxt; cA = nA; cB = nB; ++ui;
        if constexpr (ALIGN_EPI) { if (wr == 1) PG8_BAR; }
    }
    PG8_WAIT_V(0);
    if constexpr (!ALIGN_EPI) { if (wr == 0) PG8_BAR; }
    PG8_BAR;
    if constexpr (Epi::AFTER_DRAIN) { E.fused(acc, cur, wr, wc, fr, fq, lds, wid, lane); S.done(cur); }
#undef PG8_SA
#undef PG8_SB
#undef PG8_STAGE
#undef PG8_LDA
#undef PG8_LDB
#undef PG8_MMA
#undef PG8_WAIT_V
#undef PG8_WAIT_L
#undef PG8_BAR
#undef PG8_SCHED
}
}

constexpr int NB = 2, SEQ = 8192, DM = 1024, MTOK = NB * SEQ;
constexpr int NZ = 2304, NZP = 2560;
constexpr int NMEM = 256;
constexpr float EPS = 1e-6f;
constexpr float QSCALE = 0.125f * 1.4426950408889634f;
constexpr int ZC_XL = 0, ZC_GT = 512, ZC_Q = 1024, ZC_KC = 1536, ZC_VC = 1664, ZC_KS = 1792, ZC_VS = 1920, ZC_KW = 2048, ZC_VW = 2176, ZC_G = 2304;

constexpr size_t MiB = 1u << 20;
constexpr size_t WS_CTL = 0;
constexpr size_t WS_WIN = 1 * MiB, WS_WOUT = 6 * MiB, WS_WMQ = 8 * MiB, WS_WMK = 10 * MiB, WS_WMV = 12 * MiB, WS_WMO = 14 * MiB, WS_WPQ = 16 * MiB;
constexpr size_t WS_SKEY = 20 * MiB;
constexpr size_t WS_CW1T = WS_SKEY + 512 * 1024;
constexpr size_t WS_CW2T = WS_CW1T + 512 * 1024;
constexpr size_t WS_C1 = WS_CW2T + 16 * 1024;
constexpr size_t WS_WRGT = WS_C1 + 16 * 1024;
constexpr size_t WS_MEMN = 22 * MiB, WS_MEMK = 23 * MiB, WS_MEMVT = 24 * MiB;
constexpr size_t WS_KC = 26 * MiB;
constexpr size_t WS_VCT = WS_KC + 256 * 1024;
constexpr size_t WS_SUMM = 27 * MiB;
constexpr size_t WS_SSQ1 = 28 * MiB, WS_SSQ2 = 29 * MiB;
constexpr size_t WS_GATES = 30 * MiB;
constexpr size_t WS_SSQN = 31 * MiB + 512 * 1024;
constexpr size_t WS_U8 = 32 * MiB, WS_V8 = 48 * MiB;
constexpr size_t WS_SU = 64 * MiB, WS_SV = 64 * MiB + 65536;
constexpr size_t WS_SSQ3 = 65 * MiB;
constexpr size_t WS_W = 66 * MiB;
constexpr size_t WS_PART = 128 * MiB;
constexpr size_t WS_XN = 96 * MiB;
constexpr size_t WS_Z = 128 * MiB;
constexpr size_t WS_KSF = 240 * MiB, WS_VSF = 244 * MiB, WS_KWF = 248 * MiB, WS_VWF = 252 * MiB;
constexpr size_t WS_QM = 128 * MiB, WS_OM = 160 * MiB;
constexpr size_t WS_QP = 128 * MiB;
constexpr size_t WS_Y = 208 * MiB;
constexpr size_t WS_EID = 208 * MiB, WS_GW = 216 * MiB;
constexpr size_t WS_END = 256 * MiB;

constexpr int CW_KMAX = 12288;
constexpr int LDS_BYTES = 147456;

#define GAS __attribute__((address_space(1)))
#define LAS __attribute__((address_space(3)))
typedef unsigned short bf16;
typedef unsigned v4u __attribute__((ext_vector_type(4)));
typedef unsigned v2u __attribute__((ext_vector_type(2)));
typedef float f32x4 __attribute__((ext_vector_type(4)));
typedef float f32x16 __attribute__((ext_vector_type(16)));
typedef short bf16x8 __attribute__((ext_vector_type(8)));
typedef short bf16x4 __attribute__((ext_vector_type(4)));
__device__ __forceinline__ unsigned f2bf(float f) { unsigned u = __builtin_bit_cast(unsigned, f); return (u + 0x7fffu + ((u >> 16) & 1u)) >> 16; }
typedef float f32x2_ __attribute__((ext_vector_type(2))); typedef __bf16 bf16x2_ __attribute__((ext_vector_type(2)));
__device__ __forceinline__ unsigned pk2(float lo, float hi) { f32x2_ v = {lo, hi}; bf16x2_ b = __builtin_convertvector(v, bf16x2_); return __builtin_bit_cast(unsigned, b); }
__device__ __forceinline__ float bf2f(unsigned short h) { return __builtin_bit_cast(float, (unsigned)h << 16); }
__device__ __forceinline__ float bflo(unsigned w) { return __builtin_bit_cast(float, w << 16); }
__device__ __forceinline__ float bfhi(unsigned w) { return __builtin_bit_cast(float, w & 0xffff0000u); }
__device__ __forceinline__ void swap32(unsigned& a, unsigned& b) { asm("s_nop 1\n\tv_permlane32_swap_b32 %0, %1" : "+v"(a), "+v"(b)); }
__device__ __forceinline__ int maxswap32_i(int v) { unsigned a = (unsigned)v, b = (unsigned)v; swap32(a, b); return max((int)a, (int)b); }
__device__ __forceinline__ float maxswap32_f(float v) { unsigned a = __builtin_bit_cast(unsigned, v), b = a; swap32(a, b); return fmaxf(__builtin_bit_cast(float, a), __builtin_bit_cast(float, b)); }
__device__ __forceinline__ float addswap32_f(float v) { unsigned a = __builtin_bit_cast(unsigned, v), b = a; swap32(a, b); return __builtin_bit_cast(float, a) + __builtin_bit_cast(float, b); }
__device__ __forceinline__ float wave_sum(float v) {
#pragma unroll
    for (int o = 1; o < 64; o <<= 1) v += __shfl_xor(v, o);
    return v;
}

struct Args { const float* in[33]; float* out; unsigned char* ws; int ph_lo, ph_hi; };

struct Frame {
    int tid, lane, wave, vcu, G, gw, NGW;
};
__device__ __forceinline__ int lane_id() { int l; asm volatile("v_mbcnt_lo_u32_b32 %0, -1, 0\n\tv_mbcnt_hi_u32_b32 %0, -1, %0" : "=v"(l)); return l; }
#define REFRESH_LANE(F) do { (F).lane = lane_id(); (F).tid = (F).wave * 64 + (F).lane; } while (0)

__device__ __forceinline__ void transpose_item(const float* W, int K, int N, bf16* WT, int ldt, int row_off, const float* gain, int slo, int shi, float cs, LAS float* scr, int item, int lane, int kxor = 0) {
    const int nblk = (N + 31) / 32, kb = item / nblk, nb = item % nblk, k0 = 64 * kb, n0 = 32 * nb;
#pragma unroll 16
    for (int i = 0; i < 32; ++i) { const int kk = 2 * i + (lane >> 5), n = n0 + (lane & 31);
        float v = (n < N) ? __builtin_nontemporal_load(W + (size_t)(k0 + kk) * N + n) : 0.f; if (gain) v *= gain[k0 + kk]; if (n >= slo && n < shi) v *= cs;
        scr[kk * 33 + (lane & 31)] = v; }
    asm volatile("s_waitcnt lgkmcnt(0)" ::: "memory");
    const int c = lane & 7;
#pragma unroll
    for (int j = 0; j < 4; ++j) { const int n = (lane >> 3) + 8 * j; const LAS float* s = scr + (8 * c) * 33 + n;
        v4u o; o.x = pk2(s[0 * 33], s[1 * 33]); o.y = pk2(s[2 * 33], s[3 * 33]); o.z = pk2(s[4 * 33], s[5 * 33]); o.w = pk2(s[6 * 33], s[7 * 33]);
        *(v4u*)(WT + (size_t)(row_off + n0 + n) * ldt + (k0 ^ kxor) + 8 * c) = o; }
    asm volatile("s_waitcnt lgkmcnt(0)" ::: "memory");
}
__device__ __forceinline__ void rms_row_to_bf16(const float* xrow, bf16* orow, int lane) {
    const f32x4* xr = (const f32x4*)xrow + lane;
    f32x4 v[4]; float s = 0.f;
#pragma unroll
    for (int j = 0; j < 4; ++j) { v[j] = xr[64 * j]; s += (v[j].x * v[j].x + v[j].y * v[j].y) + (v[j].z * v[j].z + v[j].w * v[j].w); }
    const float rstd = rsqrtf(wave_sum(s) * (1.f / DM) + EPS);
    unsigned long long* o8 = (unsigned long long*)orow + lane;
#pragma unroll
    for (int j = 0; j < 4; ++j) o8[64 * j] = (unsigned long long)pk2(v[j].x * rstd, v[j].y * rstd) | ((unsigned long long)pk2(v[j].z * rstd, v[j].w * rstd) << 32);
}
__device__ __forceinline__ void quant_row_fp8(const float* src, const float* gain, unsigned char* dst, float* scale_out, int lane) {
    const f32x4* p = (const f32x4*)src + 4 * lane; f32x4 v[4]; float am = 0.f;
#pragma unroll
    for (int j = 0; j < 4; ++j) { v[j] = p[j]; if (gain) v[j] = v[j] * ((const f32x4*)gain)[4 * lane + j]; am = fmaxf(am, fmaxf(fmaxf(fabsf(v[j].x), fabsf(v[j].y)), fmaxf(fabsf(v[j].z), fabsf(v[j].w)))); }
#pragma unroll
    for (int o = 1; o < 64; o <<= 1) am = fmaxf(am, __shfl_xor(am, o));
    const float inv = am > 0.f ? 448.0f / am : 0.f;
    v4u o4;
#pragma unroll
    for (int j = 0; j < 4; ++j) { int w = 0; w = __builtin_amdgcn_cvt_pk_fp8_f32(v[j].x * inv, v[j].y * inv, w, false); w = __builtin_amdgcn_cvt_pk_fp8_f32(v[j].z * inv, v[j].w * inv, w, true); o4[j] = (unsigned)w; }
    *(v4u*)(dst + (size_t)(lane >> 3) * 16384 * 128 + (lane & 7) * 16) = o4;
    if (lane == 0) *scale_out = am * (1.0f / 448.0f);
}
__device__ __forceinline__ void rms_rows4_to_bf16(const float* x0, bf16* o0, size_t rstride  , int lane) {
    f32x4 v[4][4]; float s[4];
#pragma unroll
    for (int r = 0; r < 4; ++r)
#pragma unroll
        for (int j = 0; j < 4; ++j) v[r][j] = __builtin_nontemporal_load((const f32x4*)(x0 + r * rstride) + lane + 64 * j);
#pragma unroll
    for (int r = 0; r < 4; ++r) { s[r] = 0.f;
#pragma unroll
        for (int j = 0; j < 4; ++j) s[r] += (v[r][j].x * v[r][j].x + v[r][j].y * v[r][j].y) + (v[r][j].z * v[r][j].z + v[r][j].w * v[r][j].w); }
#pragma unroll
    for (int o = 1; o < 64; o <<= 1)
#pragma unroll
        for (int r = 0; r < 4; ++r) s[r] += __shfl_xor(s[r], o);
#pragma unroll
    for (int r = 0; r < 4; ++r) { const float rstd = rsqrtf(s[r] * (1.f / DM) + EPS); unsigned long long* o8 = (unsigned long long*)(o0 + r * rstride) + lane;
#pragma unroll
        for (int j = 0; j < 4; ++j) o8[64 * j] = (unsigned long long)pk2(v[r][j].x * rstd, v[r][j].y * rstd) | ((unsigned long long)pk2(v[r][j].z * rstd, v[r][j].w * rstd) << 32); }
}
__device__ __forceinline__ void quant_rows4_fp8(const float* src0, size_t rstride, const float* gain, unsigned char* dst0, float* scale0, int sstride, int lane) {
    f32x4 v[4][4]; float am[4];
#pragma unroll
    for (int r = 0; r < 4; ++r)
#pragma unroll
        for (int j = 0; j < 4; ++j) v[r][j] = __builtin_nontemporal_load((const f32x4*)(src0 + r * rstride) + 4 * lane + j);
    if (gain) {
#pragma unroll
        for (int j = 0; j < 4; ++j) { const f32x4 g = ((const f32x4*)gain)[4 * lane + j];
#pragma unroll
            for (int r = 0; r < 4; ++r) v[r][j] = v[r][j] * g; } }
#pragma unroll
    for (int r = 0; r < 4; ++r) { am[r] = 0.f;
#pragma unroll
        for (int j = 0; j < 4; ++j) am[r] = fmaxf(am[r], fmaxf(fmaxf(fabsf(v[r][j].x), fabsf(v[r][j].y)), fmaxf(fabsf(v[r][j].z), fabsf(v[r][j].w)))); }
#pragma unroll
    for (int o = 1; o < 64; o <<= 1)
#pragma unroll
        for (int r = 0; r < 4; ++r) am[r] = fmaxf(am[r], __shfl_xor(am[r], o));
#pragma unroll
    for (int r = 0; r < 4; ++r) { const float inv = am[r] > 0.f ? 448.0f / am[r] : 0.f; v4u o4;
#pragma unroll
        for (int j = 0; j < 4; ++j) { int w = 0; w = __builtin_amdgcn_cvt_pk_fp8_f32(v[r][j].x * inv, v[r][j].y * inv, w, false); w = __builtin_amdgcn_cvt_pk_fp8_f32(v[r][j].z * inv, v[r][j].w * inv, w, true); o4[j] = (unsigned)w; }
        __builtin_nontemporal_store(o4, (v4u*)(dst0 + (size_t)r * sstride * 128 + (size_t)(lane >> 3) * 16384 * 128 + (lane & 7) * 16));
        if (lane == 0) scale0[r * sstride] = am[r] * (1.0f / 448.0f); }
}
__device__ __forceinline__ void p0_prologue(const Frame& F, const Args& A, LAS unsigned char* lds) {
    unsigned char* ws = A.ws;
    LAS float* scr = (LAS float*)(lds + F.wave * 16384);
    const float* const* in = A.in;
    const int gw = F.gw, NGW = F.NGW;
    constexpr int I_IN = 16 * 73, I_SQ = 16 * 32, I_PQ = 16 * 64, I_C1 = 64, I_C2 = 2, I_RG = 2;
    constexpr int E_IN = I_IN, E_OUT = E_IN + I_SQ, E_MQ = E_OUT + I_SQ, E_MK = E_MQ + I_SQ, E_MV = E_MK + I_SQ, E_MO = E_MV + I_SQ, E_PQ = E_MO + I_PQ, E_C1 = E_PQ + 2 * I_C1, E_C2 = E_C1 + 2 * I_C2, E_RG = E_C2 + 16 * I_RG;
    for (int it = gw; it < E_RG; it += NGW) {
        if (it < E_IN) transpose_item(in[3], 1024, 2328, (bf16*)(ws + WS_WIN), 1024, 0, in[2], ZC_Q, ZC_KC, QSCALE, scr, it, F.lane);
        else if (it < E_OUT) { const int j = it - E_IN, kb = j / 32; transpose_item(in[20], 1024, 1024, (bf16*)(ws + WS_WOUT), 1024, 0, (kb < 8 ? in[18] : in[19] - 512), 0, 0, 1.f, scr, j, F.lane, 512); }
        else if (it < E_MQ) transpose_item(in[23], 1024, 1024, (bf16*)(ws + WS_WMQ), 1024, 0, in[21], 0, 1024, 0.0625f * 1.4426950408889634f, scr, it - E_OUT, F.lane);
        else if (it < E_MK) transpose_item(in[24], 1024, 1024, (bf16*)(ws + WS_WMK), 1024, 0, in[22], 0, 0, 1.f, scr, it - E_MQ, F.lane);
        else if (it < E_MV) transpose_item(in[25], 1024, 1024, (bf16*)(ws + WS_WMV), 1024, 0, in[22], 0, 0, 1.f, scr, it - E_MK, F.lane);
        else if (it < E_MO) transpose_item(in[26], 1024, 1024, (bf16*)(ws + WS_WMO), 1024, 0, nullptr, 0, 0, 1.f, scr, it - E_MV, F.lane);
        else if (it < E_PQ) transpose_item(in[28], 1024, 2048, (bf16*)(ws + WS_WPQ), 1024, 0, in[27], 0, 0, 1.f, scr, it - E_MO, F.lane);
        else if (it < E_C1) { const int j = it - E_PQ, kv = j / I_C1; transpose_item(in[kv ? 16 : 13], 2048, 64, (bf16*)(ws + WS_CW1T) + (size_t)kv * 64 * 2048, 2048, 0, nullptr, 0, 0, 1.f, scr, j % I_C1, F.lane); }
        else if (it < E_C2) { const int j = it - E_C1, kv = j / I_C2; transpose_item(in[kv ? 17 : 14], 64, 64, (bf16*)(ws + WS_CW2T) + (size_t)kv * 64 * 64, 64, 0, nullptr, 0, 0, 1.f, scr, j % I_C2, F.lane); }
        else { const int j = it - E_C2, ai = j / 16, h = (j / 2) % 8; transpose_item(in[ai ? 9 : 7] + (size_t)h * 4096, 64, 64, (bf16*)(ws + WS_WRGT) + (size_t)(ai * 8 + h) * 4096, 64, 0, nullptr, 0, 0, 1.f, scr, j % 2, F.lane); }
    }
    for (int i = gw * 64 + F.lane; i < (2560 - 2336) * 1024 / 8; i += NGW * 64) ((v4u*)((bf16*)(ws + WS_WIN) + (size_t)2336 * 1024))[i] = (v4u){0u, 0u, 0u, 0u};
    for (int it = NGW - 1 - gw; it < 32; it += NGW) { const int kv = it >> 4, ch = it & 15; const float* pos = in[kv ? 15 : 12] + 128 * ch; const float* w1 = in[kv ? 16 : 13] + (size_t)128 * ch * 64 + F.lane; float s = 0.f;
#pragma unroll 16
        for (int k = 0; k < 128; ++k) s += pos[k] * w1[(size_t)k * 64];
        ((float*)(ws + WS_C1))[it * 64 + F.lane] = s; }
    { const size_t i0 = (size_t)gw * 64 + F.lane, st = (size_t)NGW * 64;
      const int nrows0 = (F.G == 256) ? 0 : 32768;
      for (int r = gw; r < nrows0; r += 4 * NGW) { const int tb = r >> 14, e = r & 16383;
          if ((16384 % (4 * NGW)) == 0) quant_rows4_fp8(in[30 + tb] + (size_t)e * DM, (size_t)NGW * DM, tb ? nullptr : in[27], ws + (tb ? WS_V8 : WS_U8) + (size_t)e * 128, (float*)(ws + (tb ? WS_SV : WS_SU)) + e, NGW, F.lane);
          else for (int q = 0; q < 4; ++q) { const int rr = r + q * NGW; if (rr < 32768) { const int t2 = rr >> 14, e2 = rr & 16383; quant_row_fp8(in[30 + t2] + (size_t)e2 * DM, t2 ? nullptr : in[27], ws + (t2 ? WS_V8 : WS_U8) + (size_t)e2 * 128, (float*)(ws + (t2 ? WS_SV : WS_SU)) + e2, F.lane); } } }
      for (size_t i = i0; i < (size_t)8 * 2 * 128 * 128 / 8; i += st) { const f32x4 a = ((const f32x4*)in[29])[2 * i], bq = ((const f32x4*)in[29])[2 * i + 1];
          v4u o; o.x = pk2(a.x, a.y); o.y = pk2(a.z, a.w); o.z = pk2(bq.x, bq.y); o.w = pk2(bq.z, bq.w);
          const size_t R = i >> 4, d0 = (i & 15) * 8;
          *(v4u*)((bf16*)(ws + WS_SKEY) + (R >> 5) * 4096 + (d0 >> 4) * 512 + ((d0 >> 3) & 1) * 256 + (R & 31) * 8) = o; } }
    if ((MTOK % (4 * NGW)) == 0) for (int m = gw; m < MTOK; m += 4 * NGW) rms_rows4_to_bf16(in[0] + (size_t)m * DM, (bf16*)(ws + WS_XN) + (size_t)m * DM, (size_t)NGW * DM, F.lane);
    else for (int m = gw; m < MTOK; m += NGW) rms_row_to_bf16(in[0] + (size_t)m * DM, (bf16*)(ws + WS_XN) + (size_t)m * DM, F.lane);
    for (int m = gw; m < NB * NMEM; m += NGW) rms_row_to_bf16(in[1] + (size_t)m * DM, (bf16*)(ws + WS_MEMN) + (size_t)m * DM, F.lane);
}

__device__ __forceinline__ int crow(int r, int hi) { return (r & 3) + 8 * (r >> 2) + 4 * hi; }
__device__ __forceinline__ float gelu_tanh(float x) {
    const float u = 0.7978845608028654f * (x + 0.044715f * x * x * x);
    const float t = 1.0f - 2.0f * __builtin_amdgcn_rcpf(__builtin_amdgcn_exp2f(2.0f * 1.4426950408889634f * u) + 1.0f);
    return 0.5f * x * (1.0f + t);
}
constexpr int XC_LD = 520;
__device__ __forceinline__ void lru_local_item(const Frame& F, const Args& A, LAS unsigned char* lds, int item) {
    unsigned char* ws = A.ws;
    const bf16* Z = (const bf16*)(ws + WS_Z);
    const int b = item >> 7, chunk = item & 127, s0 = chunk * 64; const size_t row0 = (size_t)b * SEQ + s0;
    LAS bf16* xcs = (LAS bf16*)lds;
    {
        const int c8 = F.tid & 63, tg = F.tid >> 6, c0 = 8 * c8;
        v4u xr[11];
#pragma unroll
        for (int r = 0; r < 11; ++r) { const long tok = (long)(8 * tg + r) - 3;
            if (s0 == 0 && tok < 0) xr[r] = (v4u){0u, 0u, 0u, 0u}; else xr[r] = *(const v4u*)(Z + (size_t)((long)row0 + tok) * NZ + c0); }
        const float* cw = A.in[5]; float w0[8], w1[8], w2[8], w3[8], cb[8];
#pragma unroll
        for (int j = 0; j < 2; ++j) { const f32x4 a = *(const f32x4*)(cw + c0 + 4 * j), b = *(const f32x4*)(cw + 512 + c0 + 4 * j), c = *(const f32x4*)(cw + 1024 + c0 + 4 * j), d = *(const f32x4*)(cw + 1536 + c0 + 4 * j), e2 = *(const f32x4*)(A.in[6] + c0 + 4 * j);
#pragma unroll
            for (int k = 0; k < 4; ++k) { w0[4 * j + k] = a[k]; w1[4 * j + k] = b[k]; w2[4 * j + k] = c[k]; w3[4 * j + k] = d[k]; cb[4 * j + k] = e2[k]; } }
#pragma unroll
        for (int tt = 0; tt < 8; ++tt) { float o[8];
#pragma unroll
            for (int q = 0; q < 4; ++q) { const unsigned a = xr[tt][q], b = xr[tt + 1][q], c = xr[tt + 2][q], d = xr[tt + 3][q];
                o[2 * q] = cb[2 * q] + w0[2 * q] * bflo(a) + w1[2 * q] * bflo(b) + w2[2 * q] * bflo(c) + w3[2 * q] * bflo(d);
                o[2 * q + 1] = cb[2 * q + 1] + w0[2 * q + 1] * bfhi(a) + w1[2 * q + 1] * bfhi(b) + w2[2 * q + 1] * bfhi(c) + w3[2 * q + 1] * bfhi(d); }
            v4u ov; ov.x = pk2(o[0], o[1]); ov.y = pk2(o[2], o[3]); ov.z = pk2(o[4], o[5]); ov.w = pk2(o[6], o[7]);
            *(LAS v4u*)(xcs + (8 * tg + tt) * XC_LD + c0) = ov; }
    }
    __syncthreads();
    const int h = F.wave, lane = F.lane, r32 = lane & 31, hi = lane >> 5;
    bf16x8 af[2][4];
#pragma unroll
    for (int tt = 0; tt < 2; ++tt)
#pragma unroll
        for (int ks = 0; ks < 4; ++ks) af[tt][ks] = *(const LAS bf16x8*)(xcs + (32 * tt + r32) * XC_LD + 64 * h + 16 * ks + 8 * hi);
    const bf16* WT = (const bf16*)(ws + WS_WRGT);
    float* SUMM = (float*)(ws + WS_SUMM);
    unsigned* HA = (unsigned*)A.out;
#pragma unroll 1
    for (int ct = 0; ct < 2; ++ct) {
        const int c = 64 * h + 32 * ct + r32;
        f32x16 ga[2], gi[2];
#pragma unroll
        for (int tt = 0; tt < 2; ++tt) { ga[tt] = f32x16{}; gi[tt] = f32x16{}; }
#pragma unroll
        for (int ks = 0; ks < 4; ++ks) {
            const bf16x8 ba = *(const bf16x8*)(WT + (size_t)(0 * 8 + h) * 4096 + (32 * ct + r32) * 64 + 16 * ks + 8 * hi);
            const bf16x8 bi = *(const bf16x8*)(WT + (size_t)(1 * 8 + h) * 4096 + (32 * ct + r32) * 64 + 16 * ks + 8 * hi);
#pragma unroll
            for (int tt = 0; tt < 2; ++tt) { ga[tt] = __builtin_amdgcn_mfma_f32_32x32x16_bf16(af[tt][ks], ba, ga[tt], 0, 0, 0); gi[tt] = __builtin_amdgcn_mfma_f32_32x32x16_bf16(af[tt][ks], bi, gi[tt], 0, 0, 0); }
        }
        const float ba_ = A.in[8][c], bi_ = A.in[10][c], lam = A.in[11][c];
        const float sp = (lam > 15.f) ? __expf(-lam) : log1pf(__expf(-lam));
#pragma unroll
        for (int tt = 0; tt < 2; ++tt)
#pragma unroll
            for (int r = 0; r < 16; ++r) { const int t = 32 * tt + crow(r, hi);
                const float rr = __builtin_amdgcn_rcpf(1.0f + __builtin_amdgcn_exp2f(-1.4426950408889634f * (ga[tt][r] + ba_))), ii = __builtin_amdgcn_rcpf(1.0f + __builtin_amdgcn_exp2f(-1.4426950408889634f * (gi[tt][r] + bi_)));
                const float a = __builtin_amdgcn_exp2f(-8.0f * 1.4426950408889634f * rr * sp);
                const float xcv = bf2f(xcs[t * XC_LD + c]);
                const float bb = __builtin_amdgcn_sqrtf(fmaxf(1.0f - a * a, 0.f)) * (ii * xcv);
                ga[tt][r] = a; gi[tt][r] = bb; }
        float SA[8], SB[8];
#pragma unroll
        for (int tt = 0; tt < 2; ++tt)
#pragma unroll
            for (int q = 0; q < 4; ++q) {
#pragma unroll
                for (int k = 1; k < 4; ++k) { const int r = 4 * q + k; gi[tt][r] = ga[tt][r] * gi[tt][r - 1] + gi[tt][r]; ga[tt][r] = ga[tt][r] * ga[tt][r - 1]; }
                SA[tt * 4 + q] = ga[tt][4 * q + 3]; SB[tt * 4 + q] = gi[tt][4 * q + 3]; }
        float CA = 1.f, CB = 0.f; float inA[8], inB[8];
#pragma unroll
        for (int s = 0; s < 8; ++s) {
            const float pA = __shfl_xor(SA[s], 32), pB = __shfl_xor(SB[s], 32);
            const float Ae = hi ? pA : SA[s], Be = hi ? pB : SB[s], Ao = hi ? SA[s] : pA, Bo = hi ? SB[s] : pB;
            if (!hi) { inA[s] = CA; inB[s] = CB; }
            CB = Ae * CB + Be; CA = Ae * CA;
            if (hi) { inA[s] = CA; inB[s] = CB; }
            CB = Ao * CB + Bo; CA = Ao * CA;
        }
        unsigned hoff = (unsigned)((row0 + 4 * hi) * 512 + c);
        if (hi == 0) { float* sp2 = SUMM + ((size_t)(b * 128 + chunk) * 512 + c) * 2; sp2[0] = CA; sp2[1] = CB; }
#pragma unroll
        for (int tt = 0; tt < 2; ++tt)
#pragma unroll
            for (int r = 0; r < 16; ++r) { const int s = tt * 4 + (r >> 2);
                const float acum = ga[tt][r] * inA[s], hloc = ga[tt][r] * inB[s] + gi[tt][r];
                asm volatile("" : "+v"(hoff));
                HA[hoff + (unsigned)((32 * tt + (r & 3) + 8 * (r >> 2)) * 512)] = f2bf(hloc) | (f2bf(acum) << 16); }
    }
    __syncthreads();
}
__device__ __forceinline__ void lru_fix_item(const Frame& F, const Args& A, LAS unsigned char* lds, int item, bool zero_nsa) {
    unsigned char* ws = A.ws;
    const int b = item >> 7, chunk = item & 127; const size_t row0 = (size_t)b * SEQ + chunk * 64;
    LAS float* carry = (LAS float*)lds;
    { const int c = F.tid; const float* SUMM = (const float*)(ws + WS_SUMM) + (size_t)b * 128 * 1024 + 2 * c; float hc = 0.f;
      int j = 0;
      for (; j + 8 <= chunk; j += 8) { float2 ab[8];
#pragma unroll
          for (int q = 0; q < 8; ++q) ab[q] = *(const float2*)(SUMM + (size_t)(j + q) * 1024);
#pragma unroll
          for (int q = 0; q < 8; ++q) hc = ab[q].x * hc + ab[q].y; }
      for (; j < chunk; ++j) { const float2 ab = *(const float2*)(SUMM + (size_t)j * 1024); hc = ab.x * hc + ab.y; }
      carry[c] = hc; }
    __syncthreads();
    const bf16* Z = (const bf16*)(ws + WS_Z); const unsigned* HA = (const unsigned*)A.out; bf16* Y = (bf16*)(ws + WS_Y);
    const int c0 = 8 * F.lane;
    float cr[8];
#pragma unroll
    for (int j = 0; j < 8; ++j) cr[j] = carry[c0 + j];
#pragma unroll 1
    for (int t4 = 0; t4 < 8; t4 += 4) {
        v4u h0[4], h1[4], gz[4]; float y[4][8], s[4];
#pragma unroll
        for (int q = 0; q < 4; ++q) { const size_t row = row0 + F.wave * 8 + t4 + q; h0[q] = __builtin_nontemporal_load((const v4u*)(HA + row * 512 + c0)); h1[q] = __builtin_nontemporal_load((const v4u*)(HA + row * 512 + c0 + 4)); gz[q] = __builtin_nontemporal_load((const v4u*)(Z + row * NZ + ZC_GT + c0)); }
#pragma unroll
        for (int q = 0; q < 4; ++q) { const unsigned hw[8] = {h0[q].x, h0[q].y, h0[q].z, h0[q].w, h1[q].x, h1[q].y, h1[q].z, h1[q].w};
            const float gt[8] = {bflo(gz[q].x), bfhi(gz[q].x), bflo(gz[q].y), bfhi(gz[q].y), bflo(gz[q].z), bfhi(gz[q].z), bflo(gz[q].w), bfhi(gz[q].w)};
            s[q] = 0.f;
#pragma unroll
            for (int j = 0; j < 8; ++j) { const float hv = bfhi(hw[j]) * cr[j] + bflo(hw[j]); y[q][j] = hv * gelu_tanh(gt[j]); s[q] += y[q][j] * y[q][j]; } }
#pragma unroll
        for (int o = 1; o < 64; o <<= 1)
#pragma unroll
            for (int q = 0; q < 4; ++q) s[q] += __shfl_xor(s[q], o);
#pragma unroll
        for (int q = 0; q < 4; ++q) { const size_t row = row0 + F.wave * 8 + t4 + q; const float rstd = rsqrtf(s[q] * (1.f / 512.f) + EPS);
            v4u o; o.x = pk2(y[q][0] * rstd, y[q][1] * rstd); o.y = pk2(y[q][2] * rstd, y[q][3] * rstd); o.z = pk2(y[q][4] * rstd, y[q][5] * rstd); o.w = pk2(y[q][6] * rstd, y[q][7] * rstd);
            *(v4u*)(Y + row * DM + 512 + c0) = o;
            if (zero_nsa) *(v4u*)(Y + row * DM + c0) = (v4u){0u, 0u, 0u, 0u}; }
    }
    __syncthreads();
}

__device__ __forceinline__ void kmax_item(const Frame& F, const Args& A, int item) {
    unsigned char* ws = A.ws; const int lane = lane_id();
    const int bk = item >> 9, br = (item >> 8) & 1, tile = item & 255;
    const unsigned char* K = ws + (br ? WS_KWF : WS_KSF) + ((size_t)bk * 256 + tile) * 4096 + 16 * lane;
    float s = 0.f;
#pragma unroll
    for (int ks = 0; ks < 4; ++ks) { const v4u w = *(const v4u*)(K + 1024 * ks); const unsigned ww[4] = {w.x, w.y, w.z, w.w};
#pragma unroll
        for (int k = 0; k < 4; ++k) { const float a = bflo(ww[k]), c = bfhi(ww[k]); s += a * a + c * c; } }
    s = addswap32_f(s);
#pragma unroll
    for (int o = 1; o < 32; o <<= 1) s = fmaxf(s, __shfl_xor(s, o));
    if (lane == 0) atomicMax((unsigned*)(ws + WS_CTL) + CW_KMAX + bk * 2 + br, __builtin_bit_cast(unsigned, s));
}
__device__ __forceinline__ void compress_item(const Frame& F, const Args& A, LAS unsigned char* lds, int item) {
    unsigned char* ws = A.ws;
    const int kv = item >> 6, b = (item >> 5) & 1, h = (item >> 4) & 1, nt = item & 15, n0 = 32 * nt;
    const int lane = F.lane, r32 = lane & 31, hi = lane >> 5, w = F.wave;
    const bf16* Z = (const bf16*)(ws + WS_Z); const bf16* W1T = (const bf16*)(ws + WS_CW1T) + (size_t)kv * 64 * 2048; const bf16* W2T = (const bf16*)(ws + WS_CW2T) + (size_t)kv * 4096;
    const int zc = (kv ? ZC_VC : ZC_KC) + h * 64;
    LAS float* part = (LAS float*)lds;
    LAS float* G = (LAS float*)(lds + 65536);
    {
        int n = n0 + r32; if (n > 510) n = 510;
        f32x16 acc[2]; acc[0] = f32x16{}; acc[1] = f32x16{};
#pragma unroll 4
        for (int kk = 0; kk < 16; ++kk) { const int ks = 16 * w + kk, l = ks >> 2, d0 = (ks & 3) * 16 + 8 * hi;
            const bf16x8 bfr = *(const bf16x8*)(Z + ((size_t)b * SEQ + 16 * n + l) * NZ + zc + d0);
            const bf16x8 a0 = *(const bf16x8*)(W1T + (size_t)(r32) * 2048 + ks * 16 + 8 * hi), a1 = *(const bf16x8*)(W1T + (size_t)(32 + r32) * 2048 + ks * 16 + 8 * hi);
            acc[0] = __builtin_amdgcn_mfma_f32_32x32x16_bf16(a0, bfr, acc[0], 0, 0, 0); acc[1] = __builtin_amdgcn_mfma_f32_32x32x16_bf16(a1, bfr, acc[1], 0, 0, 0); }
#pragma unroll
        for (int ot = 0; ot < 2; ++ot)
#pragma unroll
            for (int r = 0; r < 16; ++r) part[(w * 64 + 32 * ot + crow(r, hi)) * 32 + r32] = acc[ot][r];
    }
    __syncthreads();
    { const float* c1 = (const float*)(ws + WS_C1) + kv * 16 * 64;
#pragma unroll
      for (int i = 0; i < 4; ++i) { const int e = F.tid + 512 * i, o = e >> 5, n = e & 31; float s = 0.f;
#pragma unroll
          for (int ch = 0; ch < 16; ++ch) s += c1[ch * 64 + o];
#pragma unroll
          for (int ww = 0; ww < 8; ++ww) s += part[(ww * 64 + o) * 32 + n];
          G[o * 33 + n] = gelu_tanh(s); } }
    __syncthreads();
    if (w < 2) {
        f32x16 acc = f32x16{};
#pragma unroll
        for (int ks = 0; ks < 4; ++ks) { const bf16x8 a = *(const bf16x8*)(W2T + (size_t)(32 * w + r32) * 64 + 16 * ks + 8 * hi);
            v4u bw; const LAS float* gp = G + (16 * ks + 8 * hi) * 33 + r32;
            bw.x = pk2(gp[0], gp[33]); bw.y = pk2(gp[66], gp[99]); bw.z = pk2(gp[132], gp[165]); bw.w = pk2(gp[198], gp[231]);
            acc = __builtin_amdgcn_mfma_f32_32x32x16_bf16(a, __builtin_bit_cast(bf16x8, bw), acc, 0, 0, 0); }
        const int n = n0 + r32;
        const size_t tbase = ((size_t)(b * 2 + h) * 16 + nt) * 2048;
        if (kv == 0) { bf16* KC = (bf16*)(ws + WS_KC) + tbase;
#pragma unroll
            for (int q = 0; q < 4; ++q) { v2u o; o.x = pk2(acc[4 * q], acc[4 * q + 1]); o.y = pk2(acc[4 * q + 2], acc[4 * q + 3]); if (n > 510) { o.x = 0u; o.y = 0u; }
                *(v2u*)(KC + (2 * w + (q >> 1)) * 512 + (q & 1) * 256 + r32 * 8 + 4 * hi) = o; } }
        else { bf16* VC = (bf16*)(ws + WS_VCT) + tbase; const int kk = r32 & 15, vo = (r32 >> 4) * 512 + ((kk >> 2) & 1) * 256 + (kk & 3) + 4 * (kk >> 3);
#pragma unroll
            for (int r = 0; r < 16; ++r) VC[w * 1024 + crow(r, hi) * 8 + vo] = (n > 510) ? (bf16)0 : (bf16)f2bf(acc[r]); }
    }
    __syncthreads();
}

__device__ __forceinline__ void sort16_desc(int (&k)[16]) {
#define CX(i, j) { const int hi_ = max(k[i], k[j]), lo_ = min(k[i], k[j]); k[i] = hi_; k[j] = lo_; }
    CX(0, 1) CX(2, 3) CX(0, 2) CX(1, 3) CX(1, 2) CX(4, 5) CX(6, 7) CX(4, 6) CX(5, 7) CX(5, 6) CX(0, 4) CX(2, 6) CX(2, 4) CX(1, 5) CX(3, 7) CX(3, 5) CX(1, 2)
    CX(3, 4) CX(5, 6) CX(8, 9) CX(10, 11) CX(8, 10) CX(9, 11) CX(9, 10) CX(12, 13) CX(14, 15) CX(12, 14) CX(13, 15) CX(13, 14) CX(8, 12) CX(10, 14) CX(10, 12)
    CX(9, 13) CX(11, 15) CX(11, 13) CX(9, 10) CX(11, 12) CX(13, 14) CX(0, 8) CX(4, 12) CX(4, 8) CX(2, 10) CX(6, 14) CX(6, 10) CX(2, 4) CX(6, 8) CX(10, 12)
    CX(1, 9) CX(5, 13) CX(5, 9) CX(3, 11) CX(7, 15) CX(7, 11) CX(3, 5) CX(7, 9) CX(11, 13) CX(1, 2) CX(3, 4) CX(5, 6) CX(7, 8) CX(9, 10) CX(11, 12) CX(13, 14)
#undef CX
}
__device__ __forceinline__ void sort32_desc(int (&k)[32]) {
#define CX(i, j) { const int hi_ = max(k[i], k[j]), lo_ = min(k[i], k[j]); k[i] = hi_; k[j] = lo_; }
    CX(0, 1) CX(2, 3) CX(0, 2) CX(1, 3) CX(1, 2) CX(4, 5) CX(6, 7) CX(4, 6) CX(5, 7) CX(5, 6) CX(0, 4) CX(2, 6) CX(2, 4) CX(1, 5) CX(3, 7) CX(3, 5) CX(1, 2)
    CX(3, 4) CX(5, 6) CX(8, 9) CX(10, 11) CX(8, 10) CX(9, 11) CX(9, 10) CX(12, 13) CX(14, 15) CX(12, 14) CX(13, 15) CX(13, 14) CX(8, 12) CX(10, 14) CX(10, 12)
    CX(9, 13) CX(11, 15) CX(11, 13) CX(9, 10) CX(11, 12) CX(13, 14) CX(0, 8) CX(4, 12) CX(4, 8) CX(2, 10) CX(6, 14) CX(6, 10) CX(2, 4) CX(6, 8) CX(10, 12)
    CX(1, 9) CX(5, 13) CX(5, 9) CX(3, 11) CX(7, 15) CX(7, 11) CX(3, 5) CX(7, 9) CX(11, 13) CX(1, 2) CX(3, 4) CX(5, 6) CX(7, 8) CX(9, 10) CX(11, 12) CX(13, 14)
    CX(16, 17) CX(18, 19) CX(16, 18) CX(17, 19) CX(17, 18) CX(20, 21) CX(22, 23) CX(20, 22) CX(21, 23) CX(21, 22) CX(16, 20) CX(18, 22) CX(18, 20) CX(17, 21)
    CX(19, 23) CX(19, 21) CX(17, 18) CX(19, 20) CX(21, 22) CX(24, 25) CX(26, 27) CX(24, 26) CX(25, 27) CX(25, 26) CX(28, 29) CX(30, 31) CX(28, 30) CX(29, 31)
    CX(29, 30) CX(24, 28) CX(26, 30) CX(26, 28) CX(25, 29) CX(27, 31) CX(27, 29) CX(25, 26) CX(27, 28) CX(29, 30) CX(16, 24) CX(20, 28) CX(20, 24) CX(18, 26)
    CX(22, 30) CX(22, 26) CX(18, 20) CX(22, 24) CX(26, 28) CX(17, 25) CX(21, 29) CX(21, 25) CX(19, 27) CX(23, 31) CX(23, 27) CX(19, 21) CX(23, 25) CX(27, 29)
    CX(17, 18) CX(19, 20) CX(21, 22) CX(23, 24) CX(25, 26) CX(27, 28) CX(29, 30) CX(0, 16) CX(8, 24) CX(8, 16) CX(4, 20) CX(12, 28) CX(12, 20) CX(4, 8)
    CX(12, 16) CX(20, 24) CX(2, 18) CX(10, 26) CX(10, 18) CX(6, 22) CX(14, 30) CX(14, 22) CX(6, 10) CX(14, 18) CX(22, 26) CX(2, 4) CX(6, 8) CX(10, 12)
    CX(14, 16) CX(18, 20) CX(22, 24) CX(26, 28) CX(1, 17) CX(9, 25) CX(9, 17) CX(5, 21) CX(13, 29) CX(13, 21) CX(5, 9) CX(13, 17) CX(21, 25) CX(3, 19)
    CX(11, 27) CX(11, 19) CX(7, 23) CX(15, 31) CX(15, 23) CX(7, 11) CX(15, 19) CX(23, 27) CX(3, 5) CX(7, 9) CX(11, 13) CX(15, 17) CX(19, 21) CX(23, 25)
    CX(27, 29) CX(1, 2) CX(3, 4) CX(5, 6) CX(7, 8) CX(9, 10) CX(11, 12) CX(13, 14) CX(15, 16) CX(17, 18) CX(19, 20) CX(21, 22) CX(23, 24) CX(25, 26) CX(27, 28)
    CX(29, 30)
#undef CX
}
__device__ __forceinline__ void bitonic16_desc(int (&a)[16]) {
#pragma unroll
    for (int s = 8; s >= 1; s >>= 1)
#pragma unroll
        for (int i = 0; i < 16; ++i) if ((i & s) == 0) { const int hi_ = max(a[i], a[i + s]), lo_ = min(a[i], a[i + s]); a[i] = hi_; a[i + s] = lo_; }
}
__device__ __forceinline__ void merge16_desc(int (&a)[16], const int (&b)[16]) {
#pragma unroll
    for (int i = 0; i < 16; ++i) a[i] = max(a[i], b[15 - i]);
    bitonic16_desc(a);
}
struct AttnSt { float m, l; f32x16 o[2]; };
#define EX2(x) __builtin_amdgcn_exp2f(x)
struct KVF { bf16x8 k[4]; bf16x8 v[2][2]; };
struct KVF8 { bf16x8 k[4]; v4u v8[2]; };
__device__ __forceinline__ void kv_load8(KVF8& f, const bf16* Kt, const unsigned char* Vt8, unsigned lo16) {
    const char* kb = (const char*)Kt + lo16;
#pragma unroll
    for (int ks = 0; ks < 4; ++ks) f.k[ks] = *(const bf16x8*)(kb + 1024 * ks);
#pragma unroll
    for (int dt = 0; dt < 2; ++dt) f.v8[dt] = *(const v4u*)(Vt8 + lo16 + 1024 * dt);
}
typedef __bf16 bf16x2v __attribute__((ext_vector_type(2)));
__device__ __forceinline__ bf16x8 dq8(unsigned w0, unsigned w1) {
    v4u o; o.x = __builtin_bit_cast(unsigned, __builtin_amdgcn_cvt_scalef32_pk_bf16_fp8(w0, 1.0f, false)); o.y = __builtin_bit_cast(unsigned, __builtin_amdgcn_cvt_scalef32_pk_bf16_fp8(w0, 1.0f, true));
    o.z = __builtin_bit_cast(unsigned, __builtin_amdgcn_cvt_scalef32_pk_bf16_fp8(w1, 1.0f, false)); o.w = __builtin_bit_cast(unsigned, __builtin_amdgcn_cvt_scalef32_pk_bf16_fp8(w1, 1.0f, true));
    return __builtin_bit_cast(bf16x8, o); }
__device__ __forceinline__ void kv_load(KVF& f, const bf16* Kt, const bf16* Vt, unsigned lo16) {
    const char* kb = (const char*)Kt + lo16; const char* vb = (const char*)Vt + lo16;
#pragma unroll
    for (int ks = 0; ks < 4; ++ks) f.k[ks] = *(const bf16x8*)(kb + 1024 * ks);
#pragma unroll
    for (int dt = 0; dt < 2; ++dt)
#pragma unroll
        for (int s2 = 0; s2 < 2; ++s2) f.v[dt][s2] = *(const bf16x8*)(vb + 2048 * dt + 1024 * s2);
}
#define MAX3(a, b, c) __builtin_fmaxf(__builtin_fmaxf((a), (b)), (c))
__device__ __forceinline__ float max16(const f32x16& s) { const float a = MAX3(s[0], s[1], s[2]), b = MAX3(s[3], s[4], s[5]), c = MAX3(s[6], s[7], s[8]), d = MAX3(s[9], s[10], s[11]), e = MAX3(s[12], s[13], s[14]);
    return MAX3(MAX3(a, b, c), MAX3(d, e, s[15]), -1e30f); }
__device__ __forceinline__ float sum16(const f32x16& s) { return (((s[0] + s[1]) + (s[2] + s[3])) + ((s[4] + s[5]) + (s[6] + s[7]))) + (((s[8] + s[9]) + (s[10] + s[11])) + ((s[12] + s[13]) + (s[14] + s[15]))); }
template <int MODE, bool FIXED, class AllowF>
__device__ __forceinline__ void attn_compute(const KVF8& f, const bf16x8 (&qf)[4], const f32x16& negm, bool sel, AllowF allow, AttnSt& st) {
    f32x16 s = FIXED ? negm : f32x16{};
#pragma unroll
    for (int ks = 0; ks < 4; ++ks) s = __builtin_amdgcn_mfma_f32_32x32x16_bf16(f.k[ks], qf[ks], s, 0, 0, 0);
    if (MODE == 2) {
#pragma unroll
        for (int r = 0; r < 16; ++r) if (!allow(r)) s[r] = -1e30f; }
    if (!FIXED) {
        float mt = max16(s);
        if (MODE == 1) mt = sel ? mt : -1e30f;
        mt = maxswap32_f(mt);
        if (__any(mt > st.m)) {
            const float mn = fmaxf(st.m, mt), alpha = EX2(st.m - mn);
            st.m = mn; st.l *= alpha;
#pragma unroll
            for (int dt = 0; dt < 2; ++dt)
#pragma unroll
                for (int r = 0; r < 16; ++r) st.o[dt][r] *= alpha;
        }
        const float mref = (MODE == 1 && !sel) ? 1e30f : fmaxf(st.m, -1e29f);
#pragma unroll
        for (int r = 0; r < 16; ++r) s[r] = EX2(s[r] - mref);
        st.l += sum16(s);
    } else {
#pragma unroll
        for (int r = 0; r < 16; ++r) s[r] = EX2(s[r]);
        const float ps = sum16(s);
        st.l += (MODE == 1 && !sel) ? 0.f : ps;
    }
#pragma unroll
    for (int s2 = 0; s2 < 2; ++s2) { v4u pw; pw.x = pk2(s[8 * s2], s[8 * s2 + 1]); pw.y = pk2(s[8 * s2 + 2], s[8 * s2 + 3]); pw.z = pk2(s[8 * s2 + 4], s[8 * s2 + 5]); pw.w = pk2(s[8 * s2 + 6], s[8 * s2 + 7]);
        if (FIXED && MODE == 1) { pw.x = sel ? pw.x : 0u; pw.y = sel ? pw.y : 0u; pw.z = sel ? pw.z : 0u; pw.w = sel ? pw.w : 0u; }
        const bf16x8 pf = __builtin_bit_cast(bf16x8, pw);
#pragma unroll
        for (int dt = 0; dt < 2; ++dt) st.o[dt] = __builtin_amdgcn_mfma_f32_32x32x16_bf16(dq8(f.v8[dt][2 * s2], f.v8[dt][2 * s2 + 1]), pf, st.o[dt], 0, 0, 0); }
}
constexpr int IMP_LD = 132;
__device__ __forceinline__ void nsa_item(const Frame& F, const Args& A, LAS unsigned char* lds, int b, int kvh, int tb, int wsub) {
    unsigned char* ws = A.ws;
    int lane = lane_id(); asm volatile("" : "+v"(lane));
    const int r32 = lane & 31, hi = lane >> 5, w = F.wave;
    const int t0 = 64 * tb + 8 * wsub, ti = r32 & 7, g = r32 >> 3, t = t0 + ti, cur = tb;
    const size_t rowb = (size_t)b * SEQ;
    const bf16* Z = (const bf16*)(ws + WS_Z);
    LAS float* imp = (LAS float*)lds + w * 8 * IMP_LD;
    for (int i = lane; i < 8 * IMP_LD; i += 64) imp[i] = 0.f;
    bf16x8 qf[4];
#pragma unroll
    for (int ks = 0; ks < 4; ++ks) qf[ks] = *(const bf16x8*)(Z + (rowb + t) * NZ + ZC_Q + (kvh * 4 + g) * 64 + 16 * ks + 8 * hi);
    const float* gp = (const float*)(ws + WS_GATES) + (rowb + t) * 24 + (kvh * 4 + g) * 3;
    const float gate_c = gp[0], gate_s = gp[1], gate_w = gp[2];
    LAS float* oacc = (LAS float*)(lds + 8 * 8 * IMP_LD * 4) + w * 2048 + lane;
    {
        const bf16* KC = (const bf16*)(ws + WS_KC) + (size_t)(b * 2 + kvh) * 16 * 2048;
        const bf16* VCT = (const bf16*)(ws + WS_VCT) + (size_t)(b * 2 + kvh) * 16 * 2048;
        const int nv = (t >= 31) ? ((t - 31) >> 4) + 1 : 0;
        const int tl = t0 + 7, nvmax = (tl >= 31) ? ((tl - 31) >> 4) + 1 : 0;
        const unsigned lo16 = 16u * (unsigned)lane;
        float m1 = -1e30f, l1 = 0.f;
        {
            bf16x8 ka[4], kb[4];
#pragma unroll
            for (int ks = 0; ks < 4; ++ks) ka[ks] = *(const bf16x8*)((const char*)KC + lo16 + 1024 * ks);
            for (int n0 = 0; n0 < nvmax; n0 += 32) {
                if (n0 + 32 < nvmax) {
#pragma unroll
                    for (int ks = 0; ks < 4; ++ks) kb[ks] = *(const bf16x8*)((const char*)(KC + (size_t)(n0 + 32) * 64) + lo16 + 1024 * ks);
                }
                f32x16 s = f32x16{};
#pragma unroll
                for (int ks = 0; ks < 4; ++ks) s = __builtin_amdgcn_mfma_f32_32x32x16_bf16(ka[ks], qf[ks], s, 0, 0, 0);
                float mt = -1e30f;
#pragma unroll
                for (int r = 0; r < 16; ++r) { if (n0 + crow(r, hi) >= nv) s[r] = -1e30f; mt = fmaxf(mt, s[r]); }
                const float mn = fmaxf(m1, mt); float ps = 0.f;
#pragma unroll
                for (int r = 0; r < 16; ++r) ps += (s[r] > -1e29f) ? EX2(s[r] - mn) : 0.f;
                l1 = l1 * EX2(m1 - mn) + ps; m1 = mn;
#pragma unroll
                for (int ks = 0; ks < 4; ++ks) ka[ks] = kb[ks];
            }
        }
        { const float mo = __shfl_xor(m1, 32), lo = __shfl_xor(l1, 32); const float mn = fmaxf(m1, mo); l1 = l1 * EX2(m1 - mn) + lo * EX2(mo - mn); m1 = mn; }
        const float invl = (l1 > 0.f) ? 1.0f / l1 : 0.f;
        f32x16 o[2]; o[0] = f32x16{}; o[1] = f32x16{};
        KVF fa, fb;
        if (nvmax > 0) kv_load(fa, KC, VCT, lo16);
        for (int n0 = 0; n0 < nvmax; n0 += 32) {
            if (n0 + 32 < nvmax) kv_load(fb, KC + (size_t)(n0 + 32) * 64, VCT + (size_t)(n0 + 32) * 64, lo16);
            f32x16 s = f32x16{};
#pragma unroll
            for (int ks = 0; ks < 4; ++ks) s = __builtin_amdgcn_mfma_f32_32x32x16_bf16(fa.k[ks], qf[ks], s, 0, 0, 0);
#pragma unroll
            for (int r = 0; r < 16; ++r) s[r] = (n0 + crow(r, hi) < nv) ? EX2(s[r] - m1) * invl : 0.f;
            float bs[4], sp[4];
#pragma unroll
            for (int q = 0; q < 4; ++q) { bs[q] = (s[4 * q] + s[4 * q + 1]) + (s[4 * q + 2] + s[4 * q + 3]); sp[q] = s[4 * q + 3];
                bs[q] += __shfl_xor(bs[q], 8); bs[q] += __shfl_xor(bs[q], 16); sp[q] += __shfl_xor(sp[q], 8); sp[q] += __shfl_xor(sp[q], 16); }
            if (r32 < 8) {
                LAS float* ip = imp + r32 * IMP_LD + (n0 >> 2) + hi;
#pragma unroll
                for (int q = 0; q < 4; ++q) ip[2 * q] += bs[q];
                asm volatile("s_waitcnt lgkmcnt(0)" ::: "memory");
#pragma unroll
                for (int q = 0; q < 4; ++q) ip[2 * q + 1] += sp[q];
                asm volatile("s_waitcnt lgkmcnt(0)" ::: "memory");
            }
#pragma unroll
            for (int s2 = 0; s2 < 2; ++s2) { v4u pw; pw.x = pk2(s[8 * s2], s[8 * s2 + 1]); pw.y = pk2(s[8 * s2 + 2], s[8 * s2 + 3]); pw.z = pk2(s[8 * s2 + 4], s[8 * s2 + 5]); pw.w = pk2(s[8 * s2 + 6], s[8 * s2 + 7]);
                const bf16x8 pf = __builtin_bit_cast(bf16x8, pw);
#pragma unroll
                for (int dt = 0; dt < 2; ++dt) o[dt] = __builtin_amdgcn_mfma_f32_32x32x16_bf16(fa.v[dt][s2], pf, o[dt], 0, 0, 0); }
            if (n0 + 32 < nvmax) fa = fb;
        }
#pragma unroll
        for (int dt = 0; dt < 2; ++dt)
#pragma unroll
            for (int r = 0; r < 16; ++r) oacc[(dt * 16 + r) * 64] = gate_c * o[dt][r];
    }
    asm volatile("s_waitcnt lgkmcnt(0)" ::: "memory");
    unsigned mym[4] = {0u, 0u, 0u, 0u}, un[4] = {0u, 0u, 0u, 0u};
    if (cur < 16) { const unsigned mk = (2u << cur) - 1u; mym[0] = mk; un[0] = mk; }
    else {
        const int tq = lane >> 3, sub = lane & 7;
        int key[16];
#pragma unroll
        for (int i = 0; i < 16; ++i) { const int j = 16 * sub + i; const float v = imp[tq * IMP_LD + j];
            key[i] = (j >= 1 && j <= cur - 2) ? (int)((__builtin_bit_cast(unsigned, v) & ~0x7fu) | (unsigned)(127 - j)) : 0; }
        sort16_desc(key);
        { int ot[16];
#pragma unroll
          for (int i = 0; i < 16; ++i) ot[i] = __builtin_amdgcn_mov_dpp(key[i], 0xB1, 0xf, 0xf, true);
          merge16_desc(key, ot);
#pragma unroll
          for (int i = 0; i < 16; ++i) ot[i] = __builtin_amdgcn_mov_dpp(key[i], 0x4E, 0xf, 0xf, true);
          merge16_desc(key, ot);
#pragma unroll
          for (int i = 0; i < 16; ++i) ot[i] = __builtin_amdgcn_mov_dpp(key[i], 0x141, 0xf, 0xf, true);
          merge16_desc(key, ot); }
        unsigned mk[4] = {1u, 0u, 0u, 0u};
        { const int c1 = cur - 1; if (c1 < 32) mk[0] |= 1u << c1; else if (c1 < 64) mk[1] |= 1u << (c1 - 32); else if (c1 < 96) mk[2] |= 1u << (c1 - 64); else mk[3] |= 1u << (c1 - 96);
          if (cur < 32) mk[0] |= 1u << cur; else if (cur < 64) mk[1] |= 1u << (cur - 32); else if (cur < 96) mk[2] |= 1u << (cur - 64); else mk[3] |= 1u << (cur - 96); }
#pragma unroll
        for (int i = 0; i < 13; ++i) { const int j = 127 - (key[i] & 0x7f); const unsigned bit = (key[i] != 0) ? (1u << (j & 31)) : 0u; const int wd = j >> 5;
            mk[0] |= (wd == 0) ? bit : 0u; mk[1] |= (wd == 1) ? bit : 0u; mk[2] |= (wd == 2) ? bit : 0u; mk[3] |= (wd == 3) ? bit : 0u; }
#pragma unroll
        for (int i = 0; i < 4; ++i) { unsigned u = mk[i]; u |= (unsigned)__shfl_xor((int)u, 8); u |= (unsigned)__shfl_xor((int)u, 16); u |= (unsigned)__shfl_xor((int)u, 32); un[i] = u;
            mym[i] = (unsigned)__shfl((int)mk[i], 8 * ti); }
    }
    float q2 = 0.f;
#pragma unroll
    for (int ks = 0; ks < 4; ++ks) { const v4u qw = __builtin_bit_cast(v4u, qf[ks]); const unsigned ww[4] = {qw.x, qw.y, qw.z, qw.w};
#pragma unroll
        for (int k = 0; k < 4; ++k) { const float a = bflo(ww[k]), c = bfhi(ww[k]); q2 += a * a + c * c; } }
    q2 = addswap32_f(q2);
    const unsigned* KMX = (const unsigned*)(ws + WS_CTL) + CW_KMAX + (b * 2 + kvh) * 2;
    const float Ms = __builtin_amdgcn_sqrtf(q2 * __builtin_bit_cast(float, KMX[0])) * 1.0001f + 1e-3f, Mw = __builtin_amdgcn_sqrtf(q2 * __builtin_bit_cast(float, KMX[1])) * 1.0001f + 1e-3f;
    const bool fixed_ok = !__any(Ms >= 60.f || Mw >= 60.f);
    {
        AttnSt st; st.m = -1e30f; st.l = 0.f; st.o[0] = f32x16{}; st.o[1] = f32x16{};
        const bf16* KS = (const bf16*)(ws + WS_KSF) + (size_t)(b * 2 + kvh) * 256 * 2048; const unsigned char* VS = ws + WS_VSF + (size_t)(b * 2 + kvh) * 256 * 2048;
        const unsigned lo16 = 16u * (unsigned)lane;
        unsigned um0 = (unsigned)__builtin_amdgcn_readfirstlane((int)un[0]), um1 = (unsigned)__builtin_amdgcn_readfirstlane((int)un[1]), um2 = (unsigned)__builtin_amdgcn_readfirstlane((int)un[2]), um3 = (unsigned)__builtin_amdgcn_readfirstlane((int)un[3]);
#define NEXT_BLOCK(jv) do { if (um0) { jv = __builtin_ctz(um0); um0 &= um0 - 1u; } else if (um1) { jv = 32 + __builtin_ctz(um1); um1 &= um1 - 1u; } else if (um2) { jv = 64 + __builtin_ctz(um2); um2 &= um2 - 1u; } \
            else if (um3) { jv = 96 + __builtin_ctz(um3); um3 &= um3 - 1u; } else jv = -1; } while (0)
#define SLC_LOOP(FX) do { f32x16 negm; _Pragma("unroll") for (int r = 0; r < 16; ++r) negm[r] = -Ms; \
        KVF8 fa, fb; int j; NEXT_BLOCK(j); \
        if (j >= 0) kv_load8(fa, KS + (size_t)j * 4096, VS + (size_t)j * 4096, lo16); \
        while (j >= 0) { const int key0 = j * 64; \
            const unsigned mw = (j < 32) ? mym[0] : (j < 64) ? mym[1] : (j < 96) ? mym[2] : mym[3]; const bool sel = (mw >> (j & 31)) & 1u; \
            kv_load8(fb, KS + (size_t)j * 4096 + 2048, VS + (size_t)j * 4096 + 2048, lo16); \
            if (j == cur) attn_compute<2, FX>(fa, qf, negm, sel, [&](int r) { return sel && (key0 + crow(r, hi) <= t); }, st); \
            else attn_compute<1, FX>(fa, qf, negm, sel, [&](int) { return true; }, st); \
            int jn; NEXT_BLOCK(jn); \
            if (jn >= 0) kv_load8(fa, KS + (size_t)jn * 4096, VS + (size_t)jn * 4096, lo16); \
            if (j == cur) attn_compute<2, FX>(fb, qf, negm, sel, [&](int r) { return sel && (key0 + 32 + crow(r, hi) <= t); }, st); \
            else attn_compute<1, FX>(fb, qf, negm, sel, [&](int) { return true; }, st); \
            j = jn; } } while (0)
        if (fixed_ok) SLC_LOOP(true); else SLC_LOOP(false);
#undef SLC_LOOP
#undef NEXT_BLOCK
        const float l = addswap32_f(st.l); const float sc = gate_s / l;
#pragma unroll
        for (int dt = 0; dt < 2; ++dt)
#pragma unroll
            for (int r = 0; r < 16; ++r) oacc[(dt * 16 + r) * 64] += sc * st.o[dt][r];
    }
    f32x16 outv[2];
    {
        AttnSt st; st.m = -1e30f; st.l = 0.f; st.o[0] = f32x16{}; st.o[1] = f32x16{};
        const bf16* KW = (const bf16*)(ws + WS_KWF) + (size_t)(b * 2 + kvh) * 256 * 2048; const unsigned char* VW = ws + WS_VWF + (size_t)(b * 2 + kvh) * 256 * 2048;
        const unsigned lo16 = 16u * (unsigned)lane;
        const int klo = (t0 - 511 > 0) ? ((t0 - 511) & ~31) : 0, khi = (t0 + 7) & ~31;
#define WIN_LOOP(FX) do { f32x16 negm; _Pragma("unroll") for (int r = 0; r < 16; ++r) negm[r] = -Mw; \
        KVF8 fa, fb; kv_load8(fa, KW + (size_t)klo * 64, VW + (size_t)klo * 64, lo16); \
        _Pragma("unroll 1") for (int key0 = klo; key0 <= khi; key0 += 32) { \
            if (key0 + 32 <= khi) kv_load8(fb, KW + (size_t)(key0 + 32) * 64, VW + (size_t)(key0 + 32) * 64, lo16); \
            if (key0 + 31 > t0 || key0 <= t0 + 7 - 512) attn_compute<2, FX>(fa, qf, negm, true, [&](int r) { const int kp = key0 + crow(r, hi); return kp <= t && kp > t - 512; }, st); \
            else attn_compute<0, FX>(fa, qf, negm, true, [&](int) { return true; }, st); \
            if (key0 + 32 <= khi) fa = fb; } } while (0)
        if (fixed_ok) WIN_LOOP(true); else WIN_LOOP(false);
#undef WIN_LOOP
        const float l = addswap32_f(st.l); const float sc = gate_w / l;
#pragma unroll
        for (int dt = 0; dt < 2; ++dt)
#pragma unroll
            for (int r = 0; r < 16; ++r) outv[dt][r] = oacc[(dt * 16 + r) * 64] + sc * st.o[dt][r];
    }
    float ss = 0.f;
#pragma unroll
    for (int dt = 0; dt < 2; ++dt)
#pragma unroll
        for (int r = 0; r < 16; ++r) ss += outv[dt][r] * outv[dt][r];
    ss += __shfl_xor(ss, 32); ss += __shfl_xor(ss, 8); ss += __shfl_xor(ss, 16);
    if (lane < 8) ((float*)(ws + WS_SSQN))[(rowb + t0 + lane) * 2 + kvh] = ss;
    bf16* Yp = (bf16*)(ws + WS_Y) + (rowb + t) * DM + (kvh * 4 + g) * 64 + 4 * hi;
#pragma unroll
    for (int dt = 0; dt < 2; ++dt)
#pragma unroll
        for (int q = 0; q < 4; ++q) { v2u o; o.x = pk2(outv[dt][4 * q], outv[dt][4 * q + 1]); o.y = pk2(outv[dt][4 * q + 2], outv[dt][4 * q + 3]); *(v2u*)(Yp + 32 * dt + 8 * q) = o; }
}
__device__ __forceinline__ void memattn_block(const Frame& F, const Args& A, LAS unsigned char* lds, int item) {
    unsigned char* ws = A.ws;
    const int lane = F.lane, r32 = lane & 31, hi = lane >> 5, w = F.wave;
    const int h = item & 3, tg = item >> 2, b = tg >> 5, tile = tg * 8 + w; const size_t row0 = (size_t)tile * 32;
    const bf16* Q = (const bf16*)(ws + WS_QM) + (size_t)tile * 32 * DM + (size_t)(h * 16) * 512 + 8 * lane;
    { const char* Kg = (const char*)((const bf16*)(ws + WS_MEMK) + (size_t)(b * 8 + w) * 32 * DM + (size_t)(h * 16) * 512) + 16 * lane;
#pragma unroll
      for (int j = 0; j < 16; ++j) __builtin_amdgcn_global_load_lds((const unsigned*)(Kg + j * 1024), (LAS unsigned*)(lds + (w * 16 + j) * 1024), 16, 0, 0); }
    f32x16 s[8];
#pragma unroll
    for (int kt = 0; kt < 8; ++kt) s[kt] = f32x16{};
    const LAS unsigned char* lf = lds + 16 * lane;
    asm volatile("s_waitcnt vmcnt(0)" ::: "memory");
    __syncthreads();
#define QK_LOAD(qv, kv, ks_) do { const int kk_ = (ks_) < 16 ? (ks_) : 15; qv = __builtin_nontemporal_load((const bf16x8*)(Q + 512 * kk_)); _Pragma("unroll") for (int kt = 0; kt < 8; ++kt) kv[kt] = *(const LAS bf16x8*)(lf + (kt * 16 + kk_) * 1024); } while (0)
#define QK_MMA(qv, kv) do { _Pragma("unroll") for (int kt = 0; kt < 8; ++kt) s[kt] = __builtin_amdgcn_mfma_f32_32x32x16_bf16(kv[kt], qv, s[kt], 0, 0, 0); } while (0)
    { bf16x8 qa, qb, ka[8], kb[8];
      QK_LOAD(qa, ka, 0);
#pragma unroll 1
      for (int ks = 0; ks < 16; ks += 2) {
          QK_LOAD(qb, kb, ks + 1); asm volatile("" ::: "memory");
          QK_MMA(qa, ka);
          QK_LOAD(qa, ka, ks + 2); asm volatile("" ::: "memory");
          QK_MMA(qb, kb); } }
#undef QK_LOAD
#undef QK_MMA
    asm volatile("s_waitcnt vmcnt(0) lgkmcnt(0)" ::: "memory");
    __syncthreads();
    { const char* Vg = (const char*)((const bf16*)(ws + WS_MEMVT) + (size_t)((b * 4 + h) * 8 + w) * 8192) + 16 * lane;
#pragma unroll
      for (int j = 0; j < 16; ++j) __builtin_amdgcn_global_load_lds((const unsigned*)(Vg + j * 1024), (LAS unsigned*)(lds + (w * 16 + j) * 1024), 16, 0, 0); }
    float m = -1e30f;
#pragma unroll
    for (int kt = 0; kt < 8; ++kt) m = fmaxf(m, max16(s[kt]));
    m = maxswap32_f(m);
    float l = 0.f; v4u pw[8][2];
#pragma unroll
    for (int kt = 0; kt < 8; ++kt) {
#pragma unroll
        for (int r = 0; r < 16; ++r) s[kt][r] = EX2(s[kt][r] - m);
        l += sum16(s[kt]);
#pragma unroll
        for (int s2 = 0; s2 < 2; ++s2) { pw[kt][s2].x = pk2(s[kt][8 * s2], s[kt][8 * s2 + 1]); pw[kt][s2].y = pk2(s[kt][8 * s2 + 2], s[kt][8 * s2 + 3]); pw[kt][s2].z = pk2(s[kt][8 * s2 + 4], s[kt][8 * s2 + 5]); pw[kt][s2].w = pk2(s[kt][8 * s2 + 6], s[kt][8 * s2 + 7]); } }
    l = addswap32_f(l);
    const float invl = 1.0f / l;
    bf16* O = (bf16*)(ws + WS_OM) + (row0 + r32) * DM + h * 256 + 4 * hi;
    asm volatile("s_waitcnt vmcnt(0)" ::: "memory");
    __syncthreads();
#define PV_LOAD(vv, dt_) do { const int dd_ = (dt_) < 8 ? (dt_) : 7; _Pragma("unroll") for (int kt = 0; kt < 8; ++kt) _Pragma("unroll") for (int s2 = 0; s2 < 2; ++s2) vv[2 * kt + s2] = *(const LAS bf16x8*)(lf + (kt * 16 + dd_ * 2 + s2) * 1024); } while (0)
#define PV_MMA(vv, dt_) do { f32x16 o = f32x16{}; _Pragma("unroll") for (int kt = 0; kt < 8; ++kt) _Pragma("unroll") for (int s2 = 0; s2 < 2; ++s2) o = __builtin_amdgcn_mfma_f32_32x32x16_bf16(vv[2 * kt + s2], __builtin_bit_cast(bf16x8, pw[kt][s2]), o, 0, 0, 0); \
        _Pragma("unroll") for (int q = 0; q < 4; ++q) { v2u ov; ov.x = pk2(o[4 * q] * invl, o[4 * q + 1] * invl); ov.y = pk2(o[4 * q + 2] * invl, o[4 * q + 3] * invl); *(v2u*)(O + 32 * (dt_) + 8 * q) = ov; } } while (0)
    { bf16x8 va[16], vb[16];
      PV_LOAD(va, 0);
#pragma unroll 1
      for (int dt = 0; dt < 8; dt += 2) {
          PV_LOAD(vb, dt + 1); asm volatile("" ::: "memory");
          PV_MMA(va, dt);
          PV_LOAD(va, dt + 2); asm volatile("" ::: "memory");
          PV_MMA(vb, dt + 1); } }
#undef PV_LOAD
#undef PV_MMA
    asm volatile("s_waitcnt lgkmcnt(0)" ::: "memory");
    __syncthreads();
}

__device__ __forceinline__ int f2key(float f) { const int u = __builtin_bit_cast(int, f); return u ^ ((u >> 31) & 0x7fffffff); }
__device__ __forceinline__ float key2f(int k) { const int u = k ^ ((k >> 31) & 0x7fffffff); return __builtin_bit_cast(float, u); }
__device__ __forceinline__ void top16_of_128(f32x16 (&s)[4], int hi, int (&kv)[16]) {
    int key[4][16];
#pragma unroll
    for (int nt = 0; nt < 4; ++nt)
#pragma unroll
        for (int r = 0; r < 16; ++r) key[nt][r] = (f2key(s[nt][r]) & ~0x7f) | (127 - (32 * nt + crow(r, hi)));
#pragma unroll
    for (int nt = 0; nt < 4; ++nt) sort16_desc(key[nt]);
    merge16_desc(key[0], key[1]); merge16_desc(key[2], key[3]); merge16_desc(key[0], key[2]);
    unsigned a[16], b[16];
#pragma unroll
    for (int i = 0; i < 16; ++i) { a[i] = (unsigned)key[0][i]; b[i] = a[i]; swap32(a[i], b[i]); }
#pragma unroll
    for (int i = 0; i < 16; ++i) kv[i] = max((int)a[i], (int)b[15 - i]);
    bitonic16_desc(kv);
}
template <bool LDSK>
__device__ __forceinline__ void peer_topk_item(const Frame& F, const Args& A, int item, const LAS unsigned char* lds) {
    unsigned char* ws = A.ws;
    int lane = lane_id(); asm volatile("" : "+v"(lane));
    const int r32 = lane & 31, hi = lane >> 5;
    const int h = item & 7, tile = item >> 3; const size_t row = (size_t)tile * 32 + r32;
    const bf16* QP = (const bf16*)(ws + WS_QP) + (size_t)tile * 32 * 2048 + (size_t)(h * 16) * 512 + 8 * lane;
    int k1[16], k2[16];
#pragma unroll
    for (int i = 0; i < 16; ++i) { k1[i] = 0; k2[i] = 0; }
#pragma unroll 1
    for (int c = 0; c < 2; ++c) {
        const bf16* SK = (const bf16*)(ws + WS_SKEY) + (size_t)((h * 2 + c) * 4) * 4096 + 8 * lane;
        f32x16 s[4];
#pragma unroll
        for (int nt = 0; nt < 4; ++nt) s[nt] = f32x16{};
        bf16x8 qf[8];
#pragma unroll
        for (int ks = 0; ks < 8; ++ks) qf[ks] = __builtin_nontemporal_load((const bf16x8*)(QP + (size_t)(c * 8 + ks) * 512));
#pragma unroll
        for (int ks = 0; ks < 8; ++ks) {
#pragma unroll
            for (int nt = 0; nt < 4; ++nt) { const bf16x8 kf = LDSK ? *(const LAS bf16x8*)(lds + ((c * 4 + nt) * 4096 + ks * 512) * 2 + lane * 16) : *(const bf16x8*)(SK + (size_t)nt * 4096 + ks * 512);
                s[nt] = __builtin_amdgcn_mfma_f32_32x32x16_bf16(kf, qf[ks], s[nt], 0, 0, 0); } }
        if (c == 0) top16_of_128(s, hi, k1); else top16_of_128(s, hi, k2);
    }
    float v1[16], v2[16];
#pragma unroll
    for (int i = 0; i < 16; ++i) { v1[i] = key2f(k1[i] & ~0x7f); v2[i] = key2f(k2[i] & ~0x7f); }
    int ck[32];
    {
        int idx = 0;
#pragma unroll
        for (int i = 0; i < 32; ++i) ck[i] = (int)0x80000000;
#pragma unroll
        for (int a = 0; a < 16; ++a)
#pragma unroll
            for (int bq = 0; bq < 16; ++bq) if ((a + 1) * (bq + 1) <= 16) {
                const int flat = a * 16 + bq; const int kk = (f2key(v1[a] + v2[bq]) & ~0xff) | (255 - flat);
                if ((idx & 1) == hi) ck[idx >> 1] = kk;
                ++idx; }
    }
    sort32_desc(ck);
    int tk[16];
    { unsigned a[16], b[16];
#pragma unroll
      for (int i = 0; i < 16; ++i) { a[i] = (unsigned)ck[i]; b[i] = a[i]; swap32(a[i], b[i]); }
#pragma unroll
      for (int i = 0; i < 16; ++i) tk[i] = max((int)a[i], (int)b[15 - i]);
      bitonic16_desc(tk); }
    int te[16];
    { LAS int* tab = (LAS int*)(lds + 65536 + F.wave * 8448) + lane * 33;
#pragma unroll
      for (int i = 0; i < 16; ++i) { tab[i] = 127 - (k1[i] & 0x7f); tab[16 + i] = 127 - (k2[i] & 0x7f); }
      asm volatile("s_waitcnt lgkmcnt(0)" ::: "memory");
#pragma unroll
      for (int i = 0; i < 16; ++i) { const int flat = 255 - (tk[i] & 0xff); te[i] = tab[flat >> 4] * 128 + tab[16 + (flat & 15)]; }
      asm volatile("s_waitcnt lgkmcnt(0)" ::: "memory"); }
    float gsm[16]; const float mx = key2f(tk[0] & ~0xff); float den = 0.f;
#pragma unroll
    for (int i = 0; i < 16; ++i) { gsm[i] = __expf(key2f(tk[i] & ~0xff) - mx); den += gsm[i]; }
    const float inv = 1.0f / den;
    if (hi == 0) {
        int* EID = (int*)(ws + WS_EID) + row * 128 + h * 16; float* GW = (float*)(ws + WS_GW) + row * 128 + h * 16;
#pragma unroll
        for (int q = 0; q < 4; ++q) { *(v4u*)(EID + 4 * q) = (v4u){(unsigned)te[4 * q], (unsigned)te[4 * q + 1], (unsigned)te[4 * q + 2], (unsigned)te[4 * q + 3]};
            *(f32x4*)(GW + 4 * q) = (f32x4){gsm[4 * q] * inv, gsm[4 * q + 1] * inv, gsm[4 * q + 2] * inv, gsm[4 * q + 3] * inv}; }
    }
}

typedef float f32x2 __attribute__((ext_vector_type(2)));
__device__ __forceinline__ float dot16_fp8(const v4u u, const f32x2 (&xn)[8]) {
    f32x2 a0, a1;
    { const f32x2 lo = __builtin_amdgcn_cvt_pk_f32_fp8((int)u[0], false), hi = __builtin_amdgcn_cvt_pk_f32_fp8((int)u[0], true); a0 = lo * xn[0]; a1 = hi * xn[1]; }
#pragma unroll
    for (int j = 1; j < 4; ++j) { const f32x2 lo = __builtin_amdgcn_cvt_pk_f32_fp8((int)u[j], false), hi = __builtin_amdgcn_cvt_pk_f32_fp8((int)u[j], true);
        a0 = __builtin_elementwise_fma(lo, xn[2 * j], a0); a1 = __builtin_elementwise_fma(hi, xn[2 * j + 1], a1); }
    const f32x2 s = a0 + a1;
    return s.x + s.y;
}
__device__ __forceinline__ void axpy16_fp8(f32x2 (&acc)[8], const float w, const v4u u) {
    const f32x2 w2 = {w, w};
#pragma unroll
    for (int j = 0; j < 4; ++j) { const f32x2 lo = __builtin_amdgcn_cvt_pk_f32_fp8((int)u[j], false), hi = __builtin_amdgcn_cvt_pk_f32_fp8((int)u[j], true);
        acc[2 * j] = __builtin_elementwise_fma(lo, w2, acc[2 * j]); acc[2 * j + 1] = __builtin_elementwise_fma(hi, w2, acc[2 * j + 1]); }
}
#define TIE_ROW(val, nxt) asm volatile("" : "+v"(val), "+v"((nxt).x), "+v"((nxt).y), "+v"((nxt).z), "+v"((nxt).w))
constexpr int PQ_CHUNK = 128, PQ_NCHUNK = MTOK / PQ_CHUNK;
constexpr int CW_NQ = 10240;
constexpr int CW_PQ = 8192;
__device__ __forceinline__ int pq_pop(unsigned* ctl, int pass, int own, int& q_s, LAS int* bc, int wave) {
    __syncthreads();
    if (wave == 0 && lane_id() == 0) { int res = -1; int s = q_s;
        while (s < 8) { const int x = (own + s) & 7; const unsigned c = __hip_atomic_fetch_add(ctl + CW_PQ + 64 * (8 * pass + x), 1u, __ATOMIC_RELAXED, __HIP_MEMORY_SCOPE_AGENT);
            if (c < (unsigned)PQ_NCHUNK) { res = x * PQ_NCHUNK + (int)c; break; } ++s; }
        bc[0] = res; bc[1] = s; }
    __syncthreads();
    q_s = bc[1]; return bc[0];
}
#define PQ_TICKET(pass_, own_, qs_) (((qs_) < 8 && F.wave == 0 && lane_id() == 0) ? __hip_atomic_fetch_add(ctl + CW_PQ + 64 * (8 * (pass_) + (((own_) + (qs_)) & 7)), 1u, __ATOMIC_RELAXED, __HIP_MEMORY_SCOPE_AGENT) : 0u)
__device__ __forceinline__ int pq_resolve(unsigned* ctl, int pass, int own, int& q_s, unsigned ticket, LAS int* bc, int wave) {
    if (wave == 0 && lane_id() == 0) { int res = -1; int s = q_s;
        if (s < 8) { if (ticket < (unsigned)PQ_NCHUNK) res = ((own + s) & 7) * PQ_NCHUNK + (int)ticket;
                     else { ++s; while (s < 8) { const int x = (own + s) & 7; const unsigned c = __hip_atomic_fetch_add(ctl + CW_PQ + 64 * (8 * pass + x), 1u, __ATOMIC_RELAXED, __HIP_MEMORY_SCOPE_AGENT);
                                if (c < (unsigned)PQ_NCHUNK) { res = x * PQ_NCHUNK + (int)c; break; } ++s; } } }
        bc[0] = res; bc[1] = s; }
    __syncthreads();
    q_s = bc[1]; return bc[0];
}
template <int CTRL> __device__ __forceinline__ float dppf(float v) { return __builtin_bit_cast(float, __builtin_amdgcn_mov_dpp(__builtin_bit_cast(int, v), CTRL, 0xf, 0xf, true)); }
__device__ __forceinline__ float red8(float d) { d += dppf<0xB1>(d); d += dppf<0x4E>(d); d += dppf<0x141>(d); return d; }
__device__ __forceinline__ float rs8(const float (&d)[8], int c8) {
    const bool h4 = (c8 & 4) != 0, h2 = (c8 & 2) != 0, h1 = (c8 & 1) != 0;
    float v[4], w[2];
#pragma unroll
    for (int i = 0; i < 4; ++i) { const float s = h4 ? d[4 + i] : d[i], o = h4 ? d[i] : d[4 + i]; v[i] = s + dppf<0x141>(o); }
#pragma unroll
    for (int k = 0; k < 2; ++k) { const float s = h2 ? v[2 + k] : v[k], o = h2 ? v[k] : v[2 + k]; w[k] = s + dppf<0x4E>(o); }
    return (h1 ? w[1] : w[0]) + dppf<0xB1>(h1 ? w[0] : w[1]);
}
__device__ __forceinline__ void peer_issue8(v4u (&rb)[8], const v4u ia, const v4u ib, const unsigned char* T  , unsigned c16) {
    const unsigned e[8] = {ia.x, ia.y, ia.z, ia.w, ib.x, ib.y, ib.z, ib.w};
#pragma unroll
    for (int i = 0; i < 8; ++i) rb[i] = *(const v4u*)(T + (e[i] * 128u + c16));
}
constexpr int PS_ROW = 528, PS_WAVE = 2 * 16 * PS_ROW;
__device__ __forceinline__ void peer_stage16(LAS unsigned char* st, const unsigned char* src  , int lane) {
    v4u e[8];
#pragma unroll
    for (int j = 0; j < 8; ++j) e[j] = __builtin_nontemporal_load((const v4u*)(src + (unsigned)(j * 1024 + lane * 16)));
#pragma unroll
    for (int j = 0; j < 8; ++j) *(LAS v4u*)(st + (2 * j + (lane >> 5)) * PS_ROW + (lane & 31) * 16) = e[j];
}
__device__ __forceinline__ void peer_u_chunk(const Frame& F, const Args& A, LAS unsigned char* lds, int x, int chunk) {
    unsigned char* ws = A.ws; int lane = lane_id(); asm volatile("" : "+v"(lane));
    const int tk = lane >> 3, c8 = lane & 7;
    const unsigned char* U = ws + WS_U8 + (size_t)x * 16384 * 128; const unsigned c16 = 16u * (unsigned)c8;
    LAS unsigned char* st = lds + F.wave * PS_WAVE;
    peer_stage16(st, ws + WS_EID + (size_t)(chunk * PQ_CHUNK + F.wave * 16) * 512, lane);
#pragma unroll 1
    for (int oc = 0; oc < 2; ++oc) {
        const unsigned row = (unsigned)(chunk * PQ_CHUNK + F.wave * 16 + oc * 8 + tk);
        const LAS unsigned char* est = st + (oc * 8 + tk) * PS_ROW;
#define EID_LD(i_) (*(const LAS v4u*)(est + 16 * (i_)))
        f32x2 xn[8];
        { const unsigned char* xb_ = ws + WS_XN; const unsigned xo = row * 2048u + 256u * (unsigned)x + 32u * (unsigned)c8; const v4u xa = *(const v4u*)(xb_ + xo), xb = *(const v4u*)(xb_ + (xo + 16u));
          const unsigned xw[8] = {xa.x, xa.y, xa.z, xa.w, xb.x, xb.y, xb.z, xb.w};
#pragma unroll
          for (int j = 0; j < 8; ++j) { xn[j].x = bflo(xw[j]); xn[j].y = bfhi(xw[j]); } }
        float rstd; { const f32x4* sp = (const f32x4*)(ws + WS_SSQ2 + (size_t)row * 64); const f32x4 a = sp[0], b = sp[1], c = sp[2], d = sp[3];
            rstd = rsqrtf((((a.x + a.y) + (a.z + a.w)) + ((b.x + b.y) + (b.z + b.w)) + ((c.x + c.y) + (c.z + c.w)) + ((d.x + d.y) + (d.z + d.w))) * (1.f / DM) + EPS); }
        unsigned char* ppb = ws + WS_PART; const unsigned po = ((unsigned)x * MTOK + row) * 256u + 32u * (unsigned)c8;
        v4u ra[8], rb[8]; v4u ia0 = EID_LD(0), ia1 = EID_LD(1), ib0 = EID_LD(2), ib1 = EID_LD(3);
        peer_issue8(ra, ia0, ia1, U, c16); ia0 = EID_LD(4); ia1 = EID_LD(5);
#pragma unroll 1
        for (int q = 0; q < 16; q += 2) {
            peer_issue8(rb, ib0, ib1, U, c16); { const int qn = (q + 3 < 16) ? q + 3 : 15; ib0 = EID_LD(2 * qn); ib1 = EID_LD(2 * qn + 1); }
            float k0 = 0.f, k1 = 0.f;
            { float d[8];
#pragma unroll
              for (int i = 0; i < 8; ++i) { d[i] = dot16_fp8(ra[i], xn); if (i < 7) TIE_ROW(d[i], ra[i + 1]); }
              k0 = rs8(d, c8); }
            peer_issue8(ra, ia0, ia1, U, c16); { const int qn = (q + 4 < 16) ? q + 4 : 15; ia0 = EID_LD(2 * qn); ia1 = EID_LD(2 * qn + 1); }
            { float d[8];
#pragma unroll
              for (int i = 0; i < 8; ++i) { d[i] = dot16_fp8(rb[i], xn); if (i < 7) TIE_ROW(d[i], rb[i + 1]); }
              k1 = rs8(d, c8); }
            *(unsigned*)(ppb + (po + 2u * (unsigned)q)) = pk2(k0 * rstd, k1 * rstd);
        }
    }
}
__device__ __forceinline__ void peer_w_rows(const Frame& F, const Args& A) {
    unsigned char* ws = A.ws; const int lane = lane_id();
    const float* SU = (const float*)(ws + WS_SU); const float* SV = (const float*)(ws + WS_SV);
    const int p0 = 2 * lane, k0 = 8 * (p0 & 15) + (p0 >> 4), k1 = k0 + 8;
    for (int m0 = F.gw; m0 < MTOK; m0 += 4 * F.NGW) {
        int e0[4], e1[4]; float g0[4], g1[4]; unsigned pw[4][8];
#pragma unroll
        for (int r = 0; r < 4; ++r) { const size_t row = (size_t)(m0 + r * F.NGW < MTOK ? m0 + r * F.NGW : m0);
            const int* EID = (const int*)(ws + WS_EID) + row * 128; const float* GW = (const float*)(ws + WS_GW) + row * 128;
            e0[r] = EID[k0]; e1[r] = EID[k1]; g0[r] = GW[k0]; g1[r] = GW[k1];
#pragma unroll
            for (int x = 0; x < 8; ++x) pw[r][x] = *(const unsigned*)((const bf16*)(ws + WS_PART) + ((size_t)x * MTOK + row) * 128 + p0); }
        float su0[4], su1[4], sv0[4], sv1[4];
#pragma unroll
        for (int r = 0; r < 4; ++r) { su0[r] = SU[e0[r]]; su1[r] = SU[e1[r]]; sv0[r] = SV[e0[r]]; sv1[r] = SV[e1[r]]; }
#pragma unroll
        for (int r = 0; r < 4; ++r) { if (m0 + r * F.NGW < MTOK) { const size_t row = (size_t)(m0 + r * F.NGW); float s0 = 0.f, s1 = 0.f;
#pragma unroll
            for (int x = 0; x < 8; ++x) { s0 += bflo(pw[r][x]); s1 += bfhi(pw[r][x]); }
            float* W = (float*)(ws + WS_W) + row * 128;
            W[k0] = gelu_tanh(s0 * su0[r]) * g0[r] * sv0[r]; W[k1] = gelu_tanh(s1 * su1[r]) * g1[r] * sv1[r]; } }
    }
}
__device__ __forceinline__ void peer_v_chunk(const Frame& F, const Args& A, LAS unsigned char* lds, int x, int chunk) {
    unsigned char* ws = A.ws; int lane = lane_id(); asm volatile("" : "+v"(lane));
    const int tk = lane >> 3, c8 = lane & 7;
    const unsigned char* V = ws + WS_V8 + (size_t)x * 16384 * 128; const unsigned c16 = 16u * (unsigned)c8;
    LAS unsigned char* st = lds + F.wave * PS_WAVE;
    peer_stage16(st, ws + WS_EID + (size_t)(chunk * PQ_CHUNK + F.wave * 16) * 512, lane);
    peer_stage16(st + 16 * PS_ROW, ws + WS_W + (size_t)(chunk * PQ_CHUNK + F.wave * 16) * 512, lane);
#pragma unroll 1
    for (int oc = 0; oc < 2; ++oc) {
        const unsigned row = (unsigned)(chunk * PQ_CHUNK + F.wave * 16 + oc * 8 + tk);
        const LAS unsigned char* est = st + (oc * 8 + tk) * PS_ROW;
#define W_LD(i_) (*(const LAS f32x4*)(est + 16 * PS_ROW + 16 * (i_)))
        f32x2 acc[8];
#pragma unroll
        for (int j = 0; j < 8; ++j) acc[j] = (f32x2){0.f, 0.f};
        v4u ra[8], rb[8]; v4u ia0 = EID_LD(0), ia1 = EID_LD(1), ib0 = EID_LD(2), ib1 = EID_LD(3); f32x4 wa0 = W_LD(0), wa1 = W_LD(1), wb0 = W_LD(2), wb1 = W_LD(3);
        peer_issue8(ra, ia0, ia1, V, c16); ia0 = EID_LD(4); ia1 = EID_LD(5);
#pragma unroll 1
        for (int q = 0; q < 16; q += 2) {
            peer_issue8(rb, ib0, ib1, V, c16); { const int qn = (q + 3 < 16) ? q + 3 : 15; ib0 = EID_LD(2 * qn); ib1 = EID_LD(2 * qn + 1); }
            { const float wv[8] = {wa0.x, wa0.y, wa0.z, wa0.w, wa1.x, wa1.y, wa1.z, wa1.w};
#pragma unroll
              for (int i = 0; i < 8; ++i) { axpy16_fp8(acc, wv[i], ra[i]); if (i < 7) TIE_ROW(acc[7].y, ra[i + 1]); } }
            { const int qn = (q + 2 < 16) ? q + 2 : 15; wa0 = W_LD(2 * qn); wa1 = W_LD(2 * qn + 1); }
            peer_issue8(ra, ia0, ia1, V, c16); { const int qn = (q + 4 < 16) ? q + 4 : 15; ia0 = EID_LD(2 * qn); ia1 = EID_LD(2 * qn + 1); }
            { const float wv[8] = {wb0.x, wb0.y, wb0.z, wb0.w, wb1.x, wb1.y, wb1.z, wb1.w};
#pragma unroll
              for (int i = 0; i < 8; ++i) { axpy16_fp8(acc, wv[i], rb[i]); if (i < 7) TIE_ROW(acc[7].y, rb[i + 1]); } }
            { const int qn = (q + 3 < 16) ? q + 3 : 15; wb0 = W_LD(2 * qn); wb1 = W_LD(2 * qn + 1); }
        }
        unsigned char* xr = ws + WS_XN + (row * 2048u + 256u * (unsigned)x + 32u * (unsigned)c8); float ss = 0.f;
        const v4u x2a = *(const v4u*)xr, x2b = *(const v4u*)(xr + 16);
        const unsigned xw[8] = {x2a.x, x2a.y, x2a.z, x2a.w, x2b.x, x2b.y, x2b.z, x2b.w};
        unsigned ow[8];
#pragma unroll
        for (int j = 0; j < 4; ++j) { f32x4 v; v.x = bflo(xw[2 * j]) + acc[2 * j].x; v.y = bfhi(xw[2 * j]) + acc[2 * j].y; v.z = bflo(xw[2 * j + 1]) + acc[2 * j + 1].x; v.w = bfhi(xw[2 * j + 1]) + acc[2 * j + 1].y;
            ss += (v.x * v.x + v.y * v.y) + (v.z * v.z + v.w * v.w); ow[2 * j] = pk2(v.x, v.y); ow[2 * j + 1] = pk2(v.z, v.w); }
        *(v4u*)xr = (v4u){ow[0], ow[1], ow[2], ow[3]}; *(v4u*)(xr + 16) = (v4u){ow[4], ow[5], ow[6], ow[7]};
        ss = red8(ss);
        if (c8 == 0) ((float*)(ws + WS_SSQ3))[row * 8 + x] = ss;
    }
#undef W_LD
#undef EID_LD
}
__device__ __forceinline__ void peer_final_rows(const Frame& F, const Args& A) {
    unsigned char* ws = A.ws; const int lane = lane_id(); const float* g = A.in[32];
    for (int m = F.gw; m < MTOK; m += F.NGW) {
        const f32x4 sa = *(const f32x4*)((const float*)(ws + WS_SSQ3) + (size_t)m * 8), sb = *(const f32x4*)((const float*)(ws + WS_SSQ3) + (size_t)m * 8 + 4);
        const float rstd = rsqrtf((((sa.x + sa.y) + (sa.z + sa.w)) + ((sb.x + sb.y) + (sb.z + sb.w))) * (1.f / DM) + EPS);
        f32x4* xr = (f32x4*)(A.out + (size_t)m * DM) + lane; const v2u* xb = (const v2u*)((const bf16*)(ws + WS_XN) + (size_t)m * DM) + lane;
#pragma unroll
        for (int j = 0; j < 4; ++j) { const v2u w = xb[64 * j]; const f32x4 gg = ((const f32x4*)g)[lane + 64 * j]; const f32x4 v = {bflo(w.x), bfhi(w.x), bflo(w.y), bfhi(w.y)}; __builtin_nontemporal_store(v * rstd * gg, xr + 64 * j); }
    }
}

typedef GAS unsigned gu32;
#define RLX_AGENT __ATOMIC_RELAXED, __HIP_MEMORY_SCOPE_AGENT
#define XB_TMO      128
#define XB_XCNT(j)  (256  + 64 * (j))
#define XB_XSUB(j)  (1280 + 64 * (j))
#define XB_XGEN(j)  (2304 + 64 * (j))
#define XB_TOP      3328
#define XB_TOPGEN   3392
#define XCD_BAR_WORDS 3456
#define XB_SPIN_CAP (1u << 18)

__device__ __forceinline__ unsigned xb_ld(unsigned* p)              { return __hip_atomic_load(p, __ATOMIC_RELAXED, __HIP_MEMORY_SCOPE_AGENT); }
__device__ __forceinline__ unsigned xb_add(unsigned* p, unsigned v) { return __hip_atomic_fetch_add(p, v, __ATOMIC_RELAXED, __HIP_MEMORY_SCOPE_AGENT); }
__device__ __forceinline__ unsigned xb_xcc_id() { return (unsigned)__builtin_amdgcn_s_getreg((3 << 11) | 20) & 0xFu; }
#define XB_SPIN(cond, bar) do { unsigned _sp = 0; while (cond) { __builtin_amdgcn_s_sleep(1); \
    if ((++_sp & 255u) == 0u) { if (xb_ld(&(bar)[XB_TMO])) break; if (_sp > XB_SPIN_CAP) { atomicAdd(&(bar)[XB_TMO], 1u); break; } } } } while (0)

struct XcdBarrier {
    unsigned* bar; unsigned x;
    volatile LAS unsigned* st;
};

__device__ __forceinline__ XcdBarrier xcd_barrier_post(unsigned* bar, volatile LAS unsigned* st) {
    XcdBarrier b; b.bar = bar; b.x = xb_xcc_id(); b.st = st;
    if (threadIdx.x == 0) (void)xb_add(&bar[XB_XCNT(b.x)], 1u);
    return b;
}
__device__ __forceinline__ void xcd_barrier_complete(unsigned* bar, unsigned x, unsigned& nloc, unsigned& nx) {
    const unsigned G = gridDim.x * gridDim.y * gridDim.z;
    unsigned sum, cnt, mine, sp = 0u;
    for (;;) {
        sum = 0u; cnt = 0u; mine = 0u;
#pragma unroll
        for (unsigned j = 0; j < 16; ++j) { const unsigned c = xb_ld(&bar[XB_XCNT(j)]); sum += c; cnt += (c > 0u) ? 1u : 0u; mine = (j == x) ? c : mine; }
        if (sum == G) break;
        __builtin_amdgcn_s_sleep(1);
        if ((++sp & 255u) == 0u) { if (xb_ld(&bar[XB_TMO])) break; if (sp > XB_SPIN_CAP) { atomicAdd(&bar[XB_TMO], 1u); break; } }
    }
    nloc = mine > 0u ? mine : 1u; nx = cnt > 0u ? cnt : 1u;
}

__device__ __forceinline__ void xcd_barrier(const XcdBarrier& b) {
    asm volatile("s_waitcnt vmcnt(0)" ::: "memory");
    __syncthreads();
    if (threadIdx.x == 0) {
        unsigned* bar = b.bar;
        __builtin_amdgcn_s_waitcnt(0);
        unsigned nloc = b.st[0], nx = b.st[1];
        if (nloc == 0u) { xcd_barrier_complete(bar, b.x, nloc, nx); b.st[0] = nloc; b.st[1] = nx; }
        const unsigned old = xb_add(&bar[XB_XSUB(b.x)], 1u);
        const unsigned gen = old / nloc;
        if (old + 1u == (gen + 1u) * nloc) {
            __builtin_amdgcn_fence(__ATOMIC_RELEASE, "agent");
            asm volatile("s_waitcnt vmcnt(0)" ::: "memory");
            const unsigned og = xb_add(&bar[XB_TOP], 1u);
            const unsigned tg = og / nx;
            if (og + 1u == (tg + 1u) * nx) xb_add(&bar[XB_TOPGEN], 1u);
            else XB_SPIN(xb_ld(&bar[XB_TOPGEN]) == tg, bar);
            __builtin_amdgcn_fence(__ATOMIC_ACQUIRE, "agent");
            xb_add(&bar[XB_XGEN(b.x)], 1u);
            asm volatile("s_waitcnt vmcnt(0)" ::: "memory");
        } else {
            XB_SPIN(xb_ld(&bar[XB_XGEN(b.x)]) == gen, bar);
            __builtin_amdgcn_fence(__ATOMIC_ACQUIRE, "agent");
            asm volatile("s_waitcnt vmcnt(0)" ::: "memory");
        }
    }
    __syncthreads();
}

#ifndef DBL_MASK
#define DBL_MASK 0
#endif
constexpr int NPHASE = 12;
__global__ void __launch_bounds__(512, 2) fwd_kernel(Args args) {
    extern __shared__ __attribute__((aligned(16))) unsigned char lds_raw[];
    LAS unsigned char* lds = (LAS unsigned char*)lds_raw;
    Frame F;
    F.tid = threadIdx.x; F.lane = F.tid & 63; F.wave = __builtin_amdgcn_readfirstlane(F.tid >> 6);
    F.G = gridDim.x; { const int bx = blockIdx.x; F.vcu = (F.G % 8 == 0) ? (bx % 8) * (F.G / 8) + bx / 8 : bx; }
    F.gw = F.vcu * 8 + F.wave; F.NGW = F.G * 8;
    unsigned char* ws = args.ws;
    const int lo = args.ph_lo, hi = args.ph_hi;
    volatile LAS unsigned* MISC = (volatile LAS unsigned*)(lds + LDS_BYTES - 64);
    if (F.tid < 16) MISC[F.tid] = 0u;
    __syncthreads();
    XcdBarrier bar = xcd_barrier_post((unsigned*)(ws + WS_CTL), MISC);
#define IN(k) (lo <= (k) && (k) < hi)
#define SEAM(k) do { if (IN(k) && IN((k) + 1)) xcd_barrier(bar); } while (0)

    if (IN(0)) for (int rep_ = 0; rep_ <= ((DBL_MASK >> 0) & 1); ++rep_) { if (rep_) xcd_barrier(bar); REFRESH_LANE(F); p0_prologue(F, args, lds); }
    SEAM(0);
    if (IN(1)) for (int rep_ = 0; rep_ <= ((DBL_MASK >> 1) & 1); ++rep_) { if (rep_) xcd_barrier(bar); REFRESH_LANE(F);
        { pg8::Gemm g{(const bf16*)(ws + WS_XN), (const bf16*)(ws + WS_WIN), MTOK, NZP, DM}; pg8::StaticOrder S; S.init(MTOK, NZP, F.G, (int)blockIdx.x);
          pg8::EpiZ E{(bf16*)(ws + WS_Z), (bf16*)(ws + WS_KSF), (bf16*)(ws + WS_VSF), (bf16*)(ws + WS_KWF), (bf16*)(ws + WS_VWF), (float*)(ws + WS_GATES), args.in[4]};
          pg8::gemm_phase<pg8::EpiZ, pg8::StaticOrder, true, true>(lds, g, S, E, F.wave); }
        { pg8::Gemm g{(const bf16*)(ws + WS_MEMN), (const bf16*)(ws + WS_WMK), NB * NMEM, DM, DM}; pg8::StaticOrder S; S.init(NB * NMEM, DM, F.G, ((int)blockIdx.x + 128) & 255);
          pg8::EpiStore E{(bf16*)(ws + WS_MEMK), DM, nullptr, 1};
          pg8::gemm_phase<pg8::EpiStore, pg8::StaticOrder, true, true>(lds, g, S, E, F.wave); }
        { pg8::Gemm g{(const bf16*)(ws + WS_WMV), (const bf16*)(ws + WS_MEMN), DM, NB * NMEM, DM}; pg8::StaticOrder S; S.init(DM, NB * NMEM, F.G, ((int)blockIdx.x + 120) & 255);
          pg8::EpiVFrag E{(bf16*)(ws + WS_MEMVT)};
          pg8::gemm_phase<pg8::EpiVFrag, pg8::StaticOrder, true, true>(lds, g, S, E, F.wave); }
    }
    SEAM(1);
    if (IN(2)) for (int rep_ = 0; rep_ <= ((DBL_MASK >> 2) & 1); ++rep_) { if (rep_) xcd_barrier(bar); REFRESH_LANE(F); for (int it = F.gw; it < 2048; it += F.NGW) kmax_item(F, args, it);
                 for (int it = F.vcu; it < 256; it += F.G) lru_local_item(F, args, lds, it);
                 for (int it = F.G - 1 - F.vcu; it < 128; it += F.G) compress_item(F, args, lds, it); }
    SEAM(2);
    if (IN(3)) for (int rep_ = 0; rep_ <= ((DBL_MASK >> 3) & 1); ++rep_) { if (rep_) xcd_barrier(bar); REFRESH_LANE(F);
                 { unsigned* ctl = (unsigned*)(ws + WS_CTL); const int own = (int)(((long)F.vcu * 8) / F.G) & 7; int qs = 0;
                   for (;;) { int id = -1;
                       if (lane_id() == 0) { while (qs < 8) { const int x = (own + qs) & 7; const unsigned c = __hip_atomic_fetch_add(ctl + CW_NQ + 64 * x, 1u, __ATOMIC_RELAXED, __HIP_MEMORY_SCOPE_AGENT);
                               if (c < 512u) { id = x * 512 + (int)c; break; } ++qs; } }
                       id = __builtin_amdgcn_readfirstlane(id); qs = __builtin_amdgcn_readfirstlane(qs);
                       if (id < 0) break;
                       if (F.G == 256 && (id & 511) < 256) { const int qi = (id >> 9) * 256 + (id & 255);
                           quant_rows4_fp8(args.in[31] + (size_t)qi * DM, (size_t)2048 * DM, nullptr, ws + WS_V8 + (size_t)qi * 128, (float*)(ws + WS_SV) + qi, 2048, lane_id());
                           quant_rows4_fp8(args.in[31] + (size_t)(qi + 8192) * DM, (size_t)2048 * DM, nullptr, ws + WS_V8 + (size_t)(qi + 8192) * 128, (float*)(ws + WS_SV) + qi + 8192, 2048, lane_id());
                           quant_rows4_fp8(args.in[30] + (size_t)qi * DM, (size_t)2048 * DM, args.in[27], ws + WS_U8 + (size_t)qi * 128, (float*)(ws + WS_SU) + qi, 2048, lane_id());
                           quant_rows4_fp8(args.in[30] + (size_t)(qi + 8192) * DM, (size_t)2048 * DM, args.in[27], ws + WS_U8 + (size_t)(qi + 8192) * 128, (float*)(ws + WS_SU) + qi + 8192, 2048, lane_id()); }
                       const int x = id >> 9, i = id & 511; nsa_item(F, args, lds, x >> 2, (x >> 1) & 1, 2 * (63 - (i >> 3)) + (x & 1), 7 - (i & 7)); } }
                 __syncthreads(); REFRESH_LANE(F);
                 for (int it = F.vcu; it < 256; it += F.G) lru_fix_item(F, args, lds, it, false); }
    SEAM(3);
    if (IN(4)) for (int rep_ = 0; rep_ <= ((DBL_MASK >> 4) & 1); ++rep_) { if (rep_) xcd_barrier(bar); REFRESH_LANE(F);
        pg8::Gemm g{(const bf16*)(ws + WS_Y), (const bf16*)(ws + WS_WOUT), MTOK, DM, DM}; pg8::StaticOrder S; S.init(MTOK, DM, F.G, (int)blockIdx.x);
        pg8::EpiRes<true> E{args.in[0], nullptr, nullptr, (bf16*)(ws + WS_XN), (float*)(ws + WS_SSQ1), (const float*)(ws + WS_SSQN)};
        pg8::gemm_phase<pg8::EpiRes<true>, pg8::StaticOrder, true, true>(lds, g, S, E, F.wave);
    }
    SEAM(4);
    if (IN(5)) for (int rep_ = 0; rep_ <= ((DBL_MASK >> 5) & 1); ++rep_) { if (rep_) xcd_barrier(bar); REFRESH_LANE(F);
        pg8::Gemm g{(const bf16*)(ws + WS_XN), (const bf16*)(ws + WS_WMQ), MTOK, DM, DM}; pg8::StaticOrder S; S.init(MTOK, DM, F.G, (int)blockIdx.x);
        pg8::EpiStore E{(bf16*)(ws + WS_QM), DM, (const float*)(ws + WS_SSQ1), 1};
        pg8::gemm_phase<pg8::EpiStore, pg8::StaticOrder, true, true>(lds, g, S, E, F.wave);
    }
    SEAM(5);
    if (IN(6)) for (int rep_ = 0; rep_ <= ((DBL_MASK >> 6) & 1); ++rep_) { if (rep_) xcd_barrier(bar); REFRESH_LANE(F); for (int it = F.vcu; it < 256; it += F.G) memattn_block(F, args, lds, it); }
    SEAM(6);
    if (IN(7)) for (int rep_ = 0; rep_ <= ((DBL_MASK >> 7) & 1); ++rep_) { if (rep_) xcd_barrier(bar); REFRESH_LANE(F);
        pg8::Gemm g{(const bf16*)(ws + WS_OM), (const bf16*)(ws + WS_WMO), MTOK, DM, DM}; pg8::StaticOrder S; S.init(MTOK, DM, F.G, (int)blockIdx.x);
        pg8::EpiRes<false> E{nullptr, (const bf16*)(ws + WS_XN), nullptr, (bf16*)(ws + WS_XN), (float*)(ws + WS_SSQ2), nullptr};
        pg8::gemm_phase<pg8::EpiRes<false>, pg8::StaticOrder, true, true>(lds, g, S, E, F.wave);
    }
    SEAM(7);
    if (IN(8)) for (int rep_ = 0; rep_ <= ((DBL_MASK >> 8) & 1); ++rep_) { if (rep_) xcd_barrier(bar); REFRESH_LANE(F);
        pg8::Gemm g{(const bf16*)(ws + WS_XN), (const bf16*)(ws + WS_WPQ), MTOK, 2048, DM}; pg8::StaticOrder S; S.init(MTOK, 2048, F.G, (int)blockIdx.x);
        pg8::EpiStore E{(bf16*)(ws + WS_QP), 2048, (const float*)(ws + WS_SSQ2), 1};
        pg8::gemm_phase<pg8::EpiStore, pg8::StaticOrder, true, true>(lds, g, S, E, F.wave);
    }
    SEAM(8);
    if (IN(9)) for (int rep_ = 0; rep_ <= ((DBL_MASK >> 9) & 1); ++rep_) { if (rep_) xcd_barrier(bar); REFRESH_LANE(F); for (int gi = F.vcu; gi < 256; gi += F.G) {
                     const int h = gi & 7, tgp = gi >> 3;
                     { const v4u* src = (const v4u*)((const bf16*)(ws + WS_SKEY) + (size_t)h * 8 * 4096); const int tid = F.wave * 64 + lane_id();
#pragma unroll
                       for (int i = 0; i < 8; ++i) ((LAS v4u*)lds)[tid + 512 * i] = src[tid + 512 * i]; }
                     __syncthreads();
                     peer_topk_item<true>(F, args, (tgp * 16 + F.wave) * 8 + h, lds); peer_topk_item<true>(F, args, (tgp * 16 + 8 + F.wave) * 8 + h, lds);
                     __syncthreads(); } }
    SEAM(9);
    if (IN(10)) {   REFRESH_LANE(F);
        LAS int* bc = (LAS int*)(lds + LDS_BYTES - 128); unsigned* ctl = (unsigned*)(ws + WS_CTL); const int own = (int)(bar.x & 7u);
        { int qs = 0; int id = __builtin_amdgcn_readfirstlane(pq_pop(ctl, 0, own, qs, bc, F.wave)); int par = 0;
          while (id >= 0) { const unsigned tk_ = PQ_TICKET(0, own, qs); peer_u_chunk(F, args, lds, id / PQ_NCHUNK, id % PQ_NCHUNK); par ^= 2; id = __builtin_amdgcn_readfirstlane(pq_resolve(ctl, 0, own, qs, tk_, bc + par, F.wave)); } }
        xcd_barrier(bar);
        peer_w_rows(F, args);
        xcd_barrier(bar);
        { int qs = 0; int id = __builtin_amdgcn_readfirstlane(pq_pop(ctl, 1, own, qs, bc, F.wave)); int par = 0;
          while (id >= 0) { const unsigned tk_ = PQ_TICKET(1, own, qs); peer_v_chunk(F, args, lds, id / PQ_NCHUNK, id % PQ_NCHUNK); par ^= 2; id = __builtin_amdgcn_readfirstlane(pq_resolve(ctl, 1, own, qs, tk_, bc + par, F.wave)); } }
        xcd_barrier(bar);
        peer_final_rows(F, args);
    }
#undef IN
#undef SEAM
}

extern "C" void kernel_launch(void* const* d_in, const int* in_sizes, int n_in, void* d_out, int out_size, void* d_ws, size_t ws_size, hipStream_t stream) {
    static int grid = 0;
    if (grid == 0) {
        if (n_in != 33 || out_size != MTOK * DM || ws_size < WS_END) { fprintf(stderr, "kernel_launch: unexpected problem (n_in %d, out %d, ws %zu)\n", n_in, out_size, ws_size); grid = -1; return; }
        int dev = 0, cus = 0, per_cu = 0;
        (void)hipGetDevice(&dev); (void)hipDeviceGetAttribute(&cus, hipDeviceAttributeMultiprocessorCount, dev);
        (void)hipFuncSetAttribute((const void*)fwd_kernel, hipFuncAttributeMaxDynamicSharedMemorySize, LDS_BYTES);
        (void)hipOccupancyMaxActiveBlocksPerMultiprocessor(&per_cu, (const void*)fwd_kernel, 512, LDS_BYTES);
        if (per_cu < 1) { fprintf(stderr, "kernel_launch: occupancy query says %d blocks per CU\n", per_cu); per_cu = 1; }
        grid = cus * 1;
        if (grid != 256) fprintf(stderr, "kernel_launch: %d CUs (built for 256)\n", cus);
    }
    if (grid < 0) return;
    (void)hipMemsetAsync((char*)d_ws + WS_CTL, 0, 65536, stream);
    Args a{};
    for (int i = 0; i < 33; ++i) a.in[i] = (const float*)d_in[i];
    a.out = (float*)d_out; a.ws = (unsigned char*)d_ws; a.ph_lo = 0; a.ph_hi = NPHASE;
    void* kargs[] = {&a};
    hipError_t e = hipLaunchCooperativeKernel((const void*)fwd_kernel, dim3(grid), dim3(512), kargs, LDS_BYTES, stream);
    if (e != hipSuccess) fprintf(stderr, "cooperative launch failed: %s (grid %d)\n", hipGetErrorString(e), grid);
}
```

```cpp
#include <hip/hip_runtime.h>
#include <cstdio>
#include <cstdint>

namespace pg8 {
#define PG8_LAS __attribute__((address_space(3)))
typedef unsigned short bf16_t;
typedef short bf16x8 __attribute__((ext_vector_type(8)));
typedef float f32x4 __attribute__((ext_vector_type(4)));
typedef unsigned u32x4 __attribute__((ext_vector_type(4)));
constexpr int BM = 256, BK = 64, HALF = 128, HTB = HALF * BK * 2  , STAGE_BYTES = 8 * HTB, NXCD = 8, WGM = 8;

__host__ __device__ __forceinline__ int lds_byte(int r, int c) { const int st = (r >> 4) * 2 + (c >> 5), rr = r & 15, cc = c & 31, ob = rr * 64 + cc * 2; return st * 1024 + (ob ^ (((ob >> 9) & 1) << 5)); }
__host__ __device__ __forceinline__ void stage_rc(int b, int& R, int& C) { const int st = b / 1024, sb = b % 1024, swz = sb ^ (((sb >> 9) & 1) << 5); R = (st >> 1) * 16 + swz / 64; C = (st & 1) * 32 + (swz % 64) / 2; }
__host__ __device__ __forceinline__ int perm32(int rho) { const int n = rho >> 4, i = rho & 15; return 8 * (i >> 2) + 4 * n + (i & 3); }

struct Unit { int pm, pn; };
struct Gemm { const bf16_t* A; const bf16_t* Bt; int M, N, K; };

struct StaticOrder {
    int nM, nN, nwg, G, c, lo, hi;
    __host__ __device__ void init(int M, int N, int G_, int c_) { nM = M / BM; nN = N / BM; nwg = nM * nN; G = G_; c = c_; lo = 0; hi = nwg; }
    __host__ __device__ void range(int lo_, int hi_) { lo = lo_; hi = hi_ < nwg ? hi_ : nwg; }
    __host__ __device__ bool next(int i, Unit& u) const {
        const long L = (long)lo + (long)i * G + c; if (L >= hi) return false;
        int wgid = (int)L; { const int q = nwg / NXCD, r = nwg % NXCD, xcd = wgid % NXCD, off = wgid / NXCD; wgid = (xcd < r ? xcd * (q + 1) : r * (q + 1) + (xcd - r) * q) + off; }
        const int nig = WGM * nN, gid = wgid / nig, fm = gid * WGM, gsz = (nM - fm) < WGM ? (nM - fm) : WGM;
        u.pm = fm + ((wgid % nig) % gsz); u.pn = (wgid % nig) / gsz; return true;
    }
    __device__ __forceinline__ void a_ready(const Unit&) const {}
    __device__ __forceinline__ void done(const Unit&) const {}
};

__device__ __forceinline__ unsigned cvt_pk_bf16(float lo, float hi) { unsigned r; asm volatile("v_cvt_pk_bf16_f32 %0, %1, %2" : "=v"(r) : "v"(lo), "v"(hi)); return r; }
typedef float f32x2 __attribute__((ext_vector_type(2)));
typedef unsigned u32x2 __attribute__((ext_vector_type(2)));
__device__ __forceinline__ unsigned short f2bf1(float f) { unsigned u = __builtin_bit_cast(unsigned, f); return (unsigned short)((u + 0x7fffu + ((u >> 16) & 1u)) >> 16); }
struct EpiZ {
    static constexpr bool PERM = true, AFTER_DRAIN = false, MIDSCALE = false;
    bf16_t* Z; bf16_t* KSF; bf16_t* VSF; bf16_t* KWF; bf16_t* VWF; float* GATES; const float* bgate; unsigned* kmaxw;
    __device__ __forceinline__ void operator()(const f32x4 (&acc)[2][2][4][2], const Unit& u, int wr, int wc, int fr, int fq) const {
        const int row0 = u.pm * BM + wr * 64 + fr;
        if (u.pn < 9) {
            const int col0 = u.pn * BM + wc * 32 + 8 * fq;
            if (u.pn < 7) {
#pragma unroll
            for (int ai = 0; ai < 2; ++ai)
#pragma unroll
                for (int m = 0; m < 4; ++m) { bf16_t* rowp = Z + (size_t)(row0 + ai * HALF + m * 16) * 2304 + col0;
#pragma unroll
                    for (int bj = 0; bj < 2; ++bj) { const f32x4 v0 = acc[ai][bj][m][0], v1 = acc[ai][bj][m][1];
                        u32x4 w; w.x = cvt_pk_bf16(v0[0], v0[1]); w.y = cvt_pk_bf16(v0[2], v0[3]); w.z = cvt_pk_bf16(v1[0], v1[1]); w.w = cvt_pk_bf16(v1[2], v1[3]);
                        *(u32x4*)(rowp + bj * HALF) = w; } }
            }
            if (u.pn >= 7) {
                bf16_t* KF = (u.pn == 7) ? KSF : KWF; bf16_t* VF = (u.pn == 7) ? VSF : VWF;
                const int kvh = wc >> 1, dbase = 32 * (wc & 1) + 8 * fq;
                float kmx = 0.f;
#pragma unroll
                for (int ai = 0; ai < 2; ++ai)
#pragma unroll
                    for (int m = 0; m < 4; ++m) { const int row = row0 + ai * HALF + m * 16, b = row >> 13, s = row & 8191, tile = s >> 5, k = s & 31;
                        const size_t tb = ((size_t)(b * 2 + kvh) * 256 + tile) * 2048;
                        { const f32x4 v0 = acc[ai][0][m][0], v1 = acc[ai][0][m][1];
                          float q = (v0[0] * v0[0] + v0[1] * v0[1]) + (v0[2] * v0[2] + v0[3] * v0[3]) + (v1[0] * v1[0] + v1[1] * v1[1]) + (v1[2] * v1[2] + v1[3] * v1[3]);
                          q += __shfl_xor(q, 16); q += __shfl_xor(q, 32); kmx = fmaxf(kmx, q); }
                        { const f32x4 v0 = acc[ai][0][m][0], v1 = acc[ai][0][m][1];
                          u32x4 w; w.x = cvt_pk_bf16(v0[0], v0[1]); w.y = cvt_pk_bf16(v0[2], v0[3]); w.z = cvt_pk_bf16(v1[0], v1[1]); w.w = cvt_pk_bf16(v1[2], v1[3]);
                          *(u32x4*)(KF + tb + (dbase >> 4) * 512 + ((dbase >> 3) & 1) * 256 + k * 8) = w; }
                        const int kk = k & 15, vo = ((kk >> 2) & 1) * 512 + (k >> 4) * 8 + (kk & 3) + 4 * (kk >> 3);
                        unsigned char* V8 = (unsigned char*)VF + ((size_t)(b * 2 + kvh) * 256 + tile) * 2048;
#pragma unroll
                        for (int n = 0; n < 2; ++n) { const f32x4 v = acc[ai][1][m][n]; int w = 0; w = __builtin_amdgcn_cvt_pk_fp8_f32(v[0], v[1], w, false); w = __builtin_amdgcn_cvt_pk_fp8_f32(v[2], v[3], w, true);
#pragma unroll
                            for (int e = 0; e < 4; ++e) { const int d = dbase + 4 * n + e; V8[(d >> 5) * 1024 + (d & 31) * 16 + vo] = (unsigned char)((unsigned)w >> (8 * e)); } }
                        asm volatile("" ::: "memory"); }
#pragma unroll
                for (int o = 1; o < 16; o <<= 1) kmx = fmaxf(kmx, __shfl_xor(kmx, o));
                if (fr == 0 && fq == 0) atomicMax(kmaxw + (((row0 >> 13) * 2 + kvh) * 2 + (u.pn - 7)) * 2 + (wc & 1), __builtin_bit_cast(unsigned, kmx * 1.01f));
            }
        } else {
            if (wc == 0 && fq < 3) {
                const f32x4 bg0 = *(const f32x4*)(bgate + 8 * fq), bg1 = *(const f32x4*)(bgate + 8 * fq + 4);
#pragma unroll
                for (int ai = 0; ai < 2; ++ai)
#pragma unroll
                    for (int m = 0; m < 4; ++m) { const int row = row0 + ai * HALF + m * 16;
#pragma unroll
                        for (int n = 0; n < 2; ++n) { const f32x4 bg = n ? bg1 : bg0; f32x4 g;
#pragma unroll
                            for (int e = 0; e < 4; ++e) { const float v = acc[ai][0][m][n][e] + bg[e]; g[e] = 1.0f / (1.0f + __expf(-v)); }
                            *(f32x4*)(GATES + (size_t)row * 24 + 8 * fq + 4 * n) = g; } }
            }
        }
    }
};
struct EpiStore {
    static constexpr bool PERM = true, AFTER_DRAIN = false, MIDSCALE = false;
    bf16_t* O; int ldc; const float* ssq; int frag;
    __device__ __forceinline__ void operator()(const f32x4 (&acc)[2][2][4][2], const Unit& u, int wr, int wc, int fr, int fq) const {
        const int row0 = u.pm * BM + wr * 64 + fr; const int col0 = u.pn * BM + wc * 32 + 8 * fq;
#pragma unroll
        for (int ai = 0; ai < 2; ++ai)
#pragma unroll
            for (int m = 0; m < 4; ++m) { const int row = row0 + ai * HALF + m * 16;
                bf16_t* rowp = frag ? O + (size_t)(row >> 5) * 32 * ldc + (size_t)(col0 >> 4) * 512 + ((col0 >> 3) & 1) * 256 + (row & 31) * 8 : O + (size_t)row * ldc + col0;
                const int bjstep = frag ? (HALF >> 4) * 512 : HALF;
                float sc = 1.f;
                if (ssq) { const f32x4* p = (const f32x4*)(ssq + (size_t)row * 16); const f32x4 a = p[0], b = p[1], c = p[2], d = p[3];
                    const float s = ((a[0] + a[1]) + (a[2] + a[3])) + ((b[0] + b[1]) + (b[2] + b[3])) + ((c[0] + c[1]) + (c[2] + c[3])) + ((d[0] + d[1]) + (d[2] + d[3]));
                    sc = rsqrtf(s * (1.0f / 1024.0f) + 1e-6f); }
#pragma unroll
                for (int bj = 0; bj < 2; ++bj) { const f32x4 v0 = acc[ai][bj][m][0] * sc, v1 = acc[ai][bj][m][1] * sc;
                    u32x4 w; w.x = cvt_pk_bf16(v0[0], v0[1]); w.y = cvt_pk_bf16(v0[2], v0[3]); w.z = cvt_pk_bf16(v1[0], v1[1]); w.w = cvt_pk_bf16(v1[2], v1[3]);
                    *(u32x4*)(rowp + bj * bjstep) = w; } }
    }
};
struct EpiVFrag {
    static constexpr bool PERM = true, AFTER_DRAIN = false, MIDSCALE = false;
    bf16_t* O;
    __device__ __forceinline__ void operator()(const f32x4 (&acc)[2][2][4][2], const Unit& u, int wr, int wc, int fr, int fq) const {
        const int row0 = u.pm * BM + wr * 64 + fr; const int col0 = u.pn * BM + wc * 32 + 8 * fq;
#pragma unroll
        for (int ai = 0; ai < 2; ++ai)
#pragma unroll
            for (int m = 0; m < 4; ++m) { const int D = row0 + ai * HALF + m * 16, h = D >> 8, dt = (D >> 5) & 7, r = D & 31;
#pragma unroll
                for (int bj = 0; bj < 2; ++bj) { const int K0 = col0 + bj * HALF, b = K0 >> 8, kt = (K0 >> 5) & 7, k0 = K0 & 31;
                    bf16_t* p = O + (size_t)((b * 4 + h) * 8 + kt) * 8192 + dt * 1024 + (k0 >> 4) * 512 + r * 8 + 4 * ((k0 >> 3) & 1);
                    const f32x4 v0 = acc[ai][bj][m][0], v1 = acc[ai][bj][m][1];
                    u32x2 w0, w1; w0.x = cvt_pk_bf16(v0[0], v0[1]); w0.y = cvt_pk_bf16(v0[2], v0[3]); w1.x = cvt_pk_bf16(v1[0], v1[1]); w1.y = cvt_pk_bf16(v1[2], v1[3]);
                    *(u32x2*)p = w0; *(u32x2*)(p + 256) = w1; } }
    }
};
__device__ __forceinline__ void unit_of(int M, int N, int c, int& pm, int& pn) {
    const int nM = M / BM, nN = N / BM, nwg = nM * nN; int wgid = c;
    { const int q = nwg / NXCD, r = nwg % NXCD, xcd = wgid % NXCD, off = wgid / NXCD; wgid = (xcd < r ? xcd * (q + 1) : r * (q + 1) + (xcd - r) * q) + off; }
    const int nig = WGM * nN, gid = wgid / nig, fm = gid * WGM, gsz = (nM - fm) < WGM ? (nM - fm) : WGM;
    pm = fm + ((wgid % nig) % gsz); pn = (wgid % nig) / gsz;
}
struct EpiQLds {
    static constexpr bool PERM = true, AFTER_DRAIN = true, MIDSCALE = false;
    const float* ssq;
    __device__ __forceinline__ void fused(const f32x4 (&acc)[2][2][4][2], const Unit& u, int wr, int wc, int fr, int fq, PG8_LAS unsigned char* lds, int wid, int lane) const {
        const int rl0 = wr * 64 + fr, cl0 = wc * 32 + 8 * fq;
#pragma unroll
        for (int ai = 0; ai < 2; ++ai)
#pragma unroll
            for (int m = 0; m < 4; ++m) { const int rl = rl0 + ai * HALF + m * 16; const int row = u.pm * BM + rl;
                const f32x4* p = (const f32x4*)(ssq + (size_t)row * 16); const f32x4 a = p[0], b = p[1], c = p[2], d = p[3];
                const float s = ((a[0] + a[1]) + (a[2] + a[3])) + ((b[0] + b[1]) + (b[2] + b[3])) + ((c[0] + c[1]) + (c[2] + c[3])) + ((d[0] + d[1]) + (d[2] + d[3]));
                const float sc = rsqrtf(s * (1.0f / 1024.0f) + 1e-6f);
#pragma unroll
                for (int bj = 0; bj < 2; ++bj) { const int cl = cl0 + bj * HALF; const f32x4 v0 = acc[ai][bj][m][0] * sc, v1 = acc[ai][bj][m][1] * sc;
                    u32x4 w; w.x = cvt_pk_bf16(v0[0], v0[1]); w.y = cvt_pk_bf16(v0[2], v0[3]); w.z = cvt_pk_bf16(v1[0], v1[1]); w.w = cvt_pk_bf16(v1[2], v1[3]);
                    *(PG8_LAS u32x4*)(lds + ((rl >> 5) * 16 + (cl >> 4)) * 1024 + ((cl >> 3) & 1) * 512 + (rl & 31) * 16) = w; } }
    }
};
template <bool MID> struct EpiRes {
    static constexpr bool PERM = !MID, AFTER_DRAIN = false, MIDSCALE = MID;
    const float* base; const bf16_t* base16; float* out; bf16_t* XB; float* ssq; const float* ssqn; const float* bscale;
    __device__ __forceinline__ void midscale(f32x4 (&acc)[2][2][4][2], const Unit& u, int wr, int wc, int fr, int fq) const {
        const int row0 = u.pm * BM + wr * 64 + fr;
#pragma unroll
        for (int ai = 0; ai < 2; ++ai)
#pragma unroll
            for (int m = 0; m < 4; ++m) { const int row = row0 + ai * HALF + m * 16; const f32x2 sq = *(const f32x2*)(ssqn + (size_t)row * 2);
                const float sc = rsqrtf((sq[0] + sq[1]) * (1.0f / 512.0f) + 1e-6f);
#pragma unroll
                for (int bj = 0; bj < 2; ++bj)
#pragma unroll
                    for (int n = 0; n < 2; ++n) acc[ai][bj][m][n] = acc[ai][bj][m][n] * sc; }
    }
    __device__ __forceinline__ void operator()(const f32x4 (&acc)[2][2][4][2], const Unit& u, int wr, int wc, int fr, int fq) const {
      if constexpr (PERM) {
        const int row0 = u.pm * BM + wr * 64 + fr; const int col0 = u.pn * BM + wc * 32 + 8 * fq;
#pragma unroll
        for (int ai = 0; ai < 2; ++ai)
#pragma unroll
            for (int m = 0; m < 4; ++m) { const int row = row0 + ai * HALF + m * 16; const size_t off = (size_t)row * 1024 + col0; float s = 0.f; const float bs = bscale ? bscale[row] : 1.f;
#pragma unroll
                for (int bj = 0; bj < 2; ++bj) { f32x4 v0 = acc[ai][bj][m][0], v1 = acc[ai][bj][m][1];
                    if (base) { v0 = v0 + *(const f32x4*)(base + off + bj * HALF); v1 = v1 + *(const f32x4*)(base + off + bj * HALF + 4); }
                    else { const u32x4 w = *(const u32x4*)(base16 + off + bj * HALF);
                        v0[0] = __builtin_fmaf(__builtin_bit_cast(float, w.x << 16), bs, v0[0]); v0[1] = __builtin_fmaf(__builtin_bit_cast(float, w.x & 0xffff0000u), bs, v0[1]);
                        v0[2] = __builtin_fmaf(__builtin_bit_cast(float, w.y << 16), bs, v0[2]); v0[3] = __builtin_fmaf(__builtin_bit_cast(float, w.y & 0xffff0000u), bs, v0[3]);
                        v1[0] = __builtin_fmaf(__builtin_bit_cast(float, w.z << 16), bs, v1[0]); v1[1] = __builtin_fmaf(__builtin_bit_cast(float, w.z & 0xffff0000u), bs, v1[1]);
                        v1[2] = __builtin_fmaf(__builtin_bit_cast(float, w.w << 16), bs, v1[2]); v1[3] = __builtin_fmaf(__builtin_bit_cast(float, w.w & 0xffff0000u), bs, v1[3]); }
                    if (out) { *(f32x4*)(out + off + bj * HALF) = v0; *(f32x4*)(out + off + bj * HALF + 4) = v1; }
                    s += ((v0[0] * v0[0] + v0[1] * v0[1]) + (v0[2] * v0[2] + v0[3] * v0[3])) + ((v1[0] * v1[0] + v1[1] * v1[1]) + (v1[2] * v1[2] + v1[3] * v1[3]));
                    u32x4 wo; wo.x = cvt_pk_bf16(v0[0], v0[1]); wo.y = cvt_pk_bf16(v0[2], v0[3]); wo.z = cvt_pk_bf16(v1[0], v1[1]); wo.w = cvt_pk_bf16(v1[2], v1[3]); *(u32x4*)(XB + off + bj * HALF) = wo;
                    asm volatile("" ::: "memory"); }
                s += __shfl_xor(s, 16); s += __shfl_xor(s, 32);
                if (fq == 0) ssq[(size_t)row * 16 + u.pn * 4 + wc] = s;
                asm volatile("" ::: "memory"); }
      } else {
        const int row0 = u.pm * BM + wr * 64 + fr; const int col0 = u.pn * BM + wc * 32 + 4 * fq; const int wsh = (fq & 1) ? 12 : 0;
#pragma unroll
        for (int ai = 0; ai < 2; ++ai)
#pragma unroll
            for (int m = 0; m < 4; ++m) { const int row = row0 + ai * HALF + m * 16; const size_t off = (size_t)row * 1024 + col0 + wsh; float s = 0.f; const float bs = bscale ? bscale[row] : 1.f;
#pragma unroll
                for (int bj = 0; bj < 2; ++bj) { const u32x4 w = *(const u32x4*)(base16 + off + bj * HALF);
                    const auto r0 = __builtin_amdgcn_permlane16_swap(w.x, w.z, false, false), r1 = __builtin_amdgcn_permlane16_swap(w.y, w.w, false, false);
                    f32x4 v0 = acc[ai][bj][m][0], v1 = acc[ai][bj][m][1];
                    v0[0] = __builtin_fmaf(__builtin_bit_cast(float, r0[0] << 16), bs, v0[0]); v0[1] = __builtin_fmaf(__builtin_bit_cast(float, r0[0] & 0xffff0000u), bs, v0[1]);
                    v0[2] = __builtin_fmaf(__builtin_bit_cast(float, r1[0] << 16), bs, v0[2]); v0[3] = __builtin_fmaf(__builtin_bit_cast(float, r1[0] & 0xffff0000u), bs, v0[3]);
                    v1[0] = __builtin_fmaf(__builtin_bit_cast(float, r0[1] << 16), bs, v1[0]); v1[1] = __builtin_fmaf(__builtin_bit_cast(float, r0[1] & 0xffff0000u), bs, v1[1]);
                    v1[2] = __builtin_fmaf(__builtin_bit_cast(float, r1[1] << 16), bs, v1[2]); v1[3] = __builtin_fmaf(__builtin_bit_cast(float, r1[1] & 0xffff0000u), bs, v1[3]);
                    s += ((v0[0] * v0[0] + v0[1] * v0[1]) + (v0[2] * v0[2] + v0[3] * v0[3])) + ((v1[0] * v1[0] + v1[1] * v1[1]) + (v1[2] * v1[2] + v1[3] * v1[3]));
                    const unsigned o0x = cvt_pk_bf16(v0[0], v0[1]), o0y = cvt_pk_bf16(v0[2], v0[3]), o1x = cvt_pk_bf16(v1[0], v1[1]), o1y = cvt_pk_bf16(v1[2], v1[3]);
                    const auto q0 = __builtin_amdgcn_permlane16_swap(o0x, o1x, false, false), q1 = __builtin_amdgcn_permlane16_swap(o0y, o1y, false, false);
                    u32x4 wo; wo.x = q0[0]; wo.y = q1[0]; wo.z = q0[1]; wo.w = q1[1]; *(u32x4*)(XB + off + bj * HALF) = wo;
                    asm volatile("" ::: "memory"); }
                s += __shfl_xor(s, 16); s += __shfl_xor(s, 32);
                if (fq == 0) ssq[(size_t)row * 16 + u.pn * 4 + wc] = s;
                asm volatile("" ::: "memory"); }
      }
    }
};
template <class Epi, class Sched, bool ALIGN_EPI = false, bool SP2 = false>
__device__ __forceinline__ void gemm_phase(PG8_LAS unsigned char* lds, const Gemm g, const Sched& S, const Epi& E, int wave  ) {
    int lane; asm volatile("v_mbcnt_lo_u32_b32 %0, -1, 0\n\tv_mbcnt_hi_u32_b32 %0, -1, %0" : "=v"(lane));
    const int wid = wave, tid = wid * 64 + lane, wr = wid >> 2, wc = wid & 3, fr = lane & 15, fq = lane >> 4;
    const int K = g.K, nt = K / BK;
    unsigned voffA[2], voffB[2];
#pragma unroll
    for (int i = 0; i < 2; ++i) { int R, C; stage_rc(tid * 16 + i * 8192, R, C); const int Rb = Epi::PERM ? ((R & ~31) + perm32(R & 31)) : R;
        voffA[i] = (unsigned)(R * K + C) * 2u; voffB[i] = (unsigned)(Rb * K + C) * 2u; }
    const size_t kstep = (size_t)(BK * 2);
    const size_t hstep = (size_t)HALF * K * 2;
    const size_t tstep = 2 * hstep;
    const unsigned ldsw = (unsigned)wid * 1024u;
    const int aoff = lds_byte(wr * 64 + fr, fq * 8), boff = lds_byte(wc * 32 + fr, fq * 8);
#define PG8_SA(b, h) (((b) * 2 + (h)) * HTB)
#define PG8_SB(b, h) ((4 + (b) * 2 + (h)) * HTB)
#define PG8_STAGE(bufoff, gbase, voff) do { const char* _gb = (const char*)(gbase); asm volatile("" : "+s"(_gb)); _Pragma("unroll") for (int _i = 0; _i < 2; ++_i) \
        __builtin_amdgcn_global_load_lds((const unsigned*)(_gb + (voff)[_i]), (PG8_LAS unsigned*)(lds + (bufoff) + ldsw + _i * 8192), 16, 0, 0); } while (0)
#define PG8_LDA(dst, b, h) do { _Pragma("unroll") for (int m = 0; m < 4; ++m) _Pragma("unroll") for (int k = 0; k < 2; ++k) dst[m][k] = *(const PG8_LAS bf16x8*)(lds + PG8_SA(b, h) + aoff + m * 2048 + k * 1024); } while (0)
#define PG8_LDB(dst, b, h) do { _Pragma("unroll") for (int n = 0; n < 2; ++n) _Pragma("unroll") for (int k = 0; k < 2; ++k) dst[n][k] = *(const PG8_LAS bf16x8*)(lds + PG8_SB(b, h) + boff + n * 2048 + k * 1024); } while (0)
#define PG8_MMA(ai, bj, At, Bt) do { __builtin_amdgcn_s_setprio(1); _Pragma("unroll") for (int m = 0; m < 4; ++m) _Pragma("unroll") for (int n = 0; n < 2; ++n) _Pragma("unroll") for (int k = 0; k < 2; ++k) \
        acc[ai][bj][m][n] = __builtin_amdgcn_mfma_f32_16x16x32_bf16(Bt[n][k], At[m][k], acc[ai][bj][m][n], 0, 0, 0); __builtin_amdgcn_s_setprio(0); } while (0)
#define PG8_WAIT_V(n) asm volatile("s_waitcnt vmcnt(" #n ")" ::: "memory")
#define PG8_WAIT_L(n) asm volatile("s_waitcnt lgkmcnt(" #n ")" ::: "memory")
#define PG8_BAR __builtin_amdgcn_s_barrier()
#define PG8_SCHED __builtin_amdgcn_sched_barrier(0)
    Unit cur, nxt; int ui = 0;
    if (!S.next(0, cur)) return;
    f32x4 acc[2][2][4][2];
#pragma unroll
    for (int a = 0; a < 2; ++a)
#pragma unroll
        for (int b = 0; b < 2; ++b)
#pragma unroll
            for (int m = 0; m < 4; ++m)
#pragma unroll
                for (int n = 0; n < 2; ++n) acc[a][b][m][n] = (f32x4){0.f, 0.f, 0.f, 0.f};
    bf16x8 At[4][2], B0[2][2], B1[2][2];
    const char* cA = (const char*)g.A + (size_t)cur.pm * tstep; const char* cB = (const char*)g.Bt + (size_t)cur.pn * tstep;
    S.a_ready(cur);
    if constexpr (SP2) {
        PG8_STAGE(PG8_SB(0, 0), cB, voffB); PG8_STAGE(PG8_SB(0, 1), cB + hstep, voffB); PG8_STAGE(PG8_SA(0, 0), cA, voffA); PG8_STAGE(PG8_SA(0, 1), cA + hstep, voffA);
        if (wr == 1) PG8_BAR;
        PG8_WAIT_V(2); PG8_BAR;
        PG8_STAGE(PG8_SB(1, 0), cB + kstep, voffB); PG8_STAGE(PG8_SA(1, 0), cA + kstep, voffA); PG8_STAGE(PG8_SB(1, 1), cB + hstep + kstep, voffB);
        PG8_WAIT_V(6); PG8_BAR;
    } else {
        PG8_STAGE(PG8_SB(0, 0), cB, voffB); PG8_STAGE(PG8_SA(0, 0), cA, voffA); PG8_STAGE(PG8_SB(0, 1), cB + hstep, voffB); PG8_STAGE(PG8_SA(0, 1), cA + hstep, voffA);
        if (wr == 1) PG8_BAR;
        PG8_WAIT_V(4); PG8_BAR;
        PG8_STAGE(PG8_SB(1, 0), cB + kstep, voffB); PG8_STAGE(PG8_SA(1, 0), cA + kstep, voffA); PG8_STAGE(PG8_SB(1, 1), cB + hstep + kstep, voffB);
        PG8_WAIT_V(6); PG8_BAR;
    }
    for (;;) {
        const bool has_next = S.next(ui + 1, nxt);
        const char* nA = has_next ? (const char*)g.A + (size_t)nxt.pm * tstep : cA; const char* nB = has_next ? (const char*)g.Bt + (size_t)nxt.pn * tstep : cB;
        for (int t = 0; t < nt; t += 2) {
            if constexpr (Epi::MIDSCALE) { if (t == nt / 2) E.midscale(acc, cur, wr, wc, fr, fq); }
            const bool last = (t == nt - 2);
            const char* a1 = cA + (size_t)(t + 1) * kstep;
            const char* a2 = last ? nA : cA + (size_t)(t + 2) * kstep; const char* b2 = last ? nB : cB + (size_t)(t + 2) * kstep;
            const char* a3 = a2 + kstep; const char* b3 = b2 + kstep;
            if (last && has_next) S.a_ready(nxt);
            if constexpr (SP2) {
            PG8_LDB(B0, 0, 0); PG8_LDB(B1, 0, 1); PG8_SCHED; PG8_LDA(At, 0, 0); PG8_STAGE(PG8_SA(1, 1), a1 + hstep, voffA);
            PG8_WAIT_V(8); PG8_WAIT_L(0); PG8_BAR; PG8_MMA(0, 0, At, B0); PG8_MMA(0, 1, At, B1); PG8_BAR; PG8_SCHED;
            PG8_LDA(At, 0, 1); PG8_STAGE(PG8_SB(0, 0), b2, voffB); PG8_STAGE(PG8_SB(0, 1), b2 + hstep, voffB); PG8_STAGE(PG8_SA(0, 0), a2, voffA);
            PG8_WAIT_V(8); PG8_WAIT_L(0); PG8_BAR; PG8_MMA(1, 0, At, B0); PG8_MMA(1, 1, At, B1); PG8_BAR; PG8_SCHED;
            PG8_LDB(B0, 1, 0); PG8_LDB(B1, 1, 1); PG8_SCHED; PG8_LDA(At, 1, 0); PG8_STAGE(PG8_SA(0, 1), a2 + hstep, voffA);
            PG8_WAIT_V(8); PG8_WAIT_L(0); PG8_BAR; PG8_MMA(0, 0, At, B0); PG8_MMA(0, 1, At, B1); PG8_BAR; PG8_SCHED;
            PG8_LDA(At, 1, 1); PG8_STAGE(PG8_SB(1, 0), b3, voffB); PG8_STAGE(PG8_SB(1, 1), b3 + hstep, voffB); PG8_STAGE(PG8_SA(1, 0), a3, voffA);
            PG8_WAIT_V(8); PG8_WAIT_L(0); PG8_BAR; PG8_MMA(1, 0, At, B0); PG8_MMA(1, 1, At, B1); PG8_BAR; PG8_SCHED;
            } else {
            PG8_LDB(B0, 0, 0); PG8_SCHED; PG8_LDA(At, 0, 0); PG8_STAGE(PG8_SA(1, 1), a1 + hstep, voffA);
            PG8_WAIT_L(8); PG8_BAR; PG8_WAIT_L(0); PG8_MMA(0, 0, At, B0); PG8_BAR; PG8_SCHED;
            PG8_LDB(B1, 0, 1); PG8_STAGE(PG8_SB(0, 0), b2, voffB);
            PG8_BAR; PG8_WAIT_L(0); PG8_MMA(0, 1, At, B1); PG8_BAR;
            PG8_LDA(At, 0, 1); PG8_STAGE(PG8_SA(0, 0), a2, voffA);
            PG8_BAR; PG8_WAIT_L(0); PG8_MMA(1, 0, At, B0); PG8_BAR; PG8_SCHED;
            PG8_STAGE(PG8_SB(0, 1), b2 + hstep, voffB);
            PG8_WAIT_V(6); PG8_BAR; PG8_MMA(1, 1, At, B1); PG8_BAR;
            PG8_LDB(B0, 1, 0); PG8_SCHED; PG8_LDA(At, 1, 0); PG8_STAGE(PG8_SA(0, 1), a2 + hstep, voffA);
            PG8_WAIT_L(8); PG8_BAR; PG8_WAIT_L(0); PG8_MMA(0, 0, At, B0); PG8_BAR; PG8_SCHED;
            PG8_LDB(B1, 1, 1); PG8_STAGE(PG8_SB(1, 0), b3, voffB);
            PG8_BAR; PG8_WAIT_L(0); PG8_MMA(0, 1, At, B1); PG8_BAR;
            PG8_LDA(At, 1, 1); PG8_STAGE(PG8_SA(1, 0), a3, voffA);
            PG8_BAR; PG8_WAIT_L(0); PG8_MMA(1, 0, At, B0); PG8_BAR; PG8_SCHED;
            PG8_STAGE(PG8_SB(1, 1), b3 + hstep, voffB);
            PG8_WAIT_V(6); PG8_BAR; PG8_MMA(1, 1, At, B1); PG8_BAR;
            }
        }
        if constexpr (ALIGN_EPI) { if (wr == 0) PG8_BAR; }
        if constexpr (!Epi::AFTER_DRAIN) { E(acc, cur, wr, wc, fr, fq); S.done(cur); }
        if (!has_next) break;
#pragma unroll
        for (int a = 0; a < 2; ++a)
#pragma unroll
            for (int b = 0; b < 2; ++b)
#pragma unroll
                for (int m = 0; m < 4; ++m)
#pragma unroll
                    for (int n = 0; n < 2; ++n) acc[a][b][m][n] = (f32x4){0.f, 0.f, 0.f, 0.f};
        cur = nxt; cA = nA; cB = nB; ++ui;
        if constexpr (ALIGN_EPI) { if (wr == 1) PG8_BAR; }
    }
    PG8_WAIT_V(0);
    if constexpr (!ALIGN_EPI) { if (wr == 0) PG8_BAR; }
    PG8_BAR;
    if constexpr (Epi::AFTER_DRAIN) { E.fused(acc, cur, wr, wc, fr, fq, lds, wid, lane); S.done(cur); }
#undef PG8_SA
#undef PG8_SB
#undef PG8_STAGE
#undef PG8_LDA
#undef PG8_LDB
#undef PG8_MMA
#undef PG8_WAIT_V
#undef PG8_WAIT_L
#undef PG8_BAR
#undef PG8_SCHED
}
}

constexpr int NB = 2, SEQ = 8192, DM = 1024, MTOK = NB * SEQ;
constexpr int NZ = 2304, NZP = 2560;
constexpr int NMEM = 256;
constexpr float EPS = 1e-6f;
constexpr float QSCALE = 0.125f * 1.4426950408889634f;
constexpr int ZC_XL = 0, ZC_GT = 512, ZC_Q = 1024, ZC_KC = 1536, ZC_VC = 1664, ZC_KS = 1792, ZC_VS = 1920, ZC_KW = 2048, ZC_VW = 2176, ZC_G = 2304;

constexpr size_t MiB = 1u << 20;
constexpr size_t WS_CTL = 0;
constexpr size_t WS_WIN = 1 * MiB, WS_WOUT = 6 * MiB, WS_WMQ = 8 * MiB, WS_WMK = 10 * MiB, WS_WMV = 12 * MiB, WS_WMO = 14 * MiB, WS_WPQ = 16 * MiB;
constexpr size_t WS_SKEY = 20 * MiB;
constexpr size_t WS_CW1T = WS_SKEY + 512 * 1024;
constexpr size_t WS_CW2T = WS_CW1T + 512 * 1024;
constexpr size_t WS_C1 = WS_CW2T + 16 * 1024;
constexpr size_t WS_WRGT = WS_C1 + 16 * 1024;
constexpr size_t WS_MEMN = 22 * MiB, WS_MEMK = 23 * MiB, WS_MEMVT = 24 * MiB;
constexpr size_t WS_KC = 26 * MiB;
constexpr size_t WS_VCT = WS_KC + 256 * 1024;
constexpr size_t WS_SUMM = 27 * MiB;
constexpr size_t WS_SSQ1 = 28 * MiB, WS_SSQ2 = 29 * MiB;
constexpr size_t WS_GATES = 30 * MiB;
constexpr size_t WS_XINV = 31 * MiB + 768 * 1024;
constexpr size_t WS_SSQN = 31 * MiB + 512 * 1024;
constexpr size_t WS_U8 = 32 * MiB, WS_V8 = 48 * MiB;
constexpr size_t WS_SU = 64 * MiB, WS_SV = 64 * MiB + 65536;
constexpr size_t WS_SSQ3 = 65 * MiB;
constexpr size_t WS_W = 66 * MiB;
constexpr size_t WS_PART = 128 * MiB;
constexpr size_t WS_XN = 96 * MiB;
constexpr size_t WS_Z = 128 * MiB;
constexpr size_t WS_KSF = 240 * MiB, WS_VSF = 244 * MiB, WS_KWF = 248 * MiB, WS_VWF = 252 * MiB;
constexpr size_t WS_QM = 128 * MiB, WS_OM = 160 * MiB;
constexpr size_t WS_QP = 128 * MiB;
constexpr size_t WS_Y = 208 * MiB;
constexpr size_t WS_EID = 208 * MiB, WS_GW = 216 * MiB;
constexpr size_t WS_END = 256 * MiB;

constexpr int CW_KMAXC = 12352;
constexpr int CW_CMPDONE = 14464, CW_LRUDONE = 14528;
constexpr int CW_KMAX = 12288;
constexpr int LDS_BYTES = 147456;

#define GAS __attribute__((address_space(1)))
#define LAS __attribute__((address_space(3)))
typedef unsigned short bf16;
typedef unsigned v4u __attribute__((ext_vector_type(4)));
typedef unsigned v2u __attribute__((ext_vector_type(2)));
typedef float f32x4 __attribute__((ext_vector_type(4)));
typedef float f32x16 __attribute__((ext_vector_type(16)));
typedef short bf16x8 __attribute__((ext_vector_type(8)));
typedef short bf16x4 __attribute__((ext_vector_type(4)));
__device__ __forceinline__ unsigned f2bf(float f) { unsigned u = __builtin_bit_cast(unsigned, f); return (u + 0x7fffu + ((u >> 16) & 1u)) >> 16; }
typedef float f32x2_ __attribute__((ext_vector_type(2))); typedef __bf16 bf16x2_ __attribute__((ext_vector_type(2)));
__device__ __forceinline__ unsigned pk2(float lo, float hi) { f32x2_ v = {lo, hi}; bf16x2_ b = __builtin_convertvector(v, bf16x2_); return __builtin_bit_cast(unsigned, b); }
__device__ __forceinline__ float bf2f(unsigned short h) { return __builtin_bit_cast(float, (unsigned)h << 16); }
__device__ __forceinline__ float bflo(unsigned w) { return __builtin_bit_cast(float, w << 16); }
__device__ __forceinline__ float bfhi(unsigned w) { return __builtin_bit_cast(float, w & 0xffff0000u); }
__device__ __forceinline__ void swap32(unsigned& a, unsigned& b) { asm("s_nop 1\n\tv_permlane32_swap_b32 %0, %1" : "+v"(a), "+v"(b)); }
__device__ __forceinline__ int maxswap32_i(int v) { unsigned a = (unsigned)v, b = (unsigned)v; swap32(a, b); return max((int)a, (int)b); }
__device__ __forceinline__ float maxswap32_f(float v) { unsigned a = __builtin_bit_cast(unsigned, v), b = a; swap32(a, b); return fmaxf(__builtin_bit_cast(float, a), __builtin_bit_cast(float, b)); }
__device__ __forceinline__ float addswap32_f(float v) { unsigned a = __builtin_bit_cast(unsigned, v), b = a; swap32(a, b); return __builtin_bit_cast(float, a) + __builtin_bit_cast(float, b); }
__device__ __forceinline__ float wave_sum(float v) {
#pragma unroll
    for (int o = 1; o < 64; o <<= 1) v += __shfl_xor(v, o);
    return v;
}

struct Args { const float* in[33]; float* out; unsigned char* ws; int ph_lo, ph_hi; };

struct Frame {
    int tid, lane, wave, vcu, G, gw, NGW;
};
__device__ __forceinline__ int lane_id() { int l; asm volatile("v_mbcnt_lo_u32_b32 %0, -1, 0\n\tv_mbcnt_hi_u32_b32 %0, -1, %0" : "=v"(l)); return l; }
#define REFRESH_LANE(F) do { (F).lane = lane_id(); (F).tid = (F).wave * 64 + (F).lane; } while (0)

__device__ __forceinline__ void transpose_item(const float* W, int K, int N, bf16* WT, int ldt, int row_off, const float* gain, int slo, int shi, float cs, LAS float* scr, int item, int lane, int kxor = 0) {
    const int nblk = (N + 31) / 32, kb = item / nblk, nb = item % nblk, k0 = 64 * kb, n0 = 32 * nb;
    { const int nl = lane & 31, kh = lane >> 5; const bool ok = (n0 + nl) < N;
      const float* src = W + (size_t)(k0 + kh) * N + (ok ? n0 + nl : N - 1);
      float v[32];
#pragma unroll
      for (int i = 0; i < 32; ++i) v[i] = __builtin_nontemporal_load(src + (size_t)(2 * i) * N);
#pragma unroll
      for (int i = 0; i < 32; ++i) scr[(2 * i + kh) * 33 + nl] = ok ? v[i] : 0.f; }
    asm volatile("s_waitcnt lgkmcnt(0)" ::: "memory");
    const int c = lane & 7;
    f32x4 g0 = {1.f, 1.f, 1.f, 1.f}, g1 = {1.f, 1.f, 1.f, 1.f};
    if (gain) { g0 = *(const f32x4*)(gain + k0 + 8 * c); g1 = *(const f32x4*)(gain + k0 + 8 * c + 4); }
#pragma unroll
    for (int j = 0; j < 4; ++j) { const int n = (lane >> 3) + 8 * j; const LAS float* s = scr + (8 * c) * 33 + n;
        const float sc = (n0 + n >= slo && n0 + n < shi) ? cs : 1.f;
        v4u o; o.x = pk2(s[0 * 33] * g0.x * sc, s[1 * 33] * g0.y * sc); o.y = pk2(s[2 * 33] * g0.z * sc, s[3 * 33] * g0.w * sc); o.z = pk2(s[4 * 33] * g1.x * sc, s[5 * 33] * g1.y * sc); o.w = pk2(s[6 * 33] * g1.z * sc, s[7 * 33] * g1.w * sc);
        *(v4u*)(WT + (size_t)(row_off + n0 + n) * ldt + (k0 ^ kxor) + 8 * c) = o; }
    asm volatile("s_waitcnt lgkmcnt(0)" ::: "memory");
}
__device__ __forceinline__ void rms_row_to_bf16(const float* xrow, bf16* orow, int lane, float* inv_out = nullptr) {
    const f32x4* xr = (const f32x4*)xrow + lane;
    f32x4 v[4]; float s = 0.f;
#pragma unroll
    for (int j = 0; j < 4; ++j) { v[j] = xr[64 * j]; s += (v[j].x * v[j].x + v[j].y * v[j].y) + (v[j].z * v[j].z + v[j].w * v[j].w); }
    const float ms = wave_sum(s) * (1.f / DM) + EPS; const float rstd = rsqrtf(ms);
    if (inv_out && lane == 0) *inv_out = ms * rstd;
    unsigned long long* o8 = (unsigned long long*)orow + lane;
#pragma unroll
    for (int j = 0; j < 4; ++j) o8[64 * j] = (unsigned long long)pk2(v[j].x * rstd, v[j].y * rstd) | ((unsigned long long)pk2(v[j].z * rstd, v[j].w * rstd) << 32);
}
__device__ __forceinline__ void quant_row_fp8(const float* src, const float* gain, unsigned char* dst, float* scale_out, int lane) {
    const f32x4* p = (const f32x4*)src + 4 * lane; f32x4 v[4]; float am = 0.f;
#pragma unroll
    for (int j = 0; j < 4; ++j) { v[j] = p[j]; if (gain) v[j] = v[j] * ((const f32x4*)gain)[4 * lane + j]; am = fmaxf(am, fmaxf(fmaxf(fabsf(v[j].x), fabsf(v[j].y)), fmaxf(fabsf(v[j].z), fabsf(v[j].w)))); }
#pragma unroll
    for (int o = 1; o < 64; o <<= 1) am = fmaxf(am, __shfl_xor(am, o));
    const float inv = am > 0.f ? 448.0f / am : 0.f;
    v4u o4;
#pragma unroll
    for (int j = 0; j < 4; ++j) { int w = 0; w = __builtin_amdgcn_cvt_pk_fp8_f32(v[j].x * inv, v[j].y * inv, w, false); w = __builtin_amdgcn_cvt_pk_fp8_f32(v[j].z * inv, v[j].w * inv, w, true); o4[j] = (unsigned)w; }
    *(v4u*)(dst + (size_t)(lane >> 3) * 16384 * 128 + (lane & 7) * 16) = o4;
    if (lane == 0) *scale_out = am * (1.0f / 448.0f);
}
__device__ __forceinline__ void rms_rows4_to_bf16(const float* x0, bf16* o0, size_t rstride  , int lane, float* inv0  ) {
    f32x4 v[4][4]; float s[4];
#pragma unroll
    for (int r = 0; r < 4; ++r)
#pragma unroll
        for (int j = 0; j < 4; ++j) v[r][j] = __builtin_nontemporal_load((const f32x4*)(x0 + r * rstride) + lane + 64 * j);
#pragma unroll
    for (int r = 0; r < 4; ++r) { s[r] = 0.f;
#pragma unroll
        for (int j = 0; j < 4; ++j) s[r] += (v[r][j].x * v[r][j].x + v[r][j].y * v[r][j].y) + (v[r][j].z * v[r][j].z + v[r][j].w * v[r][j].w); }
#pragma unroll
    for (int o = 1; o < 64; o <<= 1)
#pragma unroll
        for (int r = 0; r < 4; ++r) s[r] += __shfl_xor(s[r], o);
#pragma unroll
    for (int r = 0; r < 4; ++r) { const float ms = s[r] * (1.f / DM) + EPS; const float rstd = rsqrtf(ms); unsigned long long* o8 = (unsigned long long*)(o0 + r * rstride) + lane;
        if (lane == 0) inv0[r * (rstride / DM)] = ms * rstd;
#pragma unroll
        for (int j = 0; j < 4; ++j) o8[64 * j] = (unsigned long long)pk2(v[r][j].x * rstd, v[r][j].y * rstd) | ((unsigned long long)pk2(v[r][j].z * rstd, v[r][j].w * rstd) << 32); }
}
__device__ __forceinline__ void quant_rows4_fp8(const float* src0, size_t rstride, const float* gain, unsigned char* dst0, float* scale0, int sstride, int lane) {
    f32x4 v[4][4]; float am[4];
#pragma unroll
    for (int r = 0; r < 4; ++r)
#pragma unroll
        for (int j = 0; j < 4; ++j) v[r][j] = __builtin_nontemporal_load((const f32x4*)(src0 + r * rstride) + 4 * lane + j);
    if (gain) {
#pragma unroll
        for (int j = 0; j < 4; ++j) { const f32x4 g = ((const f32x4*)gain)[4 * lane + j];
#pragma unroll
            for (int r = 0; r < 4; ++r) v[r][j] = v[r][j] * g; } }
#pragma unroll
    for (int r = 0; r < 4; ++r) { am[r] = 0.f;
#pragma unroll
        for (int j = 0; j < 4; ++j) am[r] = fmaxf(am[r], fmaxf(fmaxf(fabsf(v[r][j].x), fabsf(v[r][j].y)), fmaxf(fabsf(v[r][j].z), fabsf(v[r][j].w)))); }
#pragma unroll
    for (int o = 1; o < 64; o <<= 1)
#pragma unroll
        for (int r = 0; r < 4; ++r) am[r] = fmaxf(am[r], __shfl_xor(am[r], o));
#pragma unroll
    for (int r = 0; r < 4; ++r) { const float inv = am[r] > 0.f ? 448.0f / am[r] : 0.f; v4u o4;
#pragma unroll
        for (int j = 0; j < 4; ++j) { int w = 0; w = __builtin_amdgcn_cvt_pk_fp8_f32(v[r][j].x * inv, v[r][j].y * inv, w, false); w = __builtin_amdgcn_cvt_pk_fp8_f32(v[r][j].z * inv, v[r][j].w * inv, w, true); o4[j] = (unsigned)w; }
        __builtin_nontemporal_store(o4, (v4u*)(dst0 + (size_t)r * sstride * 128 + (size_t)(lane >> 3) * 16384 * 128 + (lane & 7) * 16));
        if (lane == 0) scale0[r * sstride] = am[r] * (1.0f / 448.0f); }
}
__device__ __forceinline__ void p0_prologue(const Frame& F, const Args& A, LAS unsigned char* lds) {
    unsigned char* ws = A.ws;
    LAS float* scr = (LAS float*)(lds + F.wave * 16384);
    const float* const* in = A.in;
    const int gw = F.gw, NGW = F.NGW;
    constexpr int I_IN = 16 * 73, I_SQ = 16 * 32, I_PQ = 16 * 64, I_C1 = 64, I_C2 = 2, I_RG = 2;
    constexpr int E_IN = I_IN, E_OUT = E_IN + I_SQ, E_MQ = E_OUT + I_SQ, E_MK = E_MQ + I_SQ, E_MV = E_MK + I_SQ, E_MO = E_MV + I_SQ, E_PQ = E_MO + I_PQ, E_C1 = E_PQ + 2 * I_C1, E_C2 = E_C1 + 2 * I_C2, E_RG = E_C2 + 16 * I_RG;
    for (int it = gw; it < E_RG; it += NGW) {
        if (it < E_IN) transpose_item(in[3], 1024, 2328, (bf16*)(ws + WS_WIN), 1024, 0, in[2], ZC_Q, ZC_KC, QSCALE, scr, it, F.lane);
        else if (it < E_OUT) { const int j = it - E_IN, kb = j / 32; transpose_item(in[20], 1024, 1024, (bf16*)(ws + WS_WOUT), 1024, 0, (kb < 8 ? in[18] : in[19] - 512), 0, 0, 1.f, scr, j, F.lane, 512); }
        else if (it < E_MQ) transpose_item(in[23], 1024, 1024, (bf16*)(ws + WS_WMQ), 1024, 0, in[21], 0, 1024, 0.0625f * 1.4426950408889634f, scr, it - E_OUT, F.lane);
        else if (it < E_MK) transpose_item(in[24], 1024, 1024, (bf16*)(ws + WS_WMK), 1024, 0, in[22], 0, 0, 1.f, scr, it - E_MQ, F.lane);
        else if (it < E_MV) transpose_item(in[25], 1024, 1024, (bf16*)(ws + WS_WMV), 1024, 0, in[22], 0, 0, 1.f, scr, it - E_MK, F.lane);
        else if (it < E_MO) transpose_item(in[26], 1024, 1024, (bf16*)(ws + WS_WMO), 1024, 0, nullptr, 0, 0, 1.f, scr, it - E_MV, F.lane);
        else if (it < E_PQ) transpose_item(in[28], 1024, 2048, (bf16*)(ws + WS_WPQ), 1024, 0, in[27], 0, 0, 1.f, scr, it - E_MO, F.lane);
        else if (it < E_C1) { const int j = it - E_PQ, kv = j / I_C1; transpose_item(in[kv ? 16 : 13], 2048, 64, (bf16*)(ws + WS_CW1T) + (size_t)kv * 64 * 2048, 2048, 0, nullptr, 0, 0, 1.f, scr, j % I_C1, F.lane); }
        else if (it < E_C2) { const int j = it - E_C1, kv = j / I_C2; transpose_item(in[kv ? 17 : 14], 64, 64, (bf16*)(ws + WS_CW2T) + (size_t)kv * 64 * 64, 64, 0, nullptr, 0, 0, 1.f, scr, j % I_C2, F.lane); }
        else { const int j = it - E_C2, ai = j / 16, h = (j / 2) % 8; transpose_item(in[ai ? 9 : 7] + (size_t)h * 4096, 64, 64, (bf16*)(ws + WS_WRGT) + (size_t)(ai * 8 + h) * 4096, 64, 0, nullptr, 0, 0, 1.f, scr, j % 2, F.lane); }
    }
    for (int i = gw * 64 + F.lane; i < (2560 - 2336) * 1024 / 8; i += NGW * 64) ((v4u*)((bf16*)(ws + WS_WIN) + (size_t)2336 * 1024))[i] = (v4u){0u, 0u, 0u, 0u};
    for (int it = NGW - 1 - gw; it < 32; it += NGW) { const int kv = it >> 4, ch = it & 15; const float* pos = in[kv ? 15 : 12] + 128 * ch; const float* w1 = in[kv ? 16 : 13] + (size_t)128 * ch * 64 + F.lane; float s = 0.f;
#pragma unroll 16
        for (int k = 0; k < 128; ++k) s += pos[k] * w1[(size_t)k * 64];
        ((float*)(ws + WS_C1))[it * 64 + F.lane] = s; }
    { const size_t i0 = (size_t)gw * 64 + F.lane, st = (size_t)NGW * 64;
      const int nrows0 = (F.G == 256) ? 0 : 32768;
      for (int r = gw; r < nrows0; r += 4 * NGW) { const int tb = r >> 14, e = r & 16383;
          if ((16384 % (4 * NGW)) == 0) quant_rows4_fp8(in[30 + tb] + (size_t)e * DM, (size_t)NGW * DM, tb ? nullptr : in[27], ws + (tb ? WS_V8 : WS_U8) + (size_t)e * 128, (float*)(ws + (tb ? WS_SV : WS_SU)) + e, NGW, F.lane);
          else for (int q = 0; q < 4; ++q) { const int rr = r + q * NGW; if (rr < 32768) { const int t2 = rr >> 14, e2 = rr & 16383; quant_row_fp8(in[30 + t2] + (size_t)e2 * DM, t2 ? nullptr : in[27], ws + (t2 ? WS_V8 : WS_U8) + (size_t)e2 * 128, (float*)(ws + (t2 ? WS_SV : WS_SU)) + e2, F.lane); } } }
      for (size_t i = i0; i < (size_t)8 * 2 * 128 * 128 / 8; i += st) { const f32x4 a = ((const f32x4*)in[29])[2 * i], bq = ((const f32x4*)in[29])[2 * i + 1];
          v4u o; o.x = pk2(a.x, a.y); o.y = pk2(a.z, a.w); o.z = pk2(bq.x, bq.y); o.w = pk2(bq.z, bq.w);
          const size_t R = i >> 4, d0 = (i & 15) * 8;
          *(v4u*)((bf16*)(ws + WS_SKEY) + (R >> 5) * 4096 + (d0 >> 4) * 512 + ((d0 >> 3) & 1) * 256 + (R & 31) * 8) = o; } }
    if ((MTOK % (4 * NGW)) == 0) for (int m = gw; m < MTOK; m += 4 * NGW) rms_rows4_to_bf16(in[0] + (size_t)m * DM, (bf16*)(ws + WS_XN) + (size_t)m * DM, (size_t)NGW * DM, F.lane, (float*)(ws + WS_XINV) + m);
    else for (int m = gw; m < MTOK; m += NGW) rms_row_to_bf16(in[0] + (size_t)m * DM, (bf16*)(ws + WS_XN) + (size_t)m * DM, F.lane, (float*)(ws + WS_XINV) + m);
    for (int m = gw; m < NB * NMEM; m += NGW) rms_row_to_bf16(in[1] + (size_t)m * DM, (bf16*)(ws + WS_MEMN) + (size_t)m * DM, F.lane);
}

__device__ __forceinline__ int crow(int r, int hi) { return (r & 3) + 8 * (r >> 2) + 4 * hi; }
__device__ __forceinline__ float gelu_tanh(float x) {
    const float u = 0.7978845608028654f * (x + 0.044715f * x * x * x);
    const float t = 1.0f - 2.0f * __builtin_amdgcn_rcpf(__builtin_amdgcn_exp2f(2.0f * 1.4426950408889634f * u) + 1.0f);
    return 0.5f * x * (1.0f + t);
}
constexpr int XC_LD = 520;
__device__ __forceinline__ void lru_local_item(const Frame& F, const Args& A, LAS unsigned char* lds, int item) {
    unsigned char* ws = A.ws;
    const bf16* Z = (const bf16*)(ws + WS_Z);
    const int b = item >> 7, chunk = item & 127, s0 = chunk * 64; const size_t row0 = (size_t)b * SEQ + s0;
    LAS bf16* xcs = (LAS bf16*)lds;
    {
        const int c8 = F.tid & 63, tg = F.tid >> 6, c0 = 8 * c8;
        v4u xr[11];
#pragma unroll
        for (int r = 0; r < 11; ++r) { const long tok = (long)(8 * tg + r) - 3;
            if (s0 == 0 && tok < 0) xr[r] = (v4u){0u, 0u, 0u, 0u}; else xr[r] = *(const v4u*)(Z + (size_t)((long)row0 + tok) * NZ + c0); }
        const float* cw = A.in[5]; float w0[8], w1[8], w2[8], w3[8], cb[8];
#pragma unroll
        for (int j = 0; j < 2; ++j) { const f32x4 a = *(const f32x4*)(cw + c0 + 4 * j), b = *(const f32x4*)(cw + 512 + c0 + 4 * j), c = *(const f32x4*)(cw + 1024 + c0 + 4 * j), d = *(const f32x4*)(cw + 1536 + c0 + 4 * j), e2 = *(const f32x4*)(A.in[6] + c0 + 4 * j);
#pragma unroll
            for (int k = 0; k < 4; ++k) { w0[4 * j + k] = a[k]; w1[4 * j + k] = b[k]; w2[4 * j + k] = c[k]; w3[4 * j + k] = d[k]; cb[4 * j + k] = e2[k]; } }
#pragma unroll
        for (int tt = 0; tt < 8; ++tt) { float o[8];
#pragma unroll
            for (int q = 0; q < 4; ++q) { const unsigned a = xr[tt][q], b = xr[tt + 1][q], c = xr[tt + 2][q], d = xr[tt + 3][q];
                o[2 * q] = cb[2 * q] + w0[2 * q] * bflo(a) + w1[2 * q] * bflo(b) + w2[2 * q] * bflo(c) + w3[2 * q] * bflo(d);
                o[2 * q + 1] = cb[2 * q + 1] + w0[2 * q + 1] * bfhi(a) + w1[2 * q + 1] * bfhi(b) + w2[2 * q + 1] * bfhi(c) + w3[2 * q + 1] * bfhi(d); }
            v4u ov; ov.x = pk2(o[0], o[1]); ov.y = pk2(o[2], o[3]); ov.z = pk2(o[4], o[5]); ov.w = pk2(o[6], o[7]);
            *(LAS v4u*)(xcs + (8 * tg + tt) * XC_LD + c0) = ov; }
    }
    __syncthreads();
    const int h = F.wave, lane = F.lane, r32 = lane & 31, hi = lane >> 5;
    bf16x8 af[2][4];
#pragma unroll
    for (int tt = 0; tt < 2; ++tt)
#pragma unroll
        for (int ks = 0; ks < 4; ++ks) af[tt][ks] = *(const LAS bf16x8*)(xcs + (32 * tt + r32) * XC_LD + 64 * h + 16 * ks + 8 * hi);
    const bf16* WT = (const bf16*)(ws + WS_WRGT);
    float* SUMM = (float*)(ws + WS_SUMM);
    unsigned* HA = (unsigned*)A.out;
#pragma unroll 1
    for (int ct = 0; ct < 2; ++ct) {
        const int c = 64 * h + 32 * ct + r32;
        f32x16 ga[2], gi[2];
#pragma unroll
        for (int tt = 0; tt < 2; ++tt) { ga[tt] = f32x16{}; gi[tt] = f32x16{}; }
#pragma unroll
        for (int ks = 0; ks < 4; ++ks) {
            const bf16x8 ba = *(const bf16x8*)(WT + (size_t)(0 * 8 + h) * 4096 + (32 * ct + r32) * 64 + 16 * ks + 8 * hi);
            const bf16x8 bi = *(const bf16x8*)(WT + (size_t)(1 * 8 + h) * 4096 + (32 * ct + r32) * 64 + 16 * ks + 8 * hi);
#pragma unroll
            for (int tt = 0; tt < 2; ++tt) { ga[tt] = __builtin_amdgcn_mfma_f32_32x32x16_bf16(af[tt][ks], ba, ga[tt], 0, 0, 0); gi[tt] = __builtin_amdgcn_mfma_f32_32x32x16_bf16(af[tt][ks], bi, gi[tt], 0, 0, 0); }
        }
        const float ba_ = A.in[8][c], bi_ = A.in[10][c], lam = A.in[11][c];
        const float sp = (lam > 15.f) ? __expf(-lam) : log1pf(__expf(-lam));
#pragma unroll
        for (int tt = 0; tt < 2; ++tt)
#pragma unroll
            for (int r = 0; r < 16; ++r) { const int t = 32 * tt + crow(r, hi);
                const float rr = __builtin_amdgcn_rcpf(1.0f + __builtin_amdgcn_exp2f(-1.4426950408889634f * (ga[tt][r] + ba_))), ii = __builtin_amdgcn_rcpf(1.0f + __builtin_amdgcn_exp2f(-1.4426950408889634f * (gi[tt][r] + bi_)));
                const float a = __builtin_amdgcn_exp2f(-8.0f * 1.4426950408889634f * rr * sp);
                const float xcv = bf2f(xcs[t * XC_LD + c]);
                const float bb = __builtin_amdgcn_sqrtf(fmaxf(1.0f - a * a, 0.f)) * (ii * xcv);
                ga[tt][r] = a; gi[tt][r] = bb; }
        float SA[8], SB[8];
#pragma unroll
        for (int tt = 0; tt < 2; ++tt)
#pragma unroll
            for (int q = 0; q < 4; ++q) {
#pragma unroll
                for (int k = 1; k < 4; ++k) { const int r = 4 * q + k; gi[tt][r] = ga[tt][r] * gi[tt][r - 1] + gi[tt][r]; ga[tt][r] = ga[tt][r] * ga[tt][r - 1]; }
                SA[tt * 4 + q] = ga[tt][4 * q + 3]; SB[tt * 4 + q] = gi[tt][4 * q + 3]; }
        float CA = 1.f, CB = 0.f; float inA[8], inB[8];
#pragma unroll
        for (int s = 0; s < 8; ++s) {
            const float pA = __shfl_xor(SA[s], 32), pB = __shfl_xor(SB[s], 32);
            const float Ae = hi ? pA : SA[s], Be = hi ? pB : SB[s], Ao = hi ? SA[s] : pA, Bo = hi ? SB[s] : pB;
            if (!hi) { inA[s] = CA; inB[s] = CB; }
            CB = Ae * CB + Be; CA = Ae * CA;
            if (hi) { inA[s] = CA; inB[s] = CB; }
            CB = Ao * CB + Bo; CA = Ao * CA;
        }
        unsigned hoff = (unsigned)((row0 + 4 * hi) * 512 + c);
        if (hi == 0) { float* sp2 = SUMM + ((size_t)(b * 128 + chunk) * 512 + c) * 2;
            __hip_atomic_store((unsigned long long*)sp2, (unsigned long long)__builtin_bit_cast(unsigned, CA) | ((unsigned long long)__builtin_bit_cast(unsigned, CB) << 32), __ATOMIC_RELAXED, __HIP_MEMORY_SCOPE_AGENT); }
#pragma unroll
        for (int tt = 0; tt < 2; ++tt)
#pragma unroll
            for (int r = 0; r < 16; ++r) { const int s = tt * 4 + (r >> 2);
                const float acum = ga[tt][r] * inA[s], hloc = ga[tt][r] * inB[s] + gi[tt][r];
                asm volatile("" : "+v"(hoff));
                HA[hoff + (unsigned)((32 * tt + (r & 3) + 8 * (r >> 2)) * 512)] = f2bf(hloc) | (f2bf(acum) << 16); }
    }
    asm volatile("s_waitcnt vmcnt(0)" ::: "memory");
    __syncthreads();
    if (F.wave == 0 && F.lane == 0) __hip_atomic_fetch_add((unsigned*)(ws + WS_CTL) + CW_LRUDONE, 1u, __ATOMIC_RELAXED, __HIP_MEMORY_SCOPE_AGENT);
}
__device__ __forceinline__ void lru_fix_item(const Frame& F, const Args& A, LAS unsigned char* lds, int item, bool zero_nsa) {
    unsigned char* ws = A.ws;
    const int b = item >> 7, chunk = item & 127; const size_t row0 = (size_t)b * SEQ + chunk * 64;
    LAS float* carry = (LAS float*)lds;
    { const int c = F.tid; const float* SUMM = (const float*)(ws + WS_SUMM) + (size_t)b * 128 * 1024 + 2 * c; float hc = 0.f;
      int j = 0;
      for (; j + 8 <= chunk; j += 8) { float2 ab[8];
#pragma unroll
          for (int q = 0; q < 8; ++q) ab[q] = *(const float2*)(SUMM + (size_t)(j + q) * 1024);
#pragma unroll
          for (int q = 0; q < 8; ++q) hc = ab[q].x * hc + ab[q].y; }
      for (; j < chunk; ++j) { const float2 ab = *(const float2*)(SUMM + (size_t)j * 1024); hc = ab.x * hc + ab.y; }
      carry[c] = hc; }
    __syncthreads();
    const bf16* Z = (const bf16*)(ws + WS_Z); const unsigned* HA = (const unsigned*)A.out; bf16* Y = (bf16*)(ws + WS_Y);
    const int c0 = 8 * F.lane;
    float cr[8];
#pragma unroll
    for (int j = 0; j < 8; ++j) cr[j] = carry[c0 + j];
#pragma unroll 1
    for (int t4 = 0; t4 < 8; t4 += 4) {
        v4u h0[4], h1[4], gz[4]; float y[4][8], s[4];
#pragma unroll
        for (int q = 0; q < 4; ++q) { const size_t row = row0 + F.wave * 8 + t4 + q; h0[q] = __builtin_nontemporal_load((const v4u*)(HA + row * 512 + c0)); h1[q] = __builtin_nontemporal_load((const v4u*)(HA + row * 512 + c0 + 4)); gz[q] = __builtin_nontemporal_load((const v4u*)(Z + row * NZ + ZC_GT + c0)); }
#pragma unroll
        for (int q = 0; q < 4; ++q) { const unsigned hw[8] = {h0[q].x, h0[q].y, h0[q].z, h0[q].w, h1[q].x, h1[q].y, h1[q].z, h1[q].w};
            const float gt[8] = {bflo(gz[q].x), bfhi(gz[q].x), bflo(gz[q].y), bfhi(gz[q].y), bflo(gz[q].z), bfhi(gz[q].z), bflo(gz[q].w), bfhi(gz[q].w)};
            s[q] = 0.f;
#pragma unroll
            for (int j = 0; j < 8; ++j) { const float hv = bfhi(hw[j]) * cr[j] + bflo(hw[j]); y[q][j] = hv * gelu_tanh(gt[j]); s[q] += y[q][j] * y[q][j]; } }
#pragma unroll
        for (int o = 1; o < 64; o <<= 1)
#pragma unroll
            for (int q = 0; q < 4; ++q) s[q] += __shfl_xor(s[q], o);
#pragma unroll
        for (int q = 0; q < 4; ++q) { const size_t row = row0 + F.wave * 8 + t4 + q; const float rstd = rsqrtf(s[q] * (1.f / 512.f) + EPS);
            v4u o; o.x = pk2(y[q][0] * rstd, y[q][1] * rstd); o.y = pk2(y[q][2] * rstd, y[q][3] * rstd); o.z = pk2(y[q][4] * rstd, y[q][5] * rstd); o.w = pk2(y[q][6] * rstd, y[q][7] * rstd);
            *(v4u*)(Y + row * DM + 512 + c0) = o;
            if (zero_nsa) *(v4u*)(Y + row * DM + c0) = (v4u){0u, 0u, 0u, 0u}; }
    }
    __syncthreads();
}

constexpr size_t WS_CARRY = 128 * 1024;
constexpr int CW_FQ = 14336, CW_CFLAG = 14400;
__device__ __forceinline__ void lru_carry_scan(const Args& A, int j  , int lane) {
    unsigned char* ws = A.ws;
    const int b = j >> 3, c = (j & 7) * 64 + lane;
    const float* SUMM = (const float*)(ws + WS_SUMM) + (size_t)b * 128 * 1024 + 2 * c;
    float* CR = (float*)(ws + WS_CARRY) + (size_t)b * 128 * 512 + c;
    float hc = 0.f; CR[0] = 0.f;
#pragma unroll 1
    for (int k0 = 0; k0 < 128; k0 += 16) { float2 ab[16];
#pragma unroll
        for (int q = 0; q < 16; ++q) ab[q] = *(const float2*)(SUMM + (size_t)(k0 + q) * 1024);
#pragma unroll
        for (int q = 0; q < 16; ++q) { hc = ab[q].x * hc + ab[q].y; if (k0 + q + 1 < 128) CR[(size_t)(k0 + q + 1) * 512] = hc; } }
    __builtin_amdgcn_fence(__ATOMIC_RELEASE, "agent");
    if (lane == 0) __hip_atomic_fetch_add((unsigned*)(ws + WS_CTL) + CW_CFLAG, 1u, __ATOMIC_RELAXED, __HIP_MEMORY_SCOPE_AGENT);
}
__device__ __forceinline__ void lru_fix_wave(const Args& A, int it  , int lane) {
    unsigned char* ws = A.ws;
    const size_t row0 = (size_t)it * 8; const int b = (int)(row0 >> 13), chunk = (int)((row0 & 8191) >> 6);
    const bf16* Z = (const bf16*)(ws + WS_Z); const unsigned* HA = (const unsigned*)A.out; bf16* Y = (bf16*)(ws + WS_Y);
    const int c0 = 8 * lane;
    float cr[8];
    { unsigned long long* cp = (unsigned long long*)((float*)(ws + WS_CARRY) + ((size_t)b * 128 + chunk) * 512 + c0);
#pragma unroll
      for (int j = 0; j < 4; ++j) { const unsigned long long v = __hip_atomic_load(cp + j, __ATOMIC_RELAXED, __HIP_MEMORY_SCOPE_AGENT);
          cr[2 * j] = __builtin_bit_cast(float, (unsigned)v); cr[2 * j + 1] = __builtin_bit_cast(float, (unsigned)(v >> 32)); } }
#pragma unroll 1
    for (int t4 = 0; t4 < 8; t4 += 4) {
        v4u h0[4], h1[4], gz[4]; float y[4][8], s[4];
#pragma unroll
        for (int q = 0; q < 4; ++q) { const size_t row = row0 + t4 + q; h0[q] = __builtin_nontemporal_load((const v4u*)(HA + row * 512 + c0)); h1[q] = __builtin_nontemporal_load((const v4u*)(HA + row * 512 + c0 + 4)); gz[q] = __builtin_nontemporal_load((const v4u*)(Z + row * NZ + ZC_GT + c0)); }
#pragma unroll
        for (int q = 0; q < 4; ++q) { const unsigned hw[8] = {h0[q].x, h0[q].y, h0[q].z, h0[q].w, h1[q].x, h1[q].y, h1[q].z, h1[q].w};
            const float gt[8] = {bflo(gz[q].x), bfhi(gz[q].x), bflo(gz[q].y), bfhi(gz[q].y), bflo(gz[q].z), bfhi(gz[q].z), bflo(gz[q].w), bfhi(gz[q].w)};
            s[q] = 0.f;
#pragma unroll
            for (int j = 0; j < 8; ++j) { const float hv = bfhi(hw[j]) * cr[j] + bflo(hw[j]); y[q][j] = hv * gelu_tanh(gt[j]); s[q] += y[q][j] * y[q][j]; } }
#pragma unroll
        for (int o = 1; o < 64; o <<= 1)
#pragma unroll
            for (int q = 0; q < 4; ++q) s[q] += __shfl_xor(s[q], o);
#pragma unroll
        for (int q = 0; q < 4; ++q) { const size_t row = row0 + t4 + q; const float rstd = rsqrtf(s[q] * (1.f / 512.f) + EPS);
            v4u o; o.x = pk2(y[q][0] * rstd, y[q][1] * rstd); o.y = pk2(y[q][2] * rstd, y[q][3] * rstd); o.z = pk2(y[q][4] * rstd, y[q][5] * rstd); o.w = pk2(y[q][6] * rstd, y[q][7] * rstd);
            *(v4u*)(Y + row * DM + 512 + c0) = o; }
    }
}

__device__ __forceinline__ void kmax_item(const Frame& F, const Args& A, int item) {
    unsigned char* ws = A.ws; const int lane = lane_id();
    const int bk = item >> 9, br = (item >> 8) & 1, tile = item & 255;
    const unsigned char* K = ws + (br ? WS_KWF : WS_KSF) + ((size_t)bk * 256 + tile) * 4096 + 16 * lane;
    float s = 0.f;
#pragma unroll
    for (int ks = 0; ks < 4; ++ks) { const v4u w = *(const v4u*)(K + 1024 * ks); const unsigned ww[4] = {w.x, w.y, w.z, w.w};
#pragma unroll
        for (int k = 0; k < 4; ++k) { const float a = bflo(ww[k]), c = bfhi(ww[k]); s += a * a + c * c; } }
    s = addswap32_f(s);
#pragma unroll
    for (int o = 1; o < 32; o <<= 1) s = fmaxf(s, __shfl_xor(s, o));
    if (lane == 0) atomicMax((unsigned*)(ws + WS_CTL) + CW_KMAX + bk * 2 + br, __builtin_bit_cast(unsigned, s));
}
__device__ __forceinline__ void compress_item(const Frame& F, const Args& A, LAS unsigned char* lds, int item) {
    unsigned char* ws = A.ws;
    const int kv = item >> 6, b = (item >> 5) & 1, h = (item >> 4) & 1, nt = item & 15, n0 = 32 * nt;
    int lane = lane_id(); asm volatile("" : "+v"(lane));
    const int r32 = lane & 31, hi = lane >> 5, w = F.wave;
    const bf16* Z = (const bf16*)(ws + WS_Z); const bf16* W1T = (const bf16*)(ws + WS_CW1T) + (size_t)kv * 64 * 2048; const bf16* W2T = (const bf16*)(ws + WS_CW2T) + (size_t)kv * 4096;
    const int zc = (kv ? ZC_VC : ZC_KC) + h * 64;
    LAS float* part = (LAS float*)lds;
    LAS float* G = (LAS float*)(lds + 65536);
    {
        int n = n0 + r32; if (n > 510) n = 510;
        f32x16 acc[2]; acc[0] = f32x16{}; acc[1] = f32x16{};
#pragma unroll 4
        for (int kk = 0; kk < 16; ++kk) { const int ks = 16 * w + kk, l = ks >> 2, d0 = (ks & 3) * 16 + 8 * hi;
            const bf16x8 bfr = *(const bf16x8*)(Z + ((size_t)b * SEQ + 16 * n + l) * NZ + zc + d0);
            const bf16x8 a0 = *(const bf16x8*)(W1T + (size_t)(r32) * 2048 + ks * 16 + 8 * hi), a1 = *(const bf16x8*)(W1T + (size_t)(32 + r32) * 2048 + ks * 16 + 8 * hi);
            acc[0] = __builtin_amdgcn_mfma_f32_32x32x16_bf16(a0, bfr, acc[0], 0, 0, 0); acc[1] = __builtin_amdgcn_mfma_f32_32x32x16_bf16(a1, bfr, acc[1], 0, 0, 0); }
#pragma unroll
        for (int ot = 0; ot < 2; ++ot)
#pragma unroll
            for (int r = 0; r < 16; ++r) part[(w * 64 + 32 * ot + crow(r, hi)) * 32 + r32] = acc[ot][r];
    }
    __syncthreads();
    { const float* c1 = (const float*)(ws + WS_C1) + kv * 16 * 64;
#pragma unroll
      for (int i = 0; i < 4; ++i) { const int e = F.tid + 512 * i, o = e >> 5, n = e & 31; float s = 0.f;
#pragma unroll
          for (int ch = 0; ch < 16; ++ch) s += c1[ch * 64 + o];
#pragma unroll
          for (int ww = 0; ww < 8; ++ww) s += part[(ww * 64 + o) * 32 + n];
          G[o * 33 + n] = gelu_tanh(s); } }
    __syncthreads();
    float kss = 0.f;
    if (w < 2) {
        f32x16 acc = f32x16{};
#pragma unroll
        for (int ks = 0; ks < 4; ++ks) { const bf16x8 a = *(const bf16x8*)(W2T + (size_t)(32 * w + r32) * 64 + 16 * ks + 8 * hi);
            v4u bw; const LAS float* gp = G + (16 * ks + 8 * hi) * 33 + r32;
            bw.x = pk2(gp[0], gp[33]); bw.y = pk2(gp[66], gp[99]); bw.z = pk2(gp[132], gp[165]); bw.w = pk2(gp[198], gp[231]);
            acc = __builtin_amdgcn_mfma_f32_32x32x16_bf16(a, __builtin_bit_cast(bf16x8, bw), acc, 0, 0, 0); }
        const int n = n0 + r32;
        const size_t tbase = ((size_t)(b * 2 + h) * 16 + nt) * 2048;
        if (kv == 0) { bf16* KC = (bf16*)(ws + WS_KC) + tbase;
#pragma unroll
            for (int q = 0; q < 4; ++q) { v2u o; o.x = pk2(acc[4 * q], acc[4 * q + 1]); o.y = pk2(acc[4 * q + 2], acc[4 * q + 3]); if (n > 510) { o.x = 0u; o.y = 0u; }
                __hip_atomic_store((unsigned long long*)(KC + (2 * w + (q >> 1)) * 512 + (q & 1) * 256 + r32 * 8 + 4 * hi), (unsigned long long)o.x | ((unsigned long long)o.y << 32), __ATOMIC_RELAXED, __HIP_MEMORY_SCOPE_AGENT); }
            float ss = 0.f;
#pragma unroll
            for (int r = 0; r < 16; ++r) { const float a = bf2f((unsigned short)f2bf(acc[r])); ss += a * a; }
            ss += __shfl_xor(ss, 32); if (n > 510) ss = 0.f;
            LAS float* kx = (LAS float*)(lds + 65536 + 8448);
            if (w == 1 && hi == 0) kx[r32] = ss;
            if (w == 0) kss = ss; }
        else { bf16* VC = (bf16*)(ws + WS_VCT) + tbase; const int kk = r32 & 15, vo = (r32 >> 4) * 512 + ((kk >> 2) & 1) * 256 + (kk & 3) + 4 * (kk >> 3);
#pragma unroll
            for (int r = 0; r < 16; ++r) __hip_atomic_store(VC + w * 1024 + crow(r, hi) * 8 + vo, (n > 510) ? (bf16)0 : (bf16)f2bf(acc[r]), __ATOMIC_RELAXED, __HIP_MEMORY_SCOPE_AGENT); }
    }
    __syncthreads();
    if (kv == 0 && w == 0) { float s = kss + ((const LAS float*)(lds + 65536 + 8448))[r32];
#pragma unroll
        for (int o = 1; o < 32; o <<= 1) s = fmaxf(s, __shfl_xor(s, o));
        if (lane == 0) atomicMax((unsigned*)(ws + WS_CTL) + CW_KMAXC + b * 2 + h, __builtin_bit_cast(unsigned, s)); }
    asm volatile("s_waitcnt vmcnt(0)" ::: "memory");
    __syncthreads();
    if (w == 0 && lane == 0) __hip_atomic_fetch_add((unsigned*)(ws + WS_CTL) + CW_CMPDONE, 1u, __ATOMIC_RELAXED, __HIP_MEMORY_SCOPE_AGENT);
}

__device__ __forceinline__ void sort16_desc(int (&k)[16]) {
#define CX(i, j) { const int hi_ = max(k[i], k[j]), lo_ = min(k[i], k[j]); k[i] = hi_; k[j] = lo_; }
    CX(0, 1) CX(2, 3) CX(0, 2) CX(1, 3) CX(1, 2) CX(4, 5) CX(6, 7) CX(4, 6) CX(5, 7) CX(5, 6) CX(0, 4) CX(2, 6) CX(2, 4) CX(1, 5) CX(3, 7) CX(3, 5) CX(1, 2)
    CX(3, 4) CX(5, 6) CX(8, 9) CX(10, 11) CX(8, 10) CX(9, 11) CX(9, 10) CX(12, 13) CX(14, 15) CX(12, 14) CX(13, 15) CX(13, 14) CX(8, 12) CX(10, 14) CX(10, 12)
    CX(9, 13) CX(11, 15) CX(11, 13) CX(9, 10) CX(11, 12) CX(13, 14) CX(0, 8) CX(4, 12) CX(4, 8) CX(2, 10) CX(6, 14) CX(6, 10) CX(2, 4) CX(6, 8) CX(10, 12)
    CX(1, 9) CX(5, 13) CX(5, 9) CX(3, 11) CX(7, 15) CX(7, 11) CX(3, 5) CX(7, 9) CX(11, 13) CX(1, 2) CX(3, 4) CX(5, 6) CX(7, 8) CX(9, 10) CX(11, 12) CX(13, 14)
#undef CX
}
__device__ __forceinline__ void sort32_desc(int (&k)[32]) {
#define CX(i, j) { const int hi_ = max(k[i], k[j]), lo_ = min(k[i], k[j]); k[i] = hi_; k[j] = lo_; }
    CX(0, 1) CX(2, 3) CX(0, 2) CX(1, 3) CX(1, 2) CX(4, 5) CX(6, 7) CX(4, 6) CX(5, 7) CX(5, 6) CX(0, 4) CX(2, 6) CX(2, 4) CX(1, 5) CX(3, 7) CX(3, 5) CX(1, 2)
    CX(3, 4) CX(5, 6) CX(8, 9) CX(10, 11) CX(8, 10) CX(9, 11) CX(9, 10) CX(12, 13) CX(14, 15) CX(12, 14) CX(13, 15) CX(13, 14) CX(8, 12) CX(10, 14) CX(10, 12)
    CX(9, 13) CX(11, 15) CX(11, 13) CX(9, 10) CX(11, 12) CX(13, 14) CX(0, 8) CX(4, 12) CX(4, 8) CX(2, 10) CX(6, 14) CX(6, 10) CX(2, 4) CX(6, 8) CX(10, 12)
    CX(1, 9) CX(5, 13) CX(5, 9) CX(3, 11) CX(7, 15) CX(7, 11) CX(3, 5) CX(7, 9) CX(11, 13) CX(1, 2) CX(3, 4) CX(5, 6) CX(7, 8) CX(9, 10) CX(11, 12) CX(13, 14)
    CX(16, 17) CX(18, 19) CX(16, 18) CX(17, 19) CX(17, 18) CX(20, 21) CX(22, 23) CX(20, 22) CX(21, 23) CX(21, 22) CX(16, 20) CX(18, 22) CX(18, 20) CX(17, 21)
    CX(19, 23) CX(19, 21) CX(17, 18) CX(19, 20) CX(21, 22) CX(24, 25) CX(26, 27) CX(24, 26) CX(25, 27) CX(25, 26) CX(28, 29) CX(30, 31) CX(28, 30) CX(29, 31)
    CX(29, 30) CX(24, 28) CX(26, 30) CX(26, 28) CX(25, 29) CX(27, 31) CX(27, 29) CX(25, 26) CX(27, 28) CX(29, 30) CX(16, 24) CX(20, 28) CX(20, 24) CX(18, 26)
    CX(22, 30) CX(22, 26) CX(18, 20) CX(22, 24) CX(26, 28) CX(17, 25) CX(21, 29) CX(21, 25) CX(19, 27) CX(23, 31) CX(23, 27) CX(19, 21) CX(23, 25) CX(27, 29)
    CX(17, 18) CX(19, 20) CX(21, 22) CX(23, 24) CX(25, 26) CX(27, 28) CX(29, 30) CX(0, 16) CX(8, 24) CX(8, 16) CX(4, 20) CX(12, 28) CX(12, 20) CX(4, 8)
    CX(12, 16) CX(20, 24) CX(2, 18) CX(10, 26) CX(10, 18) CX(6, 22) CX(14, 30) CX(14, 22) CX(6, 10) CX(14, 18) CX(22, 26) CX(2, 4) CX(6, 8) CX(10, 12)
    CX(14, 16) CX(18, 20) CX(22, 24) CX(26, 28) CX(1, 17) CX(9, 25) CX(9, 17) CX(5, 21) CX(13, 29) CX(13, 21) CX(5, 9) CX(13, 17) CX(21, 25) CX(3, 19)
    CX(11, 27) CX(11, 19) CX(7, 23) CX(15, 31) CX(15, 23) CX(7, 11) CX(15, 19) CX(23, 27) CX(3, 5) CX(7, 9) CX(11, 13) CX(15, 17) CX(19, 21) CX(23, 25)
    CX(27, 29) CX(1, 2) CX(3, 4) CX(5, 6) CX(7, 8) CX(9, 10) CX(11, 12) CX(13, 14) CX(15, 16) CX(17, 18) CX(19, 20) CX(21, 22) CX(23, 24) CX(25, 26) CX(27, 28)
    CX(29, 30)
#undef CX
}
__device__ __forceinline__ void bitonic16_desc(int (&a)[16]) {
#pragma unroll
    for (int s = 8; s >= 1; s >>= 1)
#pragma unroll
        for (int i = 0; i < 16; ++i) if ((i & s) == 0) { const int hi_ = max(a[i], a[i + s]), lo_ = min(a[i], a[i + s]); a[i] = hi_; a[i + s] = lo_; }
}
__device__ __forceinline__ void merge16_desc(int (&a)[16], const int (&b)[16]) {
#pragma unroll
    for (int i = 0; i < 16; ++i) a[i] = max(a[i], b[15 - i]);
    bitonic16_desc(a);
}
struct AttnSt { float m, l; f32x16 o[2]; };
#define EX2(x) __builtin_amdgcn_exp2f(x)
struct KVF { bf16x8 k[4]; bf16x8 v[2][2]; };
struct KVF8 { bf16x8 k[4]; v4u v8[2]; };
__device__ __forceinline__ void kv_load8(KVF8& f, const bf16* Kt, const unsigned char* Vt8, unsigned lo16) {
    const char* kb = (const char*)Kt + lo16;
#pragma unroll
    for (int ks = 0; ks < 4; ++ks) f.k[ks] = *(const bf16x8*)(kb + 1024 * ks);
#pragma unroll
    for (int dt = 0; dt < 2; ++dt) f.v8[dt] = *(const v4u*)(Vt8 + lo16 + 1024 * dt);
}
typedef __bf16 bf16x2v __attribute__((ext_vector_type(2)));
__device__ __forceinline__ bf16x8 dq8(unsigned w0, unsigned w1) {
    v4u o; o.x = __builtin_bit_cast(unsigned, __builtin_amdgcn_cvt_scalef32_pk_bf16_fp8(w0, 1.0f, false)); o.y = __builtin_bit_cast(unsigned, __builtin_amdgcn_cvt_scalef32_pk_bf16_fp8(w0, 1.0f, true));
    o.z = __builtin_bit_cast(unsigned, __builtin_amdgcn_cvt_scalef32_pk_bf16_fp8(w1, 1.0f, false)); o.w = __builtin_bit_cast(unsigned, __builtin_amdgcn_cvt_scalef32_pk_bf16_fp8(w1, 1.0f, true));
    return __builtin_bit_cast(bf16x8, o); }
__device__ __forceinline__ void kv_load(KVF& f, const bf16* Kt, const bf16* Vt, unsigned lo16) {
    const char* kb = (const char*)Kt + lo16; const char* vb = (const char*)Vt + lo16;
#pragma unroll
    for (int ks = 0; ks < 4; ++ks) f.k[ks] = *(const bf16x8*)(kb + 1024 * ks);
#pragma unroll
    for (int dt = 0; dt < 2; ++dt)
#pragma unroll
        for (int s2 = 0; s2 < 2; ++s2) f.v[dt][s2] = *(const bf16x8*)(vb + 2048 * dt + 1024 * s2);
}
#define MAX3(a, b, c) __builtin_fmaxf(__builtin_fmaxf((a), (b)), (c))
__device__ __forceinline__ float max16(const f32x16& s) { const float a = MAX3(s[0], s[1], s[2]), b = MAX3(s[3], s[4], s[5]), c = MAX3(s[6], s[7], s[8]), d = MAX3(s[9], s[10], s[11]), e = MAX3(s[12], s[13], s[14]);
    return MAX3(MAX3(a, b, c), MAX3(d, e, s[15]), -1e30f); }
__device__ __forceinline__ float sum16(const f32x16& s) { return (((s[0] + s[1]) + (s[2] + s[3])) + ((s[4] + s[5]) + (s[6] + s[7]))) + (((s[8] + s[9]) + (s[10] + s[11])) + ((s[12] + s[13]) + (s[14] + s[15]))); }
template <int MODE, bool FIXED, class AllowF>
__device__ __forceinline__ void attn_compute(const KVF8& f, const bf16x8 (&qf)[4], const f32x16& negm, bool sel, AllowF allow, AttnSt& st) {
    f32x16 s = FIXED ? negm : f32x16{};
#pragma unroll
    for (int ks = 0; ks < 4; ++ks) s = __builtin_amdgcn_mfma_f32_32x32x16_bf16(f.k[ks], qf[ks], s, 0, 0, 0);
    if (MODE == 2) {
#pragma unroll
        for (int r = 0; r < 16; ++r) if (!allow(r)) s[r] = -1e30f; }
    if (!FIXED) {
        float mt = max16(s);
        if (MODE == 1) mt = sel ? mt : -1e30f;
        mt = maxswap32_f(mt);
        if (__any(mt > st.m)) {
            const float mn = fmaxf(st.m, mt), alpha = EX2(st.m - mn);
            st.m = mn; st.l *= alpha;
#pragma unroll
            for (int dt = 0; dt < 2; ++dt)
#pragma unroll
                for (int r = 0; r < 16; ++r) st.o[dt][r] *= alpha;
        }
        const float mref = (MODE == 1 && !sel) ? 1e30f : fmaxf(st.m, -1e29f);
#pragma unroll
        for (int r = 0; r < 16; ++r) s[r] = EX2(s[r] - mref);
        st.l += sum16(s);
    } else {
#pragma unroll
        for (int r = 0; r < 16; ++r) s[r] = EX2(s[r]);
        const float ps = sum16(s);
        st.l += (MODE == 1 && !sel) ? 0.f : ps;
    }
#pragma unroll
    for (int s2 = 0; s2 < 2; ++s2) { v4u pw; pw.x = pk2(s[8 * s2], s[8 * s2 + 1]); pw.y = pk2(s[8 * s2 + 2], s[8 * s2 + 3]); pw.z = pk2(s[8 * s2 + 4], s[8 * s2 + 5]); pw.w = pk2(s[8 * s2 + 6], s[8 * s2 + 7]);
        if (FIXED && MODE == 1) { pw.x = sel ? pw.x : 0u; pw.y = sel ? pw.y : 0u; pw.z = sel ? pw.z : 0u; pw.w = sel ? pw.w : 0u; }
        const bf16x8 pf = __builtin_bit_cast(bf16x8, pw);
#pragma unroll
        for (int dt = 0; dt < 2; ++dt) st.o[dt] = __builtin_amdgcn_mfma_f32_32x32x16_bf16(dq8(f.v8[dt][2 * s2], f.v8[dt][2 * s2 + 1]), pf, st.o[dt], 0, 0, 0); }
}
constexpr int IMP_LD = 132;
__device__ __forceinline__ void nsa_item(const Frame& F, const Args& A, LAS unsigned char* lds, int b, int kvh, int tb, int wsub) {
    unsigned char* ws = A.ws;
    int lane = lane_id(); asm volatile("" : "+v"(lane));
    const int r32 = lane & 31, hi = lane >> 5, w = F.wave;
    const int t0 = 64 * tb + 8 * wsub, ti = r32 & 7, g = r32 >> 3, t = t0 + ti, cur = tb;
    const size_t rowb = (size_t)b * SEQ;
    const bf16* Z = (const bf16*)(ws + WS_Z);
    LAS float* imp = (LAS float*)lds + w * 8 * IMP_LD;
    for (int i = lane; i < 8 * IMP_LD; i += 64) imp[i] = 0.f;
    bf16x8 qf[4];
#pragma unroll
    for (int ks = 0; ks < 4; ++ks) qf[ks] = *(const bf16x8*)(Z + (rowb + t) * NZ + ZC_Q + (kvh * 4 + g) * 64 + 16 * ks + 8 * hi);
    const float* gp = (const float*)(ws + WS_GATES) + (rowb + t) * 24 + (kvh * 4 + g) * 3;
    const float gate_c = gp[0], gate_s = gp[1], gate_w = gp[2];
    LAS float* oacc = (LAS float*)(lds + 8 * 8 * IMP_LD * 4) + w * 2048 + lane;
    {
        const bf16* KC = (const bf16*)(ws + WS_KC) + (size_t)(b * 2 + kvh) * 16 * 2048;
        const bf16* VCT = (const bf16*)(ws + WS_VCT) + (size_t)(b * 2 + kvh) * 16 * 2048;
        const int nv = (t >= 31) ? ((t - 31) >> 4) + 1 : 0;
        const int tl = t0 + 7, nvmax = (tl >= 31) ? ((tl - 31) >> 4) + 1 : 0;
        const unsigned lo16 = 16u * (unsigned)lane;
        float q2c = 0.f;
#pragma unroll
        for (int ks = 0; ks < 4; ++ks) { const v4u qw = __builtin_bit_cast(v4u, qf[ks]); const unsigned ww[4] = {qw.x, qw.y, qw.z, qw.w};
#pragma unroll
            for (int k = 0; k < 4; ++k) { const float a = bflo(ww[k]), c = bfhi(ww[k]); q2c += a * a + c * c; } }
        q2c = addswap32_f(q2c);
        const float Mc = __builtin_amdgcn_sqrtf(q2c * __builtin_bit_cast(float, ((const unsigned*)(ws + WS_CTL))[CW_KMAXC + b * 2 + kvh])) * 1.0001f + 1e-3f;
        const bool fixed_c = !__any(Mc >= 60.f);
        const int nvfull = (t0 >= 31) ? ((t0 - 31) >> 4) + 1 : 0;
        float m1 = -1e30f, l1 = 0.f;
        if (fixed_c) {
            f32x16 negm;
#pragma unroll
            for (int r = 0; r < 16; ++r) negm[r] = -Mc;
            bf16x8 ka[4], kb[4];
#pragma unroll
            for (int ks = 0; ks < 4; ++ks) ka[ks] = *(const bf16x8*)((const char*)KC + lo16 + 1024 * ks);
            for (int n0 = 0; n0 < nvmax; n0 += 32) {
                if (n0 + 32 < nvmax) {
#pragma unroll
                    for (int ks = 0; ks < 4; ++ks) kb[ks] = *(const bf16x8*)((const char*)(KC + (size_t)(n0 + 32) * 64) + lo16 + 1024 * ks);
                }
                f32x16 s = negm;
#pragma unroll
                for (int ks = 0; ks < 4; ++ks) s = __builtin_amdgcn_mfma_f32_32x32x16_bf16(ka[ks], qf[ks], s, 0, 0, 0);
                float ps = 0.f;
                if (n0 + 32 <= nvfull) {
#pragma unroll
                    for (int r = 0; r < 16; ++r) ps += EX2(s[r]);
                } else {
#pragma unroll
                    for (int r = 0; r < 16; ++r) ps += (n0 + crow(r, hi) < nv) ? EX2(s[r]) : 0.f;
                }
                l1 += ps;
#pragma unroll
                for (int ks = 0; ks < 4; ++ks) ka[ks] = kb[ks];
            }
            l1 += __shfl_xor(l1, 32); m1 = Mc;
        } else {
        {
            bf16x8 ka[4], kb[4];
#pragma unroll
            for (int ks = 0; ks < 4; ++ks) ka[ks] = *(const bf16x8*)((const char*)KC + lo16 + 1024 * ks);
            for (int n0 = 0; n0 < nvmax; n0 += 32) {
                if (n0 + 32 < nvmax) {
#pragma unroll
                    for (int ks = 0; ks < 4; ++ks) kb[ks] = *(const bf16x8*)((const char*)(KC + (size_t)(n0 + 32) * 64) + lo16 + 1024 * ks);
                }
                f32x16 s = f32x16{};
#pragma unroll
                for (int ks = 0; ks < 4; ++ks) s = __builtin_amdgcn_mfma_f32_32x32x16_bf16(ka[ks], qf[ks], s, 0, 0, 0);
                float mt = -1e30f;
#pragma unroll
                for (int r = 0; r < 16; ++r) { if (n0 + crow(r, hi) >= nv) s[r] = -1e30f; mt = fmaxf(mt, s[r]); }
                const float mn = fmaxf(m1, mt); float ps = 0.f;
#pragma unroll
                for (int r = 0; r < 16; ++r) ps += (s[r] > -1e29f) ? EX2(s[r] - mn) : 0.f;
                l1 = l1 * EX2(m1 - mn) + ps; m1 = mn;
#pragma unroll
                for (int ks = 0; ks < 4; ++ks) ka[ks] = kb[ks];
            }
        }
        { const float mo = __shfl_xor(m1, 32), lo = __shfl_xor(l1, 32); const float mn = fmaxf(m1, mo); l1 = l1 * EX2(m1 - mn) + lo * EX2(mo - mn); m1 = mn; }
        }
        const float invl = (l1 > 0.f) ? 1.0f / l1 : 0.f;
        f32x16 o[2]; o[0] = f32x16{}; o[1] = f32x16{};
        KVF fa, fb;
        if (nvmax > 0) kv_load(fa, KC, VCT, lo16);
        for (int n0 = 0; n0 < nvmax; n0 += 32) {
            if (n0 + 32 < nvmax) kv_load(fb, KC + (size_t)(n0 + 32) * 64, VCT + (size_t)(n0 + 32) * 64, lo16);
            f32x16 s;
#pragma unroll
            for (int r = 0; r < 16; ++r) s[r] = fixed_c ? -m1 : 0.f;
#pragma unroll
            for (int ks = 0; ks < 4; ++ks) s = __builtin_amdgcn_mfma_f32_32x32x16_bf16(fa.k[ks], qf[ks], s, 0, 0, 0);
            if (fixed_c && n0 + 32 <= nvfull) {
#pragma unroll
                for (int r = 0; r < 16; ++r) s[r] = EX2(s[r]) * invl;
            } else {
                const float mm = fixed_c ? 0.f : m1;
#pragma unroll
                for (int r = 0; r < 16; ++r) s[r] = (n0 + crow(r, hi) < nv) ? EX2(s[r] - mm) * invl : 0.f;
            }
            float bs[4], sp[4];
#pragma unroll
            for (int q = 0; q < 4; ++q) { bs[q] = (s[4 * q] + s[4 * q + 1]) + (s[4 * q + 2] + s[4 * q + 3]); sp[q] = s[4 * q + 3];
                bs[q] += __shfl_xor(bs[q], 8); bs[q] += __shfl_xor(bs[q], 16); sp[q] += __shfl_xor(sp[q], 8); sp[q] += __shfl_xor(sp[q], 16); }
            if (r32 < 8) {
                LAS float* ip = imp + r32 * IMP_LD + (n0 >> 2) + hi;
#pragma unroll
                for (int q = 0; q < 4; ++q) ip[2 * q] += bs[q];
                asm volatile("s_waitcnt lgkmcnt(0)" ::: "memory");
#pragma unroll
                for (int q = 0; q < 4; ++q) ip[2 * q + 1] += sp[q];
                asm volatile("s_waitcnt lgkmcnt(0)" ::: "memory");
            }
#pragma unroll
            for (int s2 = 0; s2 < 2; ++s2) { v4u pw; pw.x = pk2(s[8 * s2], s[8 * s2 + 1]); pw.y = pk2(s[8 * s2 + 2], s[8 * s2 + 3]); pw.z = pk2(s[8 * s2 + 4], s[8 * s2 + 5]); pw.w = pk2(s[8 * s2 + 6], s[8 * s2 + 7]);
                const bf16x8 pf = __builtin_bit_cast(bf16x8, pw);
#pragma unroll
                for (int dt = 0; dt < 2; ++dt) o[dt] = __builtin_amdgcn_mfma_f32_32x32x16_bf16(fa.v[dt][s2], pf, o[dt], 0, 0, 0); }
            if (n0 + 32 < nvmax) fa = fb;
        }
#pragma unroll
        for (int dt = 0; dt < 2; ++dt)
#pragma unroll
            for (int r = 0; r < 16; ++r) oacc[(dt * 16 + r) * 64] = gate_c * o[dt][r];
    }
    asm volatile("s_waitcnt lgkmcnt(0)" ::: "memory");
    unsigned mym[4] = {0u, 0u, 0u, 0u}, un[4] = {0u, 0u, 0u, 0u};
    if (cur < 16) { const unsigned mk = (2u << cur) - 1u; mym[0] = mk; un[0] = mk; }
    else {
        const int tq = lane >> 3, sub = lane & 7;
        int key[16];
#pragma unroll
        for (int i = 0; i < 16; ++i) { const int j = 16 * sub + i; const float v = imp[tq * IMP_LD + j];
            key[i] = (j >= 1 && j <= cur - 2) ? (int)((__builtin_bit_cast(unsigned, v) & ~0x7fu) | (unsigned)(127 - j)) : 0; }
        sort16_desc(key);
        { int ot[16];
#pragma unroll
          for (int i = 0; i < 16; ++i) ot[i] = __builtin_amdgcn_mov_dpp(key[i], 0xB1, 0xf, 0xf, true);
          merge16_desc(key, ot);
#pragma unroll
          for (int i = 0; i < 16; ++i) ot[i] = __builtin_amdgcn_mov_dpp(key[i], 0x4E, 0xf, 0xf, true);
          merge16_desc(key, ot);
#pragma unroll
          for (int i = 0; i < 16; ++i) ot[i] = __builtin_amdgcn_mov_dpp(key[i], 0x141, 0xf, 0xf, true);
          merge16_desc(key, ot); }
        unsigned mk[4] = {1u, 0u, 0u, 0u};
        { const int c1 = cur - 1; if (c1 < 32) mk[0] |= 1u << c1; else if (c1 < 64) mk[1] |= 1u << (c1 - 32); else if (c1 < 96) mk[2] |= 1u << (c1 - 64); else mk[3] |= 1u << (c1 - 96);
          if (cur < 32) mk[0] |= 1u << cur; else if (cur < 64) mk[1] |= 1u << (cur - 32); else if (cur < 96) mk[2] |= 1u << (cur - 64); else mk[3] |= 1u << (cur - 96); }
#pragma unroll
        for (int i = 0; i < 13; ++i) { const int j = 127 - (key[i] & 0x7f); const unsigned bit = (key[i] != 0) ? (1u << (j & 31)) : 0u; const int wd = j >> 5;
            mk[0] |= (wd == 0) ? bit : 0u; mk[1] |= (wd == 1) ? bit : 0u; mk[2] |= (wd == 2) ? bit : 0u; mk[3] |= (wd == 3) ? bit : 0u; }
#pragma unroll
        for (int i = 0; i < 4; ++i) { unsigned u = mk[i]; u |= (unsigned)__shfl_xor((int)u, 8); u |= (unsigned)__shfl_xor((int)u, 16); u |= (unsigned)__shfl_xor((int)u, 32); un[i] = u;
            mym[i] = (unsigned)__shfl((int)mk[i], 8 * ti); }
    }
    float q2 = 0.f;
#pragma unroll
    for (int ks = 0; ks < 4; ++ks) { const v4u qw = __builtin_bit_cast(v4u, qf[ks]); const unsigned ww[4] = {qw.x, qw.y, qw.z, qw.w};
#pragma unroll
        for (int k = 0; k < 4; ++k) { const float a = bflo(ww[k]), c = bfhi(ww[k]); q2 += a * a + c * c; } }
    q2 = addswap32_f(q2);
    const unsigned* KMX = (const unsigned*)(ws + WS_CTL) + CW_KMAX + (b * 2 + kvh) * 4;
    const float Ms = __builtin_amdgcn_sqrtf(q2 * (__builtin_bit_cast(float, KMX[0]) + __builtin_bit_cast(float, KMX[1]))) * 1.0001f + 1e-3f, Mw = __builtin_amdgcn_sqrtf(q2 * (__builtin_bit_cast(float, KMX[2]) + __builtin_bit_cast(float, KMX[3]))) * 1.0001f + 1e-3f;
    const bool fixed_ok = !__any(Ms >= 60.f || Mw >= 60.f);
    {
        AttnSt st; st.m = -1e30f; st.l = 0.f; st.o[0] = f32x16{}; st.o[1] = f32x16{};
        const bf16* KS = (const bf16*)(ws + WS_KSF) + (size_t)(b * 2 + kvh) * 256 * 2048; const unsigned char* VS = ws + WS_VSF + (size_t)(b * 2 + kvh) * 256 * 2048;
        const unsigned lo16 = 16u * (unsigned)lane;
        unsigned um0 = (unsigned)__builtin_amdgcn_readfirstlane((int)un[0]), um1 = (unsigned)__builtin_amdgcn_readfirstlane((int)un[1]), um2 = (unsigned)__builtin_amdgcn_readfirstlane((int)un[2]), um3 = (unsigned)__builtin_amdgcn_readfirstlane((int)un[3]);
#define NEXT_BLOCK(jv) do { if (um0) { jv = __builtin_ctz(um0); um0 &= um0 - 1u; } else if (um1) { jv = 32 + __builtin_ctz(um1); um1 &= um1 - 1u; } else if (um2) { jv = 64 + __builtin_ctz(um2); um2 &= um2 - 1u; } \
            else if (um3) { jv = 96 + __builtin_ctz(um3); um3 &= um3 - 1u; } else jv = -1; } while (0)
#define SLC_LOOP(FX) do { f32x16 negm; _Pragma("unroll") for (int r = 0; r < 16; ++r) negm[r] = -Ms; \
        KVF8 fa, fb; int j; NEXT_BLOCK(j); \
        if (j >= 0) kv_load8(fa, KS + (size_t)j * 4096, VS + (size_t)j * 4096, lo16); \
        while (j >= 0) { const int key0 = j * 64; \
            const unsigned mw = (j < 32) ? mym[0] : (j < 64) ? mym[1] : (j < 96) ? mym[2] : mym[3]; const bool sel = (mw >> (j & 31)) & 1u; \
            kv_load8(fb, KS + (size_t)j * 4096 + 2048, VS + (size_t)j * 4096 + 2048, lo16); \
            if (j == cur) attn_compute<2, FX>(fa, qf, negm, sel, [&](int r) { return sel && (key0 + crow(r, hi) <= t); }, st); \
            else attn_compute<1, FX>(fa, qf, negm, sel, [&](int) { return true; }, st); \
            int jn; NEXT_BLOCK(jn); \
            if (jn >= 0) kv_load8(fa, KS + (size_t)jn * 4096, VS + (size_t)jn * 4096, lo16); \
            if (j == cur) attn_compute<2, FX>(fb, qf, negm, sel, [&](int r) { return sel && (key0 + 32 + crow(r, hi) <= t); }, st); \
            else attn_compute<1, FX>(fb, qf, negm, sel, [&](int) { return true; }, st); \
            j = jn; } } while (0)
        if (fixed_ok) SLC_LOOP(true); else SLC_LOOP(false);
#undef SLC_LOOP
#undef NEXT_BLOCK
        const float l = addswap32_f(st.l); const float sc = gate_s / l;
#pragma unroll
        for (int dt = 0; dt < 2; ++dt)
#pragma unroll
            for (int r = 0; r < 16; ++r) oacc[(dt * 16 + r) * 64] += sc * st.o[dt][r];
    }
    f32x16 outv[2];
    {
        AttnSt st; st.m = -1e30f; st.l = 0.f; st.o[0] = f32x16{}; st.o[1] = f32x16{};
        const bf16* KW = (const bf16*)(ws + WS_KWF) + (size_t)(b * 2 + kvh) * 256 * 2048; const unsigned char* VW = ws + WS_VWF + (size_t)(b * 2 + kvh) * 256 * 2048;
        const unsigned lo16 = 16u * (unsigned)lane;
        const int klo = (t0 - 511 > 0) ? ((t0 - 511) & ~31) : 0, khi = (t0 + 7) & ~31;
#define WIN_LOOP(FX) do { f32x16 negm; _Pragma("unroll") for (int r = 0; r < 16; ++r) negm[r] = -Mw; \
        KVF8 fa, fb; kv_load8(fa, KW + (size_t)klo * 64, VW + (size_t)klo * 64, lo16); \
        _Pragma("unroll 1") for (int key0 = klo; key0 <= khi; key0 += 32) { \
            if (key0 + 32 <= khi) kv_load8(fb, KW + (size_t)(key0 + 32) * 64, VW + (size_t)(key0 + 32) * 64, lo16); \
            if (key0 + 31 > t0 || key0 <= t0 + 7 - 512) attn_compute<2, FX>(fa, qf, negm, true, [&](int r) { const int kp = key0 + crow(r, hi); return kp <= t && kp > t - 512; }, st); \
            else attn_compute<0, FX>(fa, qf, negm, true, [&](int) { return true; }, st); \
            if (key0 + 32 <= khi) fa = fb; } } while (0)
        if (fixed_ok) WIN_LOOP(true); else WIN_LOOP(false);
#undef WIN_LOOP
        const float l = addswap32_f(st.l); const float sc = gate_w / l;
#pragma unroll
        for (int dt = 0; dt < 2; ++dt)
#pragma unroll
            for (int r = 0; r < 16; ++r) outv[dt][r] = oacc[(dt * 16 + r) * 64] + sc * st.o[dt][r];
    }
    float ss = 0.f;
#pragma unroll
    for (int dt = 0; dt < 2; ++dt)
#pragma unroll
        for (int r = 0; r < 16; ++r) ss += outv[dt][r] * outv[dt][r];
    ss += __shfl_xor(ss, 32); ss += __shfl_xor(ss, 8); ss += __shfl_xor(ss, 16);
    if (lane < 8) ((float*)(ws + WS_SSQN))[(rowb + t0 + lane) * 2 + kvh] = ss;
    bf16* Yp = (bf16*)(ws + WS_Y) + (rowb + t) * DM + (kvh * 4 + g) * 64 + 4 * hi;
#pragma unroll
    for (int dt = 0; dt < 2; ++dt)
#pragma unroll
        for (int q = 0; q < 4; ++q) { v2u o; o.x = pk2(outv[dt][4 * q], outv[dt][4 * q + 1]); o.y = pk2(outv[dt][4 * q + 2], outv[dt][4 * q + 3]); *(v2u*)(Yp + 32 * dt + 8 * q) = o; }
}
__device__ __forceinline__ void memattn_block(const Frame& F, const Args& A, LAS unsigned char* lds, int item) {
    unsigned char* ws = A.ws;
    const int lane = F.lane, r32 = lane & 31, hi = lane >> 5, w = F.wave;
    const int h = item & 3, tg = item >> 2, b = tg >> 5, tile = tg * 8 + w; const size_t row0 = (size_t)tile * 32;
    const bf16* Q = (const bf16*)(ws + WS_QM) + (size_t)tile * 32 * DM + (size_t)(h * 16) * 512 + 8 * lane;
    { const char* Kg = (const char*)((const bf16*)(ws + WS_MEMK) + (size_t)(b * 8 + w) * 32 * DM + (size_t)(h * 16) * 512) + 16 * lane;
#pragma unroll
      for (int j = 0; j < 16; ++j) __builtin_amdgcn_global_load_lds((const unsigned*)(Kg + j * 1024), (LAS unsigned*)(lds + (w * 16 + j) * 1024), 16, 0, 0); }
    f32x16 s[8];
#pragma unroll
    for (int kt = 0; kt < 8; ++kt) s[kt] = f32x16{};
    const LAS unsigned char* lf = lds + 16 * lane;
    asm volatile("s_waitcnt vmcnt(0)" ::: "memory");
    __syncthreads();
#define QK_LOAD(qv, kv, ks_) do { const int kk_ = (ks_) < 16 ? (ks_) : 15; qv = __builtin_nontemporal_load((const bf16x8*)(Q + 512 * kk_)); _Pragma("unroll") for (int kt = 0; kt < 8; ++kt) kv[kt] = *(const LAS bf16x8*)(lf + (kt * 16 + kk_) * 1024); } while (0)
#define QK_MMA(qv, kv) do { _Pragma("unroll") for (int kt = 0; kt < 8; ++kt) s[kt] = __builtin_amdgcn_mfma_f32_32x32x16_bf16(kv[kt], qv, s[kt], 0, 0, 0); } while (0)
    { bf16x8 qa, qb, ka[8], kb[8];
      QK_LOAD(qa, ka, 0);
#pragma unroll 1
      for (int ks = 0; ks < 16; ks += 2) {
          QK_LOAD(qb, kb, ks + 1); asm volatile("" ::: "memory");
          QK_MMA(qa, ka);
          QK_LOAD(qa, ka, ks + 2); asm volatile("" ::: "memory");
          QK_MMA(qb, kb); } }
#undef QK_LOAD
#undef QK_MMA
    asm volatile("s_waitcnt vmcnt(0) lgkmcnt(0)" ::: "memory");
    __syncthreads();
    { const char* Vg = (const char*)((const bf16*)(ws + WS_MEMVT) + (size_t)((b * 4 + h) * 8 + w) * 8192) + 16 * lane;
#pragma unroll
      for (int j = 0; j < 16; ++j) __builtin_amdgcn_global_load_lds((const unsigned*)(Vg + j * 1024), (LAS unsigned*)(lds + (w * 16 + j) * 1024), 16, 0, 0); }
    float m = -1e30f;
#pragma unroll
    for (int kt = 0; kt < 8; ++kt) m = fmaxf(m, max16(s[kt]));
    m = maxswap32_f(m);
    float l = 0.f; v4u pw[8][2];
#pragma unroll
    for (int kt = 0; kt < 8; ++kt) {
#pragma unroll
        for (int r = 0; r < 16; ++r) s[kt][r] = EX2(s[kt][r] - m);
        l += sum16(s[kt]);
#pragma unroll
        for (int s2 = 0; s2 < 2; ++s2) { pw[kt][s2].x = pk2(s[kt][8 * s2], s[kt][8 * s2 + 1]); pw[kt][s2].y = pk2(s[kt][8 * s2 + 2], s[kt][8 * s2 + 3]); pw[kt][s2].z = pk2(s[kt][8 * s2 + 4], s[kt][8 * s2 + 5]); pw[kt][s2].w = pk2(s[kt][8 * s2 + 6], s[kt][8 * s2 + 7]); } }
    l = addswap32_f(l);
    const float invl = 1.0f / l;
    bf16* O = (bf16*)(ws + WS_OM) + (row0 + r32) * DM + h * 256 + 4 * hi;
    asm volatile("s_waitcnt vmcnt(0)" ::: "memory");
    __syncthreads();
#define PV_LOAD(vv, dt_) do { const int dd_ = (dt_) < 8 ? (dt_) : 7; _Pragma("unroll") for (int kt = 0; kt < 8; ++kt) _Pragma("unroll") for (int s2 = 0; s2 < 2; ++s2) vv[2 * kt + s2] = *(const LAS bf16x8*)(lf + (kt * 16 + dd_ * 2 + s2) * 1024); } while (0)
#define PV_MMA(vv, dt_) do { f32x16 o = f32x16{}; _Pragma("unroll") for (int kt = 0; kt < 8; ++kt) _Pragma("unroll") for (int s2 = 0; s2 < 2; ++s2) o = __builtin_amdgcn_mfma_f32_32x32x16_bf16(vv[2 * kt + s2], __builtin_bit_cast(bf16x8, pw[kt][s2]), o, 0, 0, 0); \
        _Pragma("unroll") for (int q = 0; q < 4; ++q) { v2u ov; ov.x = pk2(o[4 * q] * invl, o[4 * q + 1] * invl); ov.y = pk2(o[4 * q + 2] * invl, o[4 * q + 3] * invl); *(v2u*)(O + 32 * (dt_) + 8 * q) = ov; } } while (0)
    { bf16x8 va[16], vb[16];
      PV_LOAD(va, 0);
#pragma unroll 1
      for (int dt = 0; dt < 8; dt += 2) {
          PV_LOAD(vb, dt + 1); asm volatile("" ::: "memory");
          PV_MMA(va, dt);
          PV_LOAD(va, dt + 2); asm volatile("" ::: "memory");
          PV_MMA(vb, dt + 1); } }
#undef PV_LOAD
#undef PV_MMA
    asm volatile("s_waitcnt lgkmcnt(0)" ::: "memory");
    __syncthreads();
}

__device__ __forceinline__ void memattn_fused(const Frame& F, const Args& A, LAS unsigned char* lds, int tg, int h) {
    unsigned char* ws = A.ws;
    const int lane = F.lane, r32 = lane & 31, hi = lane >> 5, w = F.wave;
    const int b = tg >> 5, tile = tg * 8 + w; const size_t row0 = (size_t)tile * 32;
    const LAS unsigned char* lf = lds + 16 * lane;
    __syncthreads();
    bf16x8 qf[16];
#pragma unroll
    for (int ks = 0; ks < 16; ++ks) qf[ks] = *(const LAS bf16x8*)(lf + (w * 16 + ks) * 1024);
    asm volatile("s_waitcnt lgkmcnt(0)" ::: "memory");
    __syncthreads();
    { const char* Kg = (const char*)((const bf16*)(ws + WS_MEMK) + (size_t)(b * 8 + w) * 32 * DM + (size_t)(h * 16) * 512) + 16 * lane;
#pragma unroll
      for (int j = 0; j < 16; ++j) __builtin_amdgcn_global_load_lds((const unsigned*)(Kg + j * 1024), (LAS unsigned*)(lds + (w * 16 + j) * 1024), 16, 0, 0); }
    f32x16 s[8];
#pragma unroll
    for (int kt = 0; kt < 8; ++kt) s[kt] = f32x16{};
    asm volatile("s_waitcnt vmcnt(0)" ::: "memory");
    __syncthreads();
#pragma unroll
    for (int half = 0; half < 2; ++half) {
        bf16x8 ka[4], kb[4];
#pragma unroll
        for (int i = 0; i < 4; ++i) ka[i] = *(const LAS bf16x8*)(lf + ((4 * half + i) * 16 + 0) * 1024);
#pragma unroll
        for (int ks = 0; ks < 16; ks += 2) {
#pragma unroll
            for (int i = 0; i < 4; ++i) kb[i] = *(const LAS bf16x8*)(lf + ((4 * half + i) * 16 + ks + 1) * 1024);
#pragma unroll
            for (int i = 0; i < 4; ++i) s[4 * half + i] = __builtin_amdgcn_mfma_f32_32x32x16_bf16(ka[i], qf[ks], s[4 * half + i], 0, 0, 0);
            if (ks + 2 < 16) {
#pragma unroll
                for (int i = 0; i < 4; ++i) ka[i] = *(const LAS bf16x8*)(lf + ((4 * half + i) * 16 + ks + 2) * 1024); }
#pragma unroll
            for (int i = 0; i < 4; ++i) s[4 * half + i] = __builtin_amdgcn_mfma_f32_32x32x16_bf16(kb[i], qf[ks + 1], s[4 * half + i], 0, 0, 0);
        }
    }
    asm volatile("s_waitcnt vmcnt(0) lgkmcnt(0)" ::: "memory");
    __syncthreads();
    { const char* Vg = (const char*)((const bf16*)(ws + WS_MEMVT) + (size_t)((b * 4 + h) * 8 + w) * 8192) + 16 * lane;
#pragma unroll
      for (int j = 0; j < 16; ++j) __builtin_amdgcn_global_load_lds((const unsigned*)(Vg + j * 1024), (LAS unsigned*)(lds + (w * 16 + j) * 1024), 16, 0, 0); }
    float m = -1e30f;
#pragma unroll
    for (int kt = 0; kt < 8; ++kt) m = fmaxf(m, max16(s[kt]));
    m = maxswap32_f(m);
    float l = 0.f; v4u pw[8][2];
#pragma unroll
    for (int kt = 0; kt < 8; ++kt) {
#pragma unroll
        for (int r = 0; r < 16; ++r) s[kt][r] = EX2(s[kt][r] - m);
        l += sum16(s[kt]);
#pragma unroll
        for (int s2 = 0; s2 < 2; ++s2) { pw[kt][s2].x = pk2(s[kt][8 * s2], s[kt][8 * s2 + 1]); pw[kt][s2].y = pk2(s[kt][8 * s2 + 2], s[kt][8 * s2 + 3]); pw[kt][s2].z = pk2(s[kt][8 * s2 + 4], s[kt][8 * s2 + 5]); pw[kt][s2].w = pk2(s[kt][8 * s2 + 6], s[kt][8 * s2 + 7]); } }
    l = addswap32_f(l);
    const float invl = 1.0f / l;
    bf16* O = (bf16*)(ws + WS_OM) + (row0 + r32) * DM + h * 256 + 8 * hi;
    asm volatile("s_waitcnt vmcnt(0)" ::: "memory");
    __syncthreads();
#define PV_LOAD(vv, dt_) do { const int dd_ = (dt_) < 8 ? (dt_) : 7; _Pragma("unroll") for (int kt = 0; kt < 8; ++kt) _Pragma("unroll") for (int s2 = 0; s2 < 2; ++s2) vv[2 * kt + s2] = *(const LAS bf16x8*)(lf + (kt * 16 + dd_ * 2 + s2) * 1024); } while (0)
#define PV_MMA(vv, dt_) do { f32x16 o = f32x16{}; _Pragma("unroll") for (int kt = 0; kt < 8; ++kt) _Pragma("unroll") for (int s2 = 0; s2 < 2; ++s2) o = __builtin_amdgcn_mfma_f32_32x32x16_bf16(vv[2 * kt + s2], __builtin_bit_cast(bf16x8, pw[kt][s2]), o, 0, 0, 0); \
        _Pragma("unroll") for (int p = 0; p < 2; ++p) { unsigned ax = pk2(o[8 * p] * invl, o[8 * p + 1] * invl), ay = pk2(o[8 * p + 2] * invl, o[8 * p + 3] * invl), bx = pk2(o[8 * p + 4] * invl, o[8 * p + 5] * invl), by = pk2(o[8 * p + 6] * invl, o[8 * p + 7] * invl); \
            swap32(ax, bx); swap32(ay, by); *(v4u*)(O + 32 * (dt_) + 16 * p) = (v4u){ax, ay, bx, by}; } } while (0)
    { bf16x8 va[16], vb[16];
      PV_LOAD(va, 0);
#pragma unroll 1
      for (int dt = 0; dt < 8; dt += 2) {
          PV_LOAD(vb, dt + 1); asm volatile("" ::: "memory");
          PV_MMA(va, dt);
          PV_LOAD(va, dt + 2); asm volatile("" ::: "memory");
          PV_MMA(vb, dt + 1); } }
#undef PV_LOAD
#undef PV_MMA
    asm volatile("s_waitcnt lgkmcnt(0)" ::: "memory");
    __syncthreads();
}

__device__ __forceinline__ int f2key(float f) { const int u = __builtin_bit_cast(int, f); return u ^ ((u >> 31) & 0x7fffffff); }
__device__ __forceinline__ float key2f(int k) { const int u = k ^ ((k >> 31) & 0x7fffffff); return __builtin_bit_cast(float, u); }
__device__ __forceinline__ void top16_of_128(f32x16 (&s)[4], int hi, int (&kv)[16]) {
    int key[4][16];
#pragma unroll
    for (int nt = 0; nt < 4; ++nt)
#pragma unroll
        for (int r = 0; r < 16; ++r) key[nt][r] = (f2key(s[nt][r]) & ~0x7f) | (127 - (32 * nt + crow(r, hi)));
#pragma unroll
    for (int nt = 0; nt < 4; ++nt) sort16_desc(key[nt]);
    merge16_desc(key[0], key[1]); merge16_desc(key[2], key[3]); merge16_desc(key[0], key[2]);
    unsigned a[16], b[16];
#pragma unroll
    for (int i = 0; i < 16; ++i) { a[i] = (unsigned)key[0][i]; b[i] = a[i]; swap32(a[i], b[i]); }
#pragma unroll
    for (int i = 0; i < 16; ++i) kv[i] = max((int)a[i], (int)b[15 - i]);
    bitonic16_desc(kv);
}
template <bool LDSK, bool FUSED = false>
__device__ __forceinline__ void peer_topk_item(const Frame& F, const Args& A, int item, const LAS unsigned char* lds, const bf16x8* qA = nullptr) {
    unsigned char* ws = A.ws;
    int lane = lane_id(); asm volatile("" : "+v"(lane));
    const int r32 = lane & 31, hi = lane >> 5;
    const int h = item & 7, tile = item >> 3; const size_t row = (size_t)tile * 32 + r32;
    const bf16* QP = (const bf16*)(ws + WS_QP) + (size_t)tile * 32 * 2048 + (size_t)(h * 16) * 512 + 8 * lane;
    int k1[16], k2[16];
#pragma unroll
    for (int i = 0; i < 16; ++i) { k1[i] = 0; k2[i] = 0; }
#pragma unroll 1
    for (int c = 0; c < 2; ++c) {
        if (FUSED && c == 1) asm volatile("s_waitcnt lgkmcnt(0)" ::: "memory");
        const bf16* SK = (const bf16*)(ws + WS_SKEY) + (size_t)((h * 2 + c) * 4) * 4096 + 8 * lane;
        f32x16 s[4];
#pragma unroll
        for (int nt = 0; nt < 4; ++nt) s[nt] = f32x16{};
        bf16x8 qf[8];
        if (FUSED) {
            if (c == 0) {
#pragma unroll
                for (int ks = 0; ks < 8; ++ks) qf[ks] = qA[ks];
            } else {
#pragma unroll
                for (int ks = 0; ks < 8; ++ks) qf[ks] = *(const LAS bf16x8*)(lds + 65536 + F.wave * 8448 + ks * 1024 + lane * 16);
            }
        } else {
#pragma unroll
            for (int ks = 0; ks < 8; ++ks) qf[ks] = __builtin_nontemporal_load((const bf16x8*)(QP + (size_t)(c * 8 + ks) * 512));
        }
#pragma unroll
        for (int ks = 0; ks < 8; ++ks) {
#pragma unroll
            for (int nt = 0; nt < 4; ++nt) { const bf16x8 kf = LDSK ? *(const LAS bf16x8*)(lds + ((c * 4 + nt) * 4096 + ks * 512) * 2 + lane * 16) : *(const bf16x8*)(SK + (size_t)nt * 4096 + ks * 512);
                s[nt] = __builtin_amdgcn_mfma_f32_32x32x16_bf16(kf, qf[ks], s[nt], 0, 0, 0); } }
        if (c == 0) top16_of_128(s, hi, k1); else top16_of_128(s, hi, k2);
    }
    float v1[16], v2[16];
#pragma unroll
    for (int i = 0; i < 16; ++i) { v1[i] = key2f(k1[i] & ~0x7f); v2[i] = key2f(k2[i] & ~0x7f); }
    int ck[32];
    {
        int idx = 0;
#pragma unroll
        for (int i = 0; i < 32; ++i) ck[i] = (int)0x80000000;
#pragma unroll
        for (int a = 0; a < 16; ++a)
#pragma unroll
            for (int bq = 0; bq < 16; ++bq) if ((a + 1) * (bq + 1) <= 16) {
                const int flat = a * 16 + bq; const int kk = (f2key(v1[a] + v2[bq]) & ~0xff) | (255 - flat);
                if ((idx & 1) == hi) ck[idx >> 1] = kk;
                ++idx; }
    }
    sort32_desc(ck);
    int tk[16];
    { unsigned a[16], b[16];
#pragma unroll
      for (int i = 0; i < 16; ++i) { a[i] = (unsigned)ck[i]; b[i] = a[i]; swap32(a[i], b[i]); }
#pragma unroll
      for (int i = 0; i < 16; ++i) tk[i] = max((int)a[i], (int)b[15 - i]);
      bitonic16_desc(tk); }
    int te[16];
    { LAS int* tab = (LAS int*)(lds + 65536 + F.wave * 8448) + lane * 33;
#pragma unroll
      for (int i = 0; i < 16; ++i) { tab[i] = 127 - (k1[i] & 0x7f); tab[16 + i] = 127 - (k2[i] & 0x7f); }
      asm volatile("s_waitcnt lgkmcnt(0)" ::: "memory");
#pragma unroll
      for (int i = 0; i < 16; ++i) { const int flat = 255 - (tk[i] & 0xff); te[i] = tab[flat >> 4] * 128 + tab[16 + (flat & 15)]; }
      asm volatile("s_waitcnt lgkmcnt(0)" ::: "memory"); }
    float gsm[16]; const float mx = key2f(tk[0] & ~0xff); float den = 0.f;
#pragma unroll
    for (int i = 0; i < 16; ++i) { gsm[i] = __expf(key2f(tk[i] & ~0xff) - mx); den += gsm[i]; }
    const float inv = 1.0f / den;
    if (hi == 0) {
        int* EID = (int*)(ws + WS_EID) + row * 128 + h * 16; float* GW = (float*)(ws + WS_GW) + row * 128 + h * 16;
#pragma unroll
        for (int q = 0; q < 4; ++q) { *(v4u*)(EID + 4 * q) = (v4u){(unsigned)te[4 * q], (unsigned)te[4 * q + 1], (unsigned)te[4 * q + 2], (unsigned)te[4 * q + 3]};
            *(f32x4*)(GW + 4 * q) = (f32x4){gsm[4 * q] * inv, gsm[4 * q + 1] * inv, gsm[4 * q + 2] * inv, gsm[4 * q + 3] * inv}; }
    }
}

typedef float f32x2 __attribute__((ext_vector_type(2)));
__device__ __forceinline__ float dot16_fp8(const v4u u, const unsigned (&xw)[8]) {
    typedef __bf16 bf2_ __attribute__((ext_vector_type(2)));
    float a0 = 0.f;
#pragma unroll
    for (int j = 0; j < 4; ++j) { const bf2_ p0 = __builtin_amdgcn_cvt_scalef32_pk_bf16_fp8(u[j], 1.0f, false), p1 = __builtin_amdgcn_cvt_scalef32_pk_bf16_fp8(u[j], 1.0f, true);
        a0 = __builtin_amdgcn_fdot2_f32_bf16(p0, __builtin_bit_cast(bf2_, xw[2 * j]), a0, false); a0 = __builtin_amdgcn_fdot2_f32_bf16(p1, __builtin_bit_cast(bf2_, xw[2 * j + 1]), a0, false); }
    return a0;
}
template <int SEL> __device__ __forceinline__ void axpy16_fp8(f32x2 (&acc)[8], const f32x2 wp, const v4u u) {
#pragma unroll
    for (int j = 0; j < 4; ++j) { const f32x2 lo = __builtin_amdgcn_cvt_pk_f32_fp8((int)u[j], false), hi = __builtin_amdgcn_cvt_pk_f32_fp8((int)u[j], true);
        if (SEL == 0) { asm("v_pk_fma_f32 %0, %1, %2, %0 op_sel_hi:[1,0,1]" : "+v"(acc[2 * j]) : "v"(lo), "v"(wp)); asm("v_pk_fma_f32 %0, %1, %2, %0 op_sel_hi:[1,0,1]" : "+v"(acc[2 * j + 1]) : "v"(hi), "v"(wp)); }
        else { asm("v_pk_fma_f32 %0, %1, %2, %0 op_sel:[0,1,0] op_sel_hi:[1,1,1]" : "+v"(acc[2 * j]) : "v"(lo), "v"(wp)); asm("v_pk_fma_f32 %0, %1, %2, %0 op_sel:[0,1,0] op_sel_hi:[1,1,1]" : "+v"(acc[2 * j + 1]) : "v"(hi), "v"(wp)); } }
}
#define TIE_ROW(val, nxt) asm volatile("" : "+v"(val), "+v"((nxt).x), "+v"((nxt).y), "+v"((nxt).z), "+v"((nxt).w))
constexpr int PQ_CHUNK = 128, PQ_NCHUNK = MTOK / PQ_CHUNK;
constexpr int CW_NQ = 10240;
constexpr int CW_PQ = 8192;
__device__ __forceinline__ int pq_pop(unsigned* ctl, int pass, int own, int& q_s, LAS int* bc, int wave) {
    __syncthreads();
    if (wave == 0 && lane_id() == 0) { int res = -1; int s = q_s;
        while (s < 8) { const int x = (own + s) & 7; const unsigned c = __hip_atomic_fetch_add(ctl + CW_PQ + 64 * (8 * pass + x), 1u, __ATOMIC_RELAXED, __HIP_MEMORY_SCOPE_AGENT);
            if (c < (unsigned)PQ_NCHUNK) { res = x * PQ_NCHUNK + (int)c; break; } ++s; }
        bc[0] = res; bc[1] = s; }
    __syncthreads();
    q_s = bc[1]; return bc[0];
}
#define PQ_TICKET(pass_, own_, qs_) (((qs_) < 8 && F.wave == 0 && lane_id() == 0) ? __hip_atomic_fetch_add(ctl + CW_PQ + 64 * (8 * (pass_) + (((own_) + (qs_)) & 7)), 1u, __ATOMIC_RELAXED, __HIP_MEMORY_SCOPE_AGENT) : 0u)
__device__ __forceinline__ int pq_resolve(unsigned* ctl, int pass, int own, int& q_s, unsigned ticket, LAS int* bc, int wave) {
    if (wave == 0 && lane_id() == 0) { int res = -1; int s = q_s;
        if (s < 8) { if (ticket < (unsigned)PQ_NCHUNK) res = ((own + s) & 7) * PQ_NCHUNK + (int)ticket;
                     else { ++s; while (s < 8) { const int x = (own + s) & 7; const unsigned c = __hip_atomic_fetch_add(ctl + CW_PQ + 64 * (8 * pass + x), 1u, __ATOMIC_RELAXED, __HIP_MEMORY_SCOPE_AGENT);
                                if (c < (unsigned)PQ_NCHUNK) { res = x * PQ_NCHUNK + (int)c; break; } ++s; } } }
        bc[0] = res; bc[1] = s; }
    __syncthreads();
    q_s = bc[1]; return bc[0];
}
template <int CTRL> __device__ __forceinline__ float dppf(float v) { return __builtin_bit_cast(float, __builtin_amdgcn_mov_dpp(__builtin_bit_cast(int, v), CTRL, 0xf, 0xf, true)); }
__device__ __forceinline__ float red8(float d) { d += dppf<0xB1>(d); d += dppf<0x4E>(d); d += dppf<0x141>(d); return d; }
__device__ __forceinline__ float rs8(const float (&d)[8], int c8) {
    const bool h4 = (c8 & 4) != 0, h2 = (c8 & 2) != 0, h1 = (c8 & 1) != 0;
    float v[4], w[2];
#pragma unroll
    for (int i = 0; i < 4; ++i) { const float s = h4 ? d[4 + i] : d[i], o = h4 ? d[i] : d[4 + i]; v[i] = s + dppf<0x141>(o); }
#pragma unroll
    for (int k = 0; k < 2; ++k) { const float s = h2 ? v[2 + k] : v[k], o = h2 ? v[k] : v[2 + k]; w[k] = s + dppf<0x4E>(o); }
    return (h1 ? w[1] : w[0]) + dppf<0xB1>(h1 ? w[0] : w[1]);
}
__device__ __forceinline__ void peer_issue8(v4u (&rb)[8], const v4u ia, const v4u ib, const unsigned char* T  , unsigned c16) {
    const unsigned e[8] = {ia.x, ia.y, ia.z, ia.w, ib.x, ib.y, ib.z, ib.w};
#pragma unroll
    for (int i = 0; i < 8; ++i) rb[i] = *(const v4u*)(T + (e[i] * 128u + c16));
}
constexpr int PS_ROW = 528, PS_WAVE = 2 * 16 * PS_ROW;
__device__ __forceinline__ void peer_stage16(LAS unsigned char* st, const unsigned char* src  , int lane) {
    v4u e[8];
#pragma unroll
    for (int j = 0; j < 8; ++j) e[j] = __builtin_nontemporal_load((const v4u*)(src + (unsigned)(j * 1024 + lane * 16)));
#pragma unroll
    for (int j = 0; j < 8; ++j) *(LAS v4u*)(st + (2 * j + (lane >> 5)) * PS_ROW + (lane & 31) * 16) = e[j];
}
__device__ __forceinline__ void peer_u_chunk(const Frame& F, const Args& A, LAS unsigned char* lds, int x, int chunk) {
    unsigned char* ws = A.ws; int lane = lane_id(); asm volatile("" : "+v"(lane));
    const int tk = lane >> 3, c8 = lane & 7;
    const unsigned char* U = ws + WS_U8 + (size_t)x * 16384 * 128; const unsigned c16 = 16u * (unsigned)c8;
    LAS unsigned char* st = lds + F.wave * PS_WAVE;
    peer_stage16(st, ws + WS_EID + (size_t)(chunk * PQ_CHUNK + F.wave * 16) * 512, lane);
#pragma unroll 1
    for (int oc = 0; oc < 2; ++oc) {
        const unsigned row = (unsigned)(chunk * PQ_CHUNK + F.wave * 16 + oc * 8 + tk);
        const LAS unsigned char* est = st + (oc * 8 + tk) * PS_ROW;
#define EID_LD(i_) (*(const LAS v4u*)(est + 16 * (i_)))
        unsigned xn[8];
        { const unsigned char* xb_ = ws + WS_XN; const unsigned xo = row * 2048u + 256u * (unsigned)x + 32u * (unsigned)c8; const v4u xa = *(const v4u*)(xb_ + xo), xb = *(const v4u*)(xb_ + (xo + 16u));
          xn[0] = xa.x; xn[1] = xa.y; xn[2] = xa.z; xn[3] = xa.w; xn[4] = xb.x; xn[5] = xb.y; xn[6] = xb.z; xn[7] = xb.w; }
        float rstd; { const f32x4* sp = (const f32x4*)(ws + WS_SSQ2 + (size_t)row * 64); const f32x4 a = sp[0], b = sp[1], c = sp[2], d = sp[3];
            rstd = rsqrtf((((a.x + a.y) + (a.z + a.w)) + ((b.x + b.y) + (b.z + b.w)) + ((c.x + c.y) + (c.z + c.w)) + ((d.x + d.y) + (d.z + d.w))) * (1.f / DM) + EPS); }
        unsigned char* ppb = ws + WS_PART; const unsigned po = ((unsigned)x * MTOK + row) * 256u + 32u * (unsigned)c8;
        v4u ra[8], rb[8]; v4u ia0 = EID_LD(0), ia1 = EID_LD(1), ib0 = EID_LD(2), ib1 = EID_LD(3);
        peer_issue8(ra, ia0, ia1, U, c16); ia0 = EID_LD(4); ia1 = EID_LD(5);
#pragma unroll 1
        for (int q = 0; q < 16; q += 2) {
            peer_issue8(rb, ib0, ib1, U, c16); { const int qn = (q + 3 < 16) ? q + 3 : 15; ib0 = EID_LD(2 * qn); ib1 = EID_LD(2 * qn + 1); }
            float k0 = 0.f, k1 = 0.f;
            { float d[8];
#pragma unroll
              for (int i = 0; i < 8; ++i) { d[i] = dot16_fp8(ra[i], xn); if (i < 7) TIE_ROW(d[i], ra[i + 1]); }
              k0 = rs8(d, c8); }
            peer_issue8(ra, ia0, ia1, U, c16); { const int qn = (q + 4 < 16) ? q + 4 : 15; ia0 = EID_LD(2 * qn); ia1 = EID_LD(2 * qn + 1); }
            { float d[8];
#pragma unroll
              for (int i = 0; i < 8; ++i) { d[i] = dot16_fp8(rb[i], xn); if (i < 7) TIE_ROW(d[i], rb[i + 1]); }
              k1 = rs8(d, c8); }
            *(unsigned*)(ppb + (po + 2u * (unsigned)q)) = pk2(k0 * rstd, k1 * rstd);
        }
    }
}
__device__ __forceinline__ void peer_w_rows(const Frame& F, const Args& A) {
    unsigned char* ws = A.ws; const int lane = lane_id();
    const float* SU = (const float*)(ws + WS_SU); const float* SV = (const float*)(ws + WS_SV);
    const int p0 = 2 * lane, k0 = 8 * (p0 & 15) + (p0 >> 4), k1 = k0 + 8;
    for (int m0 = F.gw; m0 < MTOK; m0 += 8 * F.NGW) {
        int e0[8], e1[8]; float g0[8], g1[8]; unsigned pw[8][8];
#pragma unroll
        for (int r = 0; r < 8; ++r) { const size_t row = (size_t)(m0 + r * F.NGW < MTOK ? m0 + r * F.NGW : m0);
            const int* EID = (const int*)(ws + WS_EID) + row * 128; const float* GW = (const float*)(ws + WS_GW) + row * 128;
            e0[r] = EID[k0]; e1[r] = EID[k1]; g0[r] = GW[k0]; g1[r] = GW[k1];
#pragma unroll
            for (int x = 0; x < 8; ++x) pw[r][x] = *(const unsigned*)((const bf16*)(ws + WS_PART) + ((size_t)x * MTOK + row) * 128 + p0); }
        float su0[8], su1[8], sv0[8], sv1[8];
#pragma unroll
        for (int r = 0; r < 8; ++r) { su0[r] = SU[e0[r]]; su1[r] = SU[e1[r]]; sv0[r] = SV[e0[r]]; sv1[r] = SV[e1[r]]; }
#pragma unroll
        for (int r = 0; r < 8; ++r) { if (m0 + r * F.NGW < MTOK) { const size_t row = (size_t)(m0 + r * F.NGW); float s0 = 0.f, s1 = 0.f;
#pragma unroll
            for (int x = 0; x < 8; ++x) { s0 += bflo(pw[r][x]); s1 += bfhi(pw[r][x]); }
            float* W = (float*)(ws + WS_W) + row * 128;
            W[k0] = gelu_tanh(s0 * su0[r]) * g0[r] * sv0[r]; W[k1] = gelu_tanh(s1 * su1[r]) * g1[r] * sv1[r]; } }
    }
}
__device__ __forceinline__ void peer_v_chunk(const Frame& F, const Args& A, LAS unsigned char* lds, int x, int chunk) {
    unsigned char* ws = A.ws; int lane = lane_id(); asm volatile("" : "+v"(lane));
    const int tk = lane >> 3, c8 = lane & 7;
    const unsigned char* V = ws + WS_V8 + (size_t)x * 16384 * 128; const unsigned c16 = 16u * (unsigned)c8;
    LAS unsigned char* st = lds + F.wave * PS_WAVE;
    peer_stage16(st, ws + WS_EID + (size_t)(chunk * PQ_CHUNK + F.wave * 16) * 512, lane);
    peer_stage16(st + 16 * PS_ROW, ws + WS_W + (size_t)(chunk * PQ_CHUNK + F.wave * 16) * 512, lane);
#pragma unroll 1
    for (int oc = 0; oc < 2; ++oc) {
        const unsigned row = (unsigned)(chunk * PQ_CHUNK + F.wave * 16 + oc * 8 + tk);
        const LAS unsigned char* est = st + (oc * 8 + tk) * PS_ROW;
#define W_LD(i_) (*(const LAS f32x4*)(est + 16 * PS_ROW + 16 * (i_)))
        f32x2 acc[8];
#pragma unroll
        for (int j = 0; j < 8; ++j) acc[j] = (f32x2){0.f, 0.f};
        v4u ra[8], rb[8]; v4u ia0 = EID_LD(0), ia1 = EID_LD(1), ib0 = EID_LD(2), ib1 = EID_LD(3); f32x4 wa0 = W_LD(0), wa1 = W_LD(1), wb0 = W_LD(2), wb1 = W_LD(3);
        peer_issue8(ra, ia0, ia1, V, c16); ia0 = EID_LD(4); ia1 = EID_LD(5);
#pragma unroll 1
        for (int q = 0; q < 16; q += 2) {
            peer_issue8(rb, ib0, ib1, V, c16); { const int qn = (q + 3 < 16) ? q + 3 : 15; ib0 = EID_LD(2 * qn); ib1 = EID_LD(2 * qn + 1); }
            { const f32x2 wp[4] = {{wa0.x, wa0.y}, {wa0.z, wa0.w}, {wa1.x, wa1.y}, {wa1.z, wa1.w}};
#pragma unroll
              for (int i = 0; i < 8; i += 2) { axpy16_fp8<0>(acc, wp[i >> 1], ra[i]); TIE_ROW(acc[7].y, ra[i + 1]); axpy16_fp8<1>(acc, wp[i >> 1], ra[i + 1]); if (i < 6) TIE_ROW(acc[7].y, ra[i + 2]); } }
            { const int qn = (q + 2 < 16) ? q + 2 : 15; wa0 = W_LD(2 * qn); wa1 = W_LD(2 * qn + 1); }
            peer_issue8(ra, ia0, ia1, V, c16); { const int qn = (q + 4 < 16) ? q + 4 : 15; ia0 = EID_LD(2 * qn); ia1 = EID_LD(2 * qn + 1); }
            { const f32x2 wp[4] = {{wb0.x, wb0.y}, {wb0.z, wb0.w}, {wb1.x, wb1.y}, {wb1.z, wb1.w}};
#pragma unroll
              for (int i = 0; i < 8; i += 2) { axpy16_fp8<0>(acc, wp[i >> 1], rb[i]); TIE_ROW(acc[7].y, rb[i + 1]); axpy16_fp8<1>(acc, wp[i >> 1], rb[i + 1]); if (i < 6) TIE_ROW(acc[7].y, rb[i + 2]); } }
            { const int qn = (q + 3 < 16) ? q + 3 : 15; wb0 = W_LD(2 * qn); wb1 = W_LD(2 * qn + 1); }
        }
        unsigned char* xr = ws + WS_XN + (row * 2048u + 256u * (unsigned)x + 32u * (unsigned)c8); float ss = 0.f;
        const v4u x2a = *(const v4u*)xr, x2b = *(const v4u*)(xr + 16);
        const unsigned xw[8] = {x2a.x, x2a.y, x2a.z, x2a.w, x2b.x, x2b.y, x2b.z, x2b.w};
        unsigned ow[8];
#pragma unroll
        for (int j = 0; j < 4; ++j) { f32x4 v; v.x = bflo(xw[2 * j]) + acc[2 * j].x; v.y = bfhi(xw[2 * j]) + acc[2 * j].y; v.z = bflo(xw[2 * j + 1]) + acc[2 * j + 1].x; v.w = bfhi(xw[2 * j + 1]) + acc[2 * j + 1].y;
            ss += (v.x * v.x + v.y * v.y) + (v.z * v.z + v.w * v.w); ow[2 * j] = pk2(v.x, v.y); ow[2 * j + 1] = pk2(v.z, v.w); }
        *(v4u*)xr = (v4u){ow[0], ow[1], ow[2], ow[3]}; *(v4u*)(xr + 16) = (v4u){ow[4], ow[5], ow[6], ow[7]};
        ss = red8(ss);
        if (c8 == 0) ((float*)(ws + WS_SSQ3))[row * 8 + x] = ss;
    }
#undef W_LD
#undef EID_LD
}
__device__ __forceinline__ void peer_final_rows(const Frame& F, const Args& A) {
    unsigned char* ws = A.ws; const int lane = lane_id(); const float* g = A.in[32];
    for (int m = F.gw; m < MTOK; m += F.NGW) {
        const f32x4 sa = *(const f32x4*)((const float*)(ws + WS_SSQ3) + (size_t)m * 8), sb = *(const f32x4*)((const float*)(ws + WS_SSQ3) + (size_t)m * 8 + 4);
        const float rstd = rsqrtf((((sa.x + sa.y) + (sa.z + sa.w)) + ((sb.x + sb.y) + (sb.z + sb.w))) * (1.f / DM) + EPS);
        f32x4* xr = (f32x4*)(A.out + (size_t)m * DM) + lane; const v2u* xb = (const v2u*)((const bf16*)(ws + WS_XN) + (size_t)m * DM) + lane;
#pragma unroll
        for (int j = 0; j < 4; ++j) { const v2u w = xb[64 * j]; const f32x4 gg = ((const f32x4*)g)[lane + 64 * j]; const f32x4 v = {bflo(w.x), bfhi(w.x), bflo(w.y), bfhi(w.y)}; __builtin_nontemporal_store(v * rstd * gg, xr + 64 * j); }
    }
}

typedef GAS unsigned gu32;
#define RLX_AGENT __ATOMIC_RELAXED, __HIP_MEMORY_SCOPE_AGENT
#define XB_TMO      128
#define XB_XCNT(j)  (256  + 64 * (j))
#define XB_XSUB(j)  (1280 + 64 * (j))
#define XB_XGEN(j)  (2304 + 64 * (j))
#define XB_TOP      3328
#define XB_TOPGEN   3392
#define XCD_BAR_WORDS 3456
#define XB_SPIN_CAP (1u << 18)

__device__ __forceinline__ unsigned xb_ld(unsigned* p)              { return __hip_atomic_load(p, __ATOMIC_RELAXED, __HIP_MEMORY_SCOPE_AGENT); }
__device__ __forceinline__ unsigned xb_add(unsigned* p, unsigned v) { return __hip_atomic_fetch_add(p, v, __ATOMIC_RELAXED, __HIP_MEMORY_SCOPE_AGENT); }
__device__ __forceinline__ unsigned xb_xcc_id() { return (unsigned)__builtin_amdgcn_s_getreg((3 << 11) | 20) & 0xFu; }
#define XB_SPIN(cond, bar) do { unsigned _sp = 0; while (cond) { __builtin_amdgcn_s_sleep(1); \
    if ((++_sp & 255u) == 0u) { if (xb_ld(&(bar)[XB_TMO])) break; if (_sp > XB_SPIN_CAP) { atomicAdd(&(bar)[XB_TMO], 1u); break; } } } } while (0)

struct XcdBarrier {
    unsigned* bar; unsigned x;
    volatile LAS unsigned* st;
};

__device__ __forceinline__ XcdBarrier xcd_barrier_post(unsigned* bar, volatile LAS unsigned* st) {
    XcdBarrier b; b.bar = bar; b.x = xb_xcc_id(); b.st = st;
    if (threadIdx.x == 0) (void)xb_add(&bar[XB_XCNT(b.x)], 1u);
    return b;
}
__device__ __forceinline__ void xcd_barrier_complete(unsigned* bar, unsigned x, unsigned& nloc, unsigned& nx) {
    const unsigned G = gridDim.x * gridDim.y * gridDim.z;
    unsigned sum, cnt, mine, sp = 0u;
    for (;;) {
        sum = 0u; cnt = 0u; mine = 0u;
#pragma unroll
        for (unsigned j = 0; j < 16; ++j) { const unsigned c = xb_ld(&bar[XB_XCNT(j)]); sum += c; cnt += (c > 0u) ? 1u : 0u; mine = (j == x) ? c : mine; }
        if (sum == G) break;
        __builtin_amdgcn_s_sleep(1);
        if ((++sp & 255u) == 0u) { if (xb_ld(&bar[XB_TMO])) break; if (sp > XB_SPIN_CAP) { atomicAdd(&bar[XB_TMO], 1u); break; } }
    }
    nloc = mine > 0u ? mine : 1u; nx = cnt > 0u ? cnt : 1u;
}

__device__ __forceinline__ void xcd_barrier(const XcdBarrier& b) {
    asm volatile("s_waitcnt vmcnt(0)" ::: "memory");
    __syncthreads();
    if (threadIdx.x == 0) {
        unsigned* bar = b.bar;
        __builtin_amdgcn_s_waitcnt(0);
        unsigned nloc = b.st[0], nx = b.st[1];
        if (nloc == 0u) { xcd_barrier_complete(bar, b.x, nloc, nx); b.st[0] = nloc; b.st[1] = nx; }
        const unsigned old = xb_add(&bar[XB_XSUB(b.x)], 1u);
        const unsigned gen = old / nloc;
        if (old + 1u == (gen + 1u) * nloc) {
            __builtin_amdgcn_fence(__ATOMIC_RELEASE, "agent");
            asm volatile("s_waitcnt vmcnt(0)" ::: "memory");
            const unsigned og = xb_add(&bar[XB_TOP], 1u);
            const unsigned tg = og / nx;
            if (og + 1u == (tg + 1u) * nx) xb_add(&bar[XB_TOPGEN], 1u);
            else XB_SPIN(xb_ld(&bar[XB_TOPGEN]) == tg, bar);
            __builtin_amdgcn_fence(__ATOMIC_ACQUIRE, "agent");
            xb_add(&bar[XB_XGEN(b.x)], 1u);
            asm volatile("s_waitcnt vmcnt(0)" ::: "memory");
        } else {
            XB_SPIN(xb_ld(&bar[XB_XGEN(b.x)]) == gen, bar);
            __builtin_amdgcn_fence(__ATOMIC_ACQUIRE, "agent");
            asm volatile("s_waitcnt vmcnt(0)" ::: "memory");
        }
    }
    __syncthreads();
}

#ifndef DBL_MASK
#define DBL_MASK 0
#endif
constexpr int NPHASE = 12;
__global__ void __launch_bounds__(512, 2) fwd_kernel(Args args) {
    extern __shared__ __attribute__((aligned(16))) unsigned char lds_raw[];
    LAS unsigned char* lds = (LAS unsigned char*)lds_raw;
    Frame F;
    F.tid = threadIdx.x; F.lane = F.tid & 63; F.wave = __builtin_amdgcn_readfirstlane(F.tid >> 6);
    F.G = gridDim.x; { const int bx = blockIdx.x; F.vcu = (F.G % 8 == 0) ? (bx % 8) * (F.G / 8) + bx / 8 : bx; }
    F.gw = F.vcu * 8 + F.wave; F.NGW = F.G * 8;
    unsigned char* ws = args.ws;
    const int lo = args.ph_lo, hi = args.ph_hi;
    volatile LAS unsigned* MISC = (volatile LAS unsigned*)(lds + LDS_BYTES - 64);
    if (F.tid < 16) MISC[F.tid] = 0u;
    __syncthreads();
    XcdBarrier bar = xcd_barrier_post((unsigned*)(ws + WS_CTL), MISC);
#define IN(k) (lo <= (k) && (k) < hi)
#define SEAM(k) do { if (IN(k) && IN((k) + 1)) xcd_barrier(bar); } while (0)

    if (IN(0)) for (int rep_ = 0; rep_ <= ((DBL_MASK >> 0) & 1); ++rep_) { if (rep_) xcd_barrier(bar); REFRESH_LANE(F); p0_prologue(F, args, lds); }
    SEAM(0);
    if (IN(1)) for (int rep_ = 0; rep_ <= ((DBL_MASK >> 1) & 1); ++rep_) { if (rep_) xcd_barrier(bar); REFRESH_LANE(F);
        { pg8::Gemm g{(const bf16*)(ws + WS_XN), (const bf16*)(ws + WS_WIN), MTOK, NZP, DM}; pg8::StaticOrder S; S.init(MTOK, NZP, F.G, (int)blockIdx.x);
          pg8::EpiZ E{(bf16*)(ws + WS_Z), (bf16*)(ws + WS_KSF), (bf16*)(ws + WS_VSF), (bf16*)(ws + WS_KWF), (bf16*)(ws + WS_VWF), (float*)(ws + WS_GATES), args.in[4], (unsigned*)(ws + WS_CTL) + CW_KMAX};
          pg8::gemm_phase<pg8::EpiZ, pg8::StaticOrder, true, true>(lds, g, S, E, F.wave); }
        { pg8::Gemm g{(const bf16*)(ws + WS_MEMN), (const bf16*)(ws + WS_WMK), NB * NMEM, DM, DM}; pg8::StaticOrder S; S.init(NB * NMEM, DM, F.G, ((int)blockIdx.x + 128) & 255);
          pg8::EpiStore E{(bf16*)(ws + WS_MEMK), DM, nullptr, 1};
          pg8::gemm_phase<pg8::EpiStore, pg8::StaticOrder, true, true>(lds, g, S, E, F.wave); }
        { pg8::Gemm g{(const bf16*)(ws + WS_WMV), (const bf16*)(ws + WS_MEMN), DM, NB * NMEM, DM}; pg8::StaticOrder S; S.init(DM, NB * NMEM, F.G, ((int)blockIdx.x + 120) & 255);
          pg8::EpiVFrag E{(bf16*)(ws + WS_MEMVT)};
          pg8::gemm_phase<pg8::EpiVFrag, pg8::StaticOrder, true, true>(lds, g, S, E, F.wave); }
    }
    SEAM(1);
    if (IN(2) && IN(3)) { REFRESH_LANE(F);
                 for (int it = F.G - 1 - F.vcu; it < 128; it += F.G) compress_item(F, args, lds, it);
                 for (int it = F.vcu; it < 256; it += F.G) lru_local_item(F, args, lds, it);
                 { unsigned* ctl_ = (unsigned*)(ws + WS_CTL);
                   if (F.wave == 0 && lane_id() == 0) { while (__hip_atomic_load(ctl_ + CW_CMPDONE, __ATOMIC_RELAXED, __HIP_MEMORY_SCOPE_AGENT) < 128u) __builtin_amdgcn_s_sleep(8);
                       __builtin_amdgcn_fence(__ATOMIC_ACQUIRE, "agent"); asm volatile("s_waitcnt vmcnt(0)" ::: "memory"); }
                   __syncthreads(); }
                 REFRESH_LANE(F);
                 if (F.gw < 16) { unsigned* ctl_ = (unsigned*)(ws + WS_CTL);
                     if (lane_id() == 0) { while (__hip_atomic_load(ctl_ + CW_LRUDONE, __ATOMIC_RELAXED, __HIP_MEMORY_SCOPE_AGENT) < 256u) __builtin_amdgcn_s_sleep(8); }
                     __builtin_amdgcn_fence(__ATOMIC_ACQUIRE, "agent");
                     lru_carry_scan(args, F.gw, lane_id()); }
                 bool fixed_done = false;
                 { unsigned* ctl = (unsigned*)(ws + WS_CTL); const int own = (int)(((long)F.vcu * 8) / F.G) & 7; int qs = 0;
                   for (;;) { int id = -1;
                       if (lane_id() == 0) { while (qs < 8) { const int x = (own + qs) & 7; const unsigned c = __hip_atomic_fetch_add(ctl + CW_NQ + 64 * x, 1u, __ATOMIC_RELAXED, __HIP_MEMORY_SCOPE_AGENT);
                               if (c < 512u) { id = x * 512 + (int)c; break; } ++qs; } }
                       id = __builtin_amdgcn_readfirstlane(id); qs = __builtin_amdgcn_readfirstlane(qs);
                       if (id < 0) break;
                       if (F.G == 256 && (id & 511) < 256) { const int qi = (id >> 9) * 256 + (id & 255);
                           quant_rows4_fp8(args.in[31] + (size_t)qi * DM, (size_t)2048 * DM, nullptr, ws + WS_V8 + (size_t)qi * 128, (float*)(ws + WS_SV) + qi, 2048, lane_id());
                           quant_rows4_fp8(args.in[31] + (size_t)(qi + 8192) * DM, (size_t)2048 * DM, nullptr, ws + WS_V8 + (size_t)(qi + 8192) * 128, (float*)(ws + WS_SV) + qi + 8192, 2048, lane_id());
                           quant_rows4_fp8(args.in[30] + (size_t)qi * DM, (size_t)2048 * DM, args.in[27], ws + WS_U8 + (size_t)qi * 128, (float*)(ws + WS_SU) + qi, 2048, lane_id());
                           quant_rows4_fp8(args.in[30] + (size_t)(qi + 8192) * DM, (size_t)2048 * DM, args.in[27], ws + WS_U8 + (size_t)(qi + 8192) * 128, (float*)(ws + WS_SU) + qi + 8192, 2048, lane_id()); }
                       const int x = id >> 9, i = id & 511; nsa_item(F, args, lds, x >> 2, (x >> 1) & 1, 2 * (63 - (i >> 3)) + (x & 1), 7 - (i & 7));
                       if (!fixed_done) { fixed_done = true;
                           if (lane_id() == 0) { while (__hip_atomic_load(ctl + CW_CFLAG, __ATOMIC_RELAXED, __HIP_MEMORY_SCOPE_AGENT) < 16u) __builtin_amdgcn_s_sleep(4); }
                           __builtin_amdgcn_wave_barrier();
                           for (int it = F.gw; it < MTOK / 8; it += F.NGW) lru_fix_wave(args, it, lane_id()); } }
                   if (!fixed_done) {
                       if (lane_id() == 0) { while (__hip_atomic_load(ctl + CW_CFLAG, __ATOMIC_RELAXED, __HIP_MEMORY_SCOPE_AGENT) < 16u) __builtin_amdgcn_s_sleep(4); }
                       __builtin_amdgcn_wave_barrier();
                       for (int it = F.gw; it < MTOK / 8; it += F.NGW) lru_fix_wave(args, it, lane_id()); } }
    }
    SEAM(3);
    if (IN(4)) for (int rep_ = 0; rep_ <= ((DBL_MASK >> 4) & 1); ++rep_) { if (rep_) xcd_barrier(bar); REFRESH_LANE(F);
        pg8::Gemm g{(const bf16*)(ws + WS_Y), (const bf16*)(ws + WS_WOUT), MTOK, DM, DM}; pg8::StaticOrder S; S.init(MTOK, DM, F.G, (int)blockIdx.x);
        pg8::EpiRes<true> E{nullptr, (const bf16*)(ws + WS_XN), nullptr, (bf16*)(ws + WS_XN), (float*)(ws + WS_SSQ1), (const float*)(ws + WS_SSQN), (const float*)(ws + WS_XINV)};
        pg8::gemm_phase<pg8::EpiRes<true>, pg8::StaticOrder, true, true>(lds, g, S, E, F.wave);
    }
    SEAM(4);
    if (IN(5)) { REFRESH_LANE(F);
        pg8::Gemm g{(const bf16*)(ws + WS_XN), (const bf16*)(ws + WS_WMQ), MTOK, DM, DM}; pg8::StaticOrder S; S.init(MTOK, DM, F.G, (int)blockIdx.x);
        if (F.G == 256) { pg8::EpiQLds E{(const float*)(ws + WS_SSQ1)};
            pg8::gemm_phase<pg8::EpiQLds, pg8::StaticOrder, true, true>(lds, g, S, E, F.wave);
            int pm, pn; pg8::unit_of(MTOK, DM, (int)blockIdx.x, pm, pn);
            REFRESH_LANE(F); memattn_fused(F, args, lds, pm, pn); }
        else { pg8::EpiStore E{(bf16*)(ws + WS_QM), DM, (const float*)(ws + WS_SSQ1), 1};
            pg8::gemm_phase<pg8::EpiStore, pg8::StaticOrder, true, true>(lds, g, S, E, F.wave); }
    }
    if (F.G != 256) { SEAM(5);
        if (IN(6)) { REFRESH_LANE(F); for (int it = F.vcu; it < 256; it += F.G) memattn_block(F, args, lds, it); } }
    SEAM(6);
    if (IN(7)) for (int rep_ = 0; rep_ <= ((DBL_MASK >> 7) & 1); ++rep_) { if (rep_) xcd_barrier(bar); REFRESH_LANE(F);
        pg8::Gemm g{(const bf16*)(ws + WS_OM), (const bf16*)(ws + WS_WMO), MTOK, DM, DM}; pg8::StaticOrder S; S.init(MTOK, DM, F.G, (int)blockIdx.x);
        pg8::EpiRes<false> E{nullptr, (const bf16*)(ws + WS_XN), nullptr, (bf16*)(ws + WS_XN), (float*)(ws + WS_SSQ2), nullptr, nullptr};
        pg8::gemm_phase<pg8::EpiRes<false>, pg8::StaticOrder, true, true>(lds, g, S, E, F.wave);
    }
    SEAM(7);
    if (IN(8) && F.G == 256) {
#pragma unroll 1
        for (int i = 0; i < 2; ++i) { REFRESH_LANE(F);
            { pg8::Gemm g{(const bf16*)(ws + WS_XN), (const bf16*)(ws + WS_WPQ), MTOK, 2048, DM}; pg8::StaticOrder S; S.init(MTOK, 2048, F.G, (int)blockIdx.x); S.range(i * F.G, (i + 1) * F.G);
              pg8::EpiQLds E{(const float*)(ws + WS_SSQ2)};
              pg8::gemm_phase<pg8::EpiQLds, pg8::StaticOrder, true, true>(lds, g, S, E, F.wave); }
            int pm, pn; pg8::unit_of(MTOK, 2048, i * F.G + (int)blockIdx.x, pm, pn);
            REFRESH_LANE(F);
            __syncthreads();
            bf16x8 qA[8], qB[8];
            { const LAS unsigned char* lf = lds + 16 * F.lane;
#pragma unroll
              for (int ks = 0; ks < 8; ++ks) { qA[ks] = *(const LAS bf16x8*)(lf + (F.wave * 16 + ks) * 1024); qB[ks] = *(const LAS bf16x8*)(lf + (F.wave * 16 + 8 + ks) * 1024); } }
            asm volatile("s_waitcnt lgkmcnt(0)" ::: "memory");
            __syncthreads();
#pragma unroll
            for (int ks = 0; ks < 8; ++ks) *(LAS bf16x8*)(lds + 65536 + F.wave * 8448 + ks * 1024 + 16 * F.lane) = qB[ks];
            { const v4u* src_ = (const v4u*)((const bf16*)(ws + WS_SKEY) + (size_t)pn * 8 * 4096); const int tid = F.wave * 64 + F.lane;
#pragma unroll
              for (int j = 0; j < 8; ++j) ((LAS v4u*)lds)[tid + 512 * j] = src_[tid + 512 * j]; }
            __syncthreads();
            peer_topk_item<true, true>(F, args, (pm * 8 + F.wave) * 8 + pn, lds, qA);
            __syncthreads(); }
    }
    if (F.G != 256) {
    if (IN(8)) for (int rep_ = 0; rep_ <= ((DBL_MASK >> 8) & 1); ++rep_) { if (rep_) xcd_barrier(bar); REFRESH_LANE(F);
        pg8::Gemm g{(const bf16*)(ws + WS_XN), (const bf16*)(ws + WS_WPQ), MTOK, 2048, DM}; pg8::StaticOrder S; S.init(MTOK, 2048, F.G, (int)blockIdx.x);
        pg8::EpiStore E{(bf16*)(ws + WS_QP), 2048, (const float*)(ws + WS_SSQ2), 1};
        pg8::gemm_phase<pg8::EpiStore, pg8::StaticOrder, true, true>(lds, g, S, E, F.wave);
    }
    SEAM(8);
    if (IN(9)) for (int rep_ = 0; rep_ <= ((DBL_MASK >> 9) & 1); ++rep_) { if (rep_) xcd_barrier(bar); REFRESH_LANE(F); for (int gi = F.vcu; gi < 256; gi += F.G) {
                     const int h = gi & 7, tgp = gi >> 3;
                     { const v4u* src = (const v4u*)((const bf16*)(ws + WS_SKEY) + (size_t)h * 8 * 4096); const int tid = F.wave * 64 + lane_id();
#pragma unroll
                       for (int i = 0; i < 8; ++i) ((LAS v4u*)lds)[tid + 512 * i] = src[tid + 512 * i]; }
                     __syncthreads();
                     peer_topk_item<true>(F, args, (tgp * 16 + F.wave) * 8 + h, lds); peer_topk_item<true>(F, args, (tgp * 16 + 8 + F.wave) * 8 + h, lds);
                     __syncthreads(); } }
    }
    SEAM(9);
    if (IN(10)) {   REFRESH_LANE(F);
        LAS int* bc = (LAS int*)(lds + LDS_BYTES - 128); unsigned* ctl = (unsigned*)(ws + WS_CTL); const int own = (int)(bar.x & 7u);
        { int qs = 0; int id = __builtin_amdgcn_readfirstlane(pq_pop(ctl, 0, own, qs, bc, F.wave)); int par = 0;
          while (id >= 0) { const unsigned tk_ = PQ_TICKET(0, own, qs); peer_u_chunk(F, args, lds, id / PQ_NCHUNK, id % PQ_NCHUNK); par ^= 2; id = __builtin_amdgcn_readfirstlane(pq_resolve(ctl, 0, own, qs, tk_, bc + par, F.wave)); } }
        xcd_barrier(bar);
        peer_w_rows(F, args);
        xcd_barrier(bar);
        { int qs = 0; int id = __builtin_amdgcn_readfirstlane(pq_pop(ctl, 1, own, qs, bc, F.wave)); int par = 0;
          while (id >= 0) { const unsigned tk_ = PQ_TICKET(1, own, qs); peer_v_chunk(F, args, lds, id / PQ_NCHUNK, id % PQ_NCHUNK); par ^= 2; id = __builtin_amdgcn_readfirstlane(pq_resolve(ctl, 1, own, qs, tk_, bc + par, F.wave)); } }
        xcd_barrier(bar);
        peer_final_rows(F, args);
    }
#undef IN
#undef SEAM
}

extern "C" void kernel_launch(void* const* d_in, const int* in_sizes, int n_in, void* d_out, int out_size, void* d_ws, size_t ws_size, hipStream_t stream) {
    static int grid = 0;
    if (grid == 0) {
        if (n_in != 33 || out_size != MTOK * DM || ws_size < WS_END) { fprintf(stderr, "kernel_launch: unexpected problem (n_in %d, out %d, ws %zu)\n", n_in, out_size, ws_size); grid = -1; return; }
        int dev = 0, cus = 0, per_cu = 0;
        (void)hipGetDevice(&dev); (void)hipDeviceGetAttribute(&cus, hipDeviceAttributeMultiprocessorCount, dev);
        (void)hipFuncSetAttribute((const void*)fwd_kernel, hipFuncAttributeMaxDynamicSharedMemorySize, LDS_BYTES);
        (void)hipOccupancyMaxActiveBlocksPerMultiprocessor(&per_cu, (const void*)fwd_kernel, 512, LDS_BYTES);
        if (per_cu < 1) { fprintf(stderr, "kernel_launch: occupancy query says %d blocks per CU\n", per_cu); per_cu = 1; }
        grid = cus * 1;
        if (grid != 256) fprintf(stderr, "kernel_launch: %d CUs (built for 256)\n", cus);
    }
    if (grid < 0) return;
    (void)hipMemsetAsync((char*)d_ws + WS_CTL, 0, 65536, stream);
    Args a{};
    for (int i = 0; i < 33; ++i) a.in[i] = (const float*)d_in[i];
    a.out = (float*)d_out; a.ws = (unsigned char*)d_ws; a.ph_lo = 0; a.ph_hi = NPHASE;
    void* kargs[] = {&a};
    hipError_t e = hipLaunchCooperativeKernel((const void*)fwd_kernel, dim3(grid), dim3(512), kargs, LDS_BYTES, stream);
    if (e != hipSuccess) fprintf(stderr, "cooperative launch failed: %s (grid %d)\n", hipGetErrorString(e), grid);
}
```
